# Optimizing an MI355X kernel written in HIP

```python
import math
import jax, jax.numpy as jnp
from jax import lax
import numpy as np

D_MODEL = 2048
BATCH = 2
SEQ = 8192
DEPTH = 2

N_MEM = 256
MEM_HEADS = 4
MEM_HEAD_DIM = D_MODEL // MEM_HEADS
CONV_WIDTH = D_MODEL // 4
CONV_GROUPS = 4
CONV_K = 3
GMLP_WIDTH = D_MODEL // 4
GMLP_GROUPS = 4
GMLP_GROUP_DIM = GMLP_WIDTH // GMLP_GROUPS
CHUNK = 128
DIFF_HEAD_DIM = 128
DIFF_WIDTH = D_MODEL // 2
DIFF_HEADS = DIFF_WIDTH // (2 * DIFF_HEAD_DIM)
Q_BLOCK = 128
MIX_WIDTH = CONV_WIDTH + GMLP_WIDTH + DIFF_WIDTH
SPLITS = (CONV_WIDTH, 2 * CONV_WIDTH, 3 * CONV_WIDTH,
          3 * CONV_WIDTH + GMLP_WIDTH, 3 * CONV_WIDTH + 2 * GMLP_WIDTH,
          3 * CONV_WIDTH + 2 * GMLP_WIDTH + DIFF_WIDTH,
          3 * CONV_WIDTH + 2 * GMLP_WIDTH + 2 * DIFF_WIDTH)
IN_COLS = 3 * CONV_WIDTH + 2 * GMLP_WIDTH + 3 * DIFF_WIDTH
NUM_BUCKETS = 32
MAX_DISTANCE = 128
BIAS_HEADS = 2 * DIFF_HEADS
D_FF = -(-8 * D_MODEL // (3 * 256)) * 256
ALPHA = (2 * DEPTH) ** 0.25
BETA = (8 * DEPTH) ** -0.25
LN_EPS = 1e-5

kernel_name = "hybrid_conv_gmlp_diffattn_deepnorm"


def layer_norm(x, g, b):
    xf = x.astype(jnp.float32)
    mu = jnp.mean(xf, axis=-1, keepdims=True)
    var = jnp.mean(jnp.square(xf - mu), axis=-1, keepdims=True)
    return ((xf - mu) * lax.rsqrt(var + LN_EPS) * g + b).astype(x.dtype)


def rms_norm(x, g):
    xf = x.astype(jnp.float32)
    return xf * lax.rsqrt(jnp.mean(xf * xf, axis=-1, keepdims=True) + LN_EPS) * g


def causal_bucket(n):
    max_exact = NUM_BUCKETS // 2
    nf = jnp.maximum(n, 1).astype(jnp.float32)
    large = max_exact + (jnp.log(nf / max_exact) / math.log(MAX_DISTANCE / max_exact)
                         * (NUM_BUCKETS - max_exact)).astype(jnp.int32)
    large = jnp.minimum(large, NUM_BUCKETS - 1)
    return jnp.where(n < max_exact, n, large)


def short_conv_mixer(b_gate, c_gate, h, conv_w):
    z = c_gate * h
    y = lax.conv_general_dilated(
        z, conv_w[:, None, :].astype(z.dtype), window_strides=(1,),
        padding=[(CONV_K - 1, 0)], dimension_numbers=('NWC', 'WIO', 'NWC'),
        feature_group_count=CONV_WIDTH)
    return b_gate * y


def chunk_gmlp_mixer(u, v, ln_g, ln_b, w_s, b_s):
    bsz, seq, _ = v.shape
    u = jax.nn.gelu(u)
    v = layer_norm(jax.nn.gelu(v), ln_g, ln_b)
    vc = v.reshape(bsz, seq // CHUNK, CHUNK, GMLP_GROUPS, GMLP_GROUP_DIM)
    causal = jnp.tril(jnp.ones((CHUNK, CHUNK), dtype=bool))
    ws = jnp.where(causal, w_s, jnp.zeros_like(w_s))
    sv = jnp.einsum('gts,bnsgc->bntgc', ws, vc) + jnp.transpose(b_s)[None, None, :, :, None]
    return u * sv.reshape(bsz, seq, GMLP_WIDTH)


def diff_attention(q, k, v, lam, lam_init, subln_g, bias_by_dist):
    bsz, seq = q.shape[0], q.shape[1]
    nb = seq // Q_BLOCK
    scale = DIFF_HEAD_DIM ** -0.5
    qb = jnp.moveaxis(q.reshape(bsz, nb, Q_BLOCK, DIFF_HEADS, 2, DIFF_HEAD_DIM), 1, 0)
    k_pos = jnp.arange(seq)

    def block(args):
        q_blk, i = args
        q_pos = i * Q_BLOCK + jnp.arange(Q_BLOCK)
        dist = q_pos[:, None] - k_pos[None, :]
        bias = jnp.transpose(bias_by_dist[jnp.maximum(dist, 0)], (2, 3, 0, 1))
        logits = jnp.einsum('bqhmd,bkhmd->bhmqk', q_blk, k).astype(jnp.float32) * scale + bias
        logits = jnp.where(dist >= 0, logits, -jnp.inf)
        p = jax.nn.softmax(logits, axis=-1)
        a = p[:, :, 0] - lam * p[:, :, 1]
        return jnp.einsum('bhqk,bkhe->bqhe', a, v)

    out = lax.map(block, (qb, jnp.arange(nb)))
    out = jnp.moveaxis(out, 0, 1).reshape(bsz, seq, DIFF_HEADS, 2 * DIFF_HEAD_DIM)
    out = rms_norm(out, subln_g) * (1.0 - lam_init)
    return out.reshape(bsz, seq, DIFF_WIDTH).astype(v.dtype)


def hybrid_mixer(x, lam_init, bias_by_dist, w_in, conv_w, gmlp_ln_g, gmlp_ln_b,
                 gmlp_ws, gmlp_bs, lambda_q, lambda_k, subln_g, w_out):
    bsz, seq, _ = x.shape
    proj = x @ w_in
    b_gate, c_gate, h, u, v, q, k, va = jnp.split(proj, SPLITS, axis=-1)
    y_a = short_conv_mixer(b_gate, c_gate, h, conv_w)
    y_b = chunk_gmlp_mixer(u, v, gmlp_ln_g, gmlp_ln_b, gmlp_ws, gmlp_bs)
    lq = lambda_q.astype(jnp.float32)
    lk = lambda_k.astype(jnp.float32)
    lam = jnp.exp(jnp.sum(lq[0] * lk[0])) - jnp.exp(jnp.sum(lq[1] * lk[1])) + lam_init
    y_c = diff_attention(q.reshape(bsz, seq, DIFF_HEADS, 2, DIFF_HEAD_DIM),
                         k.reshape(bsz, seq, DIFF_HEADS, 2, DIFF_HEAD_DIM),
                         va.reshape(bsz, seq, DIFF_HEADS, 2 * DIFF_HEAD_DIM),
                         lam, lam_init, subln_g, bias_by_dist)
    y = jnp.concatenate([y_a, y_b.astype(y_a.dtype), y_c.astype(y_a.dtype)], axis=-1)
    return y @ w_out


def memory_attention(x, mem, w_q, w_kv, w_o):
    bsz, seq, _ = x.shape
    n_mem = mem.shape[1]
    q = (x @ w_q).reshape(bsz, seq, MEM_HEADS, MEM_HEAD_DIM)
    kv = (mem @ w_kv).reshape(bsz, n_mem, 2, MEM_HEADS, MEM_HEAD_DIM)
    k, v = kv[:, :, 0], kv[:, :, 1]
    logits = jnp.einsum('bshd,bmhd->bhsm', q, k).astype(jnp.float32) * MEM_HEAD_DIM ** -0.5
    p = jax.nn.softmax(logits, axis=-1).astype(x.dtype)
    o = jnp.einsum('bhsm,bmhd->bshd', p, v).reshape(bsz, seq, MEM_HEADS * MEM_HEAD_DIM)
    return o @ w_o


def swiglu(x, w_gu, w_down):
    g, u = jnp.split(x @ w_gu, 2, axis=-1)
    return (jax.nn.silu(g) * u) @ w_down


def setup_inputs(seed: int = 0) -> dict:
    key = jax.random.key(seed)
    ks = jax.random.split(key, 32)
    f32 = jnp.float32

    def nrm(k, shape, scale):
        return jax.random.normal(k, shape, f32) * scale

    def gain(k, shape):
        return 1.0 + 0.02 * jax.random.normal(k, shape, f32)

    L = DEPTH
    return {
        "x": nrm(ks[0], (BATCH, SEQ, D_MODEL), 1.0),
        "mem": nrm(ks[1], (BATCH, N_MEM, D_MODEL), 1.0),
        "rel_bias": nrm(ks[2], (NUM_BUCKETS, BIAS_HEADS), 0.5),
        "w_in": nrm(ks[3], (L, D_MODEL, IN_COLS), D_MODEL ** -0.5),
        "conv_w": nrm(ks[4], (L, CONV_K, CONV_WIDTH), CONV_K ** -0.5),
        "gmlp_ln_g": gain(ks[5], (L, GMLP_WIDTH)),
        "gmlp_ln_b": nrm(ks[6], (L, GMLP_WIDTH), 0.02),
        "gmlp_ws": nrm(ks[7], (L, GMLP_GROUPS, CHUNK, CHUNK), CHUNK ** -0.5),
        "gmlp_bs": 1.0 + nrm(ks[8], (L, GMLP_GROUPS, CHUNK), 0.05),
        "diff_lambda_q": nrm(ks[9], (L, 2, DIFF_HEAD_DIM), 0.1),
        "diff_lambda_k": nrm(ks[10], (L, 2, DIFF_HEAD_DIM), 0.1),
        "diff_subln_g": gain(ks[11], (L, 2 * DIFF_HEAD_DIM)),
        "w_mix_out": nrm(ks[12], (L, MIX_WIDTH, D_MODEL), BETA * MIX_WIDTH ** -0.5),
        "ln_mix_g": gain(ks[13], (L, D_MODEL)),
        "ln_mix_b": nrm(ks[14], (L, D_MODEL), 0.02),
        "w_mem_q": nrm(ks[15], (L, D_MODEL, D_MODEL), D_MODEL ** -0.5),
        "w_mem_kv": nrm(ks[16], (L, D_MODEL, 2 * D_MODEL), D_MODEL ** -0.5),
        "w_mem_out": nrm(ks[17], (L, D_MODEL, D_MODEL), BETA * D_MODEL ** -0.5),
        "ln_mem_g": gain(ks[18], (L, D_MODEL)),
        "ln_mem_b": nrm(ks[19], (L, D_MODEL), 0.02),
        "w_ffn_gu": nrm(ks[20], (L, D_MODEL, 2 * D_FF), D_MODEL ** -0.5),
        "w_ffn_down": nrm(ks[21], (L, D_FF, D_MODEL), BETA * D_FF ** -0.5),
        "ln_ffn_g": gain(ks[22], (L, D_MODEL)),
        "ln_ffn_b": nrm(ks[23], (L, D_MODEL), 0.02),
    }


def reference(x, mem, rel_bias, w_in, conv_w, gmlp_ln_g, gmlp_ln_b, gmlp_ws, gmlp_bs,
              diff_lambda_q, diff_lambda_k, diff_subln_g, w_mix_out, ln_mix_g, ln_mix_b,
              w_mem_q, w_mem_kv, w_mem_out, ln_mem_g, ln_mem_b,
              w_ffn_gu, w_ffn_down, ln_ffn_g, ln_ffn_b):
    seq = x.shape[1]
    bias_by_dist = rel_bias.astype(jnp.float32)[causal_bucket(jnp.arange(seq))]
    bias_by_dist = bias_by_dist.reshape(seq, DIFF_HEADS, 2)
    for l in range(DEPTH):
        lam_init = 0.8 - 0.6 * math.exp(-0.3 * l)
        mix = hybrid_mixer(x, lam_init, bias_by_dist, w_in[l], conv_w[l], gmlp_ln_g[l],
                           gmlp_ln_b[l], gmlp_ws[l], gmlp_bs[l], diff_lambda_q[l],
                           diff_lambda_k[l], diff_subln_g[l], w_mix_out[l])
        x = layer_norm(ALPHA * x + mix, ln_mix_g[l], ln_mix_b[l])
        x = layer_norm(ALPHA * x + memory_attention(x, mem, w_mem_q[l], w_mem_kv[l], w_mem_out[l]),
                       ln_mem_g[l], ln_mem_b[l])
        x = layer_norm(ALPHA * x + swiglu(x, w_ffn_gu[l], w_ffn_down[l]),
                       ln_ffn_g[l], ln_ffn_b[l])
    return x
```

```cpp
#include <hip/hip_runtime.h>
#include <hip/hip_cooperative_groups.h>
#include <hip/hip_bf16.h>
#include <cstdio>
#include <cstdint>
namespace cg = cooperative_groups;

constexpr int BATCH = 2, SEQ = 8192, DM = 2048, DEPTH = 2, T = BATCH * SEQ;
constexpr int NMEM = 256, INC = 5632, DFF = 5632;
constexpr float ALPHA = 1.4142135623730951f;
constexpr float LN_EPS = 1e-5f;
constexpr int NTHR = 512, NWAVES = 8;

constexpr size_t MiB = 1u << 20;
constexpr size_t WS_LAM = 0;
constexpr size_t WS_BTAB = 4096;
constexpr size_t WS_BAR = 512 * 1024;
constexpr size_t WS_C = 576 * 1024;
constexpr int C_Q = 0, C_GU = 4096, C_IN = 4096 + 22528, C_QK2 = 4096 + 22528 + 11264, C_LAYER = C_QK2 + 2048;
constexpr size_t WS_ST = 12 * MiB;
constexpr size_t WS_WTRIL = 1 * MiB;
constexpr size_t WS_MEMBF = 2 * MiB;
constexpr size_t WS_KV = 4 * MiB;
constexpr size_t WS_W = 16 * MiB;
constexpr size_t W_IN = 0, W_OUT = 22 * MiB, W_Q = 30 * MiB, W_KV = 38 * MiB, W_O = 54 * MiB, W_GU = 62 * MiB, W_D = 106 * MiB, W_LAYER = 128 * MiB;
constexpr size_t WS_XN = 272 * MiB;
constexpr size_t WS_PROJ = 336 * MiB;
constexpr size_t WS_R1 = 512 * MiB;
constexpr size_t WS_Y = 640 * MiB;
constexpr size_t WS_END = 704 * MiB;
constexpr int LDS_BYTES = 147456;

typedef unsigned short bf16_t;
typedef short bf16x8 __attribute__((ext_vector_type(8)));
typedef float f32x4 __attribute__((ext_vector_type(4)));
typedef float f32x16 __attribute__((ext_vector_type(16)));
typedef unsigned u32x4 __attribute__((ext_vector_type(4)));
typedef unsigned u32x2 __attribute__((ext_vector_type(2)));
#define LAS __attribute__((address_space(3)))
#define GAS __attribute__((address_space(1)))

__device__ __forceinline__ unsigned cvt_pk_bf16(float lo, float hi) { unsigned r; asm volatile("v_cvt_pk_bf16_f32 %0, %1, %2" : "=v"(r) : "v"(lo), "v"(hi)); return r; }
__device__ __forceinline__ float bf_lo(unsigned w) { return __uint_as_float(w << 16); }
__device__ __forceinline__ float bf_hi(unsigned w) { return __uint_as_float(w & 0xffff0000u); }
__device__ __forceinline__ float bf2f(bf16_t b) { return __uint_as_float(((unsigned)b) << 16); }
__device__ __forceinline__ bf16_t f2bf(float f) { return (bf16_t)(cvt_pk_bf16(f, 0.f) & 0xffffu); }
__device__ __forceinline__ int ltid() { int t = threadIdx.x; asm volatile("" : "+v"(t)); return t; }
__device__ __forceinline__ int cu_opaque() { int c = blockIdx.x; asm volatile("" : "+s"(c)); return c; }
#define PH_IDS const int cu = cu_opaque(); const int tid = ltid(), lane = tid & 63, wave = __builtin_amdgcn_readfirstlane(tid >> 6), gw = cu * NWAVES + wave, gt = cu * NTHR + tid; (void)lane; (void)wave; (void)gw; (void)gt
__device__ __forceinline__ float wave_sum(float v) {
#pragma unroll
    for (int o = 1; o < 64; o <<= 1) v += __shfl_xor(v, o);
    return v;
}
__device__ __forceinline__ float wave_max(float v) {
#pragma unroll
    for (int o = 1; o < 64; o <<= 1) v = fmaxf(v, __shfl_xor(v, o));
    return v;
}
__device__ __forceinline__ float gelu_tanh(float x) {
    const float y = 0.7978845608028654f * (x + 0.044715f * x * x * x);
    return x * __builtin_amdgcn_rcpf(1.f + __expf(-2.f * y));
}

namespace pg8 {
constexpr int BM = 256, BK = 64, HALF = 128, HTB = HALF * BK * 2, STAGE_BYTES = 8 * HTB, NXCD = 8, WGM = 8;
__host__ __device__ __forceinline__ int lds_byte(int r, int c) { const int st = (r >> 4) * 2 + (c >> 5), rr = r & 15, cc = c & 31, ob = rr * 64 + cc * 2; return st * 1024 + (ob ^ (((ob >> 9) & 1) << 5)); }
__host__ __device__ __forceinline__ void stage_rc(int b, int& R, int& C) { const int st = b / 1024, sb = b % 1024, swz = sb ^ (((sb >> 9) & 1) << 5); R = (st >> 1) * 16 + swz / 64; C = (st & 1) * 32 + (swz % 64) / 2; }
__host__ __device__ __forceinline__ int perm32(int rho) { const int n = rho >> 4, i = rho & 15; return 8 * (i >> 2) + 4 * n + (i & 3); }

struct Unit { int pm, pn, bz; };
struct Gemm { const bf16_t* A; const bf16_t* Bt; int lda, ldb, K, nb0; long a_s1, a_s0, b_s1, b_s0; };
__device__ __forceinline__ const char* unit_a(const Gemm& g, const Unit& u) { const int b1 = u.bz / g.nb0, b0 = u.bz % g.nb0; return (const char*)(g.A + (size_t)b1 * g.a_s1 + (size_t)b0 * g.a_s0 + (size_t)u.pm * BM * g.lda); }
__device__ __forceinline__ const char* unit_b(const Gemm& g, const Unit& u) { const int b1 = u.bz / g.nb0, b0 = u.bz % g.nb0; return (const char*)(g.Bt + (size_t)b1 * g.b_s1 + (size_t)b0 * g.b_s0 + (size_t)u.pn * BM * g.ldb); }

struct Order {
    int nM, nN, nB, G, c;
    __device__ void init(int M, int N, int nB_, int G_, int c_) { nM = M / BM; nN = N / BM; nB = nB_; G = G_; c = c_; }
    __device__ bool next(int i, Unit& u) const {
        const long L = (long)i * G + c; const int nwg = nM * nN; if (c < 0 || L >= (long)nwg * nB) return false;
        if (nB > 1) { u.bz = (int)(L / nwg); const int w = (int)(L % nwg); u.pn = w / nM; u.pm = w % nM; return true; }
        u.bz = 0;
        int wgid = (int)L; { const int q = nwg / NXCD, r = nwg % NXCD, xcd = wgid % NXCD, off = wgid / NXCD; wgid = (xcd < r ? xcd * (q + 1) : r * (q + 1) + (xcd - r) * q) + off; }
        const int nig = WGM * nN, gid = wgid / nig, fm = gid * WGM, gsz = (nM - fm) < WGM ? (nM - fm) : WGM;
        u.pm = fm + ((wgid % nig) % gsz); u.pn = (wgid % nig) / gsz; return true;
    }
};

__device__ __forceinline__ void row_stats(const float* st, int row, float& mean, float& rstd) {
    const float s1 = st[2 * row], s2 = st[2 * row + 1];
    mean = s1 * (1.f / DM); const float var = fmaxf(s2 * (1.f / DM) - mean * mean, 0.f); rstd = rsqrtf(var + LN_EPS);
}
struct EpiSplit {
    static constexpr bool PERM = true, AFTER_DRAIN = false;
    bf16_t* P; const float* st; const float* c1; const float* c2;
    __device__ __forceinline__ void operator()(const f32x4 (&acc)[2][2][4][2], const Unit& u, int wr, int wc, int fr, int fq) const {
        const int row0 = u.pm * BM + wr * 64 + fr, col0 = u.pn * BM + wc * 32 + 8 * fq;
        f32x4 k1[2][2], k2[2][2];
        if (st) {
#pragma unroll
            for (int bj = 0; bj < 2; ++bj)
#pragma unroll
                for (int n = 0; n < 2; ++n) { k1[bj][n] = *(const f32x4*)(c1 + col0 + bj * HALF + 4 * n); k2[bj][n] = *(const f32x4*)(c2 + col0 + bj * HALF + 4 * n); } }
#pragma unroll
        for (int ai = 0; ai < 2; ++ai)
#pragma unroll
            for (int m = 0; m < 4; ++m) { const int row = row0 + ai * HALF + m * 16;
                float mean = 0.f, rstd = 1.f; if (st) row_stats(st, row, mean, rstd);
#pragma unroll
                for (int bj = 0; bj < 2; ++bj) { f32x4 v0 = acc[ai][bj][m][0], v1 = acc[ai][bj][m][1];
                    if (st) { v0 = (v0 - k1[bj][0] * mean) * rstd + k2[bj][0]; v1 = (v1 - k1[bj][1] * mean) * rstd + k2[bj][1]; }
                    u32x4 w; w.x = cvt_pk_bf16(v0[0], v0[1]); w.y = cvt_pk_bf16(v0[2], v0[3]); w.z = cvt_pk_bf16(v1[0], v1[1]); w.w = cvt_pk_bf16(v1[2], v1[3]);
                    *(u32x4*)(P + ((size_t)(u.pn * 2 + bj) * T + row) * 128 + wc * 32 + 8 * fq) = w; } }
    }
};
struct EpiBf16 {
    static constexpr bool PERM = true, AFTER_DRAIN = false;
    bf16_t* O; int ldc, nb0; long o_s1, o_s0; float scale; const float* st; const float* c1; const float* c2; float* rsum;
    __device__ __forceinline__ void operator()(const f32x4 (&acc)[2][2][4][2], const Unit& u, int wr, int wc, int fr, int fq) const {
        const int row0 = u.pm * BM + wr * 64 + fr, col0 = u.pn * BM + wc * 32 + 8 * fq;
        bf16_t* base = O + (size_t)(u.bz / nb0) * o_s1 + (size_t)(u.bz % nb0) * o_s0;
        f32x4 k1[2][2], k2[2][2];
        if (st) {
#pragma unroll
            for (int bj = 0; bj < 2; ++bj)
#pragma unroll
                for (int n = 0; n < 2; ++n) { k1[bj][n] = *(const f32x4*)(c1 + col0 + bj * HALF + 4 * n); k2[bj][n] = *(const f32x4*)(c2 + col0 + bj * HALF + 4 * n); } }
#pragma unroll
        for (int ai = 0; ai < 2; ++ai)
#pragma unroll
            for (int m = 0; m < 4; ++m) { const int row = row0 + ai * HALF + m * 16; bf16_t* rowp = base + (size_t)row * ldc + col0;
                float mean = 0.f, rstd = 1.f; if (st) row_stats(st, row, mean, rstd);
                float rs = 0.f;
#pragma unroll
                for (int bj = 0; bj < 2; ++bj) { f32x4 v0 = acc[ai][bj][m][0], v1 = acc[ai][bj][m][1];
                    if (st) { v0 = (v0 - k1[bj][0] * mean) * rstd + k2[bj][0]; v1 = (v1 - k1[bj][1] * mean) * rstd + k2[bj][1]; }
                    v0 = v0 * scale; v1 = v1 * scale;
                    u32x4 w; w.x = cvt_pk_bf16(v0[0], v0[1]); w.y = cvt_pk_bf16(v0[2], v0[3]); w.z = cvt_pk_bf16(v1[0], v1[1]); w.w = cvt_pk_bf16(v1[2], v1[3]);
                    *(u32x4*)(rowp + bj * HALF) = w;
                    if (rsum) rs += ((bf_lo(w.x) + bf_hi(w.x)) + (bf_lo(w.y) + bf_hi(w.y))) + ((bf_lo(w.z) + bf_hi(w.z)) + (bf_lo(w.w) + bf_hi(w.w))); }
                if (rsum) { rs += __shfl_xor(rs, 16); rs += __shfl_xor(rs, 32); if (fq == 0) unsafeAtomicAdd(rsum + u.bz * 256 + row, rs); } }
    }
};
struct EpiF32 {
    static constexpr bool PERM = false, AFTER_DRAIN = false;
    float* out; int ldc; long o_bs; float scale;
    __device__ __forceinline__ void operator()(const f32x4 (&acc)[2][2][4][2], const Unit& u, int wr, int wc, int fr, int fq) const {
        const int row0 = u.pm * BM + wr * 64 + fr, col0 = u.pn * BM + wc * 32 + 4 * fq;
        float* ob = out + (size_t)u.bz * o_bs;
#pragma unroll
        for (int ai = 0; ai < 2; ++ai)
#pragma unroll
            for (int m = 0; m < 4; ++m) { const size_t off = (size_t)(row0 + ai * HALF + m * 16) * ldc + col0;
#pragma unroll
                for (int bj = 0; bj < 2; ++bj)
#pragma unroll
                    for (int n = 0; n < 2; ++n) *(f32x4*)(ob + off + bj * HALF + n * 16) = acc[ai][bj][m][n] * scale; }
    }
};
struct EpiRes {
    static constexpr bool PERM = true, AFTER_DRAIN = false;
    float* X; const float* raw; const float* pst; const float* pg; const float* pb; bf16_t* ZB; float* cst; float alpha; int brows;
    __device__ __forceinline__ void operator()(const f32x4 (&acc)[2][2][4][2], const Unit& u, int wr, int wc, int fr, int fq) const {
        const int row0 = u.bz * brows + u.pm * BM + wr * 64 + fr, col0 = u.pn * BM + wc * 32 + 8 * fq;
        f32x4 gv[2][2], bv[2][2];
        if (!raw) {
#pragma unroll
            for (int bj = 0; bj < 2; ++bj)
#pragma unroll
                for (int n = 0; n < 2; ++n) { gv[bj][n] = *(const f32x4*)(pg + col0 + bj * HALF + 4 * n); bv[bj][n] = *(const f32x4*)(pb + col0 + bj * HALF + 4 * n); } }
#pragma unroll
        for (int ai = 0; ai < 2; ++ai)
#pragma unroll
            for (int m = 0; m < 4; ++m) { const int row = row0 + ai * HALF + m * 16; const size_t off = (size_t)row * DM + col0;
                float mean = 0.f, rstd = 1.f; if (!raw) row_stats(pst, row, mean, rstd);
                float s1 = 0.f, s2 = 0.f;
#pragma unroll
                for (int bj = 0; bj < 2; ++bj) { f32x4 r0, r1;
                    if (raw) { r0 = *(const f32x4*)(raw + off + bj * HALF); r1 = *(const f32x4*)(raw + off + bj * HALF + 4); }
                    else { const u32x4 zw = *(const u32x4*)(ZB + off + bj * HALF);
                        r0 = (f32x4){bf_lo(zw.x), bf_hi(zw.x), bf_lo(zw.y), bf_hi(zw.y)}; r1 = (f32x4){bf_lo(zw.z), bf_hi(zw.z), bf_lo(zw.w), bf_hi(zw.w)};
                        r0 = (r0 - mean) * rstd * gv[bj][0] + bv[bj][0]; r1 = (r1 - mean) * rstd * gv[bj][1] + bv[bj][1]; }
                    const f32x4 z0 = acc[ai][bj][m][0] + r0 * alpha, z1 = acc[ai][bj][m][1] + r1 * alpha;
                    if (X) { *(f32x4*)(X + off + bj * HALF) = z0; *(f32x4*)(X + off + bj * HALF + 4) = z1; }
                    u32x4 w; w.x = cvt_pk_bf16(z0[0], z0[1]); w.y = cvt_pk_bf16(z0[2], z0[3]); w.z = cvt_pk_bf16(z1[0], z1[1]); w.w = cvt_pk_bf16(z1[2], z1[3]);
                    *(u32x4*)(ZB + off + bj * HALF) = w;
                    s1 += ((z0[0] + z0[1]) + (z0[2] + z0[3])) + ((z1[0] + z1[1]) + (z1[2] + z1[3]));
                    s2 += ((z0[0] * z0[0] + z0[1] * z0[1]) + (z0[2] * z0[2] + z0[3] * z0[3])) + ((z1[0] * z1[0] + z1[1] * z1[1]) + (z1[2] * z1[2] + z1[3] * z1[3])); }
                s1 += __shfl_xor(s1, 16); s1 += __shfl_xor(s1, 32); s2 += __shfl_xor(s2, 16); s2 += __shfl_xor(s2, 32);
                if (fq == 0) { unsafeAtomicAdd(cst + 2 * row, s1); unsafeAtomicAdd(cst + 2 * row + 1, s2); } }
    }
};
struct EpiSwiglu {
    static constexpr bool PERM = true, AFTER_DRAIN = false;
    bf16_t* H; const float* st; const float* c1; const float* c2;
    __device__ __forceinline__ void operator()(const f32x4 (&acc)[2][2][4][2], const Unit& u, int wr, int wc, int fr, int fq) const {
        const int row0 = u.pm * BM + wr * 64 + fr, col0 = u.pn * HALF + wc * 32 + 8 * fq, ccol0 = u.pn * BM + wc * 32 + 8 * fq;
        f32x4 k1[2][2], k2[2][2];
#pragma unroll
        for (int bj = 0; bj < 2; ++bj)
#pragma unroll
            for (int n = 0; n < 2; ++n) { k1[bj][n] = *(const f32x4*)(c1 + ccol0 + bj * HALF + 4 * n); k2[bj][n] = *(const f32x4*)(c2 + ccol0 + bj * HALF + 4 * n); }
#pragma unroll
        for (int ai = 0; ai < 2; ++ai)
#pragma unroll
            for (int m = 0; m < 4; ++m) { const int row = row0 + ai * HALF + m * 16; bf16_t* rowp = H + (size_t)row * DFF + col0;
                float mean, rstd; row_stats(st, row, mean, rstd);
                float h[8];
#pragma unroll
                for (int n = 0; n < 2; ++n) { const f32x4 gq = (acc[ai][0][m][n] - k1[0][n] * mean) * rstd + k2[0][n], uq = (acc[ai][1][m][n] - k1[1][n] * mean) * rstd + k2[1][n];
#pragma unroll
                    for (int j = 0; j < 4; ++j) h[n * 4 + j] = gq[j] * __builtin_amdgcn_rcpf(1.f + __expf(-gq[j])) * uq[j]; }
                u32x4 w; w.x = cvt_pk_bf16(h[0], h[1]); w.y = cvt_pk_bf16(h[2], h[3]); w.z = cvt_pk_bf16(h[4], h[5]); w.w = cvt_pk_bf16(h[6], h[7]);
                *(u32x4*)rowp = w; }
    }
};

struct EpiSoftmax {
    static constexpr bool PERM = true, AFTER_DRAIN = true;
    bf16_t* PALL; const float* st; const float* c1; const float* c2; float scale;
    __device__ __forceinline__ void fused(f32x4 (&acc)[2][2][4][2], const Unit& u, int wr, int wc, int fr, int fq, LAS unsigned char* lds) const {
        const int b = u.bz >> 2, h = u.bz & 3, rl0 = wr * 64 + fr, cc0 = wc * 32 + 8 * fq;
        LAS float* PMX = (LAS float*)lds; LAS float* PSM = PMX + 1024;
        f32x4 k1[2][2], k2[2][2];
#pragma unroll
        for (int bj = 0; bj < 2; ++bj)
#pragma unroll
            for (int n = 0; n < 2; ++n) { k1[bj][n] = *(const f32x4*)(c1 + u.bz * 256 + cc0 + bj * HALF + 4 * n); k2[bj][n] = *(const f32x4*)(c2 + u.bz * 256 + cc0 + bj * HALF + 4 * n); }
#pragma unroll
        for (int ai = 0; ai < 2; ++ai)
#pragma unroll
            for (int m = 0; m < 4; ++m) { const int rl = rl0 + ai * HALF + m * 16, row = b * SEQ + u.pm * BM + rl;
                float mean, rstd; row_stats(st, row, mean, rstd);
                float mx = -__builtin_inff();
#pragma unroll
                for (int bj = 0; bj < 2; ++bj)
#pragma unroll
                    for (int n = 0; n < 2; ++n) { const f32x4 v = ((acc[ai][bj][m][n] - k1[bj][n] * mean) * rstd + k2[bj][n]) * scale; acc[ai][bj][m][n] = v;
                        mx = fmaxf(mx, fmaxf(fmaxf(v[0], v[1]), fmaxf(v[2], v[3]))); }
                mx = fmaxf(mx, __shfl_xor(mx, 16)); mx = fmaxf(mx, __shfl_xor(mx, 32));
                if (fq == 0) PMX[rl * 4 + wc] = mx; }
        asm volatile("s_waitcnt lgkmcnt(0)" ::: "memory"); __builtin_amdgcn_s_barrier(); asm volatile("" ::: "memory");
#pragma unroll
        for (int ai = 0; ai < 2; ++ai)
#pragma unroll
            for (int m = 0; m < 4; ++m) { const int rl = rl0 + ai * HALF + m * 16;
                const f32x4 q = *(const LAS f32x4*)(PMX + rl * 4); const float mx = fmaxf(fmaxf(q[0], q[1]), fmaxf(q[2], q[3]));
                float sm = 0.f;
#pragma unroll
                for (int bj = 0; bj < 2; ++bj)
#pragma unroll
                    for (int n = 0; n < 2; ++n) { f32x4 e = acc[ai][bj][m][n] - mx; e[0] = __expf(e[0]); e[1] = __expf(e[1]); e[2] = __expf(e[2]); e[3] = __expf(e[3]); acc[ai][bj][m][n] = e;
                        sm += (e[0] + e[1]) + (e[2] + e[3]); }
                sm += __shfl_xor(sm, 16); sm += __shfl_xor(sm, 32);
                if (fq == 0) PSM[rl * 4 + wc] = sm; }
        asm volatile("s_waitcnt lgkmcnt(0)" ::: "memory"); __builtin_amdgcn_s_barrier(); asm volatile("" ::: "memory");
#pragma unroll
        for (int ai = 0; ai < 2; ++ai)
#pragma unroll
            for (int m = 0; m < 4; ++m) { const int rl = rl0 + ai * HALF + m * 16, row = b * SEQ + u.pm * BM + rl;
                const f32x4 q = *(const LAS f32x4*)(PSM + rl * 4); const float inv = __builtin_amdgcn_rcpf((q[0] + q[1]) + (q[2] + q[3]));
                bf16_t* rowp = PALL + (size_t)row * 1024 + h * 256 + cc0;
#pragma unroll
                for (int bj = 0; bj < 2; ++bj) { const f32x4 v0 = acc[ai][bj][m][0] * inv, v1 = acc[ai][bj][m][1] * inv;
                    u32x4 w; w.x = cvt_pk_bf16(v0[0], v0[1]); w.y = cvt_pk_bf16(v0[2], v0[3]); w.z = cvt_pk_bf16(v1[0], v1[1]); w.w = cvt_pk_bf16(v1[2], v1[3]);
                    *(u32x4*)(rowp + bj * HALF) = w; } }
    }
};

template <class Epi, bool ALIGN_EPI>
__device__ __forceinline__ void gemm_phase(LAS unsigned char* lds, const Gemm g, const Order& S, const Epi& E) {
    const int tid = ltid(), wid = __builtin_amdgcn_readfirstlane(tid >> 6), lane = tid & 63, wr = wid >> 2, wc = wid & 3, fr = lane & 15, fq = lane >> 4;
    const int K = g.K, nt = K / BK;
    unsigned voffA[2], voffB[2];
#pragma unroll
    for (int i = 0; i < 2; ++i) { int R, C; stage_rc(tid * 16 + i * 8192, R, C); const int Rb = Epi::PERM ? ((R & ~31) + perm32(R & 31)) : R;
        voffA[i] = (unsigned)(R * g.lda + C) * 2u; voffB[i] = (unsigned)(Rb * g.ldb + C) * 2u; }
    const size_t kstep = (size_t)(BK * 2);
    const size_t hstepA = (size_t)HALF * g.lda * 2, hstepB = (size_t)HALF * g.ldb * 2;
    const unsigned ldsw = (unsigned)wid * 1024u;
    const int aoff = lds_byte(wr * 64 + fr, fq * 8), boff = lds_byte(wc * 32 + fr, fq * 8);
#define PG8_SA(b, h) (((b) * 2 + (h)) * HTB)
#define PG8_SB(b, h) ((4 + (b) * 2 + (h)) * HTB)
#define PG8_STAGE(bufoff, gbase, voff) do { _Pragma("unroll") for (int _i = 0; _i < 2; ++_i) \
        __builtin_amdgcn_global_load_lds((const unsigned*)((const char*)(gbase) + (voff)[_i]), (LAS unsigned*)(lds + (bufoff) + ldsw + _i * 8192), 16, 0, 0); } while (0)
#define PG8_LDA(dst, b, h) do { _Pragma("unroll") for (int m = 0; m < 4; ++m) _Pragma("unroll") for (int k = 0; k < 2; ++k) dst[m][k] = *(const LAS bf16x8*)(lds + PG8_SA(b, h) + aoff + m * 2048 + k * 1024); } while (0)
#define PG8_LDB(dst, b, h) do { _Pragma("unroll") for (int n = 0; n < 2; ++n) _Pragma("unroll") for (int k = 0; k < 2; ++k) dst[n][k] = *(const LAS bf16x8*)(lds + PG8_SB(b, h) + boff + n * 2048 + k * 1024); } while (0)
#define PG8_MMA(ai, bj, At, Bt) do { __builtin_amdgcn_s_setprio(1); _Pragma("unroll") for (int m = 0; m < 4; ++m) _Pragma("unroll") for (int n = 0; n < 2; ++n) _Pragma("unroll") for (int k = 0; k < 2; ++k) \
        acc[ai][bj][m][n] = __builtin_amdgcn_mfma_f32_16x16x32_bf16(Bt[n][k], At[m][k], acc[ai][bj][m][n], 0, 0, 0); __builtin_amdgcn_s_setprio(0); } while (0)
#define PG8_WAIT_V(n) asm volatile("s_waitcnt vmcnt(" #n ")" ::: "memory")
#define PG8_WAIT_L(n) asm volatile("s_waitcnt lgkmcnt(" #n ")" ::: "memory")
#define PG8_BAR __builtin_amdgcn_s_barrier()
#define PG8_SCHED __builtin_amdgcn_sched_barrier(0)
    Unit cur, nxt; int ui = 0;
    if (!S.next(0, cur)) return;
    f32x4 acc[2][2][4][2];
#pragma unroll
    for (int a = 0; a < 2; ++a)
#pragma unroll
        for (int b = 0; b < 2; ++b)
#pragma unroll
            for (int m = 0; m < 4; ++m)
#pragma unroll
                for (int n = 0; n < 2; ++n) acc[a][b][m][n] = (f32x4){0.f, 0.f, 0.f, 0.f};
    bf16x8 At[4][2], B0[2][2], B1[2][2];
    const char* cA = unit_a(g, cur); const char* cB = unit_b(g, cur);
    PG8_STAGE(PG8_SB(0, 0), cB, voffB); PG8_STAGE(PG8_SB(0, 1), cB + hstepB, voffB); PG8_STAGE(PG8_SA(0, 0), cA, voffA); PG8_STAGE(PG8_SA(0, 1), cA + hstepA, voffA);
    if (wr == 1) PG8_BAR;
    PG8_WAIT_V(2); PG8_BAR;
    PG8_STAGE(PG8_SB(1, 0), cB + kstep, voffB); PG8_STAGE(PG8_SA(1, 0), cA + kstep, voffA); PG8_STAGE(PG8_SB(1, 1), cB + hstepB + kstep, voffB);
    PG8_WAIT_V(6); PG8_BAR;
    for (;;) {
        const bool has_next = S.next(ui + 1, nxt);
        const char* nA = has_next ? unit_a(g, nxt) : cA; const char* nB = has_next ? unit_b(g, nxt) : cB;
        for (int t = 0; t < nt; t += 2) {
            const bool last = (t == nt - 2);
            const char* a1 = cA + (size_t)(t + 1) * kstep;
            const char* a2 = last ? nA : cA + (size_t)(t + 2) * kstep; const char* b2 = last ? nB : cB + (size_t)(t + 2) * kstep;
            const char* a3 = a2 + kstep; const char* b3 = b2 + kstep;
            PG8_LDB(B0, 0, 0); PG8_LDB(B1, 0, 1); PG8_SCHED; PG8_LDA(At, 0, 0); PG8_STAGE(PG8_SA(1, 1), a1 + hstepA, voffA);
            PG8_WAIT_V(8); PG8_WAIT_L(0); PG8_BAR; PG8_MMA(0, 0, At, B0); PG8_MMA(0, 1, At, B1); PG8_BAR; PG8_SCHED;
            PG8_LDA(At, 0, 1); PG8_STAGE(PG8_SB(0, 0), b2, voffB); PG8_STAGE(PG8_SB(0, 1), b2 + hstepB, voffB); PG8_STAGE(PG8_SA(0, 0), a2, voffA);
            PG8_WAIT_V(8); PG8_WAIT_L(0); PG8_BAR; PG8_MMA(1, 0, At, B0); PG8_MMA(1, 1, At, B1); PG8_BAR; PG8_SCHED;
            PG8_LDB(B0, 1, 0); PG8_LDB(B1, 1, 1); PG8_SCHED; PG8_LDA(At, 1, 0); PG8_STAGE(PG8_SA(0, 1), a2 + hstepA, voffA);
            PG8_WAIT_V(8); PG8_WAIT_L(0); PG8_BAR; PG8_MMA(0, 0, At, B0); PG8_MMA(0, 1, At, B1); PG8_BAR; PG8_SCHED;
            PG8_LDA(At, 1, 1); PG8_STAGE(PG8_SB(1, 0), b3, voffB); PG8_STAGE(PG8_SB(1, 1), b3 + hstepB, voffB); PG8_STAGE(PG8_SA(1, 0), a3, voffA);
            PG8_WAIT_V(8); PG8_WAIT_L(0); PG8_BAR; PG8_MMA(1, 0, At, B0); PG8_MMA(1, 1, At, B1); PG8_BAR; PG8_SCHED;
        }
        if constexpr (ALIGN_EPI) { if (wr == 0) PG8_BAR; }
        if constexpr (!Epi::AFTER_DRAIN) E(acc, cur, wr, wc, fr, fq);
        if (!has_next) break;
#pragma unroll
        for (int a = 0; a < 2; ++a)
#pragma unroll
            for (int b = 0; b < 2; ++b)
#pragma unroll
                for (int m = 0; m < 4; ++m)
#pragma unroll
                    for (int n = 0; n < 2; ++n) acc[a][b][m][n] = (f32x4){0.f, 0.f, 0.f, 0.f};
        cur = nxt; cA = nA; cB = nB; ++ui;
        if constexpr (ALIGN_EPI) { if (wr == 1) PG8_BAR; }
    }
    PG8_WAIT_V(0);
    if constexpr (!ALIGN_EPI) { if (wr == 0) PG8_BAR; }
    PG8_BAR;
    if constexpr (Epi::AFTER_DRAIN) E.fused(acc, cur, wr, wc, fr, fq, lds);
#undef PG8_SA
#undef PG8_SB
#undef PG8_STAGE
#undef PG8_LDA
#undef PG8_LDB
#undef PG8_MMA
#undef PG8_WAIT_V
#undef PG8_WAIT_L
#undef PG8_BAR
#undef PG8_SCHED
}
}

namespace att {
using bf16 = __hip_bfloat16;
typedef short s16x4 __attribute__((ext_vector_type(4)));
constexpr int D = 128;
constexpr float THR = 8.f;
constexpr float SCALE = 0.08838834764831845f;
constexpr int NW = 8, QBLK = 32, KVBLK = 64, QB = NW * QBLK;
constexpr int SHM_V = KVBLK * D * 2, SHM_K = KVBLK * D * 2;
constexpr int ATT_LDS = 2 * SHM_V + 2 * SHM_K + NW * 64 * 4;
constexpr int BT_OFF = ATT_LDS;

#define KSWZ(row, colB) ((row) * 256 + ((colB) ^ (((row) & 7) << 4)))
#define SBAR() __builtin_amdgcn_sched_barrier(0)
__device__ __forceinline__ int v_st(int k, int c) { const int kk = (k & ~0xC) | ((k & 4) << 1) | ((k & 8) >> 1); return ((kk >> 3) * 4 + (c >> 5)) * 512 + ((kk & 7) * 32 + (c & 31)) * 2; }
__device__ __forceinline__ int v_rd_base(int lane) { return ((lane & 3) << 3) | (((lane >> 2) & 3) << 6) | (((lane >> 4) & 1) << 5) | (((lane >> 5) & 1) << 8); }
constexpr int v_rd_off(int d0, int ks, int half) { return d0 * 512 + ks * 4096 + half * 2048; }
__device__ __forceinline__ int crow(int r, int hi) { return (r & 3) + 8 * (r >> 2) + 4 * hi; }
__device__ __forceinline__ unsigned cvtpk(float lo, float hi) { unsigned r; asm volatile("v_cvt_pk_bf16_f32 %0, %1, %2" : "=v"(r) : "v"(lo), "v"(hi)); return r; }
__device__ __forceinline__ bf16x8 load8(const bf16* p) { return *reinterpret_cast<const bf16x8*>(p); }
__device__ __forceinline__ void bias_mask_tile(f32x16& p0, f32x16& p1, int dq, const float* bt) {
    const float NEG = -__builtin_inff();
#pragma unroll
    for (int r = 0; r < 16; ++r) {
        const int c = (r & 3) + 8 * (r >> 2);
        const int d0 = dq - c, d1 = dq - c - 32;
        const unsigned i0 = (unsigned)d0 < 255u ? (unsigned)d0 : 255u, i1 = (unsigned)d1 < 255u ? (unsigned)d1 : 255u;
        const float b0 = bt[i0], b1 = bt[i1];
        p0[r] = d0 >= 0 ? p0[r] + b0 : NEG;
        p1[r] = d1 >= 0 ? p1[r] + b1 : NEG;
    }
}
__device__ __forceinline__ void partialSM(f32x16& p0, f32x16& p1, float& m_reg, float& mn, float& alpha) {
    float pmax = p0[0]; for (int r = 1; r < 16; ++r) pmax = fmaxf(pmax, p0[r]); for (int r = 0; r < 16; ++r) pmax = fmaxf(pmax, p1[r]);
    { auto rr = __builtin_amdgcn_permlane32_swap(__float_as_uint(pmax), __float_as_uint(pmax), false, false);
      pmax = fmaxf(__uint_as_float(rr[0]), __uint_as_float(rr[1])); }
    constexpr float C2 = 1.4426950408889634f * SCALE;
    if (__builtin_expect(__all((pmax - m_reg) * SCALE <= THR), 1)) { mn = m_reg; alpha = 1.f; }
    else { mn = fmaxf(m_reg, pmax); alpha = __builtin_amdgcn_exp2f((m_reg - mn) * C2); m_reg = mn; }
    const float mnL = -mn * C2;
    for (int r = 0; r < 16; ++r) p0[r] = fmaf(p0[r], C2, mnL); for (int r = 0; r < 16; ++r) p1[r] = fmaf(p1[r], C2, mnL);
    for (int r = 0; r < 16; ++r) p0[r] = __builtin_amdgcn_exp2f(p0[r]);
}
__device__ __forceinline__ void finishSM(f32x16& p0, f32x16& p1, float alpha, float& l_reg, bf16x8& pa0, bf16x8& pa1, bf16x8& pa2, bf16x8& pa3) {
    for (int r = 0; r < 16; ++r) p1[r] = __builtin_amdgcn_exp2f(p1[r]);
    float ps = 0; for (int r = 0; r < 16; ++r) ps += p0[r]; for (int r = 0; r < 16; ++r) ps += p1[r];
    { auto rr = __builtin_amdgcn_permlane32_swap(__float_as_uint(ps), __float_as_uint(ps), false, false);
      ps = __uint_as_float(rr[0]) + __uint_as_float(rr[1]); }
    l_reg = l_reg * alpha + ps;
#define PK4(P, B_, OUT) do { unsigned a0 = cvtpk(P[B_+0], P[B_+1]), a1 = cvtpk(P[B_+2], P[B_+3]);                          \
        unsigned b0 = cvtpk(P[B_+4], P[B_+5]), b1 = cvtpk(P[B_+6], P[B_+7]);                                             \
        auto r0 = __builtin_amdgcn_permlane32_swap(a0, b0, false, false); auto r1 = __builtin_amdgcn_permlane32_swap(a1, b1, false, false); \
        u32x4 w = {r0[0], r1[0], r0[1], r1[1]}; OUT = *reinterpret_cast<bf16x8*>(&w); } while (0)
    PK4(p0, 0, pa0); PK4(p0, 8, pa1); PK4(p1, 0, pa2); PK4(p1, 8, pa3);
#undef PK4
}
template <int KB>
__device__ __forceinline__ void qkt(f32x16& p0, f32x16& p1, const char* K_lds, int r32, int hi, const bf16x8* qr) {
    p0 = f32x16{}; p1 = f32x16{};
    const char* kb[4];
#pragma unroll
    for (int dd = 0; dd < 4; ++dd) kb[dd] = K_lds + KB * SHM_K + KSWZ(r32, (dd * 16 + hi * 8) * 2);
#pragma unroll
    for (int d0 = 0; d0 < 8; ++d0) { const char* a = kb[d0 & 3] + (d0 >> 2) * 128;
        bf16x8 b0 = *reinterpret_cast<const bf16x8*>(a);
        bf16x8 b1 = *reinterpret_cast<const bf16x8*>(a + 32 * 256);
        p0 = __builtin_amdgcn_mfma_f32_32x32x16_bf16(b0, qr[d0], p0, 0, 0, 0);
        p1 = __builtin_amdgcn_mfma_f32_32x32x16_bf16(b1, qr[d0], p1, 0, 0, 0); }
}
template <int VB>
__device__ __forceinline__ void pv_tile(f32x16* o, int vb0, bf16x8 pa0, bf16x8 pa1, bf16x8 pa2, bf16x8 pa3) {
#define TRRD(dst, off) asm volatile("ds_read_b64_tr_b16 %0, %1 offset:%2" : "=&v"(dst) : "v"(vb0), "i"(off) : "memory")
#define PV_D0(d0) do { s16x4 l0, l1, l2, l3, h0, h1, h2, h3; constexpr int b_ = VB * SHM_V + v_rd_off(d0, 0, 0); \
        TRRD(l0, b_); TRRD(h0, b_ + 2048); TRRD(l1, b_ + 4096); TRRD(h1, b_ + 6144); TRRD(l2, b_ + 8192); TRRD(h2, b_ + 10240); TRRD(l3, b_ + 12288); TRRD(h3, b_ + 14336); \
        asm volatile("s_waitcnt lgkmcnt(0)" ::: "memory"); SBAR();   \
        o[d0] = __builtin_amdgcn_mfma_f32_32x32x16_bf16(pa0, (bf16x8){l0[0], l0[1], l0[2], l0[3], h0[0], h0[1], h0[2], h0[3]}, o[d0], 0, 0, 0);   \
        o[d0] = __builtin_amdgcn_mfma_f32_32x32x16_bf16(pa1, (bf16x8){l1[0], l1[1], l1[2], l1[3], h1[0], h1[1], h1[2], h1[3]}, o[d0], 0, 0, 0);   \
        o[d0] = __builtin_amdgcn_mfma_f32_32x32x16_bf16(pa2, (bf16x8){l2[0], l2[1], l2[2], l2[3], h2[0], h2[1], h2[2], h2[3]}, o[d0], 0, 0, 0);   \
        o[d0] = __builtin_amdgcn_mfma_f32_32x32x16_bf16(pa3, (bf16x8){l3[0], l3[1], l3[2], l3[3], h3[0], h3[1], h3[2], h3[3]}, o[d0], 0, 0, 0); } while (0)
    PV_D0(0); PV_D0(1); PV_D0(2); PV_D0(3);
#undef PV_D0
#undef TRRD
}
struct BlockRef { const bf16* Q; const bf16* K; const bf16* V; float* O; int P0; int hm; };
struct Seam { bf16x8 qr[8]; bf16x8 st_v0, st_v1, st_k0, st_k1; };
#define ROW(p, k0, rr) ((p) + (size_t)((k0) + (rr)) * D + sc)
#define VMW() asm volatile("s_waitcnt vmcnt(0)" ::: "memory")
#define VMWN(n) asm volatile("s_waitcnt vmcnt(%0)" :: "i"(n) : "memory")
#define SLOAD_H(Kp, Vp, k0) do { S.st_v0 = load8(ROW(Vp, k0, sr)); S.st_v1 = load8(ROW(Vp, k0, 32 + sr));              \
                         S.st_k0 = load8(ROW(Kp, k0, sr)); S.st_k1 = load8(ROW(Kp, k0, 32 + sr)); } while (0)
#define SWRITE_HK(bf) do { *(bf16x8*)(K_lds + (bf) * SHM_K + kws) = S.st_k0; *(bf16x8*)(K_lds + (bf) * SHM_K + kws + 32 * 256) = S.st_k1; } while (0)
#define SWRITE_HV(bf) do { *(bf16x8*)(V_lds + (bf) * SHM_V + vst0) = S.st_v0; *(bf16x8*)(V_lds + (bf) * SHM_V + vst1) = S.st_v1; } while (0)
#define SWRITE_H(bf) do { SWRITE_HV(bf); SWRITE_HK(bf); } while (0)
__device__ __forceinline__ void attn_prime(const BlockRef& cur, char* lds, Seam& S) {
    const int tid = ltid(), wid = __builtin_amdgcn_readfirstlane(tid >> 6), lane = tid & 63, r32 = lane & 31, hi = lane >> 5;
    const int sr = tid >> 4, sc = (tid & 15) * 8, kws = KSWZ(sr, sc * 2); char* K_lds = lds + 2 * SHM_V;
    const int kb0 = 0;
    for (int d0 = 0; d0 < 8; ++d0) S.qr[d0] = load8(cur.Q + (size_t)(wid * QBLK + r32) * D + d0 * 16 + hi * 8);
    SLOAD_H(cur.K, cur.V, kb0); VMW(); SWRITE_HK(0);
    __syncthreads();
}
__device__ __forceinline__ void attn_block(const BlockRef& cur, const BlockRef& nxt, char* lds, Seam& S) {
    const int tid = ltid(), wid = __builtin_amdgcn_readfirstlane(tid >> 6), lane = tid & 63, r32 = lane & 31, hi = lane >> 5;
    const int j_lo = 0;
    const int j_hi = (cur.P0 + QB - 1) / KVBLK + 1;
    const int NT = j_hi - j_lo;
    const int kbn = 0;
    const int qlo = cur.P0 + wid * QBLK, qm = qlo + r32 - 4 * hi;
    char* V_lds = lds; char* K_lds = lds + 2 * SHM_V;
    float* ws = (float*)(lds + 2 * SHM_V + 2 * SHM_K) + wid * 64; float* li_l = ws, * al_l = ws + 32;
    const float* bt = (const float*)(lds + BT_OFF) + cur.hm * 256;
    float m_reg = -1e30f, l_reg = 0; f32x16 o[4] = {};
    const int sr = tid >> 4, sc = (tid & 15) * 8, vst0 = v_st(sr, sc), vst1 = v_st(32 + sr, sc), kws = KSWZ(sr, sc * 2);
    const int vb0 = (int)(uintptr_t)V_lds + v_rd_base(lane);
    const bf16* Kh = cur.K; const bf16* Vh = cur.V;
#define RESC(a) do { if (__any((a) < 1.f)) { if (hi == 0) al_l[r32] = (a); asm volatile("s_waitcnt lgkmcnt(0)" ::: "memory");              \
                     for (int d_ = 0; d_ < 4; ++d_) for (int r = 0; r < 16; ++r) o[d_][r] *= al_l[crow(r, hi)]; } } while (0)
#define KBASE(t) ((j_lo + (t)) * KVBLK)
#define MASKT(P0_, P1_, t) do { const int kb_ = KBASE(t); if (kb_ + KVBLK - 1 > qlo - 128) bias_mask_tile(P0_, P1_, qm - kb_, bt); } while (0)
    constexpr int NQL = 8;
#define SEAM_K0() do { VMWN(NQL); SWRITE_HK(0); SBAR(); } while (0)
    f32x16 pA0, pA1, pB0, pB1; float mnA, mnB, alA, alB; bf16x8 pa0, pa1, pa2, pa3;
    SWRITE_HV(0); SBAR();
    if (NT > 1) { SLOAD_H(Kh, Vh, KBASE(1)); }
    SBAR(); qkt<0>(pA0, pA1, K_lds, r32, hi, S.qr);
    MASKT(pA0, pA1, 0); partialSM(pA0, pA1, m_reg, mnA, alA);
    if (NT > 1) { VMW(); SWRITE_H(1); }
    __syncthreads();
#define HALF_STEP(PX0, PX1, mnX, alX, PY0, PY1, alY, t, KB, VB, SB) do {                                                      \
        SBAR(); qkt<KB>(PX0, PX1, K_lds, r32, hi, S.qr);                                             \
        finishSM(PY0, PY1, alY, l_reg, pa0, pa1, pa2, pa3); SBAR();                                                           \
        if ((t) + 1 < NT) { SLOAD_H(Kh, Vh, KBASE((t) + 1)); SBAR(); }                                               \
        pv_tile<VB>(o, vb0, pa0, pa1, pa2, pa3); MASKT(PX0, PX1, (t)); partialSM(PX0, PX1, m_reg, mnX, alX);                                        \
        __syncthreads();                                                                                                      \
        if ((t) + 1 < NT) { VMW(); SWRITE_H(SB); }                                                                          \
        RESC(alX); __syncthreads(); } while (0)
    for (int t = 1; t + 1 < NT; t += 2) {
        HALF_STEP(pB0, pB1, mnB, alB, pA0, pA1, alA, t, 1, 0, 0);
        HALF_STEP(pA0, pA1, mnA, alA, pB0, pB1, alB, t + 1, 0, 1, 1);
    }
    const bool even = (NT & 1) == 0;
    if (even) { SBAR(); qkt<1>(pB0, pB1, K_lds, r32, hi, S.qr); SBAR(); }
    SLOAD_H(nxt.K, nxt.V, kbn); SBAR();
#pragma unroll
    for (int d0 = 0; d0 < 8; ++d0) S.qr[d0] = load8(nxt.Q + (size_t)(wid * QBLK + r32) * D + d0 * 16 + hi * 8);
    SBAR();
    finishSM(pA0, pA1, alA, l_reg, pa0, pa1, pa2, pa3); SBAR();
    pv_tile<0>(o, vb0, pa0, pa1, pa2, pa3);
    if (even) { MASKT(pB0, pB1, NT - 1); partialSM(pB0, pB1, m_reg, mnB, alB); __syncthreads(); RESC(alB);
        finishSM(pB0, pB1, alB, l_reg, pa0, pa1, pa2, pa3); SBAR(); pv_tile<1>(o, vb0, pa0, pa1, pa2, pa3); }
    SBAR(); SEAM_K0();
    if (hi == 0) li_l[r32] = l_reg; asm volatile("s_waitcnt lgkmcnt(0)" ::: "memory");
    float rli[16];
#pragma unroll
    for (int r = 0; r < 16; ++r) rli[r] = __builtin_amdgcn_rcpf(li_l[crow(r, hi)]);
    float* Ow = cur.O + (size_t)(wid * QBLK) * D;
#pragma unroll
    for (int r = 0; r < 16; ++r) { const int orow = crow(r, hi);
#pragma unroll
        for (int d0 = 0; d0 < 4; ++d0) { const float v = o[d0][r] * rli[r]; Ow[(size_t)orow * D + d0 * 32 + r32] = v; } }
    __syncthreads();
#undef RESC
#undef KBASE
#undef MASKT
#undef SEAM_K0
#undef HALF_STEP
}
#undef ROW
#undef VMW
#undef VMWN
#undef SLOAD_H
#undef SWRITE_HK
#undef SWRITE_HV
#undef SWRITE_H
}

namespace att2 {
using att::bf16; using att::D; using att::SHM_K; using att::SHM_V;
constexpr int L_V = 0, L_K = 65536, L_P = 98304, L_AL = 131072, L_FL = 132096, L_LB = 132224, L_BT = 133120;
struct Blk { const bf16* Q; const bf16* K; const bf16* V0; const bf16* V1; float* O0; float* O1; int P0; int hm; };
__device__ __forceinline__ void qkt_rt(f32x16& p0, f32x16& p1, const char* Kb, int r32, int hi, const bf16x8* qr) {
    p0 = f32x16{}; p1 = f32x16{};
    const char* kb[4];
#pragma unroll
    for (int dd = 0; dd < 4; ++dd) kb[dd] = Kb + KSWZ(r32, (dd * 16 + hi * 8) * 2);
#pragma unroll
    for (int d0 = 0; d0 < 8; ++d0) { const char* a = kb[d0 & 3] + (d0 >> 2) * 128;
        bf16x8 b0 = *reinterpret_cast<const bf16x8*>(a);
        bf16x8 b1 = *reinterpret_cast<const bf16x8*>(a + 32 * 256);
        p0 = __builtin_amdgcn_mfma_f32_32x32x16_bf16(b0, qr[d0], p0, 0, 0, 0);
        p1 = __builtin_amdgcn_mfma_f32_32x32x16_bf16(b1, qr[d0], p1, 0, 0, 0); }
}
#define A2_LOADT(t) do { const size_t ro_ = (size_t)((t) * 64 + sr) * D + sc; \
        sk0 = att::load8(c.K + ro_); sk1 = att::load8(c.K + ro_ + 32 * D); sv00 = att::load8(c.V0 + ro_); sv01 = att::load8(c.V0 + ro_ + 32 * D); sv10 = att::load8(c.V1 + ro_); sv11 = att::load8(c.V1 + ro_ + 32 * D); } while (0)
#define A2_WRITET(buf) do { char* kd_ = lds + L_K + (buf) * SHM_K; char* vd_ = lds + L_V + (buf) * 2 * SHM_V; \
        *(bf16x8*)(kd_ + kws) = sk0; *(bf16x8*)(kd_ + kws + 32 * 256) = sk1; *(bf16x8*)(vd_ + vst0) = sv00; *(bf16x8*)(vd_ + vst1) = sv01; *(bf16x8*)(vd_ + SHM_V + vst0) = sv10; *(bf16x8*)(vd_ + SHM_V + vst1) = sv11; } while (0)
__device__ __forceinline__ void attn2_block(const Blk& c, char* lds) {
    const int tid = ltid(), wid = __builtin_amdgcn_readfirstlane(tid >> 6), lane = tid & 63, r32 = lane & 31, hi = lane >> 5;
    const int g = wid & 3;
    const int NT = (c.P0 + 127) / 64 + 1;
    const int sr = tid >> 4, sc = (tid & 15) * 8, kws = KSWZ(sr, sc * 2), vst0 = att::v_st(sr, sc), vst1 = att::v_st(32 + sr, sc);
    bf16x8 sk0, sk1, sv00, sv01, sv10, sv11;
    float* ALb = (float*)(lds + L_AL) + g * 64; unsigned* FLb = (unsigned*)(lds + L_FL) + g * 2; float* LBb = (float*)(lds + L_LB) + g * 32;
    char* Pb = lds + L_P + g * 8192;
    A2_LOADT(0);
    if (wid < 4) {
        bf16x8 qr[8];
#pragma unroll
        for (int d0 = 0; d0 < 8; ++d0) qr[d0] = att::load8(c.Q + (size_t)(g * 32 + r32) * D + d0 * 16 + hi * 8);
        asm volatile("s_waitcnt vmcnt(0)" ::: "memory"); A2_WRITET(0); __syncthreads();
        const int qlo = c.P0 + g * 32, qm = qlo + r32 - 4 * hi;
        const float* bt = (const float*)(lds + L_BT) + c.hm * 256;
        float m_reg = -1e30f, l_reg = 0.f;
        for (int s = 0; s <= NT; ++s) {
            const int par = s & 1;
            if (s + 1 < NT) A2_LOADT(s + 1);
            SBAR();
            if (s < NT) {
                f32x16 p0, p1; float mn, al; bf16x8 pa0, pa1, pa2, pa3;
                qkt_rt(p0, p1, lds + L_K + par * SHM_K, r32, hi, qr);
                const int kb_ = s * 64;
                if (kb_ + 63 > qlo - 128) att::bias_mask_tile(p0, p1, qm - kb_, bt);
                att::partialSM(p0, p1, m_reg, mn, al);
                att::finishSM(p0, p1, al, l_reg, pa0, pa1, pa2, pa3);
                char* pw = Pb + par * 4096 + lane * 16;
                *(bf16x8*)(pw) = pa0; *(bf16x8*)(pw + 1024) = pa1; *(bf16x8*)(pw + 2048) = pa2; *(bf16x8*)(pw + 3072) = pa3;
                if (hi == 0) ALb[par * 32 + r32] = al;
                const bool resc = __any(al < 1.f);
                if (lane == 0) FLb[par] = resc ? 1u : 0u;
            }
            __syncthreads();
            if (s + 1 < NT) { asm volatile("s_waitcnt vmcnt(0)" ::: "memory"); A2_WRITET((s + 1) & 1); }
            __syncthreads();
        }
        if (hi == 0) LBb[r32] = l_reg;
        __syncthreads();
        __syncthreads();
    } else {
        asm volatile("s_waitcnt vmcnt(0)" ::: "memory"); A2_WRITET(0); __syncthreads();
        typedef att::s16x4 s16x4;
        f32x16 o[8];
#pragma unroll
        for (int d_ = 0; d_ < 8; ++d_) o[d_] = f32x16{};
        const int vbase = (int)(uintptr_t)(lds + L_V) + att::v_rd_base(lane) + (g >> 1) * SHM_V + (g & 1) * 1024;
        const float* ALall = (const float*)(lds + L_AL); const unsigned* FLall = (const unsigned*)(lds + L_FL); const char* Pall = lds + L_P;
        for (int s = 0; s <= NT; ++s) {
            if (s + 1 < NT) A2_LOADT(s + 1);
            SBAR();
            if (s >= 1) {
                const int par = (s - 1) & 1;
                const int vb = vbase + par * 2 * SHM_V;
                s16x4 vl[2][4], vh[2][4];
#define TRRD(dst, off) asm volatile("ds_read_b64_tr_b16 %0, %1 offset:%2" : "=&v"(dst) : "v"(vb), "i"(off) : "memory")
#define TRQ(dq) do { TRRD(vl[dq][0], (dq) * 512); TRRD(vh[dq][0], (dq) * 512 + 2048); TRRD(vl[dq][1], (dq) * 512 + 4096); TRRD(vh[dq][1], (dq) * 512 + 6144); \
                     TRRD(vl[dq][2], (dq) * 512 + 8192); TRRD(vh[dq][2], (dq) * 512 + 10240); TRRD(vl[dq][3], (dq) * 512 + 12288); TRRD(vh[dq][3], (dq) * 512 + 14336); } while (0)
                TRQ(0); TRQ(1);
#undef TRQ
#undef TRRD
#pragma unroll
                for (int rg = 0; rg < 4; ++rg) {
                    const unsigned fl = (unsigned)__builtin_amdgcn_readfirstlane((int)FLall[rg * 2 + par]);
                    if (fl) {
#pragma unroll
                        for (int r = 0; r < 16; ++r) { const float a_ = ALall[rg * 64 + par * 32 + att::crow(r, hi)]; o[rg * 2][r] *= a_; o[rg * 2 + 1][r] *= a_; } }
                    const char* pr = Pall + rg * 8192 + par * 4096 + lane * 16;
                    const bf16x8 pa0 = *(const bf16x8*)(pr), pa1 = *(const bf16x8*)(pr + 1024), pa2 = *(const bf16x8*)(pr + 2048), pa3 = *(const bf16x8*)(pr + 3072);
                    asm volatile("s_waitcnt lgkmcnt(0)" ::: "memory"); SBAR();
#pragma unroll
                    for (int dq = 0; dq < 2; ++dq) {
                        o[rg * 2 + dq] = __builtin_amdgcn_mfma_f32_32x32x16_bf16(pa0, (bf16x8){vl[dq][0][0], vl[dq][0][1], vl[dq][0][2], vl[dq][0][3], vh[dq][0][0], vh[dq][0][1], vh[dq][0][2], vh[dq][0][3]}, o[rg * 2 + dq], 0, 0, 0);
                        o[rg * 2 + dq] = __builtin_amdgcn_mfma_f32_32x32x16_bf16(pa1, (bf16x8){vl[dq][1][0], vl[dq][1][1], vl[dq][1][2], vl[dq][1][3], vh[dq][1][0], vh[dq][1][1], vh[dq][1][2], vh[dq][1][3]}, o[rg * 2 + dq], 0, 0, 0);
                        o[rg * 2 + dq] = __builtin_amdgcn_mfma_f32_32x32x16_bf16(pa2, (bf16x8){vl[dq][2][0], vl[dq][2][1], vl[dq][2][2], vl[dq][2][3], vh[dq][2][0], vh[dq][2][1], vh[dq][2][2], vh[dq][2][3]}, o[rg * 2 + dq], 0, 0, 0);
                        o[rg * 2 + dq] = __builtin_amdgcn_mfma_f32_32x32x16_bf16(pa3, (bf16x8){vl[dq][3][0], vl[dq][3][1], vl[dq][3][2], vl[dq][3][3], vh[dq][3][0], vh[dq][3][1], vh[dq][3][2], vh[dq][3][3]}, o[rg * 2 + dq], 0, 0, 0); }
                }
            }
            __syncthreads();
            if (s + 1 < NT) { asm volatile("s_waitcnt vmcnt(0)" ::: "memory"); A2_WRITET((s + 1) & 1); }
            __syncthreads();
        }
        __syncthreads();
        float* Ow = ((g >> 1) ? c.O1 : c.O0) + (g & 1) * 64 + r32;
        const float* LBall = (const float*)(lds + L_LB);
#pragma unroll
        for (int rg = 0; rg < 4; ++rg)
#pragma unroll
            for (int r = 0; r < 16; ++r) { const int orow = rg * 32 + att::crow(r, hi); const float rl = __builtin_amdgcn_rcpf(LBall[orow]);
                Ow[(size_t)orow * D] = o[rg * 2][r] * rl; Ow[(size_t)orow * D + 32] = o[rg * 2 + 1][r] * rl; }
        __syncthreads();
    }
}
#undef A2_LOADT
#undef A2_WRITET
}


#define XB_TMO      128
#define XB_XCNT(j)  (256  + 64 * (j))
#define XB_XSUB(j)  (1280 + 64 * (j))
#define XB_XGEN(j)  (2304 + 64 * (j))
#define XB_TOP      3328
#define XB_TOPGEN   3392
#define XCD_BAR_WORDS 3456
#define XB_SPIN_CAP (1u << 18)
__device__ __forceinline__ unsigned xb_ld(unsigned* p)              { return __hip_atomic_load(p, __ATOMIC_RELAXED, __HIP_MEMORY_SCOPE_AGENT); }
__device__ __forceinline__ unsigned xb_add(unsigned* p, unsigned v) { return __hip_atomic_fetch_add(p, v, __ATOMIC_RELAXED, __HIP_MEMORY_SCOPE_AGENT); }
__device__ __forceinline__ unsigned xb_xcc_id() { return (unsigned)__builtin_amdgcn_s_getreg((3 << 11) | 20) & 0xFu; }
#define XB_SPIN(cond, bar) do { unsigned _sp = 0; while (cond) { __builtin_amdgcn_s_sleep(1); \
    if ((++_sp & 255u) == 0u) { if (xb_ld(&(bar)[XB_TMO])) break; if (_sp > XB_SPIN_CAP) { atomicAdd(&(bar)[XB_TMO], 1u); break; } } } } while (0)
struct XcdBarrier { unsigned* bar; unsigned x; volatile LAS unsigned* st; };
__device__ __forceinline__ XcdBarrier xcd_barrier_post(unsigned* bar, volatile LAS unsigned* st) {
    XcdBarrier b; b.bar = bar; b.x = xb_xcc_id(); b.st = st;
    if (threadIdx.x == 0) (void)xb_add(&bar[XB_XCNT(b.x)], 1u);
    return b;
}
__device__ __forceinline__ void xcd_barrier_complete(unsigned* bar, unsigned x, unsigned& nloc, unsigned& nx) {
    const unsigned G = gridDim.x * gridDim.y * gridDim.z;
    unsigned sum, cnt, mine, sp = 0u;
    for (;;) {
        sum = 0u; cnt = 0u; mine = 0u;
#pragma unroll
        for (unsigned j = 0; j < 16; ++j) { const unsigned c = xb_ld(&bar[XB_XCNT(j)]); sum += c; cnt += (c > 0u) ? 1u : 0u; mine = (j == x) ? c : mine; }
        if (sum == G) break;
        __builtin_amdgcn_s_sleep(1);
        if ((++sp & 255u) == 0u) { if (xb_ld(&bar[XB_TMO])) break; if (sp > XB_SPIN_CAP) { atomicAdd(&bar[XB_TMO], 1u); break; } }
    }
    nloc = mine > 0u ? mine : 1u; nx = cnt > 0u ? cnt : 1u;
}
__device__ __forceinline__ void xcd_barrier(const XcdBarrier& b) {
    asm volatile("s_waitcnt vmcnt(0)" ::: "memory");
    __syncthreads();
    if (threadIdx.x == 0) {
        unsigned* bar = b.bar;
        __builtin_amdgcn_s_waitcnt(0);
        unsigned nloc = b.st[0], nx = b.st[1];
        if (nloc == 0u) { xcd_barrier_complete(bar, b.x, nloc, nx); b.st[0] = nloc; b.st[1] = nx; }
        const unsigned old = xb_add(&bar[XB_XSUB(b.x)], 1u);
        const unsigned gen = old / nloc;
        if (old + 1u == (gen + 1u) * nloc) {
            __builtin_amdgcn_fence(__ATOMIC_RELEASE, "agent");
            asm volatile("s_waitcnt vmcnt(0)" ::: "memory");
            const unsigned og = xb_add(&bar[XB_TOP], 1u);
            const unsigned tg = og / nx;
            if (og + 1u == (tg + 1u) * nx) xb_add(&bar[XB_TOPGEN], 1u);
            else XB_SPIN(xb_ld(&bar[XB_TOPGEN]) == tg, bar);
            __builtin_amdgcn_fence(__ATOMIC_ACQUIRE, "agent");
            xb_add(&bar[XB_XGEN(b.x)], 1u);
            asm volatile("s_waitcnt vmcnt(0)" ::: "memory");
        } else {
            XB_SPIN(xb_ld(&bar[XB_XGEN(b.x)]) == gen, bar);
            __builtin_amdgcn_fence(__ATOMIC_ACQUIRE, "agent");
            asm volatile("s_waitcnt vmcnt(0)" ::: "memory");
        }
    }
    __syncthreads();
}

struct Args { const float* in[24]; float* out; unsigned char* ws; };

__device__ __forceinline__ void p0_transpose_item(const float* W, int K, int N, bf16_t* WT, int swiglu, const float* gk, const float* bk, float* c1, float* c2, LAS float* scr, int item, int lane) {
    const int nblk = N / 64, kb = item / nblk, nb = item % nblk, k0 = 64 * kb, n0 = 64 * nb;
    const float* src = W + (size_t)(k0 + (lane >> 4)) * N + n0 + (lane & 15) * 4;
    f32x4 v[16];
#pragma unroll
    for (int i = 0; i < 16; ++i) v[i] = *(const f32x4*)(src + (size_t)(4 * i) * N);
#pragma unroll
    for (int i = 0; i < 16; ++i) { LAS float* d = scr + (4 * i + (lane >> 4)) * 65 + (lane & 15) * 4; d[0] = v[i][0]; d[1] = v[i][1]; d[2] = v[i][2]; d[3] = v[i][3]; }
    asm volatile("s_waitcnt lgkmcnt(0)" ::: "memory");
    int r0 = n0;
    if (swiglu) { const int half = n0 / DFF, idx = n0 % DFF; r0 = 256 * (idx / 128) + 128 * half + (idx % 128); }
    const int c = lane & 7;
    float g8[8], b8[8];
#pragma unroll
    for (int e = 0; e < 8; ++e) { g8[e] = gk ? gk[k0 + 8 * c + e] : 1.f; b8[e] = gk ? bk[k0 + 8 * c + e] : 0.f; }
#pragma unroll
    for (int j = 0; j < 8; ++j) { const int n = (lane >> 3) + 8 * j; const LAS float* q = scr + (8 * c) * 65 + n;
        float w8[8];
#pragma unroll
        for (int e = 0; e < 8; ++e) w8[e] = q[e * 65];
        u32x4 o; o.x = cvt_pk_bf16(w8[0] * g8[0], w8[1] * g8[1]); o.y = cvt_pk_bf16(w8[2] * g8[2], w8[3] * g8[3]); o.z = cvt_pk_bf16(w8[4] * g8[4], w8[5] * g8[5]); o.w = cvt_pk_bf16(w8[6] * g8[6], w8[7] * g8[7]);
        *(u32x4*)(WT + (size_t)(r0 + n) * K + k0 + 8 * c) = o;
        if (gk) {
            float s1 = ((bf_lo(o.x) + bf_hi(o.x)) + (bf_lo(o.y) + bf_hi(o.y))) + ((bf_lo(o.z) + bf_hi(o.z)) + (bf_lo(o.w) + bf_hi(o.w)));
            float s2 = ((w8[0] * b8[0] + w8[1] * b8[1]) + (w8[2] * b8[2] + w8[3] * b8[3])) + ((w8[4] * b8[4] + w8[5] * b8[5]) + (w8[6] * b8[6] + w8[7] * b8[7]));
            s1 += __shfl_xor(s1, 1); s1 += __shfl_xor(s1, 2); s1 += __shfl_xor(s1, 4); s2 += __shfl_xor(s2, 1); s2 += __shfl_xor(s2, 2); s2 += __shfl_xor(s2, 4);
            if (c == 0) { unsafeAtomicAdd(c1 + r0 + n, s1); unsafeAtomicAdd(c2 + r0 + n, s2); }
        } }
    asm volatile("s_waitcnt lgkmcnt(0)" ::: "memory");
}

__device__ __forceinline__ void p0_wq_item(const float* W, bf16_t* WN, const float* gk, const float* bk, float* bW, int item, int lane) {
    const int kb = item >> 5, jb = item & 31, k0 = 64 * kb, j0 = 64 * jb, cg8 = lane & 7, kr = lane >> 3;
    float sacc[8];
#pragma unroll
    for (int e = 0; e < 8; ++e) sacc[e] = 0.f;
#pragma unroll
    for (int i = 0; i < 8; ++i) { const int k = k0 + 8 * i + kr; const float* src = W + (size_t)k * DM + j0 + 8 * cg8;
        const f32x4 v0 = *(const f32x4*)src, v1 = *(const f32x4*)(src + 4); const float g = gk[k], bb = bk[k];
        u32x4 o; o.x = cvt_pk_bf16(v0[0] * g, v0[1] * g); o.y = cvt_pk_bf16(v0[2] * g, v0[3] * g); o.z = cvt_pk_bf16(v1[0] * g, v1[1] * g); o.w = cvt_pk_bf16(v1[2] * g, v1[3] * g);
        *(u32x4*)(WN + (size_t)k * DM + j0 + 8 * cg8) = o;
#pragma unroll
        for (int e = 0; e < 4; ++e) { sacc[e] += bb * v0[e]; sacc[4 + e] += bb * v1[e]; } }
#pragma unroll
    for (int e = 0; e < 8; ++e) { float v = sacc[e]; v += __shfl_xor(v, 8); v += __shfl_xor(v, 16); v += __shfl_xor(v, 32); if (kr == 0) unsafeAtomicAdd(bW + j0 + 8 * cg8 + e, v); }
}

__device__ __forceinline__ int causal_bucket(int n) {
    if (n < 16) return n;
    const float nf = (float)n;
    int large = 16 + (int)(logf(nf / 16.f) / 2.0794415416798357f * 16.f);
    return large < 31 ? large : 31;
}

__device__ __forceinline__ size_t zero_opaque() { size_t z = 0; asm volatile("" : "+s"(z)); return z; }
__device__ __forceinline__ const float* inp_ptr(const Args& a, int k) { return a.in[k] + zero_opaque(); }
#define INP(k) inp_ptr(a, k)
__device__ __forceinline__ unsigned char* ws_opaque(const Args& a) { return a.ws + zero_opaque(); }
__device__ __forceinline__ float* out_opaque(const Args& a) { return a.out + zero_opaque(); }
#define WSP(type, off) ((type*)(ws_opaque(a) + (off)))
__global__ void __launch_bounds__(NTHR, 2) mega_fwd(Args a) {
    extern __shared__ __attribute__((aligned(16))) unsigned char lds[];
    cg::grid_group grid = cg::this_grid();
    volatile LAS unsigned* bst = (volatile LAS unsigned*)((LAS unsigned char*)lds + LDS_BYTES - 64);
    if (threadIdx.x == 0) { bst[0] = 0u; bst[1] = 0u; }
    __syncthreads();
    const XcdBarrier xbar = xcd_barrier_post((unsigned*)(a.ws + WS_BAR), bst);
#define GRID_BAR() xcd_barrier(xbar)
    const int G = gridDim.x;
    const int NGW = G * NWAVES, NGT = G * NTHR;
    {
        PH_IDS;
        unsigned char* ws = ws_opaque(a);
        float* lamp = (float*)(ws + WS_LAM); float* btab = (float*)(ws + WS_BTAB); bf16_t* wtril = (bf16_t*)(ws + WS_WTRIL); bf16_t* membf = (bf16_t*)(ws + WS_MEMBF); bf16_t* XN = (bf16_t*)(ws + WS_XN);
        LAS float* scr = (LAS float*)((LAS unsigned char*)lds + wave * 17408);
        constexpr int I_IN = 32 * 88, I_SQ = 32 * 32, I_KV = 32 * 64, I_GU = 32 * 176, I_D = 88 * 32;
        constexpr int PER_LAYER = I_IN + 3 * I_SQ + I_KV + I_GU + I_D;
        for (int it = gw; it < 2 * PER_LAYER; it += NGW) {
            const int l = it / PER_LAYER; int r = it % PER_LAYER;
            unsigned char* wl = ws + WS_W + (size_t)l * W_LAYER;
            float* cl = (float*)(ws + WS_C) + (size_t)l * C_LAYER;
            if (r < I_IN) { const bool f = l > 0;
                p0_transpose_item(INP(3) + (size_t)l * DM * INC, DM, INC, (bf16_t*)(wl + W_IN), 0, f ? INP(22) : nullptr, f ? INP(23) : nullptr, cl + C_IN, cl + C_IN + INC, scr, r, lane); continue; } r -= I_IN;
            if (r < I_SQ) { p0_transpose_item(INP(12) + (size_t)l * DM * DM, DM, DM, (bf16_t*)(wl + W_OUT), 0, nullptr, nullptr, nullptr, nullptr, scr, r, lane); continue; } r -= I_SQ;
            if (r < I_SQ) { p0_wq_item(INP(15) + (size_t)l * DM * DM, (bf16_t*)(wl + W_Q), INP(13) + (size_t)l * DM, INP(14) + (size_t)l * DM, cl + C_Q + DM, r, lane); continue; } r -= I_SQ;
            if (r < I_KV) { p0_transpose_item(INP(16) + (size_t)l * DM * 2 * DM, DM, 2 * DM, (bf16_t*)(wl + W_KV), 0, nullptr, nullptr, nullptr, nullptr, scr, r, lane); continue; } r -= I_KV;
            if (r < I_SQ) { p0_transpose_item(INP(17) + (size_t)l * DM * DM, DM, DM, (bf16_t*)(wl + W_O), 0, nullptr, nullptr, nullptr, nullptr, scr, r, lane); continue; } r -= I_SQ;
            if (r < I_GU) { p0_transpose_item(INP(20) + (size_t)l * DM * 2 * DFF, DM, 2 * DFF, (bf16_t*)(wl + W_GU), 1, INP(18) + (size_t)l * DM, INP(19) + (size_t)l * DM, cl + C_GU, cl + C_GU + 2 * DFF, scr, r, lane); continue; } r -= I_GU;
            p0_transpose_item(INP(21) + (size_t)l * DFF * DM, DFF, DM, (bf16_t*)(wl + W_D), 0, nullptr, nullptr, nullptr, nullptr, scr, r, lane);
        }
        for (size_t i = gt; i < (size_t)T * DM / 8; i += NGT) {
            const f32x4 v0 = *(const f32x4*)(INP(0) + i * 8), v1 = *(const f32x4*)(INP(0) + i * 8 + 4);
            u32x4 w; w.x = cvt_pk_bf16(v0[0], v0[1]); w.y = cvt_pk_bf16(v0[2], v0[3]); w.z = cvt_pk_bf16(v1[0], v1[1]); w.w = cvt_pk_bf16(v1[2], v1[3]);
            *(u32x4*)(XN + i * 8) = w;
        }
        for (size_t i = gt; i < (size_t)BATCH * NMEM * DM / 8; i += NGT) {
            const f32x4 v0 = *(const f32x4*)(INP(1) + i * 8), v1 = *(const f32x4*)(INP(1) + i * 8 + 4);
            u32x4 w; w.x = cvt_pk_bf16(v0[0], v0[1]); w.y = cvt_pk_bf16(v0[2], v0[3]); w.z = cvt_pk_bf16(v1[0], v1[1]); w.w = cvt_pk_bf16(v1[2], v1[3]);
            *(u32x4*)(membf + i * 8) = w;
        }
        for (int i = gt; i < DEPTH * 4 * 128 * 128; i += NGT) { const int s = i & 127, t = (i >> 7) & 127; wtril[i] = s <= t ? f2bf(INP(7)[i]) : (bf16_t)0; }
        if (gt < 8 * 256) { const int hm = gt >> 8, d = gt & 255; const float* rb = INP(2);
            btab[gt] = (rb[causal_bucket(d) * 8 + hm] - rb[31 * 8 + hm]) * (1.f / att::SCALE); }
        if (cu == 0 && wave == 0) {
            for (int l = 0; l < DEPTH; ++l) {
                const float* lq = INP(9) + l * 256; const float* lk = INP(10) + l * 256;
                float s0 = lq[lane] * lk[lane] + lq[lane + 64] * lk[lane + 64];
                float s1 = lq[128 + lane] * lk[128 + lane] + lq[192 + lane] * lk[192 + lane];
                s0 = wave_sum(s0); s1 = wave_sum(s1);
                const float lam_init = 0.8f - 0.6f * expf(-0.3f * (float)l);
                if (lane == 0) lamp[l] = expf(s0) - expf(s1) + lam_init;
            }
        }
    }
    grid.sync();

#pragma unroll 1
    for (int l = 0; l < DEPTH; ++l) {
        {
            unsigned char* ws = ws_opaque(a);
            pg8::Gemm g{(const bf16_t*)(ws + WS_XN), (const bf16_t*)(ws + WS_W + (size_t)l * W_LAYER + W_IN), DM, DM, DM, 1, 0, 0, 0, 0};
            pg8::Order S; S.init(T, INC, 1, G, cu_opaque());
            const float* cl = (const float*)(ws + WS_C) + (size_t)l * C_LAYER;
            const float* st = l > 0 ? (const float*)(ws + WS_ST) + (size_t)(3 * l - 1) * T * 2 : nullptr;
            pg8::EpiSplit E{(bf16_t*)(ws + WS_PROJ), st, cl + C_IN, cl + C_IN + INC};
            pg8::gemm_phase<pg8::EpiSplit, true>((LAS unsigned char*)lds, g, S, E);
        }
        if (l == 0) {
            {
                unsigned char* ws = ws_opaque(a);
                pg8::Gemm g{(const bf16_t*)(ws + WS_MEMBF), (const bf16_t*)(ws + WS_W + W_KV), DM, DM, DM, 1, 0, 0, (long)(W_LAYER / 2), 0};
                pg8::Order S; const int cu = cu_opaque(); S.init(BATCH * NMEM, 2 * DM, 2, G, cu >= 128 && cu < 192 ? cu - 128 : -1);
                pg8::EpiBf16 E{(bf16_t*)(ws + WS_KV), 2 * DM, 1, (long)(BATCH * NMEM) * 2 * DM, 0, 1.f, nullptr, nullptr, nullptr, nullptr};
                pg8::gemm_phase<pg8::EpiBf16, true>((LAS unsigned char*)lds, g, S, E);
            }
        }
        GRID_BAR();

        if (l == 0) {
#pragma unroll 1
            for (int L2 = 0; L2 < DEPTH; ++L2) {
                {
                    unsigned char* ws = ws_opaque(a); unsigned char* wl2 = ws + WS_W + (size_t)L2 * W_LAYER;
                    const bf16_t* KVl = (const bf16_t*)(ws + WS_KV) + (size_t)L2 * BATCH * NMEM * 2 * DM;
                    float* cl = (float*)(ws + WS_C) + (size_t)L2 * C_LAYER;
                    pg8::Gemm g{KVl, (const bf16_t*)(wl2 + W_Q), 2 * DM, DM, 512, 4, (long)NMEM * 2 * DM, 512, 0, 512};
                    pg8::Order S; const int cu = cu_opaque(); S.init(NMEM, DM, 8, G, cu >= 64 * L2 && cu < 64 * L2 + 64 ? cu - 64 * L2 : -1);
                    pg8::EpiBf16 E{(bf16_t*)(wl2 + W_KV), DM, 1, (long)NMEM * DM, 0, 1.f, nullptr, nullptr, nullptr, cl + C_Q};
                    pg8::gemm_phase<pg8::EpiBf16, true>((LAS unsigned char*)lds, g, S, E);
                }
                {
                    unsigned char* ws = ws_opaque(a); unsigned char* wl2 = ws + WS_W + (size_t)L2 * W_LAYER;
                    const bf16_t* KVl = (const bf16_t*)(ws + WS_KV) + (size_t)L2 * BATCH * NMEM * 2 * DM;
                    pg8::Gemm g{(const bf16_t*)(wl2 + W_O), KVl + DM, DM, 2 * DM, 512, 4, 0, 512, (long)NMEM * 2 * DM, 512};
                    pg8::Order S; const int cu = cu_opaque(); S.init(DM, NMEM, 8, G, cu >= 128 + 64 * L2 && cu < 192 + 64 * L2 ? cu - 128 - 64 * L2 : -1);
                    pg8::EpiBf16 E{(bf16_t*)(wl2 + W_KV + 8 * MiB), 1024, 4, (long)DM * 1024, 256, 1.f, nullptr, nullptr, nullptr, nullptr};
                    pg8::gemm_phase<pg8::EpiBf16, true>((LAS unsigned char*)lds, g, S, E);
                }
            }
            {
                PH_IDS;
                unsigned char* ws = ws_opaque(a);
                for (int it = gw; it < DEPTH * 2048; it += NGW) {
                    const int L2 = it >> 11, r = it & 2047, b = r >> 10, h = (r >> 8) & 3, n = r & 255;
                    const bf16_t* kp = (const bf16_t*)(ws + WS_KV) + ((size_t)L2 * BATCH * NMEM + b * NMEM + n) * 2 * DM + h * 512 + 8 * lane;
                    float* cl = (float*)(ws + WS_C) + (size_t)L2 * C_LAYER;
                    const float* bw = cl + C_Q + DM + h * 512 + 8 * lane;
                    const u32x4 kw = *(const u32x4*)kp; const f32x4 b0 = *(const f32x4*)bw, b1 = *(const f32x4*)(bw + 4);
                    float d = (bf_lo(kw.x) * b0[0] + bf_hi(kw.x) * b0[1]) + (bf_lo(kw.y) * b0[2] + bf_hi(kw.y) * b0[3]) + (bf_lo(kw.z) * b1[0] + bf_hi(kw.z) * b1[1]) + (bf_lo(kw.w) * b1[2] + bf_hi(kw.w) * b1[3]);
                    d = wave_sum(d);
                    if (lane == 0) cl[C_QK2 + r] = d;
                }
            }
            __syncthreads();
        }
        {
            PH_IDS;
            bf16_t* PB = WSP(bf16_t, WS_PROJ); bf16_t* Y = WSP(bf16_t, WS_Y);
            const float* cw = INP(4) + (size_t)l * 3 * 512;
            for (int it = gt; it < T * 64; it += NGT) {
                const int r = it >> 6, cg8 = it & 63, c0 = cg8 * 8, gi = cg8 >> 4, cc = c0 & 127, t = r & (SEQ - 1);
                const bf16_t* pb = PB + ((size_t)(0 + gi) * T + r) * 128 + cc;
                const bf16_t* pc = PB + ((size_t)(4 + gi) * T + r) * 128 + cc;
                const bf16_t* ph = PB + ((size_t)(8 + gi) * T + r) * 128 + cc;
                const u32x4 wb = *(const u32x4*)pb, wc0 = *(const u32x4*)pc, wh0 = *(const u32x4*)ph;
                u32x4 wc1 = {0, 0, 0, 0}, wh1 = {0, 0, 0, 0}, wc2 = {0, 0, 0, 0}, wh2 = {0, 0, 0, 0};
                if (t >= 1) { wc1 = *(const u32x4*)(pc - 128); wh1 = *(const u32x4*)(ph - 128); }
                if (t >= 2) { wc2 = *(const u32x4*)(pc - 256); wh2 = *(const u32x4*)(ph - 256); }
                float y[8];
#pragma unroll
                for (int j = 0; j < 4; ++j) {
                    const float k0a = cw[c0 + 2 * j], k1a = cw[512 + c0 + 2 * j], k2a = cw[1024 + c0 + 2 * j];
                    const float k0b = cw[c0 + 2 * j + 1], k1b = cw[512 + c0 + 2 * j + 1], k2b = cw[1024 + c0 + 2 * j + 1];
                    const float z0a = bf_lo(wc0[j]) * bf_lo(wh0[j]), z1a = bf_lo(wc1[j]) * bf_lo(wh1[j]), z2a = bf_lo(wc2[j]) * bf_lo(wh2[j]);
                    const float z0b = bf_hi(wc0[j]) * bf_hi(wh0[j]), z1b = bf_hi(wc1[j]) * bf_hi(wh1[j]), z2b = bf_hi(wc2[j]) * bf_hi(wh2[j]);
                    y[2 * j] = bf_lo(wb[j]) * (k0a * z2a + k1a * z1a + k2a * z0a);
                    y[2 * j + 1] = bf_hi(wb[j]) * (k0b * z2b + k1b * z1b + k2b * z0b);
                }
                u32x4 w; w.x = cvt_pk_bf16(y[0], y[1]); w.y = cvt_pk_bf16(y[2], y[3]); w.z = cvt_pk_bf16(y[4], y[5]); w.w = cvt_pk_bf16(y[6], y[7]);
                *(u32x4*)(Y + (size_t)r * DM + c0) = w;
            }
        }
        {
            PH_IDS;
            bf16_t* PB = WSP(bf16_t, WS_PROJ); bf16_t* Y = WSP(bf16_t, WS_Y); bf16_t* wtril = WSP(bf16_t, WS_WTRIL);
            float* st = (float*)(lds + 40960);
            bf16_t* vT = (bf16_t*)lds;
            const float* lng = INP(5) + (size_t)l * 512; const float* lnb = INP(6) + (size_t)l * 512;
            const float* bs = INP(8) + (size_t)l * 512;
            for (int un = cu; un < (T / 128) * 4; un += G) {
                const int ch = un >> 2, gi = un & 3, r0 = ch * 128;
                const int tok = tid >> 2, q = tid & 3;
                {
                    const bf16_t* vp = PB + ((size_t)(16 + q) * T + r0 + tok) * 128;
                    float s = 0.f, ss = 0.f;
#pragma unroll 4
                    for (int i = 0; i < 16; ++i) { const u32x4 w = *(const u32x4*)(vp + 8 * i);
#pragma unroll
                        for (int j = 0; j < 4; ++j) { const float x0 = gelu_tanh(bf_lo(w[j])), x1 = gelu_tanh(bf_hi(w[j])); s += x0 + x1; ss += x0 * x0 + x1 * x1; } }
                    s += __shfl_xor(s, 1); s += __shfl_xor(s, 2); ss += __shfl_xor(ss, 1); ss += __shfl_xor(ss, 2);
                    const float mean = s * (1.f / 512.f), var = fmaxf(ss * (1.f / 512.f) - mean * mean, 0.f);
                    if (q == 0) { st[2 * tok] = mean; st[2 * tok + 1] = rsqrtf(var + LN_EPS); }
                }
                __syncthreads();
                {
                    const int cq = q * 32; const float mean = st[2 * tok], rstd = st[2 * tok + 1];
                    const bf16_t* vp = PB + ((size_t)(16 + gi) * T + r0 + tok) * 128 + cq;
#pragma unroll
                    for (int i = 0; i < 4; ++i) { const u32x4 w = *(const u32x4*)(vp + 8 * i);
#pragma unroll
                        for (int j = 0; j < 4; ++j) { const int c = cq + 8 * i + 2 * j;
                            const float x0 = gelu_tanh(bf_lo(w[j])), x1 = gelu_tanh(bf_hi(w[j]));
                            vT[c * 136 + tok] = f2bf((x0 - mean) * rstd * lng[gi * 128 + c] + lnb[gi * 128 + c]);
                            vT[(c + 1) * 136 + tok] = f2bf((x1 - mean) * rstd * lng[gi * 128 + c + 1] + lnb[gi * 128 + c + 1]); } }
                }
                __syncthreads();
                {
                    f32x4 acc[8];
#pragma unroll
                    for (int ct = 0; ct < 8; ++ct) acc[ct] = (f32x4){0.f, 0.f, 0.f, 0.f};
                    const bf16_t* wrow = wtril + ((size_t)(l * 4 + gi) * 128 + 16 * wave + (lane & 15)) * 128 + 8 * (lane >> 4);
#pragma unroll
                    for (int kk = 0; kk < 4; ++kk) { const bf16x8 av = *(const bf16x8*)(wrow + kk * 32);
#pragma unroll
                        for (int ct = 0; ct < 8; ++ct) { const bf16x8 bv = *(const bf16x8*)(vT + (ct * 16 + (lane & 15)) * 136 + kk * 32 + 8 * (lane >> 4));
                            acc[ct] = __builtin_amdgcn_mfma_f32_16x16x32_bf16(av, bv, acc[ct], 0, 0, 0); } }
#pragma unroll
                    for (int ct = 0; ct < 8; ++ct)
#pragma unroll
                        for (int j = 0; j < 4; ++j) { const int t = 16 * wave + 4 * (lane >> 4) + j, c = ct * 16 + (lane & 15);
                            const float uu = bf2f(PB[((size_t)(12 + gi) * T + r0 + t) * 128 + c]);
                            Y[(size_t)(r0 + t) * DM + 512 + gi * 128 + c] = f2bf(gelu_tanh(uu) * (acc[ct][j] + bs[gi * 128 + t])); }
                }
                __syncthreads();
            }
        }
        {
            PH_IDS;
            bf16_t* PB = WSP(bf16_t, WS_PROJ); float* OATT = WSP(float, WS_R1); float* btab = WSP(float, WS_BTAB);
            float* btl = (float*)(lds + att2::L_BT);
            for (int i = tid; i < 8 * 256; i += NTHR) btl[i] = btab[i];
            __syncthreads();
            const att::bf16* PBb = (const att::bf16*)PB;
#pragma unroll 1
            for (int L = cu; L < 512; L += G) {
                const int k_ = L >> 3, hm = L & 7, b = k_ >> 5, x = k_ & 31, h = hm >> 1;
#pragma unroll 1
                for (int pass = 0; pass < 2; ++pass) {
                    const int qb = pass ? 63 - x : x;
                    att2::Blk c;
                    c.Q = PBb + ((size_t)(20 + hm) * T + (size_t)b * SEQ + qb * 128) * 128; c.K = PBb + ((size_t)(28 + hm) * T + (size_t)b * SEQ) * 128;
                    c.V0 = PBb + ((size_t)(36 + h * 2) * T + (size_t)b * SEQ) * 128; c.V1 = PBb + ((size_t)(37 + h * 2) * T + (size_t)b * SEQ) * 128;
                    c.O0 = OATT + ((size_t)((b * 8 + hm) * 2 + 0) * SEQ + qb * 128) * 128; c.O1 = OATT + ((size_t)((b * 8 + hm) * 2 + 1) * SEQ + qb * 128) * 128;
                    c.P0 = qb * 128; c.hm = hm;
                    att2::attn2_block(c, (char*)lds);
                }
            }
        }
        GRID_BAR();

        {
            PH_IDS;
            float* OATT = WSP(float, WS_R1); bf16_t* Y = WSP(bf16_t, WS_Y); float* lamp = WSP(float, WS_LAM);
            const float lam_init = 0.8f - 0.6f * expf(-0.3f * (float)l);
            const float lam = lamp[l]; const float* sg = INP(11) + (size_t)l * 256;
            const f32x4 gv = *(const f32x4*)(sg + 4 * lane);
            for (int it = gw; it < T * 4; it += NGW) {
                const int r = it >> 2, h = it & 3, b = r >> 13, t = r & (SEQ - 1);
                const int half = lane >> 5, e = (lane & 31) * 4;
                const size_t i0 = ((size_t)(((b * 4 + h) * 2 + 0) * 2 + half) * SEQ + t) * 128 + e;
                const size_t i1 = ((size_t)(((b * 4 + h) * 2 + 1) * 2 + half) * SEQ + t) * 128 + e;
                const f32x4 o0 = *(const f32x4*)(OATT + i0), o1 = *(const f32x4*)(OATT + i1);
                const f32x4 d = o0 - o1 * lam;
                const float ss = wave_sum(d[0] * d[0] + d[1] * d[1] + d[2] * d[2] + d[3] * d[3]);
                const float sc = rsqrtf(ss * (1.f / 256.f) + LN_EPS) * (1.f - lam_init);
                u32x2 w; w.x = cvt_pk_bf16(d[0] * sc * gv[0], d[1] * sc * gv[1]); w.y = cvt_pk_bf16(d[2] * sc * gv[2], d[3] * sc * gv[3]);
                *(u32x2*)(Y + (size_t)r * DM + 1024 + h * 256 + 4 * lane) = w;
            }
        }
        GRID_BAR();

#define LN_PASS(gam, bet, write_xn) do { PH_IDS; float* X = out_opaque(a); bf16_t* XN = WSP(bf16_t, WS_XN); \
            for (int r = gw; r < T; r += NGW) { float* xr = X + (size_t)r * DM; f32x4 v[8]; float s = 0.f; \
                _Pragma("unroll") for (int j = 0; j < 8; ++j) { v[j] = *(const f32x4*)(xr + 4 * lane + 256 * j); s += (v[j][0] + v[j][1]) + (v[j][2] + v[j][3]); } \
                const float mean = wave_sum(s) * (1.f / DM); float s2 = 0.f; \
                _Pragma("unroll") for (int j = 0; j < 8; ++j) { v[j] = v[j] - mean; s2 += (v[j][0] * v[j][0] + v[j][1] * v[j][1]) + (v[j][2] * v[j][2] + v[j][3] * v[j][3]); } \
                const float rstd = rsqrtf(wave_sum(s2) * (1.f / DM) + LN_EPS); \
                _Pragma("unroll") for (int j = 0; j < 8; ++j) { const f32x4 gg = *(const f32x4*)((gam) + 4 * lane + 256 * j), bb = *(const f32x4*)((bet) + 4 * lane + 256 * j); \
                    const f32x4 o = v[j] * rstd * gg + bb; *(f32x4*)(xr + 4 * lane + 256 * j) = o; \
                    if (write_xn) { u32x2 w; w.x = cvt_pk_bf16(o[0], o[1]); w.y = cvt_pk_bf16(o[2], o[3]); *(u32x2*)(XN + (size_t)r * DM + 4 * lane + 256 * j) = w; } } } } while (0)

        {
            unsigned char* ws = ws_opaque(a); float* X = out_opaque(a); float* ST = (float*)(ws + WS_ST);
            pg8::Gemm g{(const bf16_t*)(ws + WS_Y), (const bf16_t*)(ws + WS_W + (size_t)l * W_LAYER + W_OUT), DM, DM, DM, 1, 0, 0, 0, 0};
            pg8::Order S; S.init(T, DM, 1, G, cu_opaque());
            pg8::EpiRes E{nullptr, l == 0 ? INP(0) : nullptr, ST + (size_t)(l > 0 ? 3 * l - 1 : 0) * T * 2, INP(22) + (size_t)(l > 0 ? l - 1 : 0) * DM, INP(23) + (size_t)(l > 0 ? l - 1 : 0) * DM,
                          (bf16_t*)(ws + WS_XN), ST + (size_t)(3 * l) * T * 2, ALPHA, 0};
            pg8::gemm_phase<pg8::EpiRes, true>((LAS unsigned char*)lds, g, S, E);
        }
        GRID_BAR();

        {
            unsigned char* ws = ws_opaque(a);
            const float* cl = (const float*)(ws + WS_C) + (size_t)l * C_LAYER;
            pg8::Gemm g{(const bf16_t*)(ws + WS_XN), (const bf16_t*)(ws + WS_W + (size_t)l * W_LAYER + W_KV), DM, DM, DM, 4, (long)SEQ * DM, 0, (long)4 * NMEM * DM, (long)NMEM * DM};
            pg8::Order S; S.init(SEQ, NMEM, 8, G, cu_opaque());
            pg8::EpiSoftmax E{(bf16_t*)(ws + WS_PROJ + 64 * MiB), (const float*)(ws + WS_ST) + (size_t)(3 * l) * T * 2, cl + C_Q, cl + C_QK2, 0.044194173824159216f};
            pg8::gemm_phase<pg8::EpiSoftmax, true>((LAS unsigned char*)lds, g, S, E);
        }
        GRID_BAR();
        {
            unsigned char* ws = ws_opaque(a); float* ST = (float*)(ws + WS_ST);
            pg8::Gemm g{(const bf16_t*)(ws + WS_PROJ + 64 * MiB), (const bf16_t*)(ws + WS_W + (size_t)l * W_LAYER + W_KV + 8 * MiB), 1024, 1024, 1024, 1, (long)SEQ * 1024, 0, (long)DM * 1024, 0};
            pg8::Order S; S.init(SEQ, DM, 2, G, cu_opaque());
            pg8::EpiRes E{nullptr, nullptr, ST + (size_t)(3 * l) * T * 2, INP(13) + (size_t)l * DM, INP(14) + (size_t)l * DM, (bf16_t*)(ws + WS_XN), ST + (size_t)(3 * l + 1) * T * 2, ALPHA, SEQ};
            pg8::gemm_phase<pg8::EpiRes, true>((LAS unsigned char*)lds, g, S, E);
        }
        GRID_BAR();
        {
            unsigned char* ws = ws_opaque(a);
            const float* cl = (const float*)(ws + WS_C) + (size_t)l * C_LAYER;
            pg8::Gemm g{(const bf16_t*)(ws + WS_XN), (const bf16_t*)(ws + WS_W + (size_t)l * W_LAYER + W_GU), DM, DM, DM, 1, 0, 0, 0, 0};
            pg8::Order S; S.init(T, 2 * DFF, 1, G, cu_opaque());
            pg8::EpiSwiglu E{(bf16_t*)(ws + WS_PROJ), (const float*)(ws + WS_ST) + (size_t)(3 * l + 1) * T * 2, cl + C_GU, cl + C_GU + 2 * DFF};
            pg8::gemm_phase<pg8::EpiSwiglu, true>((LAS unsigned char*)lds, g, S, E);
        }
        GRID_BAR();
        {
            unsigned char* ws = ws_opaque(a); float* X = out_opaque(a); float* ST = (float*)(ws + WS_ST);
            pg8::Gemm g{(const bf16_t*)(ws + WS_PROJ), (const bf16_t*)(ws + WS_W + (size_t)l * W_LAYER + W_D), DFF, DFF, DFF, 1, 0, 0, 0, 0};
            pg8::Order S; S.init(T, DM, 1, G, cu_opaque());
            pg8::EpiRes E{l + 1 == DEPTH ? X : nullptr, nullptr, ST + (size_t)(3 * l + 1) * T * 2, INP(18) + (size_t)l * DM, INP(19) + (size_t)l * DM, (bf16_t*)(ws + WS_XN), ST + (size_t)(3 * l + 2) * T * 2, ALPHA, 0};
            pg8::gemm_phase<pg8::EpiRes, true>((LAS unsigned char*)lds, g, S, E);
        }
        GRID_BAR();
        if (l + 1 == DEPTH) { LN_PASS(INP(22) + (size_t)l * DM, INP(23) + (size_t)l * DM, false); }
#undef LN_PASS
    }
}

extern "C" void kernel_launch(void* const* d_in, const int* in_sizes, int n_in, void* d_out, int out_size, void* d_ws, size_t ws_size, hipStream_t stream) {
    static int grid = 0;
    if (grid == 0) {
        if (n_in != 24 || in_sizes[0] != T * DM || out_size != T * DM || ws_size < WS_END) {
            fprintf(stderr, "kernel_launch: unexpected shapes (n_in %d, in0 %d, out %d, ws %zu); nothing launched\n", n_in, n_in > 0 ? in_sizes[0] : -1, out_size, ws_size); grid = -1; return; }
        int dev = 0, cus = 0, per_cu = 0;
        (void)hipGetDevice(&dev);
        if (hipDeviceGetAttribute(&cus, hipDeviceAttributeMultiprocessorCount, dev) != hipSuccess || cus <= 0) cus = 256;
        if (hipFuncSetAttribute((const void*)mega_fwd, hipFuncAttributeMaxDynamicSharedMemorySize, LDS_BYTES) != hipSuccess) fprintf(stderr, "kernel_launch: hipFuncSetAttribute failed\n");
        if (hipOccupancyMaxActiveBlocksPerMultiprocessor(&per_cu, (const void*)mega_fwd, NTHR, LDS_BYTES) != hipSuccess || per_cu < 1) { fprintf(stderr, "kernel_launch: occupancy query says %d\n", per_cu); per_cu = 1; }
        (void)hipGetLastError();
        grid = cus * per_cu;
    }
    if (grid < 0) return;
    if (hipMemsetAsync((char*)d_ws + WS_BAR, 0, 512 * 1024, stream) != hipSuccess || hipMemsetAsync((char*)d_ws + WS_ST, 0, 1 * MiB, stream) != hipSuccess) { fprintf(stderr, "kernel_launch: hipMemsetAsync failed\n"); return; }
    Args a{};
    for (int i = 0; i < 24; ++i) a.in[i] = (const float*)d_in[i];
    a.out = (float*)d_out; a.ws = (unsigned char*)d_ws;
    void* args[] = {&a};
    hipError_t e = hipLaunchCooperativeKernel((const void*)mega_fwd, dim3(grid), dim3(NTHR), args, LDS_BYTES, stream);
    if (e != hipSuccess) fprintf(stderr, "cooperative launch failed: %s (grid %d)\n", hipGetErrorString(e), grid);
}
```

```cpp
#include <hip/hip_runtime.h>
#include <hip/hip_cooperative_groups.h>
#include <hip/hip_bf16.h>
#include <cstdio>
#include <cstdint>
namespace cg = cooperative_groups;

constexpr int BATCH = 2, SEQ = 8192, DM = 2048, DEPTH = 2, T = BATCH * SEQ;
constexpr int NMEM = 256, INC = 5632, DFF = 5632;
constexpr float ALPHA = 1.4142135623730951f;
constexpr float LN_EPS = 1e-5f;
constexpr int NTHR = 512, NWAVES = 8;

constexpr size_t MiB = 1u << 20;
constexpr size_t WS_LAM = 0;
constexpr size_t WS_BTAB = 4096;
constexpr size_t WS_BAR = 512 * 1024;
constexpr size_t WS_C = 576 * 1024;
constexpr int C_Q = 0, C_GU = 4096, C_IN = 4096 + 22528, C_QK2 = 4096 + 22528 + 11264, C_LAYER = C_QK2 + 2048;
constexpr size_t WS_ST = 12 * MiB;
constexpr size_t WS_WTRIL = 1 * MiB;
constexpr size_t WS_MEMBF = 2 * MiB;
constexpr size_t WS_KV = 4 * MiB;
constexpr size_t WS_W = 16 * MiB;
constexpr size_t W_IN = 0, W_OUT = 22 * MiB, W_Q = 30 * MiB, W_KV = 38 * MiB, W_O = 54 * MiB, W_GU = 62 * MiB, W_D = 106 * MiB, W_LAYER = 128 * MiB;
constexpr size_t WS_XN = 272 * MiB;
constexpr size_t WS_PROJ = 336 * MiB;
constexpr size_t WS_R1 = 512 * MiB;
constexpr size_t WS_Y = 640 * MiB;
constexpr size_t WS_END = 704 * MiB;
constexpr int LDS_BYTES = 147456;

typedef unsigned short bf16_t;
typedef short bf16x8 __attribute__((ext_vector_type(8)));
typedef float f32x4 __attribute__((ext_vector_type(4)));
typedef float f32x16 __attribute__((ext_vector_type(16)));
typedef unsigned u32x4 __attribute__((ext_vector_type(4)));
typedef unsigned u32x2 __attribute__((ext_vector_type(2)));
#define LAS __attribute__((address_space(3)))
#define GAS __attribute__((address_space(1)))

__device__ __forceinline__ unsigned cvt_pk_bf16(float lo, float hi) { unsigned r; asm volatile("v_cvt_pk_bf16_f32 %0, %1, %2" : "=v"(r) : "v"(lo), "v"(hi)); return r; }
__device__ __forceinline__ float bf_lo(unsigned w) { return __uint_as_float(w << 16); }
__device__ __forceinline__ float bf_hi(unsigned w) { return __uint_as_float(w & 0xffff0000u); }
__device__ __forceinline__ float bf2f(bf16_t b) { return __uint_as_float(((unsigned)b) << 16); }
__device__ __forceinline__ bf16_t f2bf(float f) { return (bf16_t)(cvt_pk_bf16(f, 0.f) & 0xffffu); }
__device__ __forceinline__ int ltid() { int t = threadIdx.x; asm volatile("" : "+v"(t)); return t; }
__device__ __forceinline__ int cu_opaque() { int c = blockIdx.x; asm volatile("" : "+s"(c)); return c; }
#define PH_IDS const int cu = cu_opaque(); const int tid = ltid(), lane = tid & 63, wave = __builtin_amdgcn_readfirstlane(tid >> 6), gw = cu * NWAVES + wave, gt = cu * NTHR + tid; (void)lane; (void)wave; (void)gw; (void)gt
__device__ __forceinline__ float wave_sum(float v) {
#pragma unroll
    for (int o = 1; o < 64; o <<= 1) v += __shfl_xor(v, o);
    return v;
}
__device__ __forceinline__ float wave_max(float v) {
#pragma unroll
    for (int o = 1; o < 64; o <<= 1) v = fmaxf(v, __shfl_xor(v, o));
    return v;
}
__device__ __forceinline__ float gelu_tanh(float x) {
    const float y = 0.7978845608028654f * (x + 0.044715f * x * x * x);
    return x * __builtin_amdgcn_rcpf(1.f + __expf(-2.f * y));
}

namespace pg8 {
constexpr int BM = 256, BK = 64, HALF = 128, HTB = HALF * BK * 2, STAGE_BYTES = 8 * HTB, NXCD = 8, WGM = 8;
__host__ __device__ __forceinline__ int lds_byte(int r, int c) { const int st = (r >> 4) * 2 + (c >> 5), rr = r & 15, cc = c & 31, ob = rr * 64 + cc * 2; return st * 1024 + (ob ^ (((ob >> 9) & 1) << 5)); }
__host__ __device__ __forceinline__ void stage_rc(int b, int& R, int& C) { const int st = b / 1024, sb = b % 1024, swz = sb ^ (((sb >> 9) & 1) << 5); R = (st >> 1) * 16 + swz / 64; C = (st & 1) * 32 + (swz % 64) / 2; }
__host__ __device__ __forceinline__ int perm32(int rho) { const int n = rho >> 4, i = rho & 15; return 8 * (i >> 2) + 4 * n + (i & 3); }

struct Unit { int pm, pn, bz; };
struct Gemm { const bf16_t* A; const bf16_t* Bt; int lda, ldb, K, nb0; long a_s1, a_s0, b_s1, b_s0; };
__device__ __forceinline__ const char* unit_a(const Gemm& g, const Unit& u) { const int b1 = u.bz / g.nb0, b0 = u.bz % g.nb0; return (const char*)(g.A + (size_t)b1 * g.a_s1 + (size_t)b0 * g.a_s0 + (size_t)u.pm * BM * g.lda); }
__device__ __forceinline__ const char* unit_b(const Gemm& g, const Unit& u) { const int b1 = u.bz / g.nb0, b0 = u.bz % g.nb0; return (const char*)(g.Bt + (size_t)b1 * g.b_s1 + (size_t)b0 * g.b_s0 + (size_t)u.pn * BM * g.ldb); }

struct Order {
    int nM, nN, nB, G, c;
    __device__ void init(int M, int N, int nB_, int G_, int c_) { nM = M / BM; nN = N / BM; nB = nB_; G = G_; c = c_; }
    __device__ bool next(int i, Unit& u) const {
        const long L = (long)i * G + c; const int nwg = nM * nN; if (c < 0 || L >= (long)nwg * nB) return false;
        if (nB > 1) { u.bz = (int)(L / nwg); const int w = (int)(L % nwg); u.pn = w / nM; u.pm = w % nM; return true; }
        u.bz = 0;
        int wgid = (int)L; { const int q = nwg / NXCD, r = nwg % NXCD, xcd = wgid % NXCD, off = wgid / NXCD; wgid = (xcd < r ? xcd * (q + 1) : r * (q + 1) + (xcd - r) * q) + off; }
        const int nig = WGM * nN, gid = wgid / nig, fm = gid * WGM, gsz = (nM - fm) < WGM ? (nM - fm) : WGM;
        u.pm = fm + ((wgid % nig) % gsz); u.pn = (wgid % nig) / gsz; return true;
    }
};

__device__ __forceinline__ void row_stats(const float* st, int row, float& mean, float& rstd) {
    const float s1 = st[2 * row], s2 = st[2 * row + 1];
    mean = s1 * (1.f / DM); const float var = fmaxf(s2 * (1.f / DM) - mean * mean, 0.f); rstd = rsqrtf(var + LN_EPS);
}
struct EpiSplit {
    static constexpr bool PERM = true, AFTER_DRAIN = false;
    bf16_t* P; const float* st; const float* c1; const float* c2;
    __device__ __forceinline__ void operator()(const f32x4 (&acc)[2][2][4][2], const Unit& u, int wr, int wc, int fr, int fq) const {
        const int row0 = u.pm * BM + wr * 64 + fr, col0 = u.pn * BM + wc * 32 + 8 * fq;
        f32x4 k1[2][2], k2[2][2];
        if (st) {
#pragma unroll
            for (int bj = 0; bj < 2; ++bj)
#pragma unroll
                for (int n = 0; n < 2; ++n) { k1[bj][n] = *(const f32x4*)(c1 + col0 + bj * HALF + 4 * n); k2[bj][n] = *(const f32x4*)(c2 + col0 + bj * HALF + 4 * n); } }
#pragma unroll
        for (int ai = 0; ai < 2; ++ai)
#pragma unroll
            for (int m = 0; m < 4; ++m) { const int row = row0 + ai * HALF + m * 16;
                float mean = 0.f, rstd = 1.f; if (st) row_stats(st, row, mean, rstd);
#pragma unroll
                for (int bj = 0; bj < 2; ++bj) { f32x4 v0 = acc[ai][bj][m][0], v1 = acc[ai][bj][m][1];
                    if (st) { v0 = (v0 - k1[bj][0] * mean) * rstd + k2[bj][0]; v1 = (v1 - k1[bj][1] * mean) * rstd + k2[bj][1]; }
                    u32x4 w; w.x = cvt_pk_bf16(v0[0], v0[1]); w.y = cvt_pk_bf16(v0[2], v0[3]); w.z = cvt_pk_bf16(v1[0], v1[1]); w.w = cvt_pk_bf16(v1[2], v1[3]);
                    *(u32x4*)(P + ((size_t)(u.pn * 2 + bj) * T + row) * 128 + wc * 32 + 8 * fq) = w; } }
    }
};
struct EpiBf16 {
    static constexpr bool PERM = true, AFTER_DRAIN = false;
    bf16_t* O; int ldc, nb0; long o_s1, o_s0; float scale; const float* st; const float* c1; const float* c2; float* rsum;
    __device__ __forceinline__ void operator()(const f32x4 (&acc)[2][2][4][2], const Unit& u, int wr, int wc, int fr, int fq) const {
        const int row0 = u.pm * BM + wr * 64 + fr, col0 = u.pn * BM + wc * 32 + 8 * fq;
        bf16_t* base = O + (size_t)(u.bz / nb0) * o_s1 + (size_t)(u.bz % nb0) * o_s0;
        f32x4 k1[2][2], k2[2][2];
        if (st) {
#pragma unroll
            for (int bj = 0; bj < 2; ++bj)
#pragma unroll
                for (int n = 0; n < 2; ++n) { k1[bj][n] = *(const f32x4*)(c1 + col0 + bj * HALF + 4 * n); k2[bj][n] = *(const f32x4*)(c2 + col0 + bj * HALF + 4 * n); } }
#pragma unroll
        for (int ai = 0; ai < 2; ++ai)
#pragma unroll
            for (int m = 0; m < 4; ++m) { const int row = row0 + ai * HALF + m * 16; bf16_t* rowp = base + (size_t)row * ldc + col0;
                float mean = 0.f, rstd = 1.f; if (st) row_stats(st, row, mean, rstd);
                float rs = 0.f;
#pragma unroll
                for (int bj = 0; bj < 2; ++bj) { f32x4 v0 = acc[ai][bj][m][0], v1 = acc[ai][bj][m][1];
                    if (st) { v0 = (v0 - k1[bj][0] * mean) * rstd + k2[bj][0]; v1 = (v1 - k1[bj][1] * mean) * rstd + k2[bj][1]; }
                    v0 = v0 * scale; v1 = v1 * scale;
                    u32x4 w; w.x = cvt_pk_bf16(v0[0], v0[1]); w.y = cvt_pk_bf16(v0[2], v0[3]); w.z = cvt_pk_bf16(v1[0], v1[1]); w.w = cvt_pk_bf16(v1[2], v1[3]);
                    *(u32x4*)(rowp + bj * HALF) = w;
                    if (rsum) rs += ((bf_lo(w.x) + bf_hi(w.x)) + (bf_lo(w.y) + bf_hi(w.y))) + ((bf_lo(w.z) + bf_hi(w.z)) + (bf_lo(w.w) + bf_hi(w.w))); }
                if (rsum) { rs += __shfl_xor(rs, 16); rs += __shfl_xor(rs, 32); if (fq == 0) unsafeAtomicAdd(rsum + u.bz * 256 + row, rs); } }
    }
};
struct EpiF32 {
    static constexpr bool PERM = false, AFTER_DRAIN = false;
    float* out; int ldc; long o_bs; float scale;
    __device__ __forceinline__ void operator()(const f32x4 (&acc)[2][2][4][2], const Unit& u, int wr, int wc, int fr, int fq) const {
        const int row0 = u.pm * BM + wr * 64 + fr, col0 = u.pn * BM + wc * 32 + 4 * fq;
        float* ob = out + (size_t)u.bz * o_bs;
#pragma unroll
        for (int ai = 0; ai < 2; ++ai)
#pragma unroll
            for (int m = 0; m < 4; ++m) { const size_t off = (size_t)(row0 + ai * HALF + m * 16) * ldc + col0;
#pragma unroll
                for (int bj = 0; bj < 2; ++bj)
#pragma unroll
                    for (int n = 0; n < 2; ++n) *(f32x4*)(ob + off + bj * HALF + n * 16) = acc[ai][bj][m][n] * scale; }
    }
};
struct EpiRes {
    static constexpr bool PERM = true, AFTER_DRAIN = false;
    float* X; const float* raw; const float* pst; const float* pg; const float* pb; bf16_t* ZB; float* cst; float alpha; int brows;
    __device__ __forceinline__ void operator()(const f32x4 (&acc)[2][2][4][2], const Unit& u, int wr, int wc, int fr, int fq) const {
        const int row0 = u.bz * brows + u.pm * BM + wr * 64 + fr, col0 = u.pn * BM + wc * 32 + 8 * fq;
        f32x4 gv[2][2], bv[2][2];
        if (!raw) {
#pragma unroll
            for (int bj = 0; bj < 2; ++bj)
#pragma unroll
                for (int n = 0; n < 2; ++n) { gv[bj][n] = *(const f32x4*)(pg + col0 + bj * HALF + 4 * n); bv[bj][n] = *(const f32x4*)(pb + col0 + bj * HALF + 4 * n); } }
#pragma unroll
        for (int ai = 0; ai < 2; ++ai)
#pragma unroll
            for (int m = 0; m < 4; ++m) { const int row = row0 + ai * HALF + m * 16; const size_t off = (size_t)row * DM + col0;
                float mean = 0.f, rstd = 1.f; if (!raw) row_stats(pst, row, mean, rstd);
                float s1 = 0.f, s2 = 0.f;
#pragma unroll
                for (int bj = 0; bj < 2; ++bj) { f32x4 r0, r1;
                    if (raw) { r0 = *(const f32x4*)(raw + off + bj * HALF); r1 = *(const f32x4*)(raw + off + bj * HALF + 4); }
                    else { const u32x4 zw = *(const u32x4*)(ZB + off + bj * HALF);
                        r0 = (f32x4){bf_lo(zw.x), bf_hi(zw.x), bf_lo(zw.y), bf_hi(zw.y)}; r1 = (f32x4){bf_lo(zw.z), bf_hi(zw.z), bf_lo(zw.w), bf_hi(zw.w)};
                        r0 = (r0 - mean) * rstd * gv[bj][0] + bv[bj][0]; r1 = (r1 - mean) * rstd * gv[bj][1] + bv[bj][1]; }
                    const f32x4 z0 = acc[ai][bj][m][0] + r0 * alpha, z1 = acc[ai][bj][m][1] + r1 * alpha;
                    if (X) { *(f32x4*)(X + off + bj * HALF) = z0; *(f32x4*)(X + off + bj * HALF + 4) = z1; }
                    u32x4 w; w.x = cvt_pk_bf16(z0[0], z0[1]); w.y = cvt_pk_bf16(z0[2], z0[3]); w.z = cvt_pk_bf16(z1[0], z1[1]); w.w = cvt_pk_bf16(z1[2], z1[3]);
                    *(u32x4*)(ZB + off + bj * HALF) = w;
                    s1 += ((z0[0] + z0[1]) + (z0[2] + z0[3])) + ((z1[0] + z1[1]) + (z1[2] + z1[3]));
                    s2 += ((z0[0] * z0[0] + z0[1] * z0[1]) + (z0[2] * z0[2] + z0[3] * z0[3])) + ((z1[0] * z1[0] + z1[1] * z1[1]) + (z1[2] * z1[2] + z1[3] * z1[3])); }
                s1 += __shfl_xor(s1, 16); s1 += __shfl_xor(s1, 32); s2 += __shfl_xor(s2, 16); s2 += __shfl_xor(s2, 32);
                if (fq == 0) { unsafeAtomicAdd(cst + 2 * row, s1); unsafeAtomicAdd(cst + 2 * row + 1, s2); } }
    }
};
struct EpiSwiglu {
    static constexpr bool PERM = true, AFTER_DRAIN = false;
    bf16_t* H; const float* st; const float* c1; const float* c2;
    __device__ __forceinline__ void operator()(const f32x4 (&acc)[2][2][4][2], const Unit& u, int wr, int wc, int fr, int fq) const {
        const int row0 = u.pm * BM + wr * 64 + fr, col0 = u.pn * HALF + wc * 32 + 8 * fq, ccol0 = u.pn * BM + wc * 32 + 8 * fq;
        f32x4 k1[2][2], k2[2][2];
#pragma unroll
        for (int bj = 0; bj < 2; ++bj)
#pragma unroll
            for (int n = 0; n < 2; ++n) { k1[bj][n] = *(const f32x4*)(c1 + ccol0 + bj * HALF + 4 * n); k2[bj][n] = *(const f32x4*)(c2 + ccol0 + bj * HALF + 4 * n); }
#pragma unroll
        for (int ai = 0; ai < 2; ++ai)
#pragma unroll
            for (int m = 0; m < 4; ++m) { const int row = row0 + ai * HALF + m * 16; bf16_t* rowp = H + (size_t)row * DFF + col0;
                float mean, rstd; row_stats(st, row, mean, rstd);
                float h[8];
#pragma unroll
                for (int n = 0; n < 2; ++n) { const f32x4 gq = (acc[ai][0][m][n] - k1[0][n] * mean) * rstd + k2[0][n], uq = (acc[ai][1][m][n] - k1[1][n] * mean) * rstd + k2[1][n];
#pragma unroll
                    for (int j = 0; j < 4; ++j) h[n * 4 + j] = gq[j] * __builtin_amdgcn_rcpf(1.f + __expf(-gq[j])) * uq[j]; }
                u32x4 w; w.x = cvt_pk_bf16(h[0], h[1]); w.y = cvt_pk_bf16(h[2], h[3]); w.z = cvt_pk_bf16(h[4], h[5]); w.w = cvt_pk_bf16(h[6], h[7]);
                *(u32x4*)rowp = w; }
    }
};

struct EpiSoftmax {
    static constexpr bool PERM = true, AFTER_DRAIN = true;
    bf16_t* PALL; const float* st; const float* c1; const float* c2; float scale;
    __device__ __forceinline__ void fused(f32x4 (&acc)[2][2][4][2], const Unit& u, int wr, int wc, int fr, int fq, LAS unsigned char* lds) const {
        const int b = u.bz >> 2, h = u.bz & 3, rl0 = wr * 64 + fr, cc0 = wc * 32 + 8 * fq;
        LAS float* PMX = (LAS float*)lds; LAS float* PSM = PMX + 1024;
        f32x4 k1[2][2], k2[2][2];
#pragma unroll
        for (int bj = 0; bj < 2; ++bj)
#pragma unroll
            for (int n = 0; n < 2; ++n) { k1[bj][n] = *(const f32x4*)(c1 + u.bz * 256 + cc0 + bj * HALF + 4 * n); k2[bj][n] = *(const f32x4*)(c2 + u.bz * 256 + cc0 + bj * HALF + 4 * n); }
#pragma unroll
        for (int ai = 0; ai < 2; ++ai)
#pragma unroll
            for (int m = 0; m < 4; ++m) { const int rl = rl0 + ai * HALF + m * 16, row = b * SEQ + u.pm * BM + rl;
                float mean, rstd; row_stats(st, row, mean, rstd);
                float mx = -__builtin_inff();
#pragma unroll
                for (int bj = 0; bj < 2; ++bj)
#pragma unroll
                    for (int n = 0; n < 2; ++n) { const f32x4 v = ((acc[ai][bj][m][n] - k1[bj][n] * mean) * rstd + k2[bj][n]) * scale; acc[ai][bj][m][n] = v;
                        mx = fmaxf(mx, fmaxf(fmaxf(v[0], v[1]), fmaxf(v[2], v[3]))); }
                mx = fmaxf(mx, __shfl_xor(mx, 16)); mx = fmaxf(mx, __shfl_xor(mx, 32));
                if (fq == 0) PMX[rl * 4 + wc] = mx; }
        asm volatile("s_waitcnt lgkmcnt(0)" ::: "memory"); __builtin_amdgcn_s_barrier(); asm volatile("" ::: "memory");
#pragma unroll
        for (int ai = 0; ai < 2; ++ai)
#pragma unroll
            for (int m = 0; m < 4; ++m) { const int rl = rl0 + ai * HALF + m * 16;
                const f32x4 q = *(const LAS f32x4*)(PMX + rl * 4); const float mx = fmaxf(fmaxf(q[0], q[1]), fmaxf(q[2], q[3]));
                float sm = 0.f;
#pragma unroll
                for (int bj = 0; bj < 2; ++bj)
#pragma unroll
                    for (int n = 0; n < 2; ++n) { f32x4 e = acc[ai][bj][m][n] - mx; e[0] = __expf(e[0]); e[1] = __expf(e[1]); e[2] = __expf(e[2]); e[3] = __expf(e[3]); acc[ai][bj][m][n] = e;
                        sm += (e[0] + e[1]) + (e[2] + e[3]); }
                sm += __shfl_xor(sm, 16); sm += __shfl_xor(sm, 32);
                if (fq == 0) PSM[rl * 4 + wc] = sm; }
        asm volatile("s_waitcnt lgkmcnt(0)" ::: "memory"); __builtin_amdgcn_s_barrier(); asm volatile("" ::: "memory");
#pragma unroll
        for (int ai = 0; ai < 2; ++ai)
#pragma unroll
            for (int m = 0; m < 4; ++m) { const int rl = rl0 + ai * HALF + m * 16, row = b * SEQ + u.pm * BM + rl;
                const f32x4 q = *(const LAS f32x4*)(PSM + rl * 4); const float inv = __builtin_amdgcn_rcpf((q[0] + q[1]) + (q[2] + q[3]));
                bf16_t* rowp = PALL + (size_t)row * 1024 + h * 256 + cc0;
#pragma unroll
                for (int bj = 0; bj < 2; ++bj) { const f32x4 v0 = acc[ai][bj][m][0] * inv, v1 = acc[ai][bj][m][1] * inv;
                    u32x4 w; w.x = cvt_pk_bf16(v0[0], v0[1]); w.y = cvt_pk_bf16(v0[2], v0[3]); w.z = cvt_pk_bf16(v1[0], v1[1]); w.w = cvt_pk_bf16(v1[2], v1[3]);
                    *(u32x4*)(rowp + bj * HALF) = w; } }
    }
};

template <class Epi, bool ALIGN_EPI>
__device__ __forceinline__ void gemm_phase(LAS unsigned char* lds, const Gemm g, const Order& S, const Epi& E) {
    const int tid = ltid(), wid = __builtin_amdgcn_readfirstlane(tid >> 6), lane = tid & 63, wr = wid >> 2, wc = wid & 3, fr = lane & 15, fq = lane >> 4;
    const int K = g.K, nt = K / BK;
    unsigned voffA[2], voffB[2];
#pragma unroll
    for (int i = 0; i < 2; ++i) { int R, C; stage_rc(tid * 16 + i * 8192, R, C); const int Rb = Epi::PERM ? ((R & ~31) + perm32(R & 31)) : R;
        voffA[i] = (unsigned)(R * g.lda + C) * 2u; voffB[i] = (unsigned)(Rb * g.ldb + C) * 2u; }
    const size_t kstep = (size_t)(BK * 2);
    const size_t hstepA = (size_t)HALF * g.lda * 2, hstepB = (size_t)HALF * g.ldb * 2;
    const unsigned ldsw = (unsigned)wid * 1024u;
    const int aoff = lds_byte(wr * 64 + fr, fq * 8), boff = lds_byte(wc * 32 + fr, fq * 8);
#define PG8_SA(b, h) (((b) * 2 + (h)) * HTB)
#define PG8_SB(b, h) ((4 + (b) * 2 + (h)) * HTB)
#define PG8_STAGE(bufoff, gbase, voff) do { _Pragma("unroll") for (int _i = 0; _i < 2; ++_i) \
        __builtin_amdgcn_global_load_lds((const unsigned*)((const char*)(gbase) + (voff)[_i]), (LAS unsigned*)(lds + (bufoff) + ldsw + _i * 8192), 16, 0, 0); } while (0)
#define PG8_LDA(dst, b, h) do { _Pragma("unroll") for (int m = 0; m < 4; ++m) _Pragma("unroll") for (int k = 0; k < 2; ++k) dst[m][k] = *(const LAS bf16x8*)(lds + PG8_SA(b, h) + aoff + m * 2048 + k * 1024); } while (0)
#define PG8_LDB(dst, b, h) do { _Pragma("unroll") for (int n = 0; n < 2; ++n) _Pragma("unroll") for (int k = 0; k < 2; ++k) dst[n][k] = *(const LAS bf16x8*)(lds + PG8_SB(b, h) + boff + n * 2048 + k * 1024); } while (0)
#define PG8_MMA(ai, bj, At, Bt) do { __builtin_amdgcn_s_setprio(1); _Pragma("unroll") for (int m = 0; m < 4; ++m) _Pragma("unroll") for (int n = 0; n < 2; ++n) _Pragma("unroll") for (int k = 0; k < 2; ++k) \
        acc[ai][bj][m][n] = __builtin_amdgcn_mfma_f32_16x16x32_bf16(Bt[n][k], At[m][k], acc[ai][bj][m][n], 0, 0, 0); __builtin_amdgcn_s_setprio(0); } while (0)
#define PG8_WAIT_V(n) asm volatile("s_waitcnt vmcnt(" #n ")" ::: "memory")
#define PG8_WAIT_L(n) asm volatile("s_waitcnt lgkmcnt(" #n ")" ::: "memory")
#define PG8_BAR __builtin_amdgcn_s_barrier()
#define PG8_SCHED __builtin_amdgcn_sched_barrier(0)
    Unit cur, nxt; int ui = 0;
    if (!S.next(0, cur)) return;
    f32x4 acc[2][2][4][2];
#pragma unroll
    for (int a = 0; a < 2; ++a)
#pragma unroll
        for (int b = 0; b < 2; ++b)
#pragma unroll
            for (int m = 0; m < 4; ++m)
#pragma unroll
                for (int n = 0; n < 2; ++n) acc[a][b][m][n] = (f32x4){0.f, 0.f, 0.f, 0.f};
    bf16x8 At[4][2], B0[2][2], B1[2][2];
    const char* cA = unit_a(g, cur); const char* cB = unit_b(g, cur);
    PG8_STAGE(PG8_SB(0, 0), cB, voffB); PG8_STAGE(PG8_SB(0, 1), cB + hstepB, voffB); PG8_STAGE(PG8_SA(0, 0), cA, voffA); PG8_STAGE(PG8_SA(0, 1), cA + hstepA, voffA);
    if (wr == 1) PG8_BAR;
    PG8_WAIT_V(2); PG8_BAR;
    PG8_STAGE(PG8_SB(1, 0), cB + kstep, voffB); PG8_STAGE(PG8_SA(1, 0), cA + kstep, voffA); PG8_STAGE(PG8_SB(1, 1), cB + hstepB + kstep, voffB);
    PG8_WAIT_V(6); PG8_BAR;
    for (;;) {
        const bool has_next = S.next(ui + 1, nxt);
        const char* nA = has_next ? unit_a(g, nxt) : cA; const char* nB = has_next ? unit_b(g, nxt) : cB;
        for (int t = 0; t < nt; t += 2) {
            const bool last = (t == nt - 2);
            const char* a1 = cA + (size_t)(t + 1) * kstep;
            const char* a2 = last ? nA : cA + (size_t)(t + 2) * kstep; const char* b2 = last ? nB : cB + (size_t)(t + 2) * kstep;
            const char* a3 = a2 + kstep; const char* b3 = b2 + kstep;
            PG8_LDB(B0, 0, 0); PG8_LDB(B1, 0, 1); PG8_SCHED; PG8_LDA(At, 0, 0); PG8_STAGE(PG8_SA(1, 1), a1 + hstepA, voffA);
            PG8_WAIT_V(8); PG8_WAIT_L(0); PG8_BAR; PG8_MMA(0, 0, At, B0); PG8_MMA(0, 1, At, B1); PG8_BAR; PG8_SCHED;
            PG8_LDA(At, 0, 1); PG8_STAGE(PG8_SB(0, 0), b2, voffB); PG8_STAGE(PG8_SB(0, 1), b2 + hstepB, voffB); PG8_STAGE(PG8_SA(0, 0), a2, voffA);
            PG8_WAIT_V(8); PG8_WAIT_L(0); PG8_BAR; PG8_MMA(1, 0, At, B0); PG8_MMA(1, 1, At, B1); PG8_BAR; PG8_SCHED;
            PG8_LDB(B0, 1, 0); PG8_LDB(B1, 1, 1); PG8_SCHED; PG8_LDA(At, 1, 0); PG8_STAGE(PG8_SA(0, 1), a2 + hstepA, voffA);
            PG8_WAIT_V(8); PG8_WAIT_L(0); PG8_BAR; PG8_MMA(0, 0, At, B0); PG8_MMA(0, 1, At, B1); PG8_BAR; PG8_SCHED;
            PG8_LDA(At, 1, 1); PG8_STAGE(PG8_SB(1, 0), b3, voffB); PG8_STAGE(PG8_SB(1, 1), b3 + hstepB, voffB); PG8_STAGE(PG8_SA(1, 0), a3, voffA);
            PG8_WAIT_V(8); PG8_WAIT_L(0); PG8_BAR; PG8_MMA(1, 0, At, B0); PG8_MMA(1, 1, At, B1); PG8_BAR; PG8_SCHED;
        }
        if constexpr (ALIGN_EPI) { if (wr == 0) PG8_BAR; }
        if constexpr (!Epi::AFTER_DRAIN) E(acc, cur, wr, wc, fr, fq);
        if (!has_next) break;
#pragma unroll
        for (int a = 0; a < 2; ++a)
#pragma unroll
            for (int b = 0; b < 2; ++b)
#pragma unroll
                for (int m = 0; m < 4; ++m)
#pragma unroll
                    for (int n = 0; n < 2; ++n) acc[a][b][m][n] = (f32x4){0.f, 0.f, 0.f, 0.f};
        cur = nxt; cA = nA; cB = nB; ++ui;
        if constexpr (ALIGN_EPI) { if (wr == 1) PG8_BAR; }
    }
    PG8_WAIT_V(0);
    if constexpr (!ALIGN_EPI) { if (wr == 0) PG8_BAR; }
    PG8_BAR;
    if constexpr (Epi::AFTER_DRAIN) E.fused(acc, cur, wr, wc, fr, fq, lds);
#undef PG8_SA
#undef PG8_SB
#undef PG8_STAGE
#undef PG8_LDA
#undef PG8_LDB
#undef PG8_MMA
#undef PG8_WAIT_V
#undef PG8_WAIT_L
#undef PG8_BAR
#undef PG8_SCHED
}
}

namespace att {
using bf16 = __hip_bfloat16;
typedef short s16x4 __attribute__((ext_vector_type(4)));
constexpr int D = 128;
constexpr float THR = 8.f;
constexpr float SCALE = 0.08838834764831845f;
constexpr int NW = 8, QBLK = 32, KVBLK = 64, QB = NW * QBLK;
constexpr int SHM_V = KVBLK * D * 2, SHM_K = KVBLK * D * 2;
constexpr int ATT_LDS = 2 * SHM_V + 2 * SHM_K + NW * 64 * 4;
constexpr int BT_OFF = ATT_LDS;

#define KSWZ(row, colB) ((row) * 256 + ((colB) ^ (((row) & 7) << 4)))
#define SBAR() __builtin_amdgcn_sched_barrier(0)
__device__ __forceinline__ int v_st(int k, int c) { const int kk = (k & ~0xC) | ((k & 4) << 1) | ((k & 8) >> 1); return ((kk >> 3) * 4 + (c >> 5)) * 512 + ((kk & 7) * 32 + (c & 31)) * 2; }
__device__ __forceinline__ int v_rd_base(int lane) { return ((lane & 3) << 3) | (((lane >> 2) & 3) << 6) | (((lane >> 4) & 1) << 5) | (((lane >> 5) & 1) << 8); }
constexpr int v_rd_off(int d0, int ks, int half) { return d0 * 512 + ks * 4096 + half * 2048; }
__device__ __forceinline__ int crow(int r, int hi) { return (r & 3) + 8 * (r >> 2) + 4 * hi; }
__device__ __forceinline__ unsigned cvtpk(float lo, float hi) { unsigned r; asm volatile("v_cvt_pk_bf16_f32 %0, %1, %2" : "=v"(r) : "v"(lo), "v"(hi)); return r; }
__device__ __forceinline__ bf16x8 load8(const bf16* p) { return *reinterpret_cast<const bf16x8*>(p); }
__device__ __forceinline__ void bias_mask_tile(f32x16& p0, f32x16& p1, int dq, const float* bt) {
    const float NEG = -__builtin_inff();
#pragma unroll
    for (int r = 0; r < 16; ++r) {
        const int c = (r & 3) + 8 * (r >> 2);
        const int d0 = dq - c, d1 = dq - c - 32;
        const unsigned i0 = (unsigned)d0 < 255u ? (unsigned)d0 : 255u, i1 = (unsigned)d1 < 255u ? (unsigned)d1 : 255u;
        const float b0 = bt[i0], b1 = bt[i1];
        p0[r] = d0 >= 0 ? p0[r] + b0 : NEG;
        p1[r] = d1 >= 0 ? p1[r] + b1 : NEG;
    }
}
__device__ __forceinline__ void partialSM(f32x16& p0, f32x16& p1, float& m_reg, float& mn, float& alpha) {
    float pmax = p0[0]; for (int r = 1; r < 16; ++r) pmax = fmaxf(pmax, p0[r]); for (int r = 0; r < 16; ++r) pmax = fmaxf(pmax, p1[r]);
    { auto rr = __builtin_amdgcn_permlane32_swap(__float_as_uint(pmax), __float_as_uint(pmax), false, false);
      pmax = fmaxf(__uint_as_float(rr[0]), __uint_as_float(rr[1])); }
    constexpr float C2 = 1.4426950408889634f * SCALE;
    if (__builtin_expect(__all((pmax - m_reg) * SCALE <= THR), 1)) { mn = m_reg; alpha = 1.f; }
    else { mn = fmaxf(m_reg, pmax); alpha = __builtin_amdgcn_exp2f((m_reg - mn) * C2); m_reg = mn; }
    const float mnL = -mn * C2;
    for (int r = 0; r < 16; ++r) p0[r] = fmaf(p0[r], C2, mnL); for (int r = 0; r < 16; ++r) p1[r] = fmaf(p1[r], C2, mnL);
    for (int r = 0; r < 16; ++r) p0[r] = __builtin_amdgcn_exp2f(p0[r]);
}
__device__ __forceinline__ void finishSM(f32x16& p0, f32x16& p1, float alpha, float& l_reg, bf16x8& pa0, bf16x8& pa1, bf16x8& pa2, bf16x8& pa3) {
    for (int r = 0; r < 16; ++r) p1[r] = __builtin_amdgcn_exp2f(p1[r]);
    float ps = 0; for (int r = 0; r < 16; ++r) ps += p0[r]; for (int r = 0; r < 16; ++r) ps += p1[r];
    { auto rr = __builtin_amdgcn_permlane32_swap(__float_as_uint(ps), __float_as_uint(ps), false, false);
      ps = __uint_as_float(rr[0]) + __uint_as_float(rr[1]); }
    l_reg = l_reg * alpha + ps;
#define PK4(P, B_, OUT) do { unsigned a0 = cvtpk(P[B_+0], P[B_+1]), a1 = cvtpk(P[B_+2], P[B_+3]);                          \
        unsigned b0 = cvtpk(P[B_+4], P[B_+5]), b1 = cvtpk(P[B_+6], P[B_+7]);                                             \
        auto r0 = __builtin_amdgcn_permlane32_swap(a0, b0, false, false); auto r1 = __builtin_amdgcn_permlane32_swap(a1, b1, false, false); \
        u32x4 w = {r0[0], r1[0], r0[1], r1[1]}; OUT = *reinterpret_cast<bf16x8*>(&w); } while (0)
    PK4(p0, 0, pa0); PK4(p0, 8, pa1); PK4(p1, 0, pa2); PK4(p1, 8, pa3);
#undef PK4
}
template <int KB>
__device__ __forceinline__ void qkt(f32x16& p0, f32x16& p1, const char* K_lds, int r32, int hi, const bf16x8* qr) {
    p0 = f32x16{}; p1 = f32x16{};
    const char* kb[4];
#pragma unroll
    for (int dd = 0; dd < 4; ++dd) kb[dd] = K_lds + KB * SHM_K + KSWZ(r32, (dd * 16 + hi * 8) * 2);
#pragma unroll
    for (int d0 = 0; d0 < 8; ++d0) { const char* a = kb[d0 & 3] + (d0 >> 2) * 128;
        bf16x8 b0 = *reinterpret_cast<const bf16x8*>(a);
        bf16x8 b1 = *reinterpret_cast<const bf16x8*>(a + 32 * 256);
        p0 = __builtin_amdgcn_mfma_f32_32x32x16_bf16(b0, qr[d0], p0, 0, 0, 0);
        p1 = __builtin_amdgcn_mfma_f32_32x32x16_bf16(b1, qr[d0], p1, 0, 0, 0); }
}
template <int VB>
__device__ __forceinline__ void pv_tile(f32x16* o, int vb0, bf16x8 pa0, bf16x8 pa1, bf16x8 pa2, bf16x8 pa3) {
#define TRRD(dst, off) asm volatile("ds_read_b64_tr_b16 %0, %1 offset:%2" : "=&v"(dst) : "v"(vb0), "i"(off) : "memory")
#define PV_D0(d0) do { s16x4 l0, l1, l2, l3, h0, h1, h2, h3; constexpr int b_ = VB * SHM_V + v_rd_off(d0, 0, 0); \
        TRRD(l0, b_); TRRD(h0, b_ + 2048); TRRD(l1, b_ + 4096); TRRD(h1, b_ + 6144); TRRD(l2, b_ + 8192); TRRD(h2, b_ + 10240); TRRD(l3, b_ + 12288); TRRD(h3, b_ + 14336); \
        asm volatile("s_waitcnt lgkmcnt(0)" ::: "memory"); SBAR();   \
        o[d0] = __builtin_amdgcn_mfma_f32_32x32x16_bf16(pa0, (bf16x8){l0[0], l0[1], l0[2], l0[3], h0[0], h0[1], h0[2], h0[3]}, o[d0], 0, 0, 0);   \
        o[d0] = __builtin_amdgcn_mfma_f32_32x32x16_bf16(pa1, (bf16x8){l1[0], l1[1], l1[2], l1[3], h1[0], h1[1], h1[2], h1[3]}, o[d0], 0, 0, 0);   \
        o[d0] = __builtin_amdgcn_mfma_f32_32x32x16_bf16(pa2, (bf16x8){l2[0], l2[1], l2[2], l2[3], h2[0], h2[1], h2[2], h2[3]}, o[d0], 0, 0, 0);   \
        o[d0] = __builtin_amdgcn_mfma_f32_32x32x16_bf16(pa3, (bf16x8){l3[0], l3[1], l3[2], l3[3], h3[0], h3[1], h3[2], h3[3]}, o[d0], 0, 0, 0); } while (0)
    PV_D0(0); PV_D0(1); PV_D0(2); PV_D0(3);
#undef PV_D0
#undef TRRD
}
struct BlockRef { const bf16* Q; const bf16* K; const bf16* V; float* O; int P0; int hm; };
struct Seam { bf16x8 qr[8]; bf16x8 st_v0, st_v1, st_k0, st_k1; };
#define ROW(p, k0, rr) ((p) + (size_t)((k0) + (rr)) * D + sc)
#define VMW() asm volatile("s_waitcnt vmcnt(0)" ::: "memory")
#define VMWN(n) asm volatile("s_waitcnt vmcnt(%0)" :: "i"(n) : "memory")
#define SLOAD_H(Kp, Vp, k0) do { S.st_v0 = load8(ROW(Vp, k0, sr)); S.st_v1 = load8(ROW(Vp, k0, 32 + sr));              \
                         S.st_k0 = load8(ROW(Kp, k0, sr)); S.st_k1 = load8(ROW(Kp, k0, 32 + sr)); } while (0)
#define SWRITE_HK(bf) do { *(bf16x8*)(K_lds + (bf) * SHM_K + kws) = S.st_k0; *(bf16x8*)(K_lds + (bf) * SHM_K + kws + 32 * 256) = S.st_k1; } while (0)
#define SWRITE_HV(bf) do { *(bf16x8*)(V_lds + (bf) * SHM_V + vst0) = S.st_v0; *(bf16x8*)(V_lds + (bf) * SHM_V + vst1) = S.st_v1; } while (0)
#define SWRITE_H(bf) do { SWRITE_HV(bf); SWRITE_HK(bf); } while (0)
__device__ __forceinline__ void attn_prime(const BlockRef& cur, char* lds, Seam& S) {
    const int tid = ltid(), wid = __builtin_amdgcn_readfirstlane(tid >> 6), lane = tid & 63, r32 = lane & 31, hi = lane >> 5;
    const int sr = tid >> 4, sc = (tid & 15) * 8, kws = KSWZ(sr, sc * 2); char* K_lds = lds + 2 * SHM_V;
    const int kb0 = 0;
    for (int d0 = 0; d0 < 8; ++d0) S.qr[d0] = load8(cur.Q + (size_t)(wid * QBLK + r32) * D + d0 * 16 + hi * 8);
    SLOAD_H(cur.K, cur.V, kb0); VMW(); SWRITE_HK(0);
    __syncthreads();
}
__device__ __forceinline__ void attn_block(const BlockRef& cur, const BlockRef& nxt, char* lds, Seam& S) {
    const int tid = ltid(), wid = __builtin_amdgcn_readfirstlane(tid >> 6), lane = tid & 63, r32 = lane & 31, hi = lane >> 5;
    const int j_lo = 0;
    const int j_hi = (cur.P0 + QB - 1) / KVBLK + 1;
    const int NT = j_hi - j_lo;
    const int kbn = 0;
    const int qlo = cur.P0 + wid * QBLK, qm = qlo + r32 - 4 * hi;
    char* V_lds = lds; char* K_lds = lds + 2 * SHM_V;
    float* ws = (float*)(lds + 2 * SHM_V + 2 * SHM_K) + wid * 64; float* li_l = ws, * al_l = ws + 32;
    const float* bt = (const float*)(lds + BT_OFF) + cur.hm * 256;
    float m_reg = -1e30f, l_reg = 0; f32x16 o[4] = {};
    const int sr = tid >> 4, sc = (tid & 15) * 8, vst0 = v_st(sr, sc), vst1 = v_st(32 + sr, sc), kws = KSWZ(sr, sc * 2);
    const int vb0 = (int)(uintptr_t)V_lds + v_rd_base(lane);
    const bf16* Kh = cur.K; const bf16* Vh = cur.V;
#define RESC(a) do { if (__any((a) < 1.f)) { if (hi == 0) al_l[r32] = (a); asm volatile("s_waitcnt lgkmcnt(0)" ::: "memory");              \
                     for (int d_ = 0; d_ < 4; ++d_) for (int r = 0; r < 16; ++r) o[d_][r] *= al_l[crow(r, hi)]; } } while (0)
#define KBASE(t) ((j_lo + (t)) * KVBLK)
#define MASKT(P0_, P1_, t) do { const int kb_ = KBASE(t); if (kb_ + KVBLK - 1 > qlo - 128) bias_mask_tile(P0_, P1_, qm - kb_, bt); } while (0)
    constexpr int NQL = 8;
#define SEAM_K0() do { VMWN(NQL); SWRITE_HK(0); SBAR(); } while (0)
    f32x16 pA0, pA1, pB0, pB1; float mnA, mnB, alA, alB; bf16x8 pa0, pa1, pa2, pa3;
    SWRITE_HV(0); SBAR();
    if (NT > 1) { SLOAD_H(Kh, Vh, KBASE(1)); }
    SBAR(); qkt<0>(pA0, pA1, K_lds, r32, hi, S.qr);
    MASKT(pA0, pA1, 0); partialSM(pA0, pA1, m_reg, mnA, alA);
    if (NT > 1) { VMW(); SWRITE_H(1); }
    __syncthreads();
#define HALF_STEP(PX0, PX1, mnX, alX, PY0, PY1, alY, t, KB, VB, SB) do {                                                      \
        SBAR(); qkt<KB>(PX0, PX1, K_lds, r32, hi, S.qr);                                             \
        finishSM(PY0, PY1, alY, l_reg, pa0, pa1, pa2, pa3); SBAR();                                                           \
        if ((t) + 1 < NT) { SLOAD_H(Kh, Vh, KBASE((t) + 1)); SBAR(); }                                               \
        pv_tile<VB>(o, vb0, pa0, pa1, pa2, pa3); MASKT(PX0, PX1, (t)); partialSM(PX0, PX1, m_reg, mnX, alX);                                        \
        __syncthreads();                                                                                                      \
        if ((t) + 1 < NT) { VMW(); SWRITE_H(SB); }                                                                          \
        RESC(alX); __syncthreads(); } while (0)
    for (int t = 1; t + 1 < NT; t += 2) {
        HALF_STEP(pB0, pB1, mnB, alB, pA0, pA1, alA, t, 1, 0, 0);
        HALF_STEP(pA0, pA1, mnA, alA, pB0, pB1, alB, t + 1, 0, 1, 1);
    }
    const bool even = (NT & 1) == 0;
    if (even) { SBAR(); qkt<1>(pB0, pB1, K_lds, r32, hi, S.qr); SBAR(); }
    SLOAD_H(nxt.K, nxt.V, kbn); SBAR();
#pragma unroll
    for (int d0 = 0; d0 < 8; ++d0) S.qr[d0] = load8(nxt.Q + (size_t)(wid * QBLK + r32) * D + d0 * 16 + hi * 8);
    SBAR();
    finishSM(pA0, pA1, alA, l_reg, pa0, pa1, pa2, pa3); SBAR();
    pv_tile<0>(o, vb0, pa0, pa1, pa2, pa3);
    if (even) { MASKT(pB0, pB1, NT - 1); partialSM(pB0, pB1, m_reg, mnB, alB); __syncthreads(); RESC(alB);
        finishSM(pB0, pB1, alB, l_reg, pa0, pa1, pa2, pa3); SBAR(); pv_tile<1>(o, vb0, pa0, pa1, pa2, pa3); }
    SBAR(); SEAM_K0();
    if (hi == 0) li_l[r32] = l_reg; asm volatile("s_waitcnt lgkmcnt(0)" ::: "memory");
    float rli[16];
#pragma unroll
    for (int r = 0; r < 16; ++r) rli[r] = __builtin_amdgcn_rcpf(li_l[crow(r, hi)]);
    float* Ow = cur.O + (size_t)(wid * QBLK) * D;
#pragma unroll
    for (int r = 0; r < 16; ++r) { const int orow = crow(r, hi);
#pragma unroll
        for (int d0 = 0; d0 < 4; ++d0) { const float v = o[d0][r] * rli[r]; Ow[(size_t)orow * D + d0 * 32 + r32] = v; } }
    __syncthreads();
#undef RESC
#undef KBASE
#undef MASKT
#undef SEAM_K0
#undef HALF_STEP
}
#undef ROW
#undef VMW
#undef VMWN
#undef SLOAD_H
#undef SWRITE_HK
#undef SWRITE_HV
#undef SWRITE_H
}

namespace att2 {
using att::bf16; using att::D; using att::SHM_K; using att::SHM_V;
constexpr int L_V = 0, L_K = 65536, L_P = 98304, L_AL = 131072, L_FL = 132096, L_LB = 132224, L_BT = 133120;
struct Blk { const bf16* Q; const bf16* K; const bf16* V0; const bf16* V1; float* O0; float* O1; int P0; int hm; };
__device__ __forceinline__ void qkt_rt(f32x16& p0, f32x16& p1, const char* Kb, int r32, int hi, const bf16x8* qr) {
    p0 = f32x16{}; p1 = f32x16{};
    const char* kb[4];
#pragma unroll
    for (int dd = 0; dd < 4; ++dd) kb[dd] = Kb + KSWZ(r32, (dd * 16 + hi * 8) * 2);
#pragma unroll
    for (int d0 = 0; d0 < 8; ++d0) { const char* a = kb[d0 & 3] + (d0 >> 2) * 128;
        bf16x8 b0 = *reinterpret_cast<const bf16x8*>(a);
        bf16x8 b1 = *reinterpret_cast<const bf16x8*>(a + 32 * 256);
        p0 = __builtin_amdgcn_mfma_f32_32x32x16_bf16(b0, qr[d0], p0, 0, 0, 0);
        p1 = __builtin_amdgcn_mfma_f32_32x32x16_bf16(b1, qr[d0], p1, 0, 0, 0); }
}
#define A2_LOADT(t) do { const size_t ro_ = (size_t)((t) * 64 + sr) * D + sc; \
        sk0 = att::load8(c.K + ro_); sk1 = att::load8(c.K + ro_ + 32 * D); sv00 = att::load8(c.V0 + ro_); sv01 = att::load8(c.V0 + ro_ + 32 * D); sv10 = att::load8(c.V1 + ro_); sv11 = att::load8(c.V1 + ro_ + 32 * D); } while (0)
#define A2_WRITET(buf) do { char* kd_ = lds + L_K + (buf) * SHM_K; char* vd_ = lds + L_V + (buf) * 2 * SHM_V; \
        *(bf16x8*)(kd_ + kws) = sk0; *(bf16x8*)(kd_ + kws + 32 * 256) = sk1; *(bf16x8*)(vd_ + vst0) = sv00; *(bf16x8*)(vd_ + vst1) = sv01; *(bf16x8*)(vd_ + SHM_V + vst0) = sv10; *(bf16x8*)(vd_ + SHM_V + vst1) = sv11; } while (0)
__device__ __forceinline__ void attn2_block(const Blk& c, char* lds) {
    const int tid = ltid(), wid = __builtin_amdgcn_readfirstlane(tid >> 6), lane = tid & 63, r32 = lane & 31, hi = lane >> 5;
    const int g = wid & 3;
    const int NT = (c.P0 + 127) / 64 + 1;
    const int sr = tid >> 4, sc = (tid & 15) * 8, kws = KSWZ(sr, sc * 2), vst0 = att::v_st(sr, sc), vst1 = att::v_st(32 + sr, sc);
    bf16x8 sk0, sk1, sv00, sv01, sv10, sv11;
    float* ALb = (float*)(lds + L_AL) + g * 64; unsigned* FLb = (unsigned*)(lds + L_FL) + g * 2; float* LBb = (float*)(lds + L_LB) + g * 32;
    char* Pb = lds + L_P + g * 8192;
    A2_LOADT(0);
    if (wid < 4) {
        bf16x8 qr[8];
#pragma unroll
        for (int d0 = 0; d0 < 8; ++d0) qr[d0] = att::load8(c.Q + (size_t)(g * 32 + r32) * D + d0 * 16 + hi * 8);
        asm volatile("s_waitcnt vmcnt(0)" ::: "memory"); A2_WRITET(0); __syncthreads();
        const int qlo = c.P0 + g * 32, qm = qlo + r32 - 4 * hi;
        const float* bt = (const float*)(lds + L_BT) + c.hm * 256;
        float m_reg = -1e30f, l_reg = 0.f;
        for (int s = 0; s <= NT; ++s) {
            const int par = s & 1;
            if (s + 1 < NT) A2_LOADT(s + 1);
            SBAR();
            if (s < NT) {
                f32x16 p0, p1; float mn, al; bf16x8 pa0, pa1, pa2, pa3;
                qkt_rt(p0, p1, lds + L_K + par * SHM_K, r32, hi, qr);
                const int kb_ = s * 64;
                if (kb_ + 63 > qlo - 128) att::bias_mask_tile(p0, p1, qm - kb_, bt);
                att::partialSM(p0, p1, m_reg, mn, al);
                att::finishSM(p0, p1, al, l_reg, pa0, pa1, pa2, pa3);
                char* pw = Pb + par * 4096 + lane * 16;
                *(bf16x8*)(pw) = pa0; *(bf16x8*)(pw + 1024) = pa1; *(bf16x8*)(pw + 2048) = pa2; *(bf16x8*)(pw + 3072) = pa3;
                if (hi == 0) ALb[par * 32 + r32] = al;
                const bool resc = __any(al < 1.f);
                if (lane == 0) FLb[par] = resc ? 1u : 0u;
            }
            __syncthreads();
            if (s + 1 < NT) { asm volatile("s_waitcnt vmcnt(0)" ::: "memory"); A2_WRITET((s + 1) & 1); }
            __syncthreads();
        }
        if (hi == 0) LBb[r32] = l_reg;
        __syncthreads();
        __syncthreads();
    } else {
        asm volatile("s_waitcnt vmcnt(0)" ::: "memory"); A2_WRITET(0); __syncthreads();
        f32x16 o[8];
#pragma unroll
        for (int d_ = 0; d_ < 8; ++d_) o[d_] = f32x16{};
        const int vbase = (int)(uintptr_t)(lds + L_V) + att::v_rd_base(lane);
        for (int s = 0; s <= NT; ++s) {
            if (s + 1 < NT) A2_LOADT(s + 1);
            SBAR();
            if (s >= 1) {
                const int par = (s - 1) & 1;
                const unsigned fl = (unsigned)__builtin_amdgcn_readfirstlane((int)FLb[par]);
                if (fl) {
#pragma unroll
                    for (int r = 0; r < 16; ++r) { const float a = ALb[par * 32 + att::crow(r, hi)];
#pragma unroll
                        for (int d_ = 0; d_ < 8; ++d_) o[d_][r] *= a; } }
                const char* pr = Pb + par * 4096 + lane * 16;
                const bf16x8 pa0 = *(const bf16x8*)(pr), pa1 = *(const bf16x8*)(pr + 1024), pa2 = *(const bf16x8*)(pr + 2048), pa3 = *(const bf16x8*)(pr + 3072);
                const int vb = vbase + par * 2 * SHM_V;
                att::pv_tile<0>(o, vb, pa0, pa1, pa2, pa3);
                att::pv_tile<0>(o + 4, vb + SHM_V, pa0, pa1, pa2, pa3);
            }
            __syncthreads();
            if (s + 1 < NT) { asm volatile("s_waitcnt vmcnt(0)" ::: "memory"); A2_WRITET((s + 1) & 1); }
            __syncthreads();
        }
        __syncthreads();
        float rli[16];
#pragma unroll
        for (int r = 0; r < 16; ++r) rli[r] = __builtin_amdgcn_rcpf(LBb[att::crow(r, hi)]);
#pragma unroll
        for (int hf = 0; hf < 2; ++hf) { float* Ow = (hf ? c.O1 : c.O0) + (size_t)(g * 32) * D;
#pragma unroll
            for (int r = 0; r < 16; ++r) { const int orow = att::crow(r, hi);
#pragma unroll
                for (int d0 = 0; d0 < 4; ++d0) Ow[(size_t)orow * D + d0 * 32 + r32] = o[hf * 4 + d0][r] * rli[r]; } }
        __syncthreads();
    }
}
#undef A2_LOADT
#undef A2_WRITET
}


#define XB_TMO      128
#define XB_XCNT(j)  (256  + 64 * (j))
#define XB_XSUB(j)  (1280 + 64 * (j))
#define XB_XGEN(j)  (2304 + 64 * (j))
#define XB_TOP      3328
#define XB_TOPGEN   3392
#define XCD_BAR_WORDS 3456
#define XB_SPIN_CAP (1u << 18)
__device__ __forceinline__ unsigned xb_ld(unsigned* p)              { return __hip_atomic_load(p, __ATOMIC_RELAXED, __HIP_MEMORY_SCOPE_AGENT); }
__device__ __forceinline__ unsigned xb_add(unsigned* p, unsigned v) { return __hip_atomic_fetch_add(p, v, __ATOMIC_RELAXED, __HIP_MEMORY_SCOPE_AGENT); }
__device__ __forceinline__ unsigned xb_xcc_id() { return (unsigned)__builtin_amdgcn_s_getreg((3 << 11) | 20) & 0xFu; }
#define XB_SPIN(cond, bar) do { unsigned _sp = 0; while (cond) { __builtin_amdgcn_s_sleep(1); \
    if ((++_sp & 255u) == 0u) { if (xb_ld(&(bar)[XB_TMO])) break; if (_sp > XB_SPIN_CAP) { atomicAdd(&(bar)[XB_TMO], 1u); break; } } } } while (0)
struct XcdBarrier { unsigned* bar; unsigned x; volatile LAS unsigned* st; };
__device__ __forceinline__ XcdBarrier xcd_barrier_post(unsigned* bar, volatile LAS unsigned* st) {
    XcdBarrier b; b.bar = bar; b.x = xb_xcc_id(); b.st = st;
    if (threadIdx.x == 0) (void)xb_add(&bar[XB_XCNT(b.x)], 1u);
    return b;
}
__device__ __forceinline__ void xcd_barrier_complete(unsigned* bar, unsigned x, unsigned& nloc, unsigned& nx) {
    const unsigned G = gridDim.x * gridDim.y * gridDim.z;
    unsigned sum, cnt, mine, sp = 0u;
    for (;;) {
        sum = 0u; cnt = 0u; mine = 0u;
#pragma unroll
        for (unsigned j = 0; j < 16; ++j) { const unsigned c = xb_ld(&bar[XB_XCNT(j)]); sum += c; cnt += (c > 0u) ? 1u : 0u; mine = (j == x) ? c : mine; }
        if (sum == G) break;
        __builtin_amdgcn_s_sleep(1);
        if ((++sp & 255u) == 0u) { if (xb_ld(&bar[XB_TMO])) break; if (sp > XB_SPIN_CAP) { atomicAdd(&bar[XB_TMO], 1u); break; } }
    }
    nloc = mine > 0u ? mine : 1u; nx = cnt > 0u ? cnt : 1u;
}
__device__ __forceinline__ void xcd_barrier(const XcdBarrier& b) {
    asm volatile("s_waitcnt vmcnt(0)" ::: "memory");
    __syncthreads();
    if (threadIdx.x == 0) {
        unsigned* bar = b.bar;
        __builtin_amdgcn_s_waitcnt(0);
        unsigned nloc = b.st[0], nx = b.st[1];
        if (nloc == 0u) { xcd_barrier_complete(bar, b.x, nloc, nx); b.st[0] = nloc; b.st[1] = nx; }
        const unsigned old = xb_add(&bar[XB_XSUB(b.x)], 1u);
        const unsigned gen = old / nloc;
        if (old + 1u == (gen + 1u) * nloc) {
            __builtin_amdgcn_fence(__ATOMIC_RELEASE, "agent");
            asm volatile("s_waitcnt vmcnt(0)" ::: "memory");
            const unsigned og = xb_add(&bar[XB_TOP], 1u);
            const unsigned tg = og / nx;
            if (og + 1u == (tg + 1u) * nx) xb_add(&bar[XB_TOPGEN], 1u);
            else XB_SPIN(xb_ld(&bar[XB_TOPGEN]) == tg, bar);
            __builtin_amdgcn_fence(__ATOMIC_ACQUIRE, "agent");
            xb_add(&bar[XB_XGEN(b.x)], 1u);
            asm volatile("s_waitcnt vmcnt(0)" ::: "memory");
        } else {
            XB_SPIN(xb_ld(&bar[XB_XGEN(b.x)]) == gen, bar);
            __builtin_amdgcn_fence(__ATOMIC_ACQUIRE, "agent");
            asm volatile("s_waitcnt vmcnt(0)" ::: "memory");
        }
    }
    __syncthreads();
}

struct Args { const float* in[24]; float* out; unsigned char* ws; };

__device__ __forceinline__ void p0_transpose_item(const float* W, int K, int N, bf16_t* WT, int swiglu, const float* gk, const float* bk, float* c1, float* c2, LAS float* scr, int item, int lane) {
    const int nblk = N / 64, kb = item / nblk, nb = item % nblk, k0 = 64 * kb, n0 = 64 * nb;
    const float* src = W + (size_t)(k0 + (lane >> 4)) * N + n0 + (lane & 15) * 4;
    f32x4 v[16];
#pragma unroll
    for (int i = 0; i < 16; ++i) v[i] = *(const f32x4*)(src + (size_t)(4 * i) * N);
#pragma unroll
    for (int i = 0; i < 16; ++i) { LAS float* d = scr + (4 * i + (lane >> 4)) * 65 + (lane & 15) * 4; d[0] = v[i][0]; d[1] = v[i][1]; d[2] = v[i][2]; d[3] = v[i][3]; }
    asm volatile("s_waitcnt lgkmcnt(0)" ::: "memory");
    int r0 = n0;
    if (swiglu) { const int half = n0 / DFF, idx = n0 % DFF; r0 = 256 * (idx / 128) + 128 * half + (idx % 128); }
    const int c = lane & 7;
    float g8[8], b8[8];
#pragma unroll
    for (int e = 0; e < 8; ++e) { g8[e] = gk ? gk[k0 + 8 * c + e] : 1.f; b8[e] = gk ? bk[k0 + 8 * c + e] : 0.f; }
#pragma unroll
    for (int j = 0; j < 8; ++j) { const int n = (lane >> 3) + 8 * j; const LAS float* q = scr + (8 * c) * 65 + n;
        float w8[8];
#pragma unroll
        for (int e = 0; e < 8; ++e) w8[e] = q[e * 65];
        u32x4 o; o.x = cvt_pk_bf16(w8[0] * g8[0], w8[1] * g8[1]); o.y = cvt_pk_bf16(w8[2] * g8[2], w8[3] * g8[3]); o.z = cvt_pk_bf16(w8[4] * g8[4], w8[5] * g8[5]); o.w = cvt_pk_bf16(w8[6] * g8[6], w8[7] * g8[7]);
        *(u32x4*)(WT + (size_t)(r0 + n) * K + k0 + 8 * c) = o;
        if (gk) {
            float s1 = ((bf_lo(o.x) + bf_hi(o.x)) + (bf_lo(o.y) + bf_hi(o.y))) + ((bf_lo(o.z) + bf_hi(o.z)) + (bf_lo(o.w) + bf_hi(o.w)));
            float s2 = ((w8[0] * b8[0] + w8[1] * b8[1]) + (w8[2] * b8[2] + w8[3] * b8[3])) + ((w8[4] * b8[4] + w8[5] * b8[5]) + (w8[6] * b8[6] + w8[7] * b8[7]));
            s1 += __shfl_xor(s1, 1); s1 += __shfl_xor(s1, 2); s1 += __shfl_xor(s1, 4); s2 += __shfl_xor(s2, 1); s2 += __shfl_xor(s2, 2); s2 += __shfl_xor(s2, 4);
            if (c == 0) { unsafeAtomicAdd(c1 + r0 + n, s1); unsafeAtomicAdd(c2 + r0 + n, s2); }
        } }
    asm volatile("s_waitcnt lgkmcnt(0)" ::: "memory");
}

__device__ __forceinline__ void p0_wq_item(const float* W, bf16_t* WN, const float* gk, const float* bk, float* bW, int item, int lane) {
    const int kb = item >> 5, jb = item & 31, k0 = 64 * kb, j0 = 64 * jb, cg8 = lane & 7, kr = lane >> 3;
    float sacc[8];
#pragma unroll
    for (int e = 0; e < 8; ++e) sacc[e] = 0.f;
#pragma unroll
    for (int i = 0; i < 8; ++i) { const int k = k0 + 8 * i + kr; const float* src = W + (size_t)k * DM + j0 + 8 * cg8;
        const f32x4 v0 = *(const f32x4*)src, v1 = *(const f32x4*)(src + 4); const float g = gk[k], bb = bk[k];
        u32x4 o; o.x = cvt_pk_bf16(v0[0] * g, v0[1] * g); o.y = cvt_pk_bf16(v0[2] * g, v0[3] * g); o.z = cvt_pk_bf16(v1[0] * g, v1[1] * g); o.w = cvt_pk_bf16(v1[2] * g, v1[3] * g);
        *(u32x4*)(WN + (size_t)k * DM + j0 + 8 * cg8) = o;
#pragma unroll
        for (int e = 0; e < 4; ++e) { sacc[e] += bb * v0[e]; sacc[4 + e] += bb * v1[e]; } }
#pragma unroll
    for (int e = 0; e < 8; ++e) { float v = sacc[e]; v += __shfl_xor(v, 8); v += __shfl_xor(v, 16); v += __shfl_xor(v, 32); if (kr == 0) unsafeAtomicAdd(bW + j0 + 8 * cg8 + e, v); }
}

__device__ __forceinline__ int causal_bucket(int n) {
    if (n < 16) return n;
    const float nf = (float)n;
    int large = 16 + (int)(logf(nf / 16.f) / 2.0794415416798357f * 16.f);
    return large < 31 ? large : 31;
}

__device__ __forceinline__ size_t zero_opaque() { size_t z = 0; asm volatile("" : "+s"(z)); return z; }
__device__ __forceinline__ const float* inp_ptr(const Args& a, int k) { return a.in[k] + zero_opaque(); }
#define INP(k) inp_ptr(a, k)
__device__ __forceinline__ unsigned char* ws_opaque(const Args& a) { return a.ws + zero_opaque(); }
__device__ __forceinline__ float* out_opaque(const Args& a) { return a.out + zero_opaque(); }
#define WSP(type, off) ((type*)(ws_opaque(a) + (off)))
__global__ void __launch_bounds__(NTHR, 2) mega_fwd(Args a) {
    extern __shared__ __attribute__((aligned(16))) unsigned char lds[];
    cg::grid_group grid = cg::this_grid();
    volatile LAS unsigned* bst = (volatile LAS unsigned*)((LAS unsigned char*)lds + LDS_BYTES - 64);
    if (threadIdx.x == 0) { bst[0] = 0u; bst[1] = 0u; }
    __syncthreads();
    const XcdBarrier xbar = xcd_barrier_post((unsigned*)(a.ws + WS_BAR), bst);
#define GRID_BAR() xcd_barrier(xbar)
    const int G = gridDim.x;
    const int NGW = G * NWAVES, NGT = G * NTHR;
    {
        PH_IDS;
        unsigned char* ws = ws_opaque(a);
        float* lamp = (float*)(ws + WS_LAM); float* btab = (float*)(ws + WS_BTAB); bf16_t* wtril = (bf16_t*)(ws + WS_WTRIL); bf16_t* membf = (bf16_t*)(ws + WS_MEMBF); bf16_t* XN = (bf16_t*)(ws + WS_XN);
        LAS float* scr = (LAS float*)((LAS unsigned char*)lds + wave * 17408);
        constexpr int I_IN = 32 * 88, I_SQ = 32 * 32, I_KV = 32 * 64, I_GU = 32 * 176, I_D = 88 * 32;
        constexpr int PER_LAYER = I_IN + 3 * I_SQ + I_KV + I_GU + I_D;
        for (int it = gw; it < 2 * PER_LAYER; it += NGW) {
            const int l = it / PER_LAYER; int r = it % PER_LAYER;
            unsigned char* wl = ws + WS_W + (size_t)l * W_LAYER;
            float* cl = (float*)(ws + WS_C) + (size_t)l * C_LAYER;
            if (r < I_IN) { const bool f = l > 0;
                p0_transpose_item(INP(3) + (size_t)l * DM * INC, DM, INC, (bf16_t*)(wl + W_IN), 0, f ? INP(22) : nullptr, f ? INP(23) : nullptr, cl + C_IN, cl + C_IN + INC, scr, r, lane); continue; } r -= I_IN;
            if (r < I_SQ) { p0_transpose_item(INP(12) + (size_t)l * DM * DM, DM, DM, (bf16_t*)(wl + W_OUT), 0, nullptr, nullptr, nullptr, nullptr, scr, r, lane); continue; } r -= I_SQ;
            if (r < I_SQ) { p0_wq_item(INP(15) + (size_t)l * DM * DM, (bf16_t*)(wl + W_Q), INP(13) + (size_t)l * DM, INP(14) + (size_t)l * DM, cl + C_Q + DM, r, lane); continue; } r -= I_SQ;
            if (r < I_KV) { p0_transpose_item(INP(16) + (size_t)l * DM * 2 * DM, DM, 2 * DM, (bf16_t*)(wl + W_KV), 0, nullptr, nullptr, nullptr, nullptr, scr, r, lane); continue; } r -= I_KV;
            if (r < I_SQ) { p0_transpose_item(INP(17) + (size_t)l * DM * DM, DM, DM, (bf16_t*)(wl + W_O), 0, nullptr, nullptr, nullptr, nullptr, scr, r, lane); continue; } r -= I_SQ;
            if (r < I_GU) { p0_transpose_item(INP(20) + (size_t)l * DM * 2 * DFF, DM, 2 * DFF, (bf16_t*)(wl + W_GU), 1, INP(18) + (size_t)l * DM, INP(19) + (size_t)l * DM, cl + C_GU, cl + C_GU + 2 * DFF, scr, r, lane); continue; } r -= I_GU;
            p0_transpose_item(INP(21) + (size_t)l * DFF * DM, DFF, DM, (bf16_t*)(wl + W_D), 0, nullptr, nullptr, nullptr, nullptr, scr, r, lane);
        }
        for (size_t i = gt; i < (size_t)T * DM / 8; i += NGT) {
            const f32x4 v0 = *(const f32x4*)(INP(0) + i * 8), v1 = *(const f32x4*)(INP(0) + i * 8 + 4);
            u32x4 w; w.x = cvt_pk_bf16(v0[0], v0[1]); w.y = cvt_pk_bf16(v0[2], v0[3]); w.z = cvt_pk_bf16(v1[0], v1[1]); w.w = cvt_pk_bf16(v1[2], v1[3]);
            *(u32x4*)(XN + i * 8) = w;
        }
        for (size_t i = gt; i < (size_t)BATCH * NMEM * DM / 8; i += NGT) {
            const f32x4 v0 = *(const f32x4*)(INP(1) + i * 8), v1 = *(const f32x4*)(INP(1) + i * 8 + 4);
            u32x4 w; w.x = cvt_pk_bf16(v0[0], v0[1]); w.y = cvt_pk_bf16(v0[2], v0[3]); w.z = cvt_pk_bf16(v1[0], v1[1]); w.w = cvt_pk_bf16(v1[2], v1[3]);
            *(u32x4*)(membf + i * 8) = w;
        }
        for (int i = gt; i < DEPTH * 4 * 128 * 128; i += NGT) { const int s = i & 127, t = (i >> 7) & 127; wtril[i] = s <= t ? f2bf(INP(7)[i]) : (bf16_t)0; }
        if (gt < 8 * 256) { const int hm = gt >> 8, d = gt & 255; const float* rb = INP(2);
            btab[gt] = (rb[causal_bucket(d) * 8 + hm] - rb[31 * 8 + hm]) * (1.f / att::SCALE); }
        if (cu == 0 && wave == 0) {
            for (int l = 0; l < DEPTH; ++l) {
                const float* lq = INP(9) + l * 256; const float* lk = INP(10) + l * 256;
                float s0 = lq[lane] * lk[lane] + lq[lane + 64] * lk[lane + 64];
                float s1 = lq[128 + lane] * lk[128 + lane] + lq[192 + lane] * lk[192 + lane];
                s0 = wave_sum(s0); s1 = wave_sum(s1);
                const float lam_init = 0.8f - 0.6f * expf(-0.3f * (float)l);
                if (lane == 0) lamp[l] = expf(s0) - expf(s1) + lam_init;
            }
        }
    }
    grid.sync();

#pragma unroll 1
    for (int l = 0; l < DEPTH; ++l) {
        {
            unsigned char* ws = ws_opaque(a);
            pg8::Gemm g{(const bf16_t*)(ws + WS_XN), (const bf16_t*)(ws + WS_W + (size_t)l * W_LAYER + W_IN), DM, DM, DM, 1, 0, 0, 0, 0};
            pg8::Order S; S.init(T, INC, 1, G, cu_opaque());
            const float* cl = (const float*)(ws + WS_C) + (size_t)l * C_LAYER;
            const float* st = l > 0 ? (const float*)(ws + WS_ST) + (size_t)(3 * l - 1) * T * 2 : nullptr;
            pg8::EpiSplit E{(bf16_t*)(ws + WS_PROJ), st, cl + C_IN, cl + C_IN + INC};
            pg8::gemm_phase<pg8::EpiSplit, true>((LAS unsigned char*)lds, g, S, E);
        }
        if (l == 0) {
            {
                unsigned char* ws = ws_opaque(a);
                pg8::Gemm g{(const bf16_t*)(ws + WS_MEMBF), (const bf16_t*)(ws + WS_W + W_KV), DM, DM, DM, 1, 0, 0, (long)(W_LAYER / 2), 0};
                pg8::Order S; const int cu = cu_opaque(); S.init(BATCH * NMEM, 2 * DM, 2, G, cu >= 128 && cu < 192 ? cu - 128 : -1);
                pg8::EpiBf16 E{(bf16_t*)(ws + WS_KV), 2 * DM, 1, (long)(BATCH * NMEM) * 2 * DM, 0, 1.f, nullptr, nullptr, nullptr, nullptr};
                pg8::gemm_phase<pg8::EpiBf16, true>((LAS unsigned char*)lds, g, S, E);
            }
        }
        GRID_BAR();

        if (l == 0) {
#pragma unroll 1
            for (int L2 = 0; L2 < DEPTH; ++L2) {
                {
                    unsigned char* ws = ws_opaque(a); unsigned char* wl2 = ws + WS_W + (size_t)L2 * W_LAYER;
                    const bf16_t* KVl = (const bf16_t*)(ws + WS_KV) + (size_t)L2 * BATCH * NMEM * 2 * DM;
                    float* cl = (float*)(ws + WS_C) + (size_t)L2 * C_LAYER;
                    pg8::Gemm g{KVl, (const bf16_t*)(wl2 + W_Q), 2 * DM, DM, 512, 4, (long)NMEM * 2 * DM, 512, 0, 512};
                    pg8::Order S; const int cu = cu_opaque(); S.init(NMEM, DM, 8, G, cu >= 64 * L2 && cu < 64 * L2 + 64 ? cu - 64 * L2 : -1);
                    pg8::EpiBf16 E{(bf16_t*)(wl2 + W_KV), DM, 1, (long)NMEM * DM, 0, 1.f, nullptr, nullptr, nullptr, cl + C_Q};
                    pg8::gemm_phase<pg8::EpiBf16, true>((LAS unsigned char*)lds, g, S, E);
                }
                {
                    unsigned char* ws = ws_opaque(a); unsigned char* wl2 = ws + WS_W + (size_t)L2 * W_LAYER;
                    const bf16_t* KVl = (const bf16_t*)(ws + WS_KV) + (size_t)L2 * BATCH * NMEM * 2 * DM;
                    pg8::Gemm g{(const bf16_t*)(wl2 + W_O), KVl + DM, DM, 2 * DM, 512, 4, 0, 512, (long)NMEM * 2 * DM, 512};
                    pg8::Order S; const int cu = cu_opaque(); S.init(DM, NMEM, 8, G, cu >= 128 + 64 * L2 && cu < 192 + 64 * L2 ? cu - 128 - 64 * L2 : -1);
                    pg8::EpiBf16 E{(bf16_t*)(wl2 + W_KV + 8 * MiB), 1024, 4, (long)DM * 1024, 256, 1.f, nullptr, nullptr, nullptr, nullptr};
                    pg8::gemm_phase<pg8::EpiBf16, true>((LAS unsigned char*)lds, g, S, E);
                }
            }
            {
                PH_IDS;
                unsigned char* ws = ws_opaque(a);
                for (int it = gw; it < DEPTH * 2048; it += NGW) {
                    const int L2 = it >> 11, r = it & 2047, b = r >> 10, h = (r >> 8) & 3, n = r & 255;
                    const bf16_t* kp = (const bf16_t*)(ws + WS_KV) + ((size_t)L2 * BATCH * NMEM + b * NMEM + n) * 2 * DM + h * 512 + 8 * lane;
                    float* cl = (float*)(ws + WS_C) + (size_t)L2 * C_LAYER;
                    const float* bw = cl + C_Q + DM + h * 512 + 8 * lane;
                    const u32x4 kw = *(const u32x4*)kp; const f32x4 b0 = *(const f32x4*)bw, b1 = *(const f32x4*)(bw + 4);
                    float d = (bf_lo(kw.x) * b0[0] + bf_hi(kw.x) * b0[1]) + (bf_lo(kw.y) * b0[2] + bf_hi(kw.y) * b0[3]) + (bf_lo(kw.z) * b1[0] + bf_hi(kw.z) * b1[1]) + (bf_lo(kw.w) * b1[2] + bf_hi(kw.w) * b1[3]);
                    d = wave_sum(d);
                    if (lane == 0) cl[C_QK2 + r] = d;
                }
            }
            __syncthreads();
        }
        {
            PH_IDS;
            bf16_t* PB = WSP(bf16_t, WS_PROJ); bf16_t* Y = WSP(bf16_t, WS_Y);
            const float* cw = INP(4) + (size_t)l * 3 * 512;
            for (int it = gt; it < T * 64; it += NGT) {
                const int r = it >> 6, cg8 = it & 63, c0 = cg8 * 8, gi = cg8 >> 4, cc = c0 & 127, t = r & (SEQ - 1);
                const bf16_t* pb = PB + ((size_t)(0 + gi) * T + r) * 128 + cc;
                const bf16_t* pc = PB + ((size_t)(4 + gi) * T + r) * 128 + cc;
                const bf16_t* ph = PB + ((size_t)(8 + gi) * T + r) * 128 + cc;
                const u32x4 wb = *(const u32x4*)pb, wc0 = *(const u32x4*)pc, wh0 = *(const u32x4*)ph;
                u32x4 wc1 = {0, 0, 0, 0}, wh1 = {0, 0, 0, 0}, wc2 = {0, 0, 0, 0}, wh2 = {0, 0, 0, 0};
                if (t >= 1) { wc1 = *(const u32x4*)(pc - 128); wh1 = *(const u32x4*)(ph - 128); }
                if (t >= 2) { wc2 = *(const u32x4*)(pc - 256); wh2 = *(const u32x4*)(ph - 256); }
                float y[8];
#pragma unroll
                for (int j = 0; j < 4; ++j) {
                    const float k0a = cw[c0 + 2 * j], k1a = cw[512 + c0 + 2 * j], k2a = cw[1024 + c0 + 2 * j];
                    const float k0b = cw[c0 + 2 * j + 1], k1b = cw[512 + c0 + 2 * j + 1], k2b = cw[1024 + c0 + 2 * j + 1];
                    const float z0a = bf_lo(wc0[j]) * bf_lo(wh0[j]), z1a = bf_lo(wc1[j]) * bf_lo(wh1[j]), z2a = bf_lo(wc2[j]) * bf_lo(wh2[j]);
                    const float z0b = bf_hi(wc0[j]) * bf_hi(wh0[j]), z1b = bf_hi(wc1[j]) * bf_hi(wh1[j]), z2b = bf_hi(wc2[j]) * bf_hi(wh2[j]);
                    y[2 * j] = bf_lo(wb[j]) * (k0a * z2a + k1a * z1a + k2a * z0a);
                    y[2 * j + 1] = bf_hi(wb[j]) * (k0b * z2b + k1b * z1b + k2b * z0b);
                }
                u32x4 w; w.x = cvt_pk_bf16(y[0], y[1]); w.y = cvt_pk_bf16(y[2], y[3]); w.z = cvt_pk_bf16(y[4], y[5]); w.w = cvt_pk_bf16(y[6], y[7]);
                *(u32x4*)(Y + (size_t)r * DM + c0) = w;
            }
        }
        {
            PH_IDS;
            bf16_t* PB = WSP(bf16_t, WS_PROJ); bf16_t* Y = WSP(bf16_t, WS_Y); bf16_t* wtril = WSP(bf16_t, WS_WTRIL);
            float* st = (float*)(lds + 40960);
            bf16_t* vT = (bf16_t*)lds;
            const float* lng = INP(5) + (size_t)l * 512; const float* lnb = INP(6) + (size_t)l * 512;
            const float* bs = INP(8) + (size_t)l * 512;
            for (int un = cu; un < (T / 128) * 4; un += G) {
                const int ch = un >> 2, gi = un & 3, r0 = ch * 128;
                const int tok = tid >> 2, q = tid & 3;
                {
                    const bf16_t* vp = PB + ((size_t)(16 + q) * T + r0 + tok) * 128;
                    float s = 0.f, ss = 0.f;
#pragma unroll 4
                    for (int i = 0; i < 16; ++i) { const u32x4 w = *(const u32x4*)(vp + 8 * i);
#pragma unroll
                        for (int j = 0; j < 4; ++j) { const float x0 = gelu_tanh(bf_lo(w[j])), x1 = gelu_tanh(bf_hi(w[j])); s += x0 + x1; ss += x0 * x0 + x1 * x1; } }
                    s += __shfl_xor(s, 1); s += __shfl_xor(s, 2); ss += __shfl_xor(ss, 1); ss += __shfl_xor(ss, 2);
                    const float mean = s * (1.f / 512.f), var = fmaxf(ss * (1.f / 512.f) - mean * mean, 0.f);
                    if (q == 0) { st[2 * tok] = mean; st[2 * tok + 1] = rsqrtf(var + LN_EPS); }
                }
                __syncthreads();
                {
                    const int cq = q * 32; const float mean = st[2 * tok], rstd = st[2 * tok + 1];
                    const bf16_t* vp = PB + ((size_t)(16 + gi) * T + r0 + tok) * 128 + cq;
#pragma unroll
                    for (int i = 0; i < 4; ++i) { const u32x4 w = *(const u32x4*)(vp + 8 * i);
#pragma unroll
                        for (int j = 0; j < 4; ++j) { const int c = cq + 8 * i + 2 * j;
                            const float x0 = gelu_tanh(bf_lo(w[j])), x1 = gelu_tanh(bf_hi(w[j]));
                            vT[c * 136 + tok] = f2bf((x0 - mean) * rstd * lng[gi * 128 + c] + lnb[gi * 128 + c]);
                            vT[(c + 1) * 136 + tok] = f2bf((x1 - mean) * rstd * lng[gi * 128 + c + 1] + lnb[gi * 128 + c + 1]); } }
                }
                __syncthreads();
                {
                    f32x4 acc[8];
#pragma unroll
                    for (int ct = 0; ct < 8; ++ct) acc[ct] = (f32x4){0.f, 0.f, 0.f, 0.f};
                    const bf16_t* wrow = wtril + ((size_t)(l * 4 + gi) * 128 + 16 * wave + (lane & 15)) * 128 + 8 * (lane >> 4);
#pragma unroll
                    for (int kk = 0; kk < 4; ++kk) { const bf16x8 av = *(const bf16x8*)(wrow + kk * 32);
#pragma unroll
                        for (int ct = 0; ct < 8; ++ct) { const bf16x8 bv = *(const bf16x8*)(vT + (ct * 16 + (lane & 15)) * 136 + kk * 32 + 8 * (lane >> 4));
                            acc[ct] = __builtin_amdgcn_mfma_f32_16x16x32_bf16(av, bv, acc[ct], 0, 0, 0); } }
#pragma unroll
                    for (int ct = 0; ct < 8; ++ct)
#pragma unroll
                        for (int j = 0; j < 4; ++j) { const int t = 16 * wave + 4 * (lane >> 4) + j, c = ct * 16 + (lane & 15);
                            const float uu = bf2f(PB[((size_t)(12 + gi) * T + r0 + t) * 128 + c]);
                            Y[(size_t)(r0 + t) * DM + 512 + gi * 128 + c] = f2bf(gelu_tanh(uu) * (acc[ct][j] + bs[gi * 128 + t])); }
                }
                __syncthreads();
            }
        }
        {
            PH_IDS;
            bf16_t* PB = WSP(bf16_t, WS_PROJ); float* OATT = WSP(float, WS_R1); float* btab = WSP(float, WS_BTAB);
            float* btl = (float*)(lds + att2::L_BT);
            for (int i = tid; i < 8 * 256; i += NTHR) btl[i] = btab[i];
            __syncthreads();
            const att::bf16* PBb = (const att::bf16*)PB;
#pragma unroll 1
            for (int L = cu; L < 512; L += G) {
                const int k_ = L >> 3, hm = L & 7, b = k_ >> 5, x = k_ & 31, h = hm >> 1;
#pragma unroll 1
                for (int pass = 0; pass < 2; ++pass) {
                    const int qb = pass ? 63 - x : x;
                    att2::Blk c;
                    c.Q = PBb + ((size_t)(20 + hm) * T + (size_t)b * SEQ + qb * 128) * 128; c.K = PBb + ((size_t)(28 + hm) * T + (size_t)b * SEQ) * 128;
                    c.V0 = PBb + ((size_t)(36 + h * 2) * T + (size_t)b * SEQ) * 128; c.V1 = PBb + ((size_t)(37 + h * 2) * T + (size_t)b * SEQ) * 128;
                    c.O0 = OATT + ((size_t)((b * 8 + hm) * 2 + 0) * SEQ + qb * 128) * 128; c.O1 = OATT + ((size_t)((b * 8 + hm) * 2 + 1) * SEQ + qb * 128) * 128;
                    c.P0 = qb * 128; c.hm = hm;
                    att2::attn2_block(c, (char*)lds);
                }
            }
        }
        GRID_BAR();

        {
            PH_IDS;
            float* OATT = WSP(float, WS_R1); bf16_t* Y = WSP(bf16_t, WS_Y); float* lamp = WSP(float, WS_LAM);
            const float lam_init = 0.8f - 0.6f * expf(-0.3f * (float)l);
            const float lam = lamp[l]; const float* sg = INP(11) + (size_t)l * 256;
            const f32x4 gv = *(const f32x4*)(sg + 4 * lane);
            for (int it = gw; it < T * 4; it += NGW) {
                const int r = it >> 2, h = it & 3, b = r >> 13, t = r & (SEQ - 1);
                const int half = lane >> 5, e = (lane & 31) * 4;
                const size_t i0 = ((size_t)(((b * 4 + h) * 2 + 0) * 2 + half) * SEQ + t) * 128 + e;
                const size_t i1 = ((size_t)(((b * 4 + h) * 2 + 1) * 2 + half) * SEQ + t) * 128 + e;
                const f32x4 o0 = *(const f32x4*)(OATT + i0), o1 = *(const f32x4*)(OATT + i1);
                const f32x4 d = o0 - o1 * lam;
                const float ss = wave_sum(d[0] * d[0] + d[1] * d[1] + d[2] * d[2] + d[3] * d[3]);
                const float sc = rsqrtf(ss * (1.f / 256.f) + LN_EPS) * (1.f - lam_init);
                u32x2 w; w.x = cvt_pk_bf16(d[0] * sc * gv[0], d[1] * sc * gv[1]); w.y = cvt_pk_bf16(d[2] * sc * gv[2], d[3] * sc * gv[3]);
                *(u32x2*)(Y + (size_t)r * DM + 1024 + h * 256 + 4 * lane) = w;
            }
        }
        GRID_BAR();

#define LN_PASS(gam, bet, write_xn) do { PH_IDS; float* X = out_opaque(a); bf16_t* XN = WSP(bf16_t, WS_XN); \
            for (int r = gw; r < T; r += NGW) { float* xr = X + (size_t)r * DM; f32x4 v[8]; float s = 0.f; \
                _Pragma("unroll") for (int j = 0; j < 8; ++j) { v[j] = *(const f32x4*)(xr + 4 * lane + 256 * j); s += (v[j][0] + v[j][1]) + (v[j][2] + v[j][3]); } \
                const float mean = wave_sum(s) * (1.f / DM); float s2 = 0.f; \
                _Pragma("unroll") for (int j = 0; j < 8; ++j) { v[j] = v[j] - mean; s2 += (v[j][0] * v[j][0] + v[j][1] * v[j][1]) + (v[j][2] * v[j][2] + v[j][3] * v[j][3]); } \
                const float rstd = rsqrtf(wave_sum(s2) * (1.f / DM) + LN_EPS); \
                _Pragma("unroll") for (int j = 0; j < 8; ++j) { const f32x4 gg = *(const f32x4*)((gam) + 4 * lane + 256 * j), bb = *(const f32x4*)((bet) + 4 * lane + 256 * j); \
                    const f32x4 o = v[j] * rstd * gg + bb; *(f32x4*)(xr + 4 * lane + 256 * j) = o; \
                    if (write_xn) { u32x2 w; w.x = cvt_pk_bf16(o[0], o[1]); w.y = cvt_pk_bf16(o[2], o[3]); *(u32x2*)(XN + (size_t)r * DM + 4 * lane + 256 * j) = w; } } } } while (0)

        {
            unsigned char* ws = ws_opaque(a); float* X = out_opaque(a); float* ST = (float*)(ws + WS_ST);
            pg8::Gemm g{(const bf16_t*)(ws + WS_Y), (const bf16_t*)(ws + WS_W + (size_t)l * W_LAYER + W_OUT), DM, DM, DM, 1, 0, 0, 0, 0};
            pg8::Order S; S.init(T, DM, 1, G, cu_opaque());
            pg8::EpiRes E{nullptr, l == 0 ? INP(0) : nullptr, ST + (size_t)(l > 0 ? 3 * l - 1 : 0) * T * 2, INP(22) + (size_t)(l > 0 ? l - 1 : 0) * DM, INP(23) + (size_t)(l > 0 ? l - 1 : 0) * DM,
                          (bf16_t*)(ws + WS_XN), ST + (size_t)(3 * l) * T * 2, ALPHA, 0};
            pg8::gemm_phase<pg8::EpiRes, true>((LAS unsigned char*)lds, g, S, E);
        }
        GRID_BAR();

        {
            unsigned char* ws = ws_opaque(a);
            const float* cl = (const float*)(ws + WS_C) + (size_t)l * C_LAYER;
            pg8::Gemm g{(const bf16_t*)(ws + WS_XN), (const bf16_t*)(ws + WS_W + (size_t)l * W_LAYER + W_KV), DM, DM, DM, 4, (long)SEQ * DM, 0, (long)4 * NMEM * DM, (long)NMEM * DM};
            pg8::Order S; S.init(SEQ, NMEM, 8, G, cu_opaque());
            pg8::EpiSoftmax E{(bf16_t*)(ws + WS_PROJ + 64 * MiB), (const float*)(ws + WS_ST) + (size_t)(3 * l) * T * 2, cl + C_Q, cl + C_QK2, 0.044194173824159216f};
            pg8::gemm_phase<pg8::EpiSoftmax, true>((LAS unsigned char*)lds, g, S, E);
        }
        GRID_BAR();
        {
            unsigned char* ws = ws_opaque(a); float* ST = (float*)(ws + WS_ST);
            pg8::Gemm g{(const bf16_t*)(ws + WS_PROJ + 64 * MiB), (const bf16_t*)(ws + WS_W + (size_t)l * W_LAYER + W_KV + 8 * MiB), 1024, 1024, 1024, 1, (long)SEQ * 1024, 0, (long)DM * 1024, 0};
            pg8::Order S; S.init(SEQ, DM, 2, G, cu_opaque());
            pg8::EpiRes E{nullptr, nullptr, ST + (size_t)(3 * l) * T * 2, INP(13) + (size_t)l * DM, INP(14) + (size_t)l * DM, (bf16_t*)(ws + WS_XN), ST + (size_t)(3 * l + 1) * T * 2, ALPHA, SEQ};
            pg8::gemm_phase<pg8::EpiRes, true>((LAS unsigned char*)lds, g, S, E);
        }
        GRID_BAR();
        {
            unsigned char* ws = ws_opaque(a);
            const float* cl = (const float*)(ws + WS_C) + (size_t)l * C_LAYER;
            pg8::Gemm g{(const bf16_t*)(ws + WS_XN), (const bf16_t*)(ws + WS_W + (size_t)l * W_LAYER + W_GU), DM, DM, DM, 1, 0, 0, 0, 0};
            pg8::Order S; S.init(T, 2 * DFF, 1, G, cu_opaque());
            pg8::EpiSwiglu E{(bf16_t*)(ws + WS_PROJ), (const float*)(ws + WS_ST) + (size_t)(3 * l + 1) * T * 2, cl + C_GU, cl + C_GU + 2 * DFF};
            pg8::gemm_phase<pg8::EpiSwiglu, true>((LAS unsigned char*)lds, g, S, E);
        }
        GRID_BAR();
        {
            unsigned char* ws = ws_opaque(a); float* X = out_opaque(a); float* ST = (float*)(ws + WS_ST);
            pg8::Gemm g{(const bf16_t*)(ws + WS_PROJ), (const bf16_t*)(ws + WS_W + (size_t)l * W_LAYER + W_D), DFF, DFF, DFF, 1, 0, 0, 0, 0};
            pg8::Order S; S.init(T, DM, 1, G, cu_opaque());
            pg8::EpiRes E{l + 1 == DEPTH ? X : nullptr, nullptr, ST + (size_t)(3 * l + 1) * T * 2, INP(18) + (size_t)l * DM, INP(19) + (size_t)l * DM, (bf16_t*)(ws + WS_XN), ST + (size_t)(3 * l + 2) * T * 2, ALPHA, 0};
            pg8::gemm_phase<pg8::EpiRes, true>((LAS unsigned char*)lds, g, S, E);
        }
        GRID_BAR();
        if (l + 1 == DEPTH) { LN_PASS(INP(22) + (size_t)l * DM, INP(23) + (size_t)l * DM, false); }
#undef LN_PASS
    }
}

extern "C" void kernel_launch(void* const* d_in, const int* in_sizes, int n_in, void* d_out, int out_size, void* d_ws, size_t ws_size, hipStream_t stream) {
    static int grid = 0;
    if (grid == 0) {
        if (n_in != 24 || in_sizes[0] != T * DM || out_size != T * DM || ws_size < WS_END) {
            fprintf(stderr, "kernel_launch: unexpected shapes (n_in %d, in0 %d, out %d, ws %zu); nothing launched\n", n_in, n_in > 0 ? in_sizes[0] : -1, out_size, ws_size); grid = -1; return; }
        int dev = 0, cus = 0, per_cu = 0;
        (void)hipGetDevice(&dev);
        if (hipDeviceGetAttribute(&cus, hipDeviceAttributeMultiprocessorCount, dev) != hipSuccess || cus <= 0) cus = 256;
        if (hipFuncSetAttribute((const void*)mega_fwd, hipFuncAttributeMaxDynamicSharedMemorySize, LDS_BYTES) != hipSuccess) fprintf(stderr, "kernel_launch: hipFuncSetAttribute failed\n");
        if (hipOccupancyMaxActiveBlocksPerMultiprocessor(&per_cu, (const void*)mega_fwd, NTHR, LDS_BYTES) != hipSuccess || per_cu < 1) { fprintf(stderr, "kernel_launch: occupancy query says %d\n", per_cu); per_cu = 1; }
        (void)hipGetLastError();
        grid = cus * per_cu;
    }
    if (grid < 0) return;
    if (hipMemsetAsync((char*)d_ws + WS_BAR, 0, 512 * 1024, stream) != hipSuccess || hipMemsetAsync((char*)d_ws + WS_ST, 0, 1 * MiB, stream) != hipSuccess) { fprintf(stderr, "kernel_launch: hipMemsetAsync failed\n"); return; }
    Args a{};
    for (int i = 0; i < 24; ++i) a.in[i] = (const float*)d_in[i];
    a.out = (float*)d_out; a.ws = (unsigned char*)d_ws;
    void* args[] = {&a};
    hipError_t e = hipLaunchCooperativeKernel((const void*)mega_fwd, dim3(grid), dim3(NTHR), args, LDS_BYTES, stream);
    if (e != hipSuccess) fprintf(stderr, "cooperative launch failed: %s (grid %d)\n", hipGetErrorString(e), grid);
}
```

```cpp
#include <hip/hip_runtime.h>
#include <hip/hip_cooperative_groups.h>
#include <hip/hip_bf16.h>
#include <cstdio>
#include <cstdint>
namespace cg = cooperative_groups;

constexpr int BATCH = 2, SEQ = 8192, DM = 2048, DEPTH = 2, T = BATCH * SEQ;
constexpr int NMEM = 256, INC = 5632, DFF = 5632;
constexpr float ALPHA = 1.4142135623730951f;
constexpr float LN_EPS = 1e-5f;
constexpr int NTHR = 512, NWAVES = 8;

constexpr size_t MiB = 1u << 20;
constexpr size_t WS_LAM = 0;
constexpr size_t WS_BTAB = 4096;
constexpr size_t WS_BAR = 512 * 1024;
constexpr size_t WS_C = 576 * 1024;
constexpr int C_Q = 0, C_GU = 4096, C_IN = 4096 + 22528, C_QK2 = 4096 + 22528 + 11264, C_LAYER = C_QK2 + 2048;
constexpr size_t WS_ST = 12 * MiB;
constexpr size_t WS_WTRIL = 1 * MiB;
constexpr size_t WS_MEMBF = 2 * MiB;
constexpr size_t WS_KV = 4 * MiB;
constexpr size_t WS_W = 16 * MiB;
constexpr size_t W_IN = 0, W_OUT = 22 * MiB, W_Q = 30 * MiB, W_KV = 38 * MiB, W_O = 54 * MiB, W_GU = 62 * MiB, W_D = 106 * MiB, W_LAYER = 128 * MiB;
constexpr size_t WS_XN = 272 * MiB;
constexpr size_t WS_PROJ = 336 * MiB;
constexpr size_t WS_R1 = 512 * MiB;
constexpr size_t WS_Y = 640 * MiB;
constexpr size_t WS_END = 704 * MiB;
constexpr int LDS_BYTES = 147456;

typedef unsigned short bf16_t;
typedef short bf16x8 __attribute__((ext_vector_type(8)));
typedef float f32x4 __attribute__((ext_vector_type(4)));
typedef float f32x16 __attribute__((ext_vector_type(16)));
typedef unsigned u32x4 __attribute__((ext_vector_type(4)));
typedef unsigned u32x2 __attribute__((ext_vector_type(2)));
#define LAS __attribute__((address_space(3)))
#define GAS __attribute__((address_space(1)))

__device__ __forceinline__ unsigned cvt_pk_bf16(float lo, float hi) { unsigned r; asm volatile("v_cvt_pk_bf16_f32 %0, %1, %2" : "=v"(r) : "v"(lo), "v"(hi)); return r; }
__device__ __forceinline__ float bf_lo(unsigned w) { return __uint_as_float(w << 16); }
__device__ __forceinline__ float bf_hi(unsigned w) { return __uint_as_float(w & 0xffff0000u); }
__device__ __forceinline__ float bf2f(bf16_t b) { return __uint_as_float(((unsigned)b) << 16); }
__device__ __forceinline__ bf16_t f2bf(float f) { return (bf16_t)(cvt_pk_bf16(f, 0.f) & 0xffffu); }
__device__ __forceinline__ int ltid() { int t = threadIdx.x; asm volatile("" : "+v"(t)); return t; }
__device__ __forceinline__ int cu_opaque() { int c = blockIdx.x; asm volatile("" : "+s"(c)); return c; }
#define PH_IDS const int cu = cu_opaque(); const int tid = ltid(), lane = tid & 63, wave = __builtin_amdgcn_readfirstlane(tid >> 6), gw = cu * NWAVES + wave, gt = cu * NTHR + tid; (void)lane; (void)wave; (void)gw; (void)gt
__device__ __forceinline__ float wave_sum(float v) {
#pragma unroll
    for (int o = 1; o < 64; o <<= 1) v += __shfl_xor(v, o);
    return v;
}
__device__ __forceinline__ float wave_max(float v) {
#pragma unroll
    for (int o = 1; o < 64; o <<= 1) v = fmaxf(v, __shfl_xor(v, o));
    return v;
}
__device__ __forceinline__ float gelu_tanh(float x) {
    const float y = 0.7978845608028654f * (x + 0.044715f * x * x * x);
    return x * __builtin_amdgcn_rcpf(1.f + __expf(-2.f * y));
}

namespace pg8 {
constexpr int BM = 256, BK = 64, HALF = 128, HTB = HALF * BK * 2, STAGE_BYTES = 8 * HTB, NXCD = 8, WGM = 8;
__host__ __device__ __forceinline__ int lds_byte(int r, int c) { const int st = (r >> 4) * 2 + (c >> 5), rr = r & 15, cc = c & 31, ob = rr * 64 + cc * 2; return st * 1024 + (ob ^ (((ob >> 9) & 1) << 5)); }
__host__ __device__ __forceinline__ void stage_rc(int b, int& R, int& C) { const int st = b / 1024, sb = b % 1024, swz = sb ^ (((sb >> 9) & 1) << 5); R = (st >> 1) * 16 + swz / 64; C = (st & 1) * 32 + (swz % 64) / 2; }
__host__ __device__ __forceinline__ int perm32(int rho) { const int n = rho >> 4, i = rho & 15; return 8 * (i >> 2) + 4 * n + (i & 3); }

struct Unit { int pm, pn, bz; };
struct Gemm { const bf16_t* A; const bf16_t* Bt; int lda, ldb, K, nb0; long a_s1, a_s0, b_s1, b_s0; };
__device__ __forceinline__ const char* unit_a(const Gemm& g, const Unit& u) { const int b1 = u.bz / g.nb0, b0 = u.bz % g.nb0; return (const char*)(g.A + (size_t)b1 * g.a_s1 + (size_t)b0 * g.a_s0 + (size_t)u.pm * BM * g.lda); }
__device__ __forceinline__ const char* unit_b(const Gemm& g, const Unit& u) { const int b1 = u.bz / g.nb0, b0 = u.bz % g.nb0; return (const char*)(g.Bt + (size_t)b1 * g.b_s1 + (size_t)b0 * g.b_s0 + (size_t)u.pn * BM * g.ldb); }

struct Order {
    int nM, nN, nB, G, c;
    __device__ void init(int M, int N, int nB_, int G_, int c_) { nM = M / BM; nN = N / BM; nB = nB_; G = G_; c = c_; }
    __device__ bool next(int i, Unit& u) const {
        const long L = (long)i * G + c; const int nwg = nM * nN; if (c < 0 || L >= (long)nwg * nB) return false;
        if (nB > 1) { u.bz = (int)(L / nwg); const int w = (int)(L % nwg); u.pn = w / nM; u.pm = w % nM; return true; }
        u.bz = 0;
        int wgid = (int)L; { const int q = nwg / NXCD, r = nwg % NXCD, xcd = wgid % NXCD, off = wgid / NXCD; wgid = (xcd < r ? xcd * (q + 1) : r * (q + 1) + (xcd - r) * q) + off; }
        const int nig = WGM * nN, gid = wgid / nig, fm = gid * WGM, gsz = (nM - fm) < WGM ? (nM - fm) : WGM;
        u.pm = fm + ((wgid % nig) % gsz); u.pn = (wgid % nig) / gsz; return true;
    }
};

__device__ __forceinline__ void row_stats(const float* st, int row, float& mean, float& rstd) {
    const float s1 = st[2 * row], s2 = st[2 * row + 1];
    mean = s1 * (1.f / DM); const float var = fmaxf(s2 * (1.f / DM) - mean * mean, 0.f); rstd = rsqrtf(var + LN_EPS);
}
struct EpiSplit {
    static constexpr bool PERM = true, AFTER_DRAIN = false;
    bf16_t* P; const float* st; const float* c1; const float* c2;
    __device__ __forceinline__ void operator()(const f32x4 (&acc)[2][2][4][2], const Unit& u, int wr, int wc, int fr, int fq) const {
        const int row0 = u.pm * BM + wr * 64 + fr, col0 = u.pn * BM + wc * 32 + 8 * fq;
        f32x4 k1[2][2], k2[2][2];
        if (st) {
#pragma unroll
            for (int bj = 0; bj < 2; ++bj)
#pragma unroll
                for (int n = 0; n < 2; ++n) { k1[bj][n] = *(const f32x4*)(c1 + col0 + bj * HALF + 4 * n); k2[bj][n] = *(const f32x4*)(c2 + col0 + bj * HALF + 4 * n); } }
#pragma unroll
        for (int ai = 0; ai < 2; ++ai)
#pragma unroll
            for (int m = 0; m < 4; ++m) { const int row = row0 + ai * HALF + m * 16;
                float mean = 0.f, rstd = 1.f; if (st) row_stats(st, row, mean, rstd);
#pragma unroll
                for (int bj = 0; bj < 2; ++bj) { f32x4 v0 = acc[ai][bj][m][0], v1 = acc[ai][bj][m][1];
                    if (st) { v0 = (v0 - k1[bj][0] * mean) * rstd + k2[bj][0]; v1 = (v1 - k1[bj][1] * mean) * rstd + k2[bj][1]; }
                    u32x4 w; w.x = cvt_pk_bf16(v0[0], v0[1]); w.y = cvt_pk_bf16(v0[2], v0[3]); w.z = cvt_pk_bf16(v1[0], v1[1]); w.w = cvt_pk_bf16(v1[2], v1[3]);
                    *(u32x4*)(P + ((size_t)(u.pn * 2 + bj) * T + row) * 128 + wc * 32 + 8 * fq) = w; } }
    }
};
struct EpiBf16 {
    static constexpr bool PERM = true, AFTER_DRAIN = false;
    bf16_t* O; int ldc, nb0; long o_s1, o_s0; float scale; const float* st; const float* c1; const float* c2; float* rsum;
    __device__ __forceinline__ void operator()(const f32x4 (&acc)[2][2][4][2], const Unit& u, int wr, int wc, int fr, int fq) const {
        const int row0 = u.pm * BM + wr * 64 + fr, col0 = u.pn * BM + wc * 32 + 8 * fq;
        bf16_t* base = O + (size_t)(u.bz / nb0) * o_s1 + (size_t)(u.bz % nb0) * o_s0;
        f32x4 k1[2][2], k2[2][2];
        if (st) {
#pragma unroll
            for (int bj = 0; bj < 2; ++bj)
#pragma unroll
                for (int n = 0; n < 2; ++n) { k1[bj][n] = *(const f32x4*)(c1 + col0 + bj * HALF + 4 * n); k2[bj][n] = *(const f32x4*)(c2 + col0 + bj * HALF + 4 * n); } }
#pragma unroll
        for (int ai = 0; ai < 2; ++ai)
#pragma unroll
            for (int m = 0; m < 4; ++m) { const int row = row0 + ai * HALF + m * 16; bf16_t* rowp = base + (size_t)row * ldc + col0;
                float mean = 0.f, rstd = 1.f; if (st) row_stats(st, row, mean, rstd);
                float rs = 0.f;
#pragma unroll
                for (int bj = 0; bj < 2; ++bj) { f32x4 v0 = acc[ai][bj][m][0], v1 = acc[ai][bj][m][1];
                    if (st) { v0 = (v0 - k1[bj][0] * mean) * rstd + k2[bj][0]; v1 = (v1 - k1[bj][1] * mean) * rstd + k2[bj][1]; }
                    v0 = v0 * scale; v1 = v1 * scale;
                    u32x4 w; w.x = cvt_pk_bf16(v0[0], v0[1]); w.y = cvt_pk_bf16(v0[2], v0[3]); w.z = cvt_pk_bf16(v1[0], v1[1]); w.w = cvt_pk_bf16(v1[2], v1[3]);
                    *(u32x4*)(rowp + bj * HALF) = w;
                    if (rsum) rs += ((bf_lo(w.x) + bf_hi(w.x)) + (bf_lo(w.y) + bf_hi(w.y))) + ((bf_lo(w.z) + bf_hi(w.z)) + (bf_lo(w.w) + bf_hi(w.w))); }
                if (rsum) { rs += __shfl_xor(rs, 16); rs += __shfl_xor(rs, 32); if (fq == 0) unsafeAtomicAdd(rsum + u.bz * 256 + row, rs); } }
    }
};
struct EpiF32 {
    static constexpr bool PERM = false, AFTER_DRAIN = false;
    float* out; int ldc; long o_bs; float scale;
    __device__ __forceinline__ void operator()(const f32x4 (&acc)[2][2][4][2], const Unit& u, int wr, int wc, int fr, int fq) const {
        const int row0 = u.pm * BM + wr * 64 + fr, col0 = u.pn * BM + wc * 32 + 4 * fq;
        float* ob = out + (size_t)u.bz * o_bs;
#pragma unroll
        for (int ai = 0; ai < 2; ++ai)
#pragma unroll
            for (int m = 0; m < 4; ++m) { const size_t off = (size_t)(row0 + ai * HALF + m * 16) * ldc + col0;
#pragma unroll
                for (int bj = 0; bj < 2; ++bj)
#pragma unroll
                    for (int n = 0; n < 2; ++n) *(f32x4*)(ob + off + bj * HALF + n * 16) = acc[ai][bj][m][n] * scale; }
    }
};
struct EpiRes {
    static constexpr bool PERM = true, AFTER_DRAIN = false;
    float* X; const float* raw; const float* pst; const float* pg; const float* pb; bf16_t* ZB; float* cst; float alpha; int brows;
    __device__ __forceinline__ void operator()(const f32x4 (&acc)[2][2][4][2], const Unit& u, int wr, int wc, int fr, int fq) const {
        const int row0 = u.bz * brows + u.pm * BM + wr * 64 + fr, col0 = u.pn * BM + wc * 32 + 8 * fq;
        f32x4 gv[2][2], bv[2][2];
        if (!raw) {
#pragma unroll
            for (int bj = 0; bj < 2; ++bj)
#pragma unroll
                for (int n = 0; n < 2; ++n) { gv[bj][n] = *(const f32x4*)(pg + col0 + bj * HALF + 4 * n); bv[bj][n] = *(const f32x4*)(pb + col0 + bj * HALF + 4 * n); } }
#pragma unroll
        for (int ai = 0; ai < 2; ++ai)
#pragma unroll
            for (int m = 0; m < 4; ++m) { const int row = row0 + ai * HALF + m * 16; const size_t off = (size_t)row * DM + col0;
                float mean = 0.f, rstd = 1.f; if (!raw) row_stats(pst, row, mean, rstd);
                float s1 = 0.f, s2 = 0.f;
#pragma unroll
                for (int bj = 0; bj < 2; ++bj) { f32x4 r0, r1;
                    if (raw) { r0 = *(const f32x4*)(raw + off + bj * HALF); r1 = *(const f32x4*)(raw + off + bj * HALF + 4); }
                    else { const u32x4 zw = *(const u32x4*)(ZB + off + bj * HALF);
                        r0 = (f32x4){bf_lo(zw.x), bf_hi(zw.x), bf_lo(zw.y), bf_hi(zw.y)}; r1 = (f32x4){bf_lo(zw.z), bf_hi(zw.z), bf_lo(zw.w), bf_hi(zw.w)};
                        r0 = (r0 - mean) * rstd * gv[bj][0] + bv[bj][0]; r1 = (r1 - mean) * rstd * gv[bj][1] + bv[bj][1]; }
                    const f32x4 z0 = acc[ai][bj][m][0] + r0 * alpha, z1 = acc[ai][bj][m][1] + r1 * alpha;
                    if (X) { *(f32x4*)(X + off + bj * HALF) = z0; *(f32x4*)(X + off + bj * HALF + 4) = z1; }
                    u32x4 w; w.x = cvt_pk_bf16(z0[0], z0[1]); w.y = cvt_pk_bf16(z0[2], z0[3]); w.z = cvt_pk_bf16(z1[0], z1[1]); w.w = cvt_pk_bf16(z1[2], z1[3]);
                    *(u32x4*)(ZB + off + bj * HALF) = w;
                    s1 += ((z0[0] + z0[1]) + (z0[2] + z0[3])) + ((z1[0] + z1[1]) + (z1[2] + z1[3]));
                    s2 += ((z0[0] * z0[0] + z0[1] * z0[1]) + (z0[2] * z0[2] + z0[3] * z0[3])) + ((z1[0] * z1[0] + z1[1] * z1[1]) + (z1[2] * z1[2] + z1[3] * z1[3])); }
                s1 += __shfl_xor(s1, 16); s1 += __shfl_xor(s1, 32); s2 += __shfl_xor(s2, 16); s2 += __shfl_xor(s2, 32);
                if (fq == 0) { unsafeAtomicAdd(cst + 2 * row, s1); unsafeAtomicAdd(cst + 2 * row + 1, s2); } }
    }
};
struct EpiSwiglu {
    static constexpr bool PERM = true, AFTER_DRAIN = false;
    bf16_t* H; const float* st; const float* c1; const float* c2;
    __device__ __forceinline__ void operator()(const f32x4 (&acc)[2][2][4][2], const Unit& u, int wr, int wc, int fr, int fq) const {
        const int row0 = u.pm * BM + wr * 64 + fr, col0 = u.pn * HALF + wc * 32 + 8 * fq, ccol0 = u.pn * BM + wc * 32 + 8 * fq;
        f32x4 k1[2][2], k2[2][2];
#pragma unroll
        for (int bj = 0; bj < 2; ++bj)
#pragma unroll
            for (int n = 0; n < 2; ++n) { k1[bj][n] = *(const f32x4*)(c1 + ccol0 + bj * HALF + 4 * n); k2[bj][n] = *(const f32x4*)(c2 + ccol0 + bj * HALF + 4 * n); }
#pragma unroll
        for (int ai = 0; ai < 2; ++ai)
#pragma unroll
            for (int m = 0; m < 4; ++m) { const int row = row0 + ai * HALF + m * 16; bf16_t* rowp = H + (size_t)row * DFF + col0;
                float mean, rstd; row_stats(st, row, mean, rstd);
                float h[8];
#pragma unroll
                for (int n = 0; n < 2; ++n) { const f32x4 gq = (acc[ai][0][m][n] - k1[0][n] * mean) * rstd + k2[0][n], uq = (acc[ai][1][m][n] - k1[1][n] * mean) * rstd + k2[1][n];
#pragma unroll
                    for (int j = 0; j < 4; ++j) h[n * 4 + j] = gq[j] * __builtin_amdgcn_rcpf(1.f + __expf(-gq[j])) * uq[j]; }
                u32x4 w; w.x = cvt_pk_bf16(h[0], h[1]); w.y = cvt_pk_bf16(h[2], h[3]); w.z = cvt_pk_bf16(h[4], h[5]); w.w = cvt_pk_bf16(h[6], h[7]);
                *(u32x4*)rowp = w; }
    }
};

struct EpiSoftmax {
    static constexpr bool PERM = true, AFTER_DRAIN = true;
    bf16_t* PALL; const float* st; const float* c1; const float* c2; float scale;
    __device__ __forceinline__ void fused(f32x4 (&acc)[2][2][4][2], const Unit& u, int wr, int wc, int fr, int fq, LAS unsigned char* lds) const {
        const int b = u.bz >> 2, h = u.bz & 3, rl0 = wr * 64 + fr, cc0 = wc * 32 + 8 * fq;
        LAS float* PMX = (LAS float*)lds; LAS float* PSM = PMX + 1024;
        f32x4 k1[2][2], k2[2][2];
#pragma unroll
        for (int bj = 0; bj < 2; ++bj)
#pragma unroll
            for (int n = 0; n < 2; ++n) { k1[bj][n] = *(const f32x4*)(c1 + u.bz * 256 + cc0 + bj * HALF + 4 * n); k2[bj][n] = *(const f32x4*)(c2 + u.bz * 256 + cc0 + bj * HALF + 4 * n); }
#pragma unroll
        for (int ai = 0; ai < 2; ++ai)
#pragma unroll
            for (int m = 0; m < 4; ++m) { const int rl = rl0 + ai * HALF + m * 16, row = b * SEQ + u.pm * BM + rl;
                float mean, rstd; row_stats(st, row, mean, rstd);
                float mx = -__builtin_inff();
#pragma unroll
                for (int bj = 0; bj < 2; ++bj)
#pragma unroll
                    for (int n = 0; n < 2; ++n) { const f32x4 v = ((acc[ai][bj][m][n] - k1[bj][n] * mean) * rstd + k2[bj][n]) * scale; acc[ai][bj][m][n] = v;
                        mx = fmaxf(mx, fmaxf(fmaxf(v[0], v[1]), fmaxf(v[2], v[3]))); }
                mx = fmaxf(mx, __shfl_xor(mx, 16)); mx = fmaxf(mx, __shfl_xor(mx, 32));
                if (fq == 0) PMX[rl * 4 + wc] = mx; }
        asm volatile("s_waitcnt lgkmcnt(0)" ::: "memory"); __builtin_amdgcn_s_barrier(); asm volatile("" ::: "memory");
#pragma unroll
        for (int ai = 0; ai < 2; ++ai)
#pragma unroll
            for (int m = 0; m < 4; ++m) { const int rl = rl0 + ai * HALF + m * 16;
                const f32x4 q = *(const LAS f32x4*)(PMX + rl * 4); const float mx = fmaxf(fmaxf(q[0], q[1]), fmaxf(q[2], q[3]));
                float sm = 0.f;
#pragma unroll
                for (int bj = 0; bj < 2; ++bj)
#pragma unroll
                    for (int n = 0; n < 2; ++n) { f32x4 e = acc[ai][bj][m][n] - mx; e[0] = __expf(e[0]); e[1] = __expf(e[1]); e[2] = __expf(e[2]); e[3] = __expf(e[3]); acc[ai][bj][m][n] = e;
                        sm += (e[0] + e[1]) + (e[2] + e[3]); }
                sm += __shfl_xor(sm, 16); sm += __shfl_xor(sm, 32);
                if (fq == 0) PSM[rl * 4 + wc] = sm; }
        asm volatile("s_waitcnt lgkmcnt(0)" ::: "memory"); __builtin_amdgcn_s_barrier(); asm volatile("" ::: "memory");
#pragma unroll
        for (int ai = 0; ai < 2; ++ai)
#pragma unroll
            for (int m = 0; m < 4; ++m) { const int rl = rl0 + ai * HALF + m * 16, row = b * SEQ + u.pm * BM + rl;
                const f32x4 q = *(const LAS f32x4*)(PSM + rl * 4); const float inv = __builtin_amdgcn_rcpf((q[0] + q[1]) + (q[2] + q[3]));
                bf16_t* rowp = PALL + (size_t)row * 1024 + h * 256 + cc0;
#pragma unroll
                for (int bj = 0; bj < 2; ++bj) { const f32x4 v0 = acc[ai][bj][m][0] * inv, v1 = acc[ai][bj][m][1] * inv;
                    u32x4 w; w.x = cvt_pk_bf16(v0[0], v0[1]); w.y = cvt_pk_bf16(v0[2], v0[3]); w.z = cvt_pk_bf16(v1[0], v1[1]); w.w = cvt_pk_bf16(v1[2], v1[3]);
                    *(u32x4*)(rowp + bj * HALF) = w; } }
    }
};

template <class Epi, bool ALIGN_EPI>
__device__ __forceinline__ void gemm_phase(LAS unsigned char* lds, const Gemm g, const Order& S, const Epi& E) {
    const int tid = ltid(), wid = __builtin_amdgcn_readfirstlane(tid >> 6), lane = tid & 63, wr = wid >> 2, wc = wid & 3, fr = lane & 15, fq = lane >> 4;
    const int K = g.K, nt = K / BK;
    unsigned voffA[2], voffB[2];
#pragma unroll
    for (int i = 0; i < 2; ++i) { int R, C; stage_rc(tid * 16 + i * 8192, R, C); const int Rb = Epi::PERM ? ((R & ~31) + perm32(R & 31)) : R;
        voffA[i] = (unsigned)(R * g.lda + C) * 2u; voffB[i] = (unsigned)(Rb * g.ldb + C) * 2u; }
    const size_t kstep = (size_t)(BK * 2);
    const size_t hstepA = (size_t)HALF * g.lda * 2, hstepB = (size_t)HALF * g.ldb * 2;
    const unsigned ldsw = (unsigned)wid * 1024u;
    const int aoff = lds_byte(wr * 64 + fr, fq * 8), boff = lds_byte(wc * 32 + fr, fq * 8);
#define PG8_SA(b, h) (((b) * 2 + (h)) * HTB)
#define PG8_SB(b, h) ((4 + (b) * 2 + (h)) * HTB)
#define PG8_STAGE(bufoff, gbase, voff) do { _Pragma("unroll") for (int _i = 0; _i < 2; ++_i) \
        __builtin_amdgcn_global_load_lds((const unsigned*)((const char*)(gbase) + (voff)[_i]), (LAS unsigned*)(lds + (bufoff) + ldsw + _i * 8192), 16, 0, 0); } while (0)
#define PG8_LDA(dst, b, h) do { _Pragma("unroll") for (int m = 0; m < 4; ++m) _Pragma("unroll") for (int k = 0; k < 2; ++k) dst[m][k] = *(const LAS bf16x8*)(lds + PG8_SA(b, h) + aoff + m * 2048 + k * 1024); } while (0)
#define PG8_LDB(dst, b, h) do { _Pragma("unroll") for (int n = 0; n < 2; ++n) _Pragma("unroll") for (int k = 0; k < 2; ++k) dst[n][k] = *(const LAS bf16x8*)(lds + PG8_SB(b, h) + boff + n * 2048 + k * 1024); } while (0)
#define PG8_MMA(ai, bj, At, Bt) do { __builtin_amdgcn_s_setprio(1); _Pragma("unroll") for (int m = 0; m < 4; ++m) _Pragma("unroll") for (int n = 0; n < 2; ++n) _Pragma("unroll") for (int k = 0; k < 2; ++k) \
        acc[ai][bj][m][n] = __builtin_amdgcn_mfma_f32_16x16x32_bf16(Bt[n][k], At[m][k], acc[ai][bj][m][n], 0, 0, 0); __builtin_amdgcn_s_setprio(0); } while (0)
#define PG8_WAIT_V(n) asm volatile("s_waitcnt vmcnt(" #n ")" ::: "memory")
#define PG8_WAIT_L(n) asm volatile("s_waitcnt lgkmcnt(" #n ")" ::: "memory")
#define PG8_BAR __builtin_amdgcn_s_barrier()
#define PG8_SCHED __builtin_amdgcn_sched_barrier(0)
    Unit cur, nxt; int ui = 0;
    if (!S.next(0, cur)) return;
    f32x4 acc[2][2][4][2];
#pragma unroll
    for (int a = 0; a < 2; ++a)
#pragma unroll
        for (int b = 0; b < 2; ++b)
#pragma unroll
            for (int m = 0; m < 4; ++m)
#pragma unroll
                for (int n = 0; n < 2; ++n) acc[a][b][m][n] = (f32x4){0.f, 0.f, 0.f, 0.f};
    bf16x8 At[4][2], B0[2][2], B1[2][2];
    const char* cA = unit_a(g, cur); const char* cB = unit_b(g, cur);
    PG8_STAGE(PG8_SB(0, 0), cB, voffB); PG8_STAGE(PG8_SB(0, 1), cB + hstepB, voffB); PG8_STAGE(PG8_SA(0, 0), cA, voffA); PG8_STAGE(PG8_SA(0, 1), cA + hstepA, voffA);
    if (wr == 1) PG8_BAR;
    PG8_WAIT_V(2); PG8_BAR;
    PG8_STAGE(PG8_SB(1, 0), cB + kstep, voffB); PG8_STAGE(PG8_SA(1, 0), cA + kstep, voffA); PG8_STAGE(PG8_SB(1, 1), cB + hstepB + kstep, voffB);
    PG8_WAIT_V(6); PG8_BAR;
    for (;;) {
        const bool has_next = S.next(ui + 1, nxt);
        const char* nA = has_next ? unit_a(g, nxt) : cA; const char* nB = has_next ? unit_b(g, nxt) : cB;
        for (int t = 0; t < nt; t += 2) {
            const bool last = (t == nt - 2);
            const char* a1 = cA + (size_t)(t + 1) * kstep;
            const char* a2 = last ? nA : cA + (size_t)(t + 2) * kstep; const char* b2 = last ? nB : cB + (size_t)(t + 2) * kstep;
            const char* a3 = a2 + kstep; const char* b3 = b2 + kstep;
            PG8_LDB(B0, 0, 0); PG8_LDB(B1, 0, 1); PG8_SCHED; PG8_LDA(At, 0, 0); PG8_STAGE(PG8_SA(1, 1), a1 + hstepA, voffA);
            PG8_WAIT_V(8); PG8_WAIT_L(0); PG8_BAR; PG8_MMA(0, 0, At, B0); PG8_MMA(0, 1, At, B1); PG8_BAR; PG8_SCHED;
            PG8_LDA(At, 0, 1); PG8_STAGE(PG8_SB(0, 0), b2, voffB); PG8_STAGE(PG8_SB(0, 1), b2 + hstepB, voffB); PG8_STAGE(PG8_SA(0, 0), a2, voffA);
            PG8_WAIT_V(8); PG8_WAIT_L(0); PG8_BAR; PG8_MMA(1, 0, At, B0); PG8_MMA(1, 1, At, B1); PG8_BAR; PG8_SCHED;
            PG8_LDB(B0, 1, 0); PG8_LDB(B1, 1, 1); PG8_SCHED; PG8_LDA(At, 1, 0); PG8_STAGE(PG8_SA(0, 1), a2 + hstepA, voffA);
            PG8_WAIT_V(8); PG8_WAIT_L(0); PG8_BAR; PG8_MMA(0, 0, At, B0); PG8_MMA(0, 1, At, B1); PG8_BAR; PG8_SCHED;
            PG8_LDA(At, 1, 1); PG8_STAGE(PG8_SB(1, 0), b3, voffB); PG8_STAGE(PG8_SB(1, 1), b3 + hstepB, voffB); PG8_STAGE(PG8_SA(1, 0), a3, voffA);
            PG8_WAIT_V(8); PG8_WAIT_L(0); PG8_BAR; PG8_MMA(1, 0, At, B0); PG8_MMA(1, 1, At, B1); PG8_BAR; PG8_SCHED;
        }
        if constexpr (ALIGN_EPI) { if (wr == 0) PG8_BAR; }
        if constexpr (!Epi::AFTER_DRAIN) E(acc, cur, wr, wc, fr, fq);
        if (!has_next) break;
#pragma unroll
        for (int a = 0; a < 2; ++a)
#pragma unroll
            for (int b = 0; b < 2; ++b)
#pragma unroll
                for (int m = 0; m < 4; ++m)
#pragma unroll
                    for (int n = 0; n < 2; ++n) acc[a][b][m][n] = (f32x4){0.f, 0.f, 0.f, 0.f};
        cur = nxt; cA = nA; cB = nB; ++ui;
        if constexpr (ALIGN_EPI) { if (wr == 1) PG8_BAR; }
    }
    PG8_WAIT_V(0);
    if constexpr (!ALIGN_EPI) { if (wr == 0) PG8_BAR; }
    PG8_BAR;
    if constexpr (Epi::AFTER_DRAIN) E.fused(acc, cur, wr, wc, fr, fq, lds);
#undef PG8_SA
#undef PG8_SB
#undef PG8_STAGE
#undef PG8_LDA
#undef PG8_LDB
#undef PG8_MMA
#undef PG8_WAIT_V
#undef PG8_WAIT_L
#undef PG8_BAR
#undef PG8_SCHED
}
}

namespace att {
using bf16 = __hip_bfloat16;
typedef short s16x4 __attribute__((ext_vector_type(4)));
constexpr int D = 128;
constexpr float THR = 8.f;
constexpr float SCALE = 0.08838834764831845f;
constexpr int NW = 8, QBLK = 32, KVBLK = 64, QB = NW * QBLK;
constexpr int SHM_V = KVBLK * D * 2, SHM_K = KVBLK * D * 2;
constexpr int ATT_LDS = 2 * SHM_V + 2 * SHM_K + NW * 64 * 4;
constexpr int BT_OFF = ATT_LDS;

#define KSWZ(row, colB) ((row) * 256 + ((colB) ^ (((row) & 7) << 4)))
#define SBAR() __builtin_amdgcn_sched_barrier(0)
__device__ __forceinline__ int v_st(int k, int c) { const int kk = (k & ~0xC) | ((k & 4) << 1) | ((k & 8) >> 1); return ((kk >> 3) * 4 + (c >> 5)) * 512 + ((kk & 7) * 32 + (c & 31)) * 2; }
__device__ __forceinline__ int v_rd_base(int lane) { return ((lane & 3) << 3) | (((lane >> 2) & 3) << 6) | (((lane >> 4) & 1) << 5) | (((lane >> 5) & 1) << 8); }
constexpr int v_rd_off(int d0, int ks, int half) { return d0 * 512 + ks * 4096 + half * 2048; }
__device__ __forceinline__ int crow(int r, int hi) { return (r & 3) + 8 * (r >> 2) + 4 * hi; }
__device__ __forceinline__ unsigned cvtpk(float lo, float hi) { unsigned r; asm volatile("v_cvt_pk_bf16_f32 %0, %1, %2" : "=v"(r) : "v"(lo), "v"(hi)); return r; }
__device__ __forceinline__ bf16x8 load8(const bf16* p) { return *reinterpret_cast<const bf16x8*>(p); }
__device__ __forceinline__ void bias_mask_tile(f32x16& p0, f32x16& p1, int dq, const float* bt) {
    const float NEG = -__builtin_inff();
#pragma unroll
    for (int r = 0; r < 16; ++r) {
        const int c = (r & 3) + 8 * (r >> 2);
        const int d0 = dq - c, d1 = dq - c - 32;
        const unsigned i0 = (unsigned)d0 < 255u ? (unsigned)d0 : 255u, i1 = (unsigned)d1 < 255u ? (unsigned)d1 : 255u;
        const float b0 = bt[i0], b1 = bt[i1];
        p0[r] = d0 >= 0 ? p0[r] + b0 : NEG;
        p1[r] = d1 >= 0 ? p1[r] + b1 : NEG;
    }
}
__device__ __forceinline__ void partialSM(f32x16& p0, f32x16& p1, float& m_reg, float& mn, float& alpha) {
    float pmax = p0[0]; for (int r = 1; r < 16; ++r) pmax = fmaxf(pmax, p0[r]); for (int r = 0; r < 16; ++r) pmax = fmaxf(pmax, p1[r]);
    { auto rr = __builtin_amdgcn_permlane32_swap(__float_as_uint(pmax), __float_as_uint(pmax), false, false);
      pmax = fmaxf(__uint_as_float(rr[0]), __uint_as_float(rr[1])); }
    constexpr float C2 = 1.4426950408889634f * SCALE;
    if (__builtin_expect(__all((pmax - m_reg) * SCALE <= THR), 1)) { mn = m_reg; alpha = 1.f; }
    else { mn = fmaxf(m_reg, pmax); alpha = __builtin_amdgcn_exp2f((m_reg - mn) * C2); m_reg = mn; }
    const float mnL = -mn * C2;
    for (int r = 0; r < 16; ++r) p0[r] = fmaf(p0[r], C2, mnL); for (int r = 0; r < 16; ++r) p1[r] = fmaf(p1[r], C2, mnL);
    for (int r = 0; r < 16; ++r) p0[r] = __builtin_amdgcn_exp2f(p0[r]);
}
__device__ __forceinline__ void finishSM(f32x16& p0, f32x16& p1, float alpha, float& l_reg, bf16x8& pa0, bf16x8& pa1, bf16x8& pa2, bf16x8& pa3) {
    for (int r = 0; r < 16; ++r) p1[r] = __builtin_amdgcn_exp2f(p1[r]);
    float ps = 0; for (int r = 0; r < 16; ++r) ps += p0[r]; for (int r = 0; r < 16; ++r) ps += p1[r];
    { auto rr = __builtin_amdgcn_permlane32_swap(__float_as_uint(ps), __float_as_uint(ps), false, false);
      ps = __uint_as_float(rr[0]) + __uint_as_float(rr[1]); }
    l_reg = l_reg * alpha + ps;
#define PK4(P, B_, OUT) do { unsigned a0 = cvtpk(P[B_+0], P[B_+1]), a1 = cvtpk(P[B_+2], P[B_+3]);                          \
        unsigned b0 = cvtpk(P[B_+4], P[B_+5]), b1 = cvtpk(P[B_+6], P[B_+7]);                                             \
        auto r0 = __builtin_amdgcn_permlane32_swap(a0, b0, false, false); auto r1 = __builtin_amdgcn_permlane32_swap(a1, b1, false, false); \
        u32x4 w = {r0[0], r1[0], r0[1], r1[1]}; OUT = *reinterpret_cast<bf16x8*>(&w); } while (0)
    PK4(p0, 0, pa0); PK4(p0, 8, pa1); PK4(p1, 0, pa2); PK4(p1, 8, pa3);
#undef PK4
}
template <int KB>
__device__ __forceinline__ void qkt(f32x16& p0, f32x16& p1, const char* K_lds, int r32, int hi, const bf16x8* qr) {
    p0 = f32x16{}; p1 = f32x16{};
    const char* kb[4];
#pragma unroll
    for (int dd = 0; dd < 4; ++dd) kb[dd] = K_lds + KB * SHM_K + KSWZ(r32, (dd * 16 + hi * 8) * 2);
#pragma unroll
    for (int d0 = 0; d0 < 8; ++d0) { const char* a = kb[d0 & 3] + (d0 >> 2) * 128;
        bf16x8 b0 = *reinterpret_cast<const bf16x8*>(a);
        bf16x8 b1 = *reinterpret_cast<const bf16x8*>(a + 32 * 256);
        p0 = __builtin_amdgcn_mfma_f32_32x32x16_bf16(b0, qr[d0], p0, 0, 0, 0);
        p1 = __builtin_amdgcn_mfma_f32_32x32x16_bf16(b1, qr[d0], p1, 0, 0, 0); }
}
template <int VB>
__device__ __forceinline__ void pv_tile(f32x16* o, int vb0, bf16x8 pa0, bf16x8 pa1, bf16x8 pa2, bf16x8 pa3) {
#define TRRD(dst, off) asm volatile("ds_read_b64_tr_b16 %0, %1 offset:%2" : "=&v"(dst) : "v"(vb0), "i"(off) : "memory")
#define PV_D0(d0) do { s16x4 l0, l1, l2, l3, h0, h1, h2, h3; constexpr int b_ = VB * SHM_V + v_rd_off(d0, 0, 0); \
        TRRD(l0, b_); TRRD(h0, b_ + 2048); TRRD(l1, b_ + 4096); TRRD(h1, b_ + 6144); TRRD(l2, b_ + 8192); TRRD(h2, b_ + 10240); TRRD(l3, b_ + 12288); TRRD(h3, b_ + 14336); \
        asm volatile("s_waitcnt lgkmcnt(0)" ::: "memory"); SBAR();   \
        o[d0] = __builtin_amdgcn_mfma_f32_32x32x16_bf16(pa0, (bf16x8){l0[0], l0[1], l0[2], l0[3], h0[0], h0[1], h0[2], h0[3]}, o[d0], 0, 0, 0);   \
        o[d0] = __builtin_amdgcn_mfma_f32_32x32x16_bf16(pa1, (bf16x8){l1[0], l1[1], l1[2], l1[3], h1[0], h1[1], h1[2], h1[3]}, o[d0], 0, 0, 0);   \
        o[d0] = __builtin_amdgcn_mfma_f32_32x32x16_bf16(pa2, (bf16x8){l2[0], l2[1], l2[2], l2[3], h2[0], h2[1], h2[2], h2[3]}, o[d0], 0, 0, 0);   \
        o[d0] = __builtin_amdgcn_mfma_f32_32x32x16_bf16(pa3, (bf16x8){l3[0], l3[1], l3[2], l3[3], h3[0], h3[1], h3[2], h3[3]}, o[d0], 0, 0, 0); } while (0)
    PV_D0(0); PV_D0(1); PV_D0(2); PV_D0(3);
#undef PV_D0
#undef TRRD
}
struct BlockRef { const bf16* Q; const bf16* K; const bf16* V; float* O; int P0; int hm; };
struct Seam { bf16x8 qr[8]; bf16x8 st_v0, st_v1, st_k0, st_k1; };
#define ROW(p, k0, rr) ((p) + (size_t)((k0) + (rr)) * D + sc)
#define VMW() asm volatile("s_waitcnt vmcnt(0)" ::: "memory")
#define VMWN(n) asm volatile("s_waitcnt vmcnt(%0)" :: "i"(n) : "memory")
#define SLOAD_H(Kp, Vp, k0) do { S.st_v0 = load8(ROW(Vp, k0, sr)); S.st_v1 = load8(ROW(Vp, k0, 32 + sr));              \
                         S.st_k0 = load8(ROW(Kp, k0, sr)); S.st_k1 = load8(ROW(Kp, k0, 32 + sr)); } while (0)
#define SWRITE_HK(bf) do { *(bf16x8*)(K_lds + (bf) * SHM_K + kws) = S.st_k0; *(bf16x8*)(K_lds + (bf) * SHM_K + kws + 32 * 256) = S.st_k1; } while (0)
#define SWRITE_HV(bf) do { *(bf16x8*)(V_lds + (bf) * SHM_V + vst0) = S.st_v0; *(bf16x8*)(V_lds + (bf) * SHM_V + vst1) = S.st_v1; } while (0)
#define SWRITE_H(bf) do { SWRITE_HV(bf); SWRITE_HK(bf); } while (0)
__device__ __forceinline__ void attn_prime(const BlockRef& cur, char* lds, Seam& S) {
    const int tid = ltid(), wid = __builtin_amdgcn_readfirstlane(tid >> 6), lane = tid & 63, r32 = lane & 31, hi = lane >> 5;
    const int sr = tid >> 4, sc = (tid & 15) * 8, kws = KSWZ(sr, sc * 2); char* K_lds = lds + 2 * SHM_V;
    const int kb0 = 0;
    for (int d0 = 0; d0 < 8; ++d0) S.qr[d0] = load8(cur.Q + (size_t)(wid * QBLK + r32) * D + d0 * 16 + hi * 8);
    SLOAD_H(cur.K, cur.V, kb0); VMW(); SWRITE_HK(0);
    __syncthreads();
}
__device__ __forceinline__ void attn_block(const BlockRef& cur, const BlockRef& nxt, char* lds, Seam& S) {
    const int tid = ltid(), wid = __builtin_amdgcn_readfirstlane(tid >> 6), lane = tid & 63, r32 = lane & 31, hi = lane >> 5;
    const int j_lo = 0;
    const int j_hi = (cur.P0 + QB - 1) / KVBLK + 1;
    const int NT = j_hi - j_lo;
    const int kbn = 0;
    const int qlo = cur.P0 + wid * QBLK, qm = qlo + r32 - 4 * hi;
    char* V_lds = lds; char* K_lds = lds + 2 * SHM_V;
    float* ws = (float*)(lds + 2 * SHM_V + 2 * SHM_K) + wid * 64; float* li_l = ws, * al_l = ws + 32;
    const float* bt = (const float*)(lds + BT_OFF) + cur.hm * 256;
    float m_reg = -1e30f, l_reg = 0; f32x16 o[4] = {};
    const int sr = tid >> 4, sc = (tid & 15) * 8, vst0 = v_st(sr, sc), vst1 = v_st(32 + sr, sc), kws = KSWZ(sr, sc * 2);
    const int vb0 = (int)(uintptr_t)V_lds + v_rd_base(lane);
    const bf16* Kh = cur.K; const bf16* Vh = cur.V;
#define RESC(a) do { if (__any((a) < 1.f)) { if (hi == 0) al_l[r32] = (a); asm volatile("s_waitcnt lgkmcnt(0)" ::: "memory");              \
                     for (int d_ = 0; d_ < 4; ++d_) for (int r = 0; r < 16; ++r) o[d_][r] *= al_l[crow(r, hi)]; } } while (0)
#define KBASE(t) ((j_lo + (t)) * KVBLK)
#define MASKT(P0_, P1_, t) do { const int kb_ = KBASE(t); if (kb_ + KVBLK - 1 > qlo - 128) bias_mask_tile(P0_, P1_, qm - kb_, bt); } while (0)
    constexpr int NQL = 8;
#define SEAM_K0() do { VMWN(NQL); SWRITE_HK(0); SBAR(); } while (0)
    f32x16 pA0, pA1, pB0, pB1; float mnA, mnB, alA, alB; bf16x8 pa0, pa1, pa2, pa3;
    SWRITE_HV(0); SBAR();
    if (NT > 1) { SLOAD_H(Kh, Vh, KBASE(1)); }
    SBAR(); qkt<0>(pA0, pA1, K_lds, r32, hi, S.qr);
    MASKT(pA0, pA1, 0); partialSM(pA0, pA1, m_reg, mnA, alA);
    if (NT > 1) { VMW(); SWRITE_H(1); }
    __syncthreads();
#define HALF_STEP(PX0, PX1, mnX, alX, PY0, PY1, alY, t, KB, VB, SB) do {                                                      \
        SBAR(); qkt<KB>(PX0, PX1, K_lds, r32, hi, S.qr);                                             \
        finishSM(PY0, PY1, alY, l_reg, pa0, pa1, pa2, pa3); SBAR();                                                           \
        if ((t) + 1 < NT) { SLOAD_H(Kh, Vh, KBASE((t) + 1)); SBAR(); }                                               \
        pv_tile<VB>(o, vb0, pa0, pa1, pa2, pa3); MASKT(PX0, PX1, (t)); partialSM(PX0, PX1, m_reg, mnX, alX);                                        \
        __syncthreads();                                                                                                      \
        if ((t) + 1 < NT) { VMW(); SWRITE_H(SB); }                                                                          \
        RESC(alX); __syncthreads(); } while (0)
    for (int t = 1; t + 1 < NT; t += 2) {
        HALF_STEP(pB0, pB1, mnB, alB, pA0, pA1, alA, t, 1, 0, 0);
        HALF_STEP(pA0, pA1, mnA, alA, pB0, pB1, alB, t + 1, 0, 1, 1);
    }
    const bool even = (NT & 1) == 0;
    if (even) { SBAR(); qkt<1>(pB0, pB1, K_lds, r32, hi, S.qr); SBAR(); }
    SLOAD_H(nxt.K, nxt.V, kbn); SBAR();
#pragma unroll
    for (int d0 = 0; d0 < 8; ++d0) S.qr[d0] = load8(nxt.Q + (size_t)(wid * QBLK + r32) * D + d0 * 16 + hi * 8);
    SBAR();
    finishSM(pA0, pA1, alA, l_reg, pa0, pa1, pa2, pa3); SBAR();
    pv_tile<0>(o, vb0, pa0, pa1, pa2, pa3);
    if (even) { MASKT(pB0, pB1, NT - 1); partialSM(pB0, pB1, m_reg, mnB, alB); __syncthreads(); RESC(alB);
        finishSM(pB0, pB1, alB, l_reg, pa0, pa1, pa2, pa3); SBAR(); pv_tile<1>(o, vb0, pa0, pa1, pa2, pa3); }
    SBAR(); SEAM_K0();
    if (hi == 0) li_l[r32] = l_reg; asm volatile("s_waitcnt lgkmcnt(0)" ::: "memory");
    float rli[16];
#pragma unroll
    for (int r = 0; r < 16; ++r) rli[r] = __builtin_amdgcn_rcpf(li_l[crow(r, hi)]);
    float* Ow = cur.O + (size_t)(wid * QBLK) * D;
#pragma unroll
    for (int r = 0; r < 16; ++r) { const int orow = crow(r, hi);
#pragma unroll
        for (int d0 = 0; d0 < 4; ++d0) { const float v = o[d0][r] * rli[r]; Ow[(size_t)orow * D + d0 * 32 + r32] = v; } }
    __syncthreads();
#undef RESC
#undef KBASE
#undef MASKT
#undef SEAM_K0
#undef HALF_STEP
}
#undef ROW
#undef VMW
#undef VMWN
#undef SLOAD_H
#undef SWRITE_HK
#undef SWRITE_HV
#undef SWRITE_H
}

namespace att2 {
using att::bf16; using att::D; using att::SHM_K; using att::SHM_V;
constexpr int L_V = 0, L_K = 65536, L_P = 98304, L_AL = 131072, L_FL = 132096, L_LB = 132224, L_BT = 133120;
struct Blk { const bf16* Q; const bf16* K; const bf16* V0; const bf16* V1; float* O0; float* O1; int P0; int hm; };
__device__ __forceinline__ void qkt_rt(f32x16& p0, f32x16& p1, const char* Kb, int r32, int hi, const bf16x8* qr) {
    p0 = f32x16{}; p1 = f32x16{};
    const char* kb[4];
#pragma unroll
    for (int dd = 0; dd < 4; ++dd) kb[dd] = Kb + KSWZ(r32, (dd * 16 + hi * 8) * 2);
#pragma unroll
    for (int d0 = 0; d0 < 8; ++d0) { const char* a = kb[d0 & 3] + (d0 >> 2) * 128;
        bf16x8 b0 = *reinterpret_cast<const bf16x8*>(a);
        bf16x8 b1 = *reinterpret_cast<const bf16x8*>(a + 32 * 256);
        p0 = __builtin_amdgcn_mfma_f32_32x32x16_bf16(b0, qr[d0], p0, 0, 0, 0);
        p1 = __builtin_amdgcn_mfma_f32_32x32x16_bf16(b1, qr[d0], p1, 0, 0, 0); }
}
#define A2_LOADT(t) do { const size_t ro_ = (size_t)((t) * 64 + sr) * D + sc; \
        sk0 = att::load8(c.K + ro_); sk1 = att::load8(c.K + ro_ + 32 * D); sv00 = att::load8(c.V0 + ro_); sv01 = att::load8(c.V0 + ro_ + 32 * D); sv10 = att::load8(c.V1 + ro_); sv11 = att::load8(c.V1 + ro_ + 32 * D); } while (0)
#define A2_WRITET(buf) do { char* kd_ = lds + L_K + (buf) * SHM_K; char* vd_ = lds + L_V + (buf) * 2 * SHM_V; \
        *(bf16x8*)(kd_ + kws) = sk0; *(bf16x8*)(kd_ + kws + 32 * 256) = sk1; *(bf16x8*)(vd_ + vst0) = sv00; *(bf16x8*)(vd_ + vst1) = sv01; *(bf16x8*)(vd_ + SHM_V + vst0) = sv10; *(bf16x8*)(vd_ + SHM_V + vst1) = sv11; } while (0)
__device__ __forceinline__ void attn2_block(const Blk& c, char* lds) {
    const int tid = ltid(), wid = __builtin_amdgcn_readfirstlane(tid >> 6), lane = tid & 63, r32 = lane & 31, hi = lane >> 5;
    const int g = wid & 3;
    const int NT = (c.P0 + 127) / 64 + 1;
    const int sr = tid >> 4, sc = (tid & 15) * 8, kws = KSWZ(sr, sc * 2), vst0 = att::v_st(sr, sc), vst1 = att::v_st(32 + sr, sc);
    bf16x8 sk0, sk1, sv00, sv01, sv10, sv11;
    float* ALb = (float*)(lds + L_AL) + g * 64; unsigned* FLb = (unsigned*)(lds + L_FL) + g * 2; float* LBb = (float*)(lds + L_LB) + g * 32;
    char* Pb = lds + L_P + g * 8192;
    A2_LOADT(0);
    if (wid < 4) {
        bf16x8 qr[8];
#pragma unroll
        for (int d0 = 0; d0 < 8; ++d0) qr[d0] = att::load8(c.Q + (size_t)(g * 32 + r32) * D + d0 * 16 + hi * 8);
        asm volatile("s_waitcnt vmcnt(0)" ::: "memory"); A2_WRITET(0); __syncthreads();
        const int qlo = c.P0 + g * 32, qm = qlo + r32 - 4 * hi;
        const float* bt = (const float*)(lds + L_BT) + c.hm * 256;
        float m_reg = -1e30f, l_reg = 0.f;
        for (int s = 0; s <= NT; ++s) {
            const int par = s & 1;
            if (s + 1 < NT) A2_LOADT(s + 1);
            SBAR();
            if (s < NT) {
                f32x16 p0, p1; float mn, al; bf16x8 pa0, pa1, pa2, pa3;
                qkt_rt(p0, p1, lds + L_K + par * SHM_K, r32, hi, qr);
                const int kb_ = s * 64;
                if (kb_ + 63 > qlo - 128) att::bias_mask_tile(p0, p1, qm - kb_, bt);
                att::partialSM(p0, p1, m_reg, mn, al);
                att::finishSM(p0, p1, al, l_reg, pa0, pa1, pa2, pa3);
                char* pw = Pb + par * 4096 + lane * 16;
                *(bf16x8*)(pw) = pa0; *(bf16x8*)(pw + 1024) = pa1; *(bf16x8*)(pw + 2048) = pa2; *(bf16x8*)(pw + 3072) = pa3;
                if (hi == 0) ALb[par * 32 + r32] = al;
                const bool resc = __any(al < 1.f);
                if (lane == 0) FLb[par] = resc ? 1u : 0u;
            }
            __syncthreads();
            if (s + 1 < NT) { asm volatile("s_waitcnt vmcnt(0)" ::: "memory"); A2_WRITET((s + 1) & 1); }
            __syncthreads();
        }
        if (hi == 0) LBb[r32] = l_reg;
        __syncthreads();
        __syncthreads();
    } else {
        asm volatile("s_waitcnt vmcnt(0)" ::: "memory"); A2_WRITET(0); __syncthreads();
        f32x16 o[8];
#pragma unroll
        for (int d_ = 0; d_ < 8; ++d_) o[d_] = f32x16{};
        const int vbase = (int)(uintptr_t)(lds + L_V) + att::v_rd_base(lane);
        for (int s = 0; s <= NT; ++s) {
            if (s + 1 < NT) A2_LOADT(s + 1);
            SBAR();
            if (s >= 1) {
                const int par = (s - 1) & 1;
                const unsigned fl = (unsigned)__builtin_amdgcn_readfirstlane((int)FLb[par]);
                if (fl) {
#pragma unroll
                    for (int r = 0; r < 16; ++r) { const float a = ALb[par * 32 + att::crow(r, hi)];
#pragma unroll
                        for (int d_ = 0; d_ < 8; ++d_) o[d_][r] *= a; } }
                const char* pr = Pb + par * 4096 + lane * 16;
                const bf16x8 pa0 = *(const bf16x8*)(pr), pa1 = *(const bf16x8*)(pr + 1024), pa2 = *(const bf16x8*)(pr + 2048), pa3 = *(const bf16x8*)(pr + 3072);
                const int vb = vbase + par * 2 * SHM_V;
                att::pv_tile<0>(o, vb, pa0, pa1, pa2, pa3);
                att::pv_tile<0>(o + 4, vb + SHM_V, pa0, pa1, pa2, pa3);
            }
            __syncthreads();
            if (s + 1 < NT) { asm volatile("s_waitcnt vmcnt(0)" ::: "memory"); A2_WRITET((s + 1) & 1); }
            __syncthreads();
        }
        __syncthreads();
        float rli[16];
#pragma unroll
        for (int r = 0; r < 16; ++r) rli[r] = __builtin_amdgcn_rcpf(LBb[att::crow(r, hi)]);
#pragma unroll
        for (int hf = 0; hf < 2; ++hf) { float* Ow = (hf ? c.O1 : c.O0) + (size_t)(g * 32) * D;
#pragma unroll
            for (int r = 0; r < 16; ++r) { const int orow = att::crow(r, hi);
#pragma unroll
                for (int d0 = 0; d0 < 4; ++d0) Ow[(size_t)orow * D + d0 * 32 + r32] = o[hf * 4 + d0][r] * rli[r]; } }
        __syncthreads();
    }
}
#undef A2_LOADT
#undef A2_WRITET
}


#define XB_TMO      128
#define XB_XCNT(j)  (256  + 64 * (j))
#define XB_XSUB(j)  (1280 + 64 * (j))
#define XB_XGEN(j)  (2304 + 64 * (j))
#define XB_TOP      3328
#define XB_TOPGEN   3392
#define XCD_BAR_WORDS 3456
#define XB_SPIN_CAP (1u << 18)
__device__ __forceinline__ unsigned xb_ld(unsigned* p)              { return __hip_atomic_load(p, __ATOMIC_RELAXED, __HIP_MEMORY_SCOPE_AGENT); }
__device__ __forceinline__ unsigned xb_add(unsigned* p, unsigned v) { return __hip_atomic_fetch_add(p, v, __ATOMIC_RELAXED, __HIP_MEMORY_SCOPE_AGENT); }
__device__ __forceinline__ unsigned xb_xcc_id() { return (unsigned)__builtin_amdgcn_s_getreg((3 << 11) | 20) & 0xFu; }
#define XB_SPIN(cond, bar) do { unsigned _sp = 0; while (cond) { __builtin_amdgcn_s_sleep(1); \
    if ((++_sp & 255u) == 0u) { if (xb_ld(&(bar)[XB_TMO])) break; if (_sp > XB_SPIN_CAP) { atomicAdd(&(bar)[XB_TMO], 1u); break; } } } } while (0)
struct XcdBarrier { unsigned* bar; unsigned x; volatile LAS unsigned* st; };
__device__ __forceinline__ XcdBarrier xcd_barrier_post(unsigned* bar, volatile LAS unsigned* st) {
    XcdBarrier b; b.bar = bar; b.x = xb_xcc_id(); b.st = st;
    if (threadIdx.x == 0) (void)xb_add(&bar[XB_XCNT(b.x)], 1u);
    return b;
}
__device__ __forceinline__ void xcd_barrier_complete(unsigned* bar, unsigned x, unsigned& nloc, unsigned& nx) {
    const unsigned G = gridDim.x * gridDim.y * gridDim.z;
    unsigned sum, cnt, mine, sp = 0u;
    for (;;) {
        sum = 0u; cnt = 0u; mine = 0u;
#pragma unroll
        for (unsigned j = 0; j < 16; ++j) { const unsigned c = xb_ld(&bar[XB_XCNT(j)]); sum += c; cnt += (c > 0u) ? 1u : 0u; mine = (j == x) ? c : mine; }
        if (sum == G) break;
        __builtin_amdgcn_s_sleep(1);
        if ((++sp & 255u) == 0u) { if (xb_ld(&bar[XB_TMO])) break; if (sp > XB_SPIN_CAP) { atomicAdd(&bar[XB_TMO], 1u); break; } }
    }
    nloc = mine > 0u ? mine : 1u; nx = cnt > 0u ? cnt : 1u;
}
__device__ __forceinline__ void xcd_barrier(const XcdBarrier& b) {
    asm volatile("s_waitcnt vmcnt(0)" ::: "memory");
    __syncthreads();
    if (threadIdx.x == 0) {
        unsigned* bar = b.bar;
        __builtin_amdgcn_s_waitcnt(0);
        unsigned nloc = b.st[0], nx = b.st[1];
        if (nloc == 0u) { xcd_barrier_complete(bar, b.x, nloc, nx); b.st[0] = nloc; b.st[1] = nx; }
        const unsigned old = xb_add(&bar[XB_XSUB(b.x)], 1u);
        const unsigned gen = old / nloc;
        if (old + 1u == (gen + 1u) * nloc) {
            __builtin_amdgcn_fence(__ATOMIC_RELEASE, "agent");
            asm volatile("s_waitcnt vmcnt(0)" ::: "memory");
            const unsigned og = xb_add(&bar[XB_TOP], 1u);
            const unsigned tg = og / nx;
            if (og + 1u == (tg + 1u) * nx) xb_add(&bar[XB_TOPGEN], 1u);
            else XB_SPIN(xb_ld(&bar[XB_TOPGEN]) == tg, bar);
            __builtin_amdgcn_fence(__ATOMIC_ACQUIRE, "agent");
            xb_add(&bar[XB_XGEN(b.x)], 1u);
            asm volatile("s_waitcnt vmcnt(0)" ::: "memory");
        } else {
            XB_SPIN(xb_ld(&bar[XB_XGEN(b.x)]) == gen, bar);
            __builtin_amdgcn_fence(__ATOMIC_ACQUIRE, "agent");
            asm volatile("s_waitcnt vmcnt(0)" ::: "memory");
        }
    }
    __syncthreads();
}

struct Args { const float* in[24]; float* out; unsigned char* ws; };

__device__ __forceinline__ void p0_transpose_item(const float* W, int K, int N, bf16_t* WT, int swiglu, const float* gk, const float* bk, float* c1, float* c2, LAS float* scr, int item, int lane) {
    const int nblk = N / 64, kb = item / nblk, nb = item % nblk, k0 = 64 * kb, n0 = 64 * nb;
    const float* src = W + (size_t)(k0 + (lane >> 4)) * N + n0 + (lane & 15) * 4;
    f32x4 v[16];
#pragma unroll
    for (int i = 0; i < 16; ++i) v[i] = *(const f32x4*)(src + (size_t)(4 * i) * N);
#pragma unroll
    for (int i = 0; i < 16; ++i) { LAS float* d = scr + (4 * i + (lane >> 4)) * 65 + (lane & 15) * 4; d[0] = v[i][0]; d[1] = v[i][1]; d[2] = v[i][2]; d[3] = v[i][3]; }
    asm volatile("s_waitcnt lgkmcnt(0)" ::: "memory");
    int r0 = n0;
    if (swiglu) { const int half = n0 / DFF, idx = n0 % DFF; r0 = 256 * (idx / 128) + 128 * half + (idx % 128); }
    const int c = lane & 7;
    float g8[8], b8[8];
#pragma unroll
    for (int e = 0; e < 8; ++e) { g8[e] = gk ? gk[k0 + 8 * c + e] : 1.f; b8[e] = gk ? bk[k0 + 8 * c + e] : 0.f; }
#pragma unroll
    for (int j = 0; j < 8; ++j) { const int n = (lane >> 3) + 8 * j; const LAS float* q = scr + (8 * c) * 65 + n;
        float w8[8];
#pragma unroll
        for (int e = 0; e < 8; ++e) w8[e] = q[e * 65];
        u32x4 o; o.x = cvt_pk_bf16(w8[0] * g8[0], w8[1] * g8[1]); o.y = cvt_pk_bf16(w8[2] * g8[2], w8[3] * g8[3]); o.z = cvt_pk_bf16(w8[4] * g8[4], w8[5] * g8[5]); o.w = cvt_pk_bf16(w8[6] * g8[6], w8[7] * g8[7]);
        *(u32x4*)(WT + (size_t)(r0 + n) * K + k0 + 8 * c) = o;
        if (gk) {
            float s1 = ((bf_lo(o.x) + bf_hi(o.x)) + (bf_lo(o.y) + bf_hi(o.y))) + ((bf_lo(o.z) + bf_hi(o.z)) + (bf_lo(o.w) + bf_hi(o.w)));
            float s2 = ((w8[0] * b8[0] + w8[1] * b8[1]) + (w8[2] * b8[2] + w8[3] * b8[3])) + ((w8[4] * b8[4] + w8[5] * b8[5]) + (w8[6] * b8[6] + w8[7] * b8[7]));
            s1 += __shfl_xor(s1, 1); s1 += __shfl_xor(s1, 2); s1 += __shfl_xor(s1, 4); s2 += __shfl_xor(s2, 1); s2 += __shfl_xor(s2, 2); s2 += __shfl_xor(s2, 4);
            if (c == 0) { unsafeAtomicAdd(c1 + r0 + n, s1); unsafeAtomicAdd(c2 + r0 + n, s2); }
        } }
    asm volatile("s_waitcnt lgkmcnt(0)" ::: "memory");
}

__device__ __forceinline__ void p0_wq_item(const float* W, bf16_t* WN, const float* gk, const float* bk, float* bW, int item, int lane) {
    const int kb = item >> 5, jb = item & 31, k0 = 64 * kb, j0 = 64 * jb, cg8 = lane & 7, kr = lane >> 3;
    float sacc[8];
#pragma unroll
    for (int e = 0; e < 8; ++e) sacc[e] = 0.f;
#pragma unroll
    for (int i = 0; i < 8; ++i) { const int k = k0 + 8 * i + kr; const float* src = W + (size_t)k * DM + j0 + 8 * cg8;
        const f32x4 v0 = *(const f32x4*)src, v1 = *(const f32x4*)(src + 4); const float g = gk[k], bb = bk[k];
        u32x4 o; o.x = cvt_pk_bf16(v0[0] * g, v0[1] * g); o.y = cvt_pk_bf16(v0[2] * g, v0[3] * g); o.z = cvt_pk_bf16(v1[0] * g, v1[1] * g); o.w = cvt_pk_bf16(v1[2] * g, v1[3] * g);
        *(u32x4*)(WN + (size_t)k * DM + j0 + 8 * cg8) = o;
#pragma unroll
        for (int e = 0; e < 4; ++e) { sacc[e] += bb * v0[e]; sacc[4 + e] += bb * v1[e]; } }
#pragma unroll
    for (int e = 0; e < 8; ++e) { float v = sacc[e]; v += __shfl_xor(v, 8); v += __shfl_xor(v, 16); v += __shfl_xor(v, 32); if (kr == 0) unsafeAtomicAdd(bW + j0 + 8 * cg8 + e, v); }
}

__device__ __forceinline__ int causal_bucket(int n) {
    if (n < 16) return n;
    const float nf = (float)n;
    int large = 16 + (int)(logf(nf / 16.f) / 2.0794415416798357f * 16.f);
    return large < 31 ? large : 31;
}

__device__ __forceinline__ size_t zero_opaque() { size_t z = 0; asm volatile("" : "+s"(z)); return z; }
__device__ __forceinline__ const float* inp_ptr(const Args& a, int k) { return a.in[k] + zero_opaque(); }
#define INP(k) inp_ptr(a, k)
__device__ __forceinline__ unsigned char* ws_opaque(const Args& a) { return a.ws + zero_opaque(); }
__device__ __forceinline__ float* out_opaque(const Args& a) { return a.out + zero_opaque(); }
#define WSP(type, off) ((type*)(ws_opaque(a) + (off)))
__global__ void __launch_bounds__(NTHR, 2) mega_fwd(Args a) {
    extern __shared__ __attribute__((aligned(16))) unsigned char lds[];
    volatile LAS unsigned* bst = (volatile LAS unsigned*)((LAS unsigned char*)lds + LDS_BYTES - 64);
    if (threadIdx.x == 0) { bst[0] = 0u; bst[1] = 0u; }
    __syncthreads();
    (void)xcd_barrier_post((unsigned*)(a.ws + WS_BAR), bst);
#define GRID_BAR() do { XcdBarrier xb_; xb_.bar = (unsigned*)(ws_opaque(a) + WS_BAR); unsigned x_ = xb_xcc_id(); asm volatile("" : "+s"(x_)); xb_.x = x_; xb_.st = bst; xcd_barrier(xb_); } while (0)
    const int G = gridDim.x;
    const int NGW = G * NWAVES, NGT = G * NTHR;
    {
        PH_IDS;
        unsigned char* ws = ws_opaque(a);
        float* lamp = (float*)(ws + WS_LAM); float* btab = (float*)(ws + WS_BTAB); bf16_t* wtril = (bf16_t*)(ws + WS_WTRIL); bf16_t* membf = (bf16_t*)(ws + WS_MEMBF); bf16_t* XN = (bf16_t*)(ws + WS_XN);
        LAS float* scr = (LAS float*)((LAS unsigned char*)lds + wave * 17408);
        constexpr int I_IN = 32 * 88, I_SQ = 32 * 32, I_KV = 32 * 64, I_GU = 32 * 176, I_D = 88 * 32;
        constexpr int PER_LAYER = I_IN + 3 * I_SQ + I_KV + I_GU + I_D;
        for (int it = gw; it < 2 * PER_LAYER; it += NGW) {
            const int l = it / PER_LAYER; int r = it % PER_LAYER;
            unsigned char* wl = ws + WS_W + (size_t)l * W_LAYER;
            float* cl = (float*)(ws + WS_C) + (size_t)l * C_LAYER;
            if (r < I_IN) { const bool f = l > 0;
                p0_transpose_item(INP(3) + (size_t)l * DM * INC, DM, INC, (bf16_t*)(wl + W_IN), 0, f ? INP(22) : nullptr, f ? INP(23) : nullptr, cl + C_IN, cl + C_IN + INC, scr, r, lane); continue; } r -= I_IN;
            if (r < I_SQ) { p0_transpose_item(INP(12) + (size_t)l * DM * DM, DM, DM, (bf16_t*)(wl + W_OUT), 0, nullptr, nullptr, nullptr, nullptr, scr, r, lane); continue; } r -= I_SQ;
            if (r < I_SQ) { p0_wq_item(INP(15) + (size_t)l * DM * DM, (bf16_t*)(wl + W_Q), INP(13) + (size_t)l * DM, INP(14) + (size_t)l * DM, cl + C_Q + DM, r, lane); continue; } r -= I_SQ;
            if (r < I_KV) { p0_transpose_item(INP(16) + (size_t)l * DM * 2 * DM, DM, 2 * DM, (bf16_t*)(wl + W_KV), 0, nullptr, nullptr, nullptr, nullptr, scr, r, lane); continue; } r -= I_KV;
            if (r < I_SQ) { p0_transpose_item(INP(17) + (size_t)l * DM * DM, DM, DM, (bf16_t*)(wl + W_O), 0, nullptr, nullptr, nullptr, nullptr, scr, r, lane); continue; } r -= I_SQ;
            if (r < I_GU) { p0_transpose_item(INP(20) + (size_t)l * DM * 2 * DFF, DM, 2 * DFF, (bf16_t*)(wl + W_GU), 1, INP(18) + (size_t)l * DM, INP(19) + (size_t)l * DM, cl + C_GU, cl + C_GU + 2 * DFF, scr, r, lane); continue; } r -= I_GU;
            p0_transpose_item(INP(21) + (size_t)l * DFF * DM, DFF, DM, (bf16_t*)(wl + W_D), 0, nullptr, nullptr, nullptr, nullptr, scr, r, lane);
        }
        for (size_t i = gt; i < (size_t)T * DM / 8; i += NGT) {
            const f32x4 v0 = *(const f32x4*)(INP(0) + i * 8), v1 = *(const f32x4*)(INP(0) + i * 8 + 4);
            u32x4 w; w.x = cvt_pk_bf16(v0[0], v0[1]); w.y = cvt_pk_bf16(v0[2], v0[3]); w.z = cvt_pk_bf16(v1[0], v1[1]); w.w = cvt_pk_bf16(v1[2], v1[3]);
            *(u32x4*)(XN + i * 8) = w;
        }
        for (size_t i = gt; i < (size_t)BATCH * NMEM * DM / 8; i += NGT) {
            const f32x4 v0 = *(const f32x4*)(INP(1) + i * 8), v1 = *(const f32x4*)(INP(1) + i * 8 + 4);
            u32x4 w; w.x = cvt_pk_bf16(v0[0], v0[1]); w.y = cvt_pk_bf16(v0[2], v0[3]); w.z = cvt_pk_bf16(v1[0], v1[1]); w.w = cvt_pk_bf16(v1[2], v1[3]);
            *(u32x4*)(membf + i * 8) = w;
        }
        for (int i = gt; i < DEPTH * 4 * 128 * 128; i += NGT) { const int s = i & 127, t = (i >> 7) & 127; wtril[i] = s <= t ? f2bf(INP(7)[i]) : (bf16_t)0; }
        if (gt < 8 * 256) { const int hm = gt >> 8, d = gt & 255; const float* rb = INP(2);
            btab[gt] = (rb[causal_bucket(d) * 8 + hm] - rb[31 * 8 + hm]) * (1.f / att::SCALE); }
        if (cu == 0 && wave == 0) {
            for (int l = 0; l < DEPTH; ++l) {
                const float* lq = INP(9) + l * 256; const float* lk = INP(10) + l * 256;
                float s0 = lq[lane] * lk[lane] + lq[lane + 64] * lk[lane + 64];
                float s1 = lq[128 + lane] * lk[128 + lane] + lq[192 + lane] * lk[192 + lane];
                s0 = wave_sum(s0); s1 = wave_sum(s1);
                const float lam_init = 0.8f - 0.6f * expf(-0.3f * (float)l);
                if (lane == 0) lamp[l] = expf(s0) - expf(s1) + lam_init;
            }
        }
    }
    GRID_BAR();

#pragma unroll 1
    for (int l = 0; l < DEPTH; ++l) {
        {
            unsigned char* ws = ws_opaque(a);
            pg8::Gemm g{(const bf16_t*)(ws + WS_XN), (const bf16_t*)(ws + WS_W + (size_t)l * W_LAYER + W_IN), DM, DM, DM, 1, 0, 0, 0, 0};
            pg8::Order S; S.init(T, INC, 1, G, cu_opaque());
            const float* cl = (const float*)(ws + WS_C) + (size_t)l * C_LAYER;
            const float* st = l > 0 ? (const float*)(ws + WS_ST) + (size_t)(3 * l - 1) * T * 2 : nullptr;
            pg8::EpiSplit E{(bf16_t*)(ws + WS_PROJ), st, cl + C_IN, cl + C_IN + INC};
            pg8::gemm_phase<pg8::EpiSplit, true>((LAS unsigned char*)lds, g, S, E);
        }
        if (l == 0) {
            {
                unsigned char* ws = ws_opaque(a);
                pg8::Gemm g{(const bf16_t*)(ws + WS_MEMBF), (const bf16_t*)(ws + WS_W + W_KV), DM, DM, DM, 1, 0, 0, (long)(W_LAYER / 2), 0};
                pg8::Order S; const int cu = cu_opaque(); S.init(BATCH * NMEM, 2 * DM, 2, G, cu >= 128 && cu < 192 ? cu - 128 : -1);
                pg8::EpiBf16 E{(bf16_t*)(ws + WS_KV), 2 * DM, 1, (long)(BATCH * NMEM) * 2 * DM, 0, 1.f, nullptr, nullptr, nullptr, nullptr};
                pg8::gemm_phase<pg8::EpiBf16, true>((LAS unsigned char*)lds, g, S, E);
            }
        }
        GRID_BAR();

        if (l == 0) {
#pragma unroll 1
            for (int L2 = 0; L2 < DEPTH; ++L2) {
                {
                    unsigned char* ws = ws_opaque(a); unsigned char* wl2 = ws + WS_W + (size_t)L2 * W_LAYER;
                    const bf16_t* KVl = (const bf16_t*)(ws + WS_KV) + (size_t)L2 * BATCH * NMEM * 2 * DM;
                    float* cl = (float*)(ws + WS_C) + (size_t)L2 * C_LAYER;
                    pg8::Gemm g{KVl, (const bf16_t*)(wl2 + W_Q), 2 * DM, DM, 512, 4, (long)NMEM * 2 * DM, 512, 0, 512};
                    pg8::Order S; const int cu = cu_opaque(); S.init(NMEM, DM, 8, G, cu >= 64 * L2 && cu < 64 * L2 + 64 ? cu - 64 * L2 : -1);
                    pg8::EpiBf16 E{(bf16_t*)(wl2 + W_KV), DM, 1, (long)NMEM * DM, 0, 1.f, nullptr, nullptr, nullptr, cl + C_Q};
                    pg8::gemm_phase<pg8::EpiBf16, true>((LAS unsigned char*)lds, g, S, E);
                }
                {
                    unsigned char* ws = ws_opaque(a); unsigned char* wl2 = ws + WS_W + (size_t)L2 * W_LAYER;
                    const bf16_t* KVl = (const bf16_t*)(ws + WS_KV) + (size_t)L2 * BATCH * NMEM * 2 * DM;
                    pg8::Gemm g{(const bf16_t*)(wl2 + W_O), KVl + DM, DM, 2 * DM, 512, 4, 0, 512, (long)NMEM * 2 * DM, 512};
                    pg8::Order S; const int cu = cu_opaque(); S.init(DM, NMEM, 8, G, cu >= 128 + 64 * L2 && cu < 192 + 64 * L2 ? cu - 128 - 64 * L2 : -1);
                    pg8::EpiBf16 E{(bf16_t*)(wl2 + W_KV + 8 * MiB), 1024, 4, (long)DM * 1024, 256, 1.f, nullptr, nullptr, nullptr, nullptr};
                    pg8::gemm_phase<pg8::EpiBf16, true>((LAS unsigned char*)lds, g, S, E);
                }
            }
            {
                PH_IDS;
                unsigned char* ws = ws_opaque(a);
                for (int it = gw; it < DEPTH * 2048; it += NGW) {
                    const int L2 = it >> 11, r = it & 2047, b = r >> 10, h = (r >> 8) & 3, n = r & 255;
                    const bf16_t* kp = (const bf16_t*)(ws + WS_KV) + ((size_t)L2 * BATCH * NMEM + b * NMEM + n) * 2 * DM + h * 512 + 8 * lane;
                    float* cl = (float*)(ws + WS_C) + (size_t)L2 * C_LAYER;
                    const float* bw = cl + C_Q + DM + h * 512 + 8 * lane;
                    const u32x4 kw = *(const u32x4*)kp; const f32x4 b0 = *(const f32x4*)bw, b1 = *(const f32x4*)(bw + 4);
                    float d = (bf_lo(kw.x) * b0[0] + bf_hi(kw.x) * b0[1]) + (bf_lo(kw.y) * b0[2] + bf_hi(kw.y) * b0[3]) + (bf_lo(kw.z) * b1[0] + bf_hi(kw.z) * b1[1]) + (bf_lo(kw.w) * b1[2] + bf_hi(kw.w) * b1[3]);
                    d = wave_sum(d);
                    if (lane == 0) cl[C_QK2 + r] = d;
                }
            }
            __syncthreads();
        }
        {
            PH_IDS;
            bf16_t* PB = WSP(bf16_t, WS_PROJ); bf16_t* Y = WSP(bf16_t, WS_Y);
            const float* cw = INP(4) + (size_t)l * 3 * 512;
            for (int it = gt; it < T * 64; it += NGT) {
                const int r = it >> 6, cg8 = it & 63, c0 = cg8 * 8, gi = cg8 >> 4, cc = c0 & 127, t = r & (SEQ - 1);
                const bf16_t* pb = PB + ((size_t)(0 + gi) * T + r) * 128 + cc;
                const bf16_t* pc = PB + ((size_t)(4 + gi) * T + r) * 128 + cc;
                const bf16_t* ph = PB + ((size_t)(8 + gi) * T + r) * 128 + cc;
                const u32x4 wb = *(const u32x4*)pb, wc0 = *(const u32x4*)pc, wh0 = *(const u32x4*)ph;
                u32x4 wc1 = {0, 0, 0, 0}, wh1 = {0, 0, 0, 0}, wc2 = {0, 0, 0, 0}, wh2 = {0, 0, 0, 0};
                if (t >= 1) { wc1 = *(const u32x4*)(pc - 128); wh1 = *(const u32x4*)(ph - 128); }
                if (t >= 2) { wc2 = *(const u32x4*)(pc - 256); wh2 = *(const u32x4*)(ph - 256); }
                float y[8];
#pragma unroll
                for (int j = 0; j < 4; ++j) {
                    const float k0a = cw[c0 + 2 * j], k1a = cw[512 + c0 + 2 * j], k2a = cw[1024 + c0 + 2 * j];
                    const float k0b = cw[c0 + 2 * j + 1], k1b = cw[512 + c0 + 2 * j + 1], k2b = cw[1024 + c0 + 2 * j + 1];
                    const float z0a = bf_lo(wc0[j]) * bf_lo(wh0[j]), z1a = bf_lo(wc1[j]) * bf_lo(wh1[j]), z2a = bf_lo(wc2[j]) * bf_lo(wh2[j]);
                    const float z0b = bf_hi(wc0[j]) * bf_hi(wh0[j]), z1b = bf_hi(wc1[j]) * bf_hi(wh1[j]), z2b = bf_hi(wc2[j]) * bf_hi(wh2[j]);
                    y[2 * j] = bf_lo(wb[j]) * (k0a * z2a + k1a * z1a + k2a * z0a);
                    y[2 * j + 1] = bf_hi(wb[j]) * (k0b * z2b + k1b * z1b + k2b * z0b);
                }
                u32x4 w; w.x = cvt_pk_bf16(y[0], y[1]); w.y = cvt_pk_bf16(y[2], y[3]); w.z = cvt_pk_bf16(y[4], y[5]); w.w = cvt_pk_bf16(y[6], y[7]);
                *(u32x4*)(Y + (size_t)r * DM + c0) = w;
            }
        }
        {
            PH_IDS;
            bf16_t* PB = WSP(bf16_t, WS_PROJ); bf16_t* Y = WSP(bf16_t, WS_Y); bf16_t* wtril = WSP(bf16_t, WS_WTRIL);
            float* st = (float*)(lds + 40960);
            bf16_t* vT = (bf16_t*)lds;
            const float* lng = INP(5) + (size_t)l * 512; const float* lnb = INP(6) + (size_t)l * 512;
            const float* bs = INP(8) + (size_t)l * 512;
            for (int un = cu; un < (T / 128) * 4; un += G) {
                const int ch = un >> 2, gi = un & 3, r0 = ch * 128;
                const int tok = tid >> 2, q = tid & 3;
                {
                    const bf16_t* vp = PB + ((size_t)(16 + q) * T + r0 + tok) * 128;
                    float s = 0.f, ss = 0.f;
#pragma unroll 4
                    for (int i = 0; i < 16; ++i) { const u32x4 w = *(const u32x4*)(vp + 8 * i);
#pragma unroll
                        for (int j = 0; j < 4; ++j) { const float x0 = gelu_tanh(bf_lo(w[j])), x1 = gelu_tanh(bf_hi(w[j])); s += x0 + x1; ss += x0 * x0 + x1 * x1; } }
                    s += __shfl_xor(s, 1); s += __shfl_xor(s, 2); ss += __shfl_xor(ss, 1); ss += __shfl_xor(ss, 2);
                    const float mean = s * (1.f / 512.f), var = fmaxf(ss * (1.f / 512.f) - mean * mean, 0.f);
                    if (q == 0) { st[2 * tok] = mean; st[2 * tok + 1] = rsqrtf(var + LN_EPS); }
                }
                __syncthreads();
                {
                    const int cq = q * 32; const float mean = st[2 * tok], rstd = st[2 * tok + 1];
                    const bf16_t* vp = PB + ((size_t)(16 + gi) * T + r0 + tok) * 128 + cq;
#pragma unroll
                    for (int i = 0; i < 4; ++i) { const u32x4 w = *(const u32x4*)(vp + 8 * i);
#pragma unroll
                        for (int j = 0; j < 4; ++j) { const int c = cq + 8 * i + 2 * j;
                            const float x0 = gelu_tanh(bf_lo(w[j])), x1 = gelu_tanh(bf_hi(w[j]));
                            vT[c * 136 + tok] = f2bf((x0 - mean) * rstd * lng[gi * 128 + c] + lnb[gi * 128 + c]);
                            vT[(c + 1) * 136 + tok] = f2bf((x1 - mean) * rstd * lng[gi * 128 + c + 1] + lnb[gi * 128 + c + 1]); } }
                }
                __syncthreads();
                {
                    f32x4 acc[8];
#pragma unroll
                    for (int ct = 0; ct < 8; ++ct) acc[ct] = (f32x4){0.f, 0.f, 0.f, 0.f};
                    const bf16_t* wrow = wtril + ((size_t)(l * 4 + gi) * 128 + 16 * wave + (lane & 15)) * 128 + 8 * (lane >> 4);
#pragma unroll
                    for (int kk = 0; kk < 4; ++kk) { const bf16x8 av = *(const bf16x8*)(wrow + kk * 32);
#pragma unroll
                        for (int ct = 0; ct < 8; ++ct) { const bf16x8 bv = *(const bf16x8*)(vT + (ct * 16 + (lane & 15)) * 136 + kk * 32 + 8 * (lane >> 4));
                            acc[ct] = __builtin_amdgcn_mfma_f32_16x16x32_bf16(av, bv, acc[ct], 0, 0, 0); } }
#pragma unroll
                    for (int ct = 0; ct < 8; ++ct)
#pragma unroll
                        for (int j = 0; j < 4; ++j) { const int t = 16 * wave + 4 * (lane >> 4) + j, c = ct * 16 + (lane & 15);
                            const float uu = bf2f(PB[((size_t)(12 + gi) * T + r0 + t) * 128 + c]);
                            Y[(size_t)(r0 + t) * DM + 512 + gi * 128 + c] = f2bf(gelu_tanh(uu) * (acc[ct][j] + bs[gi * 128 + t])); }
                }
                __syncthreads();
            }
        }
        {
            PH_IDS;
            bf16_t* PB = WSP(bf16_t, WS_PROJ); float* OATT = WSP(float, WS_R1); float* btab = WSP(float, WS_BTAB);
            float* btl = (float*)(lds + att2::L_BT);
            for (int i = tid; i < 8 * 256; i += NTHR) btl[i] = btab[i];
            __syncthreads();
            const att::bf16* PBb = (const att::bf16*)PB;
#pragma unroll 1
            for (int L = cu; L < 512; L += G) {
                const int k_ = L >> 3, hm = L & 7, b = k_ >> 5, x = k_ & 31, h = hm >> 1;
#pragma unroll 1
                for (int pass = 0; pass < 2; ++pass) {
                    const int qb = pass ? 63 - x : x;
                    att2::Blk c;
                    c.Q = PBb + ((size_t)(20 + hm) * T + (size_t)b * SEQ + qb * 128) * 128; c.K = PBb + ((size_t)(28 + hm) * T + (size_t)b * SEQ) * 128;
                    c.V0 = PBb + ((size_t)(36 + h * 2) * T + (size_t)b * SEQ) * 128; c.V1 = PBb + ((size_t)(37 + h * 2) * T + (size_t)b * SEQ) * 128;
                    c.O0 = OATT + ((size_t)((b * 8 + hm) * 2 + 0) * SEQ + qb * 128) * 128; c.O1 = OATT + ((size_t)((b * 8 + hm) * 2 + 1) * SEQ + qb * 128) * 128;
                    c.P0 = qb * 128; c.hm = hm;
                    att2::attn2_block(c, (char*)lds);
                }
            }
        }
        GRID_BAR();

        {
            PH_IDS;
            float* OATT = WSP(float, WS_R1); bf16_t* Y = WSP(bf16_t, WS_Y); float* lamp = WSP(float, WS_LAM);
            const float lam_init = 0.8f - 0.6f * expf(-0.3f * (float)l);
            const float lam = lamp[l]; const float* sg = INP(11) + (size_t)l * 256;
            const f32x4 gv = *(const f32x4*)(sg + 4 * lane);
            for (int it = gw; it < T * 4; it += NGW) {
                const int r = it >> 2, h = it & 3, b = r >> 13, t = r & (SEQ - 1);
                const int half = lane >> 5, e = (lane & 31) * 4;
                const size_t i0 = ((size_t)(((b * 4 + h) * 2 + 0) * 2 + half) * SEQ + t) * 128 + e;
                const size_t i1 = ((size_t)(((b * 4 + h) * 2 + 1) * 2 + half) * SEQ + t) * 128 + e;
                const f32x4 o0 = *(const f32x4*)(OATT + i0), o1 = *(const f32x4*)(OATT + i1);
                const f32x4 d = o0 - o1 * lam;
                const float ss = wave_sum(d[0] * d[0] + d[1] * d[1] + d[2] * d[2] + d[3] * d[3]);
                const float sc = rsqrtf(ss * (1.f / 256.f) + LN_EPS) * (1.f - lam_init);
                u32x2 w; w.x = cvt_pk_bf16(d[0] * sc * gv[0], d[1] * sc * gv[1]); w.y = cvt_pk_bf16(d[2] * sc * gv[2], d[3] * sc * gv[3]);
                *(u32x2*)(Y + (size_t)r * DM + 1024 + h * 256 + 4 * lane) = w;
            }
        }
        GRID_BAR();

#define LN_PASS(gam, bet, write_xn) do { PH_IDS; float* X = out_opaque(a); bf16_t* XN = WSP(bf16_t, WS_XN); \
            for (int r = gw; r < T; r += NGW) { float* xr = X + (size_t)r * DM; f32x4 v[8]; float s = 0.f; \
                _Pragma("unroll") for (int j = 0; j < 8; ++j) { v[j] = *(const f32x4*)(xr + 4 * lane + 256 * j); s += (v[j][0] + v[j][1]) + (v[j][2] + v[j][3]); } \
                const float mean = wave_sum(s) * (1.f / DM); float s2 = 0.f; \
                _Pragma("unroll") for (int j = 0; j < 8; ++j) { v[j] = v[j] - mean; s2 += (v[j][0] * v[j][0] + v[j][1] * v[j][1]) + (v[j][2] * v[j][2] + v[j][3] * v[j][3]); } \
                const float rstd = rsqrtf(wave_sum(s2) * (1.f / DM) + LN_EPS); \
                _Pragma("unroll") for (int j = 0; j < 8; ++j) { const f32x4 gg = *(const f32x4*)((gam) + 4 * lane + 256 * j), bb = *(const f32x4*)((bet) + 4 * lane + 256 * j); \
                    const f32x4 o = v[j] * rstd * gg + bb; *(f32x4*)(xr + 4 * lane + 256 * j) = o; \
                    if (write_xn) { u32x2 w; w.x = cvt_pk_bf16(o[0], o[1]); w.y = cvt_pk_bf16(o[2], o[3]); *(u32x2*)(XN + (size_t)r * DM + 4 * lane + 256 * j) = w; } } } } while (0)

        {
            unsigned char* ws = ws_opaque(a); float* X = out_opaque(a); float* ST = (float*)(ws + WS_ST);
            pg8::Gemm g{(const bf16_t*)(ws + WS_Y), (const bf16_t*)(ws + WS_W + (size_t)l * W_LAYER + W_OUT), DM, DM, DM, 1, 0, 0, 0, 0};
            pg8::Order S; S.init(T, DM, 1, G, cu_opaque());
            pg8::EpiRes E{nullptr, l == 0 ? INP(0) : nullptr, ST + (size_t)(l > 0 ? 3 * l - 1 : 0) * T * 2, INP(22) + (size_t)(l > 0 ? l - 1 : 0) * DM, INP(23) + (size_t)(l > 0 ? l - 1 : 0) * DM,
                          (bf16_t*)(ws + WS_XN), ST + (size_t)(3 * l) * T * 2, ALPHA, 0};
            pg8::gemm_phase<pg8::EpiRes, true>((LAS unsigned char*)lds, g, S, E);
        }
        GRID_BAR();

        {
            unsigned char* ws = ws_opaque(a);
            const float* cl = (const float*)(ws + WS_C) + (size_t)l * C_LAYER;
            pg8::Gemm g{(const bf16_t*)(ws + WS_XN), (const bf16_t*)(ws + WS_W + (size_t)l * W_LAYER + W_KV), DM, DM, DM, 4, (long)SEQ * DM, 0, (long)4 * NMEM * DM, (long)NMEM * DM};
            pg8::Order S; S.init(SEQ, NMEM, 8, G, cu_opaque());
            pg8::EpiSoftmax E{(bf16_t*)(ws + WS_PROJ + 64 * MiB), (const float*)(ws + WS_ST) + (size_t)(3 * l) * T * 2, cl + C_Q, cl + C_QK2, 0.044194173824159216f};
            pg8::gemm_phase<pg8::EpiSoftmax, true>((LAS unsigned char*)lds, g, S, E);
        }
        GRID_BAR();
        {
            unsigned char* ws = ws_opaque(a); float* ST = (float*)(ws + WS_ST);
            pg8::Gemm g{(const bf16_t*)(ws + WS_PROJ + 64 * MiB), (const bf16_t*)(ws + WS_W + (size_t)l * W_LAYER + W_KV + 8 * MiB), 1024, 1024, 1024, 1, (long)SEQ * 1024, 0, (long)DM * 1024, 0};
            pg8::Order S; S.init(SEQ, DM, 2, G, cu_opaque());
            pg8::EpiRes E{nullptr, nullptr, ST + (size_t)(3 * l) * T * 2, INP(13) + (size_t)l * DM, INP(14) + (size_t)l * DM, (bf16_t*)(ws + WS_XN), ST + (size_t)(3 * l + 1) * T * 2, ALPHA, SEQ};
            pg8::gemm_phase<pg8::EpiRes, true>((LAS unsigned char*)lds, g, S, E);
        }
        GRID_BAR();
        {
            unsigned char* ws = ws_opaque(a);
            const float* cl = (const float*)(ws + WS_C) + (size_t)l * C_LAYER;
            pg8::Gemm g{(const bf16_t*)(ws + WS_XN), (const bf16_t*)(ws + WS_W + (size_t)l * W_LAYER + W_GU), DM, DM, DM, 1, 0, 0, 0, 0};
            pg8::Order S; S.init(T, 2 * DFF, 1, G, cu_opaque());
            pg8::EpiSwiglu E{(bf16_t*)(ws + WS_PROJ), (const float*)(ws + WS_ST) + (size_t)(3 * l + 1) * T * 2, cl + C_GU, cl + C_GU + 2 * DFF};
            pg8::gemm_phase<pg8::EpiSwiglu, true>((LAS unsigned char*)lds, g, S, E);
        }
        GRID_BAR();
        {
            unsigned char* ws = ws_opaque(a); float* X = out_opaque(a); float* ST = (float*)(ws + WS_ST);
            pg8::Gemm g{(const bf16_t*)(ws + WS_PROJ), (const bf16_t*)(ws + WS_W + (size_t)l * W_LAYER + W_D), DFF, DFF, DFF, 1, 0, 0, 0, 0};
            pg8::Order S; S.init(T, DM, 1, G, cu_opaque());
            pg8::EpiRes E{l + 1 == DEPTH ? X : nullptr, nullptr, ST + (size_t)(3 * l + 1) * T * 2, INP(18) + (size_t)l * DM, INP(19) + (size_t)l * DM, (bf16_t*)(ws + WS_XN), ST + (size_t)(3 * l + 2) * T * 2, ALPHA, 0};
            pg8::gemm_phase<pg8::EpiRes, true>((LAS unsigned char*)lds, g, S, E);
        }
        GRID_BAR();
        if (l + 1 == DEPTH) { LN_PASS(INP(22) + (size_t)l * DM, INP(23) + (size_t)l * DM, false); }
#undef LN_PASS
    }
    if (a.ws == nullptr) cg::this_grid().sync();
}

extern "C" void kernel_launch(void* const* d_in, const int* in_sizes, int n_in, void* d_out, int out_size, void* d_ws, size_t ws_size, hipStream_t stream) {
    static int grid = 0;
    if (grid == 0) {
        if (n_in != 24 || in_sizes[0] != T * DM || out_size != T * DM || ws_size < WS_END) {
            fprintf(stderr, "kernel_launch: unexpected shapes (n_in %d, in0 %d, out %d, ws %zu); nothing launched\n", n_in, n_in > 0 ? in_sizes[0] : -1, out_size, ws_size); grid = -1; return; }
        int dev = 0, cus = 0, per_cu = 0;
        (void)hipGetDevice(&dev);
        if (hipDeviceGetAttribute(&cus, hipDeviceAttributeMultiprocessorCount, dev) != hipSuccess || cus <= 0) cus = 256;
        if (hipFuncSetAttribute((const void*)mega_fwd, hipFuncAttributeMaxDynamicSharedMemorySize, LDS_BYTES) != hipSuccess) fprintf(stderr, "kernel_launch: hipFuncSetAttribute failed\n");
        if (hipOccupancyMaxActiveBlocksPerMultiprocessor(&per_cu, (const void*)mega_fwd, NTHR, LDS_BYTES) != hipSuccess || per_cu < 1) { fprintf(stderr, "kernel_launch: occupancy query says %d\n", per_cu); per_cu = 1; }
        (void)hipGetLastError();
        grid = cus * per_cu;
    }
    if (grid < 0) return;
    if (hipMemsetAsync((char*)d_ws + WS_BAR, 0, 512 * 1024, stream) != hipSuccess || hipMemsetAsync((char*)d_ws + WS_ST, 0, 1 * MiB, stream) != hipSuccess) { fprintf(stderr, "kernel_launch: hipMemsetAsync failed\n"); return; }
    Args a{};
    for (int i = 0; i < 24; ++i) a.in[i] = (const float*)d_in[i];
    a.out = (float*)d_out; a.ws = (unsigned char*)d_ws;
    void* args[] = {&a};
    hipError_t e = hipLaunchCooperativeKernel((const void*)mega_fwd, dim3(grid), dim3(NTHR), args, LDS_BYTES, stream);
    if (e != hipSuccess) fprintf(stderr, "cooperative launch failed: %s (grid %d)\n", hipGetErrorString(e), grid);
}
```

```cpp
#include <hip/hip_runtime.h>
#include <hip/hip_cooperative_groups.h>
#include <hip/hip_bf16.h>
#include <cstdio>
#include <cstdint>
namespace cg = cooperative_groups;

constexpr int BATCH = 2, SEQ = 8192, DM = 2048, DEPTH = 2, T = BATCH * SEQ;
constexpr int NMEM = 256, INC = 5632, DFF = 5632;
constexpr float ALPHA = 1.4142135623730951f;
constexpr float LN_EPS = 1e-5f;
constexpr int NTHR = 512, NWAVES = 8;

constexpr size_t MiB = 1u << 20;
constexpr size_t WS_LAM = 0;
constexpr size_t WS_BTAB = 4096;
constexpr size_t WS_BAR = 512 * 1024;
constexpr size_t WS_C = 576 * 1024;
constexpr int C_Q = 0, C_GU = 4096, C_IN = 4096 + 22528, C_QK2 = 4096 + 22528 + 11264, C_LAYER = C_QK2 + 2048;
constexpr size_t WS_ST = 12 * MiB;
constexpr size_t WS_WTRIL = 1 * MiB;
constexpr size_t WS_MEMBF = 2 * MiB;
constexpr size_t WS_KV = 4 * MiB;
constexpr size_t WS_W = 16 * MiB;
constexpr size_t W_IN = 0, W_OUT = 22 * MiB, W_Q = 30 * MiB, W_KV = 38 * MiB, W_O = 54 * MiB, W_GU = 62 * MiB, W_D = 106 * MiB, W_LAYER = 128 * MiB;
constexpr size_t WS_XN = 272 * MiB;
constexpr size_t WS_PROJ = 336 * MiB;
constexpr size_t WS_R1 = 512 * MiB;
constexpr size_t WS_Y = 640 * MiB;
constexpr size_t WS_END = 704 * MiB;
constexpr int LDS_BYTES = 147456;

typedef unsigned short bf16_t;
typedef short bf16x8 __attribute__((ext_vector_type(8)));
typedef float f32x4 __attribute__((ext_vector_type(4)));
typedef float f32x16 __attribute__((ext_vector_type(16)));
typedef unsigned u32x4 __attribute__((ext_vector_type(4)));
typedef unsigned u32x2 __attribute__((ext_vector_type(2)));
#define LAS __attribute__((address_space(3)))
#define GAS __attribute__((address_space(1)))

__device__ __forceinline__ unsigned cvt_pk_bf16(float lo, float hi) { unsigned r; asm volatile("v_cvt_pk_bf16_f32 %0, %1, %2" : "=v"(r) : "v"(lo), "v"(hi)); return r; }
__device__ __forceinline__ float bf_lo(unsigned w) { return __uint_as_float(w << 16); }
__device__ __forceinline__ float bf_hi(unsigned w) { return __uint_as_float(w & 0xffff0000u); }
__device__ __forceinline__ float bf2f(bf16_t b) { return __uint_as_float(((unsigned)b) << 16); }
__device__ __forceinline__ bf16_t f2bf(float f) { return (bf16_t)(cvt_pk_bf16(f, 0.f) & 0xffffu); }
__device__ __forceinline__ int ltid() { int t = threadIdx.x; asm volatile("" : "+v"(t)); return t; }
__device__ __forceinline__ int cu_opaque() { int c = blockIdx.x; asm volatile("" : "+s"(c)); return c; }
#define PH_IDS const int cu = cu_opaque(); const int tid = ltid(), lane = tid & 63, wave = __builtin_amdgcn_readfirstlane(tid >> 6), gw = cu * NWAVES + wave, gt = cu * NTHR + tid; (void)lane; (void)wave; (void)gw; (void)gt
__device__ __forceinline__ float wave_sum(float v) {
#pragma unroll
    for (int o = 1; o < 64; o <<= 1) v += __shfl_xor(v, o);
    return v;
}
__device__ __forceinline__ float wave_max(float v) {
#pragma unroll
    for (int o = 1; o < 64; o <<= 1) v = fmaxf(v, __shfl_xor(v, o));
    return v;
}
__device__ __forceinline__ float gelu_tanh(float x) {
    const float y = 0.7978845608028654f * (x + 0.044715f * x * x * x);
    return x * __builtin_amdgcn_rcpf(1.f + __expf(-2.f * y));
}

namespace pg8 {
constexpr int BM = 256, BK = 64, HALF = 128, HTB = HALF * BK * 2, STAGE_BYTES = 8 * HTB, NXCD = 8, WGM = 8;
__host__ __device__ __forceinline__ int lds_byte(int r, int c) { const int st = (r >> 4) * 2 + (c >> 5), rr = r & 15, cc = c & 31, ob = rr * 64 + cc * 2; return st * 1024 + (ob ^ (((ob >> 9) & 1) << 5)); }
__host__ __device__ __forceinline__ void stage_rc(int b, int& R, int& C) { const int st = b / 1024, sb = b % 1024, swz = sb ^ (((sb >> 9) & 1) << 5); R = (st >> 1) * 16 + swz / 64; C = (st & 1) * 32 + (swz % 64) / 2; }
__host__ __device__ __forceinline__ int perm32(int rho) { const int n = rho >> 4, i = rho & 15; return 8 * (i >> 2) + 4 * n + (i & 3); }

struct Unit { int pm, pn, bz; };
struct Gemm { const bf16_t* A; const bf16_t* Bt; int lda, ldb, K, nb0; long a_s1, a_s0, b_s1, b_s0; };
__device__ __forceinline__ const char* unit_a(const Gemm& g, const Unit& u) { const int b1 = u.bz / g.nb0, b0 = u.bz % g.nb0; return (const char*)(g.A + (size_t)b1 * g.a_s1 + (size_t)b0 * g.a_s0 + (size_t)u.pm * BM * g.lda); }
__device__ __forceinline__ const char* unit_b(const Gemm& g, const Unit& u) { const int b1 = u.bz / g.nb0, b0 = u.bz % g.nb0; return (const char*)(g.Bt + (size_t)b1 * g.b_s1 + (size_t)b0 * g.b_s0 + (size_t)u.pn * BM * g.ldb); }

struct Order {
    int nM, nN, nB, G, c;
    __device__ void init(int M, int N, int nB_, int G_, int c_) { nM = M / BM; nN = N / BM; nB = nB_; G = G_; c = c_; }
    __device__ bool next(int i, Unit& u) const {
        const long L = (long)i * G + c; const int nwg = nM * nN; if (c < 0 || L >= (long)nwg * nB) return false;
        if (nB > 1) { u.bz = (int)(L / nwg); const int w = (int)(L % nwg); u.pn = w / nM; u.pm = w % nM; return true; }
        u.bz = 0;
        int wgid = (int)L; { const int q = nwg / NXCD, r = nwg % NXCD, xcd = wgid % NXCD, off = wgid / NXCD; wgid = (xcd < r ? xcd * (q + 1) : r * (q + 1) + (xcd - r) * q) + off; }
        const int nig = WGM * nN, gid = wgid / nig, fm = gid * WGM, gsz = (nM - fm) < WGM ? (nM - fm) : WGM;
        u.pm = fm + ((wgid % nig) % gsz); u.pn = (wgid % nig) / gsz; return true;
    }
};

__device__ __forceinline__ void row_stats(const float* st, int row, float& mean, float& rstd) {
    const float s1 = st[2 * row], s2 = st[2 * row + 1];
    mean = s1 * (1.f / DM); const float var = fmaxf(s2 * (1.f / DM) - mean * mean, 0.f); rstd = rsqrtf(var + LN_EPS);
}
struct EpiSplit {
    static constexpr bool PERM = true, AFTER_DRAIN = false;
    bf16_t* P; const float* st; const float* c1; const float* c2;
    __device__ __forceinline__ void operator()(const f32x4 (&acc)[2][2][4][2], const Unit& u, int wr, int wc, int fr, int fq) const {
        const int row0 = u.pm * BM + wr * 64 + fr, col0 = u.pn * BM + wc * 32 + 8 * fq;
        f32x4 k1[2][2], k2[2][2];
        if (st) {
#pragma unroll
            for (int bj = 0; bj < 2; ++bj)
#pragma unroll
                for (int n = 0; n < 2; ++n) { k1[bj][n] = *(const f32x4*)(c1 + col0 + bj * HALF + 4 * n); k2[bj][n] = *(const f32x4*)(c2 + col0 + bj * HALF + 4 * n); } }
#pragma unroll
        for (int ai = 0; ai < 2; ++ai)
#pragma unroll
            for (int m = 0; m < 4; ++m) { const int row = row0 + ai * HALF + m * 16;
                float mean = 0.f, rstd = 1.f; if (st) row_stats(st, row, mean, rstd);
#pragma unroll
                for (int bj = 0; bj < 2; ++bj) { f32x4 v0 = acc[ai][bj][m][0], v1 = acc[ai][bj][m][1];
                    if (st) { v0 = (v0 - k1[bj][0] * mean) * rstd + k2[bj][0]; v1 = (v1 - k1[bj][1] * mean) * rstd + k2[bj][1]; }
                    u32x4 w; w.x = cvt_pk_bf16(v0[0], v0[1]); w.y = cvt_pk_bf16(v0[2], v0[3]); w.z = cvt_pk_bf16(v1[0], v1[1]); w.w = cvt_pk_bf16(v1[2], v1[3]);
                    *(u32x4*)(P + ((size_t)(u.pn * 2 + bj) * T + row) * 128 + wc * 32 + 8 * fq) = w; } }
    }
};
struct EpiBf16 {
    static constexpr bool PERM = true, AFTER_DRAIN = false;
    bf16_t* O; int ldc, nb0; long o_s1, o_s0; float scale; const float* st; const float* c1; const float* c2; float* rsum;
    __device__ __forceinline__ void operator()(const f32x4 (&acc)[2][2][4][2], const Unit& u, int wr, int wc, int fr, int fq) const {
        const int row0 = u.pm * BM + wr * 64 + fr, col0 = u.pn * BM + wc * 32 + 8 * fq;
        bf16_t* base = O + (size_t)(u.bz / nb0) * o_s1 + (size_t)(u.bz % nb0) * o_s0;
        f32x4 k1[2][2], k2[2][2];
        if (st) {
#pragma unroll
            for (int bj = 0; bj < 2; ++bj)
#pragma unroll
                for (int n = 0; n < 2; ++n) { k1[bj][n] = *(const f32x4*)(c1 + col0 + bj * HALF + 4 * n); k2[bj][n] = *(const f32x4*)(c2 + col0 + bj * HALF + 4 * n); } }
#pragma unroll
        for (int ai = 0; ai < 2; ++ai)
#pragma unroll
            for (int m = 0; m < 4; ++m) { const int row = row0 + ai * HALF + m * 16; bf16_t* rowp = base + (size_t)row * ldc + col0;
                float mean = 0.f, rstd = 1.f; if (st) row_stats(st, row, mean, rstd);
                float rs = 0.f;
#pragma unroll
                for (int bj = 0; bj < 2; ++bj) { f32x4 v0 = acc[ai][bj][m][0], v1 = acc[ai][bj][m][1];
                    if (st) { v0 = (v0 - k1[bj][0] * mean) * rstd + k2[bj][0]; v1 = (v1 - k1[bj][1] * mean) * rstd + k2[bj][1]; }
                    v0 = v0 * scale; v1 = v1 * scale;
                    u32x4 w; w.x = cvt_pk_bf16(v0[0], v0[1]); w.y = cvt_pk_bf16(v0[2], v0[3]); w.z = cvt_pk_bf16(v1[0], v1[1]); w.w = cvt_pk_bf16(v1[2], v1[3]);
                    *(u32x4*)(rowp + bj * HALF) = w;
                    if (rsum) rs += ((bf_lo(w.x) + bf_hi(w.x)) + (bf_lo(w.y) + bf_hi(w.y))) + ((bf_lo(w.z) + bf_hi(w.z)) + (bf_lo(w.w) + bf_hi(w.w))); }
                if (rsum) { rs += __shfl_xor(rs, 16); rs += __shfl_xor(rs, 32); if (fq == 0) unsafeAtomicAdd(rsum + u.bz * 256 + row, rs); } }
    }
};
struct EpiF32 {
    static constexpr bool PERM = false, AFTER_DRAIN = false;
    float* out; int ldc; long o_bs; float scale;
    __device__ __forceinline__ void operator()(const f32x4 (&acc)[2][2][4][2], const Unit& u, int wr, int wc, int fr, int fq) const {
        const int row0 = u.pm * BM + wr * 64 + fr, col0 = u.pn * BM + wc * 32 + 4 * fq;
        float* ob = out + (size_t)u.bz * o_bs;
#pragma unroll
        for (int ai = 0; ai < 2; ++ai)
#pragma unroll
            for (int m = 0; m < 4; ++m) { const size_t off = (size_t)(row0 + ai * HALF + m * 16) * ldc + col0;
#pragma unroll
                for (int bj = 0; bj < 2; ++bj)
#pragma unroll
                    for (int n = 0; n < 2; ++n) *(f32x4*)(ob + off + bj * HALF + n * 16) = acc[ai][bj][m][n] * scale; }
    }
};
struct EpiRes {
    static constexpr bool PERM = true, AFTER_DRAIN = false;
    float* X; const float* raw; const float* pst; const float* pg; const float* pb; bf16_t* ZB; float* cst; float alpha; int brows;
    __device__ __forceinline__ void operator()(const f32x4 (&acc)[2][2][4][2], const Unit& u, int wr, int wc, int fr, int fq) const {
        const int row0 = u.bz * brows + u.pm * BM + wr * 64 + fr, col0 = u.pn * BM + wc * 32 + 8 * fq;
        f32x4 gv[2][2], bv[2][2];
        if (!raw) {
#pragma unroll
            for (int bj = 0; bj < 2; ++bj)
#pragma unroll
                for (int n = 0; n < 2; ++n) { gv[bj][n] = *(const f32x4*)(pg + col0 + bj * HALF + 4 * n); bv[bj][n] = *(const f32x4*)(pb + col0 + bj * HALF + 4 * n); } }
#pragma unroll
        for (int ai = 0; ai < 2; ++ai)
#pragma unroll
            for (int m = 0; m < 4; ++m) { const int row = row0 + ai * HALF + m * 16; const size_t off = (size_t)row * DM + col0;
                float mean = 0.f, rstd = 1.f; if (!raw) row_stats(pst, row, mean, rstd);
                float s1 = 0.f, s2 = 0.f;
#pragma unroll
                for (int bj = 0; bj < 2; ++bj) { f32x4 r0, r1;
                    if (raw) { r0 = *(const f32x4*)(raw + off + bj * HALF); r1 = *(const f32x4*)(raw + off + bj * HALF + 4); }
                    else { const u32x4 zw = *(const u32x4*)(ZB + off + bj * HALF);
                        r0 = (f32x4){bf_lo(zw.x), bf_hi(zw.x), bf_lo(zw.y), bf_hi(zw.y)}; r1 = (f32x4){bf_lo(zw.z), bf_hi(zw.z), bf_lo(zw.w), bf_hi(zw.w)};
                        r0 = (r0 - mean) * rstd * gv[bj][0] + bv[bj][0]; r1 = (r1 - mean) * rstd * gv[bj][1] + bv[bj][1]; }
                    const f32x4 z0 = acc[ai][bj][m][0] + r0 * alpha, z1 = acc[ai][bj][m][1] + r1 * alpha;
                    if (X) { *(f32x4*)(X + off + bj * HALF) = z0; *(f32x4*)(X + off + bj * HALF + 4) = z1; }
                    u32x4 w; w.x = cvt_pk_bf16(z0[0], z0[1]); w.y = cvt_pk_bf16(z0[2], z0[3]); w.z = cvt_pk_bf16(z1[0], z1[1]); w.w = cvt_pk_bf16(z1[2], z1[3]);
                    *(u32x4*)(ZB + off + bj * HALF) = w;
                    s1 += ((z0[0] + z0[1]) + (z0[2] + z0[3])) + ((z1[0] + z1[1]) + (z1[2] + z1[3]));
                    s2 += ((z0[0] * z0[0] + z0[1] * z0[1]) + (z0[2] * z0[2] + z0[3] * z0[3])) + ((z1[0] * z1[0] + z1[1] * z1[1]) + (z1[2] * z1[2] + z1[3] * z1[3])); }
                s1 += __shfl_xor(s1, 16); s1 += __shfl_xor(s1, 32); s2 += __shfl_xor(s2, 16); s2 += __shfl_xor(s2, 32);
                if (fq == 0) { unsafeAtomicAdd(cst + 2 * row, s1); unsafeAtomicAdd(cst + 2 * row + 1, s2); } }
    }
};
struct EpiSwiglu {
    static constexpr bool PERM = true, AFTER_DRAIN = false;
    bf16_t* H; const float* st; const float* c1; const float* c2;
    __device__ __forceinline__ void operator()(const f32x4 (&acc)[2][2][4][2], const Unit& u, int wr, int wc, int fr, int fq) const {
        const int row0 = u.pm * BM + wr * 64 + fr, col0 = u.pn * HALF + wc * 32 + 8 * fq, ccol0 = u.pn * BM + wc * 32 + 8 * fq;
        f32x4 k1[2][2], k2[2][2];
#pragma unroll
        for (int bj = 0; bj < 2; ++bj)
#pragma unroll
            for (int n = 0; n < 2; ++n) { k1[bj][n] = *(const f32x4*)(c1 + ccol0 + bj * HALF + 4 * n); k2[bj][n] = *(const f32x4*)(c2 + ccol0 + bj * HALF + 4 * n); }
#pragma unroll
        for (int ai = 0; ai < 2; ++ai)
#pragma unroll
            for (int m = 0; m < 4; ++m) { const int row = row0 + ai * HALF + m * 16; bf16_t* rowp = H + (size_t)row * DFF + col0;
                float mean, rstd; row_stats(st, row, mean, rstd);
                float h[8];
#pragma unroll
                for (int n = 0; n < 2; ++n) { const f32x4 gq = (acc[ai][0][m][n] - k1[0][n] * mean) * rstd + k2[0][n], uq = (acc[ai][1][m][n] - k1[1][n] * mean) * rstd + k2[1][n];
#pragma unroll
                    for (int j = 0; j < 4; ++j) h[n * 4 + j] = gq[j] * __builtin_amdgcn_rcpf(1.f + __expf(-gq[j])) * uq[j]; }
                u32x4 w; w.x = cvt_pk_bf16(h[0], h[1]); w.y = cvt_pk_bf16(h[2], h[3]); w.z = cvt_pk_bf16(h[4], h[5]); w.w = cvt_pk_bf16(h[6], h[7]);
                *(u32x4*)rowp = w; }
    }
};

struct EpiSoftmax {
    static constexpr bool PERM = true, AFTER_DRAIN = true;
    bf16_t* PALL; const float* st; const float* c1; const float* c2; float scale;
    __device__ __forceinline__ void fused(f32x4 (&acc)[2][2][4][2], const Unit& u, int wr, int wc, int fr, int fq, LAS unsigned char* lds) const {
        const int b = u.bz >> 2, h = u.bz & 3, rl0 = wr * 64 + fr, cc0 = wc * 32 + 8 * fq;
        LAS float* PMX = (LAS float*)lds; LAS float* PSM = PMX + 1024;
        f32x4 k1[2][2], k2[2][2];
#pragma unroll
        for (int bj = 0; bj < 2; ++bj)
#pragma unroll
            for (int n = 0; n < 2; ++n) { k1[bj][n] = *(const f32x4*)(c1 + u.bz * 256 + cc0 + bj * HALF + 4 * n); k2[bj][n] = *(const f32x4*)(c2 + u.bz * 256 + cc0 + bj * HALF + 4 * n); }
#pragma unroll
        for (int ai = 0; ai < 2; ++ai)
#pragma unroll
            for (int m = 0; m < 4; ++m) { const int rl = rl0 + ai * HALF + m * 16, row = b * SEQ + u.pm * BM + rl;
                float mean, rstd; row_stats(st, row, mean, rstd);
                float mx = -__builtin_inff();
#pragma unroll
                for (int bj = 0; bj < 2; ++bj)
#pragma unroll
                    for (int n = 0; n < 2; ++n) { const f32x4 v = ((acc[ai][bj][m][n] - k1[bj][n] * mean) * rstd + k2[bj][n]) * scale; acc[ai][bj][m][n] = v;
                        mx = fmaxf(mx, fmaxf(fmaxf(v[0], v[1]), fmaxf(v[2], v[3]))); }
                mx = fmaxf(mx, __shfl_xor(mx, 16)); mx = fmaxf(mx, __shfl_xor(mx, 32));
                if (fq == 0) PMX[rl * 4 + wc] = mx; }
        asm volatile("s_waitcnt lgkmcnt(0)" ::: "memory"); __builtin_amdgcn_s_barrier(); asm volatile("" ::: "memory");
#pragma unroll
        for (int ai = 0; ai < 2; ++ai)
#pragma unroll
            for (int m = 0; m < 4; ++m) { const int rl = rl0 + ai * HALF + m * 16;
                const f32x4 q = *(const LAS f32x4*)(PMX + rl * 4); const float mx = fmaxf(fmaxf(q[0], q[1]), fmaxf(q[2], q[3]));
                float sm = 0.f;
#pragma unroll
                for (int bj = 0; bj < 2; ++bj)
#pragma unroll
                    for (int n = 0; n < 2; ++n) { f32x4 e = acc[ai][bj][m][n] - mx; e[0] = __expf(e[0]); e[1] = __expf(e[1]); e[2] = __expf(e[2]); e[3] = __expf(e[3]); acc[ai][bj][m][n] = e;
                        sm += (e[0] + e[1]) + (e[2] + e[3]); }
                sm += __shfl_xor(sm, 16); sm += __shfl_xor(sm, 32);
                if (fq == 0) PSM[rl * 4 + wc] = sm; }
        asm volatile("s_waitcnt lgkmcnt(0)" ::: "memory"); __builtin_amdgcn_s_barrier(); asm volatile("" ::: "memory");
#pragma unroll
        for (int ai = 0; ai < 2; ++ai)
#pragma unroll
            for (int m = 0; m < 4; ++m) { const int rl = rl0 + ai * HALF + m * 16, row = b * SEQ + u.pm * BM + rl;
                const f32x4 q = *(const LAS f32x4*)(PSM + rl * 4); const float inv = __builtin_amdgcn_rcpf((q[0] + q[1]) + (q[2] + q[3]));
                bf16_t* rowp = PALL + (size_t)row * 1024 + h * 256 + cc0;
#pragma unroll
                for (int bj = 0; bj < 2; ++bj) { const f32x4 v0 = acc[ai][bj][m][0] * inv, v1 = acc[ai][bj][m][1] * inv;
                    u32x4 w; w.x = cvt_pk_bf16(v0[0], v0[1]); w.y = cvt_pk_bf16(v0[2], v0[3]); w.z = cvt_pk_bf16(v1[0], v1[1]); w.w = cvt_pk_bf16(v1[2], v1[3]);
                    *(u32x4*)(rowp + bj * HALF) = w; } }
    }
};

template <class Epi, bool ALIGN_EPI>
__device__ __forceinline__ void gemm_phase(LAS unsigned char* lds, const Gemm g, const Order& S, const Epi& E) {
    const int tid = ltid(), wid = __builtin_amdgcn_readfirstlane(tid >> 6), lane = tid & 63, wr = wid >> 2, wc = wid & 3, fr = lane & 15, fq = lane >> 4;
    const int K = g.K, nt = K / BK;
    unsigned voffA[2], voffB[2];
#pragma unroll
    for (int i = 0; i < 2; ++i) { int R, C; stage_rc(tid * 16 + i * 8192, R, C); const int Rb = Epi::PERM ? ((R & ~31) + perm32(R & 31)) : R;
        voffA[i] = (unsigned)(R * g.lda + C) * 2u; voffB[i] = (unsigned)(Rb * g.ldb + C) * 2u; }
    const size_t kstep = (size_t)(BK * 2);
    const size_t hstepA = (size_t)HALF * g.lda * 2, hstepB = (size_t)HALF * g.ldb * 2;
    const unsigned ldsw = (unsigned)wid * 1024u;
    const int aoff = lds_byte(wr * 64 + fr, fq * 8), boff = lds_byte(wc * 32 + fr, fq * 8);
#define PG8_SA(b, h) (((b) * 2 + (h)) * HTB)
#define PG8_SB(b, h) ((4 + (b) * 2 + (h)) * HTB)
#define PG8_STAGE(bufoff, gbase, voff) do { _Pragma("unroll") for (int _i = 0; _i < 2; ++_i) \
        __builtin_amdgcn_global_load_lds((const unsigned*)((const char*)(gbase) + (voff)[_i]), (LAS unsigned*)(lds + (bufoff) + ldsw + _i * 8192), 16, 0, 0); } while (0)
#define PG8_LDA(dst, b, h) do { _Pragma("unroll") for (int m = 0; m < 4; ++m) _Pragma("unroll") for (int k = 0; k < 2; ++k) dst[m][k] = *(const LAS bf16x8*)(lds + PG8_SA(b, h) + aoff + m * 2048 + k * 1024); } while (0)
#define PG8_LDB(dst, b, h) do { _Pragma("unroll") for (int n = 0; n < 2; ++n) _Pragma("unroll") for (int k = 0; k < 2; ++k) dst[n][k] = *(const LAS bf16x8*)(lds + PG8_SB(b, h) + boff + n * 2048 + k * 1024); } while (0)
#define PG8_MMA(ai, bj, At, Bt) do { __builtin_amdgcn_s_setprio(1); _Pragma("unroll") for (int m = 0; m < 4; ++m) _Pragma("unroll") for (int n = 0; n < 2; ++n) _Pragma("unroll") for (int k = 0; k < 2; ++k) \
        acc[ai][bj][m][n] = __builtin_amdgcn_mfma_f32_16x16x32_bf16(Bt[n][k], At[m][k], acc[ai][bj][m][n], 0, 0, 0); __builtin_amdgcn_s_setprio(0); } while (0)
#define PG8_WAIT_V(n) asm volatile("s_waitcnt vmcnt(" #n ")" ::: "memory")
#define PG8_WAIT_L(n) asm volatile("s_waitcnt lgkmcnt(" #n ")" ::: "memory")
#define PG8_BAR __builtin_amdgcn_s_barrier()
#define PG8_SCHED __builtin_amdgcn_sched_barrier(0)
    Unit cur, nxt; int ui = 0;
    if (!S.next(0, cur)) return;
    f32x4 acc[2][2][4][2];
#pragma unroll
    for (int a = 0; a < 2; ++a)
#pragma unroll
        for (int b = 0; b < 2; ++b)
#pragma unroll
            for (int m = 0; m < 4; ++m)
#pragma unroll
                for (int n = 0; n < 2; ++n) acc[a][b][m][n] = (f32x4){0.f, 0.f, 0.f, 0.f};
    bf16x8 At[4][2], B0[2][2], B1[2][2];
    const char* cA = unit_a(g, cur); const char* cB = unit_b(g, cur);
    PG8_STAGE(PG8_SB(0, 0), cB, voffB); PG8_STAGE(PG8_SB(0, 1), cB + hstepB, voffB); PG8_STAGE(PG8_SA(0, 0), cA, voffA); PG8_STAGE(PG8_SA(0, 1), cA + hstepA, voffA);
    if (wr == 1) PG8_BAR;
    PG8_WAIT_V(2); PG8_BAR;
    PG8_STAGE(PG8_SB(1, 0), cB + kstep, voffB); PG8_STAGE(PG8_SA(1, 0), cA + kstep, voffA); PG8_STAGE(PG8_SB(1, 1), cB + hstepB + kstep, voffB);
    PG8_WAIT_V(6); PG8_BAR;
    for (;;) {
        const bool has_next = S.next(ui + 1, nxt);
        const char* nA = has_next ? unit_a(g, nxt) : cA; const char* nB = has_next ? unit_b(g, nxt) : cB;
        for (int t = 0; t < nt; t += 2) {
            const bool last = (t == nt - 2);
            const char* a1 = cA + (size_t)(t + 1) * kstep;
            const char* a2 = last ? nA : cA + (size_t)(t + 2) * kstep; const char* b2 = last ? nB : cB + (size_t)(t + 2) * kstep;
            const char* a3 = a2 + kstep; const char* b3 = b2 + kstep;
            PG8_LDB(B0, 0, 0); PG8_LDB(B1, 0, 1); PG8_SCHED; PG8_LDA(At, 0, 0); PG8_STAGE(PG8_SA(1, 1), a1 + hstepA, voffA);
            PG8_WAIT_V(8); PG8_WAIT_L(0); PG8_BAR; PG8_MMA(0, 0, At, B0); PG8_MMA(0, 1, At, B1); PG8_BAR; PG8_SCHED;
            PG8_LDA(At, 0, 1); PG8_STAGE(PG8_SB(0, 0), b2, voffB); PG8_STAGE(PG8_SB(0, 1), b2 + hstepB, voffB); PG8_STAGE(PG8_SA(0, 0), a2, voffA);
            PG8_WAIT_V(8); PG8_WAIT_L(0); PG8_BAR; PG8_MMA(1, 0, At, B0); PG8_MMA(1, 1, At, B1); PG8_BAR; PG8_SCHED;
            PG8_LDB(B0, 1, 0); PG8_LDB(B1, 1, 1); PG8_SCHED; PG8_LDA(At, 1, 0); PG8_STAGE(PG8_SA(0, 1), a2 + hstepA, voffA);
            PG8_WAIT_V(8); PG8_WAIT_L(0); PG8_BAR; PG8_MMA(0, 0, At, B0); PG8_MMA(0, 1, At, B1); PG8_BAR; PG8_SCHED;
            PG8_LDA(At, 1, 1); PG8_STAGE(PG8_SB(1, 0), b3, voffB); PG8_STAGE(PG8_SB(1, 1), b3 + hstepB, voffB); PG8_STAGE(PG8_SA(1, 0), a3, voffA);
            PG8_WAIT_V(8); PG8_WAIT_L(0); PG8_BAR; PG8_MMA(1, 0, At, B0); PG8_MMA(1, 1, At, B1); PG8_BAR; PG8_SCHED;
        }
        if constexpr (ALIGN_EPI) { if (wr == 0) PG8_BAR; }
        if constexpr (!Epi::AFTER_DRAIN) E(acc, cur, wr, wc, fr, fq);
        if (!has_next) break;
#pragma unroll
        for (int a = 0; a < 2; ++a)
#pragma unroll
            for (int b = 0; b < 2; ++b)
#pragma unroll
                for (int m = 0; m < 4; ++m)
#pragma unroll
                    for (int n = 0; n < 2; ++n) acc[a][b][m][n] = (f32x4){0.f, 0.f, 0.f, 0.f};
        cur = nxt; cA = nA; cB = nB; ++ui;
        if constexpr (ALIGN_EPI) { if (wr == 1) PG8_BAR; }
    }
    PG8_WAIT_V(0);
    if constexpr (!ALIGN_EPI) { if (wr == 0) PG8_BAR; }
    PG8_BAR;
    if constexpr (Epi::AFTER_DRAIN) E.fused(acc, cur, wr, wc, fr, fq, lds);
#undef PG8_SA
#undef PG8_SB
#undef PG8_STAGE
#undef PG8_LDA
#undef PG8_LDB
#undef PG8_MMA
#undef PG8_WAIT_V
#undef PG8_WAIT_L
#undef PG8_BAR
#undef PG8_SCHED
}
}

namespace att {
using bf16 = __hip_bfloat16;
typedef short s16x4 __attribute__((ext_vector_type(4)));
constexpr int D = 128;
constexpr float THR = 8.f;
constexpr float SCALE = 0.08838834764831845f;
constexpr int NW = 8, QBLK = 32, KVBLK = 64, QB = NW * QBLK;
constexpr int SHM_V = KVBLK * D * 2, SHM_K = KVBLK * D * 2;
constexpr int ATT_LDS = 2 * SHM_V + 2 * SHM_K + NW * 64 * 4;
constexpr int BT_OFF = ATT_LDS;

#define KSWZ(row, colB) ((row) * 256 + ((colB) ^ (((row) & 7) << 4)))
#define SBAR() __builtin_amdgcn_sched_barrier(0)
__device__ __forceinline__ int v_st(int k, int c) { const int kk = (k & ~0xC) | ((k & 4) << 1) | ((k & 8) >> 1); return ((kk >> 3) * 4 + (c >> 5)) * 512 + ((kk & 7) * 32 + (c & 31)) * 2; }
__device__ __forceinline__ int v_rd_base(int lane) { return ((lane & 3) << 3) | (((lane >> 2) & 3) << 6) | (((lane >> 4) & 1) << 5) | (((lane >> 5) & 1) << 8); }
constexpr int v_rd_off(int d0, int ks, int half) { return d0 * 512 + ks * 4096 + half * 2048; }
__device__ __forceinline__ int crow(int r, int hi) { return (r & 3) + 8 * (r >> 2) + 4 * hi; }
__device__ __forceinline__ unsigned cvtpk(float lo, float hi) { unsigned r; asm volatile("v_cvt_pk_bf16_f32 %0, %1, %2" : "=v"(r) : "v"(lo), "v"(hi)); return r; }
__device__ __forceinline__ bf16x8 load8(const bf16* p) { return *reinterpret_cast<const bf16x8*>(p); }
__device__ __forceinline__ void bias_mask_tile(f32x16& p0, f32x16& p1, int dq, const float* bt) {
    const float NEG = -__builtin_inff();
#pragma unroll
    for (int r = 0; r < 16; ++r) {
        const int c = (r & 3) + 8 * (r >> 2);
        const int d0 = dq - c, d1 = dq - c - 32;
        const unsigned i0 = (unsigned)d0 < 255u ? (unsigned)d0 : 255u, i1 = (unsigned)d1 < 255u ? (unsigned)d1 : 255u;
        const float b0 = bt[i0], b1 = bt[i1];
        p0[r] = d0 >= 0 ? p0[r] + b0 : NEG;
        p1[r] = d1 >= 0 ? p1[r] + b1 : NEG;
    }
}
__device__ __forceinline__ void partialSM(f32x16& p0, f32x16& p1, float& m_reg, float& mn, float& alpha) {
    float pmax = p0[0]; for (int r = 1; r < 16; ++r) pmax = fmaxf(pmax, p0[r]); for (int r = 0; r < 16; ++r) pmax = fmaxf(pmax, p1[r]);
    { auto rr = __builtin_amdgcn_permlane32_swap(__float_as_uint(pmax), __float_as_uint(pmax), false, false);
      pmax = fmaxf(__uint_as_float(rr[0]), __uint_as_float(rr[1])); }
    constexpr float C2 = 1.4426950408889634f * SCALE;
    if (__builtin_expect(__all((pmax - m_reg) * SCALE <= THR), 1)) { mn = m_reg; alpha = 1.f; }
    else { mn = fmaxf(m_reg, pmax); alpha = __builtin_amdgcn_exp2f((m_reg - mn) * C2); m_reg = mn; }
    const float mnL = -mn * C2;
    for (int r = 0; r < 16; ++r) p0[r] = fmaf(p0[r], C2, mnL); for (int r = 0; r < 16; ++r) p1[r] = fmaf(p1[r], C2, mnL);
    for (int r = 0; r < 16; ++r) p0[r] = __builtin_amdgcn_exp2f(p0[r]);
}
__device__ __forceinline__ void finishSM(f32x16& p0, f32x16& p1, float alpha, float& l_reg, bf16x8& pa0, bf16x8& pa1, bf16x8& pa2, bf16x8& pa3) {
    for (int r = 0; r < 16; ++r) p1[r] = __builtin_amdgcn_exp2f(p1[r]);
    float ps = 0; for (int r = 0; r < 16; ++r) ps += p0[r]; for (int r = 0; r < 16; ++r) ps += p1[r];
    { auto rr = __builtin_amdgcn_permlane32_swap(__float_as_uint(ps), __float_as_uint(ps), false, false);
      ps = __uint_as_float(rr[0]) + __uint_as_float(rr[1]); }
    l_reg = l_reg * alpha + ps;
#define PK4(P, B_, OUT) do { unsigned a0 = cvtpk(P[B_+0], P[B_+1]), a1 = cvtpk(P[B_+2], P[B_+3]);                          \
        unsigned b0 = cvtpk(P[B_+4], P[B_+5]), b1 = cvtpk(P[B_+6], P[B_+7]);                                             \
        auto r0 = __builtin_amdgcn_permlane32_swap(a0, b0, false, false); auto r1 = __builtin_amdgcn_permlane32_swap(a1, b1, false, false); \
        u32x4 w = {r0[0], r1[0], r0[1], r1[1]}; OUT = *reinterpret_cast<bf16x8*>(&w); } while (0)
    PK4(p0, 0, pa0); PK4(p0, 8, pa1); PK4(p1, 0, pa2); PK4(p1, 8, pa3);
#undef PK4
}
template <int KB>
__device__ __forceinline__ void qkt(f32x16& p0, f32x16& p1, const char* K_lds, int r32, int hi, const bf16x8* qr) {
    p0 = f32x16{}; p1 = f32x16{};
    const char* kb[4];
#pragma unroll
    for (int dd = 0; dd < 4; ++dd) kb[dd] = K_lds + KB * SHM_K + KSWZ(r32, (dd * 16 + hi * 8) * 2);
#pragma unroll
    for (int d0 = 0; d0 < 8; ++d0) { const char* a = kb[d0 & 3] + (d0 >> 2) * 128;
        bf16x8 b0 = *reinterpret_cast<const bf16x8*>(a);
        bf16x8 b1 = *reinterpret_cast<const bf16x8*>(a + 32 * 256);
        p0 = __builtin_amdgcn_mfma_f32_32x32x16_bf16(b0, qr[d0], p0, 0, 0, 0);
        p1 = __builtin_amdgcn_mfma_f32_32x32x16_bf16(b1, qr[d0], p1, 0, 0, 0); }
}
template <int VB>
__device__ __forceinline__ void pv_tile(f32x16* o, int vb0, bf16x8 pa0, bf16x8 pa1, bf16x8 pa2, bf16x8 pa3) {
#define TRRD(dst, off) asm volatile("ds_read_b64_tr_b16 %0, %1 offset:%2" : "=&v"(dst) : "v"(vb0), "i"(off) : "memory")
#define PV_D0(d0) do { s16x4 l0, l1, l2, l3, h0, h1, h2, h3; constexpr int b_ = VB * SHM_V + v_rd_off(d0, 0, 0); \
        TRRD(l0, b_); TRRD(h0, b_ + 2048); TRRD(l1, b_ + 4096); TRRD(h1, b_ + 6144); TRRD(l2, b_ + 8192); TRRD(h2, b_ + 10240); TRRD(l3, b_ + 12288); TRRD(h3, b_ + 14336); \
        asm volatile("s_waitcnt lgkmcnt(0)" ::: "memory"); SBAR();   \
        o[d0] = __builtin_amdgcn_mfma_f32_32x32x16_bf16(pa0, (bf16x8){l0[0], l0[1], l0[2], l0[3], h0[0], h0[1], h0[2], h0[3]}, o[d0], 0, 0, 0);   \
        o[d0] = __builtin_amdgcn_mfma_f32_32x32x16_bf16(pa1, (bf16x8){l1[0], l1[1], l1[2], l1[3], h1[0], h1[1], h1[2], h1[3]}, o[d0], 0, 0, 0);   \
        o[d0] = __builtin_amdgcn_mfma_f32_32x32x16_bf16(pa2, (bf16x8){l2[0], l2[1], l2[2], l2[3], h2[0], h2[1], h2[2], h2[3]}, o[d0], 0, 0, 0);   \
        o[d0] = __builtin_amdgcn_mfma_f32_32x32x16_bf16(pa3, (bf16x8){l3[0], l3[1], l3[2], l3[3], h3[0], h3[1], h3[2], h3[3]}, o[d0], 0, 0, 0); } while (0)
    PV_D0(0); PV_D0(1); PV_D0(2); PV_D0(3);
#undef PV_D0
#undef TRRD
}
struct BlockRef { const bf16* Q; const bf16* K; const bf16* V; float* O; int P0; int hm; };
struct Seam { bf16x8 qr[8]; bf16x8 st_v0, st_v1, st_k0, st_k1; };
#define ROW(p, k0, rr) ((p) + (size_t)((k0) + (rr)) * D + sc)
#define VMW() asm volatile("s_waitcnt vmcnt(0)" ::: "memory")
#define VMWN(n) asm volatile("s_waitcnt vmcnt(%0)" :: "i"(n) : "memory")
#define SLOAD_H(Kp, Vp, k0) do { S.st_v0 = load8(ROW(Vp, k0, sr)); S.st_v1 = load8(ROW(Vp, k0, 32 + sr));              \
                         S.st_k0 = load8(ROW(Kp, k0, sr)); S.st_k1 = load8(ROW(Kp, k0, 32 + sr)); } while (0)
#define SWRITE_HK(bf) do { *(bf16x8*)(K_lds + (bf) * SHM_K + kws) = S.st_k0; *(bf16x8*)(K_lds + (bf) * SHM_K + kws + 32 * 256) = S.st_k1; } while (0)
#define SWRITE_HV(bf) do { *(bf16x8*)(V_lds + (bf) * SHM_V + vst0) = S.st_v0; *(bf16x8*)(V_lds + (bf) * SHM_V + vst1) = S.st_v1; } while (0)
#define SWRITE_H(bf) do { SWRITE_HV(bf); SWRITE_HK(bf); } while (0)
__device__ __forceinline__ void attn_prime(const BlockRef& cur, char* lds, Seam& S) {
    const int tid = ltid(), wid = __builtin_amdgcn_readfirstlane(tid >> 6), lane = tid & 63, r32 = lane & 31, hi = lane >> 5;
    const int sr = tid >> 4, sc = (tid & 15) * 8, kws = KSWZ(sr, sc * 2); char* K_lds = lds + 2 * SHM_V;
    const int kb0 = 0;
    for (int d0 = 0; d0 < 8; ++d0) S.qr[d0] = load8(cur.Q + (size_t)(wid * QBLK + r32) * D + d0 * 16 + hi * 8);
    SLOAD_H(cur.K, cur.V, kb0); VMW(); SWRITE_HK(0);
    __syncthreads();
}
__device__ __forceinline__ void attn_block(const BlockRef& cur, const BlockRef& nxt, char* lds, Seam& S) {
    const int tid = ltid(), wid = __builtin_amdgcn_readfirstlane(tid >> 6), lane = tid & 63, r32 = lane & 31, hi = lane >> 5;
    const int j_lo = 0;
    const int j_hi = (cur.P0 + QB - 1) / KVBLK + 1;
    const int NT = j_hi - j_lo;
    const int kbn = 0;
    const int qlo = cur.P0 + wid * QBLK, qm = qlo + r32 - 4 * hi;
    char* V_lds = lds; char* K_lds = lds + 2 * SHM_V;
    float* ws = (float*)(lds + 2 * SHM_V + 2 * SHM_K) + wid * 64; float* li_l = ws, * al_l = ws + 32;
    const float* bt = (const float*)(lds + BT_OFF) + cur.hm * 256;
    float m_reg = -1e30f, l_reg = 0; f32x16 o[4] = {};
    const int sr = tid >> 4, sc = (tid & 15) * 8, vst0 = v_st(sr, sc), vst1 = v_st(32 + sr, sc), kws = KSWZ(sr, sc * 2);
    const int vb0 = (int)(uintptr_t)V_lds + v_rd_base(lane);
    const bf16* Kh = cur.K; const bf16* Vh = cur.V;
#define RESC(a) do { if (__any((a) < 1.f)) { if (hi == 0) al_l[r32] = (a); asm volatile("s_waitcnt lgkmcnt(0)" ::: "memory");              \
                     for (int d_ = 0; d_ < 4; ++d_) for (int r = 0; r < 16; ++r) o[d_][r] *= al_l[crow(r, hi)]; } } while (0)
#define KBASE(t) ((j_lo + (t)) * KVBLK)
#define MASKT(P0_, P1_, t) do { const int kb_ = KBASE(t); if (kb_ + KVBLK - 1 > qlo - 128) bias_mask_tile(P0_, P1_, qm - kb_, bt); } while (0)
    constexpr int NQL = 8;
#define SEAM_K0() do { VMWN(NQL); SWRITE_HK(0); SBAR(); } while (0)
    f32x16 pA0, pA1, pB0, pB1; float mnA, mnB, alA, alB; bf16x8 pa0, pa1, pa2, pa3;
    SWRITE_HV(0); SBAR();
    if (NT > 1) { SLOAD_H(Kh, Vh, KBASE(1)); }
    SBAR(); qkt<0>(pA0, pA1, K_lds, r32, hi, S.qr);
    MASKT(pA0, pA1, 0); partialSM(pA0, pA1, m_reg, mnA, alA);
    if (NT > 1) { VMW(); SWRITE_H(1); }
    __syncthreads();
#define HALF_STEP(PX0, PX1, mnX, alX, PY0, PY1, alY, t, KB, VB, SB) do {                                                      \
        SBAR(); qkt<KB>(PX0, PX1, K_lds, r32, hi, S.qr);                                             \
        finishSM(PY0, PY1, alY, l_reg, pa0, pa1, pa2, pa3); SBAR();                                                           \
        if ((t) + 1 < NT) { SLOAD_H(Kh, Vh, KBASE((t) + 1)); SBAR(); }                                               \
        pv_tile<VB>(o, vb0, pa0, pa1, pa2, pa3); MASKT(PX0, PX1, (t)); partialSM(PX0, PX1, m_reg, mnX, alX);                                        \
        __syncthreads();                                                                                                      \
        if ((t) + 1 < NT) { VMW(); SWRITE_H(SB); }                                                                          \
        RESC(alX); __syncthreads(); } while (0)
    for (int t = 1; t + 1 < NT; t += 2) {
        HALF_STEP(pB0, pB1, mnB, alB, pA0, pA1, alA, t, 1, 0, 0);
        HALF_STEP(pA0, pA1, mnA, alA, pB0, pB1, alB, t + 1, 0, 1, 1);
    }
    const bool even = (NT & 1) == 0;
    if (even) { SBAR(); qkt<1>(pB0, pB1, K_lds, r32, hi, S.qr); SBAR(); }
    SLOAD_H(nxt.K, nxt.V, kbn); SBAR();
#pragma unroll
    for (int d0 = 0; d0 < 8; ++d0) S.qr[d0] = load8(nxt.Q + (size_t)(wid * QBLK + r32) * D + d0 * 16 + hi * 8);
    SBAR();
    finishSM(pA0, pA1, alA, l_reg, pa0, pa1, pa2, pa3); SBAR();
    pv_tile<0>(o, vb0, pa0, pa1, pa2, pa3);
    if (even) { MASKT(pB0, pB1, NT - 1); partialSM(pB0, pB1, m_reg, mnB, alB); __syncthreads(); RESC(alB);
        finishSM(pB0, pB1, alB, l_reg, pa0, pa1, pa2, pa3); SBAR(); pv_tile<1>(o, vb0, pa0, pa1, pa2, pa3); }
    SBAR(); SEAM_K0();
    if (hi == 0) li_l[r32] = l_reg; asm volatile("s_waitcnt lgkmcnt(0)" ::: "memory");
    float rli[16];
#pragma unroll
    for (int r = 0; r < 16; ++r) rli[r] = __builtin_amdgcn_rcpf(li_l[crow(r, hi)]);
    float* Ow = cur.O + (size_t)(wid * QBLK) * D;
#pragma unroll
    for (int r = 0; r < 16; ++r) { const int orow = crow(r, hi);
#pragma unroll
        for (int d0 = 0; d0 < 4; ++d0) { const float v = o[d0][r] * rli[r]; Ow[(size_t)orow * D + d0 * 32 + r32] = v; } }
    __syncthreads();
#undef RESC
#undef KBASE
#undef MASKT
#undef SEAM_K0
#undef HALF_STEP
}
#undef ROW
#undef VMW
#undef VMWN
#undef SLOAD_H
#undef SWRITE_HK
#undef SWRITE_HV
#undef SWRITE_H
}

namespace att2 {
using att::bf16; using att::D; using att::SHM_K; using att::SHM_V;
constexpr int L_V = 0, L_K = 65536, L_P = 98304, L_AL = 131072, L_FL = 132096, L_LB = 132224, L_BT = 133120;
struct Blk { const bf16* Q; const bf16* K; const bf16* V0; const bf16* V1; float* O0; float* O1; int P0; int hm; };
__device__ __forceinline__ void qkt_rt(f32x16& p0, f32x16& p1, const char* Kb, int r32, int hi, const bf16x8* qr) {
    p0 = f32x16{}; p1 = f32x16{};
    const char* kb[4];
#pragma unroll
    for (int dd = 0; dd < 4; ++dd) kb[dd] = Kb + KSWZ(r32, (dd * 16 + hi * 8) * 2);
#pragma unroll
    for (int d0 = 0; d0 < 8; ++d0) { const char* a = kb[d0 & 3] + (d0 >> 2) * 128;
        bf16x8 b0 = *reinterpret_cast<const bf16x8*>(a);
        bf16x8 b1 = *reinterpret_cast<const bf16x8*>(a + 32 * 256);
        p0 = __builtin_amdgcn_mfma_f32_32x32x16_bf16(b0, qr[d0], p0, 0, 0, 0);
        p1 = __builtin_amdgcn_mfma_f32_32x32x16_bf16(b1, qr[d0], p1, 0, 0, 0); }
}
#define A2_LOADT(t) do { const size_t ro_ = (size_t)((t) * 64 + sr) * D + sc; \
        sk0 = att::load8(c.K + ro_); sk1 = att::load8(c.K + ro_ + 32 * D); sv00 = att::load8(c.V0 + ro_); sv01 = att::load8(c.V0 + ro_ + 32 * D); sv10 = att::load8(c.V1 + ro_); sv11 = att::load8(c.V1 + ro_ + 32 * D); } while (0)
#define A2_WRITET(buf) do { char* kd_ = lds + L_K + (buf) * SHM_K; char* vd_ = lds + L_V + (buf) * 2 * SHM_V; \
        *(bf16x8*)(kd_ + kws) = sk0; *(bf16x8*)(kd_ + kws + 32 * 256) = sk1; *(bf16x8*)(vd_ + vst0) = sv00; *(bf16x8*)(vd_ + vst1) = sv01; *(bf16x8*)(vd_ + SHM_V + vst0) = sv10; *(bf16x8*)(vd_ + SHM_V + vst1) = sv11; } while (0)
__device__ __forceinline__ void attn2_block(const Blk& c, char* lds) {
    const int tid = ltid(), wid = __builtin_amdgcn_readfirstlane(tid >> 6), lane = tid & 63, r32 = lane & 31, hi = lane >> 5;
    const int g = wid & 3;
    const int NT = (c.P0 + 127) / 64 + 1;
    const int sr = tid >> 4, sc = (tid & 15) * 8, kws = KSWZ(sr, sc * 2), vst0 = att::v_st(sr, sc), vst1 = att::v_st(32 + sr, sc);
    bf16x8 sk0, sk1, sv00, sv01, sv10, sv11;
    float* ALb = (float*)(lds + L_AL) + g * 64; unsigned* FLb = (unsigned*)(lds + L_FL) + g * 2; float* LBb = (float*)(lds + L_LB) + g * 32;
    char* Pb = lds + L_P + g * 8192;
    A2_LOADT(0);
    if (wid < 4) {
        bf16x8 qr[8];
#pragma unroll
        for (int d0 = 0; d0 < 8; ++d0) qr[d0] = att::load8(c.Q + (size_t)(g * 32 + r32) * D + d0 * 16 + hi * 8);
        asm volatile("s_waitcnt vmcnt(0)" ::: "memory"); A2_WRITET(0); __syncthreads();
        const int qlo = c.P0 + g * 32, qm = qlo + r32 - 4 * hi;
        const float* bt = (const float*)(lds + L_BT) + c.hm * 256;
        float m_reg = -1e30f, l_reg = 0.f;
        for (int s = 0; s <= NT; ++s) {
            const int par = s & 1;
            if (s + 1 < NT) A2_LOADT(s + 1);
            SBAR();
            if (s < NT) {
                f32x16 p0, p1; float mn, al; bf16x8 pa0, pa1, pa2, pa3;
                qkt_rt(p0, p1, lds + L_K + par * SHM_K, r32, hi, qr);
                const int kb_ = s * 64;
                if (kb_ + 63 > qlo - 128) att::bias_mask_tile(p0, p1, qm - kb_, bt);
                att::partialSM(p0, p1, m_reg, mn, al);
                att::finishSM(p0, p1, al, l_reg, pa0, pa1, pa2, pa3);
                char* pw = Pb + par * 4096 + lane * 16;
                *(bf16x8*)(pw) = pa0; *(bf16x8*)(pw + 1024) = pa1; *(bf16x8*)(pw + 2048) = pa2; *(bf16x8*)(pw + 3072) = pa3;
                if (hi == 0) ALb[par * 32 + r32] = al;
                const bool resc = __any(al < 1.f);
                if (lane == 0) FLb[par] = resc ? 1u : 0u;
            }
            __syncthreads();
            if (s + 1 < NT) { asm volatile("s_waitcnt vmcnt(0)" ::: "memory"); A2_WRITET((s + 1) & 1); }
            __syncthreads();
        }
        if (hi == 0) LBb[r32] = l_reg;
        __syncthreads();
        __syncthreads();
    } else {
        asm volatile("s_waitcnt vmcnt(0)" ::: "memory"); A2_WRITET(0); __syncthreads();
        f32x16 o[8];
#pragma unroll
        for (int d_ = 0; d_ < 8; ++d_) o[d_] = f32x16{};
        const int vbase = (int)(uintptr_t)(lds + L_V) + att::v_rd_base(lane);
        for (int s = 0; s <= NT; ++s) {
            if (s + 1 < NT) A2_LOADT(s + 1);
            SBAR();
            if (s >= 1) {
                const int par = (s - 1) & 1;
                const unsigned fl = (unsigned)__builtin_amdgcn_readfirstlane((int)FLb[par]);
                if (fl) {
#pragma unroll
                    for (int r = 0; r < 16; ++r) { const float a = ALb[par * 32 + att::crow(r, hi)];
#pragma unroll
                        for (int d_ = 0; d_ < 8; ++d_) o[d_][r] *= a; } }
                const char* pr = Pb + par * 4096 + lane * 16;
                const bf16x8 pa0 = *(const bf16x8*)(pr), pa1 = *(const bf16x8*)(pr + 1024), pa2 = *(const bf16x8*)(pr + 2048), pa3 = *(const bf16x8*)(pr + 3072);
                const int vb = vbase + par * 2 * SHM_V;
                att::pv_tile<0>(o, vb, pa0, pa1, pa2, pa3);
                att::pv_tile<0>(o + 4, vb + SHM_V, pa0, pa1, pa2, pa3);
            }
            __syncthreads();
            if (s + 1 < NT) { asm volatile("s_waitcnt vmcnt(0)" ::: "memory"); A2_WRITET((s + 1) & 1); }
            __syncthreads();
        }
        __syncthreads();
        float rli[16];
#pragma unroll
        for (int r = 0; r < 16; ++r) rli[r] = __builtin_amdgcn_rcpf(LBb[att::crow(r, hi)]);
#pragma unroll
        for (int hf = 0; hf < 2; ++hf) { float* Ow = (hf ? c.O1 : c.O0) + (size_t)(g * 32) * D;
#pragma unroll
            for (int r = 0; r < 16; ++r) { const int orow = att::crow(r, hi);
#pragma unroll
                for (int d0 = 0; d0 < 4; ++d0) Ow[(size_t)orow * D + d0 * 32 + r32] = o[hf * 4 + d0][r] * rli[r]; } }
        __syncthreads();
    }
}
#undef A2_LOADT
#undef A2_WRITET
}


#define XB_TMO      128
#define XB_XCNT(j)  (256  + 64 * (j))
#define XB_XSUB(j)  (1280 + 64 * (j))
#define XB_XGEN(j)  (2304 + 64 * (j))
#define XB_TOP      3328
#define XB_TOPGEN   3392
#define XCD_BAR_WORDS 3456
#define XB_SPIN_CAP (1u << 18)
__device__ __forceinline__ unsigned xb_ld(unsigned* p)              { return __hip_atomic_load(p, __ATOMIC_RELAXED, __HIP_MEMORY_SCOPE_AGENT); }
__device__ __forceinline__ unsigned xb_add(unsigned* p, unsigned v) { return __hip_atomic_fetch_add(p, v, __ATOMIC_RELAXED, __HIP_MEMORY_SCOPE_AGENT); }
__device__ __forceinline__ unsigned xb_xcc_id() { return (unsigned)__builtin_amdgcn_s_getreg((3 << 11) | 20) & 0xFu; }
#define XB_SPIN(cond, bar) do { unsigned _sp = 0; while (cond) { __builtin_amdgcn_s_sleep(1); \
    if ((++_sp & 255u) == 0u) { if (xb_ld(&(bar)[XB_TMO])) break; if (_sp > XB_SPIN_CAP) { atomicAdd(&(bar)[XB_TMO], 1u); break; } } } } while (0)
struct XcdBarrier { unsigned* bar; unsigned x; volatile LAS unsigned* st; };
__device__ __forceinline__ XcdBarrier xcd_barrier_post(unsigned* bar, volatile LAS unsigned* st) {
    XcdBarrier b; b.bar = bar; b.x = xb_xcc_id(); b.st = st;
    if (threadIdx.x == 0) (void)xb_add(&bar[XB_XCNT(b.x)], 1u);
    return b;
}
__device__ __forceinline__ void xcd_barrier_complete(unsigned* bar, unsigned x, unsigned& nloc, unsigned& nx) {
    const unsigned G = gridDim.x * gridDim.y * gridDim.z;
    unsigned sum, cnt, mine, sp = 0u;
    for (;;) {
        sum = 0u; cnt = 0u; mine = 0u;
#pragma unroll
        for (unsigned j = 0; j < 16; ++j) { const unsigned c = xb_ld(&bar[XB_XCNT(j)]); sum += c; cnt += (c > 0u) ? 1u : 0u; mine = (j == x) ? c : mine; }
        if (sum == G) break;
        __builtin_amdgcn_s_sleep(1);
        if ((++sp & 255u) == 0u) { if (xb_ld(&bar[XB_TMO])) break; if (sp > XB_SPIN_CAP) { atomicAdd(&bar[XB_TMO], 1u); break; } }
    }
    nloc = mine > 0u ? mine : 1u; nx = cnt > 0u ? cnt : 1u;
}
__device__ __forceinline__ void xcd_barrier(const XcdBarrier& b) {
    asm volatile("s_waitcnt vmcnt(0)" ::: "memory");
    __syncthreads();
    if (threadIdx.x == 0) {
        unsigned* bar = b.bar;
        __builtin_amdgcn_s_waitcnt(0);
        unsigned nloc = b.st[0], nx = b.st[1];
        if (nloc == 0u) { xcd_barrier_complete(bar, b.x, nloc, nx); b.st[0] = nloc; b.st[1] = nx; }
        const unsigned old = xb_add(&bar[XB_XSUB(b.x)], 1u);
        const unsigned gen = old / nloc;
        if (old + 1u == (gen + 1u) * nloc) {
            __builtin_amdgcn_fence(__ATOMIC_RELEASE, "agent");
            asm volatile("s_waitcnt vmcnt(0)" ::: "memory");
            const unsigned og = xb_add(&bar[XB_TOP], 1u);
            const unsigned tg = og / nx;
            if (og + 1u == (tg + 1u) * nx) xb_add(&bar[XB_TOPGEN], 1u);
            else XB_SPIN(xb_ld(&bar[XB_TOPGEN]) == tg, bar);
            __builtin_amdgcn_fence(__ATOMIC_ACQUIRE, "agent");
            xb_add(&bar[XB_XGEN(b.x)], 1u);
            asm volatile("s_waitcnt vmcnt(0)" ::: "memory");
        } else {
            XB_SPIN(xb_ld(&bar[XB_XGEN(b.x)]) == gen, bar);
            __builtin_amdgcn_fence(__ATOMIC_ACQUIRE, "agent");
            asm volatile("s_waitcnt vmcnt(0)" ::: "memory");
        }
    }
    __syncthreads();
}

struct Args { const float* in[24]; float* out; unsigned char* ws; };

__device__ __forceinline__ void p0_transpose_item(const float* W, int K, int N, bf16_t* WT, int swiglu, const float* gk, const float* bk, float* c1, float* c2, LAS float* scr, int item, int lane) {
    const int nblk = N / 64, kb = item / nblk, nb = item % nblk, k0 = 64 * kb, n0 = 64 * nb;
    const float* src = W + (size_t)(k0 + (lane >> 4)) * N + n0 + (lane & 15) * 4;
    f32x4 v[16];
#pragma unroll
    for (int i = 0; i < 16; ++i) v[i] = *(const f32x4*)(src + (size_t)(4 * i) * N);
#pragma unroll
    for (int i = 0; i < 16; ++i) { LAS float* d = scr + (4 * i + (lane >> 4)) * 65 + (lane & 15) * 4; d[0] = v[i][0]; d[1] = v[i][1]; d[2] = v[i][2]; d[3] = v[i][3]; }
    asm volatile("s_waitcnt lgkmcnt(0)" ::: "memory");
    int r0 = n0;
    if (swiglu) { const int half = n0 / DFF, idx = n0 % DFF; r0 = 256 * (idx / 128) + 128 * half + (idx % 128); }
    const int c = lane & 7;
    float g8[8], b8[8];
#pragma unroll
    for (int e = 0; e < 8; ++e) { g8[e] = gk ? gk[k0 + 8 * c + e] : 1.f; b8[e] = gk ? bk[k0 + 8 * c + e] : 0.f; }
#pragma unroll
    for (int j = 0; j < 8; ++j) { const int n = (lane >> 3) + 8 * j; const LAS float* q = scr + (8 * c) * 65 + n;
        float w8[8];
#pragma unroll
        for (int e = 0; e < 8; ++e) w8[e] = q[e * 65];
        u32x4 o; o.x = cvt_pk_bf16(w8[0] * g8[0], w8[1] * g8[1]); o.y = cvt_pk_bf16(w8[2] * g8[2], w8[3] * g8[3]); o.z = cvt_pk_bf16(w8[4] * g8[4], w8[5] * g8[5]); o.w = cvt_pk_bf16(w8[6] * g8[6], w8[7] * g8[7]);
        *(u32x4*)(WT + (size_t)(r0 + n) * K + k0 + 8 * c) = o;
        if (gk) {
            float s1 = ((bf_lo(o.x) + bf_hi(o.x)) + (bf_lo(o.y) + bf_hi(o.y))) + ((bf_lo(o.z) + bf_hi(o.z)) + (bf_lo(o.w) + bf_hi(o.w)));
            float s2 = ((w8[0] * b8[0] + w8[1] * b8[1]) + (w8[2] * b8[2] + w8[3] * b8[3])) + ((w8[4] * b8[4] + w8[5] * b8[5]) + (w8[6] * b8[6] + w8[7] * b8[7]));
            s1 += __shfl_xor(s1, 1); s1 += __shfl_xor(s1, 2); s1 += __shfl_xor(s1, 4); s2 += __shfl_xor(s2, 1); s2 += __shfl_xor(s2, 2); s2 += __shfl_xor(s2, 4);
            if (c == 0) { unsafeAtomicAdd(c1 + r0 + n, s1); unsafeAtomicAdd(c2 + r0 + n, s2); }
        } }
    asm volatile("s_waitcnt lgkmcnt(0)" ::: "memory");
}

__device__ __forceinline__ void p0_wq_item(const float* W, bf16_t* WN, const float* gk, const float* bk, float* bW, int item, int lane) {
    const int kb = item >> 5, jb = item & 31, k0 = 64 * kb, j0 = 64 * jb, cg8 = lane & 7, kr = lane >> 3;
    float sacc[8];
#pragma unroll
    for (int e = 0; e < 8; ++e) sacc[e] = 0.f;
#pragma unroll
    for (int i = 0; i < 8; ++i) { const int k = k0 + 8 * i + kr; const float* src = W + (size_t)k * DM + j0 + 8 * cg8;
        const f32x4 v0 = *(const f32x4*)src, v1 = *(const f32x4*)(src + 4); const float g = gk[k], bb = bk[k];
        u32x4 o; o.x = cvt_pk_bf16(v0[0] * g, v0[1] * g); o.y = cvt_pk_bf16(v0[2] * g, v0[3] * g); o.z = cvt_pk_bf16(v1[0] * g, v1[1] * g); o.w = cvt_pk_bf16(v1[2] * g, v1[3] * g);
        *(u32x4*)(WN + (size_t)k * DM + j0 + 8 * cg8) = o;
#pragma unroll
        for (int e = 0; e < 4; ++e) { sacc[e] += bb * v0[e]; sacc[4 + e] += bb * v1[e]; } }
#pragma unroll
    for (int e = 0; e < 8; ++e) { float v = sacc[e]; v += __shfl_xor(v, 8); v += __shfl_xor(v, 16); v += __shfl_xor(v, 32); if (kr == 0) unsafeAtomicAdd(bW + j0 + 8 * cg8 + e, v); }
}

__device__ __forceinline__ int causal_bucket(int n) {
    if (n < 16) return n;
    const float nf = (float)n;
    int large = 16 + (int)(logf(nf / 16.f) / 2.0794415416798357f * 16.f);
    return large < 31 ? large : 31;
}

__device__ __forceinline__ size_t zero_opaque() { size_t z = 0; asm volatile("" : "+s"(z)); return z; }
__device__ __forceinline__ const float* inp_ptr(const Args& a, int k) { return a.in[k] + zero_opaque(); }
#define INP(k) inp_ptr(a, k)
__device__ __forceinline__ unsigned char* ws_opaque(const Args& a) { return a.ws + zero_opaque(); }
__device__ __forceinline__ float* out_opaque(const Args& a) { return a.out + zero_opaque(); }
#define WSP(type, off) ((type*)(ws_opaque(a) + (off)))
__global__ void __launch_bounds__(NTHR, 2) mega_fwd(Args a) {
    extern __shared__ __attribute__((aligned(16))) unsigned char lds[];
    volatile LAS unsigned* bst = (volatile LAS unsigned*)((LAS unsigned char*)lds + LDS_BYTES - 64);
    if (threadIdx.x == 0) { bst[0] = 0u; bst[1] = 0u; }
    __syncthreads();
    (void)xcd_barrier_post((unsigned*)(a.ws + WS_BAR), bst);
#define GRID_BAR() do { XcdBarrier xb_; xb_.bar = (unsigned*)(ws_opaque(a) + WS_BAR); unsigned x_ = xb_xcc_id(); asm volatile("" : "+s"(x_)); xb_.x = x_; xb_.st = bst; xcd_barrier(xb_); } while (0)
    const int G = gridDim.x;
    const int NGW = G * NWAVES, NGT = G * NTHR;
    {
        PH_IDS;
        unsigned char* ws = ws_opaque(a);
        float* lamp = (float*)(ws + WS_LAM); float* btab = (float*)(ws + WS_BTAB); bf16_t* wtril = (bf16_t*)(ws + WS_WTRIL); bf16_t* membf = (bf16_t*)(ws + WS_MEMBF); bf16_t* XN = (bf16_t*)(ws + WS_XN);
        LAS float* scr = (LAS float*)((LAS unsigned char*)lds + wave * 17408);
        constexpr int I_IN = 32 * 88, I_SQ = 32 * 32, I_KV = 32 * 64, I_GU = 32 * 176, I_D = 88 * 32;
        constexpr int PER_LAYER = I_IN + 3 * I_SQ + I_KV + I_GU + I_D;
        for (int it = gw; it < 2 * PER_LAYER; it += NGW) {
            const int l = it / PER_LAYER; int r = it % PER_LAYER;
            unsigned char* wl = ws + WS_W + (size_t)l * W_LAYER;
            float* cl = (float*)(ws + WS_C) + (size_t)l * C_LAYER;
            if (r < I_IN) { const bool f = l > 0;
                p0_transpose_item(INP(3) + (size_t)l * DM * INC, DM, INC, (bf16_t*)(wl + W_IN), 0, f ? INP(22) : nullptr, f ? INP(23) : nullptr, cl + C_IN, cl + C_IN + INC, scr, r, lane); continue; } r -= I_IN;
            if (r < I_SQ) { p0_transpose_item(INP(12) + (size_t)l * DM * DM, DM, DM, (bf16_t*)(wl + W_OUT), 0, nullptr, nullptr, nullptr, nullptr, scr, r, lane); continue; } r -= I_SQ;
            if (r < I_SQ) { p0_wq_item(INP(15) + (size_t)l * DM * DM, (bf16_t*)(wl + W_Q), INP(13) + (size_t)l * DM, INP(14) + (size_t)l * DM, cl + C_Q + DM, r, lane); continue; } r -= I_SQ;
            if (r < I_KV) { p0_transpose_item(INP(16) + (size_t)l * DM * 2 * DM, DM, 2 * DM, (bf16_t*)(wl + W_KV), 0, nullptr, nullptr, nullptr, nullptr, scr, r, lane); continue; } r -= I_KV;
            if (r < I_SQ) { p0_transpose_item(INP(17) + (size_t)l * DM * DM, DM, DM, (bf16_t*)(wl + W_O), 0, nullptr, nullptr, nullptr, nullptr, scr, r, lane); continue; } r -= I_SQ;
            if (r < I_GU) { p0_transpose_item(INP(20) + (size_t)l * DM * 2 * DFF, DM, 2 * DFF, (bf16_t*)(wl + W_GU), 1, INP(18) + (size_t)l * DM, INP(19) + (size_t)l * DM, cl + C_GU, cl + C_GU + 2 * DFF, scr, r, lane); continue; } r -= I_GU;
            p0_transpose_item(INP(21) + (size_t)l * DFF * DM, DFF, DM, (bf16_t*)(wl + W_D), 0, nullptr, nullptr, nullptr, nullptr, scr, r, lane);
        }
        for (size_t i = gt; i < (size_t)T * DM / 8; i += NGT) {
            const f32x4 v0 = *(const f32x4*)(INP(0) + i * 8), v1 = *(const f32x4*)(INP(0) + i * 8 + 4);
            u32x4 w; w.x = cvt_pk_bf16(v0[0], v0[1]); w.y = cvt_pk_bf16(v0[2], v0[3]); w.z = cvt_pk_bf16(v1[0], v1[1]); w.w = cvt_pk_bf16(v1[2], v1[3]);
            *(u32x4*)(XN + i * 8) = w;
        }
        for (size_t i = gt; i < (size_t)BATCH * NMEM * DM / 8; i += NGT) {
            const f32x4 v0 = *(const f32x4*)(INP(1) + i * 8), v1 = *(const f32x4*)(INP(1) + i * 8 + 4);
            u32x4 w; w.x = cvt_pk_bf16(v0[0], v0[1]); w.y = cvt_pk_bf16(v0[2], v0[3]); w.z = cvt_pk_bf16(v1[0], v1[1]); w.w = cvt_pk_bf16(v1[2], v1[3]);
            *(u32x4*)(membf + i * 8) = w;
        }
        for (int i = gt; i < DEPTH * 4 * 128 * 128; i += NGT) { const int s = i & 127, t = (i >> 7) & 127; wtril[i] = s <= t ? f2bf(INP(7)[i]) : (bf16_t)0; }
        if (gt < 8 * 256) { const int hm = gt >> 8, d = gt & 255; const float* rb = INP(2);
            btab[gt] = (rb[causal_bucket(d) * 8 + hm] - rb[31 * 8 + hm]) * (1.f / att::SCALE); }
        if (cu == 0 && wave == 0) {
            for (int l = 0; l < DEPTH; ++l) {
                const float* lq = INP(9) + l * 256; const float* lk = INP(10) + l * 256;
                float s0 = lq[lane] * lk[lane] + lq[lane + 64] * lk[lane + 64];
                float s1 = lq[128 + lane] * lk[128 + lane] + lq[192 + lane] * lk[192 + lane];
                s0 = wave_sum(s0); s1 = wave_sum(s1);
                const float lam_init = 0.8f - 0.6f * expf(-0.3f * (float)l);
                if (lane == 0) lamp[l] = expf(s0) - expf(s1) + lam_init;
            }
        }
    }
    GRID_BAR();

#pragma unroll 1
    for (int l = 0; l < DEPTH; ++l) {
        {
            unsigned char* ws = ws_opaque(a);
            pg8::Gemm g{(const bf16_t*)(ws + WS_XN), (const bf16_t*)(ws + WS_W + (size_t)l * W_LAYER + W_IN), DM, DM, DM, 1, 0, 0, 0, 0};
            pg8::Order S; S.init(T, INC, 1, G, cu_opaque());
            const float* cl = (const float*)(ws + WS_C) + (size_t)l * C_LAYER;
            const float* st = l > 0 ? (const float*)(ws + WS_ST) + (size_t)(3 * l - 1) * T * 2 : nullptr;
            pg8::EpiSplit E{(bf16_t*)(ws + WS_PROJ), st, cl + C_IN, cl + C_IN + INC};
            pg8::gemm_phase<pg8::EpiSplit, true>((LAS unsigned char*)lds, g, S, E);
        }
        if (l == 0) {
            {
                unsigned char* ws = ws_opaque(a);
                pg8::Gemm g{(const bf16_t*)(ws + WS_MEMBF), (const bf16_t*)(ws + WS_W + W_KV), DM, DM, DM, 1, 0, 0, (long)(W_LAYER / 2), 0};
                pg8::Order S; const int cu = cu_opaque(); S.init(BATCH * NMEM, 2 * DM, 2, G, cu >= 128 && cu < 192 ? cu - 128 : -1);
                pg8::EpiBf16 E{(bf16_t*)(ws + WS_KV), 2 * DM, 1, (long)(BATCH * NMEM) * 2 * DM, 0, 1.f, nullptr, nullptr, nullptr, nullptr};
                pg8::gemm_phase<pg8::EpiBf16, true>((LAS unsigned char*)lds, g, S, E);
            }
        }
        GRID_BAR();

        if (l == 0) {
#pragma unroll 1
            for (int L2 = 0; L2 < DEPTH; ++L2) {
                {
                    unsigned char* ws = ws_opaque(a); unsigned char* wl2 = ws + WS_W + (size_t)L2 * W_LAYER;
                    const bf16_t* KVl = (const bf16_t*)(ws + WS_KV) + (size_t)L2 * BATCH * NMEM * 2 * DM;
                    float* cl = (float*)(ws + WS_C) + (size_t)L2 * C_LAYER;
                    pg8::Gemm g{KVl, (const bf16_t*)(wl2 + W_Q), 2 * DM, DM, 512, 4, (long)NMEM * 2 * DM, 512, 0, 512};
                    pg8::Order S; const int cu = cu_opaque(); S.init(NMEM, DM, 8, G, cu >= 64 * L2 && cu < 64 * L2 + 64 ? cu - 64 * L2 : -1);
                    pg8::EpiBf16 E{(bf16_t*)(wl2 + W_KV), DM, 1, (long)NMEM * DM, 0, 1.f, nullptr, nullptr, nullptr, cl + C_Q};
                    pg8::gemm_phase<pg8::EpiBf16, true>((LAS unsigned char*)lds, g, S, E);
                }
                {
                    unsigned char* ws = ws_opaque(a); unsigned char* wl2 = ws + WS_W + (size_t)L2 * W_LAYER;
                    const bf16_t* KVl = (const bf16_t*)(ws + WS_KV) + (size_t)L2 * BATCH * NMEM * 2 * DM;
                    pg8::Gemm g{(const bf16_t*)(wl2 + W_O), KVl + DM, DM, 2 * DM, 512, 4, 0, 512, (long)NMEM * 2 * DM, 512};
                    pg8::Order S; const int cu = cu_opaque(); S.init(DM, NMEM, 8, G, cu >= 128 + 64 * L2 && cu < 192 + 64 * L2 ? cu - 128 - 64 * L2 : -1);
                    pg8::EpiBf16 E{(bf16_t*)(wl2 + W_KV + 8 * MiB), 1024, 4, (long)DM * 1024, 256, 1.f, nullptr, nullptr, nullptr, nullptr};
                    pg8::gemm_phase<pg8::EpiBf16, true>((LAS unsigned char*)lds, g, S, E);
                }
            }
            {
                PH_IDS;
                unsigned char* ws = ws_opaque(a);
                for (int it = gw; it < DEPTH * 2048; it += NGW) {
                    const int L2 = it >> 11, r = it & 2047, b = r >> 10, h = (r >> 8) & 3, n = r & 255;
                    const bf16_t* kp = (const bf16_t*)(ws + WS_KV) + ((size_t)L2 * BATCH * NMEM + b * NMEM + n) * 2 * DM + h * 512 + 8 * lane;
                    float* cl = (float*)(ws + WS_C) + (size_t)L2 * C_LAYER;
                    const float* bw = cl + C_Q + DM + h * 512 + 8 * lane;
                    const u32x4 kw = *(const u32x4*)kp; const f32x4 b0 = *(const f32x4*)bw, b1 = *(const f32x4*)(bw + 4);
                    float d = (bf_lo(kw.x) * b0[0] + bf_hi(kw.x) * b0[1]) + (bf_lo(kw.y) * b0[2] + bf_hi(kw.y) * b0[3]) + (bf_lo(kw.z) * b1[0] + bf_hi(kw.z) * b1[1]) + (bf_lo(kw.w) * b1[2] + bf_hi(kw.w) * b1[3]);
                    d = wave_sum(d);
                    if (lane == 0) cl[C_QK2 + r] = d;
                }
            }
            __syncthreads();
        }
        {
            PH_IDS;
            bf16_t* PB = WSP(bf16_t, WS_PROJ); bf16_t* Y = WSP(bf16_t, WS_Y);
            const float* cw = INP(4) + (size_t)l * 3 * 512;
            const int cg8 = tid & 63, c0 = cg8 * 8, gi = cg8 >> 4, cc = c0 & 127;
            float k0[8], k1[8], k2[8];
#pragma unroll
            for (int e = 0; e < 8; ++e) { k0[e] = cw[c0 + e]; k1[e] = cw[512 + c0 + e]; k2[e] = cw[1024 + c0 + e]; }
            for (int r = gt >> 6; r < T; r += NGT >> 6) {
                const int t = r & (SEQ - 1);
                const bf16_t* pb = PB + ((size_t)(0 + gi) * T + r) * 128 + cc;
                const bf16_t* pc = PB + ((size_t)(4 + gi) * T + r) * 128 + cc;
                const bf16_t* ph = PB + ((size_t)(8 + gi) * T + r) * 128 + cc;
                const u32x4 wb = *(const u32x4*)pb, wc0 = *(const u32x4*)pc, wh0 = *(const u32x4*)ph;
                u32x4 wc1 = {0, 0, 0, 0}, wh1 = {0, 0, 0, 0}, wc2 = {0, 0, 0, 0}, wh2 = {0, 0, 0, 0};
                if (t >= 1) { wc1 = *(const u32x4*)(pc - 128); wh1 = *(const u32x4*)(ph - 128); }
                if (t >= 2) { wc2 = *(const u32x4*)(pc - 256); wh2 = *(const u32x4*)(ph - 256); }
                float y[8];
#pragma unroll
                for (int j = 0; j < 4; ++j) {
                    const float z0a = bf_lo(wc0[j]) * bf_lo(wh0[j]), z1a = bf_lo(wc1[j]) * bf_lo(wh1[j]), z2a = bf_lo(wc2[j]) * bf_lo(wh2[j]);
                    const float z0b = bf_hi(wc0[j]) * bf_hi(wh0[j]), z1b = bf_hi(wc1[j]) * bf_hi(wh1[j]), z2b = bf_hi(wc2[j]) * bf_hi(wh2[j]);
                    y[2 * j] = bf_lo(wb[j]) * (k0[2 * j] * z2a + k1[2 * j] * z1a + k2[2 * j] * z0a);
                    y[2 * j + 1] = bf_hi(wb[j]) * (k0[2 * j + 1] * z2b + k1[2 * j + 1] * z1b + k2[2 * j + 1] * z0b);
                }
                u32x4 w; w.x = cvt_pk_bf16(y[0], y[1]); w.y = cvt_pk_bf16(y[2], y[3]); w.z = cvt_pk_bf16(y[4], y[5]); w.w = cvt_pk_bf16(y[6], y[7]);
                *(u32x4*)(Y + (size_t)r * DM + c0) = w;
            }
        }
        {
            PH_IDS;
            bf16_t* PB = WSP(bf16_t, WS_PROJ); bf16_t* Y = WSP(bf16_t, WS_Y); bf16_t* wtril = WSP(bf16_t, WS_WTRIL);
            float* st = (float*)(lds + 40960);
            bf16_t* vT = (bf16_t*)lds;
            const float* lng = INP(5) + (size_t)l * 512; const float* lnb = INP(6) + (size_t)l * 512;
            const float* bs = INP(8) + (size_t)l * 512;
            float* svL = (float*)(lds + 49152);
            for (int un = cu; un < (T / 128) * 4; un += G) {
                const int ch = un >> 2, gi = un & 3, r0 = ch * 128;
                {
                    const int q = lane >> 4, within = lane & 15;
#pragma unroll 4
                    for (int i = 0; i < 16; ++i) { const int token = 8 * i + wave;
                        const u32x4 w = *(const u32x4*)(PB + ((size_t)(16 + q) * T + r0 + token) * 128 + within * 8);
                        float s = 0.f, ss = 0.f;
#pragma unroll
                        for (int j = 0; j < 4; ++j) { const float x0 = gelu_tanh(bf_lo(w[j])), x1 = gelu_tanh(bf_hi(w[j])); s += x0 + x1; ss += x0 * x0 + x1 * x1; }
                        s = wave_sum(s); ss = wave_sum(ss);
                        const float mean = s * (1.f / 512.f), var = fmaxf(ss * (1.f / 512.f) - mean * mean, 0.f);
                        if (lane == 0) { st[2 * token] = mean; st[2 * token + 1] = rsqrtf(var + LN_EPS); } }
                }
                __syncthreads();
                {
                    const int tok = tid >> 2, cq = (tid & 3) * 32; const float mean = st[2 * tok], rstd = st[2 * tok + 1];
                    const bf16_t* vp = PB + ((size_t)(16 + gi) * T + r0 + tok) * 128 + cq;
#pragma unroll
                    for (int i = 0; i < 4; ++i) { const u32x4 w = *(const u32x4*)(vp + 8 * i);
#pragma unroll
                        for (int j = 0; j < 4; ++j) { const int c = cq + 8 * i + 2 * j;
                            const float x0 = gelu_tanh(bf_lo(w[j])), x1 = gelu_tanh(bf_hi(w[j]));
                            vT[c * 136 + tok] = f2bf((x0 - mean) * rstd * lng[gi * 128 + c] + lnb[gi * 128 + c]);
                            vT[(c + 1) * 136 + tok] = f2bf((x1 - mean) * rstd * lng[gi * 128 + c + 1] + lnb[gi * 128 + c + 1]); } }
                }
                __syncthreads();
                {
                    f32x4 acc[8];
#pragma unroll
                    for (int ct = 0; ct < 8; ++ct) acc[ct] = (f32x4){0.f, 0.f, 0.f, 0.f};
                    const bf16_t* wrow = wtril + ((size_t)(l * 4 + gi) * 128 + 16 * wave + (lane & 15)) * 128 + 8 * (lane >> 4);
#pragma unroll
                    for (int kk = 0; kk < 4; ++kk) { const bf16x8 av = *(const bf16x8*)(wrow + kk * 32);
#pragma unroll
                        for (int ct = 0; ct < 8; ++ct) { const bf16x8 bv = *(const bf16x8*)(vT + (ct * 16 + (lane & 15)) * 136 + kk * 32 + 8 * (lane >> 4));
                            acc[ct] = __builtin_amdgcn_mfma_f32_16x16x32_bf16(av, bv, acc[ct], 0, 0, 0); } }
#pragma unroll
                    for (int j = 0; j < 4; ++j) { const int t = 16 * wave + 4 * (lane >> 4) + j; const float bt = bs[gi * 128 + t];
#pragma unroll
                        for (int ct = 0; ct < 8; ++ct) svL[t * 132 + ct * 16 + (lane & 15)] = acc[ct][j] + bt; }
                }
                __syncthreads();
                {
                    const int c0 = (tid & 15) * 8;
#pragma unroll
                    for (int i = 0; i < 4; ++i) { const int t = 32 * i + (tid >> 4);
                        const u32x4 uw = *(const u32x4*)(PB + ((size_t)(12 + gi) * T + r0 + t) * 128 + c0);
                        const f32x4 s0 = *(const f32x4*)(svL + t * 132 + c0), s1 = *(const f32x4*)(svL + t * 132 + c0 + 4);
                        u32x4 w; w.x = cvt_pk_bf16(gelu_tanh(bf_lo(uw.x)) * s0[0], gelu_tanh(bf_hi(uw.x)) * s0[1]); w.y = cvt_pk_bf16(gelu_tanh(bf_lo(uw.y)) * s0[2], gelu_tanh(bf_hi(uw.y)) * s0[3]);
                        w.z = cvt_pk_bf16(gelu_tanh(bf_lo(uw.z)) * s1[0], gelu_tanh(bf_hi(uw.z)) * s1[1]); w.w = cvt_pk_bf16(gelu_tanh(bf_lo(uw.w)) * s1[2], gelu_tanh(bf_hi(uw.w)) * s1[3]);
                        *(u32x4*)(Y + (size_t)(r0 + t) * DM + 512 + gi * 128 + c0) = w; }
                }
                __syncthreads();
            }
        }
        {
            PH_IDS;
            bf16_t* PB = WSP(bf16_t, WS_PROJ); float* OATT = WSP(float, WS_R1); float* btab = WSP(float, WS_BTAB);
            float* btl = (float*)(lds + att2::L_BT);
            for (int i = tid; i < 8 * 256; i += NTHR) btl[i] = btab[i];
            __syncthreads();
            const att::bf16* PBb = (const att::bf16*)PB;
#pragma unroll 1
            for (int L = cu; L < 512; L += G) {
                const int k_ = L >> 3, hm = L & 7, b = k_ >> 5, x = k_ & 31, h = hm >> 1;
#pragma unroll 1
                for (int pass = 0; pass < 2; ++pass) {
                    const int qb = pass ? 63 - x : x;
                    att2::Blk c;
                    c.Q = PBb + ((size_t)(20 + hm) * T + (size_t)b * SEQ + qb * 128) * 128; c.K = PBb + ((size_t)(28 + hm) * T + (size_t)b * SEQ) * 128;
                    c.V0 = PBb + ((size_t)(36 + h * 2) * T + (size_t)b * SEQ) * 128; c.V1 = PBb + ((size_t)(37 + h * 2) * T + (size_t)b * SEQ) * 128;
                    c.O0 = OATT + ((size_t)((b * 8 + hm) * 2 + 0) * SEQ + qb * 128) * 128; c.O1 = OATT + ((size_t)((b * 8 + hm) * 2 + 1) * SEQ + qb * 128) * 128;
                    c.P0 = qb * 128; c.hm = hm;
                    att2::attn2_block(c, (char*)lds);
                }
            }
        }
        GRID_BAR();

        {
            PH_IDS;
            float* OATT = WSP(float, WS_R1); bf16_t* Y = WSP(bf16_t, WS_Y); float* lamp = WSP(float, WS_LAM);
            const float lam_init = 0.8f - 0.6f * expf(-0.3f * (float)l);
            const float lam = lamp[l]; const float* sg = INP(11) + (size_t)l * 256;
            const f32x4 gv = *(const f32x4*)(sg + 4 * lane);
            for (int it = gw; it < T * 4; it += NGW) {
                const int r = it >> 2, h = it & 3, b = r >> 13, t = r & (SEQ - 1);
                const int half = lane >> 5, e = (lane & 31) * 4;
                const size_t i0 = ((size_t)(((b * 4 + h) * 2 + 0) * 2 + half) * SEQ + t) * 128 + e;
                const size_t i1 = ((size_t)(((b * 4 + h) * 2 + 1) * 2 + half) * SEQ + t) * 128 + e;
                const f32x4 o0 = *(const f32x4*)(OATT + i0), o1 = *(const f32x4*)(OATT + i1);
                const f32x4 d = o0 - o1 * lam;
                const float ss = wave_sum(d[0] * d[0] + d[1] * d[1] + d[2] * d[2] + d[3] * d[3]);
                const float sc = rsqrtf(ss * (1.f / 256.f) + LN_EPS) * (1.f - lam_init);
                u32x2 w; w.x = cvt_pk_bf16(d[0] * sc * gv[0], d[1] * sc * gv[1]); w.y = cvt_pk_bf16(d[2] * sc * gv[2], d[3] * sc * gv[3]);
                *(u32x2*)(Y + (size_t)r * DM + 1024 + h * 256 + 4 * lane) = w;
            }
        }
        GRID_BAR();

#define LN_PASS(gam, bet, write_xn) do { PH_IDS; float* X = out_opaque(a); bf16_t* XN = WSP(bf16_t, WS_XN); \
            for (int r = gw; r < T; r += NGW) { float* xr = X + (size_t)r * DM; f32x4 v[8]; float s = 0.f; \
                _Pragma("unroll") for (int j = 0; j < 8; ++j) { v[j] = *(const f32x4*)(xr + 4 * lane + 256 * j); s += (v[j][0] + v[j][1]) + (v[j][2] + v[j][3]); } \
                const float mean = wave_sum(s) * (1.f / DM); float s2 = 0.f; \
                _Pragma("unroll") for (int j = 0; j < 8; ++j) { v[j] = v[j] - mean; s2 += (v[j][0] * v[j][0] + v[j][1] * v[j][1]) + (v[j][2] * v[j][2] + v[j][3] * v[j][3]); } \
                const float rstd = rsqrtf(wave_sum(s2) * (1.f / DM) + LN_EPS); \
                _Pragma("unroll") for (int j = 0; j < 8; ++j) { const f32x4 gg = *(const f32x4*)((gam) + 4 * lane + 256 * j), bb = *(const f32x4*)((bet) + 4 * lane + 256 * j); \
                    const f32x4 o = v[j] * rstd * gg + bb; *(f32x4*)(xr + 4 * lane + 256 * j) = o; \
                    if (write_xn) { u32x2 w; w.x = cvt_pk_bf16(o[0], o[1]); w.y = cvt_pk_bf16(o[2], o[3]); *(u32x2*)(XN + (size_t)r * DM + 4 * lane + 256 * j) = w; } } } } while (0)

        {
            unsigned char* ws = ws_opaque(a); float* X = out_opaque(a); float* ST = (float*)(ws + WS_ST);
            pg8::Gemm g{(const bf16_t*)(ws + WS_Y), (const bf16_t*)(ws + WS_W + (size_t)l * W_LAYER + W_OUT), DM, DM, DM, 1, 0, 0, 0, 0};
            pg8::Order S; S.init(T, DM, 1, G, cu_opaque());
            pg8::EpiRes E{nullptr, l == 0 ? INP(0) : nullptr, ST + (size_t)(l > 0 ? 3 * l - 1 : 0) * T * 2, INP(22) + (size_t)(l > 0 ? l - 1 : 0) * DM, INP(23) + (size_t)(l > 0 ? l - 1 : 0) * DM,
                          (bf16_t*)(ws + WS_XN), ST + (size_t)(3 * l) * T * 2, ALPHA, 0};
            pg8::gemm_phase<pg8::EpiRes, true>((LAS unsigned char*)lds, g, S, E);
        }
        GRID_BAR();

        {
            unsigned char* ws = ws_opaque(a);
            const float* cl = (const float*)(ws + WS_C) + (size_t)l * C_LAYER;
            pg8::Gemm g{(const bf16_t*)(ws + WS_XN), (const bf16_t*)(ws + WS_W + (size_t)l * W_LAYER + W_KV), DM, DM, DM, 4, (long)SEQ * DM, 0, (long)4 * NMEM * DM, (long)NMEM * DM};
            pg8::Order S; S.init(SEQ, NMEM, 8, G, cu_opaque());
            pg8::EpiSoftmax E{(bf16_t*)(ws + WS_PROJ + 64 * MiB), (const float*)(ws + WS_ST) + (size_t)(3 * l) * T * 2, cl + C_Q, cl + C_QK2, 0.044194173824159216f};
            pg8::gemm_phase<pg8::EpiSoftmax, true>((LAS unsigned char*)lds, g, S, E);
        }
        GRID_BAR();
        {
            unsigned char* ws = ws_opaque(a); float* ST = (float*)(ws + WS_ST);
            pg8::Gemm g{(const bf16_t*)(ws + WS_PROJ + 64 * MiB), (const bf16_t*)(ws + WS_W + (size_t)l * W_LAYER + W_KV + 8 * MiB), 1024, 1024, 1024, 1, (long)SEQ * 1024, 0, (long)DM * 1024, 0};
            pg8::Order S; S.init(SEQ, DM, 2, G, cu_opaque());
            pg8::EpiRes E{nullptr, nullptr, ST + (size_t)(3 * l) * T * 2, INP(13) + (size_t)l * DM, INP(14) + (size_t)l * DM, (bf16_t*)(ws + WS_XN), ST + (size_t)(3 * l + 1) * T * 2, ALPHA, SEQ};
            pg8::gemm_phase<pg8::EpiRes, true>((LAS unsigned char*)lds, g, S, E);
        }
        GRID_BAR();
        {
            unsigned char* ws = ws_opaque(a);
            const float* cl = (const float*)(ws + WS_C) + (size_t)l * C_LAYER;
            pg8::Gemm g{(const bf16_t*)(ws + WS_XN), (const bf16_t*)(ws + WS_W + (size_t)l * W_LAYER + W_GU), DM, DM, DM, 1, 0, 0, 0, 0};
            pg8::Order S; S.init(T, 2 * DFF, 1, G, cu_opaque());
            pg8::EpiSwiglu E{(bf16_t*)(ws + WS_PROJ), (const float*)(ws + WS_ST) + (size_t)(3 * l + 1) * T * 2, cl + C_GU, cl + C_GU + 2 * DFF};
            pg8::gemm_phase<pg8::EpiSwiglu, true>((LAS unsigned char*)lds, g, S, E);
        }
        GRID_BAR();
        {
            unsigned char* ws = ws_opaque(a); float* X = out_opaque(a); float* ST = (float*)(ws + WS_ST);
            pg8::Gemm g{(const bf16_t*)(ws + WS_PROJ), (const bf16_t*)(ws + WS_W + (size_t)l * W_LAYER + W_D), DFF, DFF, DFF, 1, 0, 0, 0, 0};
            pg8::Order S; S.init(T, DM, 1, G, cu_opaque());
            pg8::EpiRes E{l + 1 == DEPTH ? X : nullptr, nullptr, ST + (size_t)(3 * l + 1) * T * 2, INP(18) + (size_t)l * DM, INP(19) + (size_t)l * DM, (bf16_t*)(ws + WS_XN), ST + (size_t)(3 * l + 2) * T * 2, ALPHA, 0};
            pg8::gemm_phase<pg8::EpiRes, true>((LAS unsigned char*)lds, g, S, E);
        }
        GRID_BAR();
        if (l + 1 == DEPTH) { LN_PASS(INP(22) + (size_t)l * DM, INP(23) + (size_t)l * DM, false); }
#undef LN_PASS
    }
    if (a.ws == nullptr) cg::this_grid().sync();
}

extern "C" void kernel_launch(void* const* d_in, const int* in_sizes, int n_in, void* d_out, int out_size, void* d_ws, size_t ws_size, hipStream_t stream) {
    static int grid = 0;
    if (grid == 0) {
        if (n_in != 24 || in_sizes[0] != T * DM || out_size != T * DM || ws_size < WS_END) {
            fprintf(stderr, "kernel_launch: unexpected shapes (n_in %d, in0 %d, out %d, ws %zu); nothing launched\n", n_in, n_in > 0 ? in_sizes[0] : -1, out_size, ws_size); grid = -1; return; }
        int dev = 0, cus = 0, per_cu = 0;
        (void)hipGetDevice(&dev);
        if (hipDeviceGetAttribute(&cus, hipDeviceAttributeMultiprocessorCount, dev) != hipSuccess || cus <= 0) cus = 256;
        if (hipFuncSetAttribute((const void*)mega_fwd, hipFuncAttributeMaxDynamicSharedMemorySize, LDS_BYTES) != hipSuccess) fprintf(stderr, "kernel_launch: hipFuncSetAttribute failed\n");
        if (hipOccupancyMaxActiveBlocksPerMultiprocessor(&per_cu, (const void*)mega_fwd, NTHR, LDS_BYTES) != hipSuccess || per_cu < 1) { fprintf(stderr, "kernel_launch: occupancy query says %d\n", per_cu); per_cu = 1; }
        (void)hipGetLastError();
        grid = cus * per_cu;
    }
    if (grid < 0) return;
    if (hipMemsetAsync((char*)d_ws + WS_BAR, 0, 512 * 1024, stream) != hipSuccess || hipMemsetAsync((char*)d_ws + WS_ST, 0, 1 * MiB, stream) != hipSuccess) { fprintf(stderr, "kernel_launch: hipMemsetAsync failed\n"); return; }
    Args a{};
    for (int i = 0; i < 24; ++i) a.in[i] = (const float*)d_in[i];
    a.out = (float*)d_out; a.ws = (unsigned char*)d_ws;
    void* args[] = {&a};
    hipError_t e = hipLaunchCooperativeKernel((const void*)mega_fwd, dim3(grid), dim3(NTHR), args, LDS_BYTES, stream);
    if (e != hipSuccess) fprintf(stderr, "cooperative launch failed: %s (grid %d)\n", hipGetErrorString(e), grid);
}
```

```cpp
#include <hip/hip_runtime.h>
#include <hip/hip_cooperative_groups.h>
#include <hip/hip_bf16.h>
#include <cstdio>
#include <cstdint>
namespace cg = cooperative_groups;

constexpr int BATCH = 2, SEQ = 8192, DM = 2048, DEPTH = 2, T = BATCH * SEQ;
constexpr int NMEM = 256, INC = 5632, DFF = 5632;
constexpr float ALPHA = 1.4142135623730951f;
constexpr float LN_EPS = 1e-5f;
constexpr int NTHR = 512, NWAVES = 8;

constexpr size_t MiB = 1u << 20;
constexpr size_t WS_LAM = 0;
constexpr size_t WS_BTAB = 4096;
constexpr size_t WS_BAR = 512 * 1024;
constexpr size_t WS_C = 576 * 1024;
constexpr int C_Q = 0, C_GU = 4096, C_IN = 4096 + 22528, C_QK2 = 4096 + 22528 + 11264, C_LAYER = C_QK2 + 2048;
constexpr size_t WS_ST = 1 * MiB;
constexpr size_t WS_WTRIL = 12 * MiB;
constexpr size_t WS_MEMBF = 2 * MiB;
constexpr size_t WS_KV = 4 * MiB;
constexpr size_t WS_W = 16 * MiB;
constexpr size_t W_IN = 0, W_OUT = 22 * MiB, W_Q = 30 * MiB, W_KV = 38 * MiB, W_O = 54 * MiB, W_GU = 62 * MiB, W_D = 106 * MiB, W_LAYER = 128 * MiB;
constexpr size_t WS_XN = 272 * MiB;
constexpr size_t WS_PROJ = 336 * MiB;
constexpr size_t WS_R1 = 512 * MiB;
constexpr size_t WS_Y = 640 * MiB;
constexpr size_t WS_END = 704 * MiB;
constexpr int LDS_BYTES = 147456;

typedef unsigned short bf16_t;
typedef short bf16x8 __attribute__((ext_vector_type(8)));
typedef float f32x4 __attribute__((ext_vector_type(4)));
typedef float f32x16 __attribute__((ext_vector_type(16)));
typedef unsigned u32x4 __attribute__((ext_vector_type(4)));
typedef unsigned u32x2 __attribute__((ext_vector_type(2)));
#define LAS __attribute__((address_space(3)))
#define GAS __attribute__((address_space(1)))

__device__ __forceinline__ unsigned cvt_pk_bf16(float lo, float hi) { unsigned r; asm volatile("v_cvt_pk_bf16_f32 %0, %1, %2" : "=v"(r) : "v"(lo), "v"(hi)); return r; }
__device__ __forceinline__ float bf_lo(unsigned w) { return __uint_as_float(w << 16); }
__device__ __forceinline__ float bf_hi(unsigned w) { return __uint_as_float(w & 0xffff0000u); }
__device__ __forceinline__ float bf2f(bf16_t b) { return __uint_as_float(((unsigned)b) << 16); }
__device__ __forceinline__ bf16_t f2bf(float f) { return (bf16_t)(cvt_pk_bf16(f, 0.f) & 0xffffu); }
__device__ __forceinline__ int ltid() { int t = threadIdx.x; asm volatile("" : "+v"(t)); return t; }
__device__ __forceinline__ int cu_opaque() { int c = blockIdx.x; asm volatile("" : "+s"(c)); return c; }
#define PH_IDS const int cu = cu_opaque(); const int tid = ltid(), lane = tid & 63, wave = __builtin_amdgcn_readfirstlane(tid >> 6), gw = cu * NWAVES + wave, gt = cu * NTHR + tid; (void)lane; (void)wave; (void)gw; (void)gt
__device__ __forceinline__ float wave_sum(float v) {
#pragma unroll
    for (int o = 1; o < 64; o <<= 1) v += __shfl_xor(v, o);
    return v;
}
__device__ __forceinline__ float wave_max(float v) {
#pragma unroll
    for (int o = 1; o < 64; o <<= 1) v = fmaxf(v, __shfl_xor(v, o));
    return v;
}
__device__ __forceinline__ float gelu_tanh(float x) {
    const float y = 0.7978845608028654f * (x + 0.044715f * x * x * x);
    return x * __builtin_amdgcn_rcpf(1.f + __expf(-2.f * y));
}

namespace pg8 {
constexpr int BM = 256, BK = 64, HALF = 128, HTB = HALF * BK * 2, STAGE_BYTES = 8 * HTB, NXCD = 8, WGM = 8;
__host__ __device__ __forceinline__ int lds_byte(int r, int c) { const int st = (r >> 4) * 2 + (c >> 5), rr = r & 15, cc = c & 31, ob = rr * 64 + cc * 2; return st * 1024 + (ob ^ (((ob >> 9) & 1) << 5)); }
__host__ __device__ __forceinline__ void stage_rc(int b, int& R, int& C) { const int st = b / 1024, sb = b % 1024, swz = sb ^ (((sb >> 9) & 1) << 5); R = (st >> 1) * 16 + swz / 64; C = (st & 1) * 32 + (swz % 64) / 2; }
__host__ __device__ __forceinline__ int perm32(int rho) { const int n = rho >> 4, i = rho & 15; return 8 * (i >> 2) + 4 * n + (i & 3); }

struct Unit { int pm, pn, bz; };
struct Gemm { const bf16_t* A; const bf16_t* Bt; int lda, ldb, K, nb0; long a_s1, a_s0, b_s1, b_s0; };
__device__ __forceinline__ const char* unit_a(const Gemm& g, const Unit& u) { const int b1 = u.bz / g.nb0, b0 = u.bz % g.nb0; return (const char*)(g.A + (size_t)b1 * g.a_s1 + (size_t)b0 * g.a_s0 + (size_t)u.pm * BM * g.lda); }
__device__ __forceinline__ const char* unit_b(const Gemm& g, const Unit& u) { const int b1 = u.bz / g.nb0, b0 = u.bz % g.nb0; return (const char*)(g.Bt + (size_t)b1 * g.b_s1 + (size_t)b0 * g.b_s0 + (size_t)u.pn * BM * g.ldb); }

struct Order {
    int nM, nN, nB, G, c;
    __device__ void init(int M, int N, int nB_, int G_, int c_) { nM = M / BM; nN = N / BM; nB = nB_; G = G_; c = c_; }
    __device__ bool next(int i, Unit& u) const {
        const long L = (long)i * G + c; const int nwg = nM * nN; if (c < 0 || L >= (long)nwg * nB) return false;
        if (nB > 1) { u.bz = (int)(L / nwg); const int w = (int)(L % nwg); u.pn = w / nM; u.pm = w % nM; return true; }
        u.bz = 0;
        int wgid = (int)L; { const int q = nwg / NXCD, r = nwg % NXCD, xcd = wgid % NXCD, off = wgid / NXCD; wgid = (xcd < r ? xcd * (q + 1) : r * (q + 1) + (xcd - r) * q) + off; }
        const int nig = WGM * nN, gid = wgid / nig, fm = gid * WGM, gsz = (nM - fm) < WGM ? (nM - fm) : WGM;
        u.pm = fm + ((wgid % nig) % gsz); u.pn = (wgid % nig) / gsz; return true;
    }
};

__device__ __forceinline__ void row_stats(const float* st, int row, float& mean, float& rstd) {
    const float s1 = st[2 * row], s2 = st[2 * row + 1];
    mean = s1 * (1.f / DM); const float var = fmaxf(s2 * (1.f / DM) - mean * mean, 0.f); rstd = rsqrtf(var + LN_EPS);
}
struct EpiSplit {
    static constexpr bool PERM = true, AFTER_DRAIN = false;
    bf16_t* P; const float* st; const float* c1; const float* c2;
    __device__ __forceinline__ void operator()(const f32x4 (&acc)[2][2][4][2], const Unit& u, int wr, int wc, int fr, int fq) const {
        const int row0 = u.pm * BM + wr * 64 + fr, col0 = u.pn * BM + wc * 32 + 8 * fq;
        f32x4 k1[2][2], k2[2][2];
        if (st) {
#pragma unroll
            for (int bj = 0; bj < 2; ++bj)
#pragma unroll
                for (int n = 0; n < 2; ++n) { k1[bj][n] = *(const f32x4*)(c1 + col0 + bj * HALF + 4 * n); k2[bj][n] = *(const f32x4*)(c2 + col0 + bj * HALF + 4 * n); } }
#pragma unroll
        for (int ai = 0; ai < 2; ++ai)
#pragma unroll
            for (int m = 0; m < 4; ++m) { const int row = row0 + ai * HALF + m * 16;
                float mean = 0.f, rstd = 1.f; if (st) row_stats(st, row, mean, rstd);
#pragma unroll
                for (int bj = 0; bj < 2; ++bj) { f32x4 v0 = acc[ai][bj][m][0], v1 = acc[ai][bj][m][1];
                    if (st) { v0 = (v0 - k1[bj][0] * mean) * rstd + k2[bj][0]; v1 = (v1 - k1[bj][1] * mean) * rstd + k2[bj][1]; }
                    u32x4 w; w.x = cvt_pk_bf16(v0[0], v0[1]); w.y = cvt_pk_bf16(v0[2], v0[3]); w.z = cvt_pk_bf16(v1[0], v1[1]); w.w = cvt_pk_bf16(v1[2], v1[3]);
                    *(u32x4*)(P + ((size_t)(u.pn * 2 + bj) * T + row) * 128 + wc * 32 + 8 * fq) = w; } }
    }
};
struct EpiBf16 {
    static constexpr bool PERM = true, AFTER_DRAIN = false;
    bf16_t* O; int ldc, nb0; long o_s1, o_s0; float scale; const float* st; const float* c1; const float* c2; float* rsum;
    __device__ __forceinline__ void operator()(const f32x4 (&acc)[2][2][4][2], const Unit& u, int wr, int wc, int fr, int fq) const {
        const int row0 = u.pm * BM + wr * 64 + fr, col0 = u.pn * BM + wc * 32 + 8 * fq;
        bf16_t* base = O + (size_t)(u.bz / nb0) * o_s1 + (size_t)(u.bz % nb0) * o_s0;
        f32x4 k1[2][2], k2[2][2];
        if (st) {
#pragma unroll
            for (int bj = 0; bj < 2; ++bj)
#pragma unroll
                for (int n = 0; n < 2; ++n) { k1[bj][n] = *(const f32x4*)(c1 + col0 + bj * HALF + 4 * n); k2[bj][n] = *(const f32x4*)(c2 + col0 + bj * HALF + 4 * n); } }
#pragma unroll
        for (int ai = 0; ai < 2; ++ai)
#pragma unroll
            for (int m = 0; m < 4; ++m) { const int row = row0 + ai * HALF + m * 16; bf16_t* rowp = base + (size_t)row * ldc + col0;
                float mean = 0.f, rstd = 1.f; if (st) row_stats(st, row, mean, rstd);
                float rs = 0.f;
#pragma unroll
                for (int bj = 0; bj < 2; ++bj) { f32x4 v0 = acc[ai][bj][m][0], v1 = acc[ai][bj][m][1];
                    if (st) { v0 = (v0 - k1[bj][0] * mean) * rstd + k2[bj][0]; v1 = (v1 - k1[bj][1] * mean) * rstd + k2[bj][1]; }
                    v0 = v0 * scale; v1 = v1 * scale;
                    u32x4 w; w.x = cvt_pk_bf16(v0[0], v0[1]); w.y = cvt_pk_bf16(v0[2], v0[3]); w.z = cvt_pk_bf16(v1[0], v1[1]); w.w = cvt_pk_bf16(v1[2], v1[3]);
                    *(u32x4*)(rowp + bj * HALF) = w;
                    if (rsum) rs += ((bf_lo(w.x) + bf_hi(w.x)) + (bf_lo(w.y) + bf_hi(w.y))) + ((bf_lo(w.z) + bf_hi(w.z)) + (bf_lo(w.w) + bf_hi(w.w))); }
                if (rsum) { rs += __shfl_xor(rs, 16); rs += __shfl_xor(rs, 32); if (fq == 0) unsafeAtomicAdd(rsum + u.bz * 256 + row, rs); } }
    }
};
struct EpiF32 {
    static constexpr bool PERM = false, AFTER_DRAIN = false;
    float* out; int ldc; long o_bs; float scale;
    __device__ __forceinline__ void operator()(const f32x4 (&acc)[2][2][4][2], const Unit& u, int wr, int wc, int fr, int fq) const {
        const int row0 = u.pm * BM + wr * 64 + fr, col0 = u.pn * BM + wc * 32 + 4 * fq;
        float* ob = out + (size_t)u.bz * o_bs;
#pragma unroll
        for (int ai = 0; ai < 2; ++ai)
#pragma unroll
            for (int m = 0; m < 4; ++m) { const size_t off = (size_t)(row0 + ai * HALF + m * 16) * ldc + col0;
#pragma unroll
                for (int bj = 0; bj < 2; ++bj)
#pragma unroll
                    for (int n = 0; n < 2; ++n) *(f32x4*)(ob + off + bj * HALF + n * 16) = acc[ai][bj][m][n] * scale; }
    }
};
struct EpiRes {
    static constexpr bool PERM = true, AFTER_DRAIN = false;
    float* X; const float* raw; const float* pst; const float* pg; const float* pb; bf16_t* ZB; float* cst; float alpha; int brows;
    __device__ __forceinline__ void operator()(const f32x4 (&acc)[2][2][4][2], const Unit& u, int wr, int wc, int fr, int fq) const {
        const int row0 = u.bz * brows + u.pm * BM + wr * 64 + fr, col0 = u.pn * BM + wc * 32 + 8 * fq;
        f32x4 gv[2][2], bv[2][2];
        if (!raw) {
#pragma unroll
            for (int bj = 0; bj < 2; ++bj)
#pragma unroll
                for (int n = 0; n < 2; ++n) { gv[bj][n] = *(const f32x4*)(pg + col0 + bj * HALF + 4 * n); bv[bj][n] = *(const f32x4*)(pb + col0 + bj * HALF + 4 * n); } }
#pragma unroll
        for (int ai = 0; ai < 2; ++ai)
#pragma unroll
            for (int m = 0; m < 4; ++m) { const int row = row0 + ai * HALF + m * 16; const size_t off = (size_t)row * DM + col0;
                float mean = 0.f, rstd = 1.f; if (!raw) row_stats(pst, row, mean, rstd);
                float s1 = 0.f, s2 = 0.f;
#pragma unroll
                for (int bj = 0; bj < 2; ++bj) { f32x4 r0, r1;
                    if (raw) { r0 = *(const f32x4*)(raw + off + bj * HALF); r1 = *(const f32x4*)(raw + off + bj * HALF + 4); }
                    else { const u32x4 zw = *(const u32x4*)(ZB + off + bj * HALF);
                        r0 = (f32x4){bf_lo(zw.x), bf_hi(zw.x), bf_lo(zw.y), bf_hi(zw.y)}; r1 = (f32x4){bf_lo(zw.z), bf_hi(zw.z), bf_lo(zw.w), bf_hi(zw.w)};
                        r0 = (r0 - mean) * rstd * gv[bj][0] + bv[bj][0]; r1 = (r1 - mean) * rstd * gv[bj][1] + bv[bj][1]; }
                    const f32x4 z0 = acc[ai][bj][m][0] + r0 * alpha, z1 = acc[ai][bj][m][1] + r1 * alpha;
                    if (X) { *(f32x4*)(X + off + bj * HALF) = z0; *(f32x4*)(X + off + bj * HALF + 4) = z1; }
                    u32x4 w; w.x = cvt_pk_bf16(z0[0], z0[1]); w.y = cvt_pk_bf16(z0[2], z0[3]); w.z = cvt_pk_bf16(z1[0], z1[1]); w.w = cvt_pk_bf16(z1[2], z1[3]);
                    *(u32x4*)(ZB + off + bj * HALF) = w;
                    s1 += ((z0[0] + z0[1]) + (z0[2] + z0[3])) + ((z1[0] + z1[1]) + (z1[2] + z1[3]));
                    s2 += ((z0[0] * z0[0] + z0[1] * z0[1]) + (z0[2] * z0[2] + z0[3] * z0[3])) + ((z1[0] * z1[0] + z1[1] * z1[1]) + (z1[2] * z1[2] + z1[3] * z1[3])); }
                s1 += __shfl_xor(s1, 16); s1 += __shfl_xor(s1, 32); s2 += __shfl_xor(s2, 16); s2 += __shfl_xor(s2, 32);
                if (fq == 0) { unsafeAtomicAdd(cst + 2 * row, s1); unsafeAtomicAdd(cst + 2 * row + 1, s2); } }
    }
};
struct EpiSwiglu {
    static constexpr bool PERM = true, AFTER_DRAIN = false;
    bf16_t* H; const float* st; const float* c1; const float* c2;
    __device__ __forceinline__ void operator()(const f32x4 (&acc)[2][2][4][2], const Unit& u, int wr, int wc, int fr, int fq) const {
        const int row0 = u.pm * BM + wr * 64 + fr, col0 = u.pn * HALF + wc * 32 + 8 * fq, ccol0 = u.pn * BM + wc * 32 + 8 * fq;
        f32x4 k1[2][2], k2[2][2];
#pragma unroll
        for (int bj = 0; bj < 2; ++bj)
#pragma unroll
            for (int n = 0; n < 2; ++n) { k1[bj][n] = *(const f32x4*)(c1 + ccol0 + bj * HALF + 4 * n); k2[bj][n] = *(const f32x4*)(c2 + ccol0 + bj * HALF + 4 * n); }
#pragma unroll
        for (int ai = 0; ai < 2; ++ai)
#pragma unroll
            for (int m = 0; m < 4; ++m) { const int row = row0 + ai * HALF + m * 16; bf16_t* rowp = H + (size_t)row * DFF + col0;
                float mean, rstd; row_stats(st, row, mean, rstd);
                float h[8];
#pragma unroll
                for (int n = 0; n < 2; ++n) { const f32x4 gq = (acc[ai][0][m][n] - k1[0][n] * mean) * rstd + k2[0][n], uq = (acc[ai][1][m][n] - k1[1][n] * mean) * rstd + k2[1][n];
#pragma unroll
                    for (int j = 0; j < 4; ++j) h[n * 4 + j] = gq[j] * __builtin_amdgcn_rcpf(1.f + __expf(-gq[j])) * uq[j]; }
                u32x4 w; w.x = cvt_pk_bf16(h[0], h[1]); w.y = cvt_pk_bf16(h[2], h[3]); w.z = cvt_pk_bf16(h[4], h[5]); w.w = cvt_pk_bf16(h[6], h[7]);
                *(u32x4*)rowp = w; }
    }
};

struct EpiSoftmax {
    static constexpr bool PERM = true, AFTER_DRAIN = true;
    bf16_t* PALL; const float* st; const float* c1; const float* c2; float scale;
    __device__ __forceinline__ void fused(f32x4 (&acc)[2][2][4][2], const Unit& u, int wr, int wc, int fr, int fq, LAS unsigned char* lds) const {
        const int b = u.bz >> 2, h = u.bz & 3, rl0 = wr * 64 + fr, cc0 = wc * 32 + 8 * fq;
        LAS float* PMX = (LAS float*)lds; LAS float* PSM = PMX + 1024;
        f32x4 k1[2][2], k2[2][2];
#pragma unroll
        for (int bj = 0; bj < 2; ++bj)
#pragma unroll
            for (int n = 0; n < 2; ++n) { k1[bj][n] = *(const f32x4*)(c1 + u.bz * 256 + cc0 + bj * HALF + 4 * n); k2[bj][n] = *(const f32x4*)(c2 + u.bz * 256 + cc0 + bj * HALF + 4 * n); }
#pragma unroll
        for (int ai = 0; ai < 2; ++ai)
#pragma unroll
            for (int m = 0; m < 4; ++m) { const int rl = rl0 + ai * HALF + m * 16, row = b * SEQ + u.pm * BM + rl;
                float mean, rstd; row_stats(st, row, mean, rstd);
                float mx = -__builtin_inff();
#pragma unroll
                for (int bj = 0; bj < 2; ++bj)
#pragma unroll
                    for (int n = 0; n < 2; ++n) { const f32x4 v = ((acc[ai][bj][m][n] - k1[bj][n] * mean) * rstd + k2[bj][n]) * scale; acc[ai][bj][m][n] = v;
                        mx = fmaxf(mx, fmaxf(fmaxf(v[0], v[1]), fmaxf(v[2], v[3]))); }
                mx = fmaxf(mx, __shfl_xor(mx, 16)); mx = fmaxf(mx, __shfl_xor(mx, 32));
                if (fq == 0) PMX[rl * 4 + wc] = mx; }
        asm volatile("s_waitcnt lgkmcnt(0)" ::: "memory"); __builtin_amdgcn_s_barrier(); asm volatile("" ::: "memory");
#pragma unroll
        for (int ai = 0; ai < 2; ++ai)
#pragma unroll
            for (int m = 0; m < 4; ++m) { const int rl = rl0 + ai * HALF + m * 16;
                const f32x4 q = *(const LAS f32x4*)(PMX + rl * 4); const float mx = fmaxf(fmaxf(q[0], q[1]), fmaxf(q[2], q[3]));
                float sm = 0.f;
#pragma unroll
                for (int bj = 0; bj < 2; ++bj)
#pragma unroll
                    for (int n = 0; n < 2; ++n) { f32x4 e = acc[ai][bj][m][n] - mx; e[0] = __expf(e[0]); e[1] = __expf(e[1]); e[2] = __expf(e[2]); e[3] = __expf(e[3]); acc[ai][bj][m][n] = e;
                        sm += (e[0] + e[1]) + (e[2] + e[3]); }
                sm += __shfl_xor(sm, 16); sm += __shfl_xor(sm, 32);
                if (fq == 0) PSM[rl * 4 + wc] = sm; }
        asm volatile("s_waitcnt lgkmcnt(0)" ::: "memory"); __builtin_amdgcn_s_barrier(); asm volatile("" ::: "memory");
#pragma unroll
        for (int ai = 0; ai < 2; ++ai)
#pragma unroll
            for (int m = 0; m < 4; ++m) { const int rl = rl0 + ai * HALF + m * 16, row = b * SEQ + u.pm * BM + rl;
                const f32x4 q = *(const LAS f32x4*)(PSM + rl * 4); const float inv = __builtin_amdgcn_rcpf((q[0] + q[1]) + (q[2] + q[3]));
                bf16_t* rowp = PALL + (size_t)row * 1024 + h * 256 + cc0;
#pragma unroll
                for (int bj = 0; bj < 2; ++bj) { const f32x4 v0 = acc[ai][bj][m][0] * inv, v1 = acc[ai][bj][m][1] * inv;
                    u32x4 w; w.x = cvt_pk_bf16(v0[0], v0[1]); w.y = cvt_pk_bf16(v0[2], v0[3]); w.z = cvt_pk_bf16(v1[0], v1[1]); w.w = cvt_pk_bf16(v1[2], v1[3]);
                    *(u32x4*)(rowp + bj * HALF) = w; } }
    }
};

template <class Epi, bool ALIGN_EPI>
__device__ __forceinline__ void gemm_phase(LAS unsigned char* lds, const Gemm g, const Order& S, const Epi& E) {
    const int tid = ltid(), wid = __builtin_amdgcn_readfirstlane(tid >> 6), lane = tid & 63, wr = wid >> 2, wc = wid & 3, fr = lane & 15, fq = lane >> 4;
    const int K = g.K, nt = K / BK;
    unsigned voffA[2], voffB[2];
#pragma unroll
    for (int i = 0; i < 2; ++i) { int R, C; stage_rc(tid * 16 + i * 8192, R, C); const int Rb = Epi::PERM ? ((R & ~31) + perm32(R & 31)) : R;
        voffA[i] = (unsigned)(R * g.lda + C) * 2u; voffB[i] = (unsigned)(Rb * g.ldb + C) * 2u; }
    const size_t kstep = (size_t)(BK * 2);
    const size_t hstepA = (size_t)HALF * g.lda * 2, hstepB = (size_t)HALF * g.ldb * 2;
    const unsigned ldsw = (unsigned)wid * 1024u;
    const int aoff = lds_byte(wr * 64 + fr, fq * 8), boff = lds_byte(wc * 32 + fr, fq * 8);
#define PG8_SA(b, h) (((b) * 2 + (h)) * HTB)
#define PG8_SB(b, h) ((4 + (b) * 2 + (h)) * HTB)
#define PG8_STAGE(bufoff, gbase, voff) do { _Pragma("unroll") for (int _i = 0; _i < 2; ++_i) \
        __builtin_amdgcn_global_load_lds((const unsigned*)((const char*)(gbase) + (voff)[_i]), (LAS unsigned*)(lds + (bufoff) + ldsw + _i * 8192), 16, 0, 0); } while (0)
#define PG8_LDA(dst, b, h) do { _Pragma("unroll") for (int m = 0; m < 4; ++m) _Pragma("unroll") for (int k = 0; k < 2; ++k) dst[m][k] = *(const LAS bf16x8*)(lds + PG8_SA(b, h) + aoff + m * 2048 + k * 1024); } while (0)
#define PG8_LDB(dst, b, h) do { _Pragma("unroll") for (int n = 0; n < 2; ++n) _Pragma("unroll") for (int k = 0; k < 2; ++k) dst[n][k] = *(const LAS bf16x8*)(lds + PG8_SB(b, h) + boff + n * 2048 + k * 1024); } while (0)
#define PG8_MMA(ai, bj, At, Bt) do { __builtin_amdgcn_s_setprio(1); _Pragma("unroll") for (int m = 0; m < 4; ++m) _Pragma("unroll") for (int n = 0; n < 2; ++n) _Pragma("unroll") for (int k = 0; k < 2; ++k) \
        acc[ai][bj][m][n] = __builtin_amdgcn_mfma_f32_16x16x32_bf16(Bt[n][k], At[m][k], acc[ai][bj][m][n], 0, 0, 0); __builtin_amdgcn_s_setprio(0); } while (0)
#define PG8_WAIT_V(n) asm volatile("s_waitcnt vmcnt(" #n ")" ::: "memory")
#define PG8_WAIT_L(n) asm volatile("s_waitcnt lgkmcnt(" #n ")" ::: "memory")
#define PG8_BAR __builtin_amdgcn_s_barrier()
#define PG8_SCHED __builtin_amdgcn_sched_barrier(0)
    Unit cur, nxt; int ui = 0;
    if (!S.next(0, cur)) return;
    f32x4 acc[2][2][4][2];
#pragma unroll
    for (int a = 0; a < 2; ++a)
#pragma unroll
        for (int b = 0; b < 2; ++b)
#pragma unroll
            for (int m = 0; m < 4; ++m)
#pragma unroll
                for (int n = 0; n < 2; ++n) acc[a][b][m][n] = (f32x4){0.f, 0.f, 0.f, 0.f};
    bf16x8 At[4][2], B0[2][2], B1[2][2];
    const char* cA = unit_a(g, cur); const char* cB = unit_b(g, cur);
    PG8_STAGE(PG8_SB(0, 0), cB, voffB); PG8_STAGE(PG8_SB(0, 1), cB + hstepB, voffB); PG8_STAGE(PG8_SA(0, 0), cA, voffA); PG8_STAGE(PG8_SA(0, 1), cA + hstepA, voffA);
    if (wr == 1) PG8_BAR;
    PG8_WAIT_V(2); PG8_BAR;
    PG8_STAGE(PG8_SB(1, 0), cB + kstep, voffB); PG8_STAGE(PG8_SA(1, 0), cA + kstep, voffA); PG8_STAGE(PG8_SB(1, 1), cB + hstepB + kstep, voffB);
    PG8_WAIT_V(6); PG8_BAR;
    for (;;) {
        const bool has_next = S.next(ui + 1, nxt);
        const char* nA = has_next ? unit_a(g, nxt) : cA; const char* nB = has_next ? unit_b(g, nxt) : cB;
        for (int t = 0; t < nt; t += 2) {
            const bool last = (t == nt - 2);
            const char* a1 = cA + (size_t)(t + 1) * kstep;
            const char* a2 = last ? nA : cA + (size_t)(t + 2) * kstep; const char* b2 = last ? nB : cB + (size_t)(t + 2) * kstep;
            const char* a3 = a2 + kstep; const char* b3 = b2 + kstep;
            PG8_LDB(B0, 0, 0); PG8_LDB(B1, 0, 1); PG8_SCHED; PG8_LDA(At, 0, 0); PG8_STAGE(PG8_SA(1, 1), a1 + hstepA, voffA);
            PG8_WAIT_V(8); PG8_WAIT_L(0); PG8_BAR; PG8_MMA(0, 0, At, B0); PG8_MMA(0, 1, At, B1); PG8_BAR; PG8_SCHED;
            PG8_LDA(At, 0, 1); PG8_STAGE(PG8_SB(0, 0), b2, voffB); PG8_STAGE(PG8_SB(0, 1), b2 + hstepB, voffB); PG8_STAGE(PG8_SA(0, 0), a2, voffA);
            PG8_WAIT_V(8); PG8_WAIT_L(0); PG8_BAR; PG8_MMA(1, 0, At, B0); PG8_MMA(1, 1, At, B1); PG8_BAR; PG8_SCHED;
            PG8_LDB(B0, 1, 0); PG8_LDB(B1, 1, 1); PG8_SCHED; PG8_LDA(At, 1, 0); PG8_STAGE(PG8_SA(0, 1), a2 + hstepA, voffA);
            PG8_WAIT_V(8); PG8_WAIT_L(0); PG8_BAR; PG8_MMA(0, 0, At, B0); PG8_MMA(0, 1, At, B1); PG8_BAR; PG8_SCHED;
            PG8_LDA(At, 1, 1); PG8_STAGE(PG8_SB(1, 0), b3, voffB); PG8_STAGE(PG8_SB(1, 1), b3 + hstepB, voffB); PG8_STAGE(PG8_SA(1, 0), a3, voffA);
            PG8_WAIT_V(8); PG8_WAIT_L(0); PG8_BAR; PG8_MMA(1, 0, At, B0); PG8_MMA(1, 1, At, B1); PG8_BAR; PG8_SCHED;
        }
        if constexpr (ALIGN_EPI) { if (wr == 0) PG8_BAR; }
        if constexpr (!Epi::AFTER_DRAIN) E(acc, cur, wr, wc, fr, fq);
        if (!has_next) break;
#pragma unroll
        for (int a = 0; a < 2; ++a)
#pragma unroll
            for (int b = 0; b < 2; ++b)
#pragma unroll
                for (int m = 0; m < 4; ++m)
#pragma unroll
                    for (int n = 0; n < 2; ++n) acc[a][b][m][n] = (f32x4){0.f, 0.f, 0.f, 0.f};
        cur = nxt; cA = nA; cB = nB; ++ui;
        if constexpr (ALIGN_EPI) { if (wr == 1) PG8_BAR; }
    }
    PG8_WAIT_V(0);
    if constexpr (!ALIGN_EPI) { if (wr == 0) PG8_BAR; }
    PG8_BAR;
    if constexpr (Epi::AFTER_DRAIN) E.fused(acc, cur, wr, wc, fr, fq, lds);
#undef PG8_SA
#undef PG8_SB
#undef PG8_STAGE
#undef PG8_LDA
#undef PG8_LDB
#undef PG8_MMA
#undef PG8_WAIT_V
#undef PG8_WAIT_L
#undef PG8_BAR
#undef PG8_SCHED
}
}

namespace att {
using bf16 = __hip_bfloat16;
typedef short s16x4 __attribute__((ext_vector_type(4)));
constexpr int D = 128;
constexpr float THR = 8.f;
constexpr float SCALE = 0.08838834764831845f;
constexpr int NW = 8, QBLK = 32, KVBLK = 64, QB = NW * QBLK;
constexpr int SHM_V = KVBLK * D * 2, SHM_K = KVBLK * D * 2;
constexpr int ATT_LDS = 2 * SHM_V + 2 * SHM_K + NW * 64 * 4;
constexpr int BT_OFF = ATT_LDS;

#define KSWZ(row, colB) ((row) * 256 + ((colB) ^ (((row) & 7) << 4)))
#define SBAR() __builtin_amdgcn_sched_barrier(0)
__device__ __forceinline__ int v_st(int k, int c) { const int kk = (k & ~0xC) | ((k & 4) << 1) | ((k & 8) >> 1); return ((kk >> 3) * 4 + (c >> 5)) * 512 + ((kk & 7) * 32 + (c & 31)) * 2; }
__device__ __forceinline__ int v_rd_base(int lane) { return ((lane & 3) << 3) | (((lane >> 2) & 3) << 6) | (((lane >> 4) & 1) << 5) | (((lane >> 5) & 1) << 8); }
constexpr int v_rd_off(int d0, int ks, int half) { return d0 * 512 + ks * 4096 + half * 2048; }
__device__ __forceinline__ int crow(int r, int hi) { return (r & 3) + 8 * (r >> 2) + 4 * hi; }
__device__ __forceinline__ unsigned cvtpk(float lo, float hi) { unsigned r; asm volatile("v_cvt_pk_bf16_f32 %0, %1, %2" : "=v"(r) : "v"(lo), "v"(hi)); return r; }
__device__ __forceinline__ bf16x8 load8(const bf16* p) { return *reinterpret_cast<const bf16x8*>(p); }
__device__ __forceinline__ void bias_mask_tile(f32x16& p0, f32x16& p1, int dq, const float* bt) {
    const float NEG = -__builtin_inff();
#pragma unroll
    for (int r = 0; r < 16; ++r) {
        const int c = (r & 3) + 8 * (r >> 2);
        const int d0 = dq - c, d1 = dq - c - 32;
        const unsigned i0 = (unsigned)d0 < 255u ? (unsigned)d0 : 255u, i1 = (unsigned)d1 < 255u ? (unsigned)d1 : 255u;
        const float b0 = bt[i0], b1 = bt[i1];
        p0[r] = d0 >= 0 ? p0[r] + b0 : NEG;
        p1[r] = d1 >= 0 ? p1[r] + b1 : NEG;
    }
}
__device__ __forceinline__ void partialSM(f32x16& p0, f32x16& p1, float& m_reg, float& mn, float& alpha) {
    float pmax = p0[0]; for (int r = 1; r < 16; ++r) pmax = fmaxf(pmax, p0[r]); for (int r = 0; r < 16; ++r) pmax = fmaxf(pmax, p1[r]);
    { auto rr = __builtin_amdgcn_permlane32_swap(__float_as_uint(pmax), __float_as_uint(pmax), false, false);
      pmax = fmaxf(__uint_as_float(rr[0]), __uint_as_float(rr[1])); }
    constexpr float C2 = 1.4426950408889634f * SCALE;
    if (__builtin_expect(__all((pmax - m_reg) * SCALE <= THR), 1)) { mn = m_reg; alpha = 1.f; }
    else { mn = fmaxf(m_reg, pmax); alpha = __builtin_amdgcn_exp2f((m_reg - mn) * C2); m_reg = mn; }
    const float mnL = -mn * C2;
    for (int r = 0; r < 16; ++r) p0[r] = fmaf(p0[r], C2, mnL); for (int r = 0; r < 16; ++r) p1[r] = fmaf(p1[r], C2, mnL);
    for (int r = 0; r < 16; ++r) p0[r] = __builtin_amdgcn_exp2f(p0[r]);
}
__device__ __forceinline__ void finishSM(f32x16& p0, f32x16& p1, float alpha, float& l_reg, bf16x8& pa0, bf16x8& pa1, bf16x8& pa2, bf16x8& pa3) {
    for (int r = 0; r < 16; ++r) p1[r] = __builtin_amdgcn_exp2f(p1[r]);
    float ps = 0; for (int r = 0; r < 16; ++r) ps += p0[r]; for (int r = 0; r < 16; ++r) ps += p1[r];
    { auto rr = __builtin_amdgcn_permlane32_swap(__float_as_uint(ps), __float_as_uint(ps), false, false);
      ps = __uint_as_float(rr[0]) + __uint_as_float(rr[1]); }
    l_reg = l_reg * alpha + ps;
#define PK4(P, B_, OUT) do { unsigned a0 = cvtpk(P[B_+0], P[B_+1]), a1 = cvtpk(P[B_+2], P[B_+3]);                          \
        unsigned b0 = cvtpk(P[B_+4], P[B_+5]), b1 = cvtpk(P[B_+6], P[B_+7]);                                             \
        auto r0 = __builtin_amdgcn_permlane32_swap(a0, b0, false, false); auto r1 = __builtin_amdgcn_permlane32_swap(a1, b1, false, false); \
        u32x4 w = {r0[0], r1[0], r0[1], r1[1]}; OUT = *reinterpret_cast<bf16x8*>(&w); } while (0)
    PK4(p0, 0, pa0); PK4(p0, 8, pa1); PK4(p1, 0, pa2); PK4(p1, 8, pa3);
#undef PK4
}
template <int KB>
__device__ __forceinline__ void qkt(f32x16& p0, f32x16& p1, const char* K_lds, int r32, int hi, const bf16x8* qr) {
    p0 = f32x16{}; p1 = f32x16{};
    const char* kb[4];
#pragma unroll
    for (int dd = 0; dd < 4; ++dd) kb[dd] = K_lds + KB * SHM_K + KSWZ(r32, (dd * 16 + hi * 8) * 2);
#pragma unroll
    for (int d0 = 0; d0 < 8; ++d0) { const char* a = kb[d0 & 3] + (d0 >> 2) * 128;
        bf16x8 b0 = *reinterpret_cast<const bf16x8*>(a);
        bf16x8 b1 = *reinterpret_cast<const bf16x8*>(a + 32 * 256);
        p0 = __builtin_amdgcn_mfma_f32_32x32x16_bf16(b0, qr[d0], p0, 0, 0, 0);
        p1 = __builtin_amdgcn_mfma_f32_32x32x16_bf16(b1, qr[d0], p1, 0, 0, 0); }
}
template <int VB>
__device__ __forceinline__ void pv_tile(f32x16* o, int vb0, bf16x8 pa0, bf16x8 pa1, bf16x8 pa2, bf16x8 pa3) {
#define TRRD(dst, off) asm volatile("ds_read_b64_tr_b16 %0, %1 offset:%2" : "=&v"(dst) : "v"(vb0), "i"(off) : "memory")
#define PV_D0(d0) do { s16x4 l0, l1, l2, l3, h0, h1, h2, h3; constexpr int b_ = VB * SHM_V + v_rd_off(d0, 0, 0); \
        TRRD(l0, b_); TRRD(h0, b_ + 2048); TRRD(l1, b_ + 4096); TRRD(h1, b_ + 6144); TRRD(l2, b_ + 8192); TRRD(h2, b_ + 10240); TRRD(l3, b_ + 12288); TRRD(h3, b_ + 14336); \
        asm volatile("s_waitcnt lgkmcnt(0)" ::: "memory"); SBAR();   \
        o[d0] = __builtin_amdgcn_mfma_f32_32x32x16_bf16(pa0, (bf16x8){l0[0], l0[1], l0[2], l0[3], h0[0], h0[1], h0[2], h0[3]}, o[d0], 0, 0, 0);   \
        o[d0] = __builtin_amdgcn_mfma_f32_32x32x16_bf16(pa1, (bf16x8){l1[0], l1[1], l1[2], l1[3], h1[0], h1[1], h1[2], h1[3]}, o[d0], 0, 0, 0);   \
        o[d0] = __builtin_amdgcn_mfma_f32_32x32x16_bf16(pa2, (bf16x8){l2[0], l2[1], l2[2], l2[3], h2[0], h2[1], h2[2], h2[3]}, o[d0], 0, 0, 0);   \
        o[d0] = __builtin_amdgcn_mfma_f32_32x32x16_bf16(pa3, (bf16x8){l3[0], l3[1], l3[2], l3[3], h3[0], h3[1], h3[2], h3[3]}, o[d0], 0, 0, 0); } while (0)
    PV_D0(0); PV_D0(1); PV_D0(2); PV_D0(3);
#undef PV_D0
#undef TRRD
}
struct BlockRef { const bf16* Q; const bf16* K; const bf16* V; float* O; int P0; int hm; };
struct Seam { bf16x8 qr[8]; bf16x8 st_v0, st_v1, st_k0, st_k1; };
#define ROW(p, k0, rr) ((p) + (size_t)((k0) + (rr)) * D + sc)
#define VMW() asm volatile("s_waitcnt vmcnt(0)" ::: "memory")
#define VMWN(n) asm volatile("s_waitcnt vmcnt(%0)" :: "i"(n) : "memory")
#define SLOAD_H(Kp, Vp, k0) do { S.st_v0 = load8(ROW(Vp, k0, sr)); S.st_v1 = load8(ROW(Vp, k0, 32 + sr));              \
                         S.st_k0 = load8(ROW(Kp, k0, sr)); S.st_k1 = load8(ROW(Kp, k0, 32 + sr)); } while (0)
#define SWRITE_HK(bf) do { *(bf16x8*)(K_lds + (bf) * SHM_K + kws) = S.st_k0; *(bf16x8*)(K_lds + (bf) * SHM_K + kws + 32 * 256) = S.st_k1; } while (0)
#define SWRITE_HV(bf) do { *(bf16x8*)(V_lds + (bf) * SHM_V + vst0) = S.st_v0; *(bf16x8*)(V_lds + (bf) * SHM_V + vst1) = S.st_v1; } while (0)
#define SWRITE_H(bf) do { SWRITE_HV(bf); SWRITE_HK(bf); } while (0)
__device__ __forceinline__ void attn_prime(const BlockRef& cur, char* lds, Seam& S) {
    const int tid = ltid(), wid = __builtin_amdgcn_readfirstlane(tid >> 6), lane = tid & 63, r32 = lane & 31, hi = lane >> 5;
    const int sr = tid >> 4, sc = (tid & 15) * 8, kws = KSWZ(sr, sc * 2); char* K_lds = lds + 2 * SHM_V;
    const int kb0 = 0;
    for (int d0 = 0; d0 < 8; ++d0) S.qr[d0] = load8(cur.Q + (size_t)(wid * QBLK + r32) * D + d0 * 16 + hi * 8);
    SLOAD_H(cur.K, cur.V, kb0); VMW(); SWRITE_HK(0);
    __syncthreads();
}
__device__ __forceinline__ void attn_block(const BlockRef& cur, const BlockRef& nxt, char* lds, Seam& S) {
    const int tid = ltid(), wid = __builtin_amdgcn_readfirstlane(tid >> 6), lane = tid & 63, r32 = lane & 31, hi = lane >> 5;
    const int j_lo = 0;
    const int j_hi = (cur.P0 + QB - 1) / KVBLK + 1;
    const int NT = j_hi - j_lo;
    const int kbn = 0;
    const int qlo = cur.P0 + wid * QBLK, qm = qlo + r32 - 4 * hi;
    char* V_lds = lds; char* K_lds = lds + 2 * SHM_V;
    float* ws = (float*)(lds + 2 * SHM_V + 2 * SHM_K) + wid * 64; float* li_l = ws, * al_l = ws + 32;
    const float* bt = (const float*)(lds + BT_OFF) + cur.hm * 256;
    float m_reg = -1e30f, l_reg = 0; f32x16 o[4] = {};
    const int sr = tid >> 4, sc = (tid & 15) * 8, vst0 = v_st(sr, sc), vst1 = v_st(32 + sr, sc), kws = KSWZ(sr, sc * 2);
    const int vb0 = (int)(uintptr_t)V_lds + v_rd_base(lane);
    const bf16* Kh = cur.K; const bf16* Vh = cur.V;
#define RESC(a) do { if (__any((a) < 1.f)) { if (hi == 0) al_l[r32] = (a); asm volatile("s_waitcnt lgkmcnt(0)" ::: "memory");              \
                     for (int d_ = 0; d_ < 4; ++d_) for (int r = 0; r < 16; ++r) o[d_][r] *= al_l[crow(r, hi)]; } } while (0)
#define KBASE(t) ((j_lo + (t)) * KVBLK)
#define MASKT(P0_, P1_, t) do { const int kb_ = KBASE(t); if (kb_ + KVBLK - 1 > qlo - 128) bias_mask_tile(P0_, P1_, qm - kb_, bt); } while (0)
    constexpr int NQL = 8;
#define SEAM_K0() do { VMWN(NQL); SWRITE_HK(0); SBAR(); } while (0)
    f32x16 pA0, pA1, pB0, pB1; float mnA, mnB, alA, alB; bf16x8 pa0, pa1, pa2, pa3;
    SWRITE_HV(0); SBAR();
    if (NT > 1) { SLOAD_H(Kh, Vh, KBASE(1)); }
    SBAR(); qkt<0>(pA0, pA1, K_lds, r32, hi, S.qr);
    MASKT(pA0, pA1, 0); partialSM(pA0, pA1, m_reg, mnA, alA);
    if (NT > 1) { VMW(); SWRITE_H(1); }
    __syncthreads();
#define HALF_STEP(PX0, PX1, mnX, alX, PY0, PY1, alY, t, KB, VB, SB) do {                                                      \
        SBAR(); qkt<KB>(PX0, PX1, K_lds, r32, hi, S.qr);                                             \
        finishSM(PY0, PY1, alY, l_reg, pa0, pa1, pa2, pa3); SBAR();                                                           \
        if ((t) + 1 < NT) { SLOAD_H(Kh, Vh, KBASE((t) + 1)); SBAR(); }                                               \
        pv_tile<VB>(o, vb0, pa0, pa1, pa2, pa3); MASKT(PX0, PX1, (t)); partialSM(PX0, PX1, m_reg, mnX, alX);                                        \
        __syncthreads();                                                                                                      \
        if ((t) + 1 < NT) { VMW(); SWRITE_H(SB); }                                                                          \
        RESC(alX); __syncthreads(); } while (0)
    for (int t = 1; t + 1 < NT; t += 2) {
        HALF_STEP(pB0, pB1, mnB, alB, pA0, pA1, alA, t, 1, 0, 0);
        HALF_STEP(pA0, pA1, mnA, alA, pB0, pB1, alB, t + 1, 0, 1, 1);
    }
    const bool even = (NT & 1) == 0;
    if (even) { SBAR(); qkt<1>(pB0, pB1, K_lds, r32, hi, S.qr); SBAR(); }
    SLOAD_H(nxt.K, nxt.V, kbn); SBAR();
#pragma unroll
    for (int d0 = 0; d0 < 8; ++d0) S.qr[d0] = load8(nxt.Q + (size_t)(wid * QBLK + r32) * D + d0 * 16 + hi * 8);
    SBAR();
    finishSM(pA0, pA1, alA, l_reg, pa0, pa1, pa2, pa3); SBAR();
    pv_tile<0>(o, vb0, pa0, pa1, pa2, pa3);
    if (even) { MASKT(pB0, pB1, NT - 1); partialSM(pB0, pB1, m_reg, mnB, alB); __syncthreads(); RESC(alB);
        finishSM(pB0, pB1, alB, l_reg, pa0, pa1, pa2, pa3); SBAR(); pv_tile<1>(o, vb0, pa0, pa1, pa2, pa3); }
    SBAR(); SEAM_K0();
    if (hi == 0) li_l[r32] = l_reg; asm volatile("s_waitcnt lgkmcnt(0)" ::: "memory");
    float rli[16];
#pragma unroll
    for (int r = 0; r < 16; ++r) rli[r] = __builtin_amdgcn_rcpf(li_l[crow(r, hi)]);
    float* Ow = cur.O + (size_t)(wid * QBLK) * D;
#pragma unroll
    for (int r = 0; r < 16; ++r) { const int orow = crow(r, hi);
#pragma unroll
        for (int d0 = 0; d0 < 4; ++d0) { const float v = o[d0][r] * rli[r]; Ow[(size_t)orow * D + d0 * 32 + r32] = v; } }
    __syncthreads();
#undef RESC
#undef KBASE
#undef MASKT
#undef SEAM_K0
#undef HALF_STEP
}
#undef ROW
#undef VMW
#undef VMWN
#undef SLOAD_H
#undef SWRITE_HK
#undef SWRITE_HV
#undef SWRITE_H
}

namespace att2 {
using att::bf16; using att::D; using att::SHM_K; using att::SHM_V;
constexpr int L_V = 0, L_K = 65536, L_P = 98304, L_AL = 131072, L_FL = 132096, L_LB = 132224, L_BT = 133120;
struct Blk { const bf16* Q; const bf16* K; const bf16* V0; const bf16* V1; float* O0; float* O1; int P0; int hm; };
__device__ __forceinline__ void qkt_rt(f32x16& p0, f32x16& p1, const char* Kb, int r32, int hi, const bf16x8* qr) {
    p0 = f32x16{}; p1 = f32x16{};
    const char* kb[4];
#pragma unroll
    for (int dd = 0; dd < 4; ++dd) kb[dd] = Kb + KSWZ(r32, (dd * 16 + hi * 8) * 2);
#pragma unroll
    for (int d0 = 0; d0 < 8; ++d0) { const char* a = kb[d0 & 3] + (d0 >> 2) * 128;
        bf16x8 b0 = *reinterpret_cast<const bf16x8*>(a);
        bf16x8 b1 = *reinterpret_cast<const bf16x8*>(a + 32 * 256);
        p0 = __builtin_amdgcn_mfma_f32_32x32x16_bf16(b0, qr[d0], p0, 0, 0, 0);
        p1 = __builtin_amdgcn_mfma_f32_32x32x16_bf16(b1, qr[d0], p1, 0, 0, 0); }
}
#define A2_LOADT(t) do { const size_t ro_ = (size_t)((t) * 64 + sr) * D + sc; \
        sk0 = att::load8(c.K + ro_); sk1 = att::load8(c.K + ro_ + 32 * D); sv00 = att::load8(c.V0 + ro_); sv01 = att::load8(c.V0 + ro_ + 32 * D); sv10 = att::load8(c.V1 + ro_); sv11 = att::load8(c.V1 + ro_ + 32 * D); } while (0)
#define A2_WRITET(buf) do { char* kd_ = lds + L_K + (buf) * SHM_K; char* vd_ = lds + L_V + (buf) * 2 * SHM_V; \
        *(bf16x8*)(kd_ + kws) = sk0; *(bf16x8*)(kd_ + kws + 32 * 256) = sk1; *(bf16x8*)(vd_ + vst0) = sv00; *(bf16x8*)(vd_ + vst1) = sv01; *(bf16x8*)(vd_ + SHM_V + vst0) = sv10; *(bf16x8*)(vd_ + SHM_V + vst1) = sv11; } while (0)
__device__ __forceinline__ void attn2_block(const Blk& c, char* lds) {
    const int tid = ltid(), wid = __builtin_amdgcn_readfirstlane(tid >> 6), lane = tid & 63, r32 = lane & 31, hi = lane >> 5;
    const int g = wid & 3;
    const int NT = (c.P0 + 127) / 64 + 1;
    const int sr = tid >> 4, sc = (tid & 15) * 8, kws = KSWZ(sr, sc * 2), vst0 = att::v_st(sr, sc), vst1 = att::v_st(32 + sr, sc);
    bf16x8 sk0, sk1, sv00, sv01, sv10, sv11;
    float* ALb = (float*)(lds + L_AL) + g * 64; unsigned* FLb = (unsigned*)(lds + L_FL) + g * 2; float* LBb = (float*)(lds + L_LB) + g * 32;
    char* Pb = lds + L_P + g * 8192;
    A2_LOADT(0);
    if (wid < 4) {
        bf16x8 qr[8];
#pragma unroll
        for (int d0 = 0; d0 < 8; ++d0) qr[d0] = att::load8(c.Q + (size_t)(g * 32 + r32) * D + d0 * 16 + hi * 8);
        asm volatile("s_waitcnt vmcnt(0)" ::: "memory"); A2_WRITET(0); __syncthreads();
        const int qlo = c.P0 + g * 32, qm = qlo + r32 - 4 * hi;
        const float* bt = (const float*)(lds + L_BT) + c.hm * 256;
        float m_reg = -1e30f, l_reg = 0.f;
        for (int s = 0; s <= NT; ++s) {
            const int par = s & 1;
            if (s + 1 < NT) A2_LOADT(s + 1);
            SBAR();
            if (s < NT) {
                f32x16 p0, p1; float mn, al; bf16x8 pa0, pa1, pa2, pa3;
                qkt_rt(p0, p1, lds + L_K + par * SHM_K, r32, hi, qr);
                const int kb_ = s * 64;
                if (kb_ + 63 > qlo - 128) att::bias_mask_tile(p0, p1, qm - kb_, bt);
                att::partialSM(p0, p1, m_reg, mn, al);
                att::finishSM(p0, p1, al, l_reg, pa0, pa1, pa2, pa3);
                char* pw = Pb + par * 4096 + lane * 16;
                *(bf16x8*)(pw) = pa0; *(bf16x8*)(pw + 1024) = pa1; *(bf16x8*)(pw + 2048) = pa2; *(bf16x8*)(pw + 3072) = pa3;
                if (hi == 0) ALb[par * 32 + r32] = al;
                const bool resc = __any(al < 1.f);
                if (lane == 0) FLb[par] = resc ? 1u : 0u;
            }
            __syncthreads();
            if (s + 1 < NT) { asm volatile("s_waitcnt vmcnt(0)" ::: "memory"); A2_WRITET((s + 1) & 1); }
            __syncthreads();
        }
        if (hi == 0) LBb[r32] = l_reg;
        __syncthreads();
        __syncthreads();
    } else {
        asm volatile("s_waitcnt vmcnt(0)" ::: "memory"); A2_WRITET(0); __syncthreads();
        f32x16 o[8];
#pragma unroll
        for (int d_ = 0; d_ < 8; ++d_) o[d_] = f32x16{};
        const int vbase = (int)(uintptr_t)(lds + L_V) + att::v_rd_base(lane);
        for (int s = 0; s <= NT; ++s) {
            if (s + 1 < NT) A2_LOADT(s + 1);
            SBAR();
            if (s >= 1) {
                const int par = (s - 1) & 1;
                const unsigned fl = (unsigned)__builtin_amdgcn_readfirstlane((int)FLb[par]);
                if (fl) {
#pragma unroll
                    for (int r = 0; r < 16; ++r) { const float a = ALb[par * 32 + att::crow(r, hi)];
#pragma unroll
                        for (int d_ = 0; d_ < 8; ++d_) o[d_][r] *= a; } }
                const char* pr = Pb + par * 4096 + lane * 16;
                const bf16x8 pa0 = *(const bf16x8*)(pr), pa1 = *(const bf16x8*)(pr + 1024), pa2 = *(const bf16x8*)(pr + 2048), pa3 = *(const bf16x8*)(pr + 3072);
                const int vb = vbase + par * 2 * SHM_V;
                att::pv_tile<0>(o, vb, pa0, pa1, pa2, pa3);
                att::pv_tile<0>(o + 4, vb + SHM_V, pa0, pa1, pa2, pa3);
            }
            __syncthreads();
            if (s + 1 < NT) { asm volatile("s_waitcnt vmcnt(0)" ::: "memory"); A2_WRITET((s + 1) & 1); }
            __syncthreads();
        }
        __syncthreads();
        float rli[16];
#pragma unroll
        for (int r = 0; r < 16; ++r) rli[r] = __builtin_amdgcn_rcpf(LBb[att::crow(r, hi)]);
#pragma unroll
        for (int hf = 0; hf < 2; ++hf) { float* Ow = (hf ? c.O1 : c.O0) + (size_t)(g * 32) * D;
#pragma unroll
            for (int r = 0; r < 16; ++r) { const int orow = att::crow(r, hi);
#pragma unroll
                for (int d0 = 0; d0 < 4; ++d0) Ow[(size_t)orow * D + d0 * 32 + r32] = o[hf * 4 + d0][r] * rli[r]; } }
        __syncthreads();
    }
}
#undef A2_LOADT
#undef A2_WRITET
}


#define XB_TMO      128
#define XB_XCNT(j)  (256  + 64 * (j))
#define XB_XSUB(j)  (1280 + 64 * (j))
#define XB_XGEN(j)  (2304 + 64 * (j))
#define XB_TOP      3328
#define XB_TOPGEN   3392
#define XCD_BAR_WORDS 3456
#define XB_SPIN_CAP (1u << 18)
__device__ __forceinline__ unsigned xb_ld(unsigned* p)              { return __hip_atomic_load(p, __ATOMIC_RELAXED, __HIP_MEMORY_SCOPE_AGENT); }
__device__ __forceinline__ unsigned xb_add(unsigned* p, unsigned v) { return __hip_atomic_fetch_add(p, v, __ATOMIC_RELAXED, __HIP_MEMORY_SCOPE_AGENT); }
__device__ __forceinline__ unsigned xb_xcc_id() { return (unsigned)__builtin_amdgcn_s_getreg((3 << 11) | 20) & 0xFu; }
#define XB_SPIN(cond, bar) do { unsigned _sp = 0; while (cond) { __builtin_amdgcn_s_sleep(1); \
    if ((++_sp & 255u) == 0u) { if (xb_ld(&(bar)[XB_TMO])) break; if (_sp > XB_SPIN_CAP) { atomicAdd(&(bar)[XB_TMO], 1u); break; } } } } while (0)
struct XcdBarrier { unsigned* bar; unsigned x; volatile LAS unsigned* st; };
__device__ __forceinline__ XcdBarrier xcd_barrier_post(unsigned* bar, volatile LAS unsigned* st) {
    XcdBarrier b; b.bar = bar; b.x = xb_xcc_id(); b.st = st;
    if (threadIdx.x == 0) (void)xb_add(&bar[XB_XCNT(b.x)], 1u);
    return b;
}
__device__ __forceinline__ void xcd_barrier_complete(unsigned* bar, unsigned x, unsigned& nloc, unsigned& nx) {
    const unsigned G = gridDim.x * gridDim.y * gridDim.z;
    unsigned sum, cnt, mine, sp = 0u;
    for (;;) {
        sum = 0u; cnt = 0u; mine = 0u;
#pragma unroll
        for (unsigned j = 0; j < 16; ++j) { const unsigned c = xb_ld(&bar[XB_XCNT(j)]); sum += c; cnt += (c > 0u) ? 1u : 0u; mine = (j == x) ? c : mine; }
        if (sum == G) break;
        __builtin_amdgcn_s_sleep(1);
        if ((++sp & 255u) == 0u) { if (xb_ld(&bar[XB_TMO])) break; if (sp > XB_SPIN_CAP) { atomicAdd(&bar[XB_TMO], 1u); break; } }
    }
    nloc = mine > 0u ? mine : 1u; nx = cnt > 0u ? cnt : 1u;
}
__device__ __forceinline__ void xcd_barrier(const XcdBarrier& b) {
    asm volatile("s_waitcnt vmcnt(0)" ::: "memory");
    __syncthreads();
    if (threadIdx.x == 0) {
        unsigned* bar = b.bar;
        __builtin_amdgcn_s_waitcnt(0);
        unsigned nloc = b.st[0], nx = b.st[1];
        if (nloc == 0u) { xcd_barrier_complete(bar, b.x, nloc, nx); b.st[0] = nloc; b.st[1] = nx; }
        const unsigned old = xb_add(&bar[XB_XSUB(b.x)], 1u);
        const unsigned gen = old / nloc;
        if (old + 1u == (gen + 1u) * nloc) {
            __builtin_amdgcn_fence(__ATOMIC_RELEASE, "agent");
            asm volatile("s_waitcnt vmcnt(0)" ::: "memory");
            const unsigned og = xb_add(&bar[XB_TOP], 1u);
            const unsigned tg = og / nx;
            if (og + 1u == (tg + 1u) * nx) xb_add(&bar[XB_TOPGEN], 1u);
            else XB_SPIN(xb_ld(&bar[XB_TOPGEN]) == tg, bar);
            __builtin_amdgcn_fence(__ATOMIC_ACQUIRE, "agent");
            xb_add(&bar[XB_XGEN(b.x)], 1u);
            asm volatile("s_waitcnt vmcnt(0)" ::: "memory");
        } else {
            XB_SPIN(xb_ld(&bar[XB_XGEN(b.x)]) == gen, bar);
            __builtin_amdgcn_fence(__ATOMIC_ACQUIRE, "agent");
            asm volatile("s_waitcnt vmcnt(0)" ::: "memory");
        }
    }
    __syncthreads();
}

struct Args { const float* in[24]; float* out; unsigned char* ws; };

__device__ __forceinline__ void p0_transpose_item(const float* W, int K, int N, bf16_t* WT, int swiglu, const float* gk, const float* bk, float* c1, float* c2, LAS float* scr, int item, int lane) {
    const int nblk = N / 64, kb = item / nblk, nb = item % nblk, k0 = 64 * kb, n0 = 64 * nb;
    const float* src = W + (size_t)(k0 + (lane >> 4)) * N + n0 + (lane & 15) * 4;
    f32x4 v[16];
#pragma unroll
    for (int i = 0; i < 16; ++i) v[i] = __builtin_nontemporal_load((const f32x4*)(src + (size_t)(4 * i) * N));
#pragma unroll
    for (int i = 0; i < 16; ++i) { LAS float* d = scr + (4 * i + (lane >> 4)) * 65 + (lane & 15) * 4; d[0] = v[i][0]; d[1] = v[i][1]; d[2] = v[i][2]; d[3] = v[i][3]; }
    asm volatile("s_waitcnt lgkmcnt(0)" ::: "memory");
    int r0 = n0;
    if (swiglu) { const int half = n0 / DFF, idx = n0 % DFF; r0 = 256 * (idx / 128) + 128 * half + (idx % 128); }
    const int c = lane & 7;
    float g8[8], b8[8];
#pragma unroll
    for (int e = 0; e < 8; ++e) { g8[e] = gk ? gk[k0 + 8 * c + e] : 1.f; b8[e] = gk ? bk[k0 + 8 * c + e] : 0.f; }
#pragma unroll
    for (int j = 0; j < 8; ++j) { const int n = (lane >> 3) + 8 * j; const LAS float* q = scr + (8 * c) * 65 + n;
        float w8[8];
#pragma unroll
        for (int e = 0; e < 8; ++e) w8[e] = q[e * 65];
        u32x4 o; o.x = cvt_pk_bf16(w8[0] * g8[0], w8[1] * g8[1]); o.y = cvt_pk_bf16(w8[2] * g8[2], w8[3] * g8[3]); o.z = cvt_pk_bf16(w8[4] * g8[4], w8[5] * g8[5]); o.w = cvt_pk_bf16(w8[6] * g8[6], w8[7] * g8[7]);
        *(u32x4*)(WT + (size_t)(r0 + n) * K + k0 + 8 * c) = o;
        if (gk) {
            float s1 = ((bf_lo(o.x) + bf_hi(o.x)) + (bf_lo(o.y) + bf_hi(o.y))) + ((bf_lo(o.z) + bf_hi(o.z)) + (bf_lo(o.w) + bf_hi(o.w)));
            float s2 = ((w8[0] * b8[0] + w8[1] * b8[1]) + (w8[2] * b8[2] + w8[3] * b8[3])) + ((w8[4] * b8[4] + w8[5] * b8[5]) + (w8[6] * b8[6] + w8[7] * b8[7]));
            s1 += __shfl_xor(s1, 1); s1 += __shfl_xor(s1, 2); s1 += __shfl_xor(s1, 4); s2 += __shfl_xor(s2, 1); s2 += __shfl_xor(s2, 2); s2 += __shfl_xor(s2, 4);
            if (c == 0) { unsafeAtomicAdd(c1 + r0 + n, s1); unsafeAtomicAdd(c2 + r0 + n, s2); }
        } }
    asm volatile("s_waitcnt lgkmcnt(0)" ::: "memory");
}

__device__ __forceinline__ void p0_wq_item(const float* W, bf16_t* WN, const float* gk, const float* bk, float* bW, int item, int lane) {
    const int kb = item >> 5, jb = item & 31, k0 = 64 * kb, j0 = 64 * jb, cg8 = lane & 7, kr = lane >> 3;
    float sacc[8];
#pragma unroll
    for (int e = 0; e < 8; ++e) sacc[e] = 0.f;
#pragma unroll
    for (int i = 0; i < 8; ++i) { const int k = k0 + 8 * i + kr; const float* src = W + (size_t)k * DM + j0 + 8 * cg8;
        const f32x4 v0 = __builtin_nontemporal_load((const f32x4*)src), v1 = __builtin_nontemporal_load((const f32x4*)(src + 4)); const float g = gk[k], bb = bk[k];
        u32x4 o; o.x = cvt_pk_bf16(v0[0] * g, v0[1] * g); o.y = cvt_pk_bf16(v0[2] * g, v0[3] * g); o.z = cvt_pk_bf16(v1[0] * g, v1[1] * g); o.w = cvt_pk_bf16(v1[2] * g, v1[3] * g);
        *(u32x4*)(WN + (size_t)k * DM + j0 + 8 * cg8) = o;
#pragma unroll
        for (int e = 0; e < 4; ++e) { sacc[e] += bb * v0[e]; sacc[4 + e] += bb * v1[e]; } }
#pragma unroll
    for (int e = 0; e < 8; ++e) { float v = sacc[e]; v += __shfl_xor(v, 8); v += __shfl_xor(v, 16); v += __shfl_xor(v, 32); if (kr == 0) unsafeAtomicAdd(bW + j0 + 8 * cg8 + e, v); }
}

__device__ __forceinline__ int causal_bucket(int n) {
    if (n < 16) return n;
    const float nf = (float)n;
    int large = 16 + (int)(logf(nf / 16.f) / 2.0794415416798357f * 16.f);
    return large < 31 ? large : 31;
}

__device__ __forceinline__ size_t zero_opaque() { size_t z = 0; asm volatile("" : "+s"(z)); return z; }
__device__ __forceinline__ const float* inp_ptr(const Args& a, int k) { return a.in[k] + zero_opaque(); }
#define INP(k) inp_ptr(a, k)
__device__ __forceinline__ unsigned char* ws_opaque(const Args& a) { return a.ws + zero_opaque(); }
__device__ __forceinline__ float* out_opaque(const Args& a) { return a.out + zero_opaque(); }
#define WSP(type, off) ((type*)(ws_opaque(a) + (off)))
__global__ void __launch_bounds__(NTHR, 2) mega_fwd(Args a) {
    extern __shared__ __attribute__((aligned(16))) unsigned char lds[];
    volatile LAS unsigned* bst = (volatile LAS unsigned*)((LAS unsigned char*)lds + LDS_BYTES - 64);
    if (threadIdx.x == 0) { bst[0] = 0u; bst[1] = 0u; }
    __syncthreads();
    (void)xcd_barrier_post((unsigned*)(a.ws + WS_BAR), bst);
#define GRID_BAR() do { XcdBarrier xb_; xb_.bar = (unsigned*)(ws_opaque(a) + WS_BAR); unsigned x_ = xb_xcc_id(); asm volatile("" : "+s"(x_)); xb_.x = x_; xb_.st = bst; xcd_barrier(xb_); } while (0)
    const int G = gridDim.x;
    const int NGW = G * NWAVES, NGT = G * NTHR;
    {
        PH_IDS;
        unsigned char* ws = ws_opaque(a);
        float* lamp = (float*)(ws + WS_LAM); float* btab = (float*)(ws + WS_BTAB); bf16_t* wtril = (bf16_t*)(ws + WS_WTRIL); bf16_t* membf = (bf16_t*)(ws + WS_MEMBF); bf16_t* XN = (bf16_t*)(ws + WS_XN);
        LAS float* scr = (LAS float*)((LAS unsigned char*)lds + wave * 17408);
        constexpr int I_IN = 32 * 88, I_SQ = 32 * 32, I_KV = 32 * 64, I_GU = 32 * 176, I_D = 88 * 32;
        constexpr int PER_LAYER = I_IN + 3 * I_SQ + I_KV + I_GU + I_D;
        for (int it = gw; it < 2 * PER_LAYER; it += NGW) {
            const int l = it / PER_LAYER; int r = it % PER_LAYER;
            unsigned char* wl = ws + WS_W + (size_t)l * W_LAYER;
            float* cl = (float*)(ws + WS_C) + (size_t)l * C_LAYER;
            if (r < I_IN) { const bool f = l > 0;
                p0_transpose_item(INP(3) + (size_t)l * DM * INC, DM, INC, (bf16_t*)(wl + W_IN), 0, f ? INP(22) : nullptr, f ? INP(23) : nullptr, cl + C_IN, cl + C_IN + INC, scr, r, lane); continue; } r -= I_IN;
            if (r < I_SQ) { p0_transpose_item(INP(12) + (size_t)l * DM * DM, DM, DM, (bf16_t*)(wl + W_OUT), 0, nullptr, nullptr, nullptr, nullptr, scr, r, lane); continue; } r -= I_SQ;
            if (r < I_SQ) { p0_wq_item(INP(15) + (size_t)l * DM * DM, (bf16_t*)(wl + W_Q), INP(13) + (size_t)l * DM, INP(14) + (size_t)l * DM, cl + C_Q + DM, r, lane); continue; } r -= I_SQ;
            if (r < I_KV) { p0_transpose_item(INP(16) + (size_t)l * DM * 2 * DM, DM, 2 * DM, (bf16_t*)(wl + W_KV), 0, nullptr, nullptr, nullptr, nullptr, scr, r, lane); continue; } r -= I_KV;
            if (r < I_SQ) { p0_transpose_item(INP(17) + (size_t)l * DM * DM, DM, DM, (bf16_t*)(wl + W_O), 0, nullptr, nullptr, nullptr, nullptr, scr, r, lane); continue; } r -= I_SQ;
            if (r < I_GU) { p0_transpose_item(INP(20) + (size_t)l * DM * 2 * DFF, DM, 2 * DFF, (bf16_t*)(wl + W_GU), 1, INP(18) + (size_t)l * DM, INP(19) + (size_t)l * DM, cl + C_GU, cl + C_GU + 2 * DFF, scr, r, lane); continue; } r -= I_GU;
            p0_transpose_item(INP(21) + (size_t)l * DFF * DM, DFF, DM, (bf16_t*)(wl + W_D), 0, nullptr, nullptr, nullptr, nullptr, scr, r, lane);
        }
        for (size_t i = gt; i < (size_t)T * DM / 8; i += NGT) {
            const f32x4 v0 = *(const f32x4*)(INP(0) + i * 8), v1 = *(const f32x4*)(INP(0) + i * 8 + 4);
            u32x4 w; w.x = cvt_pk_bf16(v0[0], v0[1]); w.y = cvt_pk_bf16(v0[2], v0[3]); w.z = cvt_pk_bf16(v1[0], v1[1]); w.w = cvt_pk_bf16(v1[2], v1[3]);
            *(u32x4*)(XN + i * 8) = w;
        }
        for (size_t i = gt; i < (size_t)BATCH * NMEM * DM / 8; i += NGT) {
            const f32x4 v0 = *(const f32x4*)(INP(1) + i * 8), v1 = *(const f32x4*)(INP(1) + i * 8 + 4);
            u32x4 w; w.x = cvt_pk_bf16(v0[0], v0[1]); w.y = cvt_pk_bf16(v0[2], v0[3]); w.z = cvt_pk_bf16(v1[0], v1[1]); w.w = cvt_pk_bf16(v1[2], v1[3]);
            *(u32x4*)(membf + i * 8) = w;
        }
        for (int i = gt; i < DEPTH * 4 * 128 * 128; i += NGT) { const int s = i & 127, t = (i >> 7) & 127; wtril[i] = s <= t ? f2bf(INP(7)[i]) : (bf16_t)0; }
        if (gt < 8 * 256) { const int hm = gt >> 8, d = gt & 255; const float* rb = INP(2);
            btab[gt] = (rb[causal_bucket(d) * 8 + hm] - rb[31 * 8 + hm]) * (1.f / att::SCALE); }
        if (cu == 0 && wave == 0) {
            for (int l = 0; l < DEPTH; ++l) {
                const float* lq = INP(9) + l * 256; const float* lk = INP(10) + l * 256;
                float s0 = lq[lane] * lk[lane] + lq[lane + 64] * lk[lane + 64];
                float s1 = lq[128 + lane] * lk[128 + lane] + lq[192 + lane] * lk[192 + lane];
                s0 = wave_sum(s0); s1 = wave_sum(s1);
                const float lam_init = 0.8f - 0.6f * expf(-0.3f * (float)l);
                if (lane == 0) lamp[l] = expf(s0) - expf(s1) + lam_init;
            }
        }
    }
    GRID_BAR();

#pragma unroll 1
    for (int l = 0; l < DEPTH; ++l) {
        {
            unsigned char* ws = ws_opaque(a);
            pg8::Gemm g{(const bf16_t*)(ws + WS_XN), (const bf16_t*)(ws + WS_W + (size_t)l * W_LAYER + W_IN), DM, DM, DM, 1, 0, 0, 0, 0};
            pg8::Order S; S.init(T, INC, 1, G, cu_opaque());
            const float* cl = (const float*)(ws + WS_C) + (size_t)l * C_LAYER;
            const float* st = l > 0 ? (const float*)(ws + WS_ST) + (size_t)(3 * l - 1) * T * 2 : nullptr;
            pg8::EpiSplit E{(bf16_t*)(ws + WS_PROJ), st, cl + C_IN, cl + C_IN + INC};
            pg8::gemm_phase<pg8::EpiSplit, true>((LAS unsigned char*)lds, g, S, E);
        }
        if (l == 0) {
            {
                unsigned char* ws = ws_opaque(a);
                pg8::Gemm g{(const bf16_t*)(ws + WS_MEMBF), (const bf16_t*)(ws + WS_W + W_KV), DM, DM, DM, 1, 0, 0, (long)(W_LAYER / 2), 0};
                pg8::Order S; const int cu = cu_opaque(); S.init(BATCH * NMEM, 2 * DM, 2, G, cu >= 128 && cu < 192 ? cu - 128 : -1);
                pg8::EpiBf16 E{(bf16_t*)(ws + WS_KV), 2 * DM, 1, (long)(BATCH * NMEM) * 2 * DM, 0, 1.f, nullptr, nullptr, nullptr, nullptr};
                pg8::gemm_phase<pg8::EpiBf16, true>((LAS unsigned char*)lds, g, S, E);
            }
        }
        GRID_BAR();

        if (l == 0) {
#pragma unroll 1
            for (int L2 = 0; L2 < DEPTH; ++L2) {
                {
                    unsigned char* ws = ws_opaque(a); unsigned char* wl2 = ws + WS_W + (size_t)L2 * W_LAYER;
                    const bf16_t* KVl = (const bf16_t*)(ws + WS_KV) + (size_t)L2 * BATCH * NMEM * 2 * DM;
                    float* cl = (float*)(ws + WS_C) + (size_t)L2 * C_LAYER;
                    pg8::Gemm g{KVl, (const bf16_t*)(wl2 + W_Q), 2 * DM, DM, 512, 4, (long)NMEM * 2 * DM, 512, 0, 512};
                    pg8::Order S; const int cu = cu_opaque(); S.init(NMEM, DM, 8, G, cu >= 64 * L2 && cu < 64 * L2 + 64 ? cu - 64 * L2 : -1);
                    pg8::EpiBf16 E{(bf16_t*)(wl2 + W_KV), DM, 1, (long)NMEM * DM, 0, 1.f, nullptr, nullptr, nullptr, cl + C_Q};
                    pg8::gemm_phase<pg8::EpiBf16, true>((LAS unsigned char*)lds, g, S, E);
                }
                {
                    unsigned char* ws = ws_opaque(a); unsigned char* wl2 = ws + WS_W + (size_t)L2 * W_LAYER;
                    const bf16_t* KVl = (const bf16_t*)(ws + WS_KV) + (size_t)L2 * BATCH * NMEM * 2 * DM;
                    pg8::Gemm g{(const bf16_t*)(wl2 + W_O), KVl + DM, DM, 2 * DM, 512, 4, 0, 512, (long)NMEM * 2 * DM, 512};
                    pg8::Order S; const int cu = cu_opaque(); S.init(DM, NMEM, 8, G, cu >= 128 + 64 * L2 && cu < 192 + 64 * L2 ? cu - 128 - 64 * L2 : -1);
                    pg8::EpiBf16 E{(bf16_t*)(wl2 + W_KV + 8 * MiB), 1024, 4, (long)DM * 1024, 256, 1.f, nullptr, nullptr, nullptr, nullptr};
                    pg8::gemm_phase<pg8::EpiBf16, true>((LAS unsigned char*)lds, g, S, E);
                }
            }
            {
                PH_IDS;
                unsigned char* ws = ws_opaque(a);
                for (int it = gw; it < DEPTH * 2048; it += NGW) {
                    const int L2 = it >> 11, r = it & 2047, b = r >> 10, h = (r >> 8) & 3, n = r & 255;
                    const bf16_t* kp = (const bf16_t*)(ws + WS_KV) + ((size_t)L2 * BATCH * NMEM + b * NMEM + n) * 2 * DM + h * 512 + 8 * lane;
                    float* cl = (float*)(ws + WS_C) + (size_t)L2 * C_LAYER;
                    const float* bw = cl + C_Q + DM + h * 512 + 8 * lane;
                    const u32x4 kw = *(const u32x4*)kp; const f32x4 b0 = *(const f32x4*)bw, b1 = *(const f32x4*)(bw + 4);
                    float d = (bf_lo(kw.x) * b0[0] + bf_hi(kw.x) * b0[1]) + (bf_lo(kw.y) * b0[2] + bf_hi(kw.y) * b0[3]) + (bf_lo(kw.z) * b1[0] + bf_hi(kw.z) * b1[1]) + (bf_lo(kw.w) * b1[2] + bf_hi(kw.w) * b1[3]);
                    d = wave_sum(d);
                    if (lane == 0) cl[C_QK2 + r] = d;
                }
            }
            __syncthreads();
        }
        {
            PH_IDS;
            bf16_t* PB = WSP(bf16_t, WS_PROJ); bf16_t* Y = WSP(bf16_t, WS_Y);
            const float* cw = INP(4) + (size_t)l * 3 * 512;
            const int cg8 = tid & 63, c0 = cg8 * 8, gi = cg8 >> 4, cc = c0 & 127;
            float k0[8], k1[8], k2[8];
#pragma unroll
            for (int e = 0; e < 8; ++e) { k0[e] = cw[c0 + e]; k1[e] = cw[512 + c0 + e]; k2[e] = cw[1024 + c0 + e]; }
            for (int r = gt >> 6; r < T; r += NGT >> 6) {
                const int t = r & (SEQ - 1);
                const bf16_t* pb = PB + ((size_t)(0 + gi) * T + r) * 128 + cc;
                const bf16_t* pc = PB + ((size_t)(4 + gi) * T + r) * 128 + cc;
                const bf16_t* ph = PB + ((size_t)(8 + gi) * T + r) * 128 + cc;
                const u32x4 wb = *(const u32x4*)pb, wc0 = *(const u32x4*)pc, wh0 = *(const u32x4*)ph;
                u32x4 wc1 = {0, 0, 0, 0}, wh1 = {0, 0, 0, 0}, wc2 = {0, 0, 0, 0}, wh2 = {0, 0, 0, 0};
                if (t >= 1) { wc1 = *(const u32x4*)(pc - 128); wh1 = *(const u32x4*)(ph - 128); }
                if (t >= 2) { wc2 = *(const u32x4*)(pc - 256); wh2 = *(const u32x4*)(ph - 256); }
                float y[8];
#pragma unroll
                for (int j = 0; j < 4; ++j) {
                    const float z0a = bf_lo(wc0[j]) * bf_lo(wh0[j]), z1a = bf_lo(wc1[j]) * bf_lo(wh1[j]), z2a = bf_lo(wc2[j]) * bf_lo(wh2[j]);
                    const float z0b = bf_hi(wc0[j]) * bf_hi(wh0[j]), z1b = bf_hi(wc1[j]) * bf_hi(wh1[j]), z2b = bf_hi(wc2[j]) * bf_hi(wh2[j]);
                    y[2 * j] = bf_lo(wb[j]) * (k0[2 * j] * z2a + k1[2 * j] * z1a + k2[2 * j] * z0a);
                    y[2 * j + 1] = bf_hi(wb[j]) * (k0[2 * j + 1] * z2b + k1[2 * j + 1] * z1b + k2[2 * j + 1] * z0b);
                }
                u32x4 w; w.x = cvt_pk_bf16(y[0], y[1]); w.y = cvt_pk_bf16(y[2], y[3]); w.z = cvt_pk_bf16(y[4], y[5]); w.w = cvt_pk_bf16(y[6], y[7]);
                *(u32x4*)(Y + (size_t)r * DM + c0) = w;
            }
        }
        {
            PH_IDS;
            bf16_t* PB = WSP(bf16_t, WS_PROJ); bf16_t* Y = WSP(bf16_t, WS_Y); bf16_t* wtril = WSP(bf16_t, WS_WTRIL);
            float* st = (float*)(lds + 40960);
            bf16_t* vT = (bf16_t*)lds;
            const float* lng = INP(5) + (size_t)l * 512; const float* lnb = INP(6) + (size_t)l * 512;
            const float* bs = INP(8) + (size_t)l * 512;
            float* svL = (float*)(lds + 49152);
            for (int un = cu; un < (T / 128) * 4; un += G) {
                const int ch = un >> 2, gi = un & 3, r0 = ch * 128;
                {
                    const int q = lane >> 4, within = lane & 15;
#pragma unroll 4
                    for (int i = 0; i < 16; ++i) { const int token = 8 * i + wave;
                        const u32x4 w = *(const u32x4*)(PB + ((size_t)(16 + q) * T + r0 + token) * 128 + within * 8);
                        float s = 0.f, ss = 0.f;
#pragma unroll
                        for (int j = 0; j < 4; ++j) { const float x0 = gelu_tanh(bf_lo(w[j])), x1 = gelu_tanh(bf_hi(w[j])); s += x0 + x1; ss += x0 * x0 + x1 * x1; }
                        s = wave_sum(s); ss = wave_sum(ss);
                        const float mean = s * (1.f / 512.f), var = fmaxf(ss * (1.f / 512.f) - mean * mean, 0.f);
                        if (lane == 0) { st[2 * token] = mean; st[2 * token + 1] = rsqrtf(var + LN_EPS); } }
                }
                __syncthreads();
                {
                    const int tok = tid >> 2, cq = (tid & 3) * 32; const float mean = st[2 * tok], rstd = st[2 * tok + 1];
                    const bf16_t* vp = PB + ((size_t)(16 + gi) * T + r0 + tok) * 128 + cq;
#pragma unroll
                    for (int i = 0; i < 4; ++i) { const u32x4 w = *(const u32x4*)(vp + 8 * i);
#pragma unroll
                        for (int j = 0; j < 4; ++j) { const int c = cq + 8 * i + 2 * j;
                            const float x0 = gelu_tanh(bf_lo(w[j])), x1 = gelu_tanh(bf_hi(w[j]));
                            vT[c * 136 + tok] = f2bf((x0 - mean) * rstd * lng[gi * 128 + c] + lnb[gi * 128 + c]);
                            vT[(c + 1) * 136 + tok] = f2bf((x1 - mean) * rstd * lng[gi * 128 + c + 1] + lnb[gi * 128 + c + 1]); } }
                }
                __syncthreads();
                {
                    f32x4 acc[8];
#pragma unroll
                    for (int ct = 0; ct < 8; ++ct) acc[ct] = (f32x4){0.f, 0.f, 0.f, 0.f};
                    const bf16_t* wrow = wtril + ((size_t)(l * 4 + gi) * 128 + 16 * wave + (lane & 15)) * 128 + 8 * (lane >> 4);
#pragma unroll
                    for (int kk = 0; kk < 4; ++kk) { const bf16x8 av = *(const bf16x8*)(wrow + kk * 32);
#pragma unroll
                        for (int ct = 0; ct < 8; ++ct) { const bf16x8 bv = *(const bf16x8*)(vT + (ct * 16 + (lane & 15)) * 136 + kk * 32 + 8 * (lane >> 4));
                            acc[ct] = __builtin_amdgcn_mfma_f32_16x16x32_bf16(av, bv, acc[ct], 0, 0, 0); } }
#pragma unroll
                    for (int j = 0; j < 4; ++j) { const int t = 16 * wave + 4 * (lane >> 4) + j; const float bt = bs[gi * 128 + t];
#pragma unroll
                        for (int ct = 0; ct < 8; ++ct) svL[t * 132 + ct * 16 + (lane & 15)] = acc[ct][j] + bt; }
                }
                __syncthreads();
                {
                    const int c0 = (tid & 15) * 8;
#pragma unroll
                    for (int i = 0; i < 4; ++i) { const int t = 32 * i + (tid >> 4);
                        const u32x4 uw = *(const u32x4*)(PB + ((size_t)(12 + gi) * T + r0 + t) * 128 + c0);
                        const f32x4 s0 = *(const f32x4*)(svL + t * 132 + c0), s1 = *(const f32x4*)(svL + t * 132 + c0 + 4);
                        u32x4 w; w.x = cvt_pk_bf16(gelu_tanh(bf_lo(uw.x)) * s0[0], gelu_tanh(bf_hi(uw.x)) * s0[1]); w.y = cvt_pk_bf16(gelu_tanh(bf_lo(uw.y)) * s0[2], gelu_tanh(bf_hi(uw.y)) * s0[3]);
                        w.z = cvt_pk_bf16(gelu_tanh(bf_lo(uw.z)) * s1[0], gelu_tanh(bf_hi(uw.z)) * s1[1]); w.w = cvt_pk_bf16(gelu_tanh(bf_lo(uw.w)) * s1[2], gelu_tanh(bf_hi(uw.w)) * s1[3]);
                        *(u32x4*)(Y + (size_t)(r0 + t) * DM + 512 + gi * 128 + c0) = w; }
                }
                __syncthreads();
            }
        }
        {
            PH_IDS;
            bf16_t* PB = WSP(bf16_t, WS_PROJ); float* OATT = WSP(float, WS_R1); float* btab = WSP(float, WS_BTAB);
            float* btl = (float*)(lds + att2::L_BT);
            for (int i = tid; i < 8 * 256; i += NTHR) btl[i] = btab[i];
            __syncthreads();
            const att::bf16* PBb = (const att::bf16*)PB;
#pragma unroll 1
            for (int L = cu; L < 512; L += G) {
                const int k_ = L >> 3, hm = L & 7, b = k_ >> 5, x = k_ & 31, h = hm >> 1;
#pragma unroll 1
                for (int pass = 0; pass < 2; ++pass) {
                    const int qb = pass ? 63 - x : x;
                    att2::Blk c;
                    c.Q = PBb + ((size_t)(20 + hm) * T + (size_t)b * SEQ + qb * 128) * 128; c.K = PBb + ((size_t)(28 + hm) * T + (size_t)b * SEQ) * 128;
                    c.V0 = PBb + ((size_t)(36 + h * 2) * T + (size_t)b * SEQ) * 128; c.V1 = PBb + ((size_t)(37 + h * 2) * T + (size_t)b * SEQ) * 128;
                    c.O0 = OATT + ((size_t)((b * 8 + hm) * 2 + 0) * SEQ + qb * 128) * 128; c.O1 = OATT + ((size_t)((b * 8 + hm) * 2 + 1) * SEQ + qb * 128) * 128;
                    c.P0 = qb * 128; c.hm = hm;
                    att2::attn2_block(c, (char*)lds);
                }
            }
        }
        GRID_BAR();

        {
            PH_IDS;
            float* OATT = WSP(float, WS_R1); bf16_t* Y = WSP(bf16_t, WS_Y); float* lamp = WSP(float, WS_LAM);
            const float lam_init = 0.8f - 0.6f * expf(-0.3f * (float)l);
            const float lam = lamp[l]; const float* sg = INP(11) + (size_t)l * 256;
            const f32x4 gv = *(const f32x4*)(sg + 4 * lane);
            for (int it = gw; it < T * 4; it += NGW) {
                const int r = it >> 2, h = it & 3, b = r >> 13, t = r & (SEQ - 1);
                const int half = lane >> 5, e = (lane & 31) * 4;
                const size_t i0 = ((size_t)(((b * 4 + h) * 2 + 0) * 2 + half) * SEQ + t) * 128 + e;
                const size_t i1 = ((size_t)(((b * 4 + h) * 2 + 1) * 2 + half) * SEQ + t) * 128 + e;
                const f32x4 o0 = *(const f32x4*)(OATT + i0), o1 = *(const f32x4*)(OATT + i1);
                const f32x4 d = o0 - o1 * lam;
                const float ss = wave_sum(d[0] * d[0] + d[1] * d[1] + d[2] * d[2] + d[3] * d[3]);
                const float sc = rsqrtf(ss * (1.f / 256.f) + LN_EPS) * (1.f - lam_init);
                u32x2 w; w.x = cvt_pk_bf16(d[0] * sc * gv[0], d[1] * sc * gv[1]); w.y = cvt_pk_bf16(d[2] * sc * gv[2], d[3] * sc * gv[3]);
                *(u32x2*)(Y + (size_t)r * DM + 1024 + h * 256 + 4 * lane) = w;
            }
        }
        GRID_BAR();

#define LN_PASS(gam, bet, write_xn) do { PH_IDS; float* X = out_opaque(a); bf16_t* XN = WSP(bf16_t, WS_XN); \
            for (int r = gw; r < T; r += NGW) { float* xr = X + (size_t)r * DM; f32x4 v[8]; float s = 0.f; \
                _Pragma("unroll") for (int j = 0; j < 8; ++j) { v[j] = *(const f32x4*)(xr + 4 * lane + 256 * j); s += (v[j][0] + v[j][1]) + (v[j][2] + v[j][3]); } \
                const float mean = wave_sum(s) * (1.f / DM); float s2 = 0.f; \
                _Pragma("unroll") for (int j = 0; j < 8; ++j) { v[j] = v[j] - mean; s2 += (v[j][0] * v[j][0] + v[j][1] * v[j][1]) + (v[j][2] * v[j][2] + v[j][3] * v[j][3]); } \
                const float rstd = rsqrtf(wave_sum(s2) * (1.f / DM) + LN_EPS); \
                _Pragma("unroll") for (int j = 0; j < 8; ++j) { const f32x4 gg = *(const f32x4*)((gam) + 4 * lane + 256 * j), bb = *(const f32x4*)((bet) + 4 * lane + 256 * j); \
                    const f32x4 o = v[j] * rstd * gg + bb; *(f32x4*)(xr + 4 * lane + 256 * j) = o; \
                    if (write_xn) { u32x2 w; w.x = cvt_pk_bf16(o[0], o[1]); w.y = cvt_pk_bf16(o[2], o[3]); *(u32x2*)(XN + (size_t)r * DM + 4 * lane + 256 * j) = w; } } } } while (0)

        {
            unsigned char* ws = ws_opaque(a); float* X = out_opaque(a); float* ST = (float*)(ws + WS_ST);
            pg8::Gemm g{(const bf16_t*)(ws + WS_Y), (const bf16_t*)(ws + WS_W + (size_t)l * W_LAYER + W_OUT), DM, DM, DM, 1, 0, 0, 0, 0};
            pg8::Order S; S.init(T, DM, 1, G, cu_opaque());
            pg8::EpiRes E{nullptr, l == 0 ? INP(0) : nullptr, ST + (size_t)(l > 0 ? 3 * l - 1 : 0) * T * 2, INP(22) + (size_t)(l > 0 ? l - 1 : 0) * DM, INP(23) + (size_t)(l > 0 ? l - 1 : 0) * DM,
                          (bf16_t*)(ws + WS_XN), ST + (size_t)(3 * l) * T * 2, ALPHA, 0};
            pg8::gemm_phase<pg8::EpiRes, true>((LAS unsigned char*)lds, g, S, E);
        }
        GRID_BAR();

        {
            unsigned char* ws = ws_opaque(a);
            const float* cl = (const float*)(ws + WS_C) + (size_t)l * C_LAYER;
            pg8::Gemm g{(const bf16_t*)(ws + WS_XN), (const bf16_t*)(ws + WS_W + (size_t)l * W_LAYER + W_KV), DM, DM, DM, 4, (long)SEQ * DM, 0, (long)4 * NMEM * DM, (long)NMEM * DM};
            pg8::Order S; S.init(SEQ, NMEM, 8, G, cu_opaque());
            pg8::EpiSoftmax E{(bf16_t*)(ws + WS_PROJ + 64 * MiB), (const float*)(ws + WS_ST) + (size_t)(3 * l) * T * 2, cl + C_Q, cl + C_QK2, 0.044194173824159216f};
            pg8::gemm_phase<pg8::EpiSoftmax, true>((LAS unsigned char*)lds, g, S, E);
        }
        GRID_BAR();
        {
            unsigned char* ws = ws_opaque(a); float* ST = (float*)(ws + WS_ST);
            pg8::Gemm g{(const bf16_t*)(ws + WS_PROJ + 64 * MiB), (const bf16_t*)(ws + WS_W + (size_t)l * W_LAYER + W_KV + 8 * MiB), 1024, 1024, 1024, 1, (long)SEQ * 1024, 0, (long)DM * 1024, 0};
            pg8::Order S; S.init(SEQ, DM, 2, G, cu_opaque());
            pg8::EpiRes E{nullptr, nullptr, ST + (size_t)(3 * l) * T * 2, INP(13) + (size_t)l * DM, INP(14) + (size_t)l * DM, (bf16_t*)(ws + WS_XN), ST + (size_t)(3 * l + 1) * T * 2, ALPHA, SEQ};
            pg8::gemm_phase<pg8::EpiRes, true>((LAS unsigned char*)lds, g, S, E);
        }
        GRID_BAR();
        {
            unsigned char* ws = ws_opaque(a);
            const float* cl = (const float*)(ws + WS_C) + (size_t)l * C_LAYER;
            pg8::Gemm g{(const bf16_t*)(ws + WS_XN), (const bf16_t*)(ws + WS_W + (size_t)l * W_LAYER + W_GU), DM, DM, DM, 1, 0, 0, 0, 0};
            pg8::Order S; S.init(T, 2 * DFF, 1, G, cu_opaque());
            pg8::EpiSwiglu E{(bf16_t*)(ws + WS_PROJ), (const float*)(ws + WS_ST) + (size_t)(3 * l + 1) * T * 2, cl + C_GU, cl + C_GU + 2 * DFF};
            pg8::gemm_phase<pg8::EpiSwiglu, true>((LAS unsigned char*)lds, g, S, E);
        }
        GRID_BAR();
        {
            unsigned char* ws = ws_opaque(a); float* X = out_opaque(a); float* ST = (float*)(ws + WS_ST);
            pg8::Gemm g{(const bf16_t*)(ws + WS_PROJ), (const bf16_t*)(ws + WS_W + (size_t)l * W_LAYER + W_D), DFF, DFF, DFF, 1, 0, 0, 0, 0};
            pg8::Order S; S.init(T, DM, 1, G, cu_opaque());
            pg8::EpiRes E{l + 1 == DEPTH ? X : nullptr, nullptr, ST + (size_t)(3 * l + 1) * T * 2, INP(18) + (size_t)l * DM, INP(19) + (size_t)l * DM, (bf16_t*)(ws + WS_XN), ST + (size_t)(3 * l + 2) * T * 2, ALPHA, 0};
            pg8::gemm_phase<pg8::EpiRes, true>((LAS unsigned char*)lds, g, S, E);
        }
        GRID_BAR();
        if (l + 1 == DEPTH) { LN_PASS(INP(22) + (size_t)l * DM, INP(23) + (size_t)l * DM, false); }
#undef LN_PASS
    }
    if (a.ws == nullptr) cg::this_grid().sync();
}

extern "C" void kernel_launch(void* const* d_in, const int* in_sizes, int n_in, void* d_out, int out_size, void* d_ws, size_t ws_size, hipStream_t stream) {
    static int grid = 0;
    if (grid == 0) {
        if (n_in != 24 || in_sizes[0] != T * DM || out_size != T * DM || ws_size < WS_END) {
            fprintf(stderr, "kernel_launch: unexpected shapes (n_in %d, in0 %d, out %d, ws %zu); nothing launched\n", n_in, n_in > 0 ? in_sizes[0] : -1, out_size, ws_size); grid = -1; return; }
        int dev = 0, cus = 0, per_cu = 0;
        (void)hipGetDevice(&dev);
        if (hipDeviceGetAttribute(&cus, hipDeviceAttributeMultiprocessorCount, dev) != hipSuccess || cus <= 0) cus = 256;
        if (hipFuncSetAttribute((const void*)mega_fwd, hipFuncAttributeMaxDynamicSharedMemorySize, LDS_BYTES) != hipSuccess) fprintf(stderr, "kernel_launch: hipFuncSetAttribute failed\n");
        if (hipOccupancyMaxActiveBlocksPerMultiprocessor(&per_cu, (const void*)mega_fwd, NTHR, LDS_BYTES) != hipSuccess || per_cu < 1) { fprintf(stderr, "kernel_launch: occupancy query says %d\n", per_cu); per_cu = 1; }
        (void)hipGetLastError();
        grid = cus * per_cu;
    }
    if (grid < 0) return;
    if (hipMemsetAsync((char*)d_ws + WS_BAR, 0, WS_ST + 768 * 1024 - WS_BAR, stream) != hipSuccess) { fprintf(stderr, "kernel_launch: hipMemsetAsync failed\n"); return; }
    Args a{};
    for (int i = 0; i < 24; ++i) a.in[i] = (const float*)d_in[i];
    a.out = (float*)d_out; a.ws = (unsigned char*)d_ws;
    void* args[] = {&a};
    hipError_t e = hipLaunchCooperativeKernel((const void*)mega_fwd, dim3(grid), dim3(NTHR), args, LDS_BYTES, stream);
    if (e != hipSuccess) fprintf(stderr, "cooperative launch failed: %s (grid %d)\n", hipGetErrorString(e), grid);
}
```

```cpp
#include <hip/hip_runtime.h>
#include <hip/hip_cooperative_groups.h>
#include <hip/hip_bf16.h>
#include <cstdio>
#include <cstdint>
namespace cg = cooperative_groups;

constexpr int BATCH = 2, SEQ = 8192, DM = 2048, DEPTH = 2, T = BATCH * SEQ;
constexpr int NMEM = 256, INC = 5632, DFF = 5632;
constexpr float ALPHA = 1.4142135623730951f;
constexpr float LN_EPS = 1e-5f;
constexpr int NTHR = 512, NWAVES = 8;

constexpr size_t MiB = 1u << 20;
constexpr size_t WS_LAM = 0;
constexpr size_t WS_BTAB = 4096;
constexpr size_t WS_BAR = 512 * 1024;
constexpr size_t WS_C = 576 * 1024;
constexpr int C_Q = 0, C_GU = 4096, C_IN = 4096 + 22528, C_QK2 = 4096 + 22528 + 11264, C_LAYER = C_QK2 + 2048;
constexpr size_t WS_ST = 1 * MiB;
constexpr size_t WS_WTRIL = 12 * MiB;
constexpr size_t WS_MEMBF = 2 * MiB;
constexpr size_t WS_KV = 4 * MiB;
constexpr size_t WS_W = 16 * MiB;
constexpr size_t W_IN = 0, W_OUT = 22 * MiB, W_Q = 30 * MiB, W_KV = 38 * MiB, W_O = 54 * MiB, W_GU = 62 * MiB, W_D = 106 * MiB, W_LAYER = 128 * MiB;
constexpr size_t WS_XN = 272 * MiB;
constexpr size_t WS_PROJ = 336 * MiB;
constexpr size_t WS_R1 = 512 * MiB;
constexpr size_t WS_Y = 640 * MiB;
constexpr size_t WS_END = 704 * MiB;
constexpr int LDS_BYTES = 147456;

typedef unsigned short bf16_t;
typedef short bf16x8 __attribute__((ext_vector_type(8)));
typedef float f32x4 __attribute__((ext_vector_type(4)));
typedef float f32x16 __attribute__((ext_vector_type(16)));
typedef unsigned u32x4 __attribute__((ext_vector_type(4)));
typedef unsigned u32x2 __attribute__((ext_vector_type(2)));
#define LAS __attribute__((address_space(3)))
#define GAS __attribute__((address_space(1)))

__device__ __forceinline__ unsigned cvt_pk_bf16(float lo, float hi) { unsigned r; asm volatile("v_cvt_pk_bf16_f32 %0, %1, %2" : "=v"(r) : "v"(lo), "v"(hi)); return r; }
__device__ __forceinline__ float bf_lo(unsigned w) { return __uint_as_float(w << 16); }
__device__ __forceinline__ float bf_hi(unsigned w) { return __uint_as_float(w & 0xffff0000u); }
__device__ __forceinline__ float bf2f(bf16_t b) { return __uint_as_float(((unsigned)b) << 16); }
__device__ __forceinline__ bf16_t f2bf(float f) { return (bf16_t)(cvt_pk_bf16(f, 0.f) & 0xffffu); }
__device__ __forceinline__ int ltid() { int t = threadIdx.x; asm volatile("" : "+v"(t)); return t; }
__device__ __forceinline__ int cu_opaque() { int c = blockIdx.x; asm volatile("" : "+s"(c)); return c; }
#define PH_IDS const int cu = cu_opaque(); const int tid = ltid(), lane = tid & 63, wave = __builtin_amdgcn_readfirstlane(tid >> 6), gw = cu * NWAVES + wave, gt = cu * NTHR + tid; (void)lane; (void)wave; (void)gw; (void)gt
__device__ __forceinline__ float wave_sum(float v) {
#pragma unroll
    for (int o = 1; o < 64; o <<= 1) v += __shfl_xor(v, o);
    return v;
}
__device__ __forceinline__ float wave_max(float v) {
#pragma unroll
    for (int o = 1; o < 64; o <<= 1) v = fmaxf(v, __shfl_xor(v, o));
    return v;
}
__device__ __forceinline__ float gelu_tanh(float x) {
    const float y = 0.7978845608028654f * (x + 0.044715f * x * x * x);
    return x * __builtin_amdgcn_rcpf(1.f + __expf(-2.f * y));
}

namespace pg8 {
constexpr int BM = 256, BK = 64, HALF = 128, HTB = HALF * BK * 2, STAGE_BYTES = 8 * HTB, NXCD = 8, WGM = 8;
__host__ __device__ __forceinline__ int lds_byte(int r, int c) { const int st = (r >> 4) * 2 + (c >> 5), rr = r & 15, cc = c & 31, ob = rr * 64 + cc * 2; return st * 1024 + (ob ^ (((ob >> 9) & 1) << 5)); }
__host__ __device__ __forceinline__ void stage_rc(int b, int& R, int& C) { const int st = b / 1024, sb = b % 1024, swz = sb ^ (((sb >> 9) & 1) << 5); R = (st >> 1) * 16 + swz / 64; C = (st & 1) * 32 + (swz % 64) / 2; }
__host__ __device__ __forceinline__ int perm32(int rho) { const int n = rho >> 4, i = rho & 15; return 8 * (i >> 2) + 4 * n + (i & 3); }

struct Unit { int pm, pn, bz; };
struct Gemm { const bf16_t* A; const bf16_t* Bt; int lda, ldb, K, nb0; long a_s1, a_s0, b_s1, b_s0; };
__device__ __forceinline__ const char* unit_a(const Gemm& g, const Unit& u) { const int b1 = u.bz / g.nb0, b0 = u.bz % g.nb0; return (const char*)(g.A + (size_t)b1 * g.a_s1 + (size_t)b0 * g.a_s0 + (size_t)u.pm * BM * g.lda); }
__device__ __forceinline__ const char* unit_b(const Gemm& g, const Unit& u) { const int b1 = u.bz / g.nb0, b0 = u.bz % g.nb0; return (const char*)(g.Bt + (size_t)b1 * g.b_s1 + (size_t)b0 * g.b_s0 + (size_t)u.pn * BM * g.ldb); }

struct Order {
    int nM, nN, nB, G, c;
    __device__ void init(int M, int N, int nB_, int G_, int c_) { nM = M / BM; nN = N / BM; nB = nB_; G = G_; c = c_; }
    __device__ bool next(int i, Unit& u) const {
        const long L = (long)i * G + c; const int nwg = nM * nN; if (c < 0 || L >= (long)nwg * nB) return false;
        if (nB > 1) { u.bz = (int)(L / nwg); const int w = (int)(L % nwg); u.pn = w / nM; u.pm = w % nM; return true; }
        u.bz = 0;
        int wgid = (int)L; { const int q = nwg / NXCD, r = nwg % NXCD, xcd = wgid % NXCD, off = wgid / NXCD; wgid = (xcd < r ? xcd * (q + 1) : r * (q + 1) + (xcd - r) * q) + off; }
        const int nig = WGM * nN, gid = wgid / nig, fm = gid * WGM, gsz = (nM - fm) < WGM ? (nM - fm) : WGM;
        u.pm = fm + ((wgid % nig) % gsz); u.pn = (wgid % nig) / gsz; return true;
    }
};

__device__ __forceinline__ void row_stats(const float* st, int row, float& mean, float& rstd) {
    const float s1 = st[2 * row], s2 = st[2 * row + 1];
    mean = s1 * (1.f / DM); const float var = fmaxf(s2 * (1.f / DM) - mean * mean, 0.f); rstd = rsqrtf(var + LN_EPS);
}
struct EpiSplit {
    static constexpr bool PERM = true, AFTER_DRAIN = false;
    bf16_t* P; const float* st; const float* c1; const float* c2;
    float* gst;
    __device__ __forceinline__ void operator()(const f32x4 (&acc)[2][2][4][2], const Unit& u, int wr, int wc, int fr, int fq) const {
        const int row0 = u.pm * BM + wr * 64 + fr, col0 = u.pn * BM + wc * 32 + 8 * fq;
        const bool vg = (u.pn == 8 || u.pn == 9);
        f32x4 k1[2][2], k2[2][2];
        if (st) {
#pragma unroll
            for (int bj = 0; bj < 2; ++bj)
#pragma unroll
                for (int n = 0; n < 2; ++n) { k1[bj][n] = *(const f32x4*)(c1 + col0 + bj * HALF + 4 * n); k2[bj][n] = *(const f32x4*)(c2 + col0 + bj * HALF + 4 * n); } }
#pragma unroll
        for (int ai = 0; ai < 2; ++ai)
#pragma unroll
            for (int m = 0; m < 4; ++m) { const int row = row0 + ai * HALF + m * 16;
                float mean = 0.f, rstd = 1.f; if (st) row_stats(st, row, mean, rstd);
                float gs = 0.f, gq = 0.f;
#pragma unroll
                for (int bj = 0; bj < 2; ++bj) { f32x4 v0 = acc[ai][bj][m][0], v1 = acc[ai][bj][m][1];
                    if (st) { v0 = (v0 - k1[bj][0] * mean) * rstd + k2[bj][0]; v1 = (v1 - k1[bj][1] * mean) * rstd + k2[bj][1]; }
                    u32x4 w; w.x = cvt_pk_bf16(v0[0], v0[1]); w.y = cvt_pk_bf16(v0[2], v0[3]); w.z = cvt_pk_bf16(v1[0], v1[1]); w.w = cvt_pk_bf16(v1[2], v1[3]);
                    *(u32x4*)(P + ((size_t)(u.pn * 2 + bj) * T + row) * 128 + wc * 32 + 8 * fq) = w;
                    if (vg) {
#pragma unroll
                        for (int j = 0; j < 4; ++j) { const float x0 = gelu_tanh(bf_lo(w[j])), x1 = gelu_tanh(bf_hi(w[j])); gs += x0 + x1; gq += x0 * x0 + x1 * x1; } } }
                if (vg) { gs += __shfl_xor(gs, 16); gs += __shfl_xor(gs, 32); gq += __shfl_xor(gq, 16); gq += __shfl_xor(gq, 32);
                    if (fq == 0) { unsafeAtomicAdd(gst + 2 * row, gs); unsafeAtomicAdd(gst + 2 * row + 1, gq); } } }
    }
};
struct EpiBf16 {
    static constexpr bool PERM = true, AFTER_DRAIN = false;
    bf16_t* O; int ldc, nb0; long o_s1, o_s0; float scale; const float* st; const float* c1; const float* c2; float* rsum;
    __device__ __forceinline__ void operator()(const f32x4 (&acc)[2][2][4][2], const Unit& u, int wr, int wc, int fr, int fq) const {
        const int row0 = u.pm * BM + wr * 64 + fr, col0 = u.pn * BM + wc * 32 + 8 * fq;
        bf16_t* base = O + (size_t)(u.bz / nb0) * o_s1 + (size_t)(u.bz % nb0) * o_s0;
        f32x4 k1[2][2], k2[2][2];
        if (st) {
#pragma unroll
            for (int bj = 0; bj < 2; ++bj)
#pragma unroll
                for (int n = 0; n < 2; ++n) { k1[bj][n] = *(const f32x4*)(c1 + col0 + bj * HALF + 4 * n); k2[bj][n] = *(const f32x4*)(c2 + col0 + bj * HALF + 4 * n); } }
#pragma unroll
        for (int ai = 0; ai < 2; ++ai)
#pragma unroll
            for (int m = 0; m < 4; ++m) { const int row = row0 + ai * HALF + m * 16; bf16_t* rowp = base + (size_t)row * ldc + col0;
                float mean = 0.f, rstd = 1.f; if (st) row_stats(st, row, mean, rstd);
                float rs = 0.f;
#pragma unroll
                for (int bj = 0; bj < 2; ++bj) { f32x4 v0 = acc[ai][bj][m][0], v1 = acc[ai][bj][m][1];
                    if (st) { v0 = (v0 - k1[bj][0] * mean) * rstd + k2[bj][0]; v1 = (v1 - k1[bj][1] * mean) * rstd + k2[bj][1]; }
                    v0 = v0 * scale; v1 = v1 * scale;
                    u32x4 w; w.x = cvt_pk_bf16(v0[0], v0[1]); w.y = cvt_pk_bf16(v0[2], v0[3]); w.z = cvt_pk_bf16(v1[0], v1[1]); w.w = cvt_pk_bf16(v1[2], v1[3]);
                    *(u32x4*)(rowp + bj * HALF) = w;
                    if (rsum) rs += ((bf_lo(w.x) + bf_hi(w.x)) + (bf_lo(w.y) + bf_hi(w.y))) + ((bf_lo(w.z) + bf_hi(w.z)) + (bf_lo(w.w) + bf_hi(w.w))); }
                if (rsum) { rs += __shfl_xor(rs, 16); rs += __shfl_xor(rs, 32); if (fq == 0) unsafeAtomicAdd(rsum + u.bz * 256 + row, rs); } }
    }
};
struct EpiF32 {
    static constexpr bool PERM = false, AFTER_DRAIN = false;
    float* out; int ldc; long o_bs; float scale;
    __device__ __forceinline__ void operator()(const f32x4 (&acc)[2][2][4][2], const Unit& u, int wr, int wc, int fr, int fq) const {
        const int row0 = u.pm * BM + wr * 64 + fr, col0 = u.pn * BM + wc * 32 + 4 * fq;
        float* ob = out + (size_t)u.bz * o_bs;
#pragma unroll
        for (int ai = 0; ai < 2; ++ai)
#pragma unroll
            for (int m = 0; m < 4; ++m) { const size_t off = (size_t)(row0 + ai * HALF + m * 16) * ldc + col0;
#pragma unroll
                for (int bj = 0; bj < 2; ++bj)
#pragma unroll
                    for (int n = 0; n < 2; ++n) *(f32x4*)(ob + off + bj * HALF + n * 16) = acc[ai][bj][m][n] * scale; }
    }
};
struct EpiRes {
    static constexpr bool PERM = true, AFTER_DRAIN = false;
    float* X; const float* raw; const float* pst; const float* pg; const float* pb; bf16_t* ZB; float* cst; float alpha; int brows;
    __device__ __forceinline__ void operator()(const f32x4 (&acc)[2][2][4][2], const Unit& u, int wr, int wc, int fr, int fq) const {
        const int row0 = u.bz * brows + u.pm * BM + wr * 64 + fr, col0 = u.pn * BM + wc * 32 + 8 * fq;
        f32x4 gv[2][2], bv[2][2];
        if (!raw) {
#pragma unroll
            for (int bj = 0; bj < 2; ++bj)
#pragma unroll
                for (int n = 0; n < 2; ++n) { gv[bj][n] = *(const f32x4*)(pg + col0 + bj * HALF + 4 * n); bv[bj][n] = *(const f32x4*)(pb + col0 + bj * HALF + 4 * n); } }
#pragma unroll
        for (int ai = 0; ai < 2; ++ai)
#pragma unroll
            for (int m = 0; m < 4; ++m) { const int row = row0 + ai * HALF + m * 16; const size_t off = (size_t)row * DM + col0;
                float mean = 0.f, rstd = 1.f; if (!raw) row_stats(pst, row, mean, rstd);
                float s1 = 0.f, s2 = 0.f;
#pragma unroll
                for (int bj = 0; bj < 2; ++bj) { f32x4 r0, r1;
                    if (raw) { r0 = *(const f32x4*)(raw + off + bj * HALF); r1 = *(const f32x4*)(raw + off + bj * HALF + 4); }
                    else { const u32x4 zw = *(const u32x4*)(ZB + off + bj * HALF);
                        r0 = (f32x4){bf_lo(zw.x), bf_hi(zw.x), bf_lo(zw.y), bf_hi(zw.y)}; r1 = (f32x4){bf_lo(zw.z), bf_hi(zw.z), bf_lo(zw.w), bf_hi(zw.w)};
                        r0 = (r0 - mean) * rstd * gv[bj][0] + bv[bj][0]; r1 = (r1 - mean) * rstd * gv[bj][1] + bv[bj][1]; }
                    const f32x4 z0 = acc[ai][bj][m][0] + r0 * alpha, z1 = acc[ai][bj][m][1] + r1 * alpha;
                    if (X) { *(f32x4*)(X + off + bj * HALF) = z0; *(f32x4*)(X + off + bj * HALF + 4) = z1; }
                    u32x4 w; w.x = cvt_pk_bf16(z0[0], z0[1]); w.y = cvt_pk_bf16(z0[2], z0[3]); w.z = cvt_pk_bf16(z1[0], z1[1]); w.w = cvt_pk_bf16(z1[2], z1[3]);
                    *(u32x4*)(ZB + off + bj * HALF) = w;
                    s1 += ((z0[0] + z0[1]) + (z0[2] + z0[3])) + ((z1[0] + z1[1]) + (z1[2] + z1[3]));
                    s2 += ((z0[0] * z0[0] + z0[1] * z0[1]) + (z0[2] * z0[2] + z0[3] * z0[3])) + ((z1[0] * z1[0] + z1[1] * z1[1]) + (z1[2] * z1[2] + z1[3] * z1[3])); }
                s1 += __shfl_xor(s1, 16); s1 += __shfl_xor(s1, 32); s2 += __shfl_xor(s2, 16); s2 += __shfl_xor(s2, 32);
                if (fq == 0) { unsafeAtomicAdd(cst + 2 * row, s1); unsafeAtomicAdd(cst + 2 * row + 1, s2); } }
    }
};
struct EpiSwiglu {
    static constexpr bool PERM = true, AFTER_DRAIN = false;
    bf16_t* H; const float* st; const float* c1; const float* c2;
    __device__ __forceinline__ void operator()(const f32x4 (&acc)[2][2][4][2], const Unit& u, int wr, int wc, int fr, int fq) const {
        const int row0 = u.pm * BM + wr * 64 + fr, col0 = u.pn * HALF + wc * 32 + 8 * fq, ccol0 = u.pn * BM + wc * 32 + 8 * fq;
        f32x4 k1[2][2], k2[2][2];
#pragma unroll
        for (int bj = 0; bj < 2; ++bj)
#pragma unroll
            for (int n = 0; n < 2; ++n) { k1[bj][n] = *(const f32x4*)(c1 + ccol0 + bj * HALF + 4 * n); k2[bj][n] = *(const f32x4*)(c2 + ccol0 + bj * HALF + 4 * n); }
#pragma unroll
        for (int ai = 0; ai < 2; ++ai)
#pragma unroll
            for (int m = 0; m < 4; ++m) { const int row = row0 + ai * HALF + m * 16; bf16_t* rowp = H + (size_t)row * DFF + col0;
                float mean, rstd; row_stats(st, row, mean, rstd);
                float h[8];
#pragma unroll
                for (int n = 0; n < 2; ++n) { const f32x4 gq = (acc[ai][0][m][n] - k1[0][n] * mean) * rstd + k2[0][n], uq = (acc[ai][1][m][n] - k1[1][n] * mean) * rstd + k2[1][n];
#pragma unroll
                    for (int j = 0; j < 4; ++j) h[n * 4 + j] = gq[j] * __builtin_amdgcn_rcpf(1.f + __expf(-gq[j])) * uq[j]; }
                u32x4 w; w.x = cvt_pk_bf16(h[0], h[1]); w.y = cvt_pk_bf16(h[2], h[3]); w.z = cvt_pk_bf16(h[4], h[5]); w.w = cvt_pk_bf16(h[6], h[7]);
                *(u32x4*)rowp = w; }
    }
};

struct EpiSoftmax {
    static constexpr bool PERM = true, AFTER_DRAIN = true;
    bf16_t* PALL; const float* st; const float* c1; const float* c2; float scale;
    __device__ __forceinline__ void fused(f32x4 (&acc)[2][2][4][2], const Unit& u, int wr, int wc, int fr, int fq, LAS unsigned char* lds) const {
        const int b = u.bz >> 2, h = u.bz & 3, rl0 = wr * 64 + fr, cc0 = wc * 32 + 8 * fq;
        LAS float* PMX = (LAS float*)lds; LAS float* PSM = PMX + 1024;
        f32x4 k1[2][2], k2[2][2];
#pragma unroll
        for (int bj = 0; bj < 2; ++bj)
#pragma unroll
            for (int n = 0; n < 2; ++n) { k1[bj][n] = *(const f32x4*)(c1 + u.bz * 256 + cc0 + bj * HALF + 4 * n); k2[bj][n] = *(const f32x4*)(c2 + u.bz * 256 + cc0 + bj * HALF + 4 * n); }
#pragma unroll
        for (int ai = 0; ai < 2; ++ai)
#pragma unroll
            for (int m = 0; m < 4; ++m) { const int rl = rl0 + ai * HALF + m * 16, row = b * SEQ + u.pm * BM + rl;
                float mean, rstd; row_stats(st, row, mean, rstd);
                float mx = -__builtin_inff();
#pragma unroll
                for (int bj = 0; bj < 2; ++bj)
#pragma unroll
                    for (int n = 0; n < 2; ++n) { const f32x4 v = ((acc[ai][bj][m][n] - k1[bj][n] * mean) * rstd + k2[bj][n]) * scale; acc[ai][bj][m][n] = v;
                        mx = fmaxf(mx, fmaxf(fmaxf(v[0], v[1]), fmaxf(v[2], v[3]))); }
                mx = fmaxf(mx, __shfl_xor(mx, 16)); mx = fmaxf(mx, __shfl_xor(mx, 32));
                if (fq == 0) PMX[rl * 4 + wc] = mx; }
        asm volatile("s_waitcnt lgkmcnt(0)" ::: "memory"); __builtin_amdgcn_s_barrier(); asm volatile("" ::: "memory");
#pragma unroll
        for (int ai = 0; ai < 2; ++ai)
#pragma unroll
            for (int m = 0; m < 4; ++m) { const int rl = rl0 + ai * HALF + m * 16;
                const f32x4 q = *(const LAS f32x4*)(PMX + rl * 4); const float mx = fmaxf(fmaxf(q[0], q[1]), fmaxf(q[2], q[3]));
                float sm = 0.f;
#pragma unroll
                for (int bj = 0; bj < 2; ++bj)
#pragma unroll
                    for (int n = 0; n < 2; ++n) { f32x4 e = acc[ai][bj][m][n] - mx; e[0] = __expf(e[0]); e[1] = __expf(e[1]); e[2] = __expf(e[2]); e[3] = __expf(e[3]); acc[ai][bj][m][n] = e;
                        sm += (e[0] + e[1]) + (e[2] + e[3]); }
                sm += __shfl_xor(sm, 16); sm += __shfl_xor(sm, 32);
                if (fq == 0) PSM[rl * 4 + wc] = sm; }
        asm volatile("s_waitcnt lgkmcnt(0)" ::: "memory"); __builtin_amdgcn_s_barrier(); asm volatile("" ::: "memory");
#pragma unroll
        for (int ai = 0; ai < 2; ++ai)
#pragma unroll
            for (int m = 0; m < 4; ++m) { const int rl = rl0 + ai * HALF + m * 16, row = b * SEQ + u.pm * BM + rl;
                const f32x4 q = *(const LAS f32x4*)(PSM + rl * 4); const float inv = __builtin_amdgcn_rcpf((q[0] + q[1]) + (q[2] + q[3]));
                bf16_t* rowp = PALL + (size_t)row * 1024 + h * 256 + cc0;
#pragma unroll
                for (int bj = 0; bj < 2; ++bj) { const f32x4 v0 = acc[ai][bj][m][0] * inv, v1 = acc[ai][bj][m][1] * inv;
                    u32x4 w; w.x = cvt_pk_bf16(v0[0], v0[1]); w.y = cvt_pk_bf16(v0[2], v0[3]); w.z = cvt_pk_bf16(v1[0], v1[1]); w.w = cvt_pk_bf16(v1[2], v1[3]);
                    *(u32x4*)(rowp + bj * HALF) = w; } }
    }
};

template <class Epi, bool ALIGN_EPI>
__device__ __forceinline__ void gemm_phase(LAS unsigned char* lds, const Gemm g, const Order& S, const Epi& E) {
    const int tid = ltid(), wid = __builtin_amdgcn_readfirstlane(tid >> 6), lane = tid & 63, wr = wid >> 2, wc = wid & 3, fr = lane & 15, fq = lane >> 4;
    const int K = g.K, nt = K / BK;
    unsigned voffA[2], voffB[2];
#pragma unroll
    for (int i = 0; i < 2; ++i) { int R, C; stage_rc(tid * 16 + i * 8192, R, C); const int Rb = Epi::PERM ? ((R & ~31) + perm32(R & 31)) : R;
        voffA[i] = (unsigned)(R * g.lda + C) * 2u; voffB[i] = (unsigned)(Rb * g.ldb + C) * 2u; }
    const size_t kstep = (size_t)(BK * 2);
    const size_t hstepA = (size_t)HALF * g.lda * 2, hstepB = (size_t)HALF * g.ldb * 2;
    const unsigned ldsw = (unsigned)wid * 1024u;
    const int aoff = lds_byte(wr * 64 + fr, fq * 8), boff = lds_byte(wc * 32 + fr, fq * 8);
#define PG8_SA(b, h) (((b) * 2 + (h)) * HTB)
#define PG8_SB(b, h) ((4 + (b) * 2 + (h)) * HTB)
#define PG8_STAGE(bufoff, gbase, voff) do { _Pragma("unroll") for (int _i = 0; _i < 2; ++_i) \
        __builtin_amdgcn_global_load_lds((const unsigned*)((const char*)(gbase) + (voff)[_i]), (LAS unsigned*)(lds + (bufoff) + ldsw + _i * 8192), 16, 0, 0); } while (0)
#define PG8_LDA(dst, b, h) do { _Pragma("unroll") for (int m = 0; m < 4; ++m) _Pragma("unroll") for (int k = 0; k < 2; ++k) dst[m][k] = *(const LAS bf16x8*)(lds + PG8_SA(b, h) + aoff + m * 2048 + k * 1024); } while (0)
#define PG8_LDB(dst, b, h) do { _Pragma("unroll") for (int n = 0; n < 2; ++n) _Pragma("unroll") for (int k = 0; k < 2; ++k) dst[n][k] = *(const LAS bf16x8*)(lds + PG8_SB(b, h) + boff + n * 2048 + k * 1024); } while (0)
#define PG8_MMA(ai, bj, At, Bt) do { __builtin_amdgcn_s_setprio(1); _Pragma("unroll") for (int m = 0; m < 4; ++m) _Pragma("unroll") for (int n = 0; n < 2; ++n) _Pragma("unroll") for (int k = 0; k < 2; ++k) \
        acc[ai][bj][m][n] = __builtin_amdgcn_mfma_f32_16x16x32_bf16(Bt[n][k], At[m][k], acc[ai][bj][m][n], 0, 0, 0); __builtin_amdgcn_s_setprio(0); } while (0)
#define PG8_WAIT_V(n) asm volatile("s_waitcnt vmcnt(" #n ")" ::: "memory")
#define PG8_WAIT_L(n) asm volatile("s_waitcnt lgkmcnt(" #n ")" ::: "memory")
#define PG8_BAR __builtin_amdgcn_s_barrier()
#define PG8_SCHED __builtin_amdgcn_sched_barrier(0)
    Unit cur, nxt; int ui = 0;
    if (!S.next(0, cur)) return;
    f32x4 acc[2][2][4][2];
#pragma unroll
    for (int a = 0; a < 2; ++a)
#pragma unroll
        for (int b = 0; b < 2; ++b)
#pragma unroll
            for (int m = 0; m < 4; ++m)
#pragma unroll
                for (int n = 0; n < 2; ++n) acc[a][b][m][n] = (f32x4){0.f, 0.f, 0.f, 0.f};
    bf16x8 At[4][2], B0[2][2], B1[2][2];
    const char* cA = unit_a(g, cur); const char* cB = unit_b(g, cur);
    PG8_STAGE(PG8_SB(0, 0), cB, voffB); PG8_STAGE(PG8_SB(0, 1), cB + hstepB, voffB); PG8_STAGE(PG8_SA(0, 0), cA, voffA); PG8_STAGE(PG8_SA(0, 1), cA + hstepA, voffA);
    if (wr == 1) PG8_BAR;
    PG8_WAIT_V(2); PG8_BAR;
    PG8_STAGE(PG8_SB(1, 0), cB + kstep, voffB); PG8_STAGE(PG8_SA(1, 0), cA + kstep, voffA); PG8_STAGE(PG8_SB(1, 1), cB + hstepB + kstep, voffB);
    PG8_WAIT_V(6); PG8_BAR;
    for (;;) {
        const bool has_next = S.next(ui + 1, nxt);
        const char* nA = has_next ? unit_a(g, nxt) : cA; const char* nB = has_next ? unit_b(g, nxt) : cB;
        for (int t = 0; t < nt; t += 2) {
            const bool last = (t == nt - 2);
            const char* a1 = cA + (size_t)(t + 1) * kstep;
            const char* a2 = last ? nA : cA + (size_t)(t + 2) * kstep; const char* b2 = last ? nB : cB + (size_t)(t + 2) * kstep;
            const char* a3 = a2 + kstep; const char* b3 = b2 + kstep;
            PG8_LDB(B0, 0, 0); PG8_LDB(B1, 0, 1); PG8_SCHED; PG8_LDA(At, 0, 0); PG8_STAGE(PG8_SA(1, 1), a1 + hstepA, voffA);
            PG8_WAIT_V(8); PG8_WAIT_L(0); PG8_BAR; PG8_MMA(0, 0, At, B0); PG8_MMA(0, 1, At, B1); PG8_BAR; PG8_SCHED;
            PG8_LDA(At, 0, 1); PG8_STAGE(PG8_SB(0, 0), b2, voffB); PG8_STAGE(PG8_SB(0, 1), b2 + hstepB, voffB); PG8_STAGE(PG8_SA(0, 0), a2, voffA);
            PG8_WAIT_V(8); PG8_WAIT_L(0); PG8_BAR; PG8_MMA(1, 0, At, B0); PG8_MMA(1, 1, At, B1); PG8_BAR; PG8_SCHED;
            PG8_LDB(B0, 1, 0); PG8_LDB(B1, 1, 1); PG8_SCHED; PG8_LDA(At, 1, 0); PG8_STAGE(PG8_SA(0, 1), a2 + hstepA, voffA);
            PG8_WAIT_V(8); PG8_WAIT_L(0); PG8_BAR; PG8_MMA(0, 0, At, B0); PG8_MMA(0, 1, At, B1); PG8_BAR; PG8_SCHED;
            PG8_LDA(At, 1, 1); PG8_STAGE(PG8_SB(1, 0), b3, voffB); PG8_STAGE(PG8_SB(1, 1), b3 + hstepB, voffB); PG8_STAGE(PG8_SA(1, 0), a3, voffA);
            PG8_WAIT_V(8); PG8_WAIT_L(0); PG8_BAR; PG8_MMA(1, 0, At, B0); PG8_MMA(1, 1, At, B1); PG8_BAR; PG8_SCHED;
        }
        if constexpr (ALIGN_EPI) { if (wr == 0) PG8_BAR; }
        if constexpr (!Epi::AFTER_DRAIN) E(acc, cur, wr, wc, fr, fq);
        if (!has_next) break;
#pragma unroll
        for (int a = 0; a < 2; ++a)
#pragma unroll
            for (int b = 0; b < 2; ++b)
#pragma unroll
                for (int m = 0; m < 4; ++m)
#pragma unroll
                    for (int n = 0; n < 2; ++n) acc[a][b][m][n] = (f32x4){0.f, 0.f, 0.f, 0.f};
        cur = nxt; cA = nA; cB = nB; ++ui;
        if constexpr (ALIGN_EPI) { if (wr == 1) PG8_BAR; }
    }
    PG8_WAIT_V(0);
    if constexpr (!ALIGN_EPI) { if (wr == 0) PG8_BAR; }
    PG8_BAR;
    if constexpr (Epi::AFTER_DRAIN) E.fused(acc, cur, wr, wc, fr, fq, lds);
#undef PG8_SA
#undef PG8_SB
#undef PG8_STAGE
#undef PG8_LDA
#undef PG8_LDB
#undef PG8_MMA
#undef PG8_WAIT_V
#undef PG8_WAIT_L
#undef PG8_BAR
#undef PG8_SCHED
}
}

namespace att {
using bf16 = __hip_bfloat16;
typedef short s16x4 __attribute__((ext_vector_type(4)));
constexpr int D = 128;
constexpr float THR = 8.f;
constexpr float SCALE = 0.08838834764831845f;
constexpr int NW = 8, QBLK = 32, KVBLK = 64, QB = NW * QBLK;
constexpr int SHM_V = KVBLK * D * 2, SHM_K = KVBLK * D * 2;
constexpr int ATT_LDS = 2 * SHM_V + 2 * SHM_K + NW * 64 * 4;
constexpr int BT_OFF = ATT_LDS;

#define KSWZ(row, colB) ((row) * 256 + ((colB) ^ (((row) & 7) << 4)))
#define SBAR() __builtin_amdgcn_sched_barrier(0)
__device__ __forceinline__ int v_st(int k, int c) { const int kk = (k & ~0xC) | ((k & 4) << 1) | ((k & 8) >> 1); return ((kk >> 3) * 4 + (c >> 5)) * 512 + ((kk & 7) * 32 + (c & 31)) * 2; }
__device__ __forceinline__ int v_rd_base(int lane) { return ((lane & 3) << 3) | (((lane >> 2) & 3) << 6) | (((lane >> 4) & 1) << 5) | (((lane >> 5) & 1) << 8); }
constexpr int v_rd_off(int d0, int ks, int half) { return d0 * 512 + ks * 4096 + half * 2048; }
__device__ __forceinline__ int crow(int r, int hi) { return (r & 3) + 8 * (r >> 2) + 4 * hi; }
__device__ __forceinline__ unsigned cvtpk(float lo, float hi) { unsigned r; asm volatile("v_cvt_pk_bf16_f32 %0, %1, %2" : "=v"(r) : "v"(lo), "v"(hi)); return r; }
__device__ __forceinline__ bf16x8 load8(const bf16* p) { return *reinterpret_cast<const bf16x8*>(p); }
__device__ __forceinline__ void bias_mask_tile(f32x16& p0, f32x16& p1, int dq, const float* bt) {
    const float NEG = -__builtin_inff();
#pragma unroll
    for (int r = 0; r < 16; ++r) {
        const int c = (r & 3) + 8 * (r >> 2);
        const int d0 = dq - c, d1 = dq - c - 32;
        const unsigned i0 = (unsigned)d0 < 255u ? (unsigned)d0 : 255u, i1 = (unsigned)d1 < 255u ? (unsigned)d1 : 255u;
        const float b0 = bt[i0], b1 = bt[i1];
        p0[r] = d0 >= 0 ? p0[r] + b0 : NEG;
        p1[r] = d1 >= 0 ? p1[r] + b1 : NEG;
    }
}
__device__ __forceinline__ void partialSM(f32x16& p0, f32x16& p1, float& m_reg, float& mn, float& alpha) {
    float pmax = p0[0]; for (int r = 1; r < 16; ++r) pmax = fmaxf(pmax, p0[r]); for (int r = 0; r < 16; ++r) pmax = fmaxf(pmax, p1[r]);
    { auto rr = __builtin_amdgcn_permlane32_swap(__float_as_uint(pmax), __float_as_uint(pmax), false, false);
      pmax = fmaxf(__uint_as_float(rr[0]), __uint_as_float(rr[1])); }
    constexpr float C2 = 1.4426950408889634f * SCALE;
    if (__builtin_expect(__all((pmax - m_reg) * SCALE <= THR), 1)) { mn = m_reg; alpha = 1.f; }
    else { mn = fmaxf(m_reg, pmax); alpha = __builtin_amdgcn_exp2f((m_reg - mn) * C2); m_reg = mn; }
    const float mnL = -mn * C2;
    for (int r = 0; r < 16; ++r) p0[r] = fmaf(p0[r], C2, mnL); for (int r = 0; r < 16; ++r) p1[r] = fmaf(p1[r], C2, mnL);
    for (int r = 0; r < 16; ++r) p0[r] = __builtin_amdgcn_exp2f(p0[r]);
}
__device__ __forceinline__ void finishSM(f32x16& p0, f32x16& p1, float alpha, float& l_reg, bf16x8& pa0, bf16x8& pa1, bf16x8& pa2, bf16x8& pa3) {
    for (int r = 0; r < 16; ++r) p1[r] = __builtin_amdgcn_exp2f(p1[r]);
    float ps = 0; for (int r = 0; r < 16; ++r) ps += p0[r]; for (int r = 0; r < 16; ++r) ps += p1[r];
    { auto rr = __builtin_amdgcn_permlane32_swap(__float_as_uint(ps), __float_as_uint(ps), false, false);
      ps = __uint_as_float(rr[0]) + __uint_as_float(rr[1]); }
    l_reg = l_reg * alpha + ps;
#define PK4(P, B_, OUT) do { unsigned a0 = cvtpk(P[B_+0], P[B_+1]), a1 = cvtpk(P[B_+2], P[B_+3]);                          \
        unsigned b0 = cvtpk(P[B_+4], P[B_+5]), b1 = cvtpk(P[B_+6], P[B_+7]);                                             \
        auto r0 = __builtin_amdgcn_permlane32_swap(a0, b0, false, false); auto r1 = __builtin_amdgcn_permlane32_swap(a1, b1, false, false); \
        u32x4 w = {r0[0], r1[0], r0[1], r1[1]}; OUT = *reinterpret_cast<bf16x8*>(&w); } while (0)
    PK4(p0, 0, pa0); PK4(p0, 8, pa1); PK4(p1, 0, pa2); PK4(p1, 8, pa3);
#undef PK4
}
template <int KB>
__device__ __forceinline__ void qkt(f32x16& p0, f32x16& p1, const char* K_lds, int r32, int hi, const bf16x8* qr) {
    p0 = f32x16{}; p1 = f32x16{};
    const char* kb[4];
#pragma unroll
    for (int dd = 0; dd < 4; ++dd) kb[dd] = K_lds + KB * SHM_K + KSWZ(r32, (dd * 16 + hi * 8) * 2);
#pragma unroll
    for (int d0 = 0; d0 < 8; ++d0) { const char* a = kb[d0 & 3] + (d0 >> 2) * 128;
        bf16x8 b0 = *reinterpret_cast<const bf16x8*>(a);
        bf16x8 b1 = *reinterpret_cast<const bf16x8*>(a + 32 * 256);
        p0 = __builtin_amdgcn_mfma_f32_32x32x16_bf16(b0, qr[d0], p0, 0, 0, 0);
        p1 = __builtin_amdgcn_mfma_f32_32x32x16_bf16(b1, qr[d0], p1, 0, 0, 0); }
}
template <int VB>
__device__ __forceinline__ void pv_tile(f32x16* o, int vb0, bf16x8 pa0, bf16x8 pa1, bf16x8 pa2, bf16x8 pa3) {
#define TRRD(dst, off) asm volatile("ds_read_b64_tr_b16 %0, %1 offset:%2" : "=&v"(dst) : "v"(vb0), "i"(off) : "memory")
#define PV_D0(d0) do { s16x4 l0, l1, l2, l3, h0, h1, h2, h3; constexpr int b_ = VB * SHM_V + v_rd_off(d0, 0, 0); \
        TRRD(l0, b_); TRRD(h0, b_ + 2048); TRRD(l1, b_ + 4096); TRRD(h1, b_ + 6144); TRRD(l2, b_ + 8192); TRRD(h2, b_ + 10240); TRRD(l3, b_ + 12288); TRRD(h3, b_ + 14336); \
        asm volatile("s_waitcnt lgkmcnt(0)" ::: "memory"); SBAR();   \
        o[d0] = __builtin_amdgcn_mfma_f32_32x32x16_bf16(pa0, (bf16x8){l0[0], l0[1], l0[2], l0[3], h0[0], h0[1], h0[2], h0[3]}, o[d0], 0, 0, 0);   \
        o[d0] = __builtin_amdgcn_mfma_f32_32x32x16_bf16(pa1, (bf16x8){l1[0], l1[1], l1[2], l1[3], h1[0], h1[1], h1[2], h1[3]}, o[d0], 0, 0, 0);   \
        o[d0] = __builtin_amdgcn_mfma_f32_32x32x16_bf16(pa2, (bf16x8){l2[0], l2[1], l2[2], l2[3], h2[0], h2[1], h2[2], h2[3]}, o[d0], 0, 0, 0);   \
        o[d0] = __builtin_amdgcn_mfma_f32_32x32x16_bf16(pa3, (bf16x8){l3[0], l3[1], l3[2], l3[3], h3[0], h3[1], h3[2], h3[3]}, o[d0], 0, 0, 0); } while (0)
    PV_D0(0); PV_D0(1); PV_D0(2); PV_D0(3);
#undef PV_D0
#undef TRRD
}
struct BlockRef { const bf16* Q; const bf16* K; const bf16* V; float* O; int P0; int hm; };
struct Seam { bf16x8 qr[8]; bf16x8 st_v0, st_v1, st_k0, st_k1; };
#define ROW(p, k0, rr) ((p) + (size_t)((k0) + (rr)) * D + sc)
#define VMW() asm volatile("s_waitcnt vmcnt(0)" ::: "memory")
#define VMWN(n) asm volatile("s_waitcnt vmcnt(%0)" :: "i"(n) : "memory")
#define SLOAD_H(Kp, Vp, k0) do { S.st_v0 = load8(ROW(Vp, k0, sr)); S.st_v1 = load8(ROW(Vp, k0, 32 + sr));              \
                         S.st_k0 = load8(ROW(Kp, k0, sr)); S.st_k1 = load8(ROW(Kp, k0, 32 + sr)); } while (0)
#define SWRITE_HK(bf) do { *(bf16x8*)(K_lds + (bf) * SHM_K + kws) = S.st_k0; *(bf16x8*)(K_lds + (bf) * SHM_K + kws + 32 * 256) = S.st_k1; } while (0)
#define SWRITE_HV(bf) do { *(bf16x8*)(V_lds + (bf) * SHM_V + vst0) = S.st_v0; *(bf16x8*)(V_lds + (bf) * SHM_V + vst1) = S.st_v1; } while (0)
#define SWRITE_H(bf) do { SWRITE_HV(bf); SWRITE_HK(bf); } while (0)
__device__ __forceinline__ void attn_prime(const BlockRef& cur, char* lds, Seam& S) {
    const int tid = ltid(), wid = __builtin_amdgcn_readfirstlane(tid >> 6), lane = tid & 63, r32 = lane & 31, hi = lane >> 5;
    const int sr = tid >> 4, sc = (tid & 15) * 8, kws = KSWZ(sr, sc * 2); char* K_lds = lds + 2 * SHM_V;
    const int kb0 = 0;
    for (int d0 = 0; d0 < 8; ++d0) S.qr[d0] = load8(cur.Q + (size_t)(wid * QBLK + r32) * D + d0 * 16 + hi * 8);
    SLOAD_H(cur.K, cur.V, kb0); VMW(); SWRITE_HK(0);
    __syncthreads();
}
__device__ __forceinline__ void attn_block(const BlockRef& cur, const BlockRef& nxt, char* lds, Seam& S) {
    const int tid = ltid(), wid = __builtin_amdgcn_readfirstlane(tid >> 6), lane = tid & 63, r32 = lane & 31, hi = lane >> 5;
    const int j_lo = 0;
    const int j_hi = (cur.P0 + QB - 1) / KVBLK + 1;
    const int NT = j_hi - j_lo;
    const int kbn = 0;
    const int qlo = cur.P0 + wid * QBLK, qm = qlo + r32 - 4 * hi;
    char* V_lds = lds; char* K_lds = lds + 2 * SHM_V;
    float* ws = (float*)(lds + 2 * SHM_V + 2 * SHM_K) + wid * 64; float* li_l = ws, * al_l = ws + 32;
    const float* bt = (const float*)(lds + BT_OFF) + cur.hm * 256;
    float m_reg = -1e30f, l_reg = 0; f32x16 o[4] = {};
    const int sr = tid >> 4, sc = (tid & 15) * 8, vst0 = v_st(sr, sc), vst1 = v_st(32 + sr, sc), kws = KSWZ(sr, sc * 2);
    const int vb0 = (int)(uintptr_t)V_lds + v_rd_base(lane);
    const bf16* Kh = cur.K; const bf16* Vh = cur.V;
#define RESC(a) do { if (__any((a) < 1.f)) { if (hi == 0) al_l[r32] = (a); asm volatile("s_waitcnt lgkmcnt(0)" ::: "memory");              \
                     for (int d_ = 0; d_ < 4; ++d_) for (int r = 0; r < 16; ++r) o[d_][r] *= al_l[crow(r, hi)]; } } while (0)
#define KBASE(t) ((j_lo + (t)) * KVBLK)
#define MASKT(P0_, P1_, t) do { const int kb_ = KBASE(t); if (kb_ + KVBLK - 1 > qlo - 128) bias_mask_tile(P0_, P1_, qm - kb_, bt); } while (0)
    constexpr int NQL = 8;
#define SEAM_K0() do { VMWN(NQL); SWRITE_HK(0); SBAR(); } while (0)
    f32x16 pA0, pA1, pB0, pB1; float mnA, mnB, alA, alB; bf16x8 pa0, pa1, pa2, pa3;
    SWRITE_HV(0); SBAR();
    if (NT > 1) { SLOAD_H(Kh, Vh, KBASE(1)); }
    SBAR(); qkt<0>(pA0, pA1, K_lds, r32, hi, S.qr);
    MASKT(pA0, pA1, 0); partialSM(pA0, pA1, m_reg, mnA, alA);
    if (NT > 1) { VMW(); SWRITE_H(1); }
    __syncthreads();
#define HALF_STEP(PX0, PX1, mnX, alX, PY0, PY1, alY, t, KB, VB, SB) do {                                                      \
        SBAR(); qkt<KB>(PX0, PX1, K_lds, r32, hi, S.qr);                                             \
        finishSM(PY0, PY1, alY, l_reg, pa0, pa1, pa2, pa3); SBAR();                                                           \
        if ((t) + 1 < NT) { SLOAD_H(Kh, Vh, KBASE((t) + 1)); SBAR(); }                                               \
        pv_tile<VB>(o, vb0, pa0, pa1, pa2, pa3); MASKT(PX0, PX1, (t)); partialSM(PX0, PX1, m_reg, mnX, alX);                                        \
        __syncthreads();                                                                                                      \
        if ((t) + 1 < NT) { VMW(); SWRITE_H(SB); }                                                                          \
        RESC(alX); __syncthreads(); } while (0)
    for (int t = 1; t + 1 < NT; t += 2) {
        HALF_STEP(pB0, pB1, mnB, alB, pA0, pA1, alA, t, 1, 0, 0);
        HALF_STEP(pA0, pA1, mnA, alA, pB0, pB1, alB, t + 1, 0, 1, 1);
    }
    const bool even = (NT & 1) == 0;
    if (even) { SBAR(); qkt<1>(pB0, pB1, K_lds, r32, hi, S.qr); SBAR(); }
    SLOAD_H(nxt.K, nxt.V, kbn); SBAR();
#pragma unroll
    for (int d0 = 0; d0 < 8; ++d0) S.qr[d0] = load8(nxt.Q + (size_t)(wid * QBLK + r32) * D + d0 * 16 + hi * 8);
    SBAR();
    finishSM(pA0, pA1, alA, l_reg, pa0, pa1, pa2, pa3); SBAR();
    pv_tile<0>(o, vb0, pa0, pa1, pa2, pa3);
    if (even) { MASKT(pB0, pB1, NT - 1); partialSM(pB0, pB1, m_reg, mnB, alB); __syncthreads(); RESC(alB);
        finishSM(pB0, pB1, alB, l_reg, pa0, pa1, pa2, pa3); SBAR(); pv_tile<1>(o, vb0, pa0, pa1, pa2, pa3); }
    SBAR(); SEAM_K0();
    if (hi == 0) li_l[r32] = l_reg; asm volatile("s_waitcnt lgkmcnt(0)" ::: "memory");
    float rli[16];
#pragma unroll
    for (int r = 0; r < 16; ++r) rli[r] = __builtin_amdgcn_rcpf(li_l[crow(r, hi)]);
    float* Ow = cur.O + (size_t)(wid * QBLK) * D;
#pragma unroll
    for (int r = 0; r < 16; ++r) { const int orow = crow(r, hi);
#pragma unroll
        for (int d0 = 0; d0 < 4; ++d0) { const float v = o[d0][r] * rli[r]; Ow[(size_t)orow * D + d0 * 32 + r32] = v; } }
    __syncthreads();
#undef RESC
#undef KBASE
#undef MASKT
#undef SEAM_K0
#undef HALF_STEP
}
#undef ROW
#undef VMW
#undef VMWN
#undef SLOAD_H
#undef SWRITE_HK
#undef SWRITE_HV
#undef SWRITE_H
}

namespace att2 {
using att::bf16; using att::D; using att::SHM_K; using att::SHM_V;
constexpr int L_V = 0, L_K = 65536, L_P = 98304, L_AL = 131072, L_FL = 132096, L_LB = 132224, L_BT = 133120;
struct Blk { const bf16* Q; const bf16* K; const bf16* V0; const bf16* V1; float* O0; float* O1; int P0; int hm; };
__device__ __forceinline__ void qkt_rt(f32x16& p0, f32x16& p1, const char* Kb, int r32, int hi, const bf16x8* qr) {
    p0 = f32x16{}; p1 = f32x16{};
    const char* kb[4];
#pragma unroll
    for (int dd = 0; dd < 4; ++dd) kb[dd] = Kb + KSWZ(r32, (dd * 16 + hi * 8) * 2);
#pragma unroll
    for (int d0 = 0; d0 < 8; ++d0) { const char* a = kb[d0 & 3] + (d0 >> 2) * 128;
        bf16x8 b0 = *reinterpret_cast<const bf16x8*>(a);
        bf16x8 b1 = *reinterpret_cast<const bf16x8*>(a + 32 * 256);
        p0 = __builtin_amdgcn_mfma_f32_32x32x16_bf16(b0, qr[d0], p0, 0, 0, 0);
        p1 = __builtin_amdgcn_mfma_f32_32x32x16_bf16(b1, qr[d0], p1, 0, 0, 0); }
}
#define A2_LOADT(t) do { const size_t ro_ = (size_t)((t) * 64 + sr) * D + sc; \
        sk0 = att::load8(c.K + ro_); sk1 = att::load8(c.K + ro_ + 32 * D); sv00 = att::load8(c.V0 + ro_); sv01 = att::load8(c.V0 + ro_ + 32 * D); sv10 = att::load8(c.V1 + ro_); sv11 = att::load8(c.V1 + ro_ + 32 * D); } while (0)
#define A2_WRITET(buf) do { char* kd_ = lds + L_K + (buf) * SHM_K; char* vd_ = lds + L_V + (buf) * 2 * SHM_V; \
        *(bf16x8*)(kd_ + kws) = sk0; *(bf16x8*)(kd_ + kws + 32 * 256) = sk1; *(bf16x8*)(vd_ + vst0) = sv00; *(bf16x8*)(vd_ + vst1) = sv01; *(bf16x8*)(vd_ + SHM_V + vst0) = sv10; *(bf16x8*)(vd_ + SHM_V + vst1) = sv11; } while (0)
__device__ __forceinline__ void attn2_block(const Blk& c, char* lds) {
    const int tid = ltid(), wid = __builtin_amdgcn_readfirstlane(tid >> 6), lane = tid & 63, r32 = lane & 31, hi = lane >> 5;
    const int g = wid & 3;
    const int NT = (c.P0 + 127) / 64 + 1;
    const int sr = tid >> 4, sc = (tid & 15) * 8, kws = KSWZ(sr, sc * 2), vst0 = att::v_st(sr, sc), vst1 = att::v_st(32 + sr, sc);
    bf16x8 sk0, sk1, sv00, sv01, sv10, sv11;
    float* ALb = (float*)(lds + L_AL) + g * 64; unsigned* FLb = (unsigned*)(lds + L_FL) + g * 2; float* LBb = (float*)(lds + L_LB) + g * 32;
    char* Pb = lds + L_P + g * 8192;
    A2_LOADT(0);
    if (wid < 4) {
        bf16x8 qr[8];
#pragma unroll
        for (int d0 = 0; d0 < 8; ++d0) qr[d0] = att::load8(c.Q + (size_t)(g * 32 + r32) * D + d0 * 16 + hi * 8);
        asm volatile("s_waitcnt vmcnt(0)" ::: "memory"); A2_WRITET(0); __syncthreads();
        const int qlo = c.P0 + g * 32, qm = qlo + r32 - 4 * hi;
        const float* bt = (const float*)(lds + L_BT) + c.hm * 256;
        float m_reg = -1e30f, l_reg = 0.f;
        for (int s = 0; s <= NT; ++s) {
            const int par = s & 1;
            if (s + 1 < NT) A2_LOADT(s + 1);
            SBAR();
            if (s < NT) {
                f32x16 p0, p1; float mn, al; bf16x8 pa0, pa1, pa2, pa3;
                qkt_rt(p0, p1, lds + L_K + par * SHM_K, r32, hi, qr);
                const int kb_ = s * 64;
                if (kb_ + 63 > qlo - 128) att::bias_mask_tile(p0, p1, qm - kb_, bt);
                att::partialSM(p0, p1, m_reg, mn, al);
                att::finishSM(p0, p1, al, l_reg, pa0, pa1, pa2, pa3);
                char* pw = Pb + par * 4096 + lane * 16;
                *(bf16x8*)(pw) = pa0; *(bf16x8*)(pw + 1024) = pa1; *(bf16x8*)(pw + 2048) = pa2; *(bf16x8*)(pw + 3072) = pa3;
                if (hi == 0) ALb[par * 32 + r32] = al;
                const bool resc = __any(al < 1.f);
                if (lane == 0) FLb[par] = resc ? 1u : 0u;
            }
            __syncthreads();
            if (s + 1 < NT) { asm volatile("s_waitcnt vmcnt(0)" ::: "memory"); A2_WRITET((s + 1) & 1); }
            __syncthreads();
        }
        if (hi == 0) LBb[r32] = l_reg;
        __syncthreads();
        __syncthreads();
    } else {
        asm volatile("s_waitcnt vmcnt(0)" ::: "memory"); A2_WRITET(0); __syncthreads();
        f32x16 o[8];
#pragma unroll
        for (int d_ = 0; d_ < 8; ++d_) o[d_] = f32x16{};
        const int vbase = (int)(uintptr_t)(lds + L_V) + att::v_rd_base(lane);
        for (int s = 0; s <= NT; ++s) {
            if (s + 1 < NT) A2_LOADT(s + 1);
            SBAR();
            if (s >= 1) {
                const int par = (s - 1) & 1;
                const unsigned fl = (unsigned)__builtin_amdgcn_readfirstlane((int)FLb[par]);
                if (fl) {
#pragma unroll
                    for (int r = 0; r < 16; ++r) { const float a = ALb[par * 32 + att::crow(r, hi)];
#pragma unroll
                        for (int d_ = 0; d_ < 8; ++d_) o[d_][r] *= a; } }
                const char* pr = Pb + par * 4096 + lane * 16;
                const bf16x8 pa0 = *(const bf16x8*)(pr), pa1 = *(const bf16x8*)(pr + 1024), pa2 = *(const bf16x8*)(pr + 2048), pa3 = *(const bf16x8*)(pr + 3072);
                const int vb = vbase + par * 2 * SHM_V;
                att::pv_tile<0>(o, vb, pa0, pa1, pa2, pa3);
                att::pv_tile<0>(o + 4, vb + SHM_V, pa0, pa1, pa2, pa3);
            }
            __syncthreads();
            if (s + 1 < NT) { asm volatile("s_waitcnt vmcnt(0)" ::: "memory"); A2_WRITET((s + 1) & 1); }
            __syncthreads();
        }
        __syncthreads();
        float rli[16];
#pragma unroll
        for (int r = 0; r < 16; ++r) rli[r] = __builtin_amdgcn_rcpf(LBb[att::crow(r, hi)]);
#pragma unroll
        for (int hf = 0; hf < 2; ++hf) { float* Ow = (hf ? c.O1 : c.O0) + (size_t)(g * 32) * D;
#pragma unroll
            for (int r = 0; r < 16; ++r) { const int orow = att::crow(r, hi);
#pragma unroll
                for (int d0 = 0; d0 < 4; ++d0) Ow[(size_t)orow * D + d0 * 32 + r32] = o[hf * 4 + d0][r] * rli[r]; } }
        __syncthreads();
    }
}
#undef A2_LOADT
#undef A2_WRITET
}


#define XB_TMO      128
#define XB_XCNT(j)  (256  + 64 * (j))
#define XB_XSUB(j)  (1280 + 64 * (j))
#define XB_XGEN(j)  (2304 + 64 * (j))
#define XB_TOP      3328
#define XB_TOPGEN   3392
#define XCD_BAR_WORDS 3456
#define XB_SPIN_CAP (1u << 18)
__device__ __forceinline__ unsigned xb_ld(unsigned* p)              { return __hip_atomic_load(p, __ATOMIC_RELAXED, __HIP_MEMORY_SCOPE_AGENT); }
__device__ __forceinline__ unsigned xb_add(unsigned* p, unsigned v) { return __hip_atomic_fetch_add(p, v, __ATOMIC_RELAXED, __HIP_MEMORY_SCOPE_AGENT); }
__device__ __forceinline__ unsigned xb_xcc_id() { return (unsigned)__builtin_amdgcn_s_getreg((3 << 11) | 20) & 0xFu; }
#define XB_SPIN(cond, bar) do { unsigned _sp = 0; while (cond) { __builtin_amdgcn_s_sleep(1); \
    if ((++_sp & 255u) == 0u) { if (xb_ld(&(bar)[XB_TMO])) break; if (_sp > XB_SPIN_CAP) { atomicAdd(&(bar)[XB_TMO], 1u); break; } } } } while (0)
struct XcdBarrier { unsigned* bar; unsigned x; volatile LAS unsigned* st; };
__device__ __forceinline__ XcdBarrier xcd_barrier_post(unsigned* bar, volatile LAS unsigned* st) {
    XcdBarrier b; b.bar = bar; b.x = xb_xcc_id(); b.st = st;
    if (threadIdx.x == 0) (void)xb_add(&bar[XB_XCNT(b.x)], 1u);
    return b;
}
__device__ __forceinline__ void xcd_barrier_complete(unsigned* bar, unsigned x, unsigned& nloc, unsigned& nx) {
    const unsigned G = gridDim.x * gridDim.y * gridDim.z;
    unsigned sum, cnt, mine, sp = 0u;
    for (;;) {
        sum = 0u; cnt = 0u; mine = 0u;
#pragma unroll
        for (unsigned j = 0; j < 16; ++j) { const unsigned c = xb_ld(&bar[XB_XCNT(j)]); sum += c; cnt += (c > 0u) ? 1u : 0u; mine = (j == x) ? c : mine; }
        if (sum == G) break;
        __builtin_amdgcn_s_sleep(1);
        if ((++sp & 255u) == 0u) { if (xb_ld(&bar[XB_TMO])) break; if (sp > XB_SPIN_CAP) { atomicAdd(&bar[XB_TMO], 1u); break; } }
    }
    nloc = mine > 0u ? mine : 1u; nx = cnt > 0u ? cnt : 1u;
}
__device__ __forceinline__ void xcd_barrier(const XcdBarrier& b) {
    asm volatile("s_waitcnt vmcnt(0)" ::: "memory");
    __syncthreads();
    if (threadIdx.x == 0) {
        unsigned* bar = b.bar;
        __builtin_amdgcn_s_waitcnt(0);
        unsigned nloc = b.st[0], nx = b.st[1];
        if (nloc == 0u) { xcd_barrier_complete(bar, b.x, nloc, nx); b.st[0] = nloc; b.st[1] = nx; }
        const unsigned old = xb_add(&bar[XB_XSUB(b.x)], 1u);
        const unsigned gen = old / nloc;
        if (old + 1u == (gen + 1u) * nloc) {
            __builtin_amdgcn_fence(__ATOMIC_RELEASE, "agent");
            asm volatile("s_waitcnt vmcnt(0)" ::: "memory");
            const unsigned og = xb_add(&bar[XB_TOP], 1u);
            const unsigned tg = og / nx;
            if (og + 1u == (tg + 1u) * nx) xb_add(&bar[XB_TOPGEN], 1u);
            else XB_SPIN(xb_ld(&bar[XB_TOPGEN]) == tg, bar);
            __builtin_amdgcn_fence(__ATOMIC_ACQUIRE, "agent");
            xb_add(&bar[XB_XGEN(b.x)], 1u);
            asm volatile("s_waitcnt vmcnt(0)" ::: "memory");
        } else {
            XB_SPIN(xb_ld(&bar[XB_XGEN(b.x)]) == gen, bar);
            __builtin_amdgcn_fence(__ATOMIC_ACQUIRE, "agent");
            asm volatile("s_waitcnt vmcnt(0)" ::: "memory");
        }
    }
    __syncthreads();
}

struct Args { const float* in[24]; float* out; unsigned char* ws; };

__device__ __forceinline__ void p0_transpose_item(const float* W, int K, int N, bf16_t* WT, int swiglu, const float* gk, const float* bk, float* c1, float* c2, LAS float* scr, int item, int lane) {
    const int nblk = N / 64, kb = item / nblk, nb = item % nblk, k0 = 64 * kb, n0 = 64 * nb;
    const float* src = W + (size_t)(k0 + (lane >> 4)) * N + n0 + (lane & 15) * 4;
    f32x4 v[16];
#pragma unroll
    for (int i = 0; i < 16; ++i) v[i] = __builtin_nontemporal_load((const f32x4*)(src + (size_t)(4 * i) * N));
#pragma unroll
    for (int i = 0; i < 16; ++i) { LAS float* d = scr + (4 * i + (lane >> 4)) * 65 + (lane & 15) * 4; d[0] = v[i][0]; d[1] = v[i][1]; d[2] = v[i][2]; d[3] = v[i][3]; }
    asm volatile("s_waitcnt lgkmcnt(0)" ::: "memory");
    int r0 = n0;
    if (swiglu) { const int half = n0 / DFF, idx = n0 % DFF; r0 = 256 * (idx / 128) + 128 * half + (idx % 128); }
    const int c = lane & 7;
    float g8[8], b8[8];
#pragma unroll
    for (int e = 0; e < 8; ++e) { g8[e] = gk ? gk[k0 + 8 * c + e] : 1.f; b8[e] = gk ? bk[k0 + 8 * c + e] : 0.f; }
#pragma unroll
    for (int j = 0; j < 8; ++j) { const int n = (lane >> 3) + 8 * j; const LAS float* q = scr + (8 * c) * 65 + n;
        float w8[8];
#pragma unroll
        for (int e = 0; e < 8; ++e) w8[e] = q[e * 65];
        u32x4 o; o.x = cvt_pk_bf16(w8[0] * g8[0], w8[1] * g8[1]); o.y = cvt_pk_bf16(w8[2] * g8[2], w8[3] * g8[3]); o.z = cvt_pk_bf16(w8[4] * g8[4], w8[5] * g8[5]); o.w = cvt_pk_bf16(w8[6] * g8[6], w8[7] * g8[7]);
        *(u32x4*)(WT + (size_t)(r0 + n) * K + k0 + 8 * c) = o;
        if (gk) {
            float s1 = ((bf_lo(o.x) + bf_hi(o.x)) + (bf_lo(o.y) + bf_hi(o.y))) + ((bf_lo(o.z) + bf_hi(o.z)) + (bf_lo(o.w) + bf_hi(o.w)));
            float s2 = ((w8[0] * b8[0] + w8[1] * b8[1]) + (w8[2] * b8[2] + w8[3] * b8[3])) + ((w8[4] * b8[4] + w8[5] * b8[5]) + (w8[6] * b8[6] + w8[7] * b8[7]));
            s1 += __shfl_xor(s1, 1); s1 += __shfl_xor(s1, 2); s1 += __shfl_xor(s1, 4); s2 += __shfl_xor(s2, 1); s2 += __shfl_xor(s2, 2); s2 += __shfl_xor(s2, 4);
            if (c == 0) { unsafeAtomicAdd(c1 + r0 + n, s1); unsafeAtomicAdd(c2 + r0 + n, s2); }
        } }
    asm volatile("s_waitcnt lgkmcnt(0)" ::: "memory");
}

__device__ __forceinline__ void p0_wq_item(const float* W, bf16_t* WN, const float* gk, const float* bk, float* bW, int item, int lane) {
    const int kb = item >> 5, jb = item & 31, k0 = 64 * kb, j0 = 64 * jb, cg8 = lane & 7, kr = lane >> 3;
    float sacc[8];
#pragma unroll
    for (int e = 0; e < 8; ++e) sacc[e] = 0.f;
#pragma unroll
    for (int i = 0; i < 8; ++i) { const int k = k0 + 8 * i + kr; const float* src = W + (size_t)k * DM + j0 + 8 * cg8;
        const f32x4 v0 = __builtin_nontemporal_load((const f32x4*)src), v1 = __builtin_nontemporal_load((const f32x4*)(src + 4)); const float g = gk[k], bb = bk[k];
        u32x4 o; o.x = cvt_pk_bf16(v0[0] * g, v0[1] * g); o.y = cvt_pk_bf16(v0[2] * g, v0[3] * g); o.z = cvt_pk_bf16(v1[0] * g, v1[1] * g); o.w = cvt_pk_bf16(v1[2] * g, v1[3] * g);
        *(u32x4*)(WN + (size_t)k * DM + j0 + 8 * cg8) = o;
#pragma unroll
        for (int e = 0; e < 4; ++e) { sacc[e] += bb * v0[e]; sacc[4 + e] += bb * v1[e]; } }
#pragma unroll
    for (int e = 0; e < 8; ++e) { float v = sacc[e]; v += __shfl_xor(v, 8); v += __shfl_xor(v, 16); v += __shfl_xor(v, 32); if (kr == 0) unsafeAtomicAdd(bW + j0 + 8 * cg8 + e, v); }
}

__device__ __forceinline__ int causal_bucket(int n) {
    if (n < 16) return n;
    const float nf = (float)n;
    int large = 16 + (int)(logf(nf / 16.f) / 2.0794415416798357f * 16.f);
    return large < 31 ? large : 31;
}

__device__ __forceinline__ size_t zero_opaque() { size_t z = 0; asm volatile("" : "+s"(z)); return z; }
__device__ __forceinline__ const float* inp_ptr(const Args& a, int k) { return a.in[k] + zero_opaque(); }
#define INP(k) inp_ptr(a, k)
__device__ __forceinline__ unsigned char* ws_opaque(const Args& a) { return a.ws + zero_opaque(); }
__device__ __forceinline__ float* out_opaque(const Args& a) { return a.out + zero_opaque(); }
#define WSP(type, off) ((type*)(ws_opaque(a) + (off)))
__global__ void __launch_bounds__(NTHR, 2) mega_fwd(Args a) {
    extern __shared__ __attribute__((aligned(16))) unsigned char lds[];
    volatile LAS unsigned* bst = (volatile LAS unsigned*)((LAS unsigned char*)lds + LDS_BYTES - 64);
    if (threadIdx.x == 0) { bst[0] = 0u; bst[1] = 0u; }
    __syncthreads();
    (void)xcd_barrier_post((unsigned*)(a.ws + WS_BAR), bst);
#define GRID_BAR() do { XcdBarrier xb_; xb_.bar = (unsigned*)(ws_opaque(a) + WS_BAR); unsigned x_ = xb_xcc_id(); asm volatile("" : "+s"(x_)); xb_.x = x_; xb_.st = bst; xcd_barrier(xb_); } while (0)
    const int G = gridDim.x;
    const int NGW = G * NWAVES, NGT = G * NTHR;
    {
        PH_IDS;
        unsigned char* ws = ws_opaque(a);
        float* lamp = (float*)(ws + WS_LAM); float* btab = (float*)(ws + WS_BTAB); bf16_t* wtril = (bf16_t*)(ws + WS_WTRIL); bf16_t* membf = (bf16_t*)(ws + WS_MEMBF); bf16_t* XN = (bf16_t*)(ws + WS_XN);
        LAS float* scr = (LAS float*)((LAS unsigned char*)lds + wave * 17408);
        constexpr int I_IN = 32 * 88, I_SQ = 32 * 32, I_KV = 32 * 64, I_GU = 32 * 176, I_D = 88 * 32;
        constexpr int PER_LAYER = I_IN + 3 * I_SQ + I_KV + I_GU + I_D;
        for (int it = gw; it < 2 * PER_LAYER; it += NGW) {
            const int l = it / PER_LAYER; int r = it % PER_LAYER;
            unsigned char* wl = ws + WS_W + (size_t)l * W_LAYER;
            float* cl = (float*)(ws + WS_C) + (size_t)l * C_LAYER;
            if (r < I_IN) { const bool f = l > 0;
                p0_transpose_item(INP(3) + (size_t)l * DM * INC, DM, INC, (bf16_t*)(wl + W_IN), 0, f ? INP(22) : nullptr, f ? INP(23) : nullptr, cl + C_IN, cl + C_IN + INC, scr, r, lane); continue; } r -= I_IN;
            if (r < I_SQ) { p0_transpose_item(INP(12) + (size_t)l * DM * DM, DM, DM, (bf16_t*)(wl + W_OUT), 0, nullptr, nullptr, nullptr, nullptr, scr, r, lane); continue; } r -= I_SQ;
            if (r < I_SQ) { p0_wq_item(INP(15) + (size_t)l * DM * DM, (bf16_t*)(wl + W_Q), INP(13) + (size_t)l * DM, INP(14) + (size_t)l * DM, cl + C_Q + DM, r, lane); continue; } r -= I_SQ;
            if (r < I_KV) { p0_transpose_item(INP(16) + (size_t)l * DM * 2 * DM, DM, 2 * DM, (bf16_t*)(wl + W_KV), 0, nullptr, nullptr, nullptr, nullptr, scr, r, lane); continue; } r -= I_KV;
            if (r < I_SQ) { p0_transpose_item(INP(17) + (size_t)l * DM * DM, DM, DM, (bf16_t*)(wl + W_O), 0, nullptr, nullptr, nullptr, nullptr, scr, r, lane); continue; } r -= I_SQ;
            if (r < I_GU) { p0_transpose_item(INP(20) + (size_t)l * DM * 2 * DFF, DM, 2 * DFF, (bf16_t*)(wl + W_GU), 1, INP(18) + (size_t)l * DM, INP(19) + (size_t)l * DM, cl + C_GU, cl + C_GU + 2 * DFF, scr, r, lane); continue; } r -= I_GU;
            p0_transpose_item(INP(21) + (size_t)l * DFF * DM, DFF, DM, (bf16_t*)(wl + W_D), 0, nullptr, nullptr, nullptr, nullptr, scr, r, lane);
        }
        for (size_t i = gt; i < (size_t)T * DM / 8; i += NGT) {
            const f32x4 v0 = *(const f32x4*)(INP(0) + i * 8), v1 = *(const f32x4*)(INP(0) + i * 8 + 4);
            u32x4 w; w.x = cvt_pk_bf16(v0[0], v0[1]); w.y = cvt_pk_bf16(v0[2], v0[3]); w.z = cvt_pk_bf16(v1[0], v1[1]); w.w = cvt_pk_bf16(v1[2], v1[3]);
            *(u32x4*)(XN + i * 8) = w;
        }
        for (size_t i = gt; i < (size_t)BATCH * NMEM * DM / 8; i += NGT) {
            const f32x4 v0 = *(const f32x4*)(INP(1) + i * 8), v1 = *(const f32x4*)(INP(1) + i * 8 + 4);
            u32x4 w; w.x = cvt_pk_bf16(v0[0], v0[1]); w.y = cvt_pk_bf16(v0[2], v0[3]); w.z = cvt_pk_bf16(v1[0], v1[1]); w.w = cvt_pk_bf16(v1[2], v1[3]);
            *(u32x4*)(membf + i * 8) = w;
        }
        for (int i = gt; i < DEPTH * 4 * 128 * 128; i += NGT) { const int s = i & 127, t = (i >> 7) & 127; wtril[i] = s <= t ? f2bf(INP(7)[i]) : (bf16_t)0; }
        if (gt < 8 * 256) { const int hm = gt >> 8, d = gt & 255; const float* rb = INP(2);
            btab[gt] = (rb[causal_bucket(d) * 8 + hm] - rb[31 * 8 + hm]) * (1.f / att::SCALE); }
        if (cu == 0 && wave == 0) {
            for (int l = 0; l < DEPTH; ++l) {
                const float* lq = INP(9) + l * 256; const float* lk = INP(10) + l * 256;
                float s0 = lq[lane] * lk[lane] + lq[lane + 64] * lk[lane + 64];
                float s1 = lq[128 + lane] * lk[128 + lane] + lq[192 + lane] * lk[192 + lane];
                s0 = wave_sum(s0); s1 = wave_sum(s1);
                const float lam_init = 0.8f - 0.6f * expf(-0.3f * (float)l);
                if (lane == 0) lamp[l] = expf(s0) - expf(s1) + lam_init;
            }
        }
    }
    GRID_BAR();

#pragma unroll 1
    for (int l = 0; l < DEPTH; ++l) {
        {
            unsigned char* ws = ws_opaque(a);
            pg8::Gemm g{(const bf16_t*)(ws + WS_XN), (const bf16_t*)(ws + WS_W + (size_t)l * W_LAYER + W_IN), DM, DM, DM, 1, 0, 0, 0, 0};
            pg8::Order S; S.init(T, INC, 1, G, cu_opaque());
            const float* cl = (const float*)(ws + WS_C) + (size_t)l * C_LAYER;
            const float* st = l > 0 ? (const float*)(ws + WS_ST) + (size_t)(3 * l - 1) * T * 2 : nullptr;
            pg8::EpiSplit E{(bf16_t*)(ws + WS_PROJ), st, cl + C_IN, cl + C_IN + INC, (float*)(ws + WS_ST) + (size_t)(6 + l) * T * 2};
            pg8::gemm_phase<pg8::EpiSplit, true>((LAS unsigned char*)lds, g, S, E);
        }
        if (l == 0) {
            {
                unsigned char* ws = ws_opaque(a);
                pg8::Gemm g{(const bf16_t*)(ws + WS_MEMBF), (const bf16_t*)(ws + WS_W + W_KV), DM, DM, DM, 1, 0, 0, (long)(W_LAYER / 2), 0};
                pg8::Order S; const int cu = cu_opaque(); S.init(BATCH * NMEM, 2 * DM, 2, G, cu >= 128 && cu < 192 ? cu - 128 : -1);
                pg8::EpiBf16 E{(bf16_t*)(ws + WS_KV), 2 * DM, 1, (long)(BATCH * NMEM) * 2 * DM, 0, 1.f, nullptr, nullptr, nullptr, nullptr};
                pg8::gemm_phase<pg8::EpiBf16, true>((LAS unsigned char*)lds, g, S, E);
            }
        }
        GRID_BAR();

        if (l == 0) {
#pragma unroll 1
            for (int L2 = 0; L2 < DEPTH; ++L2) {
                {
                    unsigned char* ws = ws_opaque(a); unsigned char* wl2 = ws + WS_W + (size_t)L2 * W_LAYER;
                    const bf16_t* KVl = (const bf16_t*)(ws + WS_KV) + (size_t)L2 * BATCH * NMEM * 2 * DM;
                    float* cl = (float*)(ws + WS_C) + (size_t)L2 * C_LAYER;
                    pg8::Gemm g{KVl, (const bf16_t*)(wl2 + W_Q), 2 * DM, DM, 512, 4, (long)NMEM * 2 * DM, 512, 0, 512};
                    pg8::Order S; const int cu = cu_opaque(); S.init(NMEM, DM, 8, G, cu >= 64 * L2 && cu < 64 * L2 + 64 ? cu - 64 * L2 : -1);
                    pg8::EpiBf16 E{(bf16_t*)(wl2 + W_KV), DM, 1, (long)NMEM * DM, 0, 1.f, nullptr, nullptr, nullptr, cl + C_Q};
                    pg8::gemm_phase<pg8::EpiBf16, true>((LAS unsigned char*)lds, g, S, E);
                }
                {
                    unsigned char* ws = ws_opaque(a); unsigned char* wl2 = ws + WS_W + (size_t)L2 * W_LAYER;
                    const bf16_t* KVl = (const bf16_t*)(ws + WS_KV) + (size_t)L2 * BATCH * NMEM * 2 * DM;
                    pg8::Gemm g{(const bf16_t*)(wl2 + W_O), KVl + DM, DM, 2 * DM, 512, 4, 0, 512, (long)NMEM * 2 * DM, 512};
                    pg8::Order S; const int cu = cu_opaque(); S.init(DM, NMEM, 8, G, cu >= 128 + 64 * L2 && cu < 192 + 64 * L2 ? cu - 128 - 64 * L2 : -1);
                    pg8::EpiBf16 E{(bf16_t*)(wl2 + W_KV + 8 * MiB), 1024, 4, (long)DM * 1024, 256, 1.f, nullptr, nullptr, nullptr, nullptr};
                    pg8::gemm_phase<pg8::EpiBf16, true>((LAS unsigned char*)lds, g, S, E);
                }
            }
            {
                PH_IDS;
                unsigned char* ws = ws_opaque(a);
                for (int it = gw; it < DEPTH * 2048; it += NGW) {
                    const int L2 = it >> 11, r = it & 2047, b = r >> 10, h = (r >> 8) & 3, n = r & 255;
                    const bf16_t* kp = (const bf16_t*)(ws + WS_KV) + ((size_t)L2 * BATCH * NMEM + b * NMEM + n) * 2 * DM + h * 512 + 8 * lane;
                    float* cl = (float*)(ws + WS_C) + (size_t)L2 * C_LAYER;
                    const float* bw = cl + C_Q + DM + h * 512 + 8 * lane;
                    const u32x4 kw = *(const u32x4*)kp; const f32x4 b0 = *(const f32x4*)bw, b1 = *(const f32x4*)(bw + 4);
                    float d = (bf_lo(kw.x) * b0[0] + bf_hi(kw.x) * b0[1]) + (bf_lo(kw.y) * b0[2] + bf_hi(kw.y) * b0[3]) + (bf_lo(kw.z) * b1[0] + bf_hi(kw.z) * b1[1]) + (bf_lo(kw.w) * b1[2] + bf_hi(kw.w) * b1[3]);
                    d = wave_sum(d);
                    if (lane == 0) cl[C_QK2 + r] = d;
                }
            }
            __syncthreads();
        }
        {
            PH_IDS;
            bf16_t* PB = WSP(bf16_t, WS_PROJ); bf16_t* Y = WSP(bf16_t, WS_Y);
            const float* cw = INP(4) + (size_t)l * 3 * 512;
            const int cg8 = tid & 63, c0 = cg8 * 8, gi = cg8 >> 4, cc = c0 & 127;
            float k0[8], k1[8], k2[8];
#pragma unroll
            for (int e = 0; e < 8; ++e) { k0[e] = cw[c0 + e]; k1[e] = cw[512 + c0 + e]; k2[e] = cw[1024 + c0 + e]; }
            for (int r = gt >> 6; r < T; r += NGT >> 6) {
                const int t = r & (SEQ - 1);
                const bf16_t* pb = PB + ((size_t)(0 + gi) * T + r) * 128 + cc;
                const bf16_t* pc = PB + ((size_t)(4 + gi) * T + r) * 128 + cc;
                const bf16_t* ph = PB + ((size_t)(8 + gi) * T + r) * 128 + cc;
                const u32x4 wb = *(const u32x4*)pb, wc0 = *(const u32x4*)pc, wh0 = *(const u32x4*)ph;
                u32x4 wc1 = {0, 0, 0, 0}, wh1 = {0, 0, 0, 0}, wc2 = {0, 0, 0, 0}, wh2 = {0, 0, 0, 0};
                if (t >= 1) { wc1 = *(const u32x4*)(pc - 128); wh1 = *(const u32x4*)(ph - 128); }
                if (t >= 2) { wc2 = *(const u32x4*)(pc - 256); wh2 = *(const u32x4*)(ph - 256); }
                float y[8];
#pragma unroll
                for (int j = 0; j < 4; ++j) {
                    const float z0a = bf_lo(wc0[j]) * bf_lo(wh0[j]), z1a = bf_lo(wc1[j]) * bf_lo(wh1[j]), z2a = bf_lo(wc2[j]) * bf_lo(wh2[j]);
                    const float z0b = bf_hi(wc0[j]) * bf_hi(wh0[j]), z1b = bf_hi(wc1[j]) * bf_hi(wh1[j]), z2b = bf_hi(wc2[j]) * bf_hi(wh2[j]);
                    y[2 * j] = bf_lo(wb[j]) * (k0[2 * j] * z2a + k1[2 * j] * z1a + k2[2 * j] * z0a);
                    y[2 * j + 1] = bf_hi(wb[j]) * (k0[2 * j + 1] * z2b + k1[2 * j + 1] * z1b + k2[2 * j + 1] * z0b);
                }
                u32x4 w; w.x = cvt_pk_bf16(y[0], y[1]); w.y = cvt_pk_bf16(y[2], y[3]); w.z = cvt_pk_bf16(y[4], y[5]); w.w = cvt_pk_bf16(y[6], y[7]);
                *(u32x4*)(Y + (size_t)r * DM + c0) = w;
            }
        }
        {
            PH_IDS;
            bf16_t* PB = WSP(bf16_t, WS_PROJ); bf16_t* Y = WSP(bf16_t, WS_Y); bf16_t* wtril = WSP(bf16_t, WS_WTRIL);
            float* st = (float*)(lds + 40960);
            bf16_t* vT = (bf16_t*)lds;
            const float* lng = INP(5) + (size_t)l * 512; const float* lnb = INP(6) + (size_t)l * 512;
            const float* bs = INP(8) + (size_t)l * 512;
            const float* gstat = WSP(float, WS_ST) + (size_t)(6 + l) * T * 2;
            float* svL = (float*)(lds + 49152);
            for (int un = cu; un < (T / 128) * 4; un += G) {
                const int ch = un >> 2, gi = un & 3, r0 = ch * 128;
                if (tid < 128) {
                    const float s1 = gstat[2 * (r0 + tid)], s2 = gstat[2 * (r0 + tid) + 1];
                    const float mean = s1 * (1.f / 512.f), var = fmaxf(s2 * (1.f / 512.f) - mean * mean, 0.f);
                    st[2 * tid] = mean; st[2 * tid + 1] = rsqrtf(var + LN_EPS); }
                __syncthreads();
                {
                    const int tok = tid >> 2, cq = (tid & 3) * 32; const float mean = st[2 * tok], rstd = st[2 * tok + 1];
                    const bf16_t* vp = PB + ((size_t)(16 + gi) * T + r0 + tok) * 128 + cq;
#pragma unroll
                    for (int i = 0; i < 4; ++i) { const u32x4 w = *(const u32x4*)(vp + 8 * i);
#pragma unroll
                        for (int j = 0; j < 4; ++j) { const int c = cq + 8 * i + 2 * j;
                            const float x0 = gelu_tanh(bf_lo(w[j])), x1 = gelu_tanh(bf_hi(w[j]));
                            vT[c * 136 + tok] = f2bf((x0 - mean) * rstd * lng[gi * 128 + c] + lnb[gi * 128 + c]);
                            vT[(c + 1) * 136 + tok] = f2bf((x1 - mean) * rstd * lng[gi * 128 + c + 1] + lnb[gi * 128 + c + 1]); } }
                }
                __syncthreads();
                {
                    f32x4 acc[8];
#pragma unroll
                    for (int ct = 0; ct < 8; ++ct) acc[ct] = (f32x4){0.f, 0.f, 0.f, 0.f};
                    const bf16_t* wrow = wtril + ((size_t)(l * 4 + gi) * 128 + 16 * wave + (lane & 15)) * 128 + 8 * (lane >> 4);
#pragma unroll
                    for (int kk = 0; kk < 4; ++kk) { const bf16x8 av = *(const bf16x8*)(wrow + kk * 32);
#pragma unroll
                        for (int ct = 0; ct < 8; ++ct) { const bf16x8 bv = *(const bf16x8*)(vT + (ct * 16 + (lane & 15)) * 136 + kk * 32 + 8 * (lane >> 4));
                            acc[ct] = __builtin_amdgcn_mfma_f32_16x16x32_bf16(av, bv, acc[ct], 0, 0, 0); } }
#pragma unroll
                    for (int j = 0; j < 4; ++j) { const int t = 16 * wave + 4 * (lane >> 4) + j; const float bt = bs[gi * 128 + t];
#pragma unroll
                        for (int ct = 0; ct < 8; ++ct) svL[t * 132 + ct * 16 + (lane & 15)] = acc[ct][j] + bt; }
                }
                __syncthreads();
                {
                    const int c0 = (tid & 15) * 8;
#pragma unroll
                    for (int i = 0; i < 4; ++i) { const int t = 32 * i + (tid >> 4);
                        const u32x4 uw = *(const u32x4*)(PB + ((size_t)(12 + gi) * T + r0 + t) * 128 + c0);
                        const f32x4 s0 = *(const f32x4*)(svL + t * 132 + c0), s1 = *(const f32x4*)(svL + t * 132 + c0 + 4);
                        u32x4 w; w.x = cvt_pk_bf16(gelu_tanh(bf_lo(uw.x)) * s0[0], gelu_tanh(bf_hi(uw.x)) * s0[1]); w.y = cvt_pk_bf16(gelu_tanh(bf_lo(uw.y)) * s0[2], gelu_tanh(bf_hi(uw.y)) * s0[3]);
                        w.z = cvt_pk_bf16(gelu_tanh(bf_lo(uw.z)) * s1[0], gelu_tanh(bf_hi(uw.z)) * s1[1]); w.w = cvt_pk_bf16(gelu_tanh(bf_lo(uw.w)) * s1[2], gelu_tanh(bf_hi(uw.w)) * s1[3]);
                        *(u32x4*)(Y + (size_t)(r0 + t) * DM + 512 + gi * 128 + c0) = w; }
                }
                __syncthreads();
            }
        }
        {
            PH_IDS;
            bf16_t* PB = WSP(bf16_t, WS_PROJ); float* OATT = WSP(float, WS_R1); float* btab = WSP(float, WS_BTAB);
            float* btl = (float*)(lds + att2::L_BT);
            for (int i = tid; i < 8 * 256; i += NTHR) btl[i] = btab[i];
            __syncthreads();
            const att::bf16* PBb = (const att::bf16*)PB;
#pragma unroll 1
            for (int L = cu; L < 512; L += G) {
                const int k_ = L >> 3, hm = L & 7, b = k_ >> 5, x = k_ & 31, h = hm >> 1;
#pragma unroll 1
                for (int pass = 0; pass < 2; ++pass) {
                    const int qb = pass ? 63 - x : x;
                    att2::Blk c;
                    c.Q = PBb + ((size_t)(20 + hm) * T + (size_t)b * SEQ + qb * 128) * 128; c.K = PBb + ((size_t)(28 + hm) * T + (size_t)b * SEQ) * 128;
                    c.V0 = PBb + ((size_t)(36 + h * 2) * T + (size_t)b * SEQ) * 128; c.V1 = PBb + ((size_t)(37 + h * 2) * T + (size_t)b * SEQ) * 128;
                    c.O0 = OATT + ((size_t)((b * 8 + hm) * 2 + 0) * SEQ + qb * 128) * 128; c.O1 = OATT + ((size_t)((b * 8 + hm) * 2 + 1) * SEQ + qb * 128) * 128;
                    c.P0 = qb * 128; c.hm = hm;
                    att2::attn2_block(c, (char*)lds);
                }
            }
        }
        GRID_BAR();

        {
            PH_IDS;
            float* OATT = WSP(float, WS_R1); bf16_t* Y = WSP(bf16_t, WS_Y); float* lamp = WSP(float, WS_LAM);
            const float lam_init = 0.8f - 0.6f * expf(-0.3f * (float)l);
            const float lam = lamp[l]; const float* sg = INP(11) + (size_t)l * 256;
            const f32x4 gv = *(const f32x4*)(sg + 4 * lane);
            for (int it = gw; it < T * 4; it += NGW) {
                const int r = it >> 2, h = it & 3, b = r >> 13, t = r & (SEQ - 1);
                const int half = lane >> 5, e = (lane & 31) * 4;
                const size_t i0 = ((size_t)(((b * 4 + h) * 2 + 0) * 2 + half) * SEQ + t) * 128 + e;
                const size_t i1 = ((size_t)(((b * 4 + h) * 2 + 1) * 2 + half) * SEQ + t) * 128 + e;
                const f32x4 o0 = *(const f32x4*)(OATT + i0), o1 = *(const f32x4*)(OATT + i1);
                const f32x4 d = o0 - o1 * lam;
                const float ss = wave_sum(d[0] * d[0] + d[1] * d[1] + d[2] * d[2] + d[3] * d[3]);
                const float sc = rsqrtf(ss * (1.f / 256.f) + LN_EPS) * (1.f - lam_init);
                u32x2 w; w.x = cvt_pk_bf16(d[0] * sc * gv[0], d[1] * sc * gv[1]); w.y = cvt_pk_bf16(d[2] * sc * gv[2], d[3] * sc * gv[3]);
                *(u32x2*)(Y + (size_t)r * DM + 1024 + h * 256 + 4 * lane) = w;
            }
        }
        GRID_BAR();

#define LN_PASS(gam, bet, write_xn) do { PH_IDS; float* X = out_opaque(a); bf16_t* XN = WSP(bf16_t, WS_XN); \
            for (int r = gw; r < T; r += NGW) { float* xr = X + (size_t)r * DM; f32x4 v[8]; float s = 0.f; \
                _Pragma("unroll") for (int j = 0; j < 8; ++j) { v[j] = *(const f32x4*)(xr + 4 * lane + 256 * j); s += (v[j][0] + v[j][1]) + (v[j][2] + v[j][3]); } \
                const float mean = wave_sum(s) * (1.f / DM); float s2 = 0.f; \
                _Pragma("unroll") for (int j = 0; j < 8; ++j) { v[j] = v[j] - mean; s2 += (v[j][0] * v[j][0] + v[j][1] * v[j][1]) + (v[j][2] * v[j][2] + v[j][3] * v[j][3]); } \
                const float rstd = rsqrtf(wave_sum(s2) * (1.f / DM) + LN_EPS); \
                _Pragma("unroll") for (int j = 0; j < 8; ++j) { const f32x4 gg = *(const f32x4*)((gam) + 4 * lane + 256 * j), bb = *(const f32x4*)((bet) + 4 * lane + 256 * j); \
                    const f32x4 o = v[j] * rstd * gg + bb; *(f32x4*)(xr + 4 * lane + 256 * j) = o; \
                    if (write_xn) { u32x2 w; w.x = cvt_pk_bf16(o[0], o[1]); w.y = cvt_pk_bf16(o[2], o[3]); *(u32x2*)(XN + (size_t)r * DM + 4 * lane + 256 * j) = w; } } } } while (0)

        {
            unsigned char* ws = ws_opaque(a); float* X = out_opaque(a); float* ST = (float*)(ws + WS_ST);
            pg8::Gemm g{(const bf16_t*)(ws + WS_Y), (const bf16_t*)(ws + WS_W + (size_t)l * W_LAYER + W_OUT), DM, DM, DM, 1, 0, 0, 0, 0};
            pg8::Order S; S.init(T, DM, 1, G, cu_opaque());
            pg8::EpiRes E{nullptr, l == 0 ? INP(0) : nullptr, ST + (size_t)(l > 0 ? 3 * l - 1 : 0) * T * 2, INP(22) + (size_t)(l > 0 ? l - 1 : 0) * DM, INP(23) + (size_t)(l > 0 ? l - 1 : 0) * DM,
                          (bf16_t*)(ws + WS_XN), ST + (size_t)(3 * l) * T * 2, ALPHA, 0};
            pg8::gemm_phase<pg8::EpiRes, true>((LAS unsigned char*)lds, g, S, E);
        }
        GRID_BAR();

        {
            unsigned char* ws = ws_opaque(a);
            const float* cl = (const float*)(ws + WS_C) + (size_t)l * C_LAYER;
            pg8::Gemm g{(const bf16_t*)(ws + WS_XN), (const bf16_t*)(ws + WS_W + (size_t)l * W_LAYER + W_KV), DM, DM, DM, 4, (long)SEQ * DM, 0, (long)4 * NMEM * DM, (long)NMEM * DM};
            pg8::Order S; S.init(SEQ, NMEM, 8, G, cu_opaque());
            pg8::EpiSoftmax E{(bf16_t*)(ws + WS_PROJ + 64 * MiB), (const float*)(ws + WS_ST) + (size_t)(3 * l) * T * 2, cl + C_Q, cl + C_QK2, 0.044194173824159216f};
            pg8::gemm_phase<pg8::EpiSoftmax, true>((LAS unsigned char*)lds, g, S, E);
        }
        GRID_BAR();
        {
            unsigned char* ws = ws_opaque(a); float* ST = (float*)(ws + WS_ST);
            pg8::Gemm g{(const bf16_t*)(ws + WS_PROJ + 64 * MiB), (const bf16_t*)(ws + WS_W + (size_t)l * W_LAYER + W_KV + 8 * MiB), 1024, 1024, 1024, 1, (long)SEQ * 1024, 0, (long)DM * 1024, 0};
            pg8::Order S; S.init(SEQ, DM, 2, G, cu_opaque());
            pg8::EpiRes E{nullptr, nullptr, ST + (size_t)(3 * l) * T * 2, INP(13) + (size_t)l * DM, INP(14) + (size_t)l * DM, (bf16_t*)(ws + WS_XN), ST + (size_t)(3 * l + 1) * T * 2, ALPHA, SEQ};
            pg8::gemm_phase<pg8::EpiRes, true>((LAS unsigned char*)lds, g, S, E);
        }
        GRID_BAR();
        {
            unsigned char* ws = ws_opaque(a);
            const float* cl = (const float*)(ws + WS_C) + (size_t)l * C_LAYER;
            pg8::Gemm g{(const bf16_t*)(ws + WS_XN), (const bf16_t*)(ws + WS_W + (size_t)l * W_LAYER + W_GU), DM, DM, DM, 1, 0, 0, 0, 0};
            pg8::Order S; S.init(T, 2 * DFF, 1, G, cu_opaque());
            pg8::EpiSwiglu E{(bf16_t*)(ws + WS_PROJ), (const float*)(ws + WS_ST) + (size_t)(3 * l + 1) * T * 2, cl + C_GU, cl + C_GU + 2 * DFF};
            pg8::gemm_phase<pg8::EpiSwiglu, true>((LAS unsigned char*)lds, g, S, E);
        }
        GRID_BAR();
        {
            unsigned char* ws = ws_opaque(a); float* X = out_opaque(a); float* ST = (float*)(ws + WS_ST);
            pg8::Gemm g{(const bf16_t*)(ws + WS_PROJ), (const bf16_t*)(ws + WS_W + (size_t)l * W_LAYER + W_D), DFF, DFF, DFF, 1, 0, 0, 0, 0};
            pg8::Order S; S.init(T, DM, 1, G, cu_opaque());
            pg8::EpiRes E{l + 1 == DEPTH ? X : nullptr, nullptr, ST + (size_t)(3 * l + 1) * T * 2, INP(18) + (size_t)l * DM, INP(19) + (size_t)l * DM, (bf16_t*)(ws + WS_XN), ST + (size_t)(3 * l + 2) * T * 2, ALPHA, 0};
            pg8::gemm_phase<pg8::EpiRes, true>((LAS unsigned char*)lds, g, S, E);
        }
        GRID_BAR();
        if (l + 1 == DEPTH) { LN_PASS(INP(22) + (size_t)l * DM, INP(23) + (size_t)l * DM, false); }
#undef LN_PASS
    }
    if (a.ws == nullptr) cg::this_grid().sync();
}

extern "C" void kernel_launch(void* const* d_in, const int* in_sizes, int n_in, void* d_out, int out_size, void* d_ws, size_t ws_size, hipStream_t stream) {
    static int grid = 0;
    if (grid == 0) {
        if (n_in != 24 || in_sizes[0] != T * DM || out_size != T * DM || ws_size < WS_END) {
            fprintf(stderr, "kernel_launch: unexpected shapes (n_in %d, in0 %d, out %d, ws %zu); nothing launched\n", n_in, n_in > 0 ? in_sizes[0] : -1, out_size, ws_size); grid = -1; return; }
        int dev = 0, cus = 0, per_cu = 0;
        (void)hipGetDevice(&dev);
        if (hipDeviceGetAttribute(&cus, hipDeviceAttributeMultiprocessorCount, dev) != hipSuccess || cus <= 0) cus = 256;
        if (hipFuncSetAttribute((const void*)mega_fwd, hipFuncAttributeMaxDynamicSharedMemorySize, LDS_BYTES) != hipSuccess) fprintf(stderr, "kernel_launch: hipFuncSetAttribute failed\n");
        if (hipOccupancyMaxActiveBlocksPerMultiprocessor(&per_cu, (const void*)mega_fwd, NTHR, LDS_BYTES) != hipSuccess || per_cu < 1) { fprintf(stderr, "kernel_launch: occupancy query says %d\n", per_cu); per_cu = 1; }
        (void)hipGetLastError();
        grid = cus * per_cu;
    }
    if (grid < 0) return;
    if (hipMemsetAsync((char*)d_ws + WS_BAR, 0, WS_ST + 1 * MiB - WS_BAR, stream) != hipSuccess) { fprintf(stderr, "kernel_launch: hipMemsetAsync failed\n"); return; }
    Args a{};
    for (int i = 0; i < 24; ++i) a.in[i] = (const float*)d_in[i];
    a.out = (float*)d_out; a.ws = (unsigned char*)d_ws;
    void* args[] = {&a};
    hipError_t e = hipLaunchCooperativeKernel((const void*)mega_fwd, dim3(grid), dim3(NTHR), args, LDS_BYTES, stream);
    if (e != hipSuccess) fprintf(stderr, "cooperative launch failed: %s (grid %d)\n", hipGetErrorString(e), grid);
}
```

```cpp
#include <hip/hip_runtime.h>
#include <hip/hip_cooperative_groups.h>
#include <hip/hip_bf16.h>
#include <cstdio>
#include <cstdint>
namespace cg = cooperative_groups;

constexpr int BATCH = 2, SEQ = 8192, DM = 2048, DEPTH = 2, T = BATCH * SEQ;
constexpr int NMEM = 256, INC = 5632, DFF = 5632;
constexpr float ALPHA = 1.4142135623730951f;
constexpr float LN_EPS = 1e-5f;
constexpr int NTHR = 512, NWAVES = 8;

constexpr size_t MiB = 1u << 20;
constexpr size_t WS_LAM = 0;
constexpr size_t WS_BTAB = 4096;
constexpr size_t WS_BAR = 512 * 1024;
constexpr size_t WS_C = 576 * 1024;
constexpr int C_Q = 0, C_GU = 4096, C_IN = 4096 + 22528, C_QK2 = 4096 + 22528 + 11264, C_LAYER = C_QK2 + 2048;
constexpr size_t WS_ST = 1 * MiB;
constexpr size_t WS_WTRIL = 12 * MiB;
constexpr size_t WS_MEMBF = 2 * MiB;
constexpr size_t WS_KV = 4 * MiB;
constexpr size_t WS_W = 16 * MiB;
constexpr size_t W_IN = 0, W_OUT = 22 * MiB, W_Q = 30 * MiB, W_KV = 38 * MiB, W_O = 54 * MiB, W_GU = 62 * MiB, W_D = 106 * MiB, W_LAYER = 128 * MiB;
constexpr size_t WS_XN = 272 * MiB;
constexpr size_t WS_PROJ = 336 * MiB;
constexpr size_t WS_R1 = 512 * MiB;
constexpr size_t WS_Y = 640 * MiB;
constexpr size_t WS_END = 704 * MiB;
constexpr int LDS_BYTES = 147456;

typedef unsigned short bf16_t;
typedef short bf16x8 __attribute__((ext_vector_type(8)));
typedef float f32x4 __attribute__((ext_vector_type(4)));
typedef float f32x16 __attribute__((ext_vector_type(16)));
typedef unsigned u32x4 __attribute__((ext_vector_type(4)));
typedef unsigned u32x2 __attribute__((ext_vector_type(2)));
#define LAS __attribute__((address_space(3)))
#define GAS __attribute__((address_space(1)))

__device__ __forceinline__ unsigned cvt_pk_bf16(float lo, float hi) { unsigned r; asm volatile("v_cvt_pk_bf16_f32 %0, %1, %2" : "=v"(r) : "v"(lo), "v"(hi)); return r; }
__device__ __forceinline__ float bf_lo(unsigned w) { return __uint_as_float(w << 16); }
__device__ __forceinline__ float bf_hi(unsigned w) { return __uint_as_float(w & 0xffff0000u); }
__device__ __forceinline__ float bf2f(bf16_t b) { return __uint_as_float(((unsigned)b) << 16); }
__device__ __forceinline__ bf16_t f2bf(float f) { return (bf16_t)(cvt_pk_bf16(f, 0.f) & 0xffffu); }
__device__ __forceinline__ int ltid() { int t = threadIdx.x; asm volatile("" : "+v"(t)); return t; }
__device__ __forceinline__ int cu_opaque() { int c = blockIdx.x; asm volatile("" : "+s"(c)); return c; }
#define PH_IDS const int cu = cu_opaque(); const int tid = ltid(), lane = tid & 63, wave = __builtin_amdgcn_readfirstlane(tid >> 6), gw = cu * NWAVES + wave, gt = cu * NTHR + tid; (void)lane; (void)wave; (void)gw; (void)gt
__device__ __forceinline__ float wave_sum(float v) {
#pragma unroll
    for (int o = 1; o < 64; o <<= 1) v += __shfl_xor(v, o);
    return v;
}
__device__ __forceinline__ float wave_max(float v) {
#pragma unroll
    for (int o = 1; o < 64; o <<= 1) v = fmaxf(v, __shfl_xor(v, o));
    return v;
}
__device__ __forceinline__ float gelu_tanh(float x) {
    const float y = 0.7978845608028654f * (x + 0.044715f * x * x * x);
    return x * __builtin_amdgcn_rcpf(1.f + __expf(-2.f * y));
}

namespace pg8 {
constexpr int BM = 256, BK = 64, HALF = 128, HTB = HALF * BK * 2, STAGE_BYTES = 8 * HTB, NXCD = 8, WGM = 8;
__host__ __device__ __forceinline__ int lds_byte(int r, int c) { const int st = (r >> 4) * 2 + (c >> 5), rr = r & 15, cc = c & 31, ob = rr * 64 + cc * 2; return st * 1024 + (ob ^ (((ob >> 9) & 1) << 5)); }
__host__ __device__ __forceinline__ void stage_rc(int b, int& R, int& C) { const int st = b / 1024, sb = b % 1024, swz = sb ^ (((sb >> 9) & 1) << 5); R = (st >> 1) * 16 + swz / 64; C = (st & 1) * 32 + (swz % 64) / 2; }
__host__ __device__ __forceinline__ int perm32(int rho) { const int n = rho >> 4, i = rho & 15; return 8 * (i >> 2) + 4 * n + (i & 3); }

struct Unit { int pm, pn, bz; };
struct Gemm { const bf16_t* A; const bf16_t* Bt; int lda, ldb, K, nb0; long a_s1, a_s0, b_s1, b_s0; };
__device__ __forceinline__ const char* unit_a(const Gemm& g, const Unit& u) { const int b1 = u.bz / g.nb0, b0 = u.bz % g.nb0; return (const char*)(g.A + (size_t)b1 * g.a_s1 + (size_t)b0 * g.a_s0 + (size_t)u.pm * BM * g.lda); }
__device__ __forceinline__ const char* unit_b(const Gemm& g, const Unit& u) { const int b1 = u.bz / g.nb0, b0 = u.bz % g.nb0; return (const char*)(g.Bt + (size_t)b1 * g.b_s1 + (size_t)b0 * g.b_s0 + (size_t)u.pn * BM * g.ldb); }

struct Order {
    int nM, nN, nB, G, c;
    __device__ void init(int M, int N, int nB_, int G_, int c_) { nM = M / BM; nN = N / BM; nB = nB_; G = G_; c = c_; }
    __device__ bool next(int i, Unit& u) const {
        const long L = (long)i * G + c; const int nwg = nM * nN; if (c < 0 || L >= (long)nwg * nB) return false;
        if (nB > 1) { u.bz = (int)(L / nwg); const int w = (int)(L % nwg); u.pn = w / nM; u.pm = w % nM; return true; }
        u.bz = 0;
        int wgid = (int)L; { const int q = nwg / NXCD, r = nwg % NXCD, xcd = wgid % NXCD, off = wgid / NXCD; wgid = (xcd < r ? xcd * (q + 1) : r * (q + 1) + (xcd - r) * q) + off; }
        const int nig = WGM * nN, gid = wgid / nig, fm = gid * WGM, gsz = (nM - fm) < WGM ? (nM - fm) : WGM;
        u.pm = fm + ((wgid % nig) % gsz); u.pn = (wgid % nig) / gsz; return true;
    }
};

__device__ __forceinline__ void row_stats(const float* st, int row, float& mean, float& rstd) {
    const float s1 = st[2 * row], s2 = st[2 * row + 1];
    mean = s1 * (1.f / DM); const float var = fmaxf(s2 * (1.f / DM) - mean * mean, 0.f); rstd = rsqrtf(var + LN_EPS);
}
struct EpiSplit {
    static constexpr bool PERM = true, AFTER_DRAIN = false;
    bf16_t* P; const float* st; const float* c1; const float* c2;
    float* gst;
    __device__ __forceinline__ void operator()(const f32x4 (&acc)[2][2][4][2], const Unit& u, int wr, int wc, int fr, int fq) const {
        const int row0 = u.pm * BM + wr * 64 + fr, col0 = u.pn * BM + wc * 32 + 8 * fq;
        const bool vg = (u.pn == 8 || u.pn == 9);
        f32x4 k1[2][2], k2[2][2];
        if (st) {
#pragma unroll
            for (int bj = 0; bj < 2; ++bj)
#pragma unroll
                for (int n = 0; n < 2; ++n) { k1[bj][n] = *(const f32x4*)(c1 + col0 + bj * HALF + 4 * n); k2[bj][n] = *(const f32x4*)(c2 + col0 + bj * HALF + 4 * n); } }
#pragma unroll
        for (int ai = 0; ai < 2; ++ai)
#pragma unroll
            for (int m = 0; m < 4; ++m) { const int row = row0 + ai * HALF + m * 16;
                float mean = 0.f, rstd = 1.f; if (st) row_stats(st, row, mean, rstd);
                float gs = 0.f, gq = 0.f;
#pragma unroll
                for (int bj = 0; bj < 2; ++bj) { f32x4 v0 = acc[ai][bj][m][0], v1 = acc[ai][bj][m][1];
                    if (st) { v0 = (v0 - k1[bj][0] * mean) * rstd + k2[bj][0]; v1 = (v1 - k1[bj][1] * mean) * rstd + k2[bj][1]; }
                    u32x4 w; w.x = cvt_pk_bf16(v0[0], v0[1]); w.y = cvt_pk_bf16(v0[2], v0[3]); w.z = cvt_pk_bf16(v1[0], v1[1]); w.w = cvt_pk_bf16(v1[2], v1[3]);
                    *(u32x4*)(P + ((size_t)(u.pn * 2 + bj) * T + row) * 128 + wc * 32 + 8 * fq) = w;
                    if (vg) {
#pragma unroll
                        for (int j = 0; j < 4; ++j) { const float x0 = gelu_tanh(bf_lo(w[j])), x1 = gelu_tanh(bf_hi(w[j])); gs += x0 + x1; gq += x0 * x0 + x1 * x1; } } }
                if (vg) { gs += __shfl_xor(gs, 16); gs += __shfl_xor(gs, 32); gq += __shfl_xor(gq, 16); gq += __shfl_xor(gq, 32);
                    if (fq == 0) { unsafeAtomicAdd(gst + 2 * row, gs); unsafeAtomicAdd(gst + 2 * row + 1, gq); } } }
    }
};
struct EpiBf16 {
    static constexpr bool PERM = true, AFTER_DRAIN = false;
    bf16_t* O; int ldc, nb0; long o_s1, o_s0; float scale; const float* st; const float* c1; const float* c2; float* rsum;
    __device__ __forceinline__ void operator()(const f32x4 (&acc)[2][2][4][2], const Unit& u, int wr, int wc, int fr, int fq) const {
        const int row0 = u.pm * BM + wr * 64 + fr, col0 = u.pn * BM + wc * 32 + 8 * fq;
        bf16_t* base = O + (size_t)(u.bz / nb0) * o_s1 + (size_t)(u.bz % nb0) * o_s0;
        f32x4 k1[2][2], k2[2][2];
        if (st) {
#pragma unroll
            for (int bj = 0; bj < 2; ++bj)
#pragma unroll
                for (int n = 0; n < 2; ++n) { k1[bj][n] = *(const f32x4*)(c1 + col0 + bj * HALF + 4 * n); k2[bj][n] = *(const f32x4*)(c2 + col0 + bj * HALF + 4 * n); } }
#pragma unroll
        for (int ai = 0; ai < 2; ++ai)
#pragma unroll
            for (int m = 0; m < 4; ++m) { const int row = row0 + ai * HALF + m * 16; bf16_t* rowp = base + (size_t)row * ldc + col0;
                float mean = 0.f, rstd = 1.f; if (st) row_stats(st, row, mean, rstd);
                float rs = 0.f;
#pragma unroll
                for (int bj = 0; bj < 2; ++bj) { f32x4 v0 = acc[ai][bj][m][0], v1 = acc[ai][bj][m][1];
                    if (st) { v0 = (v0 - k1[bj][0] * mean) * rstd + k2[bj][0]; v1 = (v1 - k1[bj][1] * mean) * rstd + k2[bj][1]; }
                    v0 = v0 * scale; v1 = v1 * scale;
                    u32x4 w; w.x = cvt_pk_bf16(v0[0], v0[1]); w.y = cvt_pk_bf16(v0[2], v0[3]); w.z = cvt_pk_bf16(v1[0], v1[1]); w.w = cvt_pk_bf16(v1[2], v1[3]);
                    *(u32x4*)(rowp + bj * HALF) = w;
                    if (rsum) rs += ((bf_lo(w.x) + bf_hi(w.x)) + (bf_lo(w.y) + bf_hi(w.y))) + ((bf_lo(w.z) + bf_hi(w.z)) + (bf_lo(w.w) + bf_hi(w.w))); }
                if (rsum) { rs += __shfl_xor(rs, 16); rs += __shfl_xor(rs, 32); if (fq == 0) unsafeAtomicAdd(rsum + u.bz * 256 + row, rs); } }
    }
};
struct EpiF32 {
    static constexpr bool PERM = false, AFTER_DRAIN = false;
    float* out; int ldc; long o_bs; float scale;
    __device__ __forceinline__ void operator()(const f32x4 (&acc)[2][2][4][2], const Unit& u, int wr, int wc, int fr, int fq) const {
        const int row0 = u.pm * BM + wr * 64 + fr, col0 = u.pn * BM + wc * 32 + 4 * fq;
        float* ob = out + (size_t)u.bz * o_bs;
#pragma unroll
        for (int ai = 0; ai < 2; ++ai)
#pragma unroll
            for (int m = 0; m < 4; ++m) { const size_t off = (size_t)(row0 + ai * HALF + m * 16) * ldc + col0;
#pragma unroll
                for (int bj = 0; bj < 2; ++bj)
#pragma unroll
                    for (int n = 0; n < 2; ++n) *(f32x4*)(ob + off + bj * HALF + n * 16) = acc[ai][bj][m][n] * scale; }
    }
};
struct EpiRes {
    static constexpr bool PERM = true, AFTER_DRAIN = false;
    float* X; const float* raw; const float* pst; const float* pg; const float* pb; bf16_t* ZB; float* cst; float alpha; int brows;
    __device__ __forceinline__ void operator()(const f32x4 (&acc)[2][2][4][2], const Unit& u, int wr, int wc, int fr, int fq) const {
        const int row0 = u.bz * brows + u.pm * BM + wr * 64 + fr, col0 = u.pn * BM + wc * 32 + 8 * fq;
        f32x4 gv[2][2], bv[2][2];
        if (!raw) {
#pragma unroll
            for (int bj = 0; bj < 2; ++bj)
#pragma unroll
                for (int n = 0; n < 2; ++n) { gv[bj][n] = *(const f32x4*)(pg + col0 + bj * HALF + 4 * n); bv[bj][n] = *(const f32x4*)(pb + col0 + bj * HALF + 4 * n); } }
#pragma unroll
        for (int ai = 0; ai < 2; ++ai)
#pragma unroll
            for (int m = 0; m < 4; ++m) { const int row = row0 + ai * HALF + m * 16; const size_t off = (size_t)row * DM + col0;
                float mean = 0.f, rstd = 1.f; if (!raw) row_stats(pst, row, mean, rstd);
                float s1 = 0.f, s2 = 0.f;
#pragma unroll
                for (int bj = 0; bj < 2; ++bj) { f32x4 r0, r1;
                    if (raw) { r0 = *(const f32x4*)(raw + off + bj * HALF); r1 = *(const f32x4*)(raw + off + bj * HALF + 4); }
                    else { const u32x4 zw = *(const u32x4*)(ZB + off + bj * HALF);
                        r0 = (f32x4){bf_lo(zw.x), bf_hi(zw.x), bf_lo(zw.y), bf_hi(zw.y)}; r1 = (f32x4){bf_lo(zw.z), bf_hi(zw.z), bf_lo(zw.w), bf_hi(zw.w)};
                        r0 = (r0 - mean) * rstd * gv[bj][0] + bv[bj][0]; r1 = (r1 - mean) * rstd * gv[bj][1] + bv[bj][1]; }
                    const f32x4 z0 = acc[ai][bj][m][0] + r0 * alpha, z1 = acc[ai][bj][m][1] + r1 * alpha;
                    if (X) { *(f32x4*)(X + off + bj * HALF) = z0; *(f32x4*)(X + off + bj * HALF + 4) = z1; }
                    u32x4 w; w.x = cvt_pk_bf16(z0[0], z0[1]); w.y = cvt_pk_bf16(z0[2], z0[3]); w.z = cvt_pk_bf16(z1[0], z1[1]); w.w = cvt_pk_bf16(z1[2], z1[3]);
                    *(u32x4*)(ZB + off + bj * HALF) = w;
                    s1 += ((z0[0] + z0[1]) + (z0[2] + z0[3])) + ((z1[0] + z1[1]) + (z1[2] + z1[3]));
                    s2 += ((z0[0] * z0[0] + z0[1] * z0[1]) + (z0[2] * z0[2] + z0[3] * z0[3])) + ((z1[0] * z1[0] + z1[1] * z1[1]) + (z1[2] * z1[2] + z1[3] * z1[3])); }
                s1 += __shfl_xor(s1, 16); s1 += __shfl_xor(s1, 32); s2 += __shfl_xor(s2, 16); s2 += __shfl_xor(s2, 32);
                if (fq == 0) { unsafeAtomicAdd(cst + 2 * row, s1); unsafeAtomicAdd(cst + 2 * row + 1, s2); } }
    }
};
struct EpiSwiglu {
    static constexpr bool PERM = true, AFTER_DRAIN = false;
    bf16_t* H; const float* st; const float* c1; const float* c2;
    __device__ __forceinline__ void operator()(const f32x4 (&acc)[2][2][4][2], const Unit& u, int wr, int wc, int fr, int fq) const {
        const int row0 = u.pm * BM + wr * 64 + fr, col0 = u.pn * HALF + wc * 32 + 8 * fq, ccol0 = u.pn * BM + wc * 32 + 8 * fq;
        f32x4 k1[2][2], k2[2][2];
#pragma unroll
        for (int bj = 0; bj < 2; ++bj)
#pragma unroll
            for (int n = 0; n < 2; ++n) { k1[bj][n] = *(const f32x4*)(c1 + ccol0 + bj * HALF + 4 * n); k2[bj][n] = *(const f32x4*)(c2 + ccol0 + bj * HALF + 4 * n); }
#pragma unroll
        for (int ai = 0; ai < 2; ++ai)
#pragma unroll
            for (int m = 0; m < 4; ++m) { const int row = row0 + ai * HALF + m * 16; bf16_t* rowp = H + (size_t)row * DFF + col0;
                float mean, rstd; row_stats(st, row, mean, rstd);
                float h[8];
#pragma unroll
                for (int n = 0; n < 2; ++n) { const f32x4 gq = (acc[ai][0][m][n] - k1[0][n] * mean) * rstd + k2[0][n], uq = (acc[ai][1][m][n] - k1[1][n] * mean) * rstd + k2[1][n];
#pragma unroll
                    for (int j = 0; j < 4; ++j) h[n * 4 + j] = gq[j] * __builtin_amdgcn_rcpf(1.f + __expf(-gq[j])) * uq[j]; }
                u32x4 w; w.x = cvt_pk_bf16(h[0], h[1]); w.y = cvt_pk_bf16(h[2], h[3]); w.z = cvt_pk_bf16(h[4], h[5]); w.w = cvt_pk_bf16(h[6], h[7]);
                *(u32x4*)rowp = w; }
    }
};

struct EpiSoftmax {
    static constexpr bool PERM = true, AFTER_DRAIN = true;
    bf16_t* PALL; const float* st; const float* c1; const float* c2; float scale;
    __device__ __forceinline__ void fused(f32x4 (&acc)[2][2][4][2], const Unit& u, int wr, int wc, int fr, int fq, LAS unsigned char* lds) const {
        const int b = u.bz >> 2, h = u.bz & 3, rl0 = wr * 64 + fr, cc0 = wc * 32 + 8 * fq;
        LAS float* PMX = (LAS float*)lds; LAS float* PSM = PMX + 1024;
        f32x4 k1[2][2], k2[2][2];
#pragma unroll
        for (int bj = 0; bj < 2; ++bj)
#pragma unroll
            for (int n = 0; n < 2; ++n) { k1[bj][n] = *(const f32x4*)(c1 + u.bz * 256 + cc0 + bj * HALF + 4 * n); k2[bj][n] = *(const f32x4*)(c2 + u.bz * 256 + cc0 + bj * HALF + 4 * n); }
#pragma unroll
        for (int ai = 0; ai < 2; ++ai)
#pragma unroll
            for (int m = 0; m < 4; ++m) { const int rl = rl0 + ai * HALF + m * 16, row = b * SEQ + u.pm * BM + rl;
                float mean, rstd; row_stats(st, row, mean, rstd);
                float mx = -__builtin_inff();
#pragma unroll
                for (int bj = 0; bj < 2; ++bj)
#pragma unroll
                    for (int n = 0; n < 2; ++n) { const f32x4 v = ((acc[ai][bj][m][n] - k1[bj][n] * mean) * rstd + k2[bj][n]) * scale; acc[ai][bj][m][n] = v;
                        mx = fmaxf(mx, fmaxf(fmaxf(v[0], v[1]), fmaxf(v[2], v[3]))); }
                mx = fmaxf(mx, __shfl_xor(mx, 16)); mx = fmaxf(mx, __shfl_xor(mx, 32));
                if (fq == 0) PMX[rl * 4 + wc] = mx; }
        asm volatile("s_waitcnt lgkmcnt(0)" ::: "memory"); __builtin_amdgcn_s_barrier(); asm volatile("" ::: "memory");
#pragma unroll
        for (int ai = 0; ai < 2; ++ai)
#pragma unroll
            for (int m = 0; m < 4; ++m) { const int rl = rl0 + ai * HALF + m * 16;
                const f32x4 q = *(const LAS f32x4*)(PMX + rl * 4); const float mx = fmaxf(fmaxf(q[0], q[1]), fmaxf(q[2], q[3]));
                float sm = 0.f;
#pragma unroll
                for (int bj = 0; bj < 2; ++bj)
#pragma unroll
                    for (int n = 0; n < 2; ++n) { f32x4 e = acc[ai][bj][m][n] - mx; e[0] = __expf(e[0]); e[1] = __expf(e[1]); e[2] = __expf(e[2]); e[3] = __expf(e[3]); acc[ai][bj][m][n] = e;
                        sm += (e[0] + e[1]) + (e[2] + e[3]); }
                sm += __shfl_xor(sm, 16); sm += __shfl_xor(sm, 32);
                if (fq == 0) PSM[rl * 4 + wc] = sm; }
        asm volatile("s_waitcnt lgkmcnt(0)" ::: "memory"); __builtin_amdgcn_s_barrier(); asm volatile("" ::: "memory");
#pragma unroll
        for (int ai = 0; ai < 2; ++ai)
#pragma unroll
            for (int m = 0; m < 4; ++m) { const int rl = rl0 + ai * HALF + m * 16, row = b * SEQ + u.pm * BM + rl;
                const f32x4 q = *(const LAS f32x4*)(PSM + rl * 4); const float inv = __builtin_amdgcn_rcpf((q[0] + q[1]) + (q[2] + q[3]));
                bf16_t* rowp = PALL + (size_t)row * 1024 + h * 256 + cc0;
#pragma unroll
                for (int bj = 0; bj < 2; ++bj) { const f32x4 v0 = acc[ai][bj][m][0] * inv, v1 = acc[ai][bj][m][1] * inv;
                    u32x4 w; w.x = cvt_pk_bf16(v0[0], v0[1]); w.y = cvt_pk_bf16(v0[2], v0[3]); w.z = cvt_pk_bf16(v1[0], v1[1]); w.w = cvt_pk_bf16(v1[2], v1[3]);
                    *(u32x4*)(rowp + bj * HALF) = w; } }
    }
};

template <class Epi, bool ALIGN_EPI>
__device__ __forceinline__ void gemm_phase(LAS unsigned char* lds, const Gemm g, const Order& S, const Epi& E) {
    const int tid = ltid(), wid = __builtin_amdgcn_readfirstlane(tid >> 6), lane = tid & 63, wr = wid >> 2, wc = wid & 3, fr = lane & 15, fq = lane >> 4;
    const int K = g.K, nt = K / BK;
    unsigned voffA[2], voffB[2];
#pragma unroll
    for (int i = 0; i < 2; ++i) { int R, C; stage_rc(tid * 16 + i * 8192, R, C); const int Rb = Epi::PERM ? ((R & ~31) + perm32(R & 31)) : R;
        voffA[i] = (unsigned)(R * g.lda + C) * 2u; voffB[i] = (unsigned)(Rb * g.ldb + C) * 2u; }
    const size_t kstep = (size_t)(BK * 2);
    const size_t hstepA = (size_t)HALF * g.lda * 2, hstepB = (size_t)HALF * g.ldb * 2;
    const unsigned ldsw = (unsigned)wid * 1024u;
    const int aoff = lds_byte(wr * 64 + fr, fq * 8), boff = lds_byte(wc * 32 + fr, fq * 8);
#define PG8_SA(b, h) (((b) * 2 + (h)) * HTB)
#define PG8_SB(b, h) ((4 + (b) * 2 + (h)) * HTB)
#define PG8_STAGE(bufoff, gbase, voff) do { _Pragma("unroll") for (int _i = 0; _i < 2; ++_i) \
        __builtin_amdgcn_global_load_lds((const unsigned*)((const char*)(gbase) + (voff)[_i]), (LAS unsigned*)(lds + (bufoff) + ldsw + _i * 8192), 16, 0, 0); } while (0)
#define PG8_LDA(dst, b, h) do { _Pragma("unroll") for (int m = 0; m < 4; ++m) _Pragma("unroll") for (int k = 0; k < 2; ++k) dst[m][k] = *(const LAS bf16x8*)(lds + PG8_SA(b, h) + aoff + m * 2048 + k * 1024); } while (0)
#define PG8_LDB(dst, b, h) do { _Pragma("unroll") for (int n = 0; n < 2; ++n) _Pragma("unroll") for (int k = 0; k < 2; ++k) dst[n][k] = *(const LAS bf16x8*)(lds + PG8_SB(b, h) + boff + n * 2048 + k * 1024); } while (0)
#define PG8_MMA(ai, bj, At, Bt) do { __builtin_amdgcn_s_setprio(1); _Pragma("unroll") for (int m = 0; m < 4; ++m) _Pragma("unroll") for (int n = 0; n < 2; ++n) _Pragma("unroll") for (int k = 0; k < 2; ++k) \
        acc[ai][bj][m][n] = __builtin_amdgcn_mfma_f32_16x16x32_bf16(Bt[n][k], At[m][k], acc[ai][bj][m][n], 0, 0, 0); __builtin_amdgcn_s_setprio(0); } while (0)
#define PG8_WAIT_V(n) asm volatile("s_waitcnt vmcnt(" #n ")" ::: "memory")
#define PG8_WAIT_L(n) asm volatile("s_waitcnt lgkmcnt(" #n ")" ::: "memory")
#define PG8_BAR __builtin_amdgcn_s_barrier()
#define PG8_SCHED __builtin_amdgcn_sched_barrier(0)
    Unit cur, nxt; int ui = 0;
    if (!S.next(0, cur)) return;
    f32x4 acc[2][2][4][2];
#pragma unroll
    for (int a = 0; a < 2; ++a)
#pragma unroll
        for (int b = 0; b < 2; ++b)
#pragma unroll
            for (int m = 0; m < 4; ++m)
#pragma unroll
                for (int n = 0; n < 2; ++n) acc[a][b][m][n] = (f32x4){0.f, 0.f, 0.f, 0.f};
    bf16x8 At[4][2], B0[2][2], B1[2][2];
    const char* cA = unit_a(g, cur); const char* cB = unit_b(g, cur);
    PG8_STAGE(PG8_SB(0, 0), cB, voffB); PG8_STAGE(PG8_SB(0, 1), cB + hstepB, voffB); PG8_STAGE(PG8_SA(0, 0), cA, voffA); PG8_STAGE(PG8_SA(0, 1), cA + hstepA, voffA);
    if (wr == 1) PG8_BAR;
    PG8_WAIT_V(2); PG8_BAR;
    PG8_STAGE(PG8_SB(1, 0), cB + kstep, voffB); PG8_STAGE(PG8_SA(1, 0), cA + kstep, voffA); PG8_STAGE(PG8_SB(1, 1), cB + hstepB + kstep, voffB);
    PG8_WAIT_V(6); PG8_BAR;
    for (;;) {
        const bool has_next = S.next(ui + 1, nxt);
        const char* nA = has_next ? unit_a(g, nxt) : cA; const char* nB = has_next ? unit_b(g, nxt) : cB;
        for (int t = 0; t < nt; t += 2) {
            const bool last = (t == nt - 2);
            const char* a1 = cA + (size_t)(t + 1) * kstep;
            const char* a2 = last ? nA : cA + (size_t)(t + 2) * kstep; const char* b2 = last ? nB : cB + (size_t)(t + 2) * kstep;
            const char* a3 = a2 + kstep; const char* b3 = b2 + kstep;
            PG8_LDB(B0, 0, 0); PG8_LDB(B1, 0, 1); PG8_SCHED; PG8_LDA(At, 0, 0); PG8_STAGE(PG8_SA(1, 1), a1 + hstepA, voffA);
            PG8_WAIT_V(8); PG8_WAIT_L(0); PG8_BAR; PG8_MMA(0, 0, At, B0); PG8_MMA(0, 1, At, B1); PG8_BAR; PG8_SCHED;
            PG8_LDA(At, 0, 1); PG8_STAGE(PG8_SB(0, 0), b2, voffB); PG8_STAGE(PG8_SB(0, 1), b2 + hstepB, voffB); PG8_STAGE(PG8_SA(0, 0), a2, voffA);
            PG8_WAIT_V(8); PG8_WAIT_L(0); PG8_BAR; PG8_MMA(1, 0, At, B0); PG8_MMA(1, 1, At, B1); PG8_BAR; PG8_SCHED;
            PG8_LDB(B0, 1, 0); PG8_LDB(B1, 1, 1); PG8_SCHED; PG8_LDA(At, 1, 0); PG8_STAGE(PG8_SA(0, 1), a2 + hstepA, voffA);
            PG8_WAIT_V(8); PG8_WAIT_L(0); PG8_BAR; PG8_MMA(0, 0, At, B0); PG8_MMA(0, 1, At, B1); PG8_BAR; PG8_SCHED;
            PG8_LDA(At, 1, 1); PG8_STAGE(PG8_SB(1, 0), b3, voffB); PG8_STAGE(PG8_SB(1, 1), b3 + hstepB, voffB); PG8_STAGE(PG8_SA(1, 0), a3, voffA);
            PG8_WAIT_V(8); PG8_WAIT_L(0); PG8_BAR; PG8_MMA(1, 0, At, B0); PG8_MMA(1, 1, At, B1); PG8_BAR; PG8_SCHED;
        }
        if constexpr (ALIGN_EPI) { if (wr == 0) PG8_BAR; }
        if constexpr (!Epi::AFTER_DRAIN) E(acc, cur, wr, wc, fr, fq);
        if (!has_next) break;
#pragma unroll
        for (int a = 0; a < 2; ++a)
#pragma unroll
            for (int b = 0; b < 2; ++b)
#pragma unroll
                for (int m = 0; m < 4; ++m)
#pragma unroll
                    for (int n = 0; n < 2; ++n) acc[a][b][m][n] = (f32x4){0.f, 0.f, 0.f, 0.f};
        cur = nxt; cA = nA; cB = nB; ++ui;
        if constexpr (ALIGN_EPI) { if (wr == 1) PG8_BAR; }
    }
    PG8_WAIT_V(0);
    if constexpr (!ALIGN_EPI) { if (wr == 0) PG8_BAR; }
    PG8_BAR;
    if constexpr (Epi::AFTER_DRAIN) E.fused(acc, cur, wr, wc, fr, fq, lds);
#undef PG8_SA
#undef PG8_SB
#undef PG8_STAGE
#undef PG8_LDA
#undef PG8_LDB
#undef PG8_MMA
#undef PG8_WAIT_V
#undef PG8_WAIT_L
#undef PG8_BAR
#undef PG8_SCHED
}
}

namespace att {
using bf16 = __hip_bfloat16;
typedef short s16x4 __attribute__((ext_vector_type(4)));
constexpr int D = 128;
constexpr float THR = 8.f;
constexpr float SCALE = 0.08838834764831845f;
constexpr int NW = 8, QBLK = 32, KVBLK = 64, QB = NW * QBLK;
constexpr int SHM_V = KVBLK * D * 2, SHM_K = KVBLK * D * 2;
constexpr int ATT_LDS = 2 * SHM_V + 2 * SHM_K + NW * 64 * 4;
constexpr int BT_OFF = ATT_LDS;

#define KSWZ(row, colB) ((row) * 256 + ((colB) ^ (((row) & 7) << 4)))
#define SBAR() __builtin_amdgcn_sched_barrier(0)
__device__ __forceinline__ int v_st(int k, int c) { const int kk = (k & ~0xC) | ((k & 4) << 1) | ((k & 8) >> 1); return ((kk >> 3) * 4 + (c >> 5)) * 512 + ((kk & 7) * 32 + (c & 31)) * 2; }
__device__ __forceinline__ int v_rd_base(int lane) { return ((lane & 3) << 3) | (((lane >> 2) & 3) << 6) | (((lane >> 4) & 1) << 5) | (((lane >> 5) & 1) << 8); }
constexpr int v_rd_off(int d0, int ks, int half) { return d0 * 512 + ks * 4096 + half * 2048; }
__device__ __forceinline__ int crow(int r, int hi) { return (r & 3) + 8 * (r >> 2) + 4 * hi; }
__device__ __forceinline__ unsigned cvtpk(float lo, float hi) { unsigned r; asm volatile("v_cvt_pk_bf16_f32 %0, %1, %2" : "=v"(r) : "v"(lo), "v"(hi)); return r; }
__device__ __forceinline__ bf16x8 load8(const bf16* p) { return *reinterpret_cast<const bf16x8*>(p); }
__device__ __forceinline__ void bias_mask_tile(f32x16& p0, f32x16& p1, int dq, const float* bt) {
    const float NEG = -__builtin_inff();
#pragma unroll
    for (int r = 0; r < 16; ++r) {
        const int c = (r & 3) + 8 * (r >> 2);
        const int d0 = dq - c, d1 = dq - c - 32;
        const unsigned i0 = (unsigned)d0 < 255u ? (unsigned)d0 : 255u, i1 = (unsigned)d1 < 255u ? (unsigned)d1 : 255u;
        const float b0 = bt[i0], b1 = bt[i1];
        p0[r] = d0 >= 0 ? p0[r] + b0 : NEG;
        p1[r] = d1 >= 0 ? p1[r] + b1 : NEG;
    }
}
__device__ __forceinline__ void partialSM(f32x16& p0, f32x16& p1, float& m_reg, float& mn, float& alpha) {
    float pmax = p0[0]; for (int r = 1; r < 16; ++r) pmax = fmaxf(pmax, p0[r]); for (int r = 0; r < 16; ++r) pmax = fmaxf(pmax, p1[r]);
    { auto rr = __builtin_amdgcn_permlane32_swap(__float_as_uint(pmax), __float_as_uint(pmax), false, false);
      pmax = fmaxf(__uint_as_float(rr[0]), __uint_as_float(rr[1])); }
    constexpr float C2 = 1.4426950408889634f * SCALE;
    if (__builtin_expect(__all((pmax - m_reg) * SCALE <= THR), 1)) { mn = m_reg; alpha = 1.f; }
    else { mn = fmaxf(m_reg, pmax); alpha = __builtin_amdgcn_exp2f((m_reg - mn) * C2); m_reg = mn; }
    const float mnL = -mn * C2;
    for (int r = 0; r < 16; ++r) p0[r] = fmaf(p0[r], C2, mnL); for (int r = 0; r < 16; ++r) p1[r] = fmaf(p1[r], C2, mnL);
    for (int r = 0; r < 16; ++r) p0[r] = __builtin_amdgcn_exp2f(p0[r]);
}
__device__ __forceinline__ void finishSM(f32x16& p0, f32x16& p1, float alpha, float& l_reg, bf16x8& pa0, bf16x8& pa1, bf16x8& pa2, bf16x8& pa3) {
    for (int r = 0; r < 16; ++r) p1[r] = __builtin_amdgcn_exp2f(p1[r]);
    float ps = 0; for (int r = 0; r < 16; ++r) ps += p0[r]; for (int r = 0; r < 16; ++r) ps += p1[r];
    { auto rr = __builtin_amdgcn_permlane32_swap(__float_as_uint(ps), __float_as_uint(ps), false, false);
      ps = __uint_as_float(rr[0]) + __uint_as_float(rr[1]); }
    l_reg = l_reg * alpha + ps;
#define PK4(P, B_, OUT) do { unsigned a0 = cvtpk(P[B_+0], P[B_+1]), a1 = cvtpk(P[B_+2], P[B_+3]);                          \
        unsigned b0 = cvtpk(P[B_+4], P[B_+5]), b1 = cvtpk(P[B_+6], P[B_+7]);                                             \
        auto r0 = __builtin_amdgcn_permlane32_swap(a0, b0, false, false); auto r1 = __builtin_amdgcn_permlane32_swap(a1, b1, false, false); \
        u32x4 w = {r0[0], r1[0], r0[1], r1[1]}; OUT = *reinterpret_cast<bf16x8*>(&w); } while (0)
    PK4(p0, 0, pa0); PK4(p0, 8, pa1); PK4(p1, 0, pa2); PK4(p1, 8, pa3);
#undef PK4
}
template <int KB>
__device__ __forceinline__ void qkt(f32x16& p0, f32x16& p1, const char* K_lds, int r32, int hi, const bf16x8* qr) {
    p0 = f32x16{}; p1 = f32x16{};
    const char* kb[4];
#pragma unroll
    for (int dd = 0; dd < 4; ++dd) kb[dd] = K_lds + KB * SHM_K + KSWZ(r32, (dd * 16 + hi * 8) * 2);
#pragma unroll
    for (int d0 = 0; d0 < 8; ++d0) { const char* a = kb[d0 & 3] + (d0 >> 2) * 128;
        bf16x8 b0 = *reinterpret_cast<const bf16x8*>(a);
        bf16x8 b1 = *reinterpret_cast<const bf16x8*>(a + 32 * 256);
        p0 = __builtin_amdgcn_mfma_f32_32x32x16_bf16(b0, qr[d0], p0, 0, 0, 0);
        p1 = __builtin_amdgcn_mfma_f32_32x32x16_bf16(b1, qr[d0], p1, 0, 0, 0); }
}
template <int VB>
__device__ __forceinline__ void pv_tile(f32x16* o, int vb0, bf16x8 pa0, bf16x8 pa1, bf16x8 pa2, bf16x8 pa3) {
#define TRRD(dst, off) asm volatile("ds_read_b64_tr_b16 %0, %1 offset:%2" : "=&v"(dst) : "v"(vb0), "i"(off) : "memory")
#define PV_D0(d0) do { s16x4 l0, l1, l2, l3, h0, h1, h2, h3; constexpr int b_ = VB * SHM_V + v_rd_off(d0, 0, 0); \
        TRRD(l0, b_); TRRD(h0, b_ + 2048); TRRD(l1, b_ + 4096); TRRD(h1, b_ + 6144); TRRD(l2, b_ + 8192); TRRD(h2, b_ + 10240); TRRD(l3, b_ + 12288); TRRD(h3, b_ + 14336); \
        asm volatile("s_waitcnt lgkmcnt(0)" ::: "memory"); SBAR();   \
        o[d0] = __builtin_amdgcn_mfma_f32_32x32x16_bf16(pa0, (bf16x8){l0[0], l0[1], l0[2], l0[3], h0[0], h0[1], h0[2], h0[3]}, o[d0], 0, 0, 0);   \
        o[d0] = __builtin_amdgcn_mfma_f32_32x32x16_bf16(pa1, (bf16x8){l1[0], l1[1], l1[2], l1[3], h1[0], h1[1], h1[2], h1[3]}, o[d0], 0, 0, 0);   \
        o[d0] = __builtin_amdgcn_mfma_f32_32x32x16_bf16(pa2, (bf16x8){l2[0], l2[1], l2[2], l2[3], h2[0], h2[1], h2[2], h2[3]}, o[d0], 0, 0, 0);   \
        o[d0] = __builtin_amdgcn_mfma_f32_32x32x16_bf16(pa3, (bf16x8){l3[0], l3[1], l3[2], l3[3], h3[0], h3[1], h3[2], h3[3]}, o[d0], 0, 0, 0); } while (0)
    PV_D0(0); PV_D0(1); PV_D0(2); PV_D0(3);
#undef PV_D0
#undef TRRD
}
struct BlockRef { const bf16* Q; const bf16* K; const bf16* V; float* O; int P0; int hm; };
struct Seam { bf16x8 qr[8]; bf16x8 st_v0, st_v1, st_k0, st_k1; };
#define ROW(p, k0, rr) ((p) + (size_t)((k0) + (rr)) * D + sc)
#define VMW() asm volatile("s_waitcnt vmcnt(0)" ::: "memory")
#define VMWN(n) asm volatile("s_waitcnt vmcnt(%0)" :: "i"(n) : "memory")
#define SLOAD_H(Kp, Vp, k0) do { S.st_v0 = load8(ROW(Vp, k0, sr)); S.st_v1 = load8(ROW(Vp, k0, 32 + sr));              \
                         S.st_k0 = load8(ROW(Kp, k0, sr)); S.st_k1 = load8(ROW(Kp, k0, 32 + sr)); } while (0)
#define SWRITE_HK(bf) do { *(bf16x8*)(K_lds + (bf) * SHM_K + kws) = S.st_k0; *(bf16x8*)(K_lds + (bf) * SHM_K + kws + 32 * 256) = S.st_k1; } while (0)
#define SWRITE_HV(bf) do { *(bf16x8*)(V_lds + (bf) * SHM_V + vst0) = S.st_v0; *(bf16x8*)(V_lds + (bf) * SHM_V + vst1) = S.st_v1; } while (0)
#define SWRITE_H(bf) do { SWRITE_HV(bf); SWRITE_HK(bf); } while (0)
__device__ __forceinline__ void attn_prime(const BlockRef& cur, char* lds, Seam& S) {
    const int tid = ltid(), wid = __builtin_amdgcn_readfirstlane(tid >> 6), lane = tid & 63, r32 = lane & 31, hi = lane >> 5;
    const int sr = tid >> 4, sc = (tid & 15) * 8, kws = KSWZ(sr, sc * 2); char* K_lds = lds + 2 * SHM_V;
    const int kb0 = 0;
    for (int d0 = 0; d0 < 8; ++d0) S.qr[d0] = load8(cur.Q + (size_t)(wid * QBLK + r32) * D + d0 * 16 + hi * 8);
    SLOAD_H(cur.K, cur.V, kb0); VMW(); SWRITE_HK(0);
    __syncthreads();
}
__device__ __forceinline__ void attn_block(const BlockRef& cur, const BlockRef& nxt, char* lds, Seam& S) {
    const int tid = ltid(), wid = __builtin_amdgcn_readfirstlane(tid >> 6), lane = tid & 63, r32 = lane & 31, hi = lane >> 5;
    const int j_lo = 0;
    const int j_hi = (cur.P0 + QB - 1) / KVBLK + 1;
    const int NT = j_hi - j_lo;
    const int kbn = 0;
    const int qlo = cur.P0 + wid * QBLK, qm = qlo + r32 - 4 * hi;
    char* V_lds = lds; char* K_lds = lds + 2 * SHM_V;
    float* ws = (float*)(lds + 2 * SHM_V + 2 * SHM_K) + wid * 64; float* li_l = ws, * al_l = ws + 32;
    const float* bt = (const float*)(lds + BT_OFF) + cur.hm * 256;
    float m_reg = -1e30f, l_reg = 0; f32x16 o[4] = {};
    const int sr = tid >> 4, sc = (tid & 15) * 8, vst0 = v_st(sr, sc), vst1 = v_st(32 + sr, sc), kws = KSWZ(sr, sc * 2);
    const int vb0 = (int)(uintptr_t)V_lds + v_rd_base(lane);
    const bf16* Kh = cur.K; const bf16* Vh = cur.V;
#define RESC(a) do { if (__any((a) < 1.f)) { if (hi == 0) al_l[r32] = (a); asm volatile("s_waitcnt lgkmcnt(0)" ::: "memory");              \
                     for (int d_ = 0; d_ < 4; ++d_) for (int r = 0; r < 16; ++r) o[d_][r] *= al_l[crow(r, hi)]; } } while (0)
#define KBASE(t) ((j_lo + (t)) * KVBLK)
#define MASKT(P0_, P1_, t) do { const int kb_ = KBASE(t); if (kb_ + KVBLK - 1 > qlo - 128) bias_mask_tile(P0_, P1_, qm - kb_, bt); } while (0)
    constexpr int NQL = 8;
#define SEAM_K0() do { VMWN(NQL); SWRITE_HK(0); SBAR(); } while (0)
    f32x16 pA0, pA1, pB0, pB1; float mnA, mnB, alA, alB; bf16x8 pa0, pa1, pa2, pa3;
    SWRITE_HV(0); SBAR();
    if (NT > 1) { SLOAD_H(Kh, Vh, KBASE(1)); }
    SBAR(); qkt<0>(pA0, pA1, K_lds, r32, hi, S.qr);
    MASKT(pA0, pA1, 0); partialSM(pA0, pA1, m_reg, mnA, alA);
    if (NT > 1) { VMW(); SWRITE_H(1); }
    __syncthreads();
#define HALF_STEP(PX0, PX1, mnX, alX, PY0, PY1, alY, t, KB, VB, SB) do {                                                      \
        SBAR(); qkt<KB>(PX0, PX1, K_lds, r32, hi, S.qr);                                             \
        finishSM(PY0, PY1, alY, l_reg, pa0, pa1, pa2, pa3); SBAR();                                                           \
        if ((t) + 1 < NT) { SLOAD_H(Kh, Vh, KBASE((t) + 1)); SBAR(); }                                               \
        pv_tile<VB>(o, vb0, pa0, pa1, pa2, pa3); MASKT(PX0, PX1, (t)); partialSM(PX0, PX1, m_reg, mnX, alX);                                        \
        __syncthreads();                                                                                                      \
        if ((t) + 1 < NT) { VMW(); SWRITE_H(SB); }                                                                          \
        RESC(alX); __syncthreads(); } while (0)
    for (int t = 1; t + 1 < NT; t += 2) {
        HALF_STEP(pB0, pB1, mnB, alB, pA0, pA1, alA, t, 1, 0, 0);
        HALF_STEP(pA0, pA1, mnA, alA, pB0, pB1, alB, t + 1, 0, 1, 1);
    }
    const bool even = (NT & 1) == 0;
    if (even) { SBAR(); qkt<1>(pB0, pB1, K_lds, r32, hi, S.qr); SBAR(); }
    SLOAD_H(nxt.K, nxt.V, kbn); SBAR();
#pragma unroll
    for (int d0 = 0; d0 < 8; ++d0) S.qr[d0] = load8(nxt.Q + (size_t)(wid * QBLK + r32) * D + d0 * 16 + hi * 8);
    SBAR();
    finishSM(pA0, pA1, alA, l_reg, pa0, pa1, pa2, pa3); SBAR();
    pv_tile<0>(o, vb0, pa0, pa1, pa2, pa3);
    if (even) { MASKT(pB0, pB1, NT - 1); partialSM(pB0, pB1, m_reg, mnB, alB); __syncthreads(); RESC(alB);
        finishSM(pB0, pB1, alB, l_reg, pa0, pa1, pa2, pa3); SBAR(); pv_tile<1>(o, vb0, pa0, pa1, pa2, pa3); }
    SBAR(); SEAM_K0();
    if (hi == 0) li_l[r32] = l_reg; asm volatile("s_waitcnt lgkmcnt(0)" ::: "memory");
    float rli[16];
#pragma unroll
    for (int r = 0; r < 16; ++r) rli[r] = __builtin_amdgcn_rcpf(li_l[crow(r, hi)]);
    float* Ow = cur.O + (size_t)(wid * QBLK) * D;
#pragma unroll
    for (int r = 0; r < 16; ++r) { const int orow = crow(r, hi);
#pragma unroll
        for (int d0 = 0; d0 < 4; ++d0) { const float v = o[d0][r] * rli[r]; Ow[(size_t)orow * D + d0 * 32 + r32] = v; } }
    __syncthreads();
#undef RESC
#undef KBASE
#undef MASKT
#undef SEAM_K0
#undef HALF_STEP
}
#undef ROW
#undef VMW
#undef VMWN
#undef SLOAD_H
#undef SWRITE_HK
#undef SWRITE_HV
#undef SWRITE_H
}

namespace att2 {
using att::bf16; using att::D; using att::SHM_K; using att::SHM_V;
constexpr int L_V = 0, L_K = 65536, L_P = 98304, L_AL = 131072, L_FL = 132096, L_LB = 132224, L_BT = 133120;
struct Blk { const bf16* Q; const bf16* K; const bf16* V0; const bf16* V1; float* O0; float* O1; int P0; int hm; };
__device__ __forceinline__ void qkt_rt(f32x16& p0, f32x16& p1, const char* Kb, int r32, int hi, const bf16x8* qr) {
    p0 = f32x16{}; p1 = f32x16{};
    const char* kb[4];
#pragma unroll
    for (int dd = 0; dd < 4; ++dd) kb[dd] = Kb + KSWZ(r32, (dd * 16 + hi * 8) * 2);
#pragma unroll
    for (int d0 = 0; d0 < 8; ++d0) { const char* a = kb[d0 & 3] + (d0 >> 2) * 128;
        bf16x8 b0 = *reinterpret_cast<const bf16x8*>(a);
        bf16x8 b1 = *reinterpret_cast<const bf16x8*>(a + 32 * 256);
        p0 = __builtin_amdgcn_mfma_f32_32x32x16_bf16(b0, qr[d0], p0, 0, 0, 0);
        p1 = __builtin_amdgcn_mfma_f32_32x32x16_bf16(b1, qr[d0], p1, 0, 0, 0); }
}
#define A2_LOADT(t) do { const size_t ro_ = (size_t)((t) * 64 + sr) * D + sc; \
        sk0 = att::load8(c.K + ro_); sk1 = att::load8(c.K + ro_ + 32 * D); sv00 = att::load8(c.V0 + ro_); sv01 = att::load8(c.V0 + ro_ + 32 * D); sv10 = att::load8(c.V1 + ro_); sv11 = att::load8(c.V1 + ro_ + 32 * D); } while (0)
#define A2_WRITET(buf) do { char* kd_ = lds + L_K + (buf) * SHM_K; char* vd_ = lds + L_V + (buf) * 2 * SHM_V; \
        *(bf16x8*)(kd_ + kws) = sk0; *(bf16x8*)(kd_ + kws + 32 * 256) = sk1; *(bf16x8*)(vd_ + vst0) = sv00; *(bf16x8*)(vd_ + vst1) = sv01; *(bf16x8*)(vd_ + SHM_V + vst0) = sv10; *(bf16x8*)(vd_ + SHM_V + vst1) = sv11; } while (0)
__device__ __forceinline__ void attn2_block(const Blk& c, char* lds) {
    const int tid = ltid(), wid = __builtin_amdgcn_readfirstlane(tid >> 6), lane = tid & 63, r32 = lane & 31, hi = lane >> 5;
    const int g = wid & 3;
    const int NT = (c.P0 + 127) / 64 + 1;
    const int sr = tid >> 4, sc = (tid & 15) * 8, kws = KSWZ(sr, sc * 2), vst0 = att::v_st(sr, sc), vst1 = att::v_st(32 + sr, sc);
    bf16x8 sk0, sk1, sv00, sv01, sv10, sv11;
    float* ALb = (float*)(lds + L_AL) + g * 64; unsigned* FLb = (unsigned*)(lds + L_FL) + g * 2; float* LBb = (float*)(lds + L_LB) + g * 32;
    char* Pb = lds + L_P + g * 8192;
    A2_LOADT(0);
    if (wid < 4) {
        bf16x8 qr[8];
#pragma unroll
        for (int d0 = 0; d0 < 8; ++d0) qr[d0] = att::load8(c.Q + (size_t)(g * 32 + r32) * D + d0 * 16 + hi * 8);
        asm volatile("s_waitcnt vmcnt(0)" ::: "memory"); A2_WRITET(0); __syncthreads();
        const int qlo = c.P0 + g * 32, qm = qlo + r32 - 4 * hi;
        const float* bt = (const float*)(lds + L_BT) + c.hm * 256;
        float m_reg = -1e30f, l_reg = 0.f;
        for (int s = 0; s <= NT; ++s) {
            const int par = s & 1;
            if (s + 1 < NT) A2_LOADT(s + 1);
            SBAR();
            if (s < NT) {
                f32x16 p0, p1; float mn, al; bf16x8 pa0, pa1, pa2, pa3;
                qkt_rt(p0, p1, lds + L_K + par * SHM_K, r32, hi, qr);
                const int kb_ = s * 64;
                if (kb_ + 63 > qlo - 128) att::bias_mask_tile(p0, p1, qm - kb_, bt);
                att::partialSM(p0, p1, m_reg, mn, al);
                att::finishSM(p0, p1, al, l_reg, pa0, pa1, pa2, pa3);
                char* pw = Pb + par * 4096 + lane * 16;
                *(bf16x8*)(pw) = pa0; *(bf16x8*)(pw + 1024) = pa1; *(bf16x8*)(pw + 2048) = pa2; *(bf16x8*)(pw + 3072) = pa3;
                if (hi == 0) ALb[par * 32 + r32] = al;
                const bool resc = __any(al < 1.f);
                if (lane == 0) FLb[par] = resc ? 1u : 0u;
            }
            __syncthreads();
            if (s + 1 < NT) { asm volatile("s_waitcnt vmcnt(0)" ::: "memory"); A2_WRITET((s + 1) & 1); }
            __syncthreads();
        }
        if (hi == 0) LBb[r32] = l_reg;
        __syncthreads();
        __syncthreads();
    } else {
        asm volatile("s_waitcnt vmcnt(0)" ::: "memory"); A2_WRITET(0); __syncthreads();
        f32x16 o[8];
#pragma unroll
        for (int d_ = 0; d_ < 8; ++d_) o[d_] = f32x16{};
        const int vbase = (int)(uintptr_t)(lds + L_V) + att::v_rd_base(lane);
        for (int s = 0; s <= NT; ++s) {
            if (s + 1 < NT) A2_LOADT(s + 1);
            SBAR();
            if (s >= 1) {
                const int par = (s - 1) & 1;
                const unsigned fl = (unsigned)__builtin_amdgcn_readfirstlane((int)FLb[par]);
                if (fl) {
#pragma unroll
                    for (int r = 0; r < 16; ++r) { const float a = ALb[par * 32 + att::crow(r, hi)];
#pragma unroll
                        for (int d_ = 0; d_ < 8; ++d_) o[d_][r] *= a; } }
                const char* pr = Pb + par * 4096 + lane * 16;
                const bf16x8 pa0 = *(const bf16x8*)(pr), pa1 = *(const bf16x8*)(pr + 1024), pa2 = *(const bf16x8*)(pr + 2048), pa3 = *(const bf16x8*)(pr + 3072);
                const int vb = vbase + par * 2 * SHM_V;
                att::pv_tile<0>(o, vb, pa0, pa1, pa2, pa3);
                att::pv_tile<0>(o + 4, vb + SHM_V, pa0, pa1, pa2, pa3);
            }
            __syncthreads();
            if (s + 1 < NT) { asm volatile("s_waitcnt vmcnt(0)" ::: "memory"); A2_WRITET((s + 1) & 1); }
            __syncthreads();
        }
        __syncthreads();
        float rli[16];
#pragma unroll
        for (int r = 0; r < 16; ++r) rli[r] = __builtin_amdgcn_rcpf(LBb[att::crow(r, hi)]);
#pragma unroll
        for (int hf = 0; hf < 2; ++hf) { float* Ow = (hf ? c.O1 : c.O0) + (size_t)(g * 32) * D;
#pragma unroll
            for (int r = 0; r < 16; ++r) { const int orow = att::crow(r, hi);
#pragma unroll
                for (int d0 = 0; d0 < 4; ++d0) Ow[(size_t)orow * D + d0 * 32 + r32] = o[hf * 4 + d0][r] * rli[r]; } }
        __syncthreads();
    }
}
#undef A2_LOADT
#undef A2_WRITET
}


#define XB_TMO      128
#define XB_XCNT(j)  (256  + 64 * (j))
#define XB_XSUB(j)  (1280 + 64 * (j))
#define XB_XGEN(j)  (2304 + 64 * (j))
#define XB_TOP      3328
#define XB_TOPGEN   3392
#define XCD_BAR_WORDS 3456
#define XB_SPIN_CAP (1u << 18)
__device__ __forceinline__ unsigned xb_ld(unsigned* p)              { return __hip_atomic_load(p, __ATOMIC_RELAXED, __HIP_MEMORY_SCOPE_AGENT); }
__device__ __forceinline__ unsigned xb_add(unsigned* p, unsigned v) { return __hip_atomic_fetch_add(p, v, __ATOMIC_RELAXED, __HIP_MEMORY_SCOPE_AGENT); }
__device__ __forceinline__ unsigned xb_xcc_id() { return (unsigned)__builtin_amdgcn_s_getreg((3 << 11) | 20) & 0xFu; }
#define XB_SPIN(cond, bar) do { unsigned _sp = 0; while (cond) { __builtin_amdgcn_s_sleep(1); \
    if ((++_sp & 255u) == 0u) { if (xb_ld(&(bar)[XB_TMO])) break; if (_sp > XB_SPIN_CAP) { atomicAdd(&(bar)[XB_TMO], 1u); break; } } } } while (0)
struct XcdBarrier { unsigned* bar; unsigned x; volatile LAS unsigned* st; };
__device__ __forceinline__ XcdBarrier xcd_barrier_post(unsigned* bar, volatile LAS unsigned* st) {
    XcdBarrier b; b.bar = bar; b.x = xb_xcc_id(); b.st = st;
    if (threadIdx.x == 0) (void)xb_add(&bar[XB_XCNT(b.x)], 1u);
    return b;
}
__device__ __forceinline__ void xcd_barrier_complete(unsigned* bar, unsigned x, unsigned& nloc, unsigned& nx) {
    const unsigned G = gridDim.x * gridDim.y * gridDim.z;
    unsigned sum, cnt, mine, sp = 0u;
    for (;;) {
        sum = 0u; cnt = 0u; mine = 0u;
#pragma unroll
        for (unsigned j = 0; j < 16; ++j) { const unsigned c = xb_ld(&bar[XB_XCNT(j)]); sum += c; cnt += (c > 0u) ? 1u : 0u; mine = (j == x) ? c : mine; }
        if (sum == G) break;
        __builtin_amdgcn_s_sleep(1);
        if ((++sp & 255u) == 0u) { if (xb_ld(&bar[XB_TMO])) break; if (sp > XB_SPIN_CAP) { atomicAdd(&bar[XB_TMO], 1u); break; } }
    }
    nloc = mine > 0u ? mine : 1u; nx = cnt > 0u ? cnt : 1u;
}
__device__ __forceinline__ void xcd_barrier(const XcdBarrier& b) {
    asm volatile("s_waitcnt vmcnt(0)" ::: "memory");
    __syncthreads();
    if (threadIdx.x == 0) {
        unsigned* bar = b.bar;
        __builtin_amdgcn_s_waitcnt(0);
        unsigned nloc = b.st[0], nx = b.st[1];
        if (nloc == 0u) { xcd_barrier_complete(bar, b.x, nloc, nx); b.st[0] = nloc; b.st[1] = nx; }
        const unsigned old = xb_add(&bar[XB_XSUB(b.x)], 1u);
        const unsigned gen = old / nloc;
        if (old + 1u == (gen + 1u) * nloc) {
            __builtin_amdgcn_fence(__ATOMIC_RELEASE, "agent");
            asm volatile("s_waitcnt vmcnt(0)" ::: "memory");
            const unsigned og = xb_add(&bar[XB_TOP], 1u);
            const unsigned tg = og / nx;
            if (og + 1u == (tg + 1u) * nx) xb_add(&bar[XB_TOPGEN], 1u);
            else XB_SPIN(xb_ld(&bar[XB_TOPGEN]) == tg, bar);
            __builtin_amdgcn_fence(__ATOMIC_ACQUIRE, "agent");
            xb_add(&bar[XB_XGEN(b.x)], 1u);
            asm volatile("s_waitcnt vmcnt(0)" ::: "memory");
        } else {
            XB_SPIN(xb_ld(&bar[XB_XGEN(b.x)]) == gen, bar);
            __builtin_amdgcn_fence(__ATOMIC_ACQUIRE, "agent");
            asm volatile("s_waitcnt vmcnt(0)" ::: "memory");
        }
    }
    __syncthreads();
}

struct Args { const float* in[24]; float* out; unsigned char* ws; };

__device__ __forceinline__ void p0_transpose_item(const float* W, int K, int N, bf16_t* WT, int swiglu, const float* gk, const float* bk, float* c1, float* c2, LAS float* scr, int item, int lane) {
    const int nblk = N / 64, kb = item / nblk, nb = item % nblk, k0 = 64 * kb, n0 = 64 * nb;
    const float* src = W + (size_t)(k0 + (lane >> 4)) * N + n0 + (lane & 15) * 4;
    f32x4 v[16];
#pragma unroll
    for (int i = 0; i < 16; ++i) v[i] = __builtin_nontemporal_load((const f32x4*)(src + (size_t)(4 * i) * N));
#pragma unroll
    for (int i = 0; i < 16; ++i) { LAS float* d = scr + (4 * i + (lane >> 4)) * 65 + (lane & 15) * 4; d[0] = v[i][0]; d[1] = v[i][1]; d[2] = v[i][2]; d[3] = v[i][3]; }
    asm volatile("s_waitcnt lgkmcnt(0)" ::: "memory");
    int r0 = n0;
    if (swiglu) { const int half = n0 / DFF, idx = n0 % DFF; r0 = 256 * (idx / 128) + 128 * half + (idx % 128); }
    const int c = lane & 7;
    float g8[8], b8[8];
#pragma unroll
    for (int e = 0; e < 8; ++e) { g8[e] = gk ? gk[k0 + 8 * c + e] : 1.f; b8[e] = gk ? bk[k0 + 8 * c + e] : 0.f; }
#pragma unroll
    for (int j = 0; j < 8; ++j) { const int n = (lane >> 3) + 8 * j; const LAS float* q = scr + (8 * c) * 65 + n;
        float w8[8];
#pragma unroll
        for (int e = 0; e < 8; ++e) w8[e] = q[e * 65];
        u32x4 o; o.x = cvt_pk_bf16(w8[0] * g8[0], w8[1] * g8[1]); o.y = cvt_pk_bf16(w8[2] * g8[2], w8[3] * g8[3]); o.z = cvt_pk_bf16(w8[4] * g8[4], w8[5] * g8[5]); o.w = cvt_pk_bf16(w8[6] * g8[6], w8[7] * g8[7]);
        *(u32x4*)(WT + (size_t)(r0 + n) * K + k0 + 8 * c) = o;
        if (gk) {
            float s1 = ((bf_lo(o.x) + bf_hi(o.x)) + (bf_lo(o.y) + bf_hi(o.y))) + ((bf_lo(o.z) + bf_hi(o.z)) + (bf_lo(o.w) + bf_hi(o.w)));
            float s2 = ((w8[0] * b8[0] + w8[1] * b8[1]) + (w8[2] * b8[2] + w8[3] * b8[3])) + ((w8[4] * b8[4] + w8[5] * b8[5]) + (w8[6] * b8[6] + w8[7] * b8[7]));
            s1 += __shfl_xor(s1, 1); s1 += __shfl_xor(s1, 2); s1 += __shfl_xor(s1, 4); s2 += __shfl_xor(s2, 1); s2 += __shfl_xor(s2, 2); s2 += __shfl_xor(s2, 4);
            if (c == 0) { unsafeAtomicAdd(c1 + r0 + n, s1); unsafeAtomicAdd(c2 + r0 + n, s2); }
        } }
    asm volatile("s_waitcnt lgkmcnt(0)" ::: "memory");
}

__device__ __forceinline__ void p0_wq_item(const float* W, bf16_t* WN, const float* gk, const float* bk, float* bW, int item, int lane) {
    const int kb = item >> 5, jb = item & 31, k0 = 64 * kb, j0 = 64 * jb, cg8 = lane & 7, kr = lane >> 3;
    float sacc[8];
#pragma unroll
    for (int e = 0; e < 8; ++e) sacc[e] = 0.f;
#pragma unroll
    for (int i = 0; i < 8; ++i) { const int k = k0 + 8 * i + kr; const float* src = W + (size_t)k * DM + j0 + 8 * cg8;
        const f32x4 v0 = __builtin_nontemporal_load((const f32x4*)src), v1 = __builtin_nontemporal_load((const f32x4*)(src + 4)); const float g = gk[k], bb = bk[k];
        u32x4 o; o.x = cvt_pk_bf16(v0[0] * g, v0[1] * g); o.y = cvt_pk_bf16(v0[2] * g, v0[3] * g); o.z = cvt_pk_bf16(v1[0] * g, v1[1] * g); o.w = cvt_pk_bf16(v1[2] * g, v1[3] * g);
        *(u32x4*)(WN + (size_t)k * DM + j0 + 8 * cg8) = o;
#pragma unroll
        for (int e = 0; e < 4; ++e) { sacc[e] += bb * v0[e]; sacc[4 + e] += bb * v1[e]; } }
#pragma unroll
    for (int e = 0; e < 8; ++e) { float v = sacc[e]; v += __shfl_xor(v, 8); v += __shfl_xor(v, 16); v += __shfl_xor(v, 32); if (kr == 0) unsafeAtomicAdd(bW + j0 + 8 * cg8 + e, v); }
}

__device__ __forceinline__ int causal_bucket(int n) {
    if (n < 16) return n;
    const float nf = (float)n;
    int large = 16 + (int)(logf(nf / 16.f) / 2.0794415416798357f * 16.f);
    return large < 31 ? large : 31;
}

__device__ __forceinline__ size_t zero_opaque() { size_t z = 0; asm volatile("" : "+s"(z)); return z; }
__device__ __forceinline__ const float* inp_ptr(const Args& a, int k) { return a.in[k] + zero_opaque(); }
#define INP(k) inp_ptr(a, k)
__device__ __forceinline__ unsigned char* ws_opaque(const Args& a) { return a.ws + zero_opaque(); }
__device__ __forceinline__ float* out_opaque(const Args& a) { return a.out + zero_opaque(); }
#define WSP(type, off) ((type*)(ws_opaque(a) + (off)))
__global__ void __launch_bounds__(NTHR, 2) mega_fwd(Args a) {
    extern __shared__ __attribute__((aligned(16))) unsigned char lds[];
    volatile LAS unsigned* bst = (volatile LAS unsigned*)((LAS unsigned char*)lds + LDS_BYTES - 64);
    if (threadIdx.x == 0) { bst[0] = 0u; bst[1] = 0u; }
    __syncthreads();
    (void)xcd_barrier_post((unsigned*)(a.ws + WS_BAR), bst);
#define GRID_BAR() do { XcdBarrier xb_; xb_.bar = (unsigned*)(ws_opaque(a) + WS_BAR); unsigned x_ = xb_xcc_id(); asm volatile("" : "+s"(x_)); xb_.x = x_; xb_.st = bst; xcd_barrier(xb_); } while (0)
    const int G = gridDim.x;
    const int NGW = G * NWAVES, NGT = G * NTHR;
    {
        PH_IDS;
        unsigned char* ws = ws_opaque(a);
        float* lamp = (float*)(ws + WS_LAM); float* btab = (float*)(ws + WS_BTAB); bf16_t* wtril = (bf16_t*)(ws + WS_WTRIL); bf16_t* membf = (bf16_t*)(ws + WS_MEMBF); bf16_t* XN = (bf16_t*)(ws + WS_XN);
        LAS float* scr = (LAS float*)((LAS unsigned char*)lds + wave * 17408);
        constexpr int I_IN = 32 * 88, I_SQ = 32 * 32, I_KV = 32 * 64, I_GU = 32 * 176, I_D = 88 * 32;
        constexpr int PER_LAYER = I_IN + 3 * I_SQ + I_KV + I_GU + I_D;
        for (int it = gw; it < 2 * PER_LAYER; it += NGW) {
            const int l = it / PER_LAYER; int r = it % PER_LAYER;
            unsigned char* wl = ws + WS_W + (size_t)l * W_LAYER;
            float* cl = (float*)(ws + WS_C) + (size_t)l * C_LAYER;
            if (r < I_IN) { const bool f = l > 0;
                p0_transpose_item(INP(3) + (size_t)l * DM * INC, DM, INC, (bf16_t*)(wl + W_IN), 0, f ? INP(22) : nullptr, f ? INP(23) : nullptr, cl + C_IN, cl + C_IN + INC, scr, r, lane); continue; } r -= I_IN;
            if (r < I_SQ) { p0_transpose_item(INP(12) + (size_t)l * DM * DM, DM, DM, (bf16_t*)(wl + W_OUT), 0, nullptr, nullptr, nullptr, nullptr, scr, r, lane); continue; } r -= I_SQ;
            if (r < I_SQ) { p0_wq_item(INP(15) + (size_t)l * DM * DM, (bf16_t*)(wl + W_Q), INP(13) + (size_t)l * DM, INP(14) + (size_t)l * DM, cl + C_Q + DM, r, lane); continue; } r -= I_SQ;
            if (r < I_KV) { p0_transpose_item(INP(16) + (size_t)l * DM * 2 * DM, DM, 2 * DM, (bf16_t*)(wl + W_KV), 0, nullptr, nullptr, nullptr, nullptr, scr, r, lane); continue; } r -= I_KV;
            if (r < I_SQ) { p0_transpose_item(INP(17) + (size_t)l * DM * DM, DM, DM, (bf16_t*)(wl + W_O), 0, nullptr, nullptr, nullptr, nullptr, scr, r, lane); continue; } r -= I_SQ;
            if (r < I_GU) { p0_transpose_item(INP(20) + (size_t)l * DM * 2 * DFF, DM, 2 * DFF, (bf16_t*)(wl + W_GU), 1, INP(18) + (size_t)l * DM, INP(19) + (size_t)l * DM, cl + C_GU, cl + C_GU + 2 * DFF, scr, r, lane); continue; } r -= I_GU;
            p0_transpose_item(INP(21) + (size_t)l * DFF * DM, DFF, DM, (bf16_t*)(wl + W_D), 0, nullptr, nullptr, nullptr, nullptr, scr, r, lane);
        }
        for (size_t i = gt; i < (size_t)T * DM / 8; i += NGT) {
            const f32x4 v0 = *(const f32x4*)(INP(0) + i * 8), v1 = *(const f32x4*)(INP(0) + i * 8 + 4);
            u32x4 w; w.x = cvt_pk_bf16(v0[0], v0[1]); w.y = cvt_pk_bf16(v0[2], v0[3]); w.z = cvt_pk_bf16(v1[0], v1[1]); w.w = cvt_pk_bf16(v1[2], v1[3]);
            *(u32x4*)(XN + i * 8) = w;
        }
        for (size_t i = gt; i < (size_t)BATCH * NMEM * DM / 8; i += NGT) {
            const f32x4 v0 = *(const f32x4*)(INP(1) + i * 8), v1 = *(const f32x4*)(INP(1) + i * 8 + 4);
            u32x4 w; w.x = cvt_pk_bf16(v0[0], v0[1]); w.y = cvt_pk_bf16(v0[2], v0[3]); w.z = cvt_pk_bf16(v1[0], v1[1]); w.w = cvt_pk_bf16(v1[2], v1[3]);
            *(u32x4*)(membf + i * 8) = w;
        }
        for (int i = gt; i < DEPTH * 4 * 128 * 128; i += NGT) { const int s = i & 127, t = (i >> 7) & 127; wtril[i] = s <= t ? f2bf(INP(7)[i]) : (bf16_t)0; }
        if (gt < 8 * 256) { const int hm = gt >> 8, d = gt & 255; const float* rb = INP(2);
            btab[gt] = (rb[causal_bucket(d) * 8 + hm] - rb[31 * 8 + hm]) * (1.f / att::SCALE); }
        if (cu == 0 && wave == 0) {
            for (int l = 0; l < DEPTH; ++l) {
                const float* lq = INP(9) + l * 256; const float* lk = INP(10) + l * 256;
                float s0 = lq[lane] * lk[lane] + lq[lane + 64] * lk[lane + 64];
                float s1 = lq[128 + lane] * lk[128 + lane] + lq[192 + lane] * lk[192 + lane];
                s0 = wave_sum(s0); s1 = wave_sum(s1);
                const float lam_init = 0.8f - 0.6f * expf(-0.3f * (float)l);
                if (lane == 0) lamp[l] = expf(s0) - expf(s1) + lam_init;
            }
        }
    }
    GRID_BAR();

#pragma unroll 1
    for (int l = 0; l < DEPTH; ++l) {
        {
            unsigned char* ws = ws_opaque(a);
            pg8::Gemm g{(const bf16_t*)(ws + WS_XN), (const bf16_t*)(ws + WS_W + (size_t)l * W_LAYER + W_IN), DM, DM, DM, 1, 0, 0, 0, 0};
            pg8::Order S; S.init(T, INC, 1, G, cu_opaque());
            const float* cl = (const float*)(ws + WS_C) + (size_t)l * C_LAYER;
            const float* st = l > 0 ? (const float*)(ws + WS_ST) + (size_t)(3 * l - 1) * T * 2 : nullptr;
            pg8::EpiSplit E{(bf16_t*)(ws + WS_PROJ), st, cl + C_IN, cl + C_IN + INC, (float*)(ws + WS_ST) + (size_t)(6 + l) * T * 2};
            pg8::gemm_phase<pg8::EpiSplit, true>((LAS unsigned char*)lds, g, S, E);
        }
        if (l == 0) {
            {
                unsigned char* ws = ws_opaque(a);
                pg8::Gemm g{(const bf16_t*)(ws + WS_MEMBF), (const bf16_t*)(ws + WS_W + W_KV), DM, DM, DM, 1, 0, 0, (long)(W_LAYER / 2), 0};
                pg8::Order S; const int cu = cu_opaque(); S.init(BATCH * NMEM, 2 * DM, 2, G, cu >= 128 && cu < 192 ? cu - 128 : -1);
                pg8::EpiBf16 E{(bf16_t*)(ws + WS_KV), 2 * DM, 1, (long)(BATCH * NMEM) * 2 * DM, 0, 1.f, nullptr, nullptr, nullptr, nullptr};
                pg8::gemm_phase<pg8::EpiBf16, true>((LAS unsigned char*)lds, g, S, E);
            }
        }
        GRID_BAR();

        if (l == 0) {
#pragma unroll 1
            for (int L2 = 0; L2 < DEPTH; ++L2) {
                {
                    unsigned char* ws = ws_opaque(a); unsigned char* wl2 = ws + WS_W + (size_t)L2 * W_LAYER;
                    const bf16_t* KVl = (const bf16_t*)(ws + WS_KV) + (size_t)L2 * BATCH * NMEM * 2 * DM;
                    float* cl = (float*)(ws + WS_C) + (size_t)L2 * C_LAYER;
                    pg8::Gemm g{KVl, (const bf16_t*)(wl2 + W_Q), 2 * DM, DM, 512, 4, (long)NMEM * 2 * DM, 512, 0, 512};
                    pg8::Order S; const int cu = cu_opaque(); S.init(NMEM, DM, 8, G, cu >= 64 * L2 && cu < 64 * L2 + 64 ? cu - 64 * L2 : -1);
                    pg8::EpiBf16 E{(bf16_t*)(wl2 + W_KV), DM, 1, (long)NMEM * DM, 0, 1.f, nullptr, nullptr, nullptr, cl + C_Q};
                    pg8::gemm_phase<pg8::EpiBf16, true>((LAS unsigned char*)lds, g, S, E);
                }
                {
                    unsigned char* ws = ws_opaque(a); unsigned char* wl2 = ws + WS_W + (size_t)L2 * W_LAYER;
                    const bf16_t* KVl = (const bf16_t*)(ws + WS_KV) + (size_t)L2 * BATCH * NMEM * 2 * DM;
                    pg8::Gemm g{(const bf16_t*)(wl2 + W_O), KVl + DM, DM, 2 * DM, 512, 4, 0, 512, (long)NMEM * 2 * DM, 512};
                    pg8::Order S; const int cu = cu_opaque(); S.init(DM, NMEM, 8, G, cu >= 128 + 64 * L2 && cu < 192 + 64 * L2 ? cu - 128 - 64 * L2 : -1);
                    pg8::EpiBf16 E{(bf16_t*)(wl2 + W_KV + 8 * MiB), 1024, 4, (long)DM * 1024, 256, 1.f, nullptr, nullptr, nullptr, nullptr};
                    pg8::gemm_phase<pg8::EpiBf16, true>((LAS unsigned char*)lds, g, S, E);
                }
            }
            {
                PH_IDS;
                unsigned char* ws = ws_opaque(a);
                for (int it = gw; it < DEPTH * 2048; it += NGW) {
                    const int L2 = it >> 11, r = it & 2047, b = r >> 10, h = (r >> 8) & 3, n = r & 255;
                    const bf16_t* kp = (const bf16_t*)(ws + WS_KV) + ((size_t)L2 * BATCH * NMEM + b * NMEM + n) * 2 * DM + h * 512 + 8 * lane;
                    float* cl = (float*)(ws + WS_C) + (size_t)L2 * C_LAYER;
                    const float* bw = cl + C_Q + DM + h * 512 + 8 * lane;
                    const u32x4 kw = *(const u32x4*)kp; const f32x4 b0 = *(const f32x4*)bw, b1 = *(const f32x4*)(bw + 4);
                    float d = (bf_lo(kw.x) * b0[0] + bf_hi(kw.x) * b0[1]) + (bf_lo(kw.y) * b0[2] + bf_hi(kw.y) * b0[3]) + (bf_lo(kw.z) * b1[0] + bf_hi(kw.z) * b1[1]) + (bf_lo(kw.w) * b1[2] + bf_hi(kw.w) * b1[3]);
                    d = wave_sum(d);
                    if (lane == 0) cl[C_QK2 + r] = d;
                }
            }
            __syncthreads();
        }
        {
            PH_IDS;
            bf16_t* PB = WSP(bf16_t, WS_PROJ); bf16_t* Y = WSP(bf16_t, WS_Y);
            const float* cw = INP(4) + (size_t)l * 3 * 512;
            const int cg8 = tid & 63, c0 = cg8 * 8, gi = cg8 >> 4, cc = c0 & 127;
            float k0[8], k1[8], k2[8];
#pragma unroll
            for (int e = 0; e < 8; ++e) { k0[e] = cw[c0 + e]; k1[e] = cw[512 + c0 + e]; k2[e] = cw[1024 + c0 + e]; }
            for (int r = gt >> 6; r < T; r += NGT >> 6) {
                const int t = r & (SEQ - 1);
                const bf16_t* pb = PB + ((size_t)(0 + gi) * T + r) * 128 + cc;
                const bf16_t* pc = PB + ((size_t)(4 + gi) * T + r) * 128 + cc;
                const bf16_t* ph = PB + ((size_t)(8 + gi) * T + r) * 128 + cc;
                const u32x4 wb = *(const u32x4*)pb, wc0 = *(const u32x4*)pc, wh0 = *(const u32x4*)ph;
                u32x4 wc1 = {0, 0, 0, 0}, wh1 = {0, 0, 0, 0}, wc2 = {0, 0, 0, 0}, wh2 = {0, 0, 0, 0};
                if (t >= 1) { wc1 = *(const u32x4*)(pc - 128); wh1 = *(const u32x4*)(ph - 128); }
                if (t >= 2) { wc2 = *(const u32x4*)(pc - 256); wh2 = *(const u32x4*)(ph - 256); }
                float y[8];
#pragma unroll
                for (int j = 0; j < 4; ++j) {
                    const float z0a = bf_lo(wc0[j]) * bf_lo(wh0[j]), z1a = bf_lo(wc1[j]) * bf_lo(wh1[j]), z2a = bf_lo(wc2[j]) * bf_lo(wh2[j]);
                    const float z0b = bf_hi(wc0[j]) * bf_hi(wh0[j]), z1b = bf_hi(wc1[j]) * bf_hi(wh1[j]), z2b = bf_hi(wc2[j]) * bf_hi(wh2[j]);
                    y[2 * j] = bf_lo(wb[j]) * (k0[2 * j] * z2a + k1[2 * j] * z1a + k2[2 * j] * z0a);
                    y[2 * j + 1] = bf_hi(wb[j]) * (k0[2 * j + 1] * z2b + k1[2 * j + 1] * z1b + k2[2 * j + 1] * z0b);
                }
                u32x4 w; w.x = cvt_pk_bf16(y[0], y[1]); w.y = cvt_pk_bf16(y[2], y[3]); w.z = cvt_pk_bf16(y[4], y[5]); w.w = cvt_pk_bf16(y[6], y[7]);
                *(u32x4*)(Y + (size_t)r * DM + c0) = w;
            }
        }
        {
            PH_IDS;
            bf16_t* PB = WSP(bf16_t, WS_PROJ); bf16_t* Y = WSP(bf16_t, WS_Y); bf16_t* wtril = WSP(bf16_t, WS_WTRIL);
            float* st = (float*)(lds + 40960);
            bf16_t* vT = (bf16_t*)lds;
            const float* lng = INP(5) + (size_t)l * 512; const float* lnb = INP(6) + (size_t)l * 512;
            const float* bs = INP(8) + (size_t)l * 512;
            const float* gstat = WSP(float, WS_ST) + (size_t)(6 + l) * T * 2;
            float* svL = (float*)(lds + 49152);
            for (int un = cu; un < (T / 128) * 4; un += G) {
                const int ch = un >> 2, gi = un & 3, r0 = ch * 128;
                if (tid < 128) {
                    const float s1 = gstat[2 * (r0 + tid)], s2 = gstat[2 * (r0 + tid) + 1];
                    const float mean = s1 * (1.f / 512.f), var = fmaxf(s2 * (1.f / 512.f) - mean * mean, 0.f);
                    st[2 * tid] = mean; st[2 * tid + 1] = rsqrtf(var + LN_EPS); }
                __syncthreads();
                {
                    const int tok = tid >> 2, cq = (tid & 3) * 32; const float mean = st[2 * tok], rstd = st[2 * tok + 1];
                    const bf16_t* vp = PB + ((size_t)(16 + gi) * T + r0 + tok) * 128 + cq;
#pragma unroll
                    for (int i = 0; i < 4; ++i) { const u32x4 w = *(const u32x4*)(vp + 8 * i);
#pragma unroll
                        for (int j = 0; j < 4; ++j) { const int c = cq + 8 * i + 2 * j;
                            const float x0 = gelu_tanh(bf_lo(w[j])), x1 = gelu_tanh(bf_hi(w[j]));
                            vT[c * 136 + tok] = f2bf((x0 - mean) * rstd * lng[gi * 128 + c] + lnb[gi * 128 + c]);
                            vT[(c + 1) * 136 + tok] = f2bf((x1 - mean) * rstd * lng[gi * 128 + c + 1] + lnb[gi * 128 + c + 1]); } }
                }
                __syncthreads();
                {
                    f32x4 acc[8];
#pragma unroll
                    for (int ct = 0; ct < 8; ++ct) acc[ct] = (f32x4){0.f, 0.f, 0.f, 0.f};
                    const bf16_t* wrow = wtril + ((size_t)(l * 4 + gi) * 128 + 16 * wave + (lane & 15)) * 128 + 8 * (lane >> 4);
#pragma unroll
                    for (int kk = 0; kk < 4; ++kk) { const bf16x8 av = *(const bf16x8*)(wrow + kk * 32);
#pragma unroll
                        for (int ct = 0; ct < 8; ++ct) { const bf16x8 bv = *(const bf16x8*)(vT + (ct * 16 + (lane & 15)) * 136 + kk * 32 + 8 * (lane >> 4));
                            acc[ct] = __builtin_amdgcn_mfma_f32_16x16x32_bf16(av, bv, acc[ct], 0, 0, 0); } }
#pragma unroll
                    for (int j = 0; j < 4; ++j) { const int t = 16 * wave + 4 * (lane >> 4) + j; const float bt = bs[gi * 128 + t];
#pragma unroll
                        for (int ct = 0; ct < 8; ++ct) svL[t * 132 + ct * 16 + (lane & 15)] = acc[ct][j] + bt; }
                }
                __syncthreads();
                {
                    const int c0 = (tid & 15) * 8;
#pragma unroll
                    for (int i = 0; i < 4; ++i) { const int t = 32 * i + (tid >> 4);
                        const u32x4 uw = *(const u32x4*)(PB + ((size_t)(12 + gi) * T + r0 + t) * 128 + c0);
                        const f32x4 s0 = *(const f32x4*)(svL + t * 132 + c0), s1 = *(const f32x4*)(svL + t * 132 + c0 + 4);
                        u32x4 w; w.x = cvt_pk_bf16(gelu_tanh(bf_lo(uw.x)) * s0[0], gelu_tanh(bf_hi(uw.x)) * s0[1]); w.y = cvt_pk_bf16(gelu_tanh(bf_lo(uw.y)) * s0[2], gelu_tanh(bf_hi(uw.y)) * s0[3]);
                        w.z = cvt_pk_bf16(gelu_tanh(bf_lo(uw.z)) * s1[0], gelu_tanh(bf_hi(uw.z)) * s1[1]); w.w = cvt_pk_bf16(gelu_tanh(bf_lo(uw.w)) * s1[2], gelu_tanh(bf_hi(uw.w)) * s1[3]);
                        *(u32x4*)(Y + (size_t)(r0 + t) * DM + 512 + gi * 128 + c0) = w; }
                }
                __syncthreads();
            }
        }
        {
            PH_IDS;
            bf16_t* PB = WSP(bf16_t, WS_PROJ); float* OATT = WSP(float, WS_R1); float* btab = WSP(float, WS_BTAB);
            float* btl = (float*)(lds + att2::L_BT);
            for (int i = tid; i < 8 * 256; i += NTHR) btl[i] = btab[i];
            __syncthreads();
            const att::bf16* PBb = (const att::bf16*)PB;
#pragma unroll 1
            for (int L = cu; L < 512; L += G) {
                const int k_ = L >> 3, hm = L & 7, b = k_ >> 5, x = k_ & 31, h = hm >> 1;
#pragma unroll 1
                for (int pass = 0; pass < 2; ++pass) {
                    const int qb = pass ? 63 - x : x;
                    att2::Blk c;
                    c.Q = PBb + ((size_t)(20 + hm) * T + (size_t)b * SEQ + qb * 128) * 128; c.K = PBb + ((size_t)(28 + hm) * T + (size_t)b * SEQ) * 128;
                    c.V0 = PBb + ((size_t)(36 + h * 2) * T + (size_t)b * SEQ) * 128; c.V1 = PBb + ((size_t)(37 + h * 2) * T + (size_t)b * SEQ) * 128;
                    c.O0 = OATT + ((size_t)((b * 8 + hm) * 2 + 0) * SEQ + qb * 128) * 128; c.O1 = OATT + ((size_t)((b * 8 + hm) * 2 + 1) * SEQ + qb * 128) * 128;
                    c.P0 = qb * 128; c.hm = hm;
                    att2::attn2_block(c, (char*)lds);
                }
            }
        }
        GRID_BAR();

        {
            PH_IDS;
            float* OATT = WSP(float, WS_R1); bf16_t* Y = WSP(bf16_t, WS_Y); float* lamp = WSP(float, WS_LAM);
            const float lam_init = 0.8f - 0.6f * expf(-0.3f * (float)l);
            const float lam = lamp[l]; const float* sg = INP(11) + (size_t)l * 256;
            const f32x4 gv = *(const f32x4*)(sg + 4 * lane);
            for (int it = gw; it < T * 4; it += NGW) {
                const int r = it >> 2, h = it & 3, b = r >> 13, t = r & (SEQ - 1);
                const int half = lane >> 5, e = (lane & 31) * 4;
                const size_t i0 = ((size_t)(((b * 4 + h) * 2 + 0) * 2 + half) * SEQ + t) * 128 + e;
                const size_t i1 = ((size_t)(((b * 4 + h) * 2 + 1) * 2 + half) * SEQ + t) * 128 + e;
                const f32x4 o0 = *(const f32x4*)(OATT + i0), o1 = *(const f32x4*)(OATT + i1);
                const f32x4 d = o0 - o1 * lam;
                const float ss = wave_sum(d[0] * d[0] + d[1] * d[1] + d[2] * d[2] + d[3] * d[3]);
                const float sc = rsqrtf(ss * (1.f / 256.f) + LN_EPS) * (1.f - lam_init);
                u32x2 w; w.x = cvt_pk_bf16(d[0] * sc * gv[0], d[1] * sc * gv[1]); w.y = cvt_pk_bf16(d[2] * sc * gv[2], d[3] * sc * gv[3]);
                *(u32x2*)(Y + (size_t)r * DM + 1024 + h * 256 + 4 * lane) = w;
            }
        }
        GRID_BAR();

#define LN_OUT_PASS(gam, bet) do { PH_IDS; float* X = out_opaque(a); const bf16_t* ZB = WSP(bf16_t, WS_XN); \
            for (int r = gw; r < T; r += NGW) { const bf16_t* zr = ZB + (size_t)r * DM; float* xr = X + (size_t)r * DM; f32x4 v[8]; float s = 0.f; \
                _Pragma("unroll") for (int j = 0; j < 4; ++j) { const u32x4 w = *(const u32x4*)(zr + 8 * lane + 512 * j); \
                    v[2 * j] = (f32x4){bf_lo(w.x), bf_hi(w.x), bf_lo(w.y), bf_hi(w.y)}; v[2 * j + 1] = (f32x4){bf_lo(w.z), bf_hi(w.z), bf_lo(w.w), bf_hi(w.w)}; } \
                _Pragma("unroll") for (int j = 0; j < 8; ++j) s += (v[j][0] + v[j][1]) + (v[j][2] + v[j][3]); \
                const float mean = wave_sum(s) * (1.f / DM); float s2 = 0.f; \
                _Pragma("unroll") for (int j = 0; j < 8; ++j) { v[j] = v[j] - mean; s2 += (v[j][0] * v[j][0] + v[j][1] * v[j][1]) + (v[j][2] * v[j][2] + v[j][3] * v[j][3]); } \
                const float rstd = rsqrtf(wave_sum(s2) * (1.f / DM) + LN_EPS); \
                _Pragma("unroll") for (int j = 0; j < 8; ++j) { const int c = 8 * lane + 512 * (j >> 1) + 4 * (j & 1); \
                    const f32x4 gg = *(const f32x4*)((gam) + c), bb = *(const f32x4*)((bet) + c); \
                    *(f32x4*)(xr + c) = v[j] * rstd * gg + bb; } } } while (0)

        {
            unsigned char* ws = ws_opaque(a); float* X = out_opaque(a); float* ST = (float*)(ws + WS_ST);
            pg8::Gemm g{(const bf16_t*)(ws + WS_Y), (const bf16_t*)(ws + WS_W + (size_t)l * W_LAYER + W_OUT), DM, DM, DM, 1, 0, 0, 0, 0};
            pg8::Order S; S.init(T, DM, 1, G, cu_opaque());
            pg8::EpiRes E{nullptr, l == 0 ? INP(0) : nullptr, ST + (size_t)(l > 0 ? 3 * l - 1 : 0) * T * 2, INP(22) + (size_t)(l > 0 ? l - 1 : 0) * DM, INP(23) + (size_t)(l > 0 ? l - 1 : 0) * DM,
                          (bf16_t*)(ws + WS_XN), ST + (size_t)(3 * l) * T * 2, ALPHA, 0};
            pg8::gemm_phase<pg8::EpiRes, true>((LAS unsigned char*)lds, g, S, E);
        }
        GRID_BAR();

        {
            unsigned char* ws = ws_opaque(a);
            const float* cl = (const float*)(ws + WS_C) + (size_t)l * C_LAYER;
            pg8::Gemm g{(const bf16_t*)(ws + WS_XN), (const bf16_t*)(ws + WS_W + (size_t)l * W_LAYER + W_KV), DM, DM, DM, 4, (long)SEQ * DM, 0, (long)4 * NMEM * DM, (long)NMEM * DM};
            pg8::Order S; S.init(SEQ, NMEM, 8, G, cu_opaque());
            pg8::EpiSoftmax E{(bf16_t*)(ws + WS_PROJ + 64 * MiB), (const float*)(ws + WS_ST) + (size_t)(3 * l) * T * 2, cl + C_Q, cl + C_QK2, 0.044194173824159216f};
            pg8::gemm_phase<pg8::EpiSoftmax, true>((LAS unsigned char*)lds, g, S, E);
        }
        GRID_BAR();
        {
            unsigned char* ws = ws_opaque(a); float* ST = (float*)(ws + WS_ST);
            pg8::Gemm g{(const bf16_t*)(ws + WS_PROJ + 64 * MiB), (const bf16_t*)(ws + WS_W + (size_t)l * W_LAYER + W_KV + 8 * MiB), 1024, 1024, 1024, 1, (long)SEQ * 1024, 0, (long)DM * 1024, 0};
            pg8::Order S; S.init(SEQ, DM, 2, G, cu_opaque());
            pg8::EpiRes E{nullptr, nullptr, ST + (size_t)(3 * l) * T * 2, INP(13) + (size_t)l * DM, INP(14) + (size_t)l * DM, (bf16_t*)(ws + WS_XN), ST + (size_t)(3 * l + 1) * T * 2, ALPHA, SEQ};
            pg8::gemm_phase<pg8::EpiRes, true>((LAS unsigned char*)lds, g, S, E);
        }
        GRID_BAR();
        {
            unsigned char* ws = ws_opaque(a);
            const float* cl = (const float*)(ws + WS_C) + (size_t)l * C_LAYER;
            pg8::Gemm g{(const bf16_t*)(ws + WS_XN), (const bf16_t*)(ws + WS_W + (size_t)l * W_LAYER + W_GU), DM, DM, DM, 1, 0, 0, 0, 0};
            pg8::Order S; S.init(T, 2 * DFF, 1, G, cu_opaque());
            pg8::EpiSwiglu E{(bf16_t*)(ws + WS_PROJ), (const float*)(ws + WS_ST) + (size_t)(3 * l + 1) * T * 2, cl + C_GU, cl + C_GU + 2 * DFF};
            pg8::gemm_phase<pg8::EpiSwiglu, true>((LAS unsigned char*)lds, g, S, E);
        }
        GRID_BAR();
        {
            unsigned char* ws = ws_opaque(a); float* X = out_opaque(a); float* ST = (float*)(ws + WS_ST);
            pg8::Gemm g{(const bf16_t*)(ws + WS_PROJ), (const bf16_t*)(ws + WS_W + (size_t)l * W_LAYER + W_D), DFF, DFF, DFF, 1, 0, 0, 0, 0};
            pg8::Order S; S.init(T, DM, 1, G, cu_opaque());
            pg8::EpiRes E{nullptr, nullptr, ST + (size_t)(3 * l + 1) * T * 2, INP(18) + (size_t)l * DM, INP(19) + (size_t)l * DM, (bf16_t*)(ws + WS_XN), ST + (size_t)(3 * l + 2) * T * 2, ALPHA, 0};
            pg8::gemm_phase<pg8::EpiRes, true>((LAS unsigned char*)lds, g, S, E);
        }
        GRID_BAR();
        if (l + 1 == DEPTH) { LN_OUT_PASS(INP(22) + (size_t)l * DM, INP(23) + (size_t)l * DM); }
#undef LN_OUT_PASS
    }
    if (a.ws == nullptr) cg::this_grid().sync();
}

extern "C" void kernel_launch(void* const* d_in, const int* in_sizes, int n_in, void* d_out, int out_size, void* d_ws, size_t ws_size, hipStream_t stream) {
    static int grid = 0;
    if (grid == 0) {
        if (n_in != 24 || in_sizes[0] != T * DM || out_size != T * DM || ws_size < WS_END) {
            fprintf(stderr, "kernel_launch: unexpected shapes (n_in %d, in0 %d, out %d, ws %zu); nothing launched\n", n_in, n_in > 0 ? in_sizes[0] : -1, out_size, ws_size); grid = -1; return; }
        int dev = 0, cus = 0, per_cu = 0;
        (void)hipGetDevice(&dev);
        if (hipDeviceGetAttribute(&cus, hipDeviceAttributeMultiprocessorCount, dev) != hipSuccess || cus <= 0) cus = 256;
        if (hipFuncSetAttribute((const void*)mega_fwd, hipFuncAttributeMaxDynamicSharedMemorySize, LDS_BYTES) != hipSuccess) fprintf(stderr, "kernel_launch: hipFuncSetAttribute failed\n");
        if (hipOccupancyMaxActiveBlocksPerMultiprocessor(&per_cu, (const void*)mega_fwd, NTHR, LDS_BYTES) != hipSuccess || per_cu < 1) { fprintf(stderr, "kernel_launch: occupancy query says %d\n", per_cu); per_cu = 1; }
        (void)hipGetLastError();
        grid = cus * per_cu;
    }
    if (grid < 0) return;
    if (hipMemsetAsync((char*)d_ws + WS_BAR, 0, WS_ST + 1 * MiB - WS_BAR, stream) != hipSuccess) { fprintf(stderr, "kernel_launch: hipMemsetAsync failed\n"); return; }
    Args a{};
    for (int i = 0; i < 24; ++i) a.in[i] = (const float*)d_in[i];
    a.out = (float*)d_out; a.ws = (unsigned char*)d_ws;
    void* args[] = {&a};
    hipError_t e = hipLaunchCooperativeKernel((const void*)mega_fwd, dim3(grid), dim3(NTHR), args, LDS_BYTES, stream);
    if (e != hipSuccess) fprintf(stderr, "cooperative launch failed: %s (grid %d)\n", hipGetErrorString(e), grid);
}
```

```cpp
#include <hip/hip_runtime.h>
#include <hip/hip_cooperative_groups.h>
#include <hip/hip_bf16.h>
#include <cstdio>
#include <cstdint>
namespace cg = cooperative_groups;

constexpr int BATCH = 2, SEQ = 8192, DM = 2048, DEPTH = 2, T = BATCH * SEQ;
constexpr int NMEM = 256, INC = 5632, DFF = 5632;
constexpr float ALPHA = 1.4142135623730951f;
constexpr float LN_EPS = 1e-5f;
constexpr int NTHR = 512, NWAVES = 8;

constexpr size_t MiB = 1u << 20;
constexpr size_t WS_LAM = 0;
constexpr size_t WS_BTAB = 4096;
constexpr size_t WS_BAR = 512 * 1024;
constexpr size_t WS_C = 576 * 1024;
constexpr int C_Q = 0, C_GU = 4096, C_IN = 4096 + 22528, C_QK2 = 4096 + 22528 + 11264, C_LAYER = C_QK2 + 2048;
constexpr size_t WS_ST = 1 * MiB;
constexpr size_t WS_WTRIL = 12 * MiB;
constexpr size_t WS_MEMBF = 2 * MiB;
constexpr size_t WS_KV = 4 * MiB;
constexpr size_t WS_W = 16 * MiB;
constexpr size_t W_IN = 0, W_OUT = 22 * MiB, W_Q = 30 * MiB, W_KV = 38 * MiB, W_O = 54 * MiB, W_GU = 62 * MiB, W_D = 106 * MiB, W_LAYER = 128 * MiB;
constexpr size_t WS_XN = 272 * MiB;
constexpr size_t WS_PROJ = 336 * MiB;
constexpr size_t WS_R1 = 512 * MiB;
constexpr size_t WS_Y = 640 * MiB;
constexpr size_t WS_END = 704 * MiB;
constexpr int LDS_BYTES = 147456;

typedef unsigned short bf16_t;
typedef short bf16x8 __attribute__((ext_vector_type(8)));
typedef float f32x4 __attribute__((ext_vector_type(4)));
typedef float f32x16 __attribute__((ext_vector_type(16)));
typedef unsigned u32x4 __attribute__((ext_vector_type(4)));
typedef unsigned u32x2 __attribute__((ext_vector_type(2)));
#define LAS __attribute__((address_space(3)))
#define GAS __attribute__((address_space(1)))

__device__ __forceinline__ unsigned cvt_pk_bf16(float lo, float hi) { unsigned r; asm volatile("v_cvt_pk_bf16_f32 %0, %1, %2" : "=v"(r) : "v"(lo), "v"(hi)); return r; }
__device__ __forceinline__ float bf_lo(unsigned w) { return __uint_as_float(w << 16); }
__device__ __forceinline__ float bf_hi(unsigned w) { return __uint_as_float(w & 0xffff0000u); }
__device__ __forceinline__ float bf2f(bf16_t b) { return __uint_as_float(((unsigned)b) << 16); }
__device__ __forceinline__ bf16_t f2bf(float f) { return (bf16_t)(cvt_pk_bf16(f, 0.f) & 0xffffu); }
__device__ __forceinline__ int ltid() { int t = threadIdx.x; asm volatile("" : "+v"(t)); return t; }
__device__ __forceinline__ int cu_opaque() { int c = blockIdx.x; asm volatile("" : "+s"(c)); return c; }
#define PH_IDS const int cu = cu_opaque(); const int tid = ltid(), lane = tid & 63, wave = __builtin_amdgcn_readfirstlane(tid >> 6), gw = cu * NWAVES + wave, gt = cu * NTHR + tid; (void)lane; (void)wave; (void)gw; (void)gt
__device__ __forceinline__ float wave_sum(float v) {
#pragma unroll
    for (int o = 1; o < 64; o <<= 1) v += __shfl_xor(v, o);
    return v;
}
__device__ __forceinline__ float wave_max(float v) {
#pragma unroll
    for (int o = 1; o < 64; o <<= 1) v = fmaxf(v, __shfl_xor(v, o));
    return v;
}
__device__ __forceinline__ float gelu_tanh(float x) {
    const float y = 0.7978845608028654f * (x + 0.044715f * x * x * x);
    return x * __builtin_amdgcn_rcpf(1.f + __expf(-2.f * y));
}

namespace pg8 {
constexpr int BM = 256, BK = 64, HALF = 128, HTB = HALF * BK * 2, STAGE_BYTES = 8 * HTB, NXCD = 8, WGM = 8;
__host__ __device__ __forceinline__ int lds_byte(int r, int c) { const int st = (r >> 4) * 2 + (c >> 5), rr = r & 15, cc = c & 31, ob = rr * 64 + cc * 2; return st * 1024 + (ob ^ (((ob >> 9) & 1) << 5)); }
__host__ __device__ __forceinline__ void stage_rc(int b, int& R, int& C) { const int st = b / 1024, sb = b % 1024, swz = sb ^ (((sb >> 9) & 1) << 5); R = (st >> 1) * 16 + swz / 64; C = (st & 1) * 32 + (swz % 64) / 2; }
__host__ __device__ __forceinline__ int perm32(int rho) { const int n = rho >> 4, i = rho & 15; return 8 * (i >> 2) + 4 * n + (i & 3); }

struct Unit { int pm, pn, bz; };
struct Gemm { const bf16_t* A; const bf16_t* Bt; int lda, ldb, K, nb0; long a_s1, a_s0, b_s1, b_s0; };
__device__ __forceinline__ const char* unit_a(const Gemm& g, const Unit& u) { const int b1 = u.bz / g.nb0, b0 = u.bz % g.nb0; return (const char*)(g.A + (size_t)b1 * g.a_s1 + (size_t)b0 * g.a_s0 + (size_t)u.pm * BM * g.lda); }
__device__ __forceinline__ const char* unit_b(const Gemm& g, const Unit& u) { const int b1 = u.bz / g.nb0, b0 = u.bz % g.nb0; return (const char*)(g.Bt + (size_t)b1 * g.b_s1 + (size_t)b0 * g.b_s0 + (size_t)u.pn * BM * g.ldb); }

struct Order {
    int nM, nN, nB, G, c;
    __device__ void init(int M, int N, int nB_, int G_, int c_) { nM = M / BM; nN = N / BM; nB = nB_; G = G_; c = c_; }
    __device__ bool next(int i, Unit& u) const {
        const long L = (long)i * G + c; const int nwg = nM * nN; if (c < 0 || L >= (long)nwg * nB) return false;
        if (nB > 1) { u.bz = (int)(L / nwg); const int w = (int)(L % nwg); u.pn = w / nM; u.pm = w % nM; return true; }
        u.bz = 0;
        int wgid = (int)L; { const int q = nwg / NXCD, r = nwg % NXCD, xcd = wgid % NXCD, off = wgid / NXCD; wgid = (xcd < r ? xcd * (q + 1) : r * (q + 1) + (xcd - r) * q) + off; }
        const int nig = WGM * nN, gid = wgid / nig, fm = gid * WGM, gsz = (nM - fm) < WGM ? (nM - fm) : WGM;
        u.pm = fm + ((wgid % nig) % gsz); u.pn = (wgid % nig) / gsz; return true;
    }
};

__device__ __forceinline__ void row_stats(const float* st, int row, float& mean, float& rstd) {
    const float s1 = st[2 * row], s2 = st[2 * row + 1];
    mean = s1 * (1.f / DM); const float var = fmaxf(s2 * (1.f / DM) - mean * mean, 0.f); rstd = rsqrtf(var + LN_EPS);
}
struct EpiSplit {
    static constexpr bool PERM = true, AFTER_DRAIN = false;
    bf16_t* P; const float* st; const float* c1; const float* c2;
    float* gst;
    __device__ __forceinline__ void operator()(const f32x4 (&acc)[2][2][4][2], const Unit& u, int wr, int wc, int fr, int fq) const {
        const int row0 = u.pm * BM + wr * 64 + fr, col0 = u.pn * BM + wc * 32 + 8 * fq;
        const bool vg = (u.pn == 8 || u.pn == 9);
        f32x4 k1[2][2], k2[2][2];
        if (st) {
#pragma unroll
            for (int bj = 0; bj < 2; ++bj)
#pragma unroll
                for (int n = 0; n < 2; ++n) { k1[bj][n] = *(const f32x4*)(c1 + col0 + bj * HALF + 4 * n); k2[bj][n] = *(const f32x4*)(c2 + col0 + bj * HALF + 4 * n); } }
#pragma unroll
        for (int ai = 0; ai < 2; ++ai)
#pragma unroll
            for (int m = 0; m < 4; ++m) { const int row = row0 + ai * HALF + m * 16;
                float mean = 0.f, rstd = 1.f; if (st) row_stats(st, row, mean, rstd);
                float gs = 0.f, gq = 0.f;
#pragma unroll
                for (int bj = 0; bj < 2; ++bj) { f32x4 v0 = acc[ai][bj][m][0], v1 = acc[ai][bj][m][1];
                    if (st) { v0 = (v0 - k1[bj][0] * mean) * rstd + k2[bj][0]; v1 = (v1 - k1[bj][1] * mean) * rstd + k2[bj][1]; }
                    u32x4 w; w.x = cvt_pk_bf16(v0[0], v0[1]); w.y = cvt_pk_bf16(v0[2], v0[3]); w.z = cvt_pk_bf16(v1[0], v1[1]); w.w = cvt_pk_bf16(v1[2], v1[3]);
                    *(u32x4*)(P + ((size_t)(u.pn * 2 + bj) * T + row) * 128 + wc * 32 + 8 * fq) = w;
                    if (vg) {
#pragma unroll
                        for (int j = 0; j < 4; ++j) { const float x0 = gelu_tanh(bf_lo(w[j])), x1 = gelu_tanh(bf_hi(w[j])); gs += x0 + x1; gq += x0 * x0 + x1 * x1; } } }
                if (vg) { gs += __shfl_xor(gs, 16); gs += __shfl_xor(gs, 32); gq += __shfl_xor(gq, 16); gq += __shfl_xor(gq, 32);
                    if (fq == 0) { unsafeAtomicAdd(gst + 2 * row, gs); unsafeAtomicAdd(gst + 2 * row + 1, gq); } } }
    }
};
struct EpiBf16 {
    static constexpr bool PERM = true, AFTER_DRAIN = false;
    bf16_t* O; int ldc, nb0; long o_s1, o_s0; float scale; const float* st; const float* c1; const float* c2; float* rsum;
    __device__ __forceinline__ void operator()(const f32x4 (&acc)[2][2][4][2], const Unit& u, int wr, int wc, int fr, int fq) const {
        const int row0 = u.pm * BM + wr * 64 + fr, col0 = u.pn * BM + wc * 32 + 8 * fq;
        bf16_t* base = O + (size_t)(u.bz / nb0) * o_s1 + (size_t)(u.bz % nb0) * o_s0;
        f32x4 k1[2][2], k2[2][2];
        if (st) {
#pragma unroll
            for (int bj = 0; bj < 2; ++bj)
#pragma unroll
                for (int n = 0; n < 2; ++n) { k1[bj][n] = *(const f32x4*)(c1 + col0 + bj * HALF + 4 * n); k2[bj][n] = *(const f32x4*)(c2 + col0 + bj * HALF + 4 * n); } }
#pragma unroll
        for (int ai = 0; ai < 2; ++ai)
#pragma unroll
            for (int m = 0; m < 4; ++m) { const int row = row0 + ai * HALF + m * 16; bf16_t* rowp = base + (size_t)row * ldc + col0;
                float mean = 0.f, rstd = 1.f; if (st) row_stats(st, row, mean, rstd);
                float rs = 0.f;
#pragma unroll
                for (int bj = 0; bj < 2; ++bj) { f32x4 v0 = acc[ai][bj][m][0], v1 = acc[ai][bj][m][1];
                    if (st) { v0 = (v0 - k1[bj][0] * mean) * rstd + k2[bj][0]; v1 = (v1 - k1[bj][1] * mean) * rstd + k2[bj][1]; }
                    v0 = v0 * scale; v1 = v1 * scale;
                    u32x4 w; w.x = cvt_pk_bf16(v0[0], v0[1]); w.y = cvt_pk_bf16(v0[2], v0[3]); w.z = cvt_pk_bf16(v1[0], v1[1]); w.w = cvt_pk_bf16(v1[2], v1[3]);
                    *(u32x4*)(rowp + bj * HALF) = w;
                    if (rsum) rs += ((bf_lo(w.x) + bf_hi(w.x)) + (bf_lo(w.y) + bf_hi(w.y))) + ((bf_lo(w.z) + bf_hi(w.z)) + (bf_lo(w.w) + bf_hi(w.w))); }
                if (rsum) { rs += __shfl_xor(rs, 16); rs += __shfl_xor(rs, 32); if (fq == 0) unsafeAtomicAdd(rsum + u.bz * 256 + row, rs); } }
    }
};
struct EpiF32 {
    static constexpr bool PERM = false, AFTER_DRAIN = false;
    float* out; int ldc; long o_bs; float scale;
    __device__ __forceinline__ void operator()(const f32x4 (&acc)[2][2][4][2], const Unit& u, int wr, int wc, int fr, int fq) const {
        const int row0 = u.pm * BM + wr * 64 + fr, col0 = u.pn * BM + wc * 32 + 4 * fq;
        float* ob = out + (size_t)u.bz * o_bs;
#pragma unroll
        for (int ai = 0; ai < 2; ++ai)
#pragma unroll
            for (int m = 0; m < 4; ++m) { const size_t off = (size_t)(row0 + ai * HALF + m * 16) * ldc + col0;
#pragma unroll
                for (int bj = 0; bj < 2; ++bj)
#pragma unroll
                    for (int n = 0; n < 2; ++n) *(f32x4*)(ob + off + bj * HALF + n * 16) = acc[ai][bj][m][n] * scale; }
    }
};
struct EpiRes {
    static constexpr bool PERM = true, AFTER_DRAIN = false;
    float* X; const float* raw; const float* pst; const float* pg; const float* pb; bf16_t* ZB; float* cst; float alpha; int brows;
    __device__ __forceinline__ void operator()(const f32x4 (&acc)[2][2][4][2], const Unit& u, int wr, int wc, int fr, int fq) const {
        const int row0 = u.bz * brows + u.pm * BM + wr * 64 + fr, col0 = u.pn * BM + wc * 32 + 8 * fq;
        f32x4 gv[2][2], bv[2][2];
        if (!raw) {
#pragma unroll
            for (int bj = 0; bj < 2; ++bj)
#pragma unroll
                for (int n = 0; n < 2; ++n) { gv[bj][n] = *(const f32x4*)(pg + col0 + bj * HALF + 4 * n); bv[bj][n] = *(const f32x4*)(pb + col0 + bj * HALF + 4 * n); } }
#pragma unroll
        for (int ai = 0; ai < 2; ++ai)
#pragma unroll
            for (int m = 0; m < 4; ++m) { const int row = row0 + ai * HALF + m * 16; const size_t off = (size_t)row * DM + col0;
                float mean = 0.f, rstd = 1.f; if (!raw) row_stats(pst, row, mean, rstd);
                float s1 = 0.f, s2 = 0.f;
#pragma unroll
                for (int bj = 0; bj < 2; ++bj) { f32x4 r0, r1;
                    if (raw) { r0 = *(const f32x4*)(raw + off + bj * HALF); r1 = *(const f32x4*)(raw + off + bj * HALF + 4); }
                    else { const u32x4 zw = *(const u32x4*)(ZB + off + bj * HALF);
                        r0 = (f32x4){bf_lo(zw.x), bf_hi(zw.x), bf_lo(zw.y), bf_hi(zw.y)}; r1 = (f32x4){bf_lo(zw.z), bf_hi(zw.z), bf_lo(zw.w), bf_hi(zw.w)};
                        r0 = (r0 - mean) * rstd * gv[bj][0] + bv[bj][0]; r1 = (r1 - mean) * rstd * gv[bj][1] + bv[bj][1]; }
                    const f32x4 z0 = acc[ai][bj][m][0] + r0 * alpha, z1 = acc[ai][bj][m][1] + r1 * alpha;
                    if (X) { *(f32x4*)(X + off + bj * HALF) = z0; *(f32x4*)(X + off + bj * HALF + 4) = z1; }
                    u32x4 w; w.x = cvt_pk_bf16(z0[0], z0[1]); w.y = cvt_pk_bf16(z0[2], z0[3]); w.z = cvt_pk_bf16(z1[0], z1[1]); w.w = cvt_pk_bf16(z1[2], z1[3]);
                    *(u32x4*)(ZB + off + bj * HALF) = w;
                    s1 += ((z0[0] + z0[1]) + (z0[2] + z0[3])) + ((z1[0] + z1[1]) + (z1[2] + z1[3]));
                    s2 += ((z0[0] * z0[0] + z0[1] * z0[1]) + (z0[2] * z0[2] + z0[3] * z0[3])) + ((z1[0] * z1[0] + z1[1] * z1[1]) + (z1[2] * z1[2] + z1[3] * z1[3])); }
                s1 += __shfl_xor(s1, 16); s1 += __shfl_xor(s1, 32); s2 += __shfl_xor(s2, 16); s2 += __shfl_xor(s2, 32);
                if (fq == 0) { unsafeAtomicAdd(cst + 2 * row, s1); unsafeAtomicAdd(cst + 2 * row + 1, s2); } }
    }
};
struct EpiSwiglu {
    static constexpr bool PERM = true, AFTER_DRAIN = false;
    bf16_t* H; const float* st; const float* c1; const float* c2;
    __device__ __forceinline__ void operator()(const f32x4 (&acc)[2][2][4][2], const Unit& u, int wr, int wc, int fr, int fq) const {
        const int row0 = u.pm * BM + wr * 64 + fr, col0 = u.pn * HALF + wc * 32 + 8 * fq, ccol0 = u.pn * BM + wc * 32 + 8 * fq;
        f32x4 k1[2][2], k2[2][2];
#pragma unroll
        for (int bj = 0; bj < 2; ++bj)
#pragma unroll
            for (int n = 0; n < 2; ++n) { k1[bj][n] = *(const f32x4*)(c1 + ccol0 + bj * HALF + 4 * n); k2[bj][n] = *(const f32x4*)(c2 + ccol0 + bj * HALF + 4 * n); }
#pragma unroll
        for (int ai = 0; ai < 2; ++ai)
#pragma unroll
            for (int m = 0; m < 4; ++m) { const int row = row0 + ai * HALF + m * 16; bf16_t* rowp = H + (size_t)row * DFF + col0;
                float mean, rstd; row_stats(st, row, mean, rstd);
                float h[8];
#pragma unroll
                for (int n = 0; n < 2; ++n) { const f32x4 gq = (acc[ai][0][m][n] - k1[0][n] * mean) * rstd + k2[0][n], uq = (acc[ai][1][m][n] - k1[1][n] * mean) * rstd + k2[1][n];
#pragma unroll
                    for (int j = 0; j < 4; ++j) h[n * 4 + j] = gq[j] * __builtin_amdgcn_rcpf(1.f + __expf(-gq[j])) * uq[j]; }
                u32x4 w; w.x = cvt_pk_bf16(h[0], h[1]); w.y = cvt_pk_bf16(h[2], h[3]); w.z = cvt_pk_bf16(h[4], h[5]); w.w = cvt_pk_bf16(h[6], h[7]);
                *(u32x4*)rowp = w; }
    }
};

struct EpiSoftmax {
    static constexpr bool PERM = true, AFTER_DRAIN = true;
    bf16_t* PALL; const float* st; const float* c1; const float* c2; float scale;
    __device__ __forceinline__ void fused(f32x4 (&acc)[2][2][4][2], const Unit& u, int wr, int wc, int fr, int fq, LAS unsigned char* lds) const {
        const int b = u.bz >> 2, h = u.bz & 3, rl0 = wr * 64 + fr, cc0 = wc * 32 + 8 * fq;
        LAS float* PMX = (LAS float*)lds; LAS float* PSM = PMX + 1024;
        f32x4 k1[2][2], k2[2][2];
#pragma unroll
        for (int bj = 0; bj < 2; ++bj)
#pragma unroll
            for (int n = 0; n < 2; ++n) { k1[bj][n] = *(const f32x4*)(c1 + u.bz * 256 + cc0 + bj * HALF + 4 * n); k2[bj][n] = *(const f32x4*)(c2 + u.bz * 256 + cc0 + bj * HALF + 4 * n); }
#pragma unroll
        for (int ai = 0; ai < 2; ++ai)
#pragma unroll
            for (int m = 0; m < 4; ++m) { const int rl = rl0 + ai * HALF + m * 16, row = b * SEQ + u.pm * BM + rl;
                float mean, rstd; row_stats(st, row, mean, rstd);
                float mx = -__builtin_inff();
#pragma unroll
                for (int bj = 0; bj < 2; ++bj)
#pragma unroll
                    for (int n = 0; n < 2; ++n) { const f32x4 v = ((acc[ai][bj][m][n] - k1[bj][n] * mean) * rstd + k2[bj][n]) * scale; acc[ai][bj][m][n] = v;
                        mx = fmaxf(mx, fmaxf(fmaxf(v[0], v[1]), fmaxf(v[2], v[3]))); }
                mx = fmaxf(mx, __shfl_xor(mx, 16)); mx = fmaxf(mx, __shfl_xor(mx, 32));
                if (fq == 0) PMX[rl * 4 + wc] = mx; }
        asm volatile("s_waitcnt lgkmcnt(0)" ::: "memory"); __builtin_amdgcn_s_barrier(); asm volatile("" ::: "memory");
#pragma unroll
        for (int ai = 0; ai < 2; ++ai)
#pragma unroll
            for (int m = 0; m < 4; ++m) { const int rl = rl0 + ai * HALF + m * 16;
                const f32x4 q = *(const LAS f32x4*)(PMX + rl * 4); const float mx = fmaxf(fmaxf(q[0], q[1]), fmaxf(q[2], q[3]));
                float sm = 0.f;
#pragma unroll
                for (int bj = 0; bj < 2; ++bj)
#pragma unroll
                    for (int n = 0; n < 2; ++n) { f32x4 e = acc[ai][bj][m][n] - mx; e[0] = __expf(e[0]); e[1] = __expf(e[1]); e[2] = __expf(e[2]); e[3] = __expf(e[3]); acc[ai][bj][m][n] = e;
                        sm += (e[0] + e[1]) + (e[2] + e[3]); }
                sm += __shfl_xor(sm, 16); sm += __shfl_xor(sm, 32);
                if (fq == 0) PSM[rl * 4 + wc] = sm; }
        asm volatile("s_waitcnt lgkmcnt(0)" ::: "memory"); __builtin_amdgcn_s_barrier(); asm volatile("" ::: "memory");
#pragma unroll
        for (int ai = 0; ai < 2; ++ai)
#pragma unroll
            for (int m = 0; m < 4; ++m) { const int rl = rl0 + ai * HALF + m * 16, row = b * SEQ + u.pm * BM + rl;
                const f32x4 q = *(const LAS f32x4*)(PSM + rl * 4); const float inv = __builtin_amdgcn_rcpf((q[0] + q[1]) + (q[2] + q[3]));
                bf16_t* rowp = PALL + (size_t)row * 1024 + h * 256 + cc0;
#pragma unroll
                for (int bj = 0; bj < 2; ++bj) { const f32x4 v0 = acc[ai][bj][m][0] * inv, v1 = acc[ai][bj][m][1] * inv;
                    u32x4 w; w.x = cvt_pk_bf16(v0[0], v0[1]); w.y = cvt_pk_bf16(v0[2], v0[3]); w.z = cvt_pk_bf16(v1[0], v1[1]); w.w = cvt_pk_bf16(v1[2], v1[3]);
                    *(u32x4*)(rowp + bj * HALF) = w; } }
    }
};

template <class Epi, bool ALIGN_EPI>
__device__ __forceinline__ void gemm_phase(LAS unsigned char* lds, const Gemm g, const Order& S, const Epi& E) {
    const int tid = ltid(), wid = __builtin_amdgcn_readfirstlane(tid >> 6), lane = tid & 63, wr = wid >> 2, wc = wid & 3, fr = lane & 15, fq = lane >> 4;
    const int K = g.K, nt = K / BK;
    unsigned voffA[2], voffB[2];
#pragma unroll
    for (int i = 0; i < 2; ++i) { int R, C; stage_rc(tid * 16 + i * 8192, R, C); const int Rb = Epi::PERM ? ((R & ~31) + perm32(R & 31)) : R;
        voffA[i] = (unsigned)(R * g.lda + C) * 2u; voffB[i] = (unsigned)(Rb * g.ldb + C) * 2u; }
    const size_t kstep = (size_t)(BK * 2);
    const size_t hstepA = (size_t)HALF * g.lda * 2, hstepB = (size_t)HALF * g.ldb * 2;
    const unsigned ldsw = (unsigned)wid * 1024u;
    const int aoff = lds_byte(wr * 64 + fr, fq * 8), boff = lds_byte(wc * 32 + fr, fq * 8);
#define PG8_SA(b, h) (((b) * 2 + (h)) * HTB)
#define PG8_SB(b, h) ((4 + (b) * 2 + (h)) * HTB)
#define PG8_STAGE(bufoff, gbase, voff) do { _Pragma("unroll") for (int _i = 0; _i < 2; ++_i) \
        __builtin_amdgcn_global_load_lds((const unsigned*)((const char*)(gbase) + (voff)[_i]), (LAS unsigned*)(lds + (bufoff) + ldsw + _i * 8192), 16, 0, 0); } while (0)
#define PG8_LDA(dst, b, h) do { _Pragma("unroll") for (int m = 0; m < 4; ++m) _Pragma("unroll") for (int k = 0; k < 2; ++k) dst[m][k] = *(const LAS bf16x8*)(lds + PG8_SA(b, h) + aoff + m * 2048 + k * 1024); } while (0)
#define PG8_LDB(dst, b, h) do { _Pragma("unroll") for (int n = 0; n < 2; ++n) _Pragma("unroll") for (int k = 0; k < 2; ++k) dst[n][k] = *(const LAS bf16x8*)(lds + PG8_SB(b, h) + boff + n * 2048 + k * 1024); } while (0)
#define PG8_MMA(ai, bj, At, Bt) do { __builtin_amdgcn_s_setprio(1); _Pragma("unroll") for (int m = 0; m < 4; ++m) _Pragma("unroll") for (int n = 0; n < 2; ++n) _Pragma("unroll") for (int k = 0; k < 2; ++k) \
        acc[ai][bj][m][n] = __builtin_amdgcn_mfma_f32_16x16x32_bf16(Bt[n][k], At[m][k], acc[ai][bj][m][n], 0, 0, 0); __builtin_amdgcn_s_setprio(0); } while (0)
#define PG8_WAIT_V(n) asm volatile("s_waitcnt vmcnt(" #n ")" ::: "memory")
#define PG8_WAIT_L(n) asm volatile("s_waitcnt lgkmcnt(" #n ")" ::: "memory")
#define PG8_BAR __builtin_amdgcn_s_barrier()
#define PG8_SCHED __builtin_amdgcn_sched_barrier(0)
    Unit cur, nxt; int ui = 0;
    if (!S.next(0, cur)) return;
    f32x4 acc[2][2][4][2];
#pragma unroll
    for (int a = 0; a < 2; ++a)
#pragma unroll
        for (int b = 0; b < 2; ++b)
#pragma unroll
            for (int m = 0; m < 4; ++m)
#pragma unroll
                for (int n = 0; n < 2; ++n) acc[a][b][m][n] = (f32x4){0.f, 0.f, 0.f, 0.f};
    bf16x8 At[4][2], B0[2][2], B1[2][2];
    const char* cA = unit_a(g, cur); const char* cB = unit_b(g, cur);
    PG8_STAGE(PG8_SB(0, 0), cB, voffB); PG8_STAGE(PG8_SB(0, 1), cB + hstepB, voffB); PG8_STAGE(PG8_SA(0, 0), cA, voffA); PG8_STAGE(PG8_SA(0, 1), cA + hstepA, voffA);
    if (wr == 1) PG8_BAR;
    PG8_WAIT_V(2); PG8_BAR;
    PG8_STAGE(PG8_SB(1, 0), cB + kstep, voffB); PG8_STAGE(PG8_SA(1, 0), cA + kstep, voffA); PG8_STAGE(PG8_SB(1, 1), cB + hstepB + kstep, voffB);
    PG8_WAIT_V(6); PG8_BAR;
    for (;;) {
        const bool has_next = S.next(ui + 1, nxt);
        const char* nA = has_next ? unit_a(g, nxt) : cA; const char* nB = has_next ? unit_b(g, nxt) : cB;
        for (int t = 0; t < nt; t += 2) {
            const bool last = (t == nt - 2);
            const char* a1 = cA + (size_t)(t + 1) * kstep;
            const char* a2 = last ? nA : cA + (size_t)(t + 2) * kstep; const char* b2 = last ? nB : cB + (size_t)(t + 2) * kstep;
            const char* a3 = a2 + kstep; const char* b3 = b2 + kstep;
            PG8_LDB(B0, 0, 0); PG8_LDB(B1, 0, 1); PG8_SCHED; PG8_LDA(At, 0, 0); PG8_STAGE(PG8_SA(1, 1), a1 + hstepA, voffA);
            PG8_WAIT_V(8); PG8_WAIT_L(0); PG8_BAR; PG8_MMA(0, 0, At, B0); PG8_MMA(0, 1, At, B1); PG8_BAR; PG8_SCHED;
            PG8_LDA(At, 0, 1); PG8_STAGE(PG8_SB(0, 0), b2, voffB); PG8_STAGE(PG8_SB(0, 1), b2 + hstepB, voffB); PG8_STAGE(PG8_SA(0, 0), a2, voffA);
            PG8_WAIT_V(8); PG8_WAIT_L(0); PG8_BAR; PG8_MMA(1, 0, At, B0); PG8_MMA(1, 1, At, B1); PG8_BAR; PG8_SCHED;
            PG8_LDB(B0, 1, 0); PG8_LDB(B1, 1, 1); PG8_SCHED; PG8_LDA(At, 1, 0); PG8_STAGE(PG8_SA(0, 1), a2 + hstepA, voffA);
            PG8_WAIT_V(8); PG8_WAIT_L(0); PG8_BAR; PG8_MMA(0, 0, At, B0); PG8_MMA(0, 1, At, B1); PG8_BAR; PG8_SCHED;
            PG8_LDA(At, 1, 1); PG8_STAGE(PG8_SB(1, 0), b3, voffB); PG8_STAGE(PG8_SB(1, 1), b3 + hstepB, voffB); PG8_STAGE(PG8_SA(1, 0), a3, voffA);
            PG8_WAIT_V(8); PG8_WAIT_L(0); PG8_BAR; PG8_MMA(1, 0, At, B0); PG8_MMA(1, 1, At, B1); PG8_BAR; PG8_SCHED;
        }
        if constexpr (ALIGN_EPI) { if (wr == 0) PG8_BAR; }
        if constexpr (!Epi::AFTER_DRAIN) E(acc, cur, wr, wc, fr, fq);
        if (!has_next) break;
#pragma unroll
        for (int a = 0; a < 2; ++a)
#pragma unroll
            for (int b = 0; b < 2; ++b)
#pragma unroll
                for (int m = 0; m < 4; ++m)
#pragma unroll
                    for (int n = 0; n < 2; ++n) acc[a][b][m][n] = (f32x4){0.f, 0.f, 0.f, 0.f};
        cur = nxt; cA = nA; cB = nB; ++ui;
        if constexpr (ALIGN_EPI) { if (wr == 1) PG8_BAR; }
    }
    PG8_WAIT_V(0);
    if constexpr (!ALIGN_EPI) { if (wr == 0) PG8_BAR; }
    PG8_BAR;
    if constexpr (Epi::AFTER_DRAIN) E.fused(acc, cur, wr, wc, fr, fq, lds);
#undef PG8_SA
#undef PG8_SB
#undef PG8_STAGE
#undef PG8_LDA
#undef PG8_LDB
#undef PG8_MMA
#undef PG8_WAIT_V
#undef PG8_WAIT_L
#undef PG8_BAR
#undef PG8_SCHED
}
}

namespace att {
using bf16 = __hip_bfloat16;
typedef short s16x4 __attribute__((ext_vector_type(4)));
constexpr int D = 128;
constexpr float THR = 8.f;
constexpr float SCALE = 0.08838834764831845f;
constexpr int NW = 8, QBLK = 32, KVBLK = 64, QB = NW * QBLK;
constexpr int SHM_V = KVBLK * D * 2, SHM_K = KVBLK * D * 2;
constexpr int ATT_LDS = 2 * SHM_V + 2 * SHM_K + NW * 64 * 4;
constexpr int BT_OFF = ATT_LDS;

#define KSWZ(row, colB) ((row) * 256 + ((colB) ^ (((row) & 7) << 4)))
#define SBAR() __builtin_amdgcn_sched_barrier(0)
__device__ __forceinline__ int v_st(int k, int c) { const int kk = (k & ~0xC) | ((k & 4) << 1) | ((k & 8) >> 1); return ((kk >> 3) * 4 + (c >> 5)) * 512 + ((kk & 7) * 32 + (c & 31)) * 2; }
__device__ __forceinline__ int v_rd_base(int lane) { return ((lane & 3) << 3) | (((lane >> 2) & 3) << 6) | (((lane >> 4) & 1) << 5) | (((lane >> 5) & 1) << 8); }
constexpr int v_rd_off(int d0, int ks, int half) { return d0 * 512 + ks * 4096 + half * 2048; }
__device__ __forceinline__ int crow(int r, int hi) { return (r & 3) + 8 * (r >> 2) + 4 * hi; }
__device__ __forceinline__ unsigned cvtpk(float lo, float hi) { unsigned r; asm volatile("v_cvt_pk_bf16_f32 %0, %1, %2" : "=v"(r) : "v"(lo), "v"(hi)); return r; }
__device__ __forceinline__ bf16x8 load8(const bf16* p) { return *reinterpret_cast<const bf16x8*>(p); }
__device__ __forceinline__ void bias_mask_tile(f32x16& p0, f32x16& p1, int dq, const float* bt) {
    const float NEG = -__builtin_inff();
#pragma unroll
    for (int r = 0; r < 16; ++r) {
        const int c = (r & 3) + 8 * (r >> 2);
        const int d0 = dq - c, d1 = dq - c - 32;
        const unsigned i0 = (unsigned)d0 < 255u ? (unsigned)d0 : 255u, i1 = (unsigned)d1 < 255u ? (unsigned)d1 : 255u;
        const float b0 = bt[i0], b1 = bt[i1];
        p0[r] = d0 >= 0 ? p0[r] + b0 : NEG;
        p1[r] = d1 >= 0 ? p1[r] + b1 : NEG;
    }
}
__device__ __forceinline__ void partialSM(f32x16& p0, f32x16& p1, float& m_reg, float& mn, float& alpha) {
    float pmax = p0[0]; for (int r = 1; r < 16; ++r) pmax = fmaxf(pmax, p0[r]); for (int r = 0; r < 16; ++r) pmax = fmaxf(pmax, p1[r]);
    { auto rr = __builtin_amdgcn_permlane32_swap(__float_as_uint(pmax), __float_as_uint(pmax), false, false);
      pmax = fmaxf(__uint_as_float(rr[0]), __uint_as_float(rr[1])); }
    constexpr float C2 = 1.4426950408889634f * SCALE;
    if (__builtin_expect(__all((pmax - m_reg) * SCALE <= THR), 1)) { mn = m_reg; alpha = 1.f; }
    else { mn = fmaxf(m_reg, pmax); alpha = __builtin_amdgcn_exp2f((m_reg - mn) * C2); m_reg = mn; }
    const float mnL = -mn * C2;
    for (int r = 0; r < 16; ++r) p0[r] = fmaf(p0[r], C2, mnL); for (int r = 0; r < 16; ++r) p1[r] = fmaf(p1[r], C2, mnL);
    for (int r = 0; r < 16; ++r) p0[r] = __builtin_amdgcn_exp2f(p0[r]);
}
__device__ __forceinline__ void finishSM(f32x16& p0, f32x16& p1, float alpha, float& l_reg, bf16x8& pa0, bf16x8& pa1, bf16x8& pa2, bf16x8& pa3) {
    for (int r = 0; r < 16; ++r) p1[r] = __builtin_amdgcn_exp2f(p1[r]);
    float ps = 0; for (int r = 0; r < 16; ++r) ps += p0[r]; for (int r = 0; r < 16; ++r) ps += p1[r];
    { auto rr = __builtin_amdgcn_permlane32_swap(__float_as_uint(ps), __float_as_uint(ps), false, false);
      ps = __uint_as_float(rr[0]) + __uint_as_float(rr[1]); }
    l_reg = l_reg * alpha + ps;
#define PK4(P, B_, OUT) do { unsigned a0 = cvtpk(P[B_+0], P[B_+1]), a1 = cvtpk(P[B_+2], P[B_+3]);                          \
        unsigned b0 = cvtpk(P[B_+4], P[B_+5]), b1 = cvtpk(P[B_+6], P[B_+7]);                                             \
        auto r0 = __builtin_amdgcn_permlane32_swap(a0, b0, false, false); auto r1 = __builtin_amdgcn_permlane32_swap(a1, b1, false, false); \
        u32x4 w = {r0[0], r1[0], r0[1], r1[1]}; OUT = *reinterpret_cast<bf16x8*>(&w); } while (0)
    PK4(p0, 0, pa0); PK4(p0, 8, pa1); PK4(p1, 0, pa2); PK4(p1, 8, pa3);
#undef PK4
}
template <int KB>
__device__ __forceinline__ void qkt(f32x16& p0, f32x16& p1, const char* K_lds, int r32, int hi, const bf16x8* qr) {
    p0 = f32x16{}; p1 = f32x16{};
    const char* kb[4];
#pragma unroll
    for (int dd = 0; dd < 4; ++dd) kb[dd] = K_lds + KB * SHM_K + KSWZ(r32, (dd * 16 + hi * 8) * 2);
#pragma unroll
    for (int d0 = 0; d0 < 8; ++d0) { const char* a = kb[d0 & 3] + (d0 >> 2) * 128;
        bf16x8 b0 = *reinterpret_cast<const bf16x8*>(a);
        bf16x8 b1 = *reinterpret_cast<const bf16x8*>(a + 32 * 256);
        p0 = __builtin_amdgcn_mfma_f32_32x32x16_bf16(b0, qr[d0], p0, 0, 0, 0);
        p1 = __builtin_amdgcn_mfma_f32_32x32x16_bf16(b1, qr[d0], p1, 0, 0, 0); }
}
template <int VB>
__device__ __forceinline__ void pv_tile(f32x16* o, int vb0, bf16x8 pa0, bf16x8 pa1, bf16x8 pa2, bf16x8 pa3) {
#define TRRD(dst, off) asm volatile("ds_read_b64_tr_b16 %0, %1 offset:%2" : "=&v"(dst) : "v"(vb0), "i"(off) : "memory")
#define PV_D0(d0) do { s16x4 l0, l1, l2, l3, h0, h1, h2, h3; constexpr int b_ = VB * SHM_V + v_rd_off(d0, 0, 0); \
        TRRD(l0, b_); TRRD(h0, b_ + 2048); TRRD(l1, b_ + 4096); TRRD(h1, b_ + 6144); TRRD(l2, b_ + 8192); TRRD(h2, b_ + 10240); TRRD(l3, b_ + 12288); TRRD(h3, b_ + 14336); \
        asm volatile("s_waitcnt lgkmcnt(0)" ::: "memory"); SBAR();   \
        o[d0] = __builtin_amdgcn_mfma_f32_32x32x16_bf16(pa0, (bf16x8){l0[0], l0[1], l0[2], l0[3], h0[0], h0[1], h0[2], h0[3]}, o[d0], 0, 0, 0);   \
        o[d0] = __builtin_amdgcn_mfma_f32_32x32x16_bf16(pa1, (bf16x8){l1[0], l1[1], l1[2], l1[3], h1[0], h1[1], h1[2], h1[3]}, o[d0], 0, 0, 0);   \
        o[d0] = __builtin_amdgcn_mfma_f32_32x32x16_bf16(pa2, (bf16x8){l2[0], l2[1], l2[2], l2[3], h2[0], h2[1], h2[2], h2[3]}, o[d0], 0, 0, 0);   \
        o[d0] = __builtin_amdgcn_mfma_f32_32x32x16_bf16(pa3, (bf16x8){l3[0], l3[1], l3[2], l3[3], h3[0], h3[1], h3[2], h3[3]}, o[d0], 0, 0, 0); } while (0)
    PV_D0(0); PV_D0(1); PV_D0(2); PV_D0(3);
#undef PV_D0
#undef TRRD
}
struct BlockRef { const bf16* Q; const bf16* K; const bf16* V; float* O; int P0; int hm; };
struct Seam { bf16x8 qr[8]; bf16x8 st_v0, st_v1, st_k0, st_k1; };
#define ROW(p, k0, rr) ((p) + (size_t)((k0) + (rr)) * D + sc)
#define VMW() asm volatile("s_waitcnt vmcnt(0)" ::: "memory")
#define VMWN(n) asm volatile("s_waitcnt vmcnt(%0)" :: "i"(n) : "memory")
#define SLOAD_H(Kp, Vp, k0) do { S.st_v0 = load8(ROW(Vp, k0, sr)); S.st_v1 = load8(ROW(Vp, k0, 32 + sr));              \
                         S.st_k0 = load8(ROW(Kp, k0, sr)); S.st_k1 = load8(ROW(Kp, k0, 32 + sr)); } while (0)
#define SWRITE_HK(bf) do { *(bf16x8*)(K_lds + (bf) * SHM_K + kws) = S.st_k0; *(bf16x8*)(K_lds + (bf) * SHM_K + kws + 32 * 256) = S.st_k1; } while (0)
#define SWRITE_HV(bf) do { *(bf16x8*)(V_lds + (bf) * SHM_V + vst0) = S.st_v0; *(bf16x8*)(V_lds + (bf) * SHM_V + vst1) = S.st_v1; } while (0)
#define SWRITE_H(bf) do { SWRITE_HV(bf); SWRITE_HK(bf); } while (0)
__device__ __forceinline__ void attn_prime(const BlockRef& cur, char* lds, Seam& S) {
    const int tid = ltid(), wid = __builtin_amdgcn_readfirstlane(tid >> 6), lane = tid & 63, r32 = lane & 31, hi = lane >> 5;
    const int sr = tid >> 4, sc = (tid & 15) * 8, kws = KSWZ(sr, sc * 2); char* K_lds = lds + 2 * SHM_V;
    const int kb0 = 0;
    for (int d0 = 0; d0 < 8; ++d0) S.qr[d0] = load8(cur.Q + (size_t)(wid * QBLK + r32) * D + d0 * 16 + hi * 8);
    SLOAD_H(cur.K, cur.V, kb0); VMW(); SWRITE_HK(0);
    __syncthreads();
}
__device__ __forceinline__ void attn_block(const BlockRef& cur, const BlockRef& nxt, char* lds, Seam& S) {
    const int tid = ltid(), wid = __builtin_amdgcn_readfirstlane(tid >> 6), lane = tid & 63, r32 = lane & 31, hi = lane >> 5;
    const int j_lo = 0;
    const int j_hi = (cur.P0 + QB - 1) / KVBLK + 1;
    const int NT = j_hi - j_lo;
    const int kbn = 0;
    const int qlo = cur.P0 + wid * QBLK, qm = qlo + r32 - 4 * hi;
    char* V_lds = lds; char* K_lds = lds + 2 * SHM_V;
    float* ws = (float*)(lds + 2 * SHM_V + 2 * SHM_K) + wid * 64; float* li_l = ws, * al_l = ws + 32;
    const float* bt = (const float*)(lds + BT_OFF) + cur.hm * 256;
    float m_reg = -1e30f, l_reg = 0; f32x16 o[4] = {};
    const int sr = tid >> 4, sc = (tid & 15) * 8, vst0 = v_st(sr, sc), vst1 = v_st(32 + sr, sc), kws = KSWZ(sr, sc * 2);
    const int vb0 = (int)(uintptr_t)V_lds + v_rd_base(lane);
    const bf16* Kh = cur.K; const bf16* Vh = cur.V;
#define RESC(a) do { if (__any((a) < 1.f)) { if (hi == 0) al_l[r32] = (a); asm volatile("s_waitcnt lgkmcnt(0)" ::: "memory");              \
                     for (int d_ = 0; d_ < 4; ++d_) for (int r = 0; r < 16; ++r) o[d_][r] *= al_l[crow(r, hi)]; } } while (0)
#define KBASE(t) ((j_lo + (t)) * KVBLK)
#define MASKT(P0_, P1_, t) do { const int kb_ = KBASE(t); if (kb_ + KVBLK - 1 > qlo - 128) bias_mask_tile(P0_, P1_, qm - kb_, bt); } while (0)
    constexpr int NQL = 8;
#define SEAM_K0() do { VMWN(NQL); SWRITE_HK(0); SBAR(); } while (0)
    f32x16 pA0, pA1, pB0, pB1; float mnA, mnB, alA, alB; bf16x8 pa0, pa1, pa2, pa3;
    SWRITE_HV(0); SBAR();
    if (NT > 1) { SLOAD_H(Kh, Vh, KBASE(1)); }
    SBAR(); qkt<0>(pA0, pA1, K_lds, r32, hi, S.qr);
    MASKT(pA0, pA1, 0); partialSM(pA0, pA1, m_reg, mnA, alA);
    if (NT > 1) { VMW(); SWRITE_H(1); }
    __syncthreads();
#define HALF_STEP(PX0, PX1, mnX, alX, PY0, PY1, alY, t, KB, VB, SB) do {                                                      \
        SBAR(); qkt<KB>(PX0, PX1, K_lds, r32, hi, S.qr);                                             \
        finishSM(PY0, PY1, alY, l_reg, pa0, pa1, pa2, pa3); SBAR();                                                           \
        if ((t) + 1 < NT) { SLOAD_H(Kh, Vh, KBASE((t) + 1)); SBAR(); }                                               \
        pv_tile<VB>(o, vb0, pa0, pa1, pa2, pa3); MASKT(PX0, PX1, (t)); partialSM(PX0, PX1, m_reg, mnX, alX);                                        \
        __syncthreads();                                                                                                      \
        if ((t) + 1 < NT) { VMW(); SWRITE_H(SB); }                                                                          \
        RESC(alX); __syncthreads(); } while (0)
    for (int t = 1; t + 1 < NT; t += 2) {
        HALF_STEP(pB0, pB1, mnB, alB, pA0, pA1, alA, t, 1, 0, 0);
        HALF_STEP(pA0, pA1, mnA, alA, pB0, pB1, alB, t + 1, 0, 1, 1);
    }
    const bool even = (NT & 1) == 0;
    if (even) { SBAR(); qkt<1>(pB0, pB1, K_lds, r32, hi, S.qr); SBAR(); }
    SLOAD_H(nxt.K, nxt.V, kbn); SBAR();
#pragma unroll
    for (int d0 = 0; d0 < 8; ++d0) S.qr[d0] = load8(nxt.Q + (size_t)(wid * QBLK + r32) * D + d0 * 16 + hi * 8);
    SBAR();
    finishSM(pA0, pA1, alA, l_reg, pa0, pa1, pa2, pa3); SBAR();
    pv_tile<0>(o, vb0, pa0, pa1, pa2, pa3);
    if (even) { MASKT(pB0, pB1, NT - 1); partialSM(pB0, pB1, m_reg, mnB, alB); __syncthreads(); RESC(alB);
        finishSM(pB0, pB1, alB, l_reg, pa0, pa1, pa2, pa3); SBAR(); pv_tile<1>(o, vb0, pa0, pa1, pa2, pa3); }
    SBAR(); SEAM_K0();
    if (hi == 0) li_l[r32] = l_reg; asm volatile("s_waitcnt lgkmcnt(0)" ::: "memory");
    float rli[16];
#pragma unroll
    for (int r = 0; r < 16; ++r) rli[r] = __builtin_amdgcn_rcpf(li_l[crow(r, hi)]);
    float* Ow = cur.O + (size_t)(wid * QBLK) * D;
#pragma unroll
    for (int r = 0; r < 16; ++r) { const int orow = crow(r, hi);
#pragma unroll
        for (int d0 = 0; d0 < 4; ++d0) { const float v = o[d0][r] * rli[r]; Ow[(size_t)orow * D + d0 * 32 + r32] = v; } }
    __syncthreads();
#undef RESC
#undef KBASE
#undef MASKT
#undef SEAM_K0
#undef HALF_STEP
}
#undef ROW
#undef VMW
#undef VMWN
#undef SLOAD_H
#undef SWRITE_HK
#undef SWRITE_HV
#undef SWRITE_H
}

namespace att2 {
using att::bf16; using att::D; using att::SHM_K; using att::SHM_V;
constexpr int L_V = 0, L_K = 65536, L_P = 98304, L_AL = 131072, L_FL = 132096, L_LB = 132224, L_BT = 133120;
struct Blk { const bf16* Q; const bf16* K; const bf16* V0; const bf16* V1; float* O0; float* O1; int P0; int hm; };
__device__ __forceinline__ void qkt_rt(f32x16& p0, f32x16& p1, const char* Kb, int r32, int hi, const bf16x8* qr) {
    p0 = f32x16{}; p1 = f32x16{};
    const char* kb[4];
#pragma unroll
    for (int dd = 0; dd < 4; ++dd) kb[dd] = Kb + KSWZ(r32, (dd * 16 + hi * 8) * 2);
#pragma unroll
    for (int d0 = 0; d0 < 8; ++d0) { const char* a = kb[d0 & 3] + (d0 >> 2) * 128;
        bf16x8 b0 = *reinterpret_cast<const bf16x8*>(a);
        bf16x8 b1 = *reinterpret_cast<const bf16x8*>(a + 32 * 256);
        p0 = __builtin_amdgcn_mfma_f32_32x32x16_bf16(b0, qr[d0], p0, 0, 0, 0);
        p1 = __builtin_amdgcn_mfma_f32_32x32x16_bf16(b1, qr[d0], p1, 0, 0, 0); }
}
#define A2_LOADT(t) do { const size_t ro_ = (size_t)((t) * 64 + sr) * D + sc; \
        sk0 = att::load8(c.K + ro_); sk1 = att::load8(c.K + ro_ + 32 * D); sv00 = att::load8(c.V0 + ro_); sv01 = att::load8(c.V0 + ro_ + 32 * D); sv10 = att::load8(c.V1 + ro_); sv11 = att::load8(c.V1 + ro_ + 32 * D); } while (0)
#define A2_WRITET(buf) do { char* kd_ = lds + L_K + (buf) * SHM_K; char* vd_ = lds + L_V + (buf) * 2 * SHM_V; \
        *(bf16x8*)(kd_ + kws) = sk0; *(bf16x8*)(kd_ + kws + 32 * 256) = sk1; *(bf16x8*)(vd_ + vst0) = sv00; *(bf16x8*)(vd_ + vst1) = sv01; *(bf16x8*)(vd_ + SHM_V + vst0) = sv10; *(bf16x8*)(vd_ + SHM_V + vst1) = sv11; } while (0)
__device__ __forceinline__ void attn2_block(const Blk& c, char* lds) {
    const int tid = ltid(), wid = __builtin_amdgcn_readfirstlane(tid >> 6), lane = tid & 63, r32 = lane & 31, hi = lane >> 5;
    const int g = wid & 3;
    const int NT = (c.P0 + 127) / 64 + 1;
    const int sr = tid >> 4, sc = (tid & 15) * 8, kws = KSWZ(sr, sc * 2), vst0 = att::v_st(sr, sc), vst1 = att::v_st(32 + sr, sc);
    bf16x8 sk0, sk1, sv00, sv01, sv10, sv11;
    float* ALb = (float*)(lds + L_AL) + g * 64; unsigned* FLb = (unsigned*)(lds + L_FL) + g * 2; float* LBb = (float*)(lds + L_LB) + g * 32;
    char* Pb = lds + L_P + g * 8192;
    A2_LOADT(0);
    if (wid < 4) {
        bf16x8 qr[8];
#pragma unroll
        for (int d0 = 0; d0 < 8; ++d0) qr[d0] = att::load8(c.Q + (size_t)(g * 32 + r32) * D + d0 * 16 + hi * 8);
        asm volatile("s_waitcnt vmcnt(0)" ::: "memory"); A2_WRITET(0); __syncthreads();
        const int qlo = c.P0 + g * 32, qm = qlo + r32 - 4 * hi;
        const float* bt = (const float*)(lds + L_BT) + c.hm * 256;
        float m_reg = -1e30f, l_reg = 0.f;
        for (int s = 0; s <= NT; ++s) {
            const int par = s & 1;
            if (s + 1 < NT) A2_LOADT(s + 1);
            SBAR();
            if (s < NT) {
                f32x16 p0, p1; float mn, al; bf16x8 pa0, pa1, pa2, pa3;
                qkt_rt(p0, p1, lds + L_K + par * SHM_K, r32, hi, qr);
                const int kb_ = s * 64;
                if (kb_ + 63 > qlo - 128) att::bias_mask_tile(p0, p1, qm - kb_, bt);
                att::partialSM(p0, p1, m_reg, mn, al);
                att::finishSM(p0, p1, al, l_reg, pa0, pa1, pa2, pa3);
                char* pw = Pb + par * 4096 + lane * 16;
                *(bf16x8*)(pw) = pa0; *(bf16x8*)(pw + 1024) = pa1; *(bf16x8*)(pw + 2048) = pa2; *(bf16x8*)(pw + 3072) = pa3;
                if (hi == 0) ALb[par * 32 + r32] = al;
                const bool resc = __any(al < 1.f);
                if (lane == 0) FLb[par] = resc ? 1u : 0u;
            }
            __syncthreads();
            if (s + 1 < NT) { asm volatile("s_waitcnt vmcnt(0)" ::: "memory"); A2_WRITET((s + 1) & 1); }
            __syncthreads();
        }
        if (hi == 0) LBb[r32] = l_reg;
        __syncthreads();
        __syncthreads();
    } else {
        asm volatile("s_waitcnt vmcnt(0)" ::: "memory"); A2_WRITET(0); __syncthreads();
        f32x16 o[8];
#pragma unroll
        for (int d_ = 0; d_ < 8; ++d_) o[d_] = f32x16{};
        const int vbase = (int)(uintptr_t)(lds + L_V) + att::v_rd_base(lane);
        for (int s = 0; s <= NT; ++s) {
            if (s + 1 < NT) A2_LOADT(s + 1);
            SBAR();
            if (s >= 1) {
                const int par = (s - 1) & 1;
                const unsigned fl = (unsigned)__builtin_amdgcn_readfirstlane((int)FLb[par]);
                if (fl) {
#pragma unroll
                    for (int r = 0; r < 16; ++r) { const float a = ALb[par * 32 + att::crow(r, hi)];
#pragma unroll
                        for (int d_ = 0; d_ < 8; ++d_) o[d_][r] *= a; } }
                const char* pr = Pb + par * 4096 + lane * 16;
                const bf16x8 pa0 = *(const bf16x8*)(pr), pa1 = *(const bf16x8*)(pr + 1024), pa2 = *(const bf16x8*)(pr + 2048), pa3 = *(const bf16x8*)(pr + 3072);
                const int vb = vbase + par * 2 * SHM_V;
                att::pv_tile<0>(o, vb, pa0, pa1, pa2, pa3);
                att::pv_tile<0>(o + 4, vb + SHM_V, pa0, pa1, pa2, pa3);
            }
            __syncthreads();
            if (s + 1 < NT) { asm volatile("s_waitcnt vmcnt(0)" ::: "memory"); A2_WRITET((s + 1) & 1); }
            __syncthreads();
        }
        __syncthreads();
        float rli[16];
#pragma unroll
        for (int r = 0; r < 16; ++r) rli[r] = __builtin_amdgcn_rcpf(LBb[att::crow(r, hi)]);
#pragma unroll
        for (int hf = 0; hf < 2; ++hf) { float* Ow = (hf ? c.O1 : c.O0) + (size_t)(g * 32) * D;
#pragma unroll
            for (int r = 0; r < 16; ++r) { const int orow = att::crow(r, hi);
#pragma unroll
                for (int d0 = 0; d0 < 4; ++d0) Ow[(size_t)orow * D + d0 * 32 + r32] = o[hf * 4 + d0][r] * rli[r]; } }
        __syncthreads();
    }
}
#undef A2_LOADT
#undef A2_WRITET
}


#define XB_TMO      128
#define XB_XCNT(j)  (256  + 64 * (j))
#define XB_XSUB(j)  (1280 + 64 * (j))
#define XB_XGEN(j)  (2304 + 64 * (j))
#define XB_TOP      3328
#define XB_TOPGEN   3392
#define XCD_BAR_WORDS 3456
#define XB_SPIN_CAP (1u << 18)
__device__ __forceinline__ unsigned xb_ld(unsigned* p)              { return __hip_atomic_load(p, __ATOMIC_RELAXED, __HIP_MEMORY_SCOPE_AGENT); }
__device__ __forceinline__ unsigned xb_add(unsigned* p, unsigned v) { return __hip_atomic_fetch_add(p, v, __ATOMIC_RELAXED, __HIP_MEMORY_SCOPE_AGENT); }
__device__ __forceinline__ unsigned xb_xcc_id() { return (unsigned)__builtin_amdgcn_s_getreg((3 << 11) | 20) & 0xFu; }
#define XB_SPIN(cond, bar) do { unsigned _sp = 0; while (cond) { __builtin_amdgcn_s_sleep(1); \
    if ((++_sp & 255u) == 0u) { if (xb_ld(&(bar)[XB_TMO])) break; if (_sp > XB_SPIN_CAP) { atomicAdd(&(bar)[XB_TMO], 1u); break; } } } } while (0)
struct XcdBarrier { unsigned* bar; unsigned x; volatile LAS unsigned* st; };
__device__ __forceinline__ XcdBarrier xcd_barrier_post(unsigned* bar, volatile LAS unsigned* st) {
    XcdBarrier b; b.bar = bar; b.x = xb_xcc_id(); b.st = st;
    if (threadIdx.x == 0) (void)xb_add(&bar[XB_XCNT(b.x)], 1u);
    return b;
}
__device__ __forceinline__ void xcd_barrier_complete(unsigned* bar, unsigned x, unsigned& nloc, unsigned& nx) {
    const unsigned G = gridDim.x * gridDim.y * gridDim.z;
    unsigned sum, cnt, mine, sp = 0u;
    for (;;) {
        sum = 0u; cnt = 0u; mine = 0u;
#pragma unroll
        for (unsigned j = 0; j < 16; ++j) { const unsigned c = xb_ld(&bar[XB_XCNT(j)]); sum += c; cnt += (c > 0u) ? 1u : 0u; mine = (j == x) ? c : mine; }
        if (sum == G) break;
        __builtin_amdgcn_s_sleep(1);
        if ((++sp & 255u) == 0u) { if (xb_ld(&bar[XB_TMO])) break; if (sp > XB_SPIN_CAP) { atomicAdd(&bar[XB_TMO], 1u); break; } }
    }
    nloc = mine > 0u ? mine : 1u; nx = cnt > 0u ? cnt : 1u;
}
__device__ __forceinline__ void xcd_barrier(const XcdBarrier& b) {
    asm volatile("s_waitcnt vmcnt(0)" ::: "memory");
    __syncthreads();
    if (threadIdx.x == 0) {
        unsigned* bar = b.bar;
        __builtin_amdgcn_s_waitcnt(0);
        unsigned nloc = b.st[0], nx = b.st[1];
        if (nloc == 0u) { xcd_barrier_complete(bar, b.x, nloc, nx); b.st[0] = nloc; b.st[1] = nx; }
        const unsigned old = xb_add(&bar[XB_XSUB(b.x)], 1u);
        const unsigned gen = old / nloc;
        if (old + 1u == (gen + 1u) * nloc) {
            __builtin_amdgcn_fence(__ATOMIC_RELEASE, "agent");
            asm volatile("s_waitcnt vmcnt(0)" ::: "memory");
            const unsigned og = xb_add(&bar[XB_TOP], 1u);
            const unsigned tg = og / nx;
            if (og + 1u == (tg + 1u) * nx) xb_add(&bar[XB_TOPGEN], 1u);
            else XB_SPIN(xb_ld(&bar[XB_TOPGEN]) == tg, bar);
            __builtin_amdgcn_fence(__ATOMIC_ACQUIRE, "agent");
            xb_add(&bar[XB_XGEN(b.x)], 1u);
            asm volatile("s_waitcnt vmcnt(0)" ::: "memory");
        } else {
            XB_SPIN(xb_ld(&bar[XB_XGEN(b.x)]) == gen, bar);
            __builtin_amdgcn_fence(__ATOMIC_ACQUIRE, "agent");
            asm volatile("s_waitcnt vmcnt(0)" ::: "memory");
        }
    }
    __syncthreads();
}

struct Args { const float* in[24]; float* out; unsigned char* ws; };

__device__ __forceinline__ void p0_transpose_item(const float* W, int K, int N, bf16_t* WT, int swiglu, const float* gk, const float* bk, float* c1, float* c2, LAS float* scr, int item, int lane) {
    const int nblk = N / 64, kb = item / nblk, nb = item % nblk, k0 = 64 * kb, n0 = 64 * nb;
    const float* src = W + (size_t)(k0 + (lane >> 4)) * N + n0 + (lane & 15) * 4;
    f32x4 v[16];
#pragma unroll
    for (int i = 0; i < 16; ++i) v[i] = __builtin_nontemporal_load((const f32x4*)(src + (size_t)(4 * i) * N));
#pragma unroll
    for (int i = 0; i < 16; ++i) { LAS float* d = scr + (4 * i + (lane >> 4)) * 65 + (lane & 15) * 4; d[0] = v[i][0]; d[1] = v[i][1]; d[2] = v[i][2]; d[3] = v[i][3]; }
    asm volatile("s_waitcnt lgkmcnt(0)" ::: "memory");
    int r0 = n0;
    if (swiglu) { const int half = n0 / DFF, idx = n0 % DFF; r0 = 256 * (idx / 128) + 128 * half + (idx % 128); }
    const int c = lane & 7;
    float g8[8], b8[8];
#pragma unroll
    for (int e = 0; e < 8; ++e) { g8[e] = gk ? gk[k0 + 8 * c + e] : 1.f; b8[e] = gk ? bk[k0 + 8 * c + e] : 0.f; }
#pragma unroll
    for (int j = 0; j < 8; ++j) { const int n = (lane >> 3) + 8 * j; const LAS float* q = scr + (8 * c) * 65 + n;
        float w8[8];
#pragma unroll
        for (int e = 0; e < 8; ++e) w8[e] = q[e * 65];
        u32x4 o; o.x = cvt_pk_bf16(w8[0] * g8[0], w8[1] * g8[1]); o.y = cvt_pk_bf16(w8[2] * g8[2], w8[3] * g8[3]); o.z = cvt_pk_bf16(w8[4] * g8[4], w8[5] * g8[5]); o.w = cvt_pk_bf16(w8[6] * g8[6], w8[7] * g8[7]);
        *(u32x4*)(WT + (size_t)(r0 + n) * K + k0 + 8 * c) = o;
        if (gk) {
            float s1 = ((bf_lo(o.x) + bf_hi(o.x)) + (bf_lo(o.y) + bf_hi(o.y))) + ((bf_lo(o.z) + bf_hi(o.z)) + (bf_lo(o.w) + bf_hi(o.w)));
            float s2 = ((w8[0] * b8[0] + w8[1] * b8[1]) + (w8[2] * b8[2] + w8[3] * b8[3])) + ((w8[4] * b8[4] + w8[5] * b8[5]) + (w8[6] * b8[6] + w8[7] * b8[7]));
            s1 += __shfl_xor(s1, 1); s1 += __shfl_xor(s1, 2); s1 += __shfl_xor(s1, 4); s2 += __shfl_xor(s2, 1); s2 += __shfl_xor(s2, 2); s2 += __shfl_xor(s2, 4);
            if (c == 0) { unsafeAtomicAdd(c1 + r0 + n, s1); unsafeAtomicAdd(c2 + r0 + n, s2); }
        } }
    asm volatile("s_waitcnt lgkmcnt(0)" ::: "memory");
}

__device__ __forceinline__ void p0_wq_item(const float* W, bf16_t* WN, const float* gk, const float* bk, float* bW, int item, int lane) {
    const int kb = item >> 5, jb = item & 31, k0 = 64 * kb, j0 = 64 * jb, cg8 = lane & 7, kr = lane >> 3;
    float sacc[8];
#pragma unroll
    for (int e = 0; e < 8; ++e) sacc[e] = 0.f;
#pragma unroll
    for (int i = 0; i < 8; ++i) { const int k = k0 + 8 * i + kr; const float* src = W + (size_t)k * DM + j0 + 8 * cg8;
        const f32x4 v0 = __builtin_nontemporal_load((const f32x4*)src), v1 = __builtin_nontemporal_load((const f32x4*)(src + 4)); const float g = gk[k], bb = bk[k];
        u32x4 o; o.x = cvt_pk_bf16(v0[0] * g, v0[1] * g); o.y = cvt_pk_bf16(v0[2] * g, v0[3] * g); o.z = cvt_pk_bf16(v1[0] * g, v1[1] * g); o.w = cvt_pk_bf16(v1[2] * g, v1[3] * g);
        *(u32x4*)(WN + (size_t)k * DM + j0 + 8 * cg8) = o;
#pragma unroll
        for (int e = 0; e < 4; ++e) { sacc[e] += bb * v0[e]; sacc[4 + e] += bb * v1[e]; } }
#pragma unroll
    for (int e = 0; e < 8; ++e) { float v = sacc[e]; v += __shfl_xor(v, 8); v += __shfl_xor(v, 16); v += __shfl_xor(v, 32); if (kr == 0) unsafeAtomicAdd(bW + j0 + 8 * cg8 + e, v); }
}

__device__ __forceinline__ int causal_bucket(int n) {
    if (n < 16) return n;
    const float nf = (float)n;
    int large = 16 + (int)(logf(nf / 16.f) / 2.0794415416798357f * 16.f);
    return large < 31 ? large : 31;
}

__device__ __forceinline__ size_t zero_opaque() { size_t z = 0; asm volatile("" : "+s"(z)); return z; }
__device__ __forceinline__ const float* inp_ptr(const Args& a, int k) { return a.in[k] + zero_opaque(); }
#define INP(k) inp_ptr(a, k)
__device__ __forceinline__ unsigned char* ws_opaque(const Args& a) { return a.ws + zero_opaque(); }
__device__ __forceinline__ float* out_opaque(const Args& a) { return a.out + zero_opaque(); }
#define WSP(type, off) ((type*)(ws_opaque(a) + (off)))
__global__ void __launch_bounds__(NTHR, 2) mega_fwd(Args a) {
    extern __shared__ __attribute__((aligned(16))) unsigned char lds[];
    volatile LAS unsigned* bst = (volatile LAS unsigned*)((LAS unsigned char*)lds + LDS_BYTES - 64);
    if (threadIdx.x == 0) { bst[0] = 0u; bst[1] = 0u; }
    __syncthreads();
    (void)xcd_barrier_post((unsigned*)(a.ws + WS_BAR), bst);
#define GRID_BAR() do { XcdBarrier xb_; xb_.bar = (unsigned*)(ws_opaque(a) + WS_BAR); unsigned x_ = xb_xcc_id(); asm volatile("" : "+s"(x_)); xb_.x = x_; xb_.st = bst; xcd_barrier(xb_); } while (0)
    const int G = gridDim.x;
    const int NGW = G * NWAVES, NGT = G * NTHR;
    {
        PH_IDS;
        unsigned char* ws = ws_opaque(a);
        float* lamp = (float*)(ws + WS_LAM); float* btab = (float*)(ws + WS_BTAB); bf16_t* wtril = (bf16_t*)(ws + WS_WTRIL); bf16_t* membf = (bf16_t*)(ws + WS_MEMBF); bf16_t* XN = (bf16_t*)(ws + WS_XN);
        LAS float* scr = (LAS float*)((LAS unsigned char*)lds + wave * 17408);
        constexpr int I_IN = 32 * 88, I_SQ = 32 * 32, I_KV = 32 * 64, I_GU = 32 * 176, I_D = 88 * 32;
        constexpr int PER_LAYER = I_IN + 3 * I_SQ + I_KV + I_GU + I_D;
        for (int it = gw; it < 2 * PER_LAYER; it += NGW) {
            const int l = it / PER_LAYER; int r = it % PER_LAYER;
            unsigned char* wl = ws + WS_W + (size_t)l * W_LAYER;
            float* cl = (float*)(ws + WS_C) + (size_t)l * C_LAYER;
            if (r < I_IN) { const bool f = l > 0;
                p0_transpose_item(INP(3) + (size_t)l * DM * INC, DM, INC, (bf16_t*)(wl + W_IN), 0, f ? INP(22) : nullptr, f ? INP(23) : nullptr, cl + C_IN, cl + C_IN + INC, scr, r, lane); continue; } r -= I_IN;
            if (r < I_SQ) { p0_transpose_item(INP(12) + (size_t)l * DM * DM, DM, DM, (bf16_t*)(wl + W_OUT), 0, nullptr, nullptr, nullptr, nullptr, scr, r, lane); continue; } r -= I_SQ;
            if (r < I_SQ) { p0_wq_item(INP(15) + (size_t)l * DM * DM, (bf16_t*)(wl + W_Q), INP(13) + (size_t)l * DM, INP(14) + (size_t)l * DM, cl + C_Q + DM, r, lane); continue; } r -= I_SQ;
            if (r < I_KV) { p0_transpose_item(INP(16) + (size_t)l * DM * 2 * DM, DM, 2 * DM, (bf16_t*)(wl + W_KV), 0, nullptr, nullptr, nullptr, nullptr, scr, r, lane); continue; } r -= I_KV;
            if (r < I_SQ) { p0_transpose_item(INP(17) + (size_t)l * DM * DM, DM, DM, (bf16_t*)(wl + W_O), 0, nullptr, nullptr, nullptr, nullptr, scr, r, lane); continue; } r -= I_SQ;
            if (r < I_GU) { p0_transpose_item(INP(20) + (size_t)l * DM * 2 * DFF, DM, 2 * DFF, (bf16_t*)(wl + W_GU), 1, INP(18) + (size_t)l * DM, INP(19) + (size_t)l * DM, cl + C_GU, cl + C_GU + 2 * DFF, scr, r, lane); continue; } r -= I_GU;
            p0_transpose_item(INP(21) + (size_t)l * DFF * DM, DFF, DM, (bf16_t*)(wl + W_D), 0, nullptr, nullptr, nullptr, nullptr, scr, r, lane);
        }
        for (size_t i = gt; i < (size_t)T * DM / 8; i += NGT) {
            const f32x4 v0 = *(const f32x4*)(INP(0) + i * 8), v1 = *(const f32x4*)(INP(0) + i * 8 + 4);
            u32x4 w; w.x = cvt_pk_bf16(v0[0], v0[1]); w.y = cvt_pk_bf16(v0[2], v0[3]); w.z = cvt_pk_bf16(v1[0], v1[1]); w.w = cvt_pk_bf16(v1[2], v1[3]);
            *(u32x4*)(XN + i * 8) = w;
        }
        for (size_t i = gt; i < (size_t)BATCH * NMEM * DM / 8; i += NGT) {
            const f32x4 v0 = *(const f32x4*)(INP(1) + i * 8), v1 = *(const f32x4*)(INP(1) + i * 8 + 4);
            u32x4 w; w.x = cvt_pk_bf16(v0[0], v0[1]); w.y = cvt_pk_bf16(v0[2], v0[3]); w.z = cvt_pk_bf16(v1[0], v1[1]); w.w = cvt_pk_bf16(v1[2], v1[3]);
            *(u32x4*)(membf + i * 8) = w;
        }
        for (int i = gt; i < DEPTH * 4 * 128 * 128; i += NGT) { const int s = i & 127, t = (i >> 7) & 127; wtril[i] = s <= t ? f2bf(INP(7)[i]) : (bf16_t)0; }
        if (gt < 8 * 256) { const int hm = gt >> 8, d = gt & 255; const float* rb = INP(2);
            btab[gt] = (rb[causal_bucket(d) * 8 + hm] - rb[31 * 8 + hm]) * (1.f / att::SCALE); }
        if (cu == 0 && wave == 0) {
            for (int l = 0; l < DEPTH; ++l) {
                const float* lq = INP(9) + l * 256; const float* lk = INP(10) + l * 256;
                float s0 = lq[lane] * lk[lane] + lq[lane + 64] * lk[lane + 64];
                float s1 = lq[128 + lane] * lk[128 + lane] + lq[192 + lane] * lk[192 + lane];
                s0 = wave_sum(s0); s1 = wave_sum(s1);
                const float lam_init = 0.8f - 0.6f * expf(-0.3f * (float)l);
                if (lane == 0) lamp[l] = expf(s0) - expf(s1) + lam_init;
            }
        }
    }
    GRID_BAR();

#pragma unroll 1
    for (int l = 0; l < DEPTH; ++l) {
        {
            unsigned char* ws = ws_opaque(a);
            pg8::Gemm g{(const bf16_t*)(ws + WS_XN), (const bf16_t*)(ws + WS_W + (size_t)l * W_LAYER + W_IN), DM, DM, DM, 1, 0, 0, 0, 0};
            pg8::Order S; S.init(T, INC, 1, G, cu_opaque());
            const float* cl = (const float*)(ws + WS_C) + (size_t)l * C_LAYER;
            const float* st = l > 0 ? (const float*)(ws + WS_ST) + (size_t)(3 * l - 1) * T * 2 : nullptr;
            pg8::EpiSplit E{(bf16_t*)(ws + WS_PROJ), st, cl + C_IN, cl + C_IN + INC, (float*)(ws + WS_ST) + (size_t)(6 + l) * T * 2};
            pg8::gemm_phase<pg8::EpiSplit, true>((LAS unsigned char*)lds, g, S, E);
        }
        if (l == 0) {
            {
                unsigned char* ws = ws_opaque(a);
                pg8::Gemm g{(const bf16_t*)(ws + WS_MEMBF), (const bf16_t*)(ws + WS_W + W_KV), DM, DM, DM, 1, 0, 0, (long)(W_LAYER / 2), 0};
                pg8::Order S; const int cu = cu_opaque(); S.init(BATCH * NMEM, 2 * DM, 2, G, cu >= 128 && cu < 192 ? cu - 128 : -1);
                pg8::EpiBf16 E{(bf16_t*)(ws + WS_KV), 2 * DM, 1, (long)(BATCH * NMEM) * 2 * DM, 0, 1.f, nullptr, nullptr, nullptr, nullptr};
                pg8::gemm_phase<pg8::EpiBf16, true>((LAS unsigned char*)lds, g, S, E);
            }
        }
        GRID_BAR();

        if (l == 0) {
#pragma unroll 1
            for (int L2 = 0; L2 < DEPTH; ++L2) {
                {
                    unsigned char* ws = ws_opaque(a); unsigned char* wl2 = ws + WS_W + (size_t)L2 * W_LAYER;
                    const bf16_t* KVl = (const bf16_t*)(ws + WS_KV) + (size_t)L2 * BATCH * NMEM * 2 * DM;
                    float* cl = (float*)(ws + WS_C) + (size_t)L2 * C_LAYER;
                    pg8::Gemm g{KVl, (const bf16_t*)(wl2 + W_Q), 2 * DM, DM, 512, 4, (long)NMEM * 2 * DM, 512, 0, 512};
                    pg8::Order S; const int cu = cu_opaque(); S.init(NMEM, DM, 8, G, cu >= 64 * L2 && cu < 64 * L2 + 64 ? cu - 64 * L2 : -1);
                    pg8::EpiBf16 E{(bf16_t*)(wl2 + W_KV), DM, 1, (long)NMEM * DM, 0, 1.f, nullptr, nullptr, nullptr, cl + C_Q};
                    pg8::gemm_phase<pg8::EpiBf16, true>((LAS unsigned char*)lds, g, S, E);
                }
                {
                    unsigned char* ws = ws_opaque(a); unsigned char* wl2 = ws + WS_W + (size_t)L2 * W_LAYER;
                    const bf16_t* KVl = (const bf16_t*)(ws + WS_KV) + (size_t)L2 * BATCH * NMEM * 2 * DM;
                    pg8::Gemm g{(const bf16_t*)(wl2 + W_O), KVl + DM, DM, 2 * DM, 512, 4, 0, 512, (long)NMEM * 2 * DM, 512};
                    pg8::Order S; const int cu = cu_opaque(); S.init(DM, NMEM, 8, G, cu >= 128 + 64 * L2 && cu < 192 + 64 * L2 ? cu - 128 - 64 * L2 : -1);
                    pg8::EpiBf16 E{(bf16_t*)(wl2 + W_KV + 8 * MiB), 1024, 4, (long)DM * 1024, 256, 1.f, nullptr, nullptr, nullptr, nullptr};
                    pg8::gemm_phase<pg8::EpiBf16, true>((LAS unsigned char*)lds, g, S, E);
                }
            }
            {
                PH_IDS;
                unsigned char* ws = ws_opaque(a);
                for (int it = gw; it < DEPTH * 2048; it += NGW) {
                    const int L2 = it >> 11, r = it & 2047, b = r >> 10, h = (r >> 8) & 3, n = r & 255;
                    const bf16_t* kp = (const bf16_t*)(ws + WS_KV) + ((size_t)L2 * BATCH * NMEM + b * NMEM + n) * 2 * DM + h * 512 + 8 * lane;
                    float* cl = (float*)(ws + WS_C) + (size_t)L2 * C_LAYER;
                    const float* bw = cl + C_Q + DM + h * 512 + 8 * lane;
                    const u32x4 kw = *(const u32x4*)kp; const f32x4 b0 = *(const f32x4*)bw, b1 = *(const f32x4*)(bw + 4);
                    float d = (bf_lo(kw.x) * b0[0] + bf_hi(kw.x) * b0[1]) + (bf_lo(kw.y) * b0[2] + bf_hi(kw.y) * b0[3]) + (bf_lo(kw.z) * b1[0] + bf_hi(kw.z) * b1[1]) + (bf_lo(kw.w) * b1[2] + bf_hi(kw.w) * b1[3]);
                    d = wave_sum(d);
                    if (lane == 0) cl[C_QK2 + r] = d;
                }
            }
            __syncthreads();
        }
        {
            PH_IDS;
            bf16_t* PB = WSP(bf16_t, WS_PROJ); bf16_t* Y = WSP(bf16_t, WS_Y);
            const float* cw = INP(4) + (size_t)l * 3 * 512;
            const int cg8 = tid & 63, c0 = cg8 * 8, gi = cg8 >> 4, cc = c0 & 127;
            float k0[8], k1[8], k2[8];
#pragma unroll
            for (int e = 0; e < 8; ++e) { k0[e] = cw[c0 + e]; k1[e] = cw[512 + c0 + e]; k2[e] = cw[1024 + c0 + e]; }
            for (int r4 = gt >> 6; r4 < T / 4; r4 += NGT >> 6) {
                const int r = 4 * r4, t = r & (SEQ - 1);
                const bf16_t* pb = PB + ((size_t)(0 + gi) * T + r) * 128 + cc;
                const bf16_t* pc = PB + ((size_t)(4 + gi) * T + r) * 128 + cc;
                const bf16_t* ph = PB + ((size_t)(8 + gi) * T + r) * 128 + cc;
                u32x4 wc[6], wh[6], wb[4];
#pragma unroll
                for (int i = 0; i < 6; ++i) { wc[i] = (u32x4){0, 0, 0, 0}; wh[i] = (u32x4){0, 0, 0, 0}; }
                if (t >= 2) { wc[0] = *(const u32x4*)(pc - 256); wh[0] = *(const u32x4*)(ph - 256); wc[1] = *(const u32x4*)(pc - 128); wh[1] = *(const u32x4*)(ph - 128); }
#pragma unroll
                for (int i = 0; i < 4; ++i) { wc[2 + i] = *(const u32x4*)(pc + i * 128); wh[2 + i] = *(const u32x4*)(ph + i * 128); wb[i] = *(const u32x4*)(pb + i * 128); }
                float z[6][8];
#pragma unroll
                for (int i = 0; i < 6; ++i)
#pragma unroll
                    for (int j = 0; j < 4; ++j) { z[i][2 * j] = bf_lo(wc[i][j]) * bf_lo(wh[i][j]); z[i][2 * j + 1] = bf_hi(wc[i][j]) * bf_hi(wh[i][j]); }
#pragma unroll
                for (int i = 0; i < 4; ++i) { float y[8];
#pragma unroll
                    for (int j = 0; j < 4; ++j) {
                        y[2 * j] = bf_lo(wb[i][j]) * (k0[2 * j] * z[i][2 * j] + k1[2 * j] * z[i + 1][2 * j] + k2[2 * j] * z[i + 2][2 * j]);
                        y[2 * j + 1] = bf_hi(wb[i][j]) * (k0[2 * j + 1] * z[i][2 * j + 1] + k1[2 * j + 1] * z[i + 1][2 * j + 1] + k2[2 * j + 1] * z[i + 2][2 * j + 1]); }
                    u32x4 w; w.x = cvt_pk_bf16(y[0], y[1]); w.y = cvt_pk_bf16(y[2], y[3]); w.z = cvt_pk_bf16(y[4], y[5]); w.w = cvt_pk_bf16(y[6], y[7]);
                    *(u32x4*)(Y + (size_t)(r + i) * DM + c0) = w; }
            }
        }
        {
            PH_IDS;
            bf16_t* PB = WSP(bf16_t, WS_PROJ); bf16_t* Y = WSP(bf16_t, WS_Y); bf16_t* wtril = WSP(bf16_t, WS_WTRIL);
            float* st = (float*)(lds + 40960);
            bf16_t* vT = (bf16_t*)lds;
            const float* lng = INP(5) + (size_t)l * 512; const float* lnb = INP(6) + (size_t)l * 512;
            const float* bs = INP(8) + (size_t)l * 512;
            const float* gstat = WSP(float, WS_ST) + (size_t)(6 + l) * T * 2;
            float* svL = (float*)(lds + 49152);
            for (int un = cu; un < (T / 128) * 4; un += G) {
                const int ch = un >> 2, gi = un & 3, r0 = ch * 128;
                if (tid < 128) {
                    const float s1 = gstat[2 * (r0 + tid)], s2 = gstat[2 * (r0 + tid) + 1];
                    const float mean = s1 * (1.f / 512.f), var = fmaxf(s2 * (1.f / 512.f) - mean * mean, 0.f);
                    st[2 * tid] = mean; st[2 * tid + 1] = rsqrtf(var + LN_EPS); }
                __syncthreads();
                {
                    const int tok = tid >> 2, cq = (tid & 3) * 32; const float mean = st[2 * tok], rstd = st[2 * tok + 1];
                    const bf16_t* vp = PB + ((size_t)(16 + gi) * T + r0 + tok) * 128 + cq;
#pragma unroll
                    for (int i = 0; i < 4; ++i) { const u32x4 w = *(const u32x4*)(vp + 8 * i);
#pragma unroll
                        for (int j = 0; j < 4; ++j) { const int c = cq + 8 * i + 2 * j;
                            const float x0 = gelu_tanh(bf_lo(w[j])), x1 = gelu_tanh(bf_hi(w[j]));
                            vT[c * 136 + tok] = f2bf((x0 - mean) * rstd * lng[gi * 128 + c] + lnb[gi * 128 + c]);
                            vT[(c + 1) * 136 + tok] = f2bf((x1 - mean) * rstd * lng[gi * 128 + c + 1] + lnb[gi * 128 + c + 1]); } }
                }
                __syncthreads();
                {
                    f32x4 acc[8];
#pragma unroll
                    for (int ct = 0; ct < 8; ++ct) acc[ct] = (f32x4){0.f, 0.f, 0.f, 0.f};
                    const bf16_t* wrow = wtril + ((size_t)(l * 4 + gi) * 128 + 16 * wave + (lane & 15)) * 128 + 8 * (lane >> 4);
#pragma unroll
                    for (int kk = 0; kk < 4; ++kk) { const bf16x8 av = *(const bf16x8*)(wrow + kk * 32);
#pragma unroll
                        for (int ct = 0; ct < 8; ++ct) { const bf16x8 bv = *(const bf16x8*)(vT + (ct * 16 + (lane & 15)) * 136 + kk * 32 + 8 * (lane >> 4));
                            acc[ct] = __builtin_amdgcn_mfma_f32_16x16x32_bf16(av, bv, acc[ct], 0, 0, 0); } }
#pragma unroll
                    for (int j = 0; j < 4; ++j) { const int t = 16 * wave + 4 * (lane >> 4) + j; const float bt = bs[gi * 128 + t];
#pragma unroll
                        for (int ct = 0; ct < 8; ++ct) svL[t * 132 + ct * 16 + (lane & 15)] = acc[ct][j] + bt; }
                }
                __syncthreads();
                {
                    const int c0 = (tid & 15) * 8;
#pragma unroll
                    for (int i = 0; i < 4; ++i) { const int t = 32 * i + (tid >> 4);
                        const u32x4 uw = *(const u32x4*)(PB + ((size_t)(12 + gi) * T + r0 + t) * 128 + c0);
                        const f32x4 s0 = *(const f32x4*)(svL + t * 132 + c0), s1 = *(const f32x4*)(svL + t * 132 + c0 + 4);
                        u32x4 w; w.x = cvt_pk_bf16(gelu_tanh(bf_lo(uw.x)) * s0[0], gelu_tanh(bf_hi(uw.x)) * s0[1]); w.y = cvt_pk_bf16(gelu_tanh(bf_lo(uw.y)) * s0[2], gelu_tanh(bf_hi(uw.y)) * s0[3]);
                        w.z = cvt_pk_bf16(gelu_tanh(bf_lo(uw.z)) * s1[0], gelu_tanh(bf_hi(uw.z)) * s1[1]); w.w = cvt_pk_bf16(gelu_tanh(bf_lo(uw.w)) * s1[2], gelu_tanh(bf_hi(uw.w)) * s1[3]);
                        *(u32x4*)(Y + (size_t)(r0 + t) * DM + 512 + gi * 128 + c0) = w; }
                }
                __syncthreads();
            }
        }
        {
            PH_IDS;
            bf16_t* PB = WSP(bf16_t, WS_PROJ); float* OATT = WSP(float, WS_R1); float* btab = WSP(float, WS_BTAB);
            float* btl = (float*)(lds + att2::L_BT);
            for (int i = tid; i < 8 * 256; i += NTHR) btl[i] = btab[i];
            __syncthreads();
            const att::bf16* PBb = (const att::bf16*)PB;
#pragma unroll 1
            for (int L = cu; L < 512; L += G) {
                const int k_ = L >> 3, hm = L & 7, b = k_ >> 5, x = k_ & 31, h = hm >> 1;
#pragma unroll 1
                for (int pass = 0; pass < 2; ++pass) {
                    const int qb = pass ? 63 - x : x;
                    att2::Blk c;
                    c.Q = PBb + ((size_t)(20 + hm) * T + (size_t)b * SEQ + qb * 128) * 128; c.K = PBb + ((size_t)(28 + hm) * T + (size_t)b * SEQ) * 128;
                    c.V0 = PBb + ((size_t)(36 + h * 2) * T + (size_t)b * SEQ) * 128; c.V1 = PBb + ((size_t)(37 + h * 2) * T + (size_t)b * SEQ) * 128;
                    c.O0 = OATT + ((size_t)((b * 8 + hm) * 2 + 0) * SEQ + qb * 128) * 128; c.O1 = OATT + ((size_t)((b * 8 + hm) * 2 + 1) * SEQ + qb * 128) * 128;
                    c.P0 = qb * 128; c.hm = hm;
                    att2::attn2_block(c, (char*)lds);
                }
            }
        }
        GRID_BAR();

        {
            PH_IDS;
            float* OATT = WSP(float, WS_R1); bf16_t* Y = WSP(bf16_t, WS_Y); float* lamp = WSP(float, WS_LAM);
            const float lam_init = 0.8f - 0.6f * expf(-0.3f * (float)l);
            const float lam = lamp[l]; const float* sg = INP(11) + (size_t)l * 256;
            const f32x4 gv = *(const f32x4*)(sg + 4 * lane);
            for (int it = gw; it < T * 4; it += NGW) {
                const int r = it >> 2, h = it & 3, b = r >> 13, t = r & (SEQ - 1);
                const int half = lane >> 5, e = (lane & 31) * 4;
                const size_t i0 = ((size_t)(((b * 4 + h) * 2 + 0) * 2 + half) * SEQ + t) * 128 + e;
                const size_t i1 = ((size_t)(((b * 4 + h) * 2 + 1) * 2 + half) * SEQ + t) * 128 + e;
                const f32x4 o0 = *(const f32x4*)(OATT + i0), o1 = *(const f32x4*)(OATT + i1);
                const f32x4 d = o0 - o1 * lam;
                const float ss = wave_sum(d[0] * d[0] + d[1] * d[1] + d[2] * d[2] + d[3] * d[3]);
                const float sc = rsqrtf(ss * (1.f / 256.f) + LN_EPS) * (1.f - lam_init);
                u32x2 w; w.x = cvt_pk_bf16(d[0] * sc * gv[0], d[1] * sc * gv[1]); w.y = cvt_pk_bf16(d[2] * sc * gv[2], d[3] * sc * gv[3]);
                *(u32x2*)(Y + (size_t)r * DM + 1024 + h * 256 + 4 * lane) = w;
            }
        }
        GRID_BAR();

#define LN_OUT_PASS(gam, bet) do { PH_IDS; float* X = out_opaque(a); const bf16_t* ZB = WSP(bf16_t, WS_XN); \
            for (int r = gw; r < T; r += NGW) { const bf16_t* zr = ZB + (size_t)r * DM; float* xr = X + (size_t)r * DM; f32x4 v[8]; float s = 0.f; \
                _Pragma("unroll") for (int j = 0; j < 4; ++j) { const u32x4 w = *(const u32x4*)(zr + 8 * lane + 512 * j); \
                    v[2 * j] = (f32x4){bf_lo(w.x), bf_hi(w.x), bf_lo(w.y), bf_hi(w.y)}; v[2 * j + 1] = (f32x4){bf_lo(w.z), bf_hi(w.z), bf_lo(w.w), bf_hi(w.w)}; } \
                _Pragma("unroll") for (int j = 0; j < 8; ++j) s += (v[j][0] + v[j][1]) + (v[j][2] + v[j][3]); \
                const float mean = wave_sum(s) * (1.f / DM); float s2 = 0.f; \
                _Pragma("unroll") for (int j = 0; j < 8; ++j) { v[j] = v[j] - mean; s2 += (v[j][0] * v[j][0] + v[j][1] * v[j][1]) + (v[j][2] * v[j][2] + v[j][3] * v[j][3]); } \
                const float rstd = rsqrtf(wave_sum(s2) * (1.f / DM) + LN_EPS); \
                _Pragma("unroll") for (int j = 0; j < 8; ++j) { const int c = 8 * lane + 512 * (j >> 1) + 4 * (j & 1); \
                    const f32x4 gg = *(const f32x4*)((gam) + c), bb = *(const f32x4*)((bet) + c); \
                    *(f32x4*)(xr + c) = v[j] * rstd * gg + bb; } } } while (0)

        {
            unsigned char* ws = ws_opaque(a); float* X = out_opaque(a); float* ST = (float*)(ws + WS_ST);
            pg8::Gemm g{(const bf16_t*)(ws + WS_Y), (const bf16_t*)(ws + WS_W + (size_t)l * W_LAYER + W_OUT), DM, DM, DM, 1, 0, 0, 0, 0};
            pg8::Order S; S.init(T, DM, 1, G, cu_opaque());
            pg8::EpiRes E{nullptr, l == 0 ? INP(0) : nullptr, ST + (size_t)(l > 0 ? 3 * l - 1 : 0) * T * 2, INP(22) + (size_t)(l > 0 ? l - 1 : 0) * DM, INP(23) + (size_t)(l > 0 ? l - 1 : 0) * DM,
                          (bf16_t*)(ws + WS_XN), ST + (size_t)(3 * l) * T * 2, ALPHA, 0};
            pg8::gemm_phase<pg8::EpiRes, true>((LAS unsigned char*)lds, g, S, E);
        }
        GRID_BAR();

        {
            unsigned char* ws = ws_opaque(a);
            const float* cl = (const float*)(ws + WS_C) + (size_t)l * C_LAYER;
            pg8::Gemm g{(const bf16_t*)(ws + WS_XN), (const bf16_t*)(ws + WS_W + (size_t)l * W_LAYER + W_KV), DM, DM, DM, 4, (long)SEQ * DM, 0, (long)4 * NMEM * DM, (long)NMEM * DM};
            pg8::Order S; S.init(SEQ, NMEM, 8, G, cu_opaque());
            pg8::EpiSoftmax E{(bf16_t*)(ws + WS_PROJ + 64 * MiB), (const float*)(ws + WS_ST) + (size_t)(3 * l) * T * 2, cl + C_Q, cl + C_QK2, 0.044194173824159216f};
            pg8::gemm_phase<pg8::EpiSoftmax, true>((LAS unsigned char*)lds, g, S, E);
        }
        GRID_BAR();
        {
            unsigned char* ws = ws_opaque(a); float* ST = (float*)(ws + WS_ST);
            pg8::Gemm g{(const bf16_t*)(ws + WS_PROJ + 64 * MiB), (const bf16_t*)(ws + WS_W + (size_t)l * W_LAYER + W_KV + 8 * MiB), 1024, 1024, 1024, 1, (long)SEQ * 1024, 0, (long)DM * 1024, 0};
            pg8::Order S; S.init(SEQ, DM, 2, G, cu_opaque());
            pg8::EpiRes E{nullptr, nullptr, ST + (size_t)(3 * l) * T * 2, INP(13) + (size_t)l * DM, INP(14) + (size_t)l * DM, (bf16_t*)(ws + WS_XN), ST + (size_t)(3 * l + 1) * T * 2, ALPHA, SEQ};
            pg8::gemm_phase<pg8::EpiRes, true>((LAS unsigned char*)lds, g, S, E);
        }
        GRID_BAR();
        {
            unsigned char* ws = ws_opaque(a);
            const float* cl = (const float*)(ws + WS_C) + (size_t)l * C_LAYER;
            pg8::Gemm g{(const bf16_t*)(ws + WS_XN), (const bf16_t*)(ws + WS_W + (size_t)l * W_LAYER + W_GU), DM, DM, DM, 1, 0, 0, 0, 0};
            pg8::Order S; S.init(T, 2 * DFF, 1, G, cu_opaque());
            pg8::EpiSwiglu E{(bf16_t*)(ws + WS_PROJ), (const float*)(ws + WS_ST) + (size_t)(3 * l + 1) * T * 2, cl + C_GU, cl + C_GU + 2 * DFF};
            pg8::gemm_phase<pg8::EpiSwiglu, true>((LAS unsigned char*)lds, g, S, E);
        }
        GRID_BAR();
        {
            unsigned char* ws = ws_opaque(a); float* X = out_opaque(a); float* ST = (float*)(ws + WS_ST);
            pg8::Gemm g{(const bf16_t*)(ws + WS_PROJ), (const bf16_t*)(ws + WS_W + (size_t)l * W_LAYER + W_D), DFF, DFF, DFF, 1, 0, 0, 0, 0};
            pg8::Order S; S.init(T, DM, 1, G, cu_opaque());
            pg8::EpiRes E{nullptr, nullptr, ST + (size_t)(3 * l + 1) * T * 2, INP(18) + (size_t)l * DM, INP(19) + (size_t)l * DM, (bf16_t*)(ws + WS_XN), ST + (size_t)(3 * l + 2) * T * 2, ALPHA, 0};
            pg8::gemm_phase<pg8::EpiRes, true>((LAS unsigned char*)lds, g, S, E);
        }
        GRID_BAR();
        if (l + 1 == DEPTH) { LN_OUT_PASS(INP(22) + (size_t)l * DM, INP(23) + (size_t)l * DM); }
#undef LN_OUT_PASS
    }
    if (a.ws == nullptr) cg::this_grid().sync();
}

extern "C" void kernel_launch(void* const* d_in, const int* in_sizes, int n_in, void* d_out, int out_size, void* d_ws, size_t ws_size, hipStream_t stream) {
    static int grid = 0;
    if (grid == 0) {
        if (n_in != 24 || in_sizes[0] != T * DM || out_size != T * DM || ws_size < WS_END) {
            fprintf(stderr, "kernel_launch: unexpected shapes (n_in %d, in0 %d, out %d, ws %zu); nothing launched\n", n_in, n_in > 0 ? in_sizes[0] : -1, out_size, ws_size); grid = -1; return; }
        int dev = 0, cus = 0, per_cu = 0;
        (void)hipGetDevice(&dev);
        if (hipDeviceGetAttribute(&cus, hipDeviceAttributeMultiprocessorCount, dev) != hipSuccess || cus <= 0) cus = 256;
        if (hipFuncSetAttribute((const void*)mega_fwd, hipFuncAttributeMaxDynamicSharedMemorySize, LDS_BYTES) != hipSuccess) fprintf(stderr, "kernel_launch: hipFuncSetAttribute failed\n");
        if (hipOccupancyMaxActiveBlocksPerMultiprocessor(&per_cu, (const void*)mega_fwd, NTHR, LDS_BYTES) != hipSuccess || per_cu < 1) { fprintf(stderr, "kernel_launch: occupancy query says %d\n", per_cu); per_cu = 1; }
        (void)hipGetLastError();
        grid = cus * per_cu;
    }
    if (grid < 0) return;
    if (hipMemsetAsync((char*)d_ws + WS_BAR, 0, WS_ST + 1 * MiB - WS_BAR, stream) != hipSuccess) { fprintf(stderr, "kernel_launch: hipMemsetAsync failed\n"); return; }
    Args a{};
    for (int i = 0; i < 24; ++i) a.in[i] = (const float*)d_in[i];
    a.out = (float*)d_out; a.ws = (unsigned char*)d_ws;
    void* args[] = {&a};
    hipError_t e = hipLaunchCooperativeKernel((const void*)mega_fwd, dim3(grid), dim3(NTHR), args, LDS_BYTES, stream);
    if (e != hipSuccess) fprintf(stderr, "cooperative launch failed: %s (grid %d)\n", hipGetErrorString(e), grid);
}
```

```cpp
#include <hip/hip_runtime.h>
#include <hip/hip_cooperative_groups.h>
#include <hip/hip_bf16.h>
#include <cstdio>
#include <cstdint>
namespace cg = cooperative_groups;

constexpr int BATCH = 2, SEQ = 8192, DM = 2048, DEPTH = 2, T = BATCH * SEQ;
constexpr int NMEM = 256, INC = 5632, DFF = 5632;
constexpr float ALPHA = 1.4142135623730951f;
constexpr float LN_EPS = 1e-5f;
constexpr int NTHR = 512, NWAVES = 8;

constexpr size_t MiB = 1u << 20;
constexpr size_t WS_LAM = 0;
constexpr size_t WS_BTAB = 4096;
constexpr size_t WS_BAR = 512 * 1024;
constexpr size_t WS_C = 576 * 1024;
constexpr int C_Q = 0, C_GU = 4096, C_IN = 4096 + 22528, C_QK2 = 4096 + 22528 + 11264, C_LAYER = C_QK2 + 2048;
constexpr size_t WS_ST = 1 * MiB;
constexpr size_t WS_WTRIL = 12 * MiB;
constexpr size_t WS_MEMBF = 2 * MiB;
constexpr size_t WS_KV = 4 * MiB;
constexpr size_t WS_W = 16 * MiB;
constexpr size_t W_IN = 0, W_OUT = 22 * MiB, W_Q = 30 * MiB, W_KV = 38 * MiB, W_O = 54 * MiB, W_GU = 62 * MiB, W_D = 106 * MiB, W_LAYER = 128 * MiB;
constexpr size_t WS_XN = 272 * MiB;
constexpr size_t WS_PROJ = 336 * MiB;
constexpr size_t WS_R1 = 512 * MiB;
constexpr size_t WS_Y = 640 * MiB;
constexpr size_t WS_END = 704 * MiB;
constexpr int LDS_BYTES = 147456;

typedef unsigned short bf16_t;
typedef short bf16x8 __attribute__((ext_vector_type(8)));
typedef float f32x4 __attribute__((ext_vector_type(4)));
typedef float f32x16 __attribute__((ext_vector_type(16)));
typedef unsigned u32x4 __attribute__((ext_vector_type(4)));
typedef unsigned u32x2 __attribute__((ext_vector_type(2)));
#define LAS __attribute__((address_space(3)))
#define GAS __attribute__((address_space(1)))

__device__ __forceinline__ unsigned cvt_pk_bf16(float lo, float hi) { unsigned r; asm volatile("v_cvt_pk_bf16_f32 %0, %1, %2" : "=v"(r) : "v"(lo), "v"(hi)); return r; }
__device__ __forceinline__ float bf_lo(unsigned w) { return __uint_as_float(w << 16); }
__device__ __forceinline__ float bf_hi(unsigned w) { return __uint_as_float(w & 0xffff0000u); }
__device__ __forceinline__ float bf2f(bf16_t b) { return __uint_as_float(((unsigned)b) << 16); }
__device__ __forceinline__ bf16_t f2bf(float f) { return (bf16_t)(cvt_pk_bf16(f, 0.f) & 0xffffu); }
__device__ __forceinline__ int ltid() { int t = threadIdx.x; asm volatile("" : "+v"(t)); return t; }
__device__ __forceinline__ int cu_opaque() { int c = blockIdx.x; asm volatile("" : "+s"(c)); return c; }
#define PH_IDS const int cu = cu_opaque(); const int tid = ltid(), lane = tid & 63, wave = __builtin_amdgcn_readfirstlane(tid >> 6), gw = cu * NWAVES + wave, gt = cu * NTHR + tid; (void)lane; (void)wave; (void)gw; (void)gt
__device__ __forceinline__ float wave_sum(float v) {
#pragma unroll
    for (int o = 1; o < 64; o <<= 1) v += __shfl_xor(v, o);
    return v;
}
__device__ __forceinline__ float wave_max(float v) {
#pragma unroll
    for (int o = 1; o < 64; o <<= 1) v = fmaxf(v, __shfl_xor(v, o));
    return v;
}
__device__ __forceinline__ float gelu_tanh(float x) {
    const float y = 0.7978845608028654f * (x + 0.044715f * x * x * x);
    return x * __builtin_amdgcn_rcpf(1.f + __expf(-2.f * y));
}

namespace pg8 {
constexpr int BM = 256, BK = 64, HALF = 128, HTB = HALF * BK * 2, STAGE_BYTES = 8 * HTB, NXCD = 8, WGM = 8;
__host__ __device__ __forceinline__ int lds_byte(int r, int c) { const int st = (r >> 4) * 2 + (c >> 5), rr = r & 15, cc = c & 31, ob = rr * 64 + cc * 2; return st * 1024 + (ob ^ (((ob >> 9) & 1) << 5)); }
__host__ __device__ __forceinline__ void stage_rc(int b, int& R, int& C) { const int st = b / 1024, sb = b % 1024, swz = sb ^ (((sb >> 9) & 1) << 5); R = (st >> 1) * 16 + swz / 64; C = (st & 1) * 32 + (swz % 64) / 2; }
__host__ __device__ __forceinline__ int perm32(int rho) { const int n = rho >> 4, i = rho & 15; return 8 * (i >> 2) + 4 * n + (i & 3); }

struct Unit { int pm, pn, bz; };
struct Gemm { const bf16_t* A; const bf16_t* Bt; int lda, ldb, K, nb0; long a_s1, a_s0, b_s1, b_s0; };
__device__ __forceinline__ const char* unit_a(const Gemm& g, const Unit& u) { const int b1 = u.bz / g.nb0, b0 = u.bz % g.nb0; return (const char*)(g.A + (size_t)b1 * g.a_s1 + (size_t)b0 * g.a_s0 + (size_t)u.pm * BM * g.lda); }
__device__ __forceinline__ const char* unit_b(const Gemm& g, const Unit& u) { const int b1 = u.bz / g.nb0, b0 = u.bz % g.nb0; return (const char*)(g.Bt + (size_t)b1 * g.b_s1 + (size_t)b0 * g.b_s0 + (size_t)u.pn * BM * g.ldb); }

struct Order {
    int nM, nN, nB, G, c;
    __device__ void init(int M, int N, int nB_, int G_, int c_) { nM = M / BM; nN = N / BM; nB = nB_; G = G_; c = c_; }
    __device__ bool next(int i, Unit& u) const {
        const long L = (long)i * G + c; const int nwg = nM * nN; if (c < 0 || L >= (long)nwg * nB) return false;
        if (nB > 1) { u.bz = (int)(L / nwg); const int w = (int)(L % nwg); u.pn = w / nM; u.pm = w % nM; return true; }
        u.bz = 0;
        int wgid = (int)L; { const int q = nwg / NXCD, r = nwg % NXCD, xcd = wgid % NXCD, off = wgid / NXCD; wgid = (xcd < r ? xcd * (q + 1) : r * (q + 1) + (xcd - r) * q) + off; }
        const int nig = WGM * nN, gid = wgid / nig, fm = gid * WGM, gsz = (nM - fm) < WGM ? (nM - fm) : WGM;
        u.pm = fm + ((wgid % nig) % gsz); u.pn = (wgid % nig) / gsz; return true;
    }
};

__device__ __forceinline__ void row_stats(const float* st, int row, float& mean, float& rstd) {
    const float s1 = st[2 * row], s2 = st[2 * row + 1];
    mean = s1 * (1.f / DM); const float var = fmaxf(s2 * (1.f / DM) - mean * mean, 0.f); rstd = rsqrtf(var + LN_EPS);
}
struct EpiSplit {
    static constexpr bool PERM = true, AFTER_DRAIN = false;
    bf16_t* P; const float* st; const float* c1; const float* c2;
    float* gst;
    __device__ __forceinline__ void operator()(const f32x4 (&acc)[2][2][4][2], const Unit& u, int wr, int wc, int fr, int fq) const {
        const int row0 = u.pm * BM + wr * 64 + fr, col0 = u.pn * BM + wc * 32 + 8 * fq;
        const bool vg = (u.pn == 8 || u.pn == 9);
        f32x4 k1[2][2], k2[2][2];
        if (st) {
#pragma unroll
            for (int bj = 0; bj < 2; ++bj)
#pragma unroll
                for (int n = 0; n < 2; ++n) { k1[bj][n] = *(const f32x4*)(c1 + col0 + bj * HALF + 4 * n); k2[bj][n] = *(const f32x4*)(c2 + col0 + bj * HALF + 4 * n); } }
#pragma unroll
        for (int ai = 0; ai < 2; ++ai)
#pragma unroll
            for (int m = 0; m < 4; ++m) { const int row = row0 + ai * HALF + m * 16;
                float mean = 0.f, rstd = 1.f; if (st) row_stats(st, row, mean, rstd);
                float gs = 0.f, gq = 0.f;
#pragma unroll
                for (int bj = 0; bj < 2; ++bj) { f32x4 v0 = acc[ai][bj][m][0], v1 = acc[ai][bj][m][1];
                    if (st) { v0 = (v0 - k1[bj][0] * mean) * rstd + k2[bj][0]; v1 = (v1 - k1[bj][1] * mean) * rstd + k2[bj][1]; }
                    u32x4 w; w.x = cvt_pk_bf16(v0[0], v0[1]); w.y = cvt_pk_bf16(v0[2], v0[3]); w.z = cvt_pk_bf16(v1[0], v1[1]); w.w = cvt_pk_bf16(v1[2], v1[3]);
                    *(u32x4*)(P + ((size_t)(u.pn * 2 + bj) * T + row) * 128 + wc * 32 + 8 * fq) = w;
                    if (vg) {
#pragma unroll
                        for (int j = 0; j < 4; ++j) { const float x0 = gelu_tanh(bf_lo(w[j])), x1 = gelu_tanh(bf_hi(w[j])); gs += x0 + x1; gq += x0 * x0 + x1 * x1; } } }
                if (vg) { gs += __shfl_xor(gs, 16); gs += __shfl_xor(gs, 32); gq += __shfl_xor(gq, 16); gq += __shfl_xor(gq, 32);
                    if (fq == 0) { unsafeAtomicAdd(gst + 2 * row, gs); unsafeAtomicAdd(gst + 2 * row + 1, gq); } } }
    }
};
struct EpiBf16 {
    static constexpr bool PERM = true, AFTER_DRAIN = false;
    bf16_t* O; int ldc, nb0; long o_s1, o_s0; float scale; const float* st; const float* c1; const float* c2; float* rsum;
    __device__ __forceinline__ void operator()(const f32x4 (&acc)[2][2][4][2], const Unit& u, int wr, int wc, int fr, int fq) const {
        const int row0 = u.pm * BM + wr * 64 + fr, col0 = u.pn * BM + wc * 32 + 8 * fq;
        bf16_t* base = O + (size_t)(u.bz / nb0) * o_s1 + (size_t)(u.bz % nb0) * o_s0;
        f32x4 k1[2][2], k2[2][2];
        if (st) {
#pragma unroll
            for (int bj = 0; bj < 2; ++bj)
#pragma unroll
                for (int n = 0; n < 2; ++n) { k1[bj][n] = *(const f32x4*)(c1 + col0 + bj * HALF + 4 * n); k2[bj][n] = *(const f32x4*)(c2 + col0 + bj * HALF + 4 * n); } }
#pragma unroll
        for (int ai = 0; ai < 2; ++ai)
#pragma unroll
            for (int m = 0; m < 4; ++m) { const int row = row0 + ai * HALF + m * 16; bf16_t* rowp = base + (size_t)row * ldc + col0;
                float mean = 0.f, rstd = 1.f; if (st) row_stats(st, row, mean, rstd);
                float rs = 0.f;
#pragma unroll
                for (int bj = 0; bj < 2; ++bj) { f32x4 v0 = acc[ai][bj][m][0], v1 = acc[ai][bj][m][1];
                    if (st) { v0 = (v0 - k1[bj][0] * mean) * rstd + k2[bj][0]; v1 = (v1 - k1[bj][1] * mean) * rstd + k2[bj][1]; }
                    v0 = v0 * scale; v1 = v1 * scale;
                    u32x4 w; w.x = cvt_pk_bf16(v0[0], v0[1]); w.y = cvt_pk_bf16(v0[2], v0[3]); w.z = cvt_pk_bf16(v1[0], v1[1]); w.w = cvt_pk_bf16(v1[2], v1[3]);
                    *(u32x4*)(rowp + bj * HALF) = w;
                    if (rsum) rs += ((bf_lo(w.x) + bf_hi(w.x)) + (bf_lo(w.y) + bf_hi(w.y))) + ((bf_lo(w.z) + bf_hi(w.z)) + (bf_lo(w.w) + bf_hi(w.w))); }
                if (rsum) { rs += __shfl_xor(rs, 16); rs += __shfl_xor(rs, 32); if (fq == 0) unsafeAtomicAdd(rsum + u.bz * 256 + row, rs); } }
    }
};
struct EpiF32 {
    static constexpr bool PERM = false, AFTER_DRAIN = false;
    float* out; int ldc; long o_bs; float scale;
    __device__ __forceinline__ void operator()(const f32x4 (&acc)[2][2][4][2], const Unit& u, int wr, int wc, int fr, int fq) const {
        const int row0 = u.pm * BM + wr * 64 + fr, col0 = u.pn * BM + wc * 32 + 4 * fq;
        float* ob = out + (size_t)u.bz * o_bs;
#pragma unroll
        for (int ai = 0; ai < 2; ++ai)
#pragma unroll
            for (int m = 0; m < 4; ++m) { const size_t off = (size_t)(row0 + ai * HALF + m * 16) * ldc + col0;
#pragma unroll
                for (int bj = 0; bj < 2; ++bj)
#pragma unroll
                    for (int n = 0; n < 2; ++n) *(f32x4*)(ob + off + bj * HALF + n * 16) = acc[ai][bj][m][n] * scale; }
    }
};
struct EpiRes {
    static constexpr bool PERM = true, AFTER_DRAIN = false;
    float* X; const float* raw; const float* pst; const float* pg; const float* pb; bf16_t* ZB; float* cst; float alpha; int brows;
    __device__ __forceinline__ void operator()(const f32x4 (&acc)[2][2][4][2], const Unit& u, int wr, int wc, int fr, int fq) const {
        const int row0 = u.bz * brows + u.pm * BM + wr * 64 + fr, col0 = u.pn * BM + wc * 32 + 8 * fq;
        f32x4 gv[2][2], bv[2][2];
        if (!raw) {
#pragma unroll
            for (int bj = 0; bj < 2; ++bj)
#pragma unroll
                for (int n = 0; n < 2; ++n) { gv[bj][n] = *(const f32x4*)(pg + col0 + bj * HALF + 4 * n); bv[bj][n] = *(const f32x4*)(pb + col0 + bj * HALF + 4 * n); } }
#pragma unroll
        for (int ai = 0; ai < 2; ++ai)
#pragma unroll
            for (int m = 0; m < 4; ++m) { const int row = row0 + ai * HALF + m * 16; const size_t off = (size_t)row * DM + col0;
                float mean = 0.f, rstd = 1.f; if (!raw) row_stats(pst, row, mean, rstd);
                float s1 = 0.f, s2 = 0.f;
#pragma unroll
                for (int bj = 0; bj < 2; ++bj) { f32x4 r0, r1;
                    if (raw) { r0 = *(const f32x4*)(raw + off + bj * HALF); r1 = *(const f32x4*)(raw + off + bj * HALF + 4); }
                    else { const u32x4 zw = *(const u32x4*)(ZB + off + bj * HALF);
                        r0 = (f32x4){bf_lo(zw.x), bf_hi(zw.x), bf_lo(zw.y), bf_hi(zw.y)}; r1 = (f32x4){bf_lo(zw.z), bf_hi(zw.z), bf_lo(zw.w), bf_hi(zw.w)};
                        r0 = (r0 - mean) * rstd * gv[bj][0] + bv[bj][0]; r1 = (r1 - mean) * rstd * gv[bj][1] + bv[bj][1]; }
                    const f32x4 z0 = acc[ai][bj][m][0] + r0 * alpha, z1 = acc[ai][bj][m][1] + r1 * alpha;
                    if (X) { *(f32x4*)(X + off + bj * HALF) = z0; *(f32x4*)(X + off + bj * HALF + 4) = z1; }
                    u32x4 w; w.x = cvt_pk_bf16(z0[0], z0[1]); w.y = cvt_pk_bf16(z0[2], z0[3]); w.z = cvt_pk_bf16(z1[0], z1[1]); w.w = cvt_pk_bf16(z1[2], z1[3]);
                    *(u32x4*)(ZB + off + bj * HALF) = w;
                    s1 += ((z0[0] + z0[1]) + (z0[2] + z0[3])) + ((z1[0] + z1[1]) + (z1[2] + z1[3]));
                    s2 += ((z0[0] * z0[0] + z0[1] * z0[1]) + (z0[2] * z0[2] + z0[3] * z0[3])) + ((z1[0] * z1[0] + z1[1] * z1[1]) + (z1[2] * z1[2] + z1[3] * z1[3])); }
                s1 += __shfl_xor(s1, 16); s1 += __shfl_xor(s1, 32); s2 += __shfl_xor(s2, 16); s2 += __shfl_xor(s2, 32);
                if (fq == 0) { unsafeAtomicAdd(cst + 2 * row, s1); unsafeAtomicAdd(cst + 2 * row + 1, s2); } }
    }
};
struct EpiSwiglu {
    static constexpr bool PERM = true, AFTER_DRAIN = false;
    bf16_t* H; const float* st; const float* c1; const float* c2;
    __device__ __forceinline__ void operator()(const f32x4 (&acc)[2][2][4][2], const Unit& u, int wr, int wc, int fr, int fq) const {
        const int row0 = u.pm * BM + wr * 64 + fr, col0 = u.pn * HALF + wc * 32 + 8 * fq, ccol0 = u.pn * BM + wc * 32 + 8 * fq;
        f32x4 k1[2][2], k2[2][2];
#pragma unroll
        for (int bj = 0; bj < 2; ++bj)
#pragma unroll
            for (int n = 0; n < 2; ++n) { k1[bj][n] = *(const f32x4*)(c1 + ccol0 + bj * HALF + 4 * n); k2[bj][n] = *(const f32x4*)(c2 + ccol0 + bj * HALF + 4 * n); }
#pragma unroll
        for (int ai = 0; ai < 2; ++ai)
#pragma unroll
            for (int m = 0; m < 4; ++m) { const int row = row0 + ai * HALF + m * 16; bf16_t* rowp = H + (size_t)row * DFF + col0;
                float mean, rstd; row_stats(st, row, mean, rstd);
                float h[8];
#pragma unroll
                for (int n = 0; n < 2; ++n) { const f32x4 gq = (acc[ai][0][m][n] - k1[0][n] * mean) * rstd + k2[0][n], uq = (acc[ai][1][m][n] - k1[1][n] * mean) * rstd + k2[1][n];
#pragma unroll
                    for (int j = 0; j < 4; ++j) h[n * 4 + j] = gq[j] * __builtin_amdgcn_rcpf(1.f + __expf(-gq[j])) * uq[j]; }
                u32x4 w; w.x = cvt_pk_bf16(h[0], h[1]); w.y = cvt_pk_bf16(h[2], h[3]); w.z = cvt_pk_bf16(h[4], h[5]); w.w = cvt_pk_bf16(h[6], h[7]);
                *(u32x4*)rowp = w; }
    }
};

struct EpiSoftmax {
    static constexpr bool PERM = true, AFTER_DRAIN = true;
    bf16_t* PALL; const float* st; const float* c1; const float* c2; float scale;
    __device__ __forceinline__ void fused(f32x4 (&acc)[2][2][4][2], const Unit& u, int wr, int wc, int fr, int fq, LAS unsigned char* lds) const {
        const int b = u.bz >> 2, h = u.bz & 3, rl0 = wr * 64 + fr, cc0 = wc * 32 + 8 * fq;
        LAS float* PMX = (LAS float*)lds; LAS float* PSM = PMX + 1024;
        f32x4 k1[2][2], k2[2][2];
#pragma unroll
        for (int bj = 0; bj < 2; ++bj)
#pragma unroll
            for (int n = 0; n < 2; ++n) { k1[bj][n] = *(const f32x4*)(c1 + u.bz * 256 + cc0 + bj * HALF + 4 * n); k2[bj][n] = *(const f32x4*)(c2 + u.bz * 256 + cc0 + bj * HALF + 4 * n); }
#pragma unroll
        for (int ai = 0; ai < 2; ++ai)
#pragma unroll
            for (int m = 0; m < 4; ++m) { const int rl = rl0 + ai * HALF + m * 16, row = b * SEQ + u.pm * BM + rl;
                float mean, rstd; row_stats(st, row, mean, rstd);
                float mx = -__builtin_inff();
#pragma unroll
                for (int bj = 0; bj < 2; ++bj)
#pragma unroll
                    for (int n = 0; n < 2; ++n) { const f32x4 v = ((acc[ai][bj][m][n] - k1[bj][n] * mean) * rstd + k2[bj][n]) * scale; acc[ai][bj][m][n] = v;
                        mx = fmaxf(mx, fmaxf(fmaxf(v[0], v[1]), fmaxf(v[2], v[3]))); }
                mx = fmaxf(mx, __shfl_xor(mx, 16)); mx = fmaxf(mx, __shfl_xor(mx, 32));
                if (fq == 0) PMX[rl * 4 + wc] = mx; }
        asm volatile("s_waitcnt lgkmcnt(0)" ::: "memory"); __builtin_amdgcn_s_barrier(); asm volatile("" ::: "memory");
#pragma unroll
        for (int ai = 0; ai < 2; ++ai)
#pragma unroll
            for (int m = 0; m < 4; ++m) { const int rl = rl0 + ai * HALF + m * 16;
                const f32x4 q = *(const LAS f32x4*)(PMX + rl * 4); const float mx = fmaxf(fmaxf(q[0], q[1]), fmaxf(q[2], q[3]));
                float sm = 0.f;
#pragma unroll
                for (int bj = 0; bj < 2; ++bj)
#pragma unroll
                    for (int n = 0; n < 2; ++n) { f32x4 e = acc[ai][bj][m][n] - mx; e[0] = __expf(e[0]); e[1] = __expf(e[1]); e[2] = __expf(e[2]); e[3] = __expf(e[3]); acc[ai][bj][m][n] = e;
                        sm += (e[0] + e[1]) + (e[2] + e[3]); }
                sm += __shfl_xor(sm, 16); sm += __shfl_xor(sm, 32);
                if (fq == 0) PSM[rl * 4 + wc] = sm; }
        asm volatile("s_waitcnt lgkmcnt(0)" ::: "memory"); __builtin_amdgcn_s_barrier(); asm volatile("" ::: "memory");
#pragma unroll
        for (int ai = 0; ai < 2; ++ai)
#pragma unroll
            for (int m = 0; m < 4; ++m) { const int rl = rl0 + ai * HALF + m * 16, row = b * SEQ + u.pm * BM + rl;
                const f32x4 q = *(const LAS f32x4*)(PSM + rl * 4); const float inv = __builtin_amdgcn_rcpf((q[0] + q[1]) + (q[2] + q[3]));
                bf16_t* rowp = PALL + (size_t)row * 1024 + h * 256 + cc0;
#pragma unroll
                for (int bj = 0; bj < 2; ++bj) { const f32x4 v0 = acc[ai][bj][m][0] * inv, v1 = acc[ai][bj][m][1] * inv;
                    u32x4 w; w.x = cvt_pk_bf16(v0[0], v0[1]); w.y = cvt_pk_bf16(v0[2], v0[3]); w.z = cvt_pk_bf16(v1[0], v1[1]); w.w = cvt_pk_bf16(v1[2], v1[3]);
                    *(u32x4*)(rowp + bj * HALF) = w; } }
    }
};

template <class Epi, bool ALIGN_EPI>
__device__ __forceinline__ void gemm_phase(LAS unsigned char* lds, const Gemm g, const Order& S, const Epi& E) {
    const int tid = ltid(), wid = __builtin_amdgcn_readfirstlane(tid >> 6), lane = tid & 63, wr = wid >> 2, wc = wid & 3, fr = lane & 15, fq = lane >> 4;
    const int K = g.K, nt = K / BK;
    unsigned voffA[2], voffB[2];
#pragma unroll
    for (int i = 0; i < 2; ++i) { int R, C; stage_rc(tid * 16 + i * 8192, R, C); const int Rb = Epi::PERM ? ((R & ~31) + perm32(R & 31)) : R;
        voffA[i] = (unsigned)(R * g.lda + C) * 2u; voffB[i] = (unsigned)(Rb * g.ldb + C) * 2u; }
    const size_t kstep = (size_t)(BK * 2);
    const size_t hstepA = (size_t)HALF * g.lda * 2, hstepB = (size_t)HALF * g.ldb * 2;
    const unsigned ldsw = (unsigned)wid * 1024u;
    const int aoff = lds_byte(wr * 64 + fr, fq * 8), boff = lds_byte(wc * 32 + fr, fq * 8);
#define PG8_SA(b, h) (((b) * 2 + (h)) * HTB)
#define PG8_SB(b, h) ((4 + (b) * 2 + (h)) * HTB)
#define PG8_STAGE(bufoff, gbase, voff) do { _Pragma("unroll") for (int _i = 0; _i < 2; ++_i) \
        __builtin_amdgcn_global_load_lds((const unsigned*)((const char*)(gbase) + (voff)[_i]), (LAS unsigned*)(lds + (bufoff) + ldsw + _i * 8192), 16, 0, 0); } while (0)
#define PG8_LDA(dst, b, h) do { _Pragma("unroll") for (int m = 0; m < 4; ++m) _Pragma("unroll") for (int k = 0; k < 2; ++k) dst[m][k] = *(const LAS bf16x8*)(lds + PG8_SA(b, h) + aoff + m * 2048 + k * 1024); } while (0)
#define PG8_LDB(dst, b, h) do { _Pragma("unroll") for (int n = 0; n < 2; ++n) _Pragma("unroll") for (int k = 0; k < 2; ++k) dst[n][k] = *(const LAS bf16x8*)(lds + PG8_SB(b, h) + boff + n * 2048 + k * 1024); } while (0)
#define PG8_MMA(ai, bj, At, Bt) do { __builtin_amdgcn_s_setprio(1); _Pragma("unroll") for (int m = 0; m < 4; ++m) _Pragma("unroll") for (int n = 0; n < 2; ++n) _Pragma("unroll") for (int k = 0; k < 2; ++k) \
        acc[ai][bj][m][n] = __builtin_amdgcn_mfma_f32_16x16x32_bf16(Bt[n][k], At[m][k], acc[ai][bj][m][n], 0, 0, 0); __builtin_amdgcn_s_setprio(0); } while (0)
#define PG8_WAIT_V(n) asm volatile("s_waitcnt vmcnt(" #n ")" ::: "memory")
#define PG8_WAIT_L(n) asm volatile("s_waitcnt lgkmcnt(" #n ")" ::: "memory")
#define PG8_BAR __builtin_amdgcn_s_barrier()
#define PG8_SCHED __builtin_amdgcn_sched_barrier(0)
    Unit cur, nxt; int ui = 0;
    if (!S.next(0, cur)) return;
    f32x4 acc[2][2][4][2];
#pragma unroll
    for (int a = 0; a < 2; ++a)
#pragma unroll
        for (int b = 0; b < 2; ++b)
#pragma unroll
            for (int m = 0; m < 4; ++m)
#pragma unroll
                for (int n = 0; n < 2; ++n) acc[a][b][m][n] = (f32x4){0.f, 0.f, 0.f, 0.f};
    bf16x8 At[4][2], B0[2][2], B1[2][2];
    const char* cA = unit_a(g, cur); const char* cB = unit_b(g, cur);
    PG8_STAGE(PG8_SB(0, 0), cB, voffB); PG8_STAGE(PG8_SB(0, 1), cB + hstepB, voffB); PG8_STAGE(PG8_SA(0, 0), cA, voffA); PG8_STAGE(PG8_SA(0, 1), cA + hstepA, voffA);
    if (wr == 1) PG8_BAR;
    PG8_WAIT_V(2); PG8_BAR;
    PG8_STAGE(PG8_SB(1, 0), cB + kstep, voffB); PG8_STAGE(PG8_SA(1, 0), cA + kstep, voffA); PG8_STAGE(PG8_SB(1, 1), cB + hstepB + kstep, voffB);
    PG8_WAIT_V(6); PG8_BAR;
    for (;;) {
        const bool has_next = S.next(ui + 1, nxt);
        const char* nA = has_next ? unit_a(g, nxt) : cA; const char* nB = has_next ? unit_b(g, nxt) : cB;
        for (int t = 0; t < nt; t += 2) {
            const bool last = (t == nt - 2);
            const char* a1 = cA + (size_t)(t + 1) * kstep;
            const char* a2 = last ? nA : cA + (size_t)(t + 2) * kstep; const char* b2 = last ? nB : cB + (size_t)(t + 2) * kstep;
            const char* a3 = a2 + kstep; const char* b3 = b2 + kstep;
            PG8_LDB(B0, 0, 0); PG8_LDB(B1, 0, 1); PG8_SCHED; PG8_LDA(At, 0, 0); PG8_STAGE(PG8_SA(1, 1), a1 + hstepA, voffA);
            PG8_WAIT_V(8); PG8_WAIT_L(0); PG8_BAR; PG8_MMA(0, 0, At, B0); PG8_MMA(0, 1, At, B1); PG8_BAR; PG8_SCHED;
            PG8_LDA(At, 0, 1); PG8_STAGE(PG8_SB(0, 0), b2, voffB); PG8_STAGE(PG8_SB(0, 1), b2 + hstepB, voffB); PG8_STAGE(PG8_SA(0, 0), a2, voffA);
            PG8_WAIT_V(8); PG8_WAIT_L(0); PG8_BAR; PG8_MMA(1, 0, At, B0); PG8_MMA(1, 1, At, B1); PG8_BAR; PG8_SCHED;
            PG8_LDB(B0, 1, 0); PG8_LDB(B1, 1, 1); PG8_SCHED; PG8_LDA(At, 1, 0); PG8_STAGE(PG8_SA(0, 1), a2 + hstepA, voffA);
            PG8_WAIT_V(8); PG8_WAIT_L(0); PG8_BAR; PG8_MMA(0, 0, At, B0); PG8_MMA(0, 1, At, B1); PG8_BAR; PG8_SCHED;
            PG8_LDA(At, 1, 1); PG8_STAGE(PG8_SB(1, 0), b3, voffB); PG8_STAGE(PG8_SB(1, 1), b3 + hstepB, voffB); PG8_STAGE(PG8_SA(1, 0), a3, voffA);
            PG8_WAIT_V(8); PG8_WAIT_L(0); PG8_BAR; PG8_MMA(1, 0, At, B0); PG8_MMA(1, 1, At, B1); PG8_BAR; PG8_SCHED;
        }
        if constexpr (ALIGN_EPI) { if (wr == 0) PG8_BAR; }
        if constexpr (!Epi::AFTER_DRAIN) E(acc, cur, wr, wc, fr, fq);
        if (!has_next) break;
#pragma unroll
        for (int a = 0; a < 2; ++a)
#pragma unroll
            for (int b = 0; b < 2; ++b)
#pragma unroll
                for (int m = 0; m < 4; ++m)
#pragma unroll
                    for (int n = 0; n < 2; ++n) acc[a][b][m][n] = (f32x4){0.f, 0.f, 0.f, 0.f};
        cur = nxt; cA = nA; cB = nB; ++ui;
        if constexpr (ALIGN_EPI) { if (wr == 1) PG8_BAR; }
    }
    PG8_WAIT_V(0);
    if constexpr (!ALIGN_EPI) { if (wr == 0) PG8_BAR; }
    PG8_BAR;
    if constexpr (Epi::AFTER_DRAIN) E.fused(acc, cur, wr, wc, fr, fq, lds);
#undef PG8_SA
#undef PG8_SB
#undef PG8_STAGE
#undef PG8_LDA
#undef PG8_LDB
#undef PG8_MMA
#undef PG8_WAIT_V
#undef PG8_WAIT_L
#undef PG8_BAR
#undef PG8_SCHED
}
}

namespace att {
using bf16 = __hip_bfloat16;
typedef short s16x4 __attribute__((ext_vector_type(4)));
constexpr int D = 128;
constexpr float THR = 8.f;
constexpr float SCALE = 0.08838834764831845f;
constexpr int NW = 8, QBLK = 32, KVBLK = 64, QB = NW * QBLK;
constexpr int SHM_V = KVBLK * D * 2, SHM_K = KVBLK * D * 2;
constexpr int ATT_LDS = 2 * SHM_V + 2 * SHM_K + NW * 64 * 4;
constexpr int BT_OFF = ATT_LDS;

#define KSWZ(row, colB) ((row) * 256 + ((colB) ^ (((row) & 7) << 4)))
#define SBAR() __builtin_amdgcn_sched_barrier(0)
__device__ __forceinline__ int v_st(int k, int c) { const int kk = (k & ~0xC) | ((k & 4) << 1) | ((k & 8) >> 1); return ((kk >> 3) * 4 + (c >> 5)) * 512 + ((kk & 7) * 32 + (c & 31)) * 2; }
__device__ __forceinline__ int v_rd_base(int lane) { return ((lane & 3) << 3) | (((lane >> 2) & 3) << 6) | (((lane >> 4) & 1) << 5) | (((lane >> 5) & 1) << 8); }
constexpr int v_rd_off(int d0, int ks, int half) { return d0 * 512 + ks * 4096 + half * 2048; }
__device__ __forceinline__ int crow(int r, int hi) { return (r & 3) + 8 * (r >> 2) + 4 * hi; }
__device__ __forceinline__ unsigned cvtpk(float lo, float hi) { unsigned r; asm volatile("v_cvt_pk_bf16_f32 %0, %1, %2" : "=v"(r) : "v"(lo), "v"(hi)); return r; }
__device__ __forceinline__ bf16x8 load8(const bf16* p) { return *reinterpret_cast<const bf16x8*>(p); }
__device__ __forceinline__ void bias_mask_tile(f32x16& p0, f32x16& p1, int dq, const float* bt) {
    const float NEG = -__builtin_inff();
#pragma unroll
    for (int r = 0; r < 16; ++r) {
        const int c = (r & 3) + 8 * (r >> 2);
        const int d0 = dq - c, d1 = dq - c - 32;
        const unsigned i0 = (unsigned)d0 < 255u ? (unsigned)d0 : 255u, i1 = (unsigned)d1 < 255u ? (unsigned)d1 : 255u;
        const float b0 = bt[i0], b1 = bt[i1];
        p0[r] = d0 >= 0 ? p0[r] + b0 : NEG;
        p1[r] = d1 >= 0 ? p1[r] + b1 : NEG;
    }
}
__device__ __forceinline__ void partialSM(f32x16& p0, f32x16& p1, float& m_reg, float& mn, float& alpha) {
    float pmax = p0[0]; for (int r = 1; r < 16; ++r) pmax = fmaxf(pmax, p0[r]); for (int r = 0; r < 16; ++r) pmax = fmaxf(pmax, p1[r]);
    { auto rr = __builtin_amdgcn_permlane32_swap(__float_as_uint(pmax), __float_as_uint(pmax), false, false);
      pmax = fmaxf(__uint_as_float(rr[0]), __uint_as_float(rr[1])); }
    constexpr float C2 = 1.4426950408889634f * SCALE;
    if (__builtin_expect(__all((pmax - m_reg) * SCALE <= THR), 1)) { mn = m_reg; alpha = 1.f; }
    else { mn = fmaxf(m_reg, pmax); alpha = __builtin_amdgcn_exp2f((m_reg - mn) * C2); m_reg = mn; }
    const float mnL = -mn * C2;
    for (int r = 0; r < 16; ++r) p0[r] = fmaf(p0[r], C2, mnL); for (int r = 0; r < 16; ++r) p1[r] = fmaf(p1[r], C2, mnL);
    for (int r = 0; r < 16; ++r) p0[r] = __builtin_amdgcn_exp2f(p0[r]);
}
__device__ __forceinline__ void finishSM(f32x16& p0, f32x16& p1, float alpha, float& l_reg, bf16x8& pa0, bf16x8& pa1, bf16x8& pa2, bf16x8& pa3) {
    for (int r = 0; r < 16; ++r) p1[r] = __builtin_amdgcn_exp2f(p1[r]);
    float ps = 0; for (int r = 0; r < 16; ++r) ps += p0[r]; for (int r = 0; r < 16; ++r) ps += p1[r];
    { auto rr = __builtin_amdgcn_permlane32_swap(__float_as_uint(ps), __float_as_uint(ps), false, false);
      ps = __uint_as_float(rr[0]) + __uint_as_float(rr[1]); }
    l_reg = l_reg * alpha + ps;
#define PK4(P, B_, OUT) do { unsigned a0 = cvtpk(P[B_+0], P[B_+1]), a1 = cvtpk(P[B_+2], P[B_+3]);                          \
        unsigned b0 = cvtpk(P[B_+4], P[B_+5]), b1 = cvtpk(P[B_+6], P[B_+7]);                                             \
        auto r0 = __builtin_amdgcn_permlane32_swap(a0, b0, false, false); auto r1 = __builtin_amdgcn_permlane32_swap(a1, b1, false, false); \
        u32x4 w = {r0[0], r1[0], r0[1], r1[1]}; OUT = *reinterpret_cast<bf16x8*>(&w); } while (0)
    PK4(p0, 0, pa0); PK4(p0, 8, pa1); PK4(p1, 0, pa2); PK4(p1, 8, pa3);
#undef PK4
}
template <int KB>
__device__ __forceinline__ void qkt(f32x16& p0, f32x16& p1, const char* K_lds, int r32, int hi, const bf16x8* qr) {
    p0 = f32x16{}; p1 = f32x16{};
    const char* kb[4];
#pragma unroll
    for (int dd = 0; dd < 4; ++dd) kb[dd] = K_lds + KB * SHM_K + KSWZ(r32, (dd * 16 + hi * 8) * 2);
#pragma unroll
    for (int d0 = 0; d0 < 8; ++d0) { const char* a = kb[d0 & 3] + (d0 >> 2) * 128;
        bf16x8 b0 = *reinterpret_cast<const bf16x8*>(a);
        bf16x8 b1 = *reinterpret_cast<const bf16x8*>(a + 32 * 256);
        p0 = __builtin_amdgcn_mfma_f32_32x32x16_bf16(b0, qr[d0], p0, 0, 0, 0);
        p1 = __builtin_amdgcn_mfma_f32_32x32x16_bf16(b1, qr[d0], p1, 0, 0, 0); }
}
template <int VB>
__device__ __forceinline__ void pv_tile(f32x16* o, int vb0, bf16x8 pa0, bf16x8 pa1, bf16x8 pa2, bf16x8 pa3) {
#define TRRD(dst, off) asm volatile("ds_read_b64_tr_b16 %0, %1 offset:%2" : "=&v"(dst) : "v"(vb0), "i"(off) : "memory")
#define PV_D0(d0) do { s16x4 l0, l1, l2, l3, h0, h1, h2, h3; constexpr int b_ = VB * SHM_V + v_rd_off(d0, 0, 0); \
        TRRD(l0, b_); TRRD(h0, b_ + 2048); TRRD(l1, b_ + 4096); TRRD(h1, b_ + 6144); TRRD(l2, b_ + 8192); TRRD(h2, b_ + 10240); TRRD(l3, b_ + 12288); TRRD(h3, b_ + 14336); \
        asm volatile("s_waitcnt lgkmcnt(0)" ::: "memory"); SBAR();   \
        o[d0] = __builtin_amdgcn_mfma_f32_32x32x16_bf16(pa0, (bf16x8){l0[0], l0[1], l0[2], l0[3], h0[0], h0[1], h0[2], h0[3]}, o[d0], 0, 0, 0);   \
        o[d0] = __builtin_amdgcn_mfma_f32_32x32x16_bf16(pa1, (bf16x8){l1[0], l1[1], l1[2], l1[3], h1[0], h1[1], h1[2], h1[3]}, o[d0], 0, 0, 0);   \
        o[d0] = __builtin_amdgcn_mfma_f32_32x32x16_bf16(pa2, (bf16x8){l2[0], l2[1], l2[2], l2[3], h2[0], h2[1], h2[2], h2[3]}, o[d0], 0, 0, 0);   \
        o[d0] = __builtin_amdgcn_mfma_f32_32x32x16_bf16(pa3, (bf16x8){l3[0], l3[1], l3[2], l3[3], h3[0], h3[1], h3[2], h3[3]}, o[d0], 0, 0, 0); } while (0)
    PV_D0(0); PV_D0(1); PV_D0(2); PV_D0(3);
#undef PV_D0
#undef TRRD
}
struct BlockRef { const bf16* Q; const bf16* K; const bf16* V; float* O; int P0; int hm; };
struct Seam { bf16x8 qr[8]; bf16x8 st_v0, st_v1, st_k0, st_k1; };
#define ROW(p, k0, rr) ((p) + (size_t)((k0) + (rr)) * D + sc)
#define VMW() asm volatile("s_waitcnt vmcnt(0)" ::: "memory")
#define VMWN(n) asm volatile("s_waitcnt vmcnt(%0)" :: "i"(n) : "memory")
#define SLOAD_H(Kp, Vp, k0) do { S.st_v0 = load8(ROW(Vp, k0, sr)); S.st_v1 = load8(ROW(Vp, k0, 32 + sr));              \
                         S.st_k0 = load8(ROW(Kp, k0, sr)); S.st_k1 = load8(ROW(Kp, k0, 32 + sr)); } while (0)
#define SWRITE_HK(bf) do { *(bf16x8*)(K_lds + (bf) * SHM_K + kws) = S.st_k0; *(bf16x8*)(K_lds + (bf) * SHM_K + kws + 32 * 256) = S.st_k1; } while (0)
#define SWRITE_HV(bf) do { *(bf16x8*)(V_lds + (bf) * SHM_V + vst0) = S.st_v0; *(bf16x8*)(V_lds + (bf) * SHM_V + vst1) = S.st_v1; } while (0)
#define SWRITE_H(bf) do { SWRITE_HV(bf); SWRITE_HK(bf); } while (0)
__device__ __forceinline__ void attn_prime(const BlockRef& cur, char* lds, Seam& S) {
    const int tid = ltid(), wid = __builtin_amdgcn_readfirstlane(tid >> 6), lane = tid & 63, r32 = lane & 31, hi = lane >> 5;
    const int sr = tid >> 4, sc = (tid & 15) * 8, kws = KSWZ(sr, sc * 2); char* K_lds = lds + 2 * SHM_V;
    const int kb0 = 0;
    for (int d0 = 0; d0 < 8; ++d0) S.qr[d0] = load8(cur.Q + (size_t)(wid * QBLK + r32) * D + d0 * 16 + hi * 8);
    SLOAD_H(cur.K, cur.V, kb0); VMW(); SWRITE_HK(0);
    __syncthreads();
}
__device__ __forceinline__ void attn_block(const BlockRef& cur, const BlockRef& nxt, char* lds, Seam& S) {
    const int tid = ltid(), wid = __builtin_amdgcn_readfirstlane(tid >> 6), lane = tid & 63, r32 = lane & 31, hi = lane >> 5;
    const int j_lo = 0;
    const int j_hi = (cur.P0 + QB - 1) / KVBLK + 1;
    const int NT = j_hi - j_lo;
    const int kbn = 0;
    const int qlo = cur.P0 + wid * QBLK, qm = qlo + r32 - 4 * hi;
    char* V_lds = lds; char* K_lds = lds + 2 * SHM_V;
    float* ws = (float*)(lds + 2 * SHM_V + 2 * SHM_K) + wid * 64; float* li_l = ws, * al_l = ws + 32;
    const float* bt = (const float*)(lds + BT_OFF) + cur.hm * 256;
    float m_reg = -1e30f, l_reg = 0; f32x16 o[4] = {};
    const int sr = tid >> 4, sc = (tid & 15) * 8, vst0 = v_st(sr, sc), vst1 = v_st(32 + sr, sc), kws = KSWZ(sr, sc * 2);
    const int vb0 = (int)(uintptr_t)V_lds + v_rd_base(lane);
    const bf16* Kh = cur.K; const bf16* Vh = cur.V;
#define RESC(a) do { if (__any((a) < 1.f)) { if (hi == 0) al_l[r32] = (a); asm volatile("s_waitcnt lgkmcnt(0)" ::: "memory");              \
                     for (int d_ = 0; d_ < 4; ++d_) for (int r = 0; r < 16; ++r) o[d_][r] *= al_l[crow(r, hi)]; } } while (0)
#define KBASE(t) ((j_lo + (t)) * KVBLK)
#define MASKT(P0_, P1_, t) do { const int kb_ = KBASE(t); if (kb_ + KVBLK - 1 > qlo - 128) bias_mask_tile(P0_, P1_, qm - kb_, bt); } while (0)
    constexpr int NQL = 8;
#define SEAM_K0() do { VMWN(NQL); SWRITE_HK(0); SBAR(); } while (0)
    f32x16 pA0, pA1, pB0, pB1; float mnA, mnB, alA, alB; bf16x8 pa0, pa1, pa2, pa3;
    SWRITE_HV(0); SBAR();
    if (NT > 1) { SLOAD_H(Kh, Vh, KBASE(1)); }
    SBAR(); qkt<0>(pA0, pA1, K_lds, r32, hi, S.qr);
    MASKT(pA0, pA1, 0); partialSM(pA0, pA1, m_reg, mnA, alA);
    if (NT > 1) { VMW(); SWRITE_H(1); }
    __syncthreads();
#define HALF_STEP(PX0, PX1, mnX, alX, PY0, PY1, alY, t, KB, VB, SB) do {                                                      \
        SBAR(); qkt<KB>(PX0, PX1, K_lds, r32, hi, S.qr);                                             \
        finishSM(PY0, PY1, alY, l_reg, pa0, pa1, pa2, pa3); SBAR();                                                           \
        if ((t) + 1 < NT) { SLOAD_H(Kh, Vh, KBASE((t) + 1)); SBAR(); }                                               \
        pv_tile<VB>(o, vb0, pa0, pa1, pa2, pa3); MASKT(PX0, PX1, (t)); partialSM(PX0, PX1, m_reg, mnX, alX);                                        \
        __syncthreads();                                                                                                      \
        if ((t) + 1 < NT) { VMW(); SWRITE_H(SB); }                                                                          \
        RESC(alX); __syncthreads(); } while (0)
    for (int t = 1; t + 1 < NT; t += 2) {
        HALF_STEP(pB0, pB1, mnB, alB, pA0, pA1, alA, t, 1, 0, 0);
        HALF_STEP(pA0, pA1, mnA, alA, pB0, pB1, alB, t + 1, 0, 1, 1);
    }
    const bool even = (NT & 1) == 0;
    if (even) { SBAR(); qkt<1>(pB0, pB1, K_lds, r32, hi, S.qr); SBAR(); }
    SLOAD_H(nxt.K, nxt.V, kbn); SBAR();
#pragma unroll
    for (int d0 = 0; d0 < 8; ++d0) S.qr[d0] = load8(nxt.Q + (size_t)(wid * QBLK + r32) * D + d0 * 16 + hi * 8);
    SBAR();
    finishSM(pA0, pA1, alA, l_reg, pa0, pa1, pa2, pa3); SBAR();
    pv_tile<0>(o, vb0, pa0, pa1, pa2, pa3);
    if (even) { MASKT(pB0, pB1, NT - 1); partialSM(pB0, pB1, m_reg, mnB, alB); __syncthreads(); RESC(alB);
        finishSM(pB0, pB1, alB, l_reg, pa0, pa1, pa2, pa3); SBAR(); pv_tile<1>(o, vb0, pa0, pa1, pa2, pa3); }
    SBAR(); SEAM_K0();
    if (hi == 0) li_l[r32] = l_reg; asm volatile("s_waitcnt lgkmcnt(0)" ::: "memory");
    float rli[16];
#pragma unroll
    for (int r = 0; r < 16; ++r) rli[r] = __builtin_amdgcn_rcpf(li_l[crow(r, hi)]);
    float* Ow = cur.O + (size_t)(wid * QBLK) * D;
#pragma unroll
    for (int r = 0; r < 16; ++r) { const int orow = crow(r, hi);
#pragma unroll
        for (int d0 = 0; d0 < 4; ++d0) { const float v = o[d0][r] * rli[r]; Ow[(size_t)orow * D + d0 * 32 + r32] = v; } }
    __syncthreads();
#undef RESC
#undef KBASE
#undef MASKT
#undef SEAM_K0
#undef HALF_STEP
}
#undef ROW
#undef VMW
#undef VMWN
#undef SLOAD_H
#undef SWRITE_HK
#undef SWRITE_HV
#undef SWRITE_H
}

namespace att2 {
using att::bf16; using att::D; using att::SHM_K; using att::SHM_V;
constexpr int L_V = 0, L_K = 65536, L_P = 98304, L_AL = 131072, L_FL = 132096, L_LB = 132224, L_BT = 133120;
struct Blk { const bf16* Q; const bf16* K; const bf16* V0; const bf16* V1; float* O0; float* O1; int P0; int hm; };
__device__ __forceinline__ void qkt_rt(f32x16& p0, f32x16& p1, const char* Kb, int r32, int hi, const bf16x8* qr) {
    p0 = f32x16{}; p1 = f32x16{};
    const char* kb[4];
#pragma unroll
    for (int dd = 0; dd < 4; ++dd) kb[dd] = Kb + KSWZ(r32, (dd * 16 + hi * 8) * 2);
#pragma unroll
    for (int d0 = 0; d0 < 8; ++d0) { const char* a = kb[d0 & 3] + (d0 >> 2) * 128;
        bf16x8 b0 = *reinterpret_cast<const bf16x8*>(a);
        bf16x8 b1 = *reinterpret_cast<const bf16x8*>(a + 32 * 256);
        p0 = __builtin_amdgcn_mfma_f32_32x32x16_bf16(b0, qr[d0], p0, 0, 0, 0);
        p1 = __builtin_amdgcn_mfma_f32_32x32x16_bf16(b1, qr[d0], p1, 0, 0, 0); }
}
#define A2_LOADT(t) do { const size_t ro_ = (size_t)((t) * 64 + sr) * D + sc; \
        sk0 = att::load8(c.K + ro_); sk1 = att::load8(c.K + ro_ + 32 * D); sv00 = att::load8(c.V0 + ro_); sv01 = att::load8(c.V0 + ro_ + 32 * D); sv10 = att::load8(c.V1 + ro_); sv11 = att::load8(c.V1 + ro_ + 32 * D); } while (0)
#define A2_WRITET(buf) do { char* kd_ = lds + L_K + (buf) * SHM_K; char* vd_ = lds + L_V + (buf) * 2 * SHM_V; \
        *(bf16x8*)(kd_ + kws) = sk0; *(bf16x8*)(kd_ + kws + 32 * 256) = sk1; *(bf16x8*)(vd_ + vst0) = sv00; *(bf16x8*)(vd_ + vst1) = sv01; *(bf16x8*)(vd_ + SHM_V + vst0) = sv10; *(bf16x8*)(vd_ + SHM_V + vst1) = sv11; } while (0)
__device__ __forceinline__ void attn2_block(const Blk& c, char* lds) {
    const int tid = ltid(), wid = __builtin_amdgcn_readfirstlane(tid >> 6), lane = tid & 63, r32 = lane & 31, hi = lane >> 5;
    const int g = wid & 3;
    const int NT = (c.P0 + 127) / 64 + 1;
    const int sr = tid >> 4, sc = (tid & 15) * 8, kws = KSWZ(sr, sc * 2), vst0 = att::v_st(sr, sc), vst1 = att::v_st(32 + sr, sc);
    bf16x8 sk0, sk1, sv00, sv01, sv10, sv11;
    float* ALb = (float*)(lds + L_AL) + g * 64; unsigned* FLb = (unsigned*)(lds + L_FL) + g * 2; float* LBb = (float*)(lds + L_LB) + g * 32;
    char* Pb = lds + L_P + g * 8192;
    A2_LOADT(0);
    if (wid < 4) {
        bf16x8 qr[8];
#pragma unroll
        for (int d0 = 0; d0 < 8; ++d0) qr[d0] = att::load8(c.Q + (size_t)(g * 32 + r32) * D + d0 * 16 + hi * 8);
        asm volatile("s_waitcnt vmcnt(0)" ::: "memory"); A2_WRITET(0); __syncthreads();
        const int qlo = c.P0 + g * 32, qm = qlo + r32 - 4 * hi;
        const float* bt = (const float*)(lds + L_BT) + c.hm * 256;
        float m_reg = -1e30f, l_reg = 0.f;
        for (int s = 0; s <= NT; ++s) {
            const int par = s & 1;
            if (s + 1 < NT) A2_LOADT(s + 1);
            SBAR();
            if (s < NT) {
                f32x16 p0, p1; float mn, al; bf16x8 pa0, pa1, pa2, pa3;
                qkt_rt(p0, p1, lds + L_K + par * SHM_K, r32, hi, qr);
                const int kb_ = s * 64;
                if (kb_ + 63 > qlo - 128) att::bias_mask_tile(p0, p1, qm - kb_, bt);
                att::partialSM(p0, p1, m_reg, mn, al);
                att::finishSM(p0, p1, al, l_reg, pa0, pa1, pa2, pa3);
                char* pw = Pb + par * 4096 + lane * 16;
                *(bf16x8*)(pw) = pa0; *(bf16x8*)(pw + 1024) = pa1; *(bf16x8*)(pw + 2048) = pa2; *(bf16x8*)(pw + 3072) = pa3;
                if (hi == 0) ALb[par * 32 + r32] = al;
                const bool resc = __any(al < 1.f);
                if (lane == 0) FLb[par] = resc ? 1u : 0u;
            }
            __syncthreads();
            if (s + 1 < NT) { asm volatile("s_waitcnt vmcnt(0)" ::: "memory"); A2_WRITET((s + 1) & 1); }
            __syncthreads();
        }
        if (hi == 0) LBb[r32] = l_reg;
        __syncthreads();
        __syncthreads();
    } else {
        asm volatile("s_waitcnt vmcnt(0)" ::: "memory"); A2_WRITET(0); __syncthreads();
        f32x16 o[8];
#pragma unroll
        for (int d_ = 0; d_ < 8; ++d_) o[d_] = f32x16{};
        const int vbase = (int)(uintptr_t)(lds + L_V) + att::v_rd_base(lane);
        for (int s = 0; s <= NT; ++s) {
            if (s + 1 < NT) A2_LOADT(s + 1);
            SBAR();
            if (s >= 1) {
                const int par = (s - 1) & 1;
                const unsigned fl = (unsigned)__builtin_amdgcn_readfirstlane((int)FLb[par]);
                if (fl) {
#pragma unroll
                    for (int r = 0; r < 16; ++r) { const float a = ALb[par * 32 + att::crow(r, hi)];
#pragma unroll
                        for (int d_ = 0; d_ < 8; ++d_) o[d_][r] *= a; } }
                const char* pr = Pb + par * 4096 + lane * 16;
                const bf16x8 pa0 = *(const bf16x8*)(pr), pa1 = *(const bf16x8*)(pr + 1024), pa2 = *(const bf16x8*)(pr + 2048), pa3 = *(const bf16x8*)(pr + 3072);
                const int vb = vbase + par * 2 * SHM_V;
                att::pv_tile<0>(o, vb, pa0, pa1, pa2, pa3);
                att::pv_tile<0>(o + 4, vb + SHM_V, pa0, pa1, pa2, pa3);
            }
            __syncthreads();
            if (s + 1 < NT) { asm volatile("s_waitcnt vmcnt(0)" ::: "memory"); A2_WRITET((s + 1) & 1); }
            __syncthreads();
        }
        __syncthreads();
        float rli[16];
#pragma unroll
        for (int r = 0; r < 16; ++r) rli[r] = __builtin_amdgcn_rcpf(LBb[att::crow(r, hi)]);
#pragma unroll
        for (int hf = 0; hf < 2; ++hf) { float* Ow = (hf ? c.O1 : c.O0) + (size_t)(g * 32) * D;
#pragma unroll
            for (int r = 0; r < 16; ++r) { const int orow = att::crow(r, hi);
#pragma unroll
                for (int d0 = 0; d0 < 4; ++d0) Ow[(size_t)orow * D + d0 * 32 + r32] = o[hf * 4 + d0][r] * rli[r]; } }
        __syncthreads();
    }
}
#undef A2_LOADT
#undef A2_WRITET
}


#define XB_TMO      128
#define XB_XCNT(j)  (256  + 64 * (j))
#define XB_XSUB(j)  (1280 + 64 * (j))
#define XB_XGEN(j)  (2304 + 64 * (j))
#define XB_TOP      3328
#define XB_TOPGEN   3392
#define XCD_BAR_WORDS 3456
#define XB_SPIN_CAP (1u << 18)
__device__ __forceinline__ unsigned xb_ld(unsigned* p)              { return __hip_atomic_load(p, __ATOMIC_RELAXED, __HIP_MEMORY_SCOPE_AGENT); }
__device__ __forceinline__ unsigned xb_add(unsigned* p, unsigned v) { return __hip_atomic_fetch_add(p, v, __ATOMIC_RELAXED, __HIP_MEMORY_SCOPE_AGENT); }
__device__ __forceinline__ unsigned xb_xcc_id() { return (unsigned)__builtin_amdgcn_s_getreg((3 << 11) | 20) & 0xFu; }
#define XB_SPIN(cond, bar) do { unsigned _sp = 0; while (cond) { __builtin_amdgcn_s_sleep(1); \
    if ((++_sp & 255u) == 0u) { if (xb_ld(&(bar)[XB_TMO])) break; if (_sp > XB_SPIN_CAP) { atomicAdd(&(bar)[XB_TMO], 1u); break; } } } } while (0)
struct XcdBarrier { unsigned* bar; unsigned x; volatile LAS unsigned* st; };
__device__ __forceinline__ XcdBarrier xcd_barrier_post(unsigned* bar, volatile LAS unsigned* st) {
    XcdBarrier b; b.bar = bar; b.x = xb_xcc_id(); b.st = st;
    if (threadIdx.x == 0) (void)xb_add(&bar[XB_XCNT(b.x)], 1u);
    return b;
}
__device__ __forceinline__ void xcd_barrier_complete(unsigned* bar, unsigned x, unsigned& nloc, unsigned& nx) {
    const unsigned G = gridDim.x * gridDim.y * gridDim.z;
    unsigned sum, cnt, mine, sp = 0u;
    for (;;) {
        sum = 0u; cnt = 0u; mine = 0u;
#pragma unroll
        for (unsigned j = 0; j < 16; ++j) { const unsigned c = xb_ld(&bar[XB_XCNT(j)]); sum += c; cnt += (c > 0u) ? 1u : 0u; mine = (j == x) ? c : mine; }
        if (sum == G) break;
        __builtin_amdgcn_s_sleep(1);
        if ((++sp & 255u) == 0u) { if (xb_ld(&bar[XB_TMO])) break; if (sp > XB_SPIN_CAP) { atomicAdd(&bar[XB_TMO], 1u); break; } }
    }
    nloc = mine > 0u ? mine : 1u; nx = cnt > 0u ? cnt : 1u;
}
__device__ __forceinline__ void xcd_barrier(const XcdBarrier& b) {
    asm volatile("s_waitcnt vmcnt(0)" ::: "memory");
    __syncthreads();
    if (threadIdx.x == 0) {
        unsigned* bar = b.bar;
        __builtin_amdgcn_s_waitcnt(0);
        unsigned nloc = b.st[0], nx = b.st[1];
        if (nloc == 0u) { xcd_barrier_complete(bar, b.x, nloc, nx); b.st[0] = nloc; b.st[1] = nx; }
        const unsigned old = xb_add(&bar[XB_XSUB(b.x)], 1u);
        const unsigned gen = old / nloc;
        if (old + 1u == (gen + 1u) * nloc) {
            __builtin_amdgcn_fence(__ATOMIC_RELEASE, "agent");
            asm volatile("s_waitcnt vmcnt(0)" ::: "memory");
            const unsigned og = xb_add(&bar[XB_TOP], 1u);
            const unsigned tg = og / nx;
            if (og + 1u == (tg + 1u) * nx) xb_add(&bar[XB_TOPGEN], 1u);
            else XB_SPIN(xb_ld(&bar[XB_TOPGEN]) == tg, bar);
            __builtin_amdgcn_fence(__ATOMIC_ACQUIRE, "agent");
            xb_add(&bar[XB_XGEN(b.x)], 1u);
            asm volatile("s_waitcnt vmcnt(0)" ::: "memory");
        } else {
            XB_SPIN(xb_ld(&bar[XB_XGEN(b.x)]) == gen, bar);
            __builtin_amdgcn_fence(__ATOMIC_ACQUIRE, "agent");
            asm volatile("s_waitcnt vmcnt(0)" ::: "memory");
        }
    }
    __syncthreads();
}

struct Args { const float* in[24]; float* out; unsigned char* ws; };

__device__ __forceinline__ void p0_transpose_item(const float* W, int K, int N, bf16_t* WT, int swiglu, const float* gk, const float* bk, float* c1, float* c2, LAS float* scr, int item, int lane) {
    const int nblk = N / 64, kb = item / nblk, nb = item % nblk, k0 = 64 * kb, n0 = 64 * nb;
    const float* src = W + (size_t)(k0 + (lane >> 4)) * N + n0 + (lane & 15) * 4;
    f32x4 v[16];
#pragma unroll
    for (int i = 0; i < 16; ++i) v[i] = __builtin_nontemporal_load((const f32x4*)(src + (size_t)(4 * i) * N));
#pragma unroll
    for (int i = 0; i < 16; ++i) { LAS float* d = scr + (4 * i + (lane >> 4)) * 65 + (lane & 15) * 4; d[0] = v[i][0]; d[1] = v[i][1]; d[2] = v[i][2]; d[3] = v[i][3]; }
    asm volatile("s_waitcnt lgkmcnt(0)" ::: "memory");
    int r0 = n0;
    if (swiglu) { const int half = n0 / DFF, idx = n0 % DFF; r0 = 256 * (idx / 128) + 128 * half + (idx % 128); }
    const int c = lane & 7;
    float g8[8], b8[8];
#pragma unroll
    for (int e = 0; e < 8; ++e) { g8[e] = gk ? gk[k0 + 8 * c + e] : 1.f; b8[e] = gk ? bk[k0 + 8 * c + e] : 0.f; }
#pragma unroll
    for (int j = 0; j < 8; ++j) { const int n = (lane >> 3) + 8 * j; const LAS float* q = scr + (8 * c) * 65 + n;
        float w8[8];
#pragma unroll
        for (int e = 0; e < 8; ++e) w8[e] = q[e * 65];
        u32x4 o; o.x = cvt_pk_bf16(w8[0] * g8[0], w8[1] * g8[1]); o.y = cvt_pk_bf16(w8[2] * g8[2], w8[3] * g8[3]); o.z = cvt_pk_bf16(w8[4] * g8[4], w8[5] * g8[5]); o.w = cvt_pk_bf16(w8[6] * g8[6], w8[7] * g8[7]);
        *(u32x4*)(WT + (size_t)(r0 + n) * K + k0 + 8 * c) = o;
        if (gk) {
            float s1 = ((bf_lo(o.x) + bf_hi(o.x)) + (bf_lo(o.y) + bf_hi(o.y))) + ((bf_lo(o.z) + bf_hi(o.z)) + (bf_lo(o.w) + bf_hi(o.w)));
            float s2 = ((w8[0] * b8[0] + w8[1] * b8[1]) + (w8[2] * b8[2] + w8[3] * b8[3])) + ((w8[4] * b8[4] + w8[5] * b8[5]) + (w8[6] * b8[6] + w8[7] * b8[7]));
            s1 += __shfl_xor(s1, 1); s1 += __shfl_xor(s1, 2); s1 += __shfl_xor(s1, 4); s2 += __shfl_xor(s2, 1); s2 += __shfl_xor(s2, 2); s2 += __shfl_xor(s2, 4);
            if (c == 0) { unsafeAtomicAdd(c1 + r0 + n, s1); unsafeAtomicAdd(c2 + r0 + n, s2); }
        } }
    asm volatile("s_waitcnt lgkmcnt(0)" ::: "memory");
}

__device__ __forceinline__ void p0_wq_item(const float* W, bf16_t* WN, const float* gk, const float* bk, float* bW, int item, int lane) {
    const int kb = item >> 5, jb = item & 31, k0 = 64 * kb, j0 = 64 * jb, cg8 = lane & 7, kr = lane >> 3;
    float sacc[8];
#pragma unroll
    for (int e = 0; e < 8; ++e) sacc[e] = 0.f;
#pragma unroll
    for (int i = 0; i < 8; ++i) { const int k = k0 + 8 * i + kr; const float* src = W + (size_t)k * DM + j0 + 8 * cg8;
        const f32x4 v0 = __builtin_nontemporal_load((const f32x4*)src), v1 = __builtin_nontemporal_load((const f32x4*)(src + 4)); const float g = gk[k], bb = bk[k];
        u32x4 o; o.x = cvt_pk_bf16(v0[0] * g, v0[1] * g); o.y = cvt_pk_bf16(v0[2] * g, v0[3] * g); o.z = cvt_pk_bf16(v1[0] * g, v1[1] * g); o.w = cvt_pk_bf16(v1[2] * g, v1[3] * g);
        *(u32x4*)(WN + (size_t)k * DM + j0 + 8 * cg8) = o;
#pragma unroll
        for (int e = 0; e < 4; ++e) { sacc[e] += bb * v0[e]; sacc[4 + e] += bb * v1[e]; } }
#pragma unroll
    for (int e = 0; e < 8; ++e) { float v = sacc[e]; v += __shfl_xor(v, 8); v += __shfl_xor(v, 16); v += __shfl_xor(v, 32); if (kr == 0) unsafeAtomicAdd(bW + j0 + 8 * cg8 + e, v); }
}

__device__ __forceinline__ int causal_bucket(int n) {
    if (n < 16) return n;
    const float nf = (float)n;
    int large = 16 + (int)(logf(nf / 16.f) / 2.0794415416798357f * 16.f);
    return large < 31 ? large : 31;
}

__device__ __forceinline__ size_t zero_opaque() { size_t z = 0; asm volatile("" : "+s"(z)); return z; }
__device__ __forceinline__ const float* inp_ptr(const Args& a, int k) { return a.in[k] + zero_opaque(); }
#define INP(k) inp_ptr(a, k)
__device__ __forceinline__ unsigned char* ws_opaque(const Args& a) { return a.ws + zero_opaque(); }
__device__ __forceinline__ float* out_opaque(const Args& a) { return a.out + zero_opaque(); }
#define WSP(type, off) ((type*)(ws_opaque(a) + (off)))
__global__ void __launch_bounds__(NTHR, 2) mega_fwd(Args a) {
    extern __shared__ __attribute__((aligned(16))) unsigned char lds[];
    volatile LAS unsigned* bst = (volatile LAS unsigned*)((LAS unsigned char*)lds + LDS_BYTES - 64);
    if (threadIdx.x == 0) { bst[0] = 0u; bst[1] = 0u; }
    __syncthreads();
    (void)xcd_barrier_post((unsigned*)(a.ws + WS_BAR), bst);
#define GRID_BAR() do { XcdBarrier xb_; xb_.bar = (unsigned*)(ws_opaque(a) + WS_BAR); unsigned x_ = xb_xcc_id(); asm volatile("" : "+s"(x_)); xb_.x = x_; xb_.st = bst; xcd_barrier(xb_); } while (0)
    const int G = gridDim.x;
    const int NGW = G * NWAVES, NGT = G * NTHR;
    {
        PH_IDS;
        unsigned char* ws = ws_opaque(a);
        float* lamp = (float*)(ws + WS_LAM); float* btab = (float*)(ws + WS_BTAB); bf16_t* wtril = (bf16_t*)(ws + WS_WTRIL); bf16_t* membf = (bf16_t*)(ws + WS_MEMBF); bf16_t* XN = (bf16_t*)(ws + WS_XN);
        LAS float* scr = (LAS float*)((LAS unsigned char*)lds + wave * 17408);
        constexpr int I_IN = 32 * 88, I_SQ = 32 * 32, I_KV = 32 * 64, I_GU = 32 * 176, I_D = 88 * 32;
        constexpr int PER_LAYER = I_IN + 3 * I_SQ + I_KV + I_GU + I_D;
        for (int it = gw; it < 2 * PER_LAYER; it += NGW) {
            const int l = it / PER_LAYER; int r = it % PER_LAYER;
            unsigned char* wl = ws + WS_W + (size_t)l * W_LAYER;
            float* cl = (float*)(ws + WS_C) + (size_t)l * C_LAYER;
            if (r < I_IN) { const bool f = l > 0;
                p0_transpose_item(INP(3) + (size_t)l * DM * INC, DM, INC, (bf16_t*)(wl + W_IN), 0, f ? INP(22) : nullptr, f ? INP(23) : nullptr, cl + C_IN, cl + C_IN + INC, scr, r, lane); continue; } r -= I_IN;
            if (r < I_SQ) { p0_transpose_item(INP(12) + (size_t)l * DM * DM, DM, DM, (bf16_t*)(wl + W_OUT), 0, nullptr, nullptr, nullptr, nullptr, scr, r, lane); continue; } r -= I_SQ;
            if (r < I_SQ) { p0_wq_item(INP(15) + (size_t)l * DM * DM, (bf16_t*)(wl + W_Q), INP(13) + (size_t)l * DM, INP(14) + (size_t)l * DM, cl + C_Q + DM, r, lane); continue; } r -= I_SQ;
            if (r < I_KV) { p0_transpose_item(INP(16) + (size_t)l * DM * 2 * DM, DM, 2 * DM, (bf16_t*)(wl + W_KV), 0, nullptr, nullptr, nullptr, nullptr, scr, r, lane); continue; } r -= I_KV;
            if (r < I_SQ) { p0_transpose_item(INP(17) + (size_t)l * DM * DM, DM, DM, (bf16_t*)(wl + W_O), 0, nullptr, nullptr, nullptr, nullptr, scr, r, lane); continue; } r -= I_SQ;
            if (r < I_GU) { p0_transpose_item(INP(20) + (size_t)l * DM * 2 * DFF, DM, 2 * DFF, (bf16_t*)(wl + W_GU), 1, INP(18) + (size_t)l * DM, INP(19) + (size_t)l * DM, cl + C_GU, cl + C_GU + 2 * DFF, scr, r, lane); continue; } r -= I_GU;
            p0_transpose_item(INP(21) + (size_t)l * DFF * DM, DFF, DM, (bf16_t*)(wl + W_D), 0, nullptr, nullptr, nullptr, nullptr, scr, r, lane);
        }
        for (size_t i = gt; i < (size_t)T * DM / 8; i += (size_t)4 * NGT) {
            f32x4 v0[4], v1[4];
#pragma unroll
            for (int q = 0; q < 4; ++q) { const float* xp = INP(0) + (i + (size_t)q * NGT) * 8; v0[q] = __builtin_nontemporal_load((const f32x4*)xp); v1[q] = __builtin_nontemporal_load((const f32x4*)(xp + 4)); }
#pragma unroll
            for (int q = 0; q < 4; ++q) { u32x4 w; w.x = cvt_pk_bf16(v0[q][0], v0[q][1]); w.y = cvt_pk_bf16(v0[q][2], v0[q][3]); w.z = cvt_pk_bf16(v1[q][0], v1[q][1]); w.w = cvt_pk_bf16(v1[q][2], v1[q][3]);
                *(u32x4*)(XN + (i + (size_t)q * NGT) * 8) = w; }
        }
        for (size_t i = gt; i < (size_t)BATCH * NMEM * DM / 8; i += NGT) {
            const f32x4 v0 = *(const f32x4*)(INP(1) + i * 8), v1 = *(const f32x4*)(INP(1) + i * 8 + 4);
            u32x4 w; w.x = cvt_pk_bf16(v0[0], v0[1]); w.y = cvt_pk_bf16(v0[2], v0[3]); w.z = cvt_pk_bf16(v1[0], v1[1]); w.w = cvt_pk_bf16(v1[2], v1[3]);
            *(u32x4*)(membf + i * 8) = w;
        }
        for (int i = gt; i < DEPTH * 4 * 128 * 128; i += NGT) { const int s = i & 127, t = (i >> 7) & 127; wtril[i] = s <= t ? f2bf(INP(7)[i]) : (bf16_t)0; }
        if (gt < 8 * 256) { const int hm = gt >> 8, d = gt & 255; const float* rb = INP(2);
            btab[gt] = (rb[causal_bucket(d) * 8 + hm] - rb[31 * 8 + hm]) * (1.f / att::SCALE); }
        if (cu == 0 && wave == 0) {
            for (int l = 0; l < DEPTH; ++l) {
                const float* lq = INP(9) + l * 256; const float* lk = INP(10) + l * 256;
                float s0 = lq[lane] * lk[lane] + lq[lane + 64] * lk[lane + 64];
                float s1 = lq[128 + lane] * lk[128 + lane] + lq[192 + lane] * lk[192 + lane];
                s0 = wave_sum(s0); s1 = wave_sum(s1);
                const float lam_init = 0.8f - 0.6f * expf(-0.3f * (float)l);
                if (lane == 0) lamp[l] = expf(s0) - expf(s1) + lam_init;
            }
        }
    }
    GRID_BAR();

#pragma unroll 1
    for (int l = 0; l < DEPTH; ++l) {
        {
            unsigned char* ws = ws_opaque(a);
            pg8::Gemm g{(const bf16_t*)(ws + WS_XN), (const bf16_t*)(ws + WS_W + (size_t)l * W_LAYER + W_IN), DM, DM, DM, 1, 0, 0, 0, 0};
            pg8::Order S; S.init(T, INC, 1, G, cu_opaque());
            const float* cl = (const float*)(ws + WS_C) + (size_t)l * C_LAYER;
            const float* st = l > 0 ? (const float*)(ws + WS_ST) + (size_t)(3 * l - 1) * T * 2 : nullptr;
            pg8::EpiSplit E{(bf16_t*)(ws + WS_PROJ), st, cl + C_IN, cl + C_IN + INC, (float*)(ws + WS_ST) + (size_t)(6 + l) * T * 2};
            pg8::gemm_phase<pg8::EpiSplit, true>((LAS unsigned char*)lds, g, S, E);
        }
        if (l == 0) {
            {
                unsigned char* ws = ws_opaque(a);
                pg8::Gemm g{(const bf16_t*)(ws + WS_MEMBF), (const bf16_t*)(ws + WS_W + W_KV), DM, DM, DM, 1, 0, 0, (long)(W_LAYER / 2), 0};
                pg8::Order S; const int cu = cu_opaque(); S.init(BATCH * NMEM, 2 * DM, 2, G, cu >= 128 && cu < 192 ? cu - 128 : -1);
                pg8::EpiBf16 E{(bf16_t*)(ws + WS_KV), 2 * DM, 1, (long)(BATCH * NMEM) * 2 * DM, 0, 1.f, nullptr, nullptr, nullptr, nullptr};
                pg8::gemm_phase<pg8::EpiBf16, true>((LAS unsigned char*)lds, g, S, E);
            }
        }
        GRID_BAR();

        if (l == 0) {
#pragma unroll 1
            for (int L2 = 0; L2 < DEPTH; ++L2) {
                {
                    unsigned char* ws = ws_opaque(a); unsigned char* wl2 = ws + WS_W + (size_t)L2 * W_LAYER;
                    const bf16_t* KVl = (const bf16_t*)(ws + WS_KV) + (size_t)L2 * BATCH * NMEM * 2 * DM;
                    float* cl = (float*)(ws + WS_C) + (size_t)L2 * C_LAYER;
                    pg8::Gemm g{KVl, (const bf16_t*)(wl2 + W_Q), 2 * DM, DM, 512, 4, (long)NMEM * 2 * DM, 512, 0, 512};
                    pg8::Order S; const int cu = cu_opaque(); S.init(NMEM, DM, 8, G, cu >= 64 * L2 && cu < 64 * L2 + 64 ? cu - 64 * L2 : -1);
                    pg8::EpiBf16 E{(bf16_t*)(wl2 + W_KV), DM, 1, (long)NMEM * DM, 0, 1.f, nullptr, nullptr, nullptr, cl + C_Q};
                    pg8::gemm_phase<pg8::EpiBf16, true>((LAS unsigned char*)lds, g, S, E);
                }
                {
                    unsigned char* ws = ws_opaque(a); unsigned char* wl2 = ws + WS_W + (size_t)L2 * W_LAYER;
                    const bf16_t* KVl = (const bf16_t*)(ws + WS_KV) + (size_t)L2 * BATCH * NMEM * 2 * DM;
                    pg8::Gemm g{(const bf16_t*)(wl2 + W_O), KVl + DM, DM, 2 * DM, 512, 4, 0, 512, (long)NMEM * 2 * DM, 512};
                    pg8::Order S; const int cu = cu_opaque(); S.init(DM, NMEM, 8, G, cu >= 128 + 64 * L2 && cu < 192 + 64 * L2 ? cu - 128 - 64 * L2 : -1);
                    pg8::EpiBf16 E{(bf16_t*)(wl2 + W_KV + 8 * MiB), 1024, 4, (long)DM * 1024, 256, 1.f, nullptr, nullptr, nullptr, nullptr};
                    pg8::gemm_phase<pg8::EpiBf16, true>((LAS unsigned char*)lds, g, S, E);
                }
            }
            {
                PH_IDS;
                unsigned char* ws = ws_opaque(a);
                for (int it = gw; it < DEPTH * 2048; it += NGW) {
                    const int L2 = it >> 11, r = it & 2047, b = r >> 10, h = (r >> 8) & 3, n = r & 255;
                    const bf16_t* kp = (const bf16_t*)(ws + WS_KV) + ((size_t)L2 * BATCH * NMEM + b * NMEM + n) * 2 * DM + h * 512 + 8 * lane;
                    float* cl = (float*)(ws + WS_C) + (size_t)L2 * C_LAYER;
                    const float* bw = cl + C_Q + DM + h * 512 + 8 * lane;
                    const u32x4 kw = *(const u32x4*)kp; const f32x4 b0 = *(const f32x4*)bw, b1 = *(const f32x4*)(bw + 4);
                    float d = (bf_lo(kw.x) * b0[0] + bf_hi(kw.x) * b0[1]) + (bf_lo(kw.y) * b0[2] + bf_hi(kw.y) * b0[3]) + (bf_lo(kw.z) * b1[0] + bf_hi(kw.z) * b1[1]) + (bf_lo(kw.w) * b1[2] + bf_hi(kw.w) * b1[3]);
                    d = wave_sum(d);
                    if (lane == 0) cl[C_QK2 + r] = d;
                }
            }
            __syncthreads();
        }
        {
            PH_IDS;
            bf16_t* PB = WSP(bf16_t, WS_PROJ); bf16_t* Y = WSP(bf16_t, WS_Y);
            const float* cw = INP(4) + (size_t)l * 3 * 512;
            const int cg8 = tid & 63, c0 = cg8 * 8, gi = cg8 >> 4, cc = c0 & 127;
            float k0[8], k1[8], k2[8];
#pragma unroll
            for (int e = 0; e < 8; ++e) { k0[e] = cw[c0 + e]; k1[e] = cw[512 + c0 + e]; k2[e] = cw[1024 + c0 + e]; }
            for (int r4 = gt >> 6; r4 < T / 4; r4 += NGT >> 6) {
                const int r = 4 * r4, t = r & (SEQ - 1);
                const bf16_t* pb = PB + ((size_t)(0 + gi) * T + r) * 128 + cc;
                const bf16_t* pc = PB + ((size_t)(4 + gi) * T + r) * 128 + cc;
                const bf16_t* ph = PB + ((size_t)(8 + gi) * T + r) * 128 + cc;
                u32x4 wc[6], wh[6], wb[4];
#pragma unroll
                for (int i = 0; i < 6; ++i) { wc[i] = (u32x4){0, 0, 0, 0}; wh[i] = (u32x4){0, 0, 0, 0}; }
                if (t >= 2) { wc[0] = *(const u32x4*)(pc - 256); wh[0] = *(const u32x4*)(ph - 256); wc[1] = *(const u32x4*)(pc - 128); wh[1] = *(const u32x4*)(ph - 128); }
#pragma unroll
                for (int i = 0; i < 4; ++i) { wc[2 + i] = *(const u32x4*)(pc + i * 128); wh[2 + i] = *(const u32x4*)(ph + i * 128); wb[i] = *(const u32x4*)(pb + i * 128); }
                float z[6][8];
#pragma unroll
                for (int i = 0; i < 6; ++i)
#pragma unroll
                    for (int j = 0; j < 4; ++j) { z[i][2 * j] = bf_lo(wc[i][j]) * bf_lo(wh[i][j]); z[i][2 * j + 1] = bf_hi(wc[i][j]) * bf_hi(wh[i][j]); }
#pragma unroll
                for (int i = 0; i < 4; ++i) { float y[8];
#pragma unroll
                    for (int j = 0; j < 4; ++j) {
                        y[2 * j] = bf_lo(wb[i][j]) * (k0[2 * j] * z[i][2 * j] + k1[2 * j] * z[i + 1][2 * j] + k2[2 * j] * z[i + 2][2 * j]);
                        y[2 * j + 1] = bf_hi(wb[i][j]) * (k0[2 * j + 1] * z[i][2 * j + 1] + k1[2 * j + 1] * z[i + 1][2 * j + 1] + k2[2 * j + 1] * z[i + 2][2 * j + 1]); }
                    u32x4 w; w.x = cvt_pk_bf16(y[0], y[1]); w.y = cvt_pk_bf16(y[2], y[3]); w.z = cvt_pk_bf16(y[4], y[5]); w.w = cvt_pk_bf16(y[6], y[7]);
                    *(u32x4*)(Y + (size_t)(r + i) * DM + c0) = w; }
            }
        }
        {
            PH_IDS;
            bf16_t* PB = WSP(bf16_t, WS_PROJ); bf16_t* Y = WSP(bf16_t, WS_Y); bf16_t* wtril = WSP(bf16_t, WS_WTRIL);
            float* st = (float*)(lds + 40960);
            bf16_t* vT = (bf16_t*)lds;
            const float* lng = INP(5) + (size_t)l * 512; const float* lnb = INP(6) + (size_t)l * 512;
            const float* bs = INP(8) + (size_t)l * 512;
            const float* gstat = WSP(float, WS_ST) + (size_t)(6 + l) * T * 2;
            float* svL = (float*)(lds + 49152);
            for (int un = cu; un < (T / 128) * 4; un += G) {
                const int ch = un >> 2, gi = un & 3, r0 = ch * 128;
                if (tid < 128) {
                    const float s1 = gstat[2 * (r0 + tid)], s2 = gstat[2 * (r0 + tid) + 1];
                    const float mean = s1 * (1.f / 512.f), var = fmaxf(s2 * (1.f / 512.f) - mean * mean, 0.f);
                    st[2 * tid] = mean; st[2 * tid + 1] = rsqrtf(var + LN_EPS); }
                __syncthreads();
                {
                    const int tok = tid >> 2, cq = (tid & 3) * 32; const float mean = st[2 * tok], rstd = st[2 * tok + 1];
                    const bf16_t* vp = PB + ((size_t)(16 + gi) * T + r0 + tok) * 128 + cq;
#pragma unroll
                    for (int i = 0; i < 4; ++i) { const u32x4 w = *(const u32x4*)(vp + 8 * i);
#pragma unroll
                        for (int j = 0; j < 4; ++j) { const int c = cq + 8 * i + 2 * j;
                            const float x0 = gelu_tanh(bf_lo(w[j])), x1 = gelu_tanh(bf_hi(w[j]));
                            vT[c * 136 + tok] = f2bf((x0 - mean) * rstd * lng[gi * 128 + c] + lnb[gi * 128 + c]);
                            vT[(c + 1) * 136 + tok] = f2bf((x1 - mean) * rstd * lng[gi * 128 + c + 1] + lnb[gi * 128 + c + 1]); } }
                }
                __syncthreads();
                {
                    f32x4 acc[8];
#pragma unroll
                    for (int ct = 0; ct < 8; ++ct) acc[ct] = (f32x4){0.f, 0.f, 0.f, 0.f};
                    const bf16_t* wrow = wtril + ((size_t)(l * 4 + gi) * 128 + 16 * wave + (lane & 15)) * 128 + 8 * (lane >> 4);
#pragma unroll
                    for (int kk = 0; kk < 4; ++kk) { const bf16x8 av = *(const bf16x8*)(wrow + kk * 32);
#pragma unroll
                        for (int ct = 0; ct < 8; ++ct) { const bf16x8 bv = *(const bf16x8*)(vT + (ct * 16 + (lane & 15)) * 136 + kk * 32 + 8 * (lane >> 4));
                            acc[ct] = __builtin_amdgcn_mfma_f32_16x16x32_bf16(av, bv, acc[ct], 0, 0, 0); } }
#pragma unroll
                    for (int j = 0; j < 4; ++j) { const int t = 16 * wave + 4 * (lane >> 4) + j; const float bt = bs[gi * 128 + t];
#pragma unroll
                        for (int ct = 0; ct < 8; ++ct) svL[t * 132 + ct * 16 + (lane & 15)] = acc[ct][j] + bt; }
                }
                __syncthreads();
                {
                    const int c0 = (tid & 15) * 8;
#pragma unroll
                    for (int i = 0; i < 4; ++i) { const int t = 32 * i + (tid >> 4);
                        const u32x4 uw = *(const u32x4*)(PB + ((size_t)(12 + gi) * T + r0 + t) * 128 + c0);
                        const f32x4 s0 = *(const f32x4*)(svL + t * 132 + c0), s1 = *(const f32x4*)(svL + t * 132 + c0 + 4);
                        u32x4 w; w.x = cvt_pk_bf16(gelu_tanh(bf_lo(uw.x)) * s0[0], gelu_tanh(bf_hi(uw.x)) * s0[1]); w.y = cvt_pk_bf16(gelu_tanh(bf_lo(uw.y)) * s0[2], gelu_tanh(bf_hi(uw.y)) * s0[3]);
                        w.z = cvt_pk_bf16(gelu_tanh(bf_lo(uw.z)) * s1[0], gelu_tanh(bf_hi(uw.z)) * s1[1]); w.w = cvt_pk_bf16(gelu_tanh(bf_lo(uw.w)) * s1[2], gelu_tanh(bf_hi(uw.w)) * s1[3]);
                        *(u32x4*)(Y + (size_t)(r0 + t) * DM + 512 + gi * 128 + c0) = w; }
                }
                __syncthreads();
            }
        }
        {
            PH_IDS;
            bf16_t* PB = WSP(bf16_t, WS_PROJ); float* OATT = WSP(float, WS_R1); float* btab = WSP(float, WS_BTAB);
            float* btl = (float*)(lds + att2::L_BT);
            for (int i = tid; i < 8 * 256; i += NTHR) btl[i] = btab[i];
            __syncthreads();
            const att::bf16* PBb = (const att::bf16*)PB;
#pragma unroll 1
            for (int L = cu; L < 512; L += G) {
                const int k_ = L >> 3, hm = L & 7, b = k_ >> 5, x = k_ & 31, h = hm >> 1;
#pragma unroll 1
                for (int pass = 0; pass < 2; ++pass) {
                    const int qb = pass ? 63 - x : x;
                    att2::Blk c;
                    c.Q = PBb + ((size_t)(20 + hm) * T + (size_t)b * SEQ + qb * 128) * 128; c.K = PBb + ((size_t)(28 + hm) * T + (size_t)b * SEQ) * 128;
                    c.V0 = PBb + ((size_t)(36 + h * 2) * T + (size_t)b * SEQ) * 128; c.V1 = PBb + ((size_t)(37 + h * 2) * T + (size_t)b * SEQ) * 128;
                    c.O0 = OATT + ((size_t)((b * 8 + hm) * 2 + 0) * SEQ + qb * 128) * 128; c.O1 = OATT + ((size_t)((b * 8 + hm) * 2 + 1) * SEQ + qb * 128) * 128;
                    c.P0 = qb * 128; c.hm = hm;
                    att2::attn2_block(c, (char*)lds);
                }
            }
        }
        GRID_BAR();

        {
            PH_IDS;
            float* OATT = WSP(float, WS_R1); bf16_t* Y = WSP(bf16_t, WS_Y); float* lamp = WSP(float, WS_LAM);
            const float lam_init = 0.8f - 0.6f * expf(-0.3f * (float)l);
            const float lam = lamp[l]; const float* sg = INP(11) + (size_t)l * 256;
            const f32x4 gv = *(const f32x4*)(sg + 4 * lane);
            for (int it = gw; it < T * 4; it += 2 * NGW) {
                const int half = lane >> 5, e = (lane & 31) * 4;
                const int itb = it + NGW;
                const int ra = it >> 2, ha = it & 3, ba = ra >> 13, ta = ra & (SEQ - 1);
                const int rb = itb >> 2, hb = itb & 3, bb = rb >> 13, tb = rb & (SEQ - 1);
                const size_t a0 = ((size_t)(((ba * 4 + ha) * 2 + 0) * 2 + half) * SEQ + ta) * 128 + e, a1 = ((size_t)(((ba * 4 + ha) * 2 + 1) * 2 + half) * SEQ + ta) * 128 + e;
                const size_t b0 = ((size_t)(((bb * 4 + hb) * 2 + 0) * 2 + half) * SEQ + tb) * 128 + e, b1 = ((size_t)(((bb * 4 + hb) * 2 + 1) * 2 + half) * SEQ + tb) * 128 + e;
                const f32x4 oa0 = *(const f32x4*)(OATT + a0), oa1 = *(const f32x4*)(OATT + a1), ob0 = *(const f32x4*)(OATT + b0), ob1 = *(const f32x4*)(OATT + b1);
                const f32x4 da = oa0 - oa1 * lam, db = ob0 - ob1 * lam;
                const float ssa = wave_sum(da[0] * da[0] + da[1] * da[1] + da[2] * da[2] + da[3] * da[3]);
                const float ssb = wave_sum(db[0] * db[0] + db[1] * db[1] + db[2] * db[2] + db[3] * db[3]);
                const float sca = rsqrtf(ssa * (1.f / 256.f) + LN_EPS) * (1.f - lam_init), scb = rsqrtf(ssb * (1.f / 256.f) + LN_EPS) * (1.f - lam_init);
                u32x2 wa; wa.x = cvt_pk_bf16(da[0] * sca * gv[0], da[1] * sca * gv[1]); wa.y = cvt_pk_bf16(da[2] * sca * gv[2], da[3] * sca * gv[3]);
                u32x2 wb; wb.x = cvt_pk_bf16(db[0] * scb * gv[0], db[1] * scb * gv[1]); wb.y = cvt_pk_bf16(db[2] * scb * gv[2], db[3] * scb * gv[3]);
                *(u32x2*)(Y + (size_t)ra * DM + 1024 + ha * 256 + 4 * lane) = wa;
                *(u32x2*)(Y + (size_t)rb * DM + 1024 + hb * 256 + 4 * lane) = wb;
            }
        }
        GRID_BAR();

#define LN_OUT_PASS(gam, bet) do { PH_IDS; float* X = out_opaque(a); const bf16_t* ZB = WSP(bf16_t, WS_XN); \
            for (int r = gw; r < T; r += NGW) { const bf16_t* zr = ZB + (size_t)r * DM; float* xr = X + (size_t)r * DM; f32x4 v[8]; float s = 0.f; \
                _Pragma("unroll") for (int j = 0; j < 4; ++j) { const u32x4 w = *(const u32x4*)(zr + 8 * lane + 512 * j); \
                    v[2 * j] = (f32x4){bf_lo(w.x), bf_hi(w.x), bf_lo(w.y), bf_hi(w.y)}; v[2 * j + 1] = (f32x4){bf_lo(w.z), bf_hi(w.z), bf_lo(w.w), bf_hi(w.w)}; } \
                _Pragma("unroll") for (int j = 0; j < 8; ++j) s += (v[j][0] + v[j][1]) + (v[j][2] + v[j][3]); \
                const float mean = wave_sum(s) * (1.f / DM); float s2 = 0.f; \
                _Pragma("unroll") for (int j = 0; j < 8; ++j) { v[j] = v[j] - mean; s2 += (v[j][0] * v[j][0] + v[j][1] * v[j][1]) + (v[j][2] * v[j][2] + v[j][3] * v[j][3]); } \
                const float rstd = rsqrtf(wave_sum(s2) * (1.f / DM) + LN_EPS); \
                _Pragma("unroll") for (int j = 0; j < 8; ++j) { const int c = 8 * lane + 512 * (j >> 1) + 4 * (j & 1); \
                    const f32x4 gg = *(const f32x4*)((gam) + c), bb = *(const f32x4*)((bet) + c); \
                    *(f32x4*)(xr + c) = v[j] * rstd * gg + bb; } } } while (0)

        {
            unsigned char* ws = ws_opaque(a); float* X = out_opaque(a); float* ST = (float*)(ws + WS_ST);
            pg8::Gemm g{(const bf16_t*)(ws + WS_Y), (const bf16_t*)(ws + WS_W + (size_t)l * W_LAYER + W_OUT), DM, DM, DM, 1, 0, 0, 0, 0};
            pg8::Order S; S.init(T, DM, 1, G, cu_opaque());
            pg8::EpiRes E{nullptr, l == 0 ? INP(0) : nullptr, ST + (size_t)(l > 0 ? 3 * l - 1 : 0) * T * 2, INP(22) + (size_t)(l > 0 ? l - 1 : 0) * DM, INP(23) + (size_t)(l > 0 ? l - 1 : 0) * DM,
                          (bf16_t*)(ws + WS_XN), ST + (size_t)(3 * l) * T * 2, ALPHA, 0};
            pg8::gemm_phase<pg8::EpiRes, true>((LAS unsigned char*)lds, g, S, E);
        }
        GRID_BAR();

        {
            unsigned char* ws = ws_opaque(a);
            const float* cl = (const float*)(ws + WS_C) + (size_t)l * C_LAYER;
            pg8::Gemm g{(const bf16_t*)(ws + WS_XN), (const bf16_t*)(ws + WS_W + (size_t)l * W_LAYER + W_KV), DM, DM, DM, 4, (long)SEQ * DM, 0, (long)4 * NMEM * DM, (long)NMEM * DM};
            pg8::Order S; S.init(SEQ, NMEM, 8, G, cu_opaque());
            pg8::EpiSoftmax E{(bf16_t*)(ws + WS_PROJ + 64 * MiB), (const float*)(ws + WS_ST) + (size_t)(3 * l) * T * 2, cl + C_Q, cl + C_QK2, 0.044194173824159216f};
            pg8::gemm_phase<pg8::EpiSoftmax, true>((LAS unsigned char*)lds, g, S, E);
        }
        GRID_BAR();
        {
            unsigned char* ws = ws_opaque(a); float* ST = (float*)(ws + WS_ST);
            pg8::Gemm g{(const bf16_t*)(ws + WS_PROJ + 64 * MiB), (const bf16_t*)(ws + WS_W + (size_t)l * W_LAYER + W_KV + 8 * MiB), 1024, 1024, 1024, 1, (long)SEQ * 1024, 0, (long)DM * 1024, 0};
            pg8::Order S; S.init(SEQ, DM, 2, G, cu_opaque());
            pg8::EpiRes E{nullptr, nullptr, ST + (size_t)(3 * l) * T * 2, INP(13) + (size_t)l * DM, INP(14) + (size_t)l * DM, (bf16_t*)(ws + WS_XN), ST + (size_t)(3 * l + 1) * T * 2, ALPHA, SEQ};
            pg8::gemm_phase<pg8::EpiRes, true>((LAS unsigned char*)lds, g, S, E);
        }
        GRID_BAR();
        {
            unsigned char* ws = ws_opaque(a);
            const float* cl = (const float*)(ws + WS_C) + (size_t)l * C_LAYER;
            pg8::Gemm g{(const bf16_t*)(ws + WS_XN), (const bf16_t*)(ws + WS_W + (size_t)l * W_LAYER + W_GU), DM, DM, DM, 1, 0, 0, 0, 0};
            pg8::Order S; S.init(T, 2 * DFF, 1, G, cu_opaque());
            pg8::EpiSwiglu E{(bf16_t*)(ws + WS_PROJ), (const float*)(ws + WS_ST) + (size_t)(3 * l + 1) * T * 2, cl + C_GU, cl + C_GU + 2 * DFF};
            pg8::gemm_phase<pg8::EpiSwiglu, true>((LAS unsigned char*)lds, g, S, E);
        }
        GRID_BAR();
        {
            unsigned char* ws = ws_opaque(a); float* X = out_opaque(a); float* ST = (float*)(ws + WS_ST);
            pg8::Gemm g{(const bf16_t*)(ws + WS_PROJ), (const bf16_t*)(ws + WS_W + (size_t)l * W_LAYER + W_D), DFF, DFF, DFF, 1, 0, 0, 0, 0};
            pg8::Order S; S.init(T, DM, 1, G, cu_opaque());
            pg8::EpiRes E{nullptr, nullptr, ST + (size_t)(3 * l + 1) * T * 2, INP(18) + (size_t)l * DM, INP(19) + (size_t)l * DM, (bf16_t*)(ws + WS_XN), ST + (size_t)(3 * l + 2) * T * 2, ALPHA, 0};
            pg8::gemm_phase<pg8::EpiRes, true>((LAS unsigned char*)lds, g, S, E);
        }
        GRID_BAR();
        if (l + 1 == DEPTH) { LN_OUT_PASS(INP(22) + (size_t)l * DM, INP(23) + (size_t)l * DM); }
#undef LN_OUT_PASS
    }
    if (a.ws == nullptr) cg::this_grid().sync();
}

extern "C" void kernel_launch(void* const* d_in, const int* in_sizes, int n_in, void* d_out, int out_size, void* d_ws, size_t ws_size, hipStream_t stream) {
    static int grid = 0;
    if (grid == 0) {
        if (n_in != 24 || in_sizes[0] != T * DM || out_size != T * DM || ws_size < WS_END) {
            fprintf(stderr, "kernel_launch: unexpected shapes (n_in %d, in0 %d, out %d, ws %zu); nothing launched\n", n_in, n_in > 0 ? in_sizes[0] : -1, out_size, ws_size); grid = -1; return; }
        int dev = 0, cus = 0, per_cu = 0;
        (void)hipGetDevice(&dev);
        if (hipDeviceGetAttribute(&cus, hipDeviceAttributeMultiprocessorCount, dev) != hipSuccess || cus <= 0) cus = 256;
        if (hipFuncSetAttribute((const void*)mega_fwd, hipFuncAttributeMaxDynamicSharedMemorySize, LDS_BYTES) != hipSuccess) fprintf(stderr, "kernel_launch: hipFuncSetAttribute failed\n");
        if (hipOccupancyMaxActiveBlocksPerMultiprocessor(&per_cu, (const void*)mega_fwd, NTHR, LDS_BYTES) != hipSuccess || per_cu < 1) { fprintf(stderr, "kernel_launch: occupancy query says %d\n", per_cu); per_cu = 1; }
        (void)hipGetLastError();
        grid = cus * per_cu;
    }
    if (grid < 0) return;
    if (hipMemsetAsync((char*)d_ws + WS_BAR, 0, WS_ST + 1 * MiB - WS_BAR, stream) != hipSuccess) { fprintf(stderr, "kernel_launch: hipMemsetAsync failed\n"); return; }
    Args a{};
    for (int i = 0; i < 24; ++i) a.in[i] = (const float*)d_in[i];
    a.out = (float*)d_out; a.ws = (unsigned char*)d_ws;
    void* args[] = {&a};
    hipError_t e = hipLaunchCooperativeKernel((const void*)mega_fwd, dim3(grid), dim3(NTHR), args, LDS_BYTES, stream);
    if (e != hipSuccess) fprintf(stderr, "cooperative launch failed: %s (grid %d)\n", hipGetErrorString(e), grid);
}
```

```cpp
#include <hip/hip_runtime.h>
#include <hip/hip_cooperative_groups.h>
#include <hip/hip_bf16.h>
#include <cstdio>
#include <cstdint>
namespace cg = cooperative_groups;

constexpr int BATCH = 2, SEQ = 8192, DM = 2048, DEPTH = 2, T = BATCH * SEQ;
constexpr int NMEM = 256, INC = 5632, DFF = 5632;
constexpr float ALPHA = 1.4142135623730951f;
constexpr float LN_EPS = 1e-5f;
constexpr int NTHR = 512, NWAVES = 8;

constexpr size_t MiB = 1u << 20;
constexpr size_t WS_LAM = 0;
constexpr size_t WS_BTAB = 4096;
constexpr size_t WS_BAR = 512 * 1024;
constexpr size_t WS_C = 576 * 1024;
constexpr int C_Q = 0, C_GU = 4096, C_IN = 4096 + 22528, C_QK2 = 4096 + 22528 + 11264, C_LAYER = C_QK2 + 2048;
constexpr size_t WS_ST = 1 * MiB;
constexpr size_t WS_WTRIL = 12 * MiB;
constexpr size_t WS_MEMBF = 2 * MiB;
constexpr size_t WS_KV = 4 * MiB;
constexpr size_t WS_W = 16 * MiB;
constexpr size_t W_IN = 0, W_OUT = 22 * MiB, W_Q = 30 * MiB, W_KV = 38 * MiB, W_O = 54 * MiB, W_GU = 62 * MiB, W_D = 106 * MiB, W_LAYER = 128 * MiB;
constexpr size_t WS_XN = 272 * MiB;
constexpr size_t WS_PROJ = 336 * MiB;
constexpr size_t WS_R1 = 512 * MiB;
constexpr size_t WS_Y = 640 * MiB;
constexpr size_t WS_END = 704 * MiB;
constexpr int LDS_BYTES = 147456;

typedef unsigned short bf16_t;
typedef short bf16x8 __attribute__((ext_vector_type(8)));
typedef float f32x4 __attribute__((ext_vector_type(4)));
typedef float f32x16 __attribute__((ext_vector_type(16)));
typedef unsigned u32x4 __attribute__((ext_vector_type(4)));
typedef unsigned u32x2 __attribute__((ext_vector_type(2)));
#define LAS __attribute__((address_space(3)))
#define GAS __attribute__((address_space(1)))

__device__ __forceinline__ unsigned cvt_pk_bf16(float lo, float hi) { unsigned r; asm volatile("v_cvt_pk_bf16_f32 %0, %1, %2" : "=v"(r) : "v"(lo), "v"(hi)); return r; }
__device__ __forceinline__ float bf_lo(unsigned w) { return __uint_as_float(w << 16); }
__device__ __forceinline__ float bf_hi(unsigned w) { return __uint_as_float(w & 0xffff0000u); }
__device__ __forceinline__ float bf2f(bf16_t b) { return __uint_as_float(((unsigned)b) << 16); }
__device__ __forceinline__ bf16_t f2bf(float f) { return (bf16_t)(cvt_pk_bf16(f, 0.f) & 0xffffu); }
__device__ __forceinline__ int ltid() { int t = threadIdx.x; asm volatile("" : "+v"(t)); return t; }
__device__ __forceinline__ int cu_opaque() { int c = blockIdx.x; asm volatile("" : "+s"(c)); return c; }
#define PH_IDS const int cu = cu_opaque(); const int tid = ltid(), lane = tid & 63, wave = __builtin_amdgcn_readfirstlane(tid >> 6), gw = cu * NWAVES + wave, gt = cu * NTHR + tid; (void)lane; (void)wave; (void)gw; (void)gt
__device__ __forceinline__ float wave_sum(float v) {
#pragma unroll
    for (int o = 1; o < 64; o <<= 1) v += __shfl_xor(v, o);
    return v;
}
__device__ __forceinline__ float wave_max(float v) {
#pragma unroll
    for (int o = 1; o < 64; o <<= 1) v = fmaxf(v, __shfl_xor(v, o));
    return v;
}
__device__ __forceinline__ float gelu_tanh(float x) {
    const float y = 0.7978845608028654f * (x + 0.044715f * x * x * x);
    return x * __builtin_amdgcn_rcpf(1.f + __expf(-2.f * y));
}

namespace pg8 {
constexpr int BM = 256, BK = 64, HALF = 128, HTB = HALF * BK * 2, STAGE_BYTES = 8 * HTB, NXCD = 8, WGM = 8;
__host__ __device__ __forceinline__ int lds_byte(int r, int c) { const int st = (r >> 4) * 2 + (c >> 5), rr = r & 15, cc = c & 31, ob = rr * 64 + cc * 2; return st * 1024 + (ob ^ (((ob >> 9) & 1) << 5)); }
__host__ __device__ __forceinline__ void stage_rc(int b, int& R, int& C) { const int st = b / 1024, sb = b % 1024, swz = sb ^ (((sb >> 9) & 1) << 5); R = (st >> 1) * 16 + swz / 64; C = (st & 1) * 32 + (swz % 64) / 2; }
__host__ __device__ __forceinline__ int perm32(int rho) { const int n = rho >> 4, i = rho & 15; return 8 * (i >> 2) + 4 * n + (i & 3); }

struct Unit { int pm, pn, bz; };
struct Gemm { const bf16_t* A; const bf16_t* Bt; int lda, ldb, K, nb0; long a_s1, a_s0, b_s1, b_s0; };
__device__ __forceinline__ const char* unit_a(const Gemm& g, const Unit& u) { const int b1 = u.bz / g.nb0, b0 = u.bz % g.nb0; return (const char*)(g.A + (size_t)b1 * g.a_s1 + (size_t)b0 * g.a_s0 + (size_t)u.pm * BM * g.lda); }
__device__ __forceinline__ const char* unit_b(const Gemm& g, const Unit& u) { const int b1 = u.bz / g.nb0, b0 = u.bz % g.nb0; return (const char*)(g.Bt + (size_t)b1 * g.b_s1 + (size_t)b0 * g.b_s0 + (size_t)u.pn * BM * g.ldb); }

struct Order {
    int nM, nN, nB, G, c;
    __device__ void init(int M, int N, int nB_, int G_, int c_) { nM = M / BM; nN = N / BM; nB = nB_; G = G_; c = c_; }
    __device__ bool next(int i, Unit& u) const {
        const long L = (long)i * G + c; const int nwg = nM * nN; if (c < 0 || L >= (long)nwg * nB) return false;
        if (nB > 1) { u.bz = (int)(L / nwg); const int w = (int)(L % nwg); u.pn = w / nM; u.pm = w % nM; return true; }
        u.bz = 0;
        int wgid = (int)L; { const int q = nwg / NXCD, r = nwg % NXCD, xcd = wgid % NXCD, off = wgid / NXCD; wgid = (xcd < r ? xcd * (q + 1) : r * (q + 1) + (xcd - r) * q) + off; }
        const int nig = WGM * nN, gid = wgid / nig, fm = gid * WGM, gsz = (nM - fm) < WGM ? (nM - fm) : WGM;
        u.pm = fm + ((wgid % nig) % gsz); u.pn = (wgid % nig) / gsz; return true;
    }
};

__device__ __forceinline__ void row_stats(const float* st, int row, float& mean, float& rstd) {
    const float s1 = st[2 * row], s2 = st[2 * row + 1];
    mean = s1 * (1.f / DM); const float var = fmaxf(s2 * (1.f / DM) - mean * mean, 0.f); rstd = rsqrtf(var + LN_EPS);
}
struct EpiSplit {
    static constexpr bool PERM = true, AFTER_DRAIN = false;
    bf16_t* P; const float* st; const float* c1; const float* c2;
    float* gst;
    __device__ __forceinline__ void operator()(const f32x4 (&acc)[2][2][4][2], const Unit& u, int wr, int wc, int fr, int fq) const {
        const int row0 = u.pm * BM + wr * 64 + fr, col0 = u.pn * BM + wc * 32 + 8 * fq;
        const bool vg = (u.pn == 8 || u.pn == 9);
        f32x4 k1[2][2], k2[2][2];
        if (st) {
#pragma unroll
            for (int bj = 0; bj < 2; ++bj)
#pragma unroll
                for (int n = 0; n < 2; ++n) { k1[bj][n] = *(const f32x4*)(c1 + col0 + bj * HALF + 4 * n); k2[bj][n] = *(const f32x4*)(c2 + col0 + bj * HALF + 4 * n); } }
#pragma unroll
        for (int ai = 0; ai < 2; ++ai)
#pragma unroll
            for (int m = 0; m < 4; ++m) { const int row = row0 + ai * HALF + m * 16;
                float mean = 0.f, rstd = 1.f; if (st) row_stats(st, row, mean, rstd);
                float gs = 0.f, gq = 0.f;
#pragma unroll
                for (int bj = 0; bj < 2; ++bj) { f32x4 v0 = acc[ai][bj][m][0], v1 = acc[ai][bj][m][1];
                    if (st) { v0 = (v0 - k1[bj][0] * mean) * rstd + k2[bj][0]; v1 = (v1 - k1[bj][1] * mean) * rstd + k2[bj][1]; }
                    u32x4 w; w.x = cvt_pk_bf16(v0[0], v0[1]); w.y = cvt_pk_bf16(v0[2], v0[3]); w.z = cvt_pk_bf16(v1[0], v1[1]); w.w = cvt_pk_bf16(v1[2], v1[3]);
                    *(u32x4*)(P + ((size_t)(u.pn * 2 + bj) * T + row) * 128 + wc * 32 + 8 * fq) = w;
                    if (vg) {
#pragma unroll
                        for (int j = 0; j < 4; ++j) { const float x0 = gelu_tanh(bf_lo(w[j])), x1 = gelu_tanh(bf_hi(w[j])); gs += x0 + x1; gq += x0 * x0 + x1 * x1; } } }
                if (vg) { gs += __shfl_xor(gs, 16); gs += __shfl_xor(gs, 32); gq += __shfl_xor(gq, 16); gq += __shfl_xor(gq, 32);
                    if (fq == 0) { unsafeAtomicAdd(gst + 2 * row, gs); unsafeAtomicAdd(gst + 2 * row + 1, gq); } } }
    }
};
struct EpiBf16 {
    static constexpr bool PERM = true, AFTER_DRAIN = false;
    bf16_t* O; int ldc, nb0; long o_s1, o_s0; float scale; const float* st; const float* c1; const float* c2; float* rsum;
    __device__ __forceinline__ void operator()(const f32x4 (&acc)[2][2][4][2], const Unit& u, int wr, int wc, int fr, int fq) const {
        const int row0 = u.pm * BM + wr * 64 + fr, col0 = u.pn * BM + wc * 32 + 8 * fq;
        bf16_t* base = O + (size_t)(u.bz / nb0) * o_s1 + (size_t)(u.bz % nb0) * o_s0;
        f32x4 k1[2][2], k2[2][2];
        if (st) {
#pragma unroll
            for (int bj = 0; bj < 2; ++bj)
#pragma unroll
                for (int n = 0; n < 2; ++n) { k1[bj][n] = *(const f32x4*)(c1 + col0 + bj * HALF + 4 * n); k2[bj][n] = *(const f32x4*)(c2 + col0 + bj * HALF + 4 * n); } }
#pragma unroll
        for (int ai = 0; ai < 2; ++ai)
#pragma unroll
            for (int m = 0; m < 4; ++m) { const int row = row0 + ai * HALF + m * 16; bf16_t* rowp = base + (size_t)row * ldc + col0;
                float mean = 0.f, rstd = 1.f; if (st) row_stats(st, row, mean, rstd);
                float rs = 0.f;
#pragma unroll
                for (int bj = 0; bj < 2; ++bj) { f32x4 v0 = acc[ai][bj][m][0], v1 = acc[ai][bj][m][1];
                    if (st) { v0 = (v0 - k1[bj][0] * mean) * rstd + k2[bj][0]; v1 = (v1 - k1[bj][1] * mean) * rstd + k2[bj][1]; }
                    v0 = v0 * scale; v1 = v1 * scale;
                    u32x4 w; w.x = cvt_pk_bf16(v0[0], v0[1]); w.y = cvt_pk_bf16(v0[2], v0[3]); w.z = cvt_pk_bf16(v1[0], v1[1]); w.w = cvt_pk_bf16(v1[2], v1[3]);
                    *(u32x4*)(rowp + bj * HALF) = w;
                    if (rsum) rs += ((bf_lo(w.x) + bf_hi(w.x)) + (bf_lo(w.y) + bf_hi(w.y))) + ((bf_lo(w.z) + bf_hi(w.z)) + (bf_lo(w.w) + bf_hi(w.w))); }
                if (rsum) { rs += __shfl_xor(rs, 16); rs += __shfl_xor(rs, 32); if (fq == 0) unsafeAtomicAdd(rsum + u.bz * 256 + row, rs); } }
    }
};
struct EpiF32 {
    static constexpr bool PERM = false, AFTER_DRAIN = false;
    float* out; int ldc; long o_bs; float scale;
    __device__ __forceinline__ void operator()(const f32x4 (&acc)[2][2][4][2], const Unit& u, int wr, int wc, int fr, int fq) const {
        const int row0 = u.pm * BM + wr * 64 + fr, col0 = u.pn * BM + wc * 32 + 4 * fq;
        float* ob = out + (size_t)u.bz * o_bs;
#pragma unroll
        for (int ai = 0; ai < 2; ++ai)
#pragma unroll
            for (int m = 0; m < 4; ++m) { const size_t off = (size_t)(row0 + ai * HALF + m * 16) * ldc + col0;
#pragma unroll
                for (int bj = 0; bj < 2; ++bj)
#pragma unroll
                    for (int n = 0; n < 2; ++n) *(f32x4*)(ob + off + bj * HALF + n * 16) = acc[ai][bj][m][n] * scale; }
    }
};
struct EpiRes {
    static constexpr bool PERM = true, AFTER_DRAIN = false;
    float* X; const float* raw; const float* pst; const float* pg; const float* pb; bf16_t* ZB; float* cst; float alpha; int brows;
    __device__ __forceinline__ void operator()(const f32x4 (&acc)[2][2][4][2], const Unit& u, int wr, int wc, int fr, int fq) const {
        const int row0 = u.bz * brows + u.pm * BM + wr * 64 + fr, col0 = u.pn * BM + wc * 32 + 8 * fq;
        f32x4 gv[2][2], bv[2][2];
        if (!raw) {
#pragma unroll
            for (int bj = 0; bj < 2; ++bj)
#pragma unroll
                for (int n = 0; n < 2; ++n) { gv[bj][n] = *(const f32x4*)(pg + col0 + bj * HALF + 4 * n); bv[bj][n] = *(const f32x4*)(pb + col0 + bj * HALF + 4 * n); } }
#pragma unroll
        for (int ai = 0; ai < 2; ++ai)
#pragma unroll
            for (int m = 0; m < 4; ++m) { const int row = row0 + ai * HALF + m * 16; const size_t off = (size_t)row * DM + col0;
                float mean = 0.f, rstd = 1.f; if (!raw) row_stats(pst, row, mean, rstd);
                float s1 = 0.f, s2 = 0.f;
#pragma unroll
                for (int bj = 0; bj < 2; ++bj) { f32x4 r0, r1;
                    if (raw) { r0 = *(const f32x4*)(raw + off + bj * HALF); r1 = *(const f32x4*)(raw + off + bj * HALF + 4); }
                    else { const u32x4 zw = *(const u32x4*)(ZB + off + bj * HALF);
                        r0 = (f32x4){bf_lo(zw.x), bf_hi(zw.x), bf_lo(zw.y), bf_hi(zw.y)}; r1 = (f32x4){bf_lo(zw.z), bf_hi(zw.z), bf_lo(zw.w), bf_hi(zw.w)};
                        r0 = (r0 - mean) * rstd * gv[bj][0] + bv[bj][0]; r1 = (r1 - mean) * rstd * gv[bj][1] + bv[bj][1]; }
                    const f32x4 z0 = acc[ai][bj][m][0] + r0 * alpha, z1 = acc[ai][bj][m][1] + r1 * alpha;
                    if (X) { *(f32x4*)(X + off + bj * HALF) = z0; *(f32x4*)(X + off + bj * HALF + 4) = z1; }
                    u32x4 w; w.x = cvt_pk_bf16(z0[0], z0[1]); w.y = cvt_pk_bf16(z0[2], z0[3]); w.z = cvt_pk_bf16(z1[0], z1[1]); w.w = cvt_pk_bf16(z1[2], z1[3]);
                    *(u32x4*)(ZB + off + bj * HALF) = w;
                    s1 += ((z0[0] + z0[1]) + (z0[2] + z0[3])) + ((z1[0] + z1[1]) + (z1[2] + z1[3]));
                    s2 += ((z0[0] * z0[0] + z0[1] * z0[1]) + (z0[2] * z0[2] + z0[3] * z0[3])) + ((z1[0] * z1[0] + z1[1] * z1[1]) + (z1[2] * z1[2] + z1[3] * z1[3])); }
                s1 += __shfl_xor(s1, 16); s1 += __shfl_xor(s1, 32); s2 += __shfl_xor(s2, 16); s2 += __shfl_xor(s2, 32);
                if (fq == 0) { unsafeAtomicAdd(cst + 2 * row, s1); unsafeAtomicAdd(cst + 2 * row + 1, s2); } }
    }
};
struct EpiSwiglu {
    static constexpr bool PERM = true, AFTER_DRAIN = false;
    bf16_t* H; const float* st; const float* c1; const float* c2;
    __device__ __forceinline__ void operator()(const f32x4 (&acc)[2][2][4][2], const Unit& u, int wr, int wc, int fr, int fq) const {
        const int row0 = u.pm * BM + wr * 64 + fr, col0 = u.pn * HALF + wc * 32 + 8 * fq, ccol0 = u.pn * BM + wc * 32 + 8 * fq;
        f32x4 k1[2][2], k2[2][2];
#pragma unroll
        for (int bj = 0; bj < 2; ++bj)
#pragma unroll
            for (int n = 0; n < 2; ++n) { k1[bj][n] = *(const f32x4*)(c1 + ccol0 + bj * HALF + 4 * n); k2[bj][n] = *(const f32x4*)(c2 + ccol0 + bj * HALF + 4 * n); }
#pragma unroll
        for (int ai = 0; ai < 2; ++ai)
#pragma unroll
            for (int m = 0; m < 4; ++m) { const int row = row0 + ai * HALF + m * 16; bf16_t* rowp = H + (size_t)row * DFF + col0;
                float mean, rstd; row_stats(st, row, mean, rstd);
                float h[8];
#pragma unroll
                for (int n = 0; n < 2; ++n) { const f32x4 gq = (acc[ai][0][m][n] - k1[0][n] * mean) * rstd + k2[0][n], uq = (acc[ai][1][m][n] - k1[1][n] * mean) * rstd + k2[1][n];
#pragma unroll
                    for (int j = 0; j < 4; ++j) h[n * 4 + j] = gq[j] * __builtin_amdgcn_rcpf(1.f + __expf(-gq[j])) * uq[j]; }
                u32x4 w; w.x = cvt_pk_bf16(h[0], h[1]); w.y = cvt_pk_bf16(h[2], h[3]); w.z = cvt_pk_bf16(h[4], h[5]); w.w = cvt_pk_bf16(h[6], h[7]);
                *(u32x4*)rowp = w; }
    }
};

struct EpiSoftmax {
    static constexpr bool PERM = true, AFTER_DRAIN = true;
    bf16_t* PALL; const float* st; const float* c1; const float* c2; float scale;
    __device__ __forceinline__ void fused(f32x4 (&acc)[2][2][4][2], const Unit& u, int wr, int wc, int fr, int fq, LAS unsigned char* lds) const {
        const int b = u.bz >> 2, h = u.bz & 3, rl0 = wr * 64 + fr, cc0 = wc * 32 + 8 * fq;
        LAS float* PMX = (LAS float*)lds; LAS float* PSM = PMX + 1024;
        f32x4 k1[2][2], k2[2][2];
#pragma unroll
        for (int bj = 0; bj < 2; ++bj)
#pragma unroll
            for (int n = 0; n < 2; ++n) { k1[bj][n] = *(const f32x4*)(c1 + u.bz * 256 + cc0 + bj * HALF + 4 * n); k2[bj][n] = *(const f32x4*)(c2 + u.bz * 256 + cc0 + bj * HALF + 4 * n); }
#pragma unroll
        for (int ai = 0; ai < 2; ++ai)
#pragma unroll
            for (int m = 0; m < 4; ++m) { const int rl = rl0 + ai * HALF + m * 16, row = b * SEQ + u.pm * BM + rl;
                float mean, rstd; row_stats(st, row, mean, rstd);
                float mx = -__builtin_inff();
#pragma unroll
                for (int bj = 0; bj < 2; ++bj)
#pragma unroll
                    for (int n = 0; n < 2; ++n) { const f32x4 v = ((acc[ai][bj][m][n] - k1[bj][n] * mean) * rstd + k2[bj][n]) * scale; acc[ai][bj][m][n] = v;
                        mx = fmaxf(mx, fmaxf(fmaxf(v[0], v[1]), fmaxf(v[2], v[3]))); }
                mx = fmaxf(mx, __shfl_xor(mx, 16)); mx = fmaxf(mx, __shfl_xor(mx, 32));
                if (fq == 0) PMX[rl * 4 + wc] = mx; }
        asm volatile("s_waitcnt lgkmcnt(0)" ::: "memory"); __builtin_amdgcn_s_barrier(); asm volatile("" ::: "memory");
#pragma unroll
        for (int ai = 0; ai < 2; ++ai)
#pragma unroll
            for (int m = 0; m < 4; ++m) { const int rl = rl0 + ai * HALF + m * 16;
                const f32x4 q = *(const LAS f32x4*)(PMX + rl * 4); const float mx = fmaxf(fmaxf(q[0], q[1]), fmaxf(q[2], q[3]));
                float sm = 0.f;
#pragma unroll
                for (int bj = 0; bj < 2; ++bj)
#pragma unroll
                    for (int n = 0; n < 2; ++n) { f32x4 e = acc[ai][bj][m][n] - mx; e[0] = __expf(e[0]); e[1] = __expf(e[1]); e[2] = __expf(e[2]); e[3] = __expf(e[3]); acc[ai][bj][m][n] = e;
                        sm += (e[0] + e[1]) + (e[2] + e[3]); }
                sm += __shfl_xor(sm, 16); sm += __shfl_xor(sm, 32);
                if (fq == 0) PSM[rl * 4 + wc] = sm; }
        asm volatile("s_waitcnt lgkmcnt(0)" ::: "memory"); __builtin_amdgcn_s_barrier(); asm volatile("" ::: "memory");
#pragma unroll
        for (int ai = 0; ai < 2; ++ai)
#pragma unroll
            for (int m = 0; m < 4; ++m) { const int rl = rl0 + ai * HALF + m * 16, row = b * SEQ + u.pm * BM + rl;
                const f32x4 q = *(const LAS f32x4*)(PSM + rl * 4); const float inv = __builtin_amdgcn_rcpf((q[0] + q[1]) + (q[2] + q[3]));
                bf16_t* rowp = PALL + (size_t)row * 1024 + h * 256 + cc0;
#pragma unroll
                for (int bj = 0; bj < 2; ++bj) { const f32x4 v0 = acc[ai][bj][m][0] * inv, v1 = acc[ai][bj][m][1] * inv;
                    u32x4 w; w.x = cvt_pk_bf16(v0[0], v0[1]); w.y = cvt_pk_bf16(v0[2], v0[3]); w.z = cvt_pk_bf16(v1[0], v1[1]); w.w = cvt_pk_bf16(v1[2], v1[3]);
                    *(u32x4*)(rowp + bj * HALF) = w; } }
    }
};

template <class Epi, bool ALIGN_EPI>
__device__ __forceinline__ void gemm_phase(LAS unsigned char* lds, const Gemm g, const Order& S, const Epi& E) {
    const int tid = ltid(), wid = __builtin_amdgcn_readfirstlane(tid >> 6), lane = tid & 63, wr = wid >> 2, wc = wid & 3, fr = lane & 15, fq = lane >> 4;
    const int K = g.K, nt = K / BK;
    unsigned voffA[2], voffB[2];
#pragma unroll
    for (int i = 0; i < 2; ++i) { int R, C; stage_rc(tid * 16 + i * 8192, R, C); const int Rb = Epi::PERM ? ((R & ~31) + perm32(R & 31)) : R;
        voffA[i] = (unsigned)(R * g.lda + C) * 2u; voffB[i] = (unsigned)(Rb * g.ldb + C) * 2u; }
    const size_t kstep = (size_t)(BK * 2);
    const size_t hstepA = (size_t)HALF * g.lda * 2, hstepB = (size_t)HALF * g.ldb * 2;
    const unsigned ldsw = (unsigned)wid * 1024u;
    const int aoff = lds_byte(wr * 64 + fr, fq * 8), boff = lds_byte(wc * 32 + fr, fq * 8);
#define PG8_SA(b, h) (((b) * 2 + (h)) * HTB)
#define PG8_SB(b, h) ((4 + (b) * 2 + (h)) * HTB)
#define PG8_STAGE(bufoff, gbase, voff) do { _Pragma("unroll") for (int _i = 0; _i < 2; ++_i) \
        __builtin_amdgcn_global_load_lds((const unsigned*)((const char*)(gbase) + (voff)[_i]), (LAS unsigned*)(lds + (bufoff) + ldsw + _i * 8192), 16, 0, 0); } while (0)
#define PG8_LDA(dst, b, h) do { _Pragma("unroll") for (int m = 0; m < 4; ++m) _Pragma("unroll") for (int k = 0; k < 2; ++k) dst[m][k] = *(const LAS bf16x8*)(lds + PG8_SA(b, h) + aoff + m * 2048 + k * 1024); } while (0)
#define PG8_LDB(dst, b, h) do { _Pragma("unroll") for (int n = 0; n < 2; ++n) _Pragma("unroll") for (int k = 0; k < 2; ++k) dst[n][k] = *(const LAS bf16x8*)(lds + PG8_SB(b, h) + boff + n * 2048 + k * 1024); } while (0)
#define PG8_MMA(ai, bj, At, Bt) do { __builtin_amdgcn_s_setprio(1); _Pragma("unroll") for (int m = 0; m < 4; ++m) _Pragma("unroll") for (int n = 0; n < 2; ++n) _Pragma("unroll") for (int k = 0; k < 2; ++k) \
        acc[ai][bj][m][n] = __builtin_amdgcn_mfma_f32_16x16x32_bf16(Bt[n][k], At[m][k], acc[ai][bj][m][n], 0, 0, 0); __builtin_amdgcn_s_setprio(0); } while (0)
#define PG8_WAIT_V(n) asm volatile("s_waitcnt vmcnt(" #n ")" ::: "memory")
#define PG8_WAIT_L(n) asm volatile("s_waitcnt lgkmcnt(" #n ")" ::: "memory")
#define PG8_BAR __builtin_amdgcn_s_barrier()
#define PG8_SCHED __builtin_amdgcn_sched_barrier(0)
    Unit cur, nxt; int ui = 0;
    if (!S.next(0, cur)) return;
    f32x4 acc[2][2][4][2];
#pragma unroll
    for (int a = 0; a < 2; ++a)
#pragma unroll
        for (int b = 0; b < 2; ++b)
#pragma unroll
            for (int m = 0; m < 4; ++m)
#pragma unroll
                for (int n = 0; n < 2; ++n) acc[a][b][m][n] = (f32x4){0.f, 0.f, 0.f, 0.f};
    bf16x8 At[4][2], B0[2][2], B1[2][2];
    const char* cA = unit_a(g, cur); const char* cB = unit_b(g, cur);
    PG8_STAGE(PG8_SB(0, 0), cB, voffB); PG8_STAGE(PG8_SB(0, 1), cB + hstepB, voffB); PG8_STAGE(PG8_SA(0, 0), cA, voffA); PG8_STAGE(PG8_SA(0, 1), cA + hstepA, voffA);
    if (wr == 1) PG8_BAR;
    PG8_WAIT_V(2); PG8_BAR;
    PG8_STAGE(PG8_SB(1, 0), cB + kstep, voffB); PG8_STAGE(PG8_SA(1, 0), cA + kstep, voffA); PG8_STAGE(PG8_SB(1, 1), cB + hstepB + kstep, voffB);
    PG8_WAIT_V(6); PG8_BAR;
    for (;;) {
        const bool has_next = S.next(ui + 1, nxt);
        const char* nA = has_next ? unit_a(g, nxt) : cA; const char* nB = has_next ? unit_b(g, nxt) : cB;
        for (int t = 0; t < nt; t += 2) {
            const bool last = (t == nt - 2);
            const char* a1 = cA + (size_t)(t + 1) * kstep;
            const char* a2 = last ? nA : cA + (size_t)(t + 2) * kstep; const char* b2 = last ? nB : cB + (size_t)(t + 2) * kstep;
            const char* a3 = a2 + kstep; const char* b3 = b2 + kstep;
            PG8_LDB(B0, 0, 0); PG8_LDB(B1, 0, 1); PG8_SCHED; PG8_LDA(At, 0, 0); PG8_STAGE(PG8_SA(1, 1), a1 + hstepA, voffA);
            PG8_WAIT_V(8); PG8_WAIT_L(0); PG8_BAR; PG8_MMA(0, 0, At, B0); PG8_MMA(0, 1, At, B1); PG8_BAR; PG8_SCHED;
            PG8_LDA(At, 0, 1); PG8_STAGE(PG8_SB(0, 0), b2, voffB); PG8_STAGE(PG8_SB(0, 1), b2 + hstepB, voffB); PG8_STAGE(PG8_SA(0, 0), a2, voffA);
            PG8_WAIT_V(8); PG8_WAIT_L(0); PG8_BAR; PG8_MMA(1, 0, At, B0); PG8_MMA(1, 1, At, B1); PG8_BAR; PG8_SCHED;
            PG8_LDB(B0, 1, 0); PG8_LDB(B1, 1, 1); PG8_SCHED; PG8_LDA(At, 1, 0); PG8_STAGE(PG8_SA(0, 1), a2 + hstepA, voffA);
            PG8_WAIT_V(8); PG8_WAIT_L(0); PG8_BAR; PG8_MMA(0, 0, At, B0); PG8_MMA(0, 1, At, B1); PG8_BAR; PG8_SCHED;
            PG8_LDA(At, 1, 1); PG8_STAGE(PG8_SB(1, 0), b3, voffB); PG8_STAGE(PG8_SB(1, 1), b3 + hstepB, voffB); PG8_STAGE(PG8_SA(1, 0), a3, voffA);
            PG8_WAIT_V(8); PG8_WAIT_L(0); PG8_BAR; PG8_MMA(1, 0, At, B0); PG8_MMA(1, 1, At, B1); PG8_BAR; PG8_SCHED;
        }
        if constexpr (ALIGN_EPI) { if (wr == 0) PG8_BAR; }
        if constexpr (!Epi::AFTER_DRAIN) E(acc, cur, wr, wc, fr, fq);
        if (!has_next) break;
#pragma unroll
        for (int a = 0; a < 2; ++a)
#pragma unroll
            for (int b = 0; b < 2; ++b)
#pragma unroll
                for (int m = 0; m < 4; ++m)
#pragma unroll
                    for (int n = 0; n < 2; ++n) acc[a][b][m][n] = (f32x4){0.f, 0.f, 0.f, 0.f};
        cur = nxt; cA = nA; cB = nB; ++ui;
        if constexpr (ALIGN_EPI) { if (wr == 1) PG8_BAR; }
    }
    PG8_WAIT_V(0);
    if constexpr (!ALIGN_EPI) { if (wr == 0) PG8_BAR; }
    PG8_BAR;
    if constexpr (Epi::AFTER_DRAIN) E.fused(acc, cur, wr, wc, fr, fq, lds);
#undef PG8_SA
#undef PG8_SB
#undef PG8_STAGE
#undef PG8_LDA
#undef PG8_LDB
#undef PG8_MMA
#undef PG8_WAIT_V
#undef PG8_WAIT_L
#undef PG8_BAR
#undef PG8_SCHED
}
}

namespace att {
using bf16 = __hip_bfloat16;
typedef short s16x4 __attribute__((ext_vector_type(4)));
constexpr int D = 128;
constexpr float THR = 8.f;
constexpr float SCALE = 0.08838834764831845f;
constexpr int NW = 8, QBLK = 32, KVBLK = 64, QB = NW * QBLK;
constexpr int SHM_V = KVBLK * D * 2, SHM_K = KVBLK * D * 2;
constexpr int ATT_LDS = 2 * SHM_V + 2 * SHM_K + NW * 64 * 4;
constexpr int BT_OFF = ATT_LDS;

#define KSWZ(row, colB) ((row) * 256 + ((colB) ^ (((row) & 7) << 4)))
#define SBAR() __builtin_amdgcn_sched_barrier(0)
__device__ __forceinline__ int v_st(int k, int c) { const int kk = (k & ~0xC) | ((k & 4) << 1) | ((k & 8) >> 1); return ((kk >> 3) * 4 + (c >> 5)) * 512 + ((kk & 7) * 32 + (c & 31)) * 2; }
__device__ __forceinline__ int v_rd_base(int lane) { return ((lane & 3) << 3) | (((lane >> 2) & 3) << 6) | (((lane >> 4) & 1) << 5) | (((lane >> 5) & 1) << 8); }
constexpr int v_rd_off(int d0, int ks, int half) { return d0 * 512 + ks * 4096 + half * 2048; }
__device__ __forceinline__ int crow(int r, int hi) { return (r & 3) + 8 * (r >> 2) + 4 * hi; }
__device__ __forceinline__ unsigned cvtpk(float lo, float hi) { unsigned r; asm volatile("v_cvt_pk_bf16_f32 %0, %1, %2" : "=v"(r) : "v"(lo), "v"(hi)); return r; }
__device__ __forceinline__ bf16x8 load8(const bf16* p) { return *reinterpret_cast<const bf16x8*>(p); }
__device__ __forceinline__ void bias_mask_tile(f32x16& p0, f32x16& p1, int dq, const float* bt) {
    const float NEG = -__builtin_inff();
#pragma unroll
    for (int r = 0; r < 16; ++r) {
        const int c = (r & 3) + 8 * (r >> 2);
        const int d0 = dq - c, d1 = dq - c - 32;
        const unsigned i0 = (unsigned)d0 < 255u ? (unsigned)d0 : 255u, i1 = (unsigned)d1 < 255u ? (unsigned)d1 : 255u;
        const float b0 = bt[i0], b1 = bt[i1];
        p0[r] = d0 >= 0 ? p0[r] + b0 : NEG;
        p1[r] = d1 >= 0 ? p1[r] + b1 : NEG;
    }
}
__device__ __forceinline__ void partialSM(f32x16& p0, f32x16& p1, float& m_reg, float& mn, float& alpha) {
    float pmax = p0[0]; for (int r = 1; r < 16; ++r) pmax = fmaxf(pmax, p0[r]); for (int r = 0; r < 16; ++r) pmax = fmaxf(pmax, p1[r]);
    { auto rr = __builtin_amdgcn_permlane32_swap(__float_as_uint(pmax), __float_as_uint(pmax), false, false);
      pmax = fmaxf(__uint_as_float(rr[0]), __uint_as_float(rr[1])); }
    constexpr float C2 = 1.4426950408889634f * SCALE;
    if (__builtin_expect(__all((pmax - m_reg) * SCALE <= THR), 1)) { mn = m_reg; alpha = 1.f; }
    else { mn = fmaxf(m_reg, pmax); alpha = __builtin_amdgcn_exp2f((m_reg - mn) * C2); m_reg = mn; }
    const float mnL = -mn * C2;
    for (int r = 0; r < 16; ++r) p0[r] = fmaf(p0[r], C2, mnL); for (int r = 0; r < 16; ++r) p1[r] = fmaf(p1[r], C2, mnL);
    for (int r = 0; r < 16; ++r) p0[r] = __builtin_amdgcn_exp2f(p0[r]);
}
__device__ __forceinline__ void finishSM(f32x16& p0, f32x16& p1, float alpha, float& l_reg, bf16x8& pa0, bf16x8& pa1, bf16x8& pa2, bf16x8& pa3) {
    for (int r = 0; r < 16; ++r) p1[r] = __builtin_amdgcn_exp2f(p1[r]);
    float ps = 0; for (int r = 0; r < 16; ++r) ps += p0[r]; for (int r = 0; r < 16; ++r) ps += p1[r];
    { auto rr = __builtin_amdgcn_permlane32_swap(__float_as_uint(ps), __float_as_uint(ps), false, false);
      ps = __uint_as_float(rr[0]) + __uint_as_float(rr[1]); }
    l_reg = l_reg * alpha + ps;
#define PK4(P, B_, OUT) do { unsigned a0 = cvtpk(P[B_+0], P[B_+1]), a1 = cvtpk(P[B_+2], P[B_+3]);                          \
        unsigned b0 = cvtpk(P[B_+4], P[B_+5]), b1 = cvtpk(P[B_+6], P[B_+7]);                                             \
        auto r0 = __builtin_amdgcn_permlane32_swap(a0, b0, false, false); auto r1 = __builtin_amdgcn_permlane32_swap(a1, b1, false, false); \
        u32x4 w = {r0[0], r1[0], r0[1], r1[1]}; OUT = *reinterpret_cast<bf16x8*>(&w); } while (0)
    PK4(p0, 0, pa0); PK4(p0, 8, pa1); PK4(p1, 0, pa2); PK4(p1, 8, pa3);
#undef PK4
}
template <int KB>
__device__ __forceinline__ void qkt(f32x16& p0, f32x16& p1, const char* K_lds, int r32, int hi, const bf16x8* qr) {
    p0 = f32x16{}; p1 = f32x16{};
    const char* kb[4];
#pragma unroll
    for (int dd = 0; dd < 4; ++dd) kb[dd] = K_lds + KB * SHM_K + KSWZ(r32, (dd * 16 + hi * 8) * 2);
#pragma unroll
    for (int d0 = 0; d0 < 8; ++d0) { const char* a = kb[d0 & 3] + (d0 >> 2) * 128;
        bf16x8 b0 = *reinterpret_cast<const bf16x8*>(a);
        bf16x8 b1 = *reinterpret_cast<const bf16x8*>(a + 32 * 256);
        p0 = __builtin_amdgcn_mfma_f32_32x32x16_bf16(b0, qr[d0], p0, 0, 0, 0);
        p1 = __builtin_amdgcn_mfma_f32_32x32x16_bf16(b1, qr[d0], p1, 0, 0, 0); }
}
template <int VB>
__device__ __forceinline__ void pv_tile(f32x16* o, int vb0, bf16x8 pa0, bf16x8 pa1, bf16x8 pa2, bf16x8 pa3) {
#define TRRD(dst, off) asm volatile("ds_read_b64_tr_b16 %0, %1 offset:%2" : "=&v"(dst) : "v"(vb0), "i"(off) : "memory")
#define PV_D0(d0) do { s16x4 l0, l1, l2, l3, h0, h1, h2, h3; constexpr int b_ = VB * SHM_V + v_rd_off(d0, 0, 0); \
        TRRD(l0, b_); TRRD(h0, b_ + 2048); TRRD(l1, b_ + 4096); TRRD(h1, b_ + 6144); TRRD(l2, b_ + 8192); TRRD(h2, b_ + 10240); TRRD(l3, b_ + 12288); TRRD(h3, b_ + 14336); \
        asm volatile("s_waitcnt lgkmcnt(0)" ::: "memory"); SBAR();   \
        o[d0] = __builtin_amdgcn_mfma_f32_32x32x16_bf16(pa0, (bf16x8){l0[0], l0[1], l0[2], l0[3], h0[0], h0[1], h0[2], h0[3]}, o[d0], 0, 0, 0);   \
        o[d0] = __builtin_amdgcn_mfma_f32_32x32x16_bf16(pa1, (bf16x8){l1[0], l1[1], l1[2], l1[3], h1[0], h1[1], h1[2], h1[3]}, o[d0], 0, 0, 0);   \
        o[d0] = __builtin_amdgcn_mfma_f32_32x32x16_bf16(pa2, (bf16x8){l2[0], l2[1], l2[2], l2[3], h2[0], h2[1], h2[2], h2[3]}, o[d0], 0, 0, 0);   \
        o[d0] = __builtin_amdgcn_mfma_f32_32x32x16_bf16(pa3, (bf16x8){l3[0], l3[1], l3[2], l3[3], h3[0], h3[1], h3[2], h3[3]}, o[d0], 0, 0, 0); } while (0)
    PV_D0(0); PV_D0(1); PV_D0(2); PV_D0(3);
#undef PV_D0
#undef TRRD
}
struct BlockRef { const bf16* Q; const bf16* K; const bf16* V; float* O; int P0; int hm; };
struct Seam { bf16x8 qr[8]; bf16x8 st_v0, st_v1, st_k0, st_k1; };
#define ROW(p, k0, rr) ((p) + (size_t)((k0) + (rr)) * D + sc)
#define VMW() asm volatile("s_waitcnt vmcnt(0)" ::: "memory")
#define VMWN(n) asm volatile("s_waitcnt vmcnt(%0)" :: "i"(n) : "memory")
#define SLOAD_H(Kp, Vp, k0) do { S.st_v0 = load8(ROW(Vp, k0, sr)); S.st_v1 = load8(ROW(Vp, k0, 32 + sr));              \
                         S.st_k0 = load8(ROW(Kp, k0, sr)); S.st_k1 = load8(ROW(Kp, k0, 32 + sr)); } while (0)
#define SWRITE_HK(bf) do { *(bf16x8*)(K_lds + (bf) * SHM_K + kws) = S.st_k0; *(bf16x8*)(K_lds + (bf) * SHM_K + kws + 32 * 256) = S.st_k1; } while (0)
#define SWRITE_HV(bf) do { *(bf16x8*)(V_lds + (bf) * SHM_V + vst0) = S.st_v0; *(bf16x8*)(V_lds + (bf) * SHM_V + vst1) = S.st_v1; } while (0)
#define SWRITE_H(bf) do { SWRITE_HV(bf); SWRITE_HK(bf); } while (0)
__device__ __forceinline__ void attn_prime(const BlockRef& cur, char* lds, Seam& S) {
    const int tid = ltid(), wid = __builtin_amdgcn_readfirstlane(tid >> 6), lane = tid & 63, r32 = lane & 31, hi = lane >> 5;
    const int sr = tid >> 4, sc = (tid & 15) * 8, kws = KSWZ(sr, sc * 2); char* K_lds = lds + 2 * SHM_V;
    const int kb0 = 0;
    for (int d0 = 0; d0 < 8; ++d0) S.qr[d0] = load8(cur.Q + (size_t)(wid * QBLK + r32) * D + d0 * 16 + hi * 8);
    SLOAD_H(cur.K, cur.V, kb0); VMW(); SWRITE_HK(0);
    __syncthreads();
}
__device__ __forceinline__ void attn_block(const BlockRef& cur, const BlockRef& nxt, char* lds, Seam& S) {
    const int tid = ltid(), wid = __builtin_amdgcn_readfirstlane(tid >> 6), lane = tid & 63, r32 = lane & 31, hi = lane >> 5;
    const int j_lo = 0;
    const int j_hi = (cur.P0 + QB - 1) / KVBLK + 1;
    const int NT = j_hi - j_lo;
    const int kbn = 0;
    const int qlo = cur.P0 + wid * QBLK, qm = qlo + r32 - 4 * hi;
    char* V_lds = lds; char* K_lds = lds + 2 * SHM_V;
    float* ws = (float*)(lds + 2 * SHM_V + 2 * SHM_K) + wid * 64; float* li_l = ws, * al_l = ws + 32;
    const float* bt = (const float*)(lds + BT_OFF) + cur.hm * 256;
    float m_reg = -1e30f, l_reg = 0; f32x16 o[4] = {};
    const int sr = tid >> 4, sc = (tid & 15) * 8, vst0 = v_st(sr, sc), vst1 = v_st(32 + sr, sc), kws = KSWZ(sr, sc * 2);
    const int vb0 = (int)(uintptr_t)V_lds + v_rd_base(lane);
    const bf16* Kh = cur.K; const bf16* Vh = cur.V;
#define RESC(a) do { if (__any((a) < 1.f)) { if (hi == 0) al_l[r32] = (a); asm volatile("s_waitcnt lgkmcnt(0)" ::: "memory");              \
                     for (int d_ = 0; d_ < 4; ++d_) for (int r = 0; r < 16; ++r) o[d_][r] *= al_l[crow(r, hi)]; } } while (0)
#define KBASE(t) ((j_lo + (t)) * KVBLK)
#define MASKT(P0_, P1_, t) do { const int kb_ = KBASE(t); if (kb_ + KVBLK - 1 > qlo - 128) bias_mask_tile(P0_, P1_, qm - kb_, bt); } while (0)
    constexpr int NQL = 8;
#define SEAM_K0() do { VMWN(NQL); SWRITE_HK(0); SBAR(); } while (0)
    f32x16 pA0, pA1, pB0, pB1; float mnA, mnB, alA, alB; bf16x8 pa0, pa1, pa2, pa3;
    SWRITE_HV(0); SBAR();
    if (NT > 1) { SLOAD_H(Kh, Vh, KBASE(1)); }
    SBAR(); qkt<0>(pA0, pA1, K_lds, r32, hi, S.qr);
    MASKT(pA0, pA1, 0); partialSM(pA0, pA1, m_reg, mnA, alA);
    if (NT > 1) { VMW(); SWRITE_H(1); }
    __syncthreads();
#define HALF_STEP(PX0, PX1, mnX, alX, PY0, PY1, alY, t, KB, VB, SB) do {                                                      \
        SBAR(); qkt<KB>(PX0, PX1, K_lds, r32, hi, S.qr);                                             \
        finishSM(PY0, PY1, alY, l_reg, pa0, pa1, pa2, pa3); SBAR();                                                           \
        if ((t) + 1 < NT) { SLOAD_H(Kh, Vh, KBASE((t) + 1)); SBAR(); }                                               \
        pv_tile<VB>(o, vb0, pa0, pa1, pa2, pa3); MASKT(PX0, PX1, (t)); partialSM(PX0, PX1, m_reg, mnX, alX);                                        \
        __syncthreads();                                                                                                      \
        if ((t) + 1 < NT) { VMW(); SWRITE_H(SB); }                                                                          \
        RESC(alX); __syncthreads(); } while (0)
    for (int t = 1; t + 1 < NT; t += 2) {
        HALF_STEP(pB0, pB1, mnB, alB, pA0, pA1, alA, t, 1, 0, 0);
        HALF_STEP(pA0, pA1, mnA, alA, pB0, pB1, alB, t + 1, 0, 1, 1);
    }
    const bool even = (NT & 1) == 0;
    if (even) { SBAR(); qkt<1>(pB0, pB1, K_lds, r32, hi, S.qr); SBAR(); }
    SLOAD_H(nxt.K, nxt.V, kbn); SBAR();
#pragma unroll
    for (int d0 = 0; d0 < 8; ++d0) S.qr[d0] = load8(nxt.Q + (size_t)(wid * QBLK + r32) * D + d0 * 16 + hi * 8);
    SBAR();
    finishSM(pA0, pA1, alA, l_reg, pa0, pa1, pa2, pa3); SBAR();
    pv_tile<0>(o, vb0, pa0, pa1, pa2, pa3);
    if (even) { MASKT(pB0, pB1, NT - 1); partialSM(pB0, pB1, m_reg, mnB, alB); __syncthreads(); RESC(alB);
        finishSM(pB0, pB1, alB, l_reg, pa0, pa1, pa2, pa3); SBAR(); pv_tile<1>(o, vb0, pa0, pa1, pa2, pa3); }
    SBAR(); SEAM_K0();
    if (hi == 0) li_l[r32] = l_reg; asm volatile("s_waitcnt lgkmcnt(0)" ::: "memory");
    float rli[16];
#pragma unroll
    for (int r = 0; r < 16; ++r) rli[r] = __builtin_amdgcn_rcpf(li_l[crow(r, hi)]);
    float* Ow = cur.O + (size_t)(wid * QBLK) * D;
#pragma unroll
    for (int r = 0; r < 16; ++r) { const int orow = crow(r, hi);
#pragma unroll
        for (int d0 = 0; d0 < 4; ++d0) { const float v = o[d0][r] * rli[r]; Ow[(size_t)orow * D + d0 * 32 + r32] = v; } }
    __syncthreads();
#undef RESC
#undef KBASE
#undef MASKT
#undef SEAM_K0
#undef HALF_STEP
}
#undef ROW
#undef VMW
#undef VMWN
#undef SLOAD_H
#undef SWRITE_HK
#undef SWRITE_HV
#undef SWRITE_H
}

namespace att2 {
using att::bf16; using att::D; using att::SHM_K; using att::SHM_V;
constexpr int L_V = 0, L_K = 65536, L_P = 98304, L_AL = 131072, L_FL = 132096, L_LB = 132224, L_BT = 133120;
struct Blk { const bf16* Q; const bf16* K; const bf16* V0; const bf16* V1; float* O0; float* O1; int P0; int hm; };
__device__ __forceinline__ void qkt_rt(f32x16& p0, f32x16& p1, const char* Kb, int r32, int hi, const bf16x8* qr) {
    p0 = f32x16{}; p1 = f32x16{};
    const char* kb[4];
#pragma unroll
    for (int dd = 0; dd < 4; ++dd) kb[dd] = Kb + KSWZ(r32, (dd * 16 + hi * 8) * 2);
#pragma unroll
    for (int d0 = 0; d0 < 8; ++d0) { const char* a = kb[d0 & 3] + (d0 >> 2) * 128;
        bf16x8 b0 = *reinterpret_cast<const bf16x8*>(a);
        bf16x8 b1 = *reinterpret_cast<const bf16x8*>(a + 32 * 256);
        p0 = __builtin_amdgcn_mfma_f32_32x32x16_bf16(b0, qr[d0], p0, 0, 0, 0);
        p1 = __builtin_amdgcn_mfma_f32_32x32x16_bf16(b1, qr[d0], p1, 0, 0, 0); }
}
#define A2_LOADT(t) do { const size_t ro_ = (size_t)((t) * 64 + sr) * D + sc; \
        sk0 = att::load8(c.K + ro_); sk1 = att::load8(c.K + ro_ + 32 * D); sv00 = att::load8(c.V0 + ro_); sv01 = att::load8(c.V0 + ro_ + 32 * D); sv10 = att::load8(c.V1 + ro_); sv11 = att::load8(c.V1 + ro_ + 32 * D); } while (0)
#define A2_WRITET(buf) do { char* kd_ = lds + L_K + (buf) * SHM_K; char* vd_ = lds + L_V + (buf) * 2 * SHM_V; \
        *(bf16x8*)(kd_ + kws) = sk0; *(bf16x8*)(kd_ + kws + 32 * 256) = sk1; *(bf16x8*)(vd_ + vst0) = sv00; *(bf16x8*)(vd_ + vst1) = sv01; *(bf16x8*)(vd_ + SHM_V + vst0) = sv10; *(bf16x8*)(vd_ + SHM_V + vst1) = sv11; } while (0)
__device__ __forceinline__ void attn2_block(const Blk& c, char* lds) {
    const int tid = ltid(), wid = __builtin_amdgcn_readfirstlane(tid >> 6), lane = tid & 63, r32 = lane & 31, hi = lane >> 5;
    const int g = wid & 3;
    const int NT = (c.P0 + 127) / 64 + 1;
    const int sr = tid >> 4, sc = (tid & 15) * 8, kws = KSWZ(sr, sc * 2), vst0 = att::v_st(sr, sc), vst1 = att::v_st(32 + sr, sc);
    bf16x8 sk0, sk1, sv00, sv01, sv10, sv11;
    float* ALb = (float*)(lds + L_AL) + g * 64; unsigned* FLb = (unsigned*)(lds + L_FL) + g * 2; float* LBb = (float*)(lds + L_LB) + g * 32;
    char* Pb = lds + L_P + g * 8192;
    A2_LOADT(0);
    if (wid < 4) {
        bf16x8 qr[8];
#pragma unroll
        for (int d0 = 0; d0 < 8; ++d0) qr[d0] = att::load8(c.Q + (size_t)(g * 32 + r32) * D + d0 * 16 + hi * 8);
        asm volatile("s_waitcnt vmcnt(0)" ::: "memory"); A2_WRITET(0); __syncthreads();
        const int qlo = c.P0 + g * 32, qm = qlo + r32 - 4 * hi;
        const float* bt = (const float*)(lds + L_BT) + c.hm * 256;
        float m_reg = -1e30f, l_reg = 0.f;
        for (int s = 0; s <= NT; ++s) {
            const int par = s & 1;
            if (s + 1 < NT) A2_LOADT(s + 1);
            SBAR();
            if (s < NT) {
                f32x16 p0, p1; float mn, al; bf16x8 pa0, pa1, pa2, pa3;
                qkt_rt(p0, p1, lds + L_K + par * SHM_K, r32, hi, qr);
                const int kb_ = s * 64;
                if (kb_ + 63 > qlo - 128) att::bias_mask_tile(p0, p1, qm - kb_, bt);
                att::partialSM(p0, p1, m_reg, mn, al);
                att::finishSM(p0, p1, al, l_reg, pa0, pa1, pa2, pa3);
                char* pw = Pb + par * 4096 + lane * 16;
                *(bf16x8*)(pw) = pa0; *(bf16x8*)(pw + 1024) = pa1; *(bf16x8*)(pw + 2048) = pa2; *(bf16x8*)(pw + 3072) = pa3;
                if (hi == 0) ALb[par * 32 + r32] = al;
                const bool resc = __any(al < 1.f);
                if (lane == 0) FLb[par] = resc ? 1u : 0u;
            }
            __syncthreads();
            if (s + 1 < NT) { asm volatile("s_waitcnt vmcnt(0)" ::: "memory"); A2_WRITET((s + 1) & 1); }
            __syncthreads();
        }
        if (hi == 0) LBb[r32] = l_reg;
        __syncthreads();
        __syncthreads();
    } else {
        asm volatile("s_waitcnt vmcnt(0)" ::: "memory"); A2_WRITET(0); __syncthreads();
        f32x16 o[8];
#pragma unroll
        for (int d_ = 0; d_ < 8; ++d_) o[d_] = f32x16{};
        const int vbase = (int)(uintptr_t)(lds + L_V) + att::v_rd_base(lane);
        for (int s = 0; s <= NT; ++s) {
            if (s + 1 < NT) A2_LOADT(s + 1);
            SBAR();
            if (s >= 1) {
                const int par = (s - 1) & 1;
                const unsigned fl = (unsigned)__builtin_amdgcn_readfirstlane((int)FLb[par]);
                if (fl) {
#pragma unroll
                    for (int r = 0; r < 16; ++r) { const float a = ALb[par * 32 + att::crow(r, hi)];
#pragma unroll
                        for (int d_ = 0; d_ < 8; ++d_) o[d_][r] *= a; } }
                const char* pr = Pb + par * 4096 + lane * 16;
                const bf16x8 pa0 = *(const bf16x8*)(pr), pa1 = *(const bf16x8*)(pr + 1024), pa2 = *(const bf16x8*)(pr + 2048), pa3 = *(const bf16x8*)(pr + 3072);
                const int vb = vbase + par * 2 * SHM_V;
                att::pv_tile<0>(o, vb, pa0, pa1, pa2, pa3);
                att::pv_tile<0>(o + 4, vb + SHM_V, pa0, pa1, pa2, pa3);
            }
            __syncthreads();
            if (s + 1 < NT) { asm volatile("s_waitcnt vmcnt(0)" ::: "memory"); A2_WRITET((s + 1) & 1); }
            __syncthreads();
        }
        __syncthreads();
        float rli[16];
#pragma unroll
        for (int r = 0; r < 16; ++r) rli[r] = __builtin_amdgcn_rcpf(LBb[att::crow(r, hi)]);
#pragma unroll
        for (int hf = 0; hf < 2; ++hf) { float* Ow = (hf ? c.O1 : c.O0) + (size_t)(g * 32) * D;
#pragma unroll
            for (int r = 0; r < 16; ++r) { const int orow = att::crow(r, hi);
#pragma unroll
                for (int d0 = 0; d0 < 4; ++d0) Ow[(size_t)orow * D + d0 * 32 + r32] = o[hf * 4 + d0][r] * rli[r]; } }
        __syncthreads();
    }
}
#undef A2_LOADT
#undef A2_WRITET
}


#define XB_TMO      128
#define XB_XCNT(j)  (256  + 64 * (j))
#define XB_XSUB(j)  (1280 + 64 * (j))
#define XB_XGEN(j)  (2304 + 64 * (j))
#define XB_TOP      3328
#define XB_TOPGEN   3392
#define XCD_BAR_WORDS 3456
#define XB_SPIN_CAP (1u << 18)
__device__ __forceinline__ unsigned xb_ld(unsigned* p)              { return __hip_atomic_load(p, __ATOMIC_RELAXED, __HIP_MEMORY_SCOPE_AGENT); }
__device__ __forceinline__ unsigned xb_add(unsigned* p, unsigned v) { return __hip_atomic_fetch_add(p, v, __ATOMIC_RELAXED, __HIP_MEMORY_SCOPE_AGENT); }
__device__ __forceinline__ unsigned xb_xcc_id() { return (unsigned)__builtin_amdgcn_s_getreg((3 << 11) | 20) & 0xFu; }
#define XB_SPIN(cond, bar) do { unsigned _sp = 0; while (cond) { __builtin_amdgcn_s_sleep(1); \
    if ((++_sp & 255u) == 0u) { if (xb_ld(&(bar)[XB_TMO])) break; if (_sp > XB_SPIN_CAP) { atomicAdd(&(bar)[XB_TMO], 1u); break; } } } } while (0)
struct XcdBarrier { unsigned* bar; unsigned x; volatile LAS unsigned* st; };
__device__ __forceinline__ XcdBarrier xcd_barrier_post(unsigned* bar, volatile LAS unsigned* st) {
    XcdBarrier b; b.bar = bar; b.x = xb_xcc_id(); b.st = st;
    if (threadIdx.x == 0) (void)xb_add(&bar[XB_XCNT(b.x)], 1u);
    return b;
}
__device__ __forceinline__ void xcd_barrier_complete(unsigned* bar, unsigned x, unsigned& nloc, unsigned& nx) {
    const unsigned G = gridDim.x * gridDim.y * gridDim.z;
    unsigned sum, cnt, mine, sp = 0u;
    for (;;) {
        sum = 0u; cnt = 0u; mine = 0u;
#pragma unroll
        for (unsigned j = 0; j < 16; ++j) { const unsigned c = xb_ld(&bar[XB_XCNT(j)]); sum += c; cnt += (c > 0u) ? 1u : 0u; mine = (j == x) ? c : mine; }
        if (sum == G) break;
        __builtin_amdgcn_s_sleep(1);
        if ((++sp & 255u) == 0u) { if (xb_ld(&bar[XB_TMO])) break; if (sp > XB_SPIN_CAP) { atomicAdd(&bar[XB_TMO], 1u); break; } }
    }
    nloc = mine > 0u ? mine : 1u; nx = cnt > 0u ? cnt : 1u;
}
__device__ __forceinline__ void xcd_barrier(const XcdBarrier& b) {
    asm volatile("s_waitcnt vmcnt(0)" ::: "memory");
    __syncthreads();
    if (threadIdx.x == 0) {
        unsigned* bar = b.bar;
        __builtin_amdgcn_s_waitcnt(0);
        unsigned nloc = b.st[0], nx = b.st[1];
        if (nloc == 0u) { xcd_barrier_complete(bar, b.x, nloc, nx); b.st[0] = nloc; b.st[1] = nx; }
        const unsigned old = xb_add(&bar[XB_XSUB(b.x)], 1u);
        const unsigned gen = old / nloc;
        if (old + 1u == (gen + 1u) * nloc) {
            __builtin_amdgcn_fence(__ATOMIC_RELEASE, "agent");
            asm volatile("s_waitcnt vmcnt(0)" ::: "memory");
            const unsigned og = xb_add(&bar[XB_TOP], 1u);
            const unsigned tg = og / nx;
            if (og + 1u == (tg + 1u) * nx) xb_add(&bar[XB_TOPGEN], 1u);
            else XB_SPIN(xb_ld(&bar[XB_TOPGEN]) == tg, bar);
            __builtin_amdgcn_fence(__ATOMIC_ACQUIRE, "agent");
            xb_add(&bar[XB_XGEN(b.x)], 1u);
            asm volatile("s_waitcnt vmcnt(0)" ::: "memory");
        } else {
            XB_SPIN(xb_ld(&bar[XB_XGEN(b.x)]) == gen, bar);
            __builtin_amdgcn_fence(__ATOMIC_ACQUIRE, "agent");
            asm volatile("s_waitcnt vmcnt(0)" ::: "memory");
        }
    }
    __syncthreads();
}

struct Args { const float* in[24]; float* out; unsigned char* ws; };

__device__ __forceinline__ void p0_transpose_item(const float* W, int K, int N, bf16_t* WT, int swiglu, const float* gk, const float* bk, float* c1, float* c2, LAS float* scr, int item, int lane) {
    const int nblk = N / 64, kb = item / nblk, nb = item % nblk, k0 = 64 * kb, n0 = 64 * nb;
    const float* src = W + (size_t)(k0 + (lane >> 4)) * N + n0 + (lane & 15) * 4;
    f32x4 v[16];
#pragma unroll
    for (int i = 0; i < 16; ++i) v[i] = __builtin_nontemporal_load((const f32x4*)(src + (size_t)(4 * i) * N));
#pragma unroll
    for (int i = 0; i < 16; ++i) { LAS float* d = scr + (4 * i + (lane >> 4)) * 65 + (lane & 15) * 4; d[0] = v[i][0]; d[1] = v[i][1]; d[2] = v[i][2]; d[3] = v[i][3]; }
    asm volatile("s_waitcnt lgkmcnt(0)" ::: "memory");
    int r0 = n0;
    if (swiglu) { const int half = n0 / DFF, idx = n0 % DFF; r0 = 256 * (idx / 128) + 128 * half + (idx % 128); }
    const int c = lane & 7;
    float g8[8], b8[8];
#pragma unroll
    for (int e = 0; e < 8; ++e) { g8[e] = gk ? gk[k0 + 8 * c + e] : 1.f; b8[e] = gk ? bk[k0 + 8 * c + e] : 0.f; }
#pragma unroll
    for (int j = 0; j < 8; ++j) { const int n = (lane >> 3) + 8 * j; const LAS float* q = scr + (8 * c) * 65 + n;
        float w8[8];
#pragma unroll
        for (int e = 0; e < 8; ++e) w8[e] = q[e * 65];
        u32x4 o; o.x = cvt_pk_bf16(w8[0] * g8[0], w8[1] * g8[1]); o.y = cvt_pk_bf16(w8[2] * g8[2], w8[3] * g8[3]); o.z = cvt_pk_bf16(w8[4] * g8[4], w8[5] * g8[5]); o.w = cvt_pk_bf16(w8[6] * g8[6], w8[7] * g8[7]);
        *(u32x4*)(WT + (size_t)(r0 + n) * K + k0 + 8 * c) = o;
        if (gk) {
            float s1 = ((bf_lo(o.x) + bf_hi(o.x)) + (bf_lo(o.y) + bf_hi(o.y))) + ((bf_lo(o.z) + bf_hi(o.z)) + (bf_lo(o.w) + bf_hi(o.w)));
            float s2 = ((w8[0] * b8[0] + w8[1] * b8[1]) + (w8[2] * b8[2] + w8[3] * b8[3])) + ((w8[4] * b8[4] + w8[5] * b8[5]) + (w8[6] * b8[6] + w8[7] * b8[7]));
            s1 += __shfl_xor(s1, 1); s1 += __shfl_xor(s1, 2); s1 += __shfl_xor(s1, 4); s2 += __shfl_xor(s2, 1); s2 += __shfl_xor(s2, 2); s2 += __shfl_xor(s2, 4);
            if (c == 0) { unsafeAtomicAdd(c1 + r0 + n, s1); unsafeAtomicAdd(c2 + r0 + n, s2); }
        } }
    asm volatile("s_waitcnt lgkmcnt(0)" ::: "memory");
}

__device__ __forceinline__ void p0_wq_item(const float* W, bf16_t* WN, const float* gk, const float* bk, float* bW, int item, int lane) {
    const int kb = item >> 5, jb = item & 31, k0 = 64 * kb, j0 = 64 * jb, cg8 = lane & 7, kr = lane >> 3;
    float sacc[8];
#pragma unroll
    for (int e = 0; e < 8; ++e) sacc[e] = 0.f;
#pragma unroll
    for (int i = 0; i < 8; ++i) { const int k = k0 + 8 * i + kr; const float* src = W + (size_t)k * DM + j0 + 8 * cg8;
        const f32x4 v0 = __builtin_nontemporal_load((const f32x4*)src), v1 = __builtin_nontemporal_load((const f32x4*)(src + 4)); const float g = gk[k], bb = bk[k];
        u32x4 o; o.x = cvt_pk_bf16(v0[0] * g, v0[1] * g); o.y = cvt_pk_bf16(v0[2] * g, v0[3] * g); o.z = cvt_pk_bf16(v1[0] * g, v1[1] * g); o.w = cvt_pk_bf16(v1[2] * g, v1[3] * g);
        *(u32x4*)(WN + (size_t)k * DM + j0 + 8 * cg8) = o;
#pragma unroll
        for (int e = 0; e < 4; ++e) { sacc[e] += bb * v0[e]; sacc[4 + e] += bb * v1[e]; } }
#pragma unroll
    for (int e = 0; e < 8; ++e) { float v = sacc[e]; v += __shfl_xor(v, 8); v += __shfl_xor(v, 16); v += __shfl_xor(v, 32); if (kr == 0) unsafeAtomicAdd(bW + j0 + 8 * cg8 + e, v); }
}

__device__ __forceinline__ int causal_bucket(int n) {
    if (n < 16) return n;
    const float nf = (float)n;
    int large = 16 + (int)(logf(nf / 16.f) / 2.0794415416798357f * 16.f);
    return large < 31 ? large : 31;
}

__device__ __forceinline__ size_t zero_opaque() { size_t z = 0; asm volatile("" : "+s"(z)); return z; }
__device__ __forceinline__ const float* inp_ptr(const Args& a, int k) { return a.in[k] + zero_opaque(); }
#define INP(k) inp_ptr(a, k)
__device__ __forceinline__ unsigned char* ws_opaque(const Args& a) { return a.ws + zero_opaque(); }
__device__ __forceinline__ float* out_opaque(const Args& a) { return a.out + zero_opaque(); }
#define WSP(type, off) ((type*)(ws_opaque(a) + (off)))
__global__ void __launch_bounds__(NTHR, 2) mega_fwd(Args a) {
    extern __shared__ __attribute__((aligned(16))) unsigned char lds[];
    volatile LAS unsigned* bst = (volatile LAS unsigned*)((LAS unsigned char*)lds + LDS_BYTES - 64);
    if (threadIdx.x == 0) { bst[0] = 0u; bst[1] = 0u; }
    __syncthreads();
    (void)xcd_barrier_post((unsigned*)(a.ws + WS_BAR), bst);
#define GRID_BAR() do { XcdBarrier xb_; xb_.bar = (unsigned*)(ws_opaque(a) + WS_BAR); unsigned x_ = xb_xcc_id(); asm volatile("" : "+s"(x_)); xb_.x = x_; xb_.st = bst; xcd_barrier(xb_); } while (0)
    const int G = gridDim.x;
    const int NGW = G * NWAVES, NGT = G * NTHR;
    {
        PH_IDS;
        unsigned char* ws = ws_opaque(a);
        float* lamp = (float*)(ws + WS_LAM); float* btab = (float*)(ws + WS_BTAB); bf16_t* wtril = (bf16_t*)(ws + WS_WTRIL); bf16_t* membf = (bf16_t*)(ws + WS_MEMBF); bf16_t* XN = (bf16_t*)(ws + WS_XN);
        LAS float* scr = (LAS float*)((LAS unsigned char*)lds + wave * 17408);
        constexpr int I_IN = 32 * 88, I_SQ = 32 * 32, I_KV = 32 * 64, I_GU = 32 * 176, I_D = 88 * 32;
        constexpr int PER_LAYER = I_IN + 3 * I_SQ + I_KV + I_GU + I_D;
        for (int it = gw; it < 2 * PER_LAYER; it += NGW) {
            const int l = it / PER_LAYER; int r = it % PER_LAYER;
            unsigned char* wl = ws + WS_W + (size_t)l * W_LAYER;
            float* cl = (float*)(ws + WS_C) + (size_t)l * C_LAYER;
            if (r < I_IN) { const bool f = l > 0;
                p0_transpose_item(INP(3) + (size_t)l * DM * INC, DM, INC, (bf16_t*)(wl + W_IN), 0, f ? INP(22) : nullptr, f ? INP(23) : nullptr, cl + C_IN, cl + C_IN + INC, scr, r, lane); continue; } r -= I_IN;
            if (r < I_SQ) { p0_transpose_item(INP(12) + (size_t)l * DM * DM, DM, DM, (bf16_t*)(wl + W_OUT), 0, nullptr, nullptr, nullptr, nullptr, scr, r, lane); continue; } r -= I_SQ;
            if (r < I_SQ) { p0_wq_item(INP(15) + (size_t)l * DM * DM, (bf16_t*)(wl + W_Q), INP(13) + (size_t)l * DM, INP(14) + (size_t)l * DM, cl + C_Q + DM, r, lane); continue; } r -= I_SQ;
            if (r < I_KV) { p0_transpose_item(INP(16) + (size_t)l * DM * 2 * DM, DM, 2 * DM, (bf16_t*)(wl + W_KV), 0, nullptr, nullptr, nullptr, nullptr, scr, r, lane); continue; } r -= I_KV;
            if (r < I_SQ) { p0_transpose_item(INP(17) + (size_t)l * DM * DM, DM, DM, (bf16_t*)(wl + W_O), 0, nullptr, nullptr, nullptr, nullptr, scr, r, lane); continue; } r -= I_SQ;
            if (r < I_GU) { p0_transpose_item(INP(20) + (size_t)l * DM * 2 * DFF, DM, 2 * DFF, (bf16_t*)(wl + W_GU), 1, INP(18) + (size_t)l * DM, INP(19) + (size_t)l * DM, cl + C_GU, cl + C_GU + 2 * DFF, scr, r, lane); continue; } r -= I_GU;
            p0_transpose_item(INP(21) + (size_t)l * DFF * DM, DFF, DM, (bf16_t*)(wl + W_D), 0, nullptr, nullptr, nullptr, nullptr, scr, r, lane);
        }
        for (size_t i = gt; i < (size_t)T * DM / 8; i += (size_t)4 * NGT) {
            f32x4 v0[4], v1[4];
#pragma unroll
            for (int q = 0; q < 4; ++q) { const float* xp = INP(0) + (i + (size_t)q * NGT) * 8; v0[q] = __builtin_nontemporal_load((const f32x4*)xp); v1[q] = __builtin_nontemporal_load((const f32x4*)(xp + 4)); }
#pragma unroll
            for (int q = 0; q < 4; ++q) { u32x4 w; w.x = cvt_pk_bf16(v0[q][0], v0[q][1]); w.y = cvt_pk_bf16(v0[q][2], v0[q][3]); w.z = cvt_pk_bf16(v1[q][0], v1[q][1]); w.w = cvt_pk_bf16(v1[q][2], v1[q][3]);
                *(u32x4*)(XN + (i + (size_t)q * NGT) * 8) = w; }
        }
        for (size_t i = gt; i < (size_t)BATCH * NMEM * DM / 8; i += NGT) {
            const f32x4 v0 = *(const f32x4*)(INP(1) + i * 8), v1 = *(const f32x4*)(INP(1) + i * 8 + 4);
            u32x4 w; w.x = cvt_pk_bf16(v0[0], v0[1]); w.y = cvt_pk_bf16(v0[2], v0[3]); w.z = cvt_pk_bf16(v1[0], v1[1]); w.w = cvt_pk_bf16(v1[2], v1[3]);
            *(u32x4*)(membf + i * 8) = w;
        }
        for (int i = gt; i < DEPTH * 4 * 128 * 128; i += NGT) { const int s = i & 127, t = (i >> 7) & 127; wtril[i] = s <= t ? f2bf(INP(7)[i]) : (bf16_t)0; }
        if (gt < 8 * 256) { const int hm = gt >> 8, d = gt & 255; const float* rb = INP(2);
            btab[gt] = (rb[causal_bucket(d) * 8 + hm] - rb[31 * 8 + hm]) * (1.f / att::SCALE); }
        if (cu == 0 && wave == 0) {
            for (int l = 0; l < DEPTH; ++l) {
                const float* lq = INP(9) + l * 256; const float* lk = INP(10) + l * 256;
                float s0 = lq[lane] * lk[lane] + lq[lane + 64] * lk[lane + 64];
                float s1 = lq[128 + lane] * lk[128 + lane] + lq[192 + lane] * lk[192 + lane];
                s0 = wave_sum(s0); s1 = wave_sum(s1);
                const float lam_init = 0.8f - 0.6f * expf(-0.3f * (float)l);
                if (lane == 0) lamp[l] = expf(s0) - expf(s1) + lam_init;
            }
        }
    }
    GRID_BAR();

#pragma unroll 1
    for (int l = 0; l < DEPTH; ++l) {
        {
            unsigned char* ws = ws_opaque(a);
            pg8::Gemm g{(const bf16_t*)(ws + WS_XN), (const bf16_t*)(ws + WS_W + (size_t)l * W_LAYER + W_IN), DM, DM, DM, 1, 0, 0, 0, 0};
            pg8::Order S; S.init(T, INC, 1, G, cu_opaque());
            const float* cl = (const float*)(ws + WS_C) + (size_t)l * C_LAYER;
            const float* st = l > 0 ? (const float*)(ws + WS_ST) + (size_t)(3 * l - 1) * T * 2 : nullptr;
            pg8::EpiSplit E{(bf16_t*)(ws + WS_PROJ), st, cl + C_IN, cl + C_IN + INC, (float*)(ws + WS_ST) + (size_t)(6 + l) * T * 2};
            pg8::gemm_phase<pg8::EpiSplit, true>((LAS unsigned char*)lds, g, S, E);
        }
        if (l == 0) {
            {
                unsigned char* ws = ws_opaque(a);
                pg8::Gemm g{(const bf16_t*)(ws + WS_MEMBF), (const bf16_t*)(ws + WS_W + W_KV), DM, DM, DM, 1, 0, 0, (long)(W_LAYER / 2), 0};
                pg8::Order S; const int cu = cu_opaque(); S.init(BATCH * NMEM, 2 * DM, 2, G, cu >= 128 && cu < 192 ? cu - 128 : -1);
                pg8::EpiBf16 E{(bf16_t*)(ws + WS_KV), 2 * DM, 1, (long)(BATCH * NMEM) * 2 * DM, 0, 1.f, nullptr, nullptr, nullptr, nullptr};
                pg8::gemm_phase<pg8::EpiBf16, true>((LAS unsigned char*)lds, g, S, E);
            }
        }
        GRID_BAR();

        if (l == 0) {
#pragma unroll 1
            for (int L2 = 0; L2 < DEPTH; ++L2) {
                {
                    unsigned char* ws = ws_opaque(a); unsigned char* wl2 = ws + WS_W + (size_t)L2 * W_LAYER;
                    const bf16_t* KVl = (const bf16_t*)(ws + WS_KV) + (size_t)L2 * BATCH * NMEM * 2 * DM;
                    float* cl = (float*)(ws + WS_C) + (size_t)L2 * C_LAYER;
                    pg8::Gemm g{KVl, (const bf16_t*)(wl2 + W_Q), 2 * DM, DM, 512, 4, (long)NMEM * 2 * DM, 512, 0, 512};
                    pg8::Order S; const int cu = cu_opaque(); S.init(NMEM, DM, 8, G, cu >= 64 * L2 && cu < 64 * L2 + 64 ? cu - 64 * L2 : -1);
                    pg8::EpiBf16 E{(bf16_t*)(wl2 + W_KV), DM, 1, (long)NMEM * DM, 0, 1.f, nullptr, nullptr, nullptr, cl + C_Q};
                    pg8::gemm_phase<pg8::EpiBf16, true>((LAS unsigned char*)lds, g, S, E);
                }
                {
                    unsigned char* ws = ws_opaque(a); unsigned char* wl2 = ws + WS_W + (size_t)L2 * W_LAYER;
                    const bf16_t* KVl = (const bf16_t*)(ws + WS_KV) + (size_t)L2 * BATCH * NMEM * 2 * DM;
                    pg8::Gemm g{(const bf16_t*)(wl2 + W_O), KVl + DM, DM, 2 * DM, 512, 4, 0, 512, (long)NMEM * 2 * DM, 512};
                    pg8::Order S; const int cu = cu_opaque(); S.init(DM, NMEM, 8, G, cu >= 128 + 64 * L2 && cu < 192 + 64 * L2 ? cu - 128 - 64 * L2 : -1);
                    pg8::EpiBf16 E{(bf16_t*)(wl2 + W_KV + 8 * MiB), 1024, 4, (long)DM * 1024, 256, 1.f, nullptr, nullptr, nullptr, nullptr};
                    pg8::gemm_phase<pg8::EpiBf16, true>((LAS unsigned char*)lds, g, S, E);
                }
            }
            {
                PH_IDS;
                unsigned char* ws = ws_opaque(a);
                for (int it = gw; it < DEPTH * 2048; it += NGW) {
                    const int L2 = it >> 11, r = it & 2047, b = r >> 10, h = (r >> 8) & 3, n = r & 255;
                    const bf16_t* kp = (const bf16_t*)(ws + WS_KV) + ((size_t)L2 * BATCH * NMEM + b * NMEM + n) * 2 * DM + h * 512 + 8 * lane;
                    float* cl = (float*)(ws + WS_C) + (size_t)L2 * C_LAYER;
                    const float* bw = cl + C_Q + DM + h * 512 + 8 * lane;
                    const u32x4 kw = *(const u32x4*)kp; const f32x4 b0 = *(const f32x4*)bw, b1 = *(const f32x4*)(bw + 4);
                    float d = (bf_lo(kw.x) * b0[0] + bf_hi(kw.x) * b0[1]) + (bf_lo(kw.y) * b0[2] + bf_hi(kw.y) * b0[3]) + (bf_lo(kw.z) * b1[0] + bf_hi(kw.z) * b1[1]) + (bf_lo(kw.w) * b1[2] + bf_hi(kw.w) * b1[3]);
                    d = wave_sum(d);
                    if (lane == 0) cl[C_QK2 + r] = d;
                }
            }
            __syncthreads();
        }
        {
            PH_IDS;
            bf16_t* PB = WSP(bf16_t, WS_PROJ); bf16_t* Y = WSP(bf16_t, WS_Y);
            const float* cw = INP(4) + (size_t)l * 3 * 512;
            const int cg8 = tid & 63, c0 = cg8 * 8, gi = cg8 >> 4, cc = c0 & 127;
            float k0[8], k1[8], k2[8];
#pragma unroll
            for (int e = 0; e < 8; ++e) { k0[e] = cw[c0 + e]; k1[e] = cw[512 + c0 + e]; k2[e] = cw[1024 + c0 + e]; }
            for (int r4 = gt >> 6; r4 < T / 4; r4 += NGT >> 6) {
                const int r = 4 * r4, t = r & (SEQ - 1);
                const bf16_t* pb = PB + ((size_t)(0 + gi) * T + r) * 128 + cc;
                const bf16_t* pc = PB + ((size_t)(4 + gi) * T + r) * 128 + cc;
                const bf16_t* ph = PB + ((size_t)(8 + gi) * T + r) * 128 + cc;
                u32x4 wc[6], wh[6], wb[4];
#pragma unroll
                for (int i = 0; i < 6; ++i) { wc[i] = (u32x4){0, 0, 0, 0}; wh[i] = (u32x4){0, 0, 0, 0}; }
                if (t >= 2) { wc[0] = *(const u32x4*)(pc - 256); wh[0] = *(const u32x4*)(ph - 256); wc[1] = *(const u32x4*)(pc - 128); wh[1] = *(const u32x4*)(ph - 128); }
#pragma unroll
                for (int i = 0; i < 4; ++i) { wc[2 + i] = *(const u32x4*)(pc + i * 128); wh[2 + i] = *(const u32x4*)(ph + i * 128); wb[i] = *(const u32x4*)(pb + i * 128); }
                float z[6][8];
#pragma unroll
                for (int i = 0; i < 6; ++i)
#pragma unroll
                    for (int j = 0; j < 4; ++j) { z[i][2 * j] = bf_lo(wc[i][j]) * bf_lo(wh[i][j]); z[i][2 * j + 1] = bf_hi(wc[i][j]) * bf_hi(wh[i][j]); }
#pragma unroll
                for (int i = 0; i < 4; ++i) { float y[8];
#pragma unroll
                    for (int j = 0; j < 4; ++j) {
                        y[2 * j] = bf_lo(wb[i][j]) * (k0[2 * j] * z[i][2 * j] + k1[2 * j] * z[i + 1][2 * j] + k2[2 * j] * z[i + 2][2 * j]);
                        y[2 * j + 1] = bf_hi(wb[i][j]) * (k0[2 * j + 1] * z[i][2 * j + 1] + k1[2 * j + 1] * z[i + 1][2 * j + 1] + k2[2 * j + 1] * z[i + 2][2 * j + 1]); }
                    u32x4 w; w.x = cvt_pk_bf16(y[0], y[1]); w.y = cvt_pk_bf16(y[2], y[3]); w.z = cvt_pk_bf16(y[4], y[5]); w.w = cvt_pk_bf16(y[6], y[7]);
                    *(u32x4*)(Y + (size_t)(r + i) * DM + c0) = w; }
            }
        }
        {
            PH_IDS;
            bf16_t* PB = WSP(bf16_t, WS_PROJ); bf16_t* Y = WSP(bf16_t, WS_Y); bf16_t* wtril = WSP(bf16_t, WS_WTRIL);
            float* st = (float*)(lds + 40960);
            bf16_t* vT = (bf16_t*)lds;
            const float* lng = INP(5) + (size_t)l * 512; const float* lnb = INP(6) + (size_t)l * 512;
            const float* bs = INP(8) + (size_t)l * 512;
            const float* gstat = WSP(float, WS_ST) + (size_t)(6 + l) * T * 2;
            float* svL = (float*)(lds + 49152);
            for (int un = cu; un < (T / 128) * 4; un += G) {
                const int ch = un >> 2, gi = un & 3, r0 = ch * 128;
                if (tid < 128) {
                    const float s1 = gstat[2 * (r0 + tid)], s2 = gstat[2 * (r0 + tid) + 1];
                    const float mean = s1 * (1.f / 512.f), var = fmaxf(s2 * (1.f / 512.f) - mean * mean, 0.f);
                    st[2 * tid] = mean; st[2 * tid + 1] = rsqrtf(var + LN_EPS); }
                __syncthreads();
                {
                    const int tok = tid >> 2, cq = (tid & 3) * 32; const float mean = st[2 * tok], rstd = st[2 * tok + 1];
                    const bf16_t* vp = PB + ((size_t)(16 + gi) * T + r0 + tok) * 128 + cq;
#pragma unroll
                    for (int i = 0; i < 4; ++i) { const u32x4 w = *(const u32x4*)(vp + 8 * i);
#pragma unroll
                        for (int j = 0; j < 4; ++j) { const int c = cq + 8 * i + 2 * j;
                            const float x0 = gelu_tanh(bf_lo(w[j])), x1 = gelu_tanh(bf_hi(w[j]));
                            vT[c * 136 + tok] = f2bf((x0 - mean) * rstd * lng[gi * 128 + c] + lnb[gi * 128 + c]);
                            vT[(c + 1) * 136 + tok] = f2bf((x1 - mean) * rstd * lng[gi * 128 + c + 1] + lnb[gi * 128 + c + 1]); } }
                }
                __syncthreads();
                {
                    f32x4 acc[8];
#pragma unroll
                    for (int ct = 0; ct < 8; ++ct) acc[ct] = (f32x4){0.f, 0.f, 0.f, 0.f};
                    const bf16_t* wrow = wtril + ((size_t)(l * 4 + gi) * 128 + 16 * wave + (lane & 15)) * 128 + 8 * (lane >> 4);
#pragma unroll
                    for (int kk = 0; kk < 4; ++kk) { const bf16x8 av = *(const bf16x8*)(wrow + kk * 32);
#pragma unroll
                        for (int ct = 0; ct < 8; ++ct) { const bf16x8 bv = *(const bf16x8*)(vT + (ct * 16 + (lane & 15)) * 136 + kk * 32 + 8 * (lane >> 4));
                            acc[ct] = __builtin_amdgcn_mfma_f32_16x16x32_bf16(av, bv, acc[ct], 0, 0, 0); } }
#pragma unroll
                    for (int j = 0; j < 4; ++j) { const int t = 16 * wave + 4 * (lane >> 4) + j; const float bt = bs[gi * 128 + t];
#pragma unroll
                        for (int ct = 0; ct < 8; ++ct) svL[t * 132 + ct * 16 + (lane & 15)] = acc[ct][j] + bt; }
                }
                __syncthreads();
                {
                    const int c0 = (tid & 15) * 8;
#pragma unroll
                    for (int i = 0; i < 4; ++i) { const int t = 32 * i + (tid >> 4);
                        const u32x4 uw = *(const u32x4*)(PB + ((size_t)(12 + gi) * T + r0 + t) * 128 + c0);
                        const f32x4 s0 = *(const f32x4*)(svL + t * 132 + c0), s1 = *(const f32x4*)(svL + t * 132 + c0 + 4);
                        u32x4 w; w.x = cvt_pk_bf16(gelu_tanh(bf_lo(uw.x)) * s0[0], gelu_tanh(bf_hi(uw.x)) * s0[1]); w.y = cvt_pk_bf16(gelu_tanh(bf_lo(uw.y)) * s0[2], gelu_tanh(bf_hi(uw.y)) * s0[3]);
                        w.z = cvt_pk_bf16(gelu_tanh(bf_lo(uw.z)) * s1[0], gelu_tanh(bf_hi(uw.z)) * s1[1]); w.w = cvt_pk_bf16(gelu_tanh(bf_lo(uw.w)) * s1[2], gelu_tanh(bf_hi(uw.w)) * s1[3]);
                        *(u32x4*)(Y + (size_t)(r0 + t) * DM + 512 + gi * 128 + c0) = w; }
                }
                __syncthreads();
            }
        }
        {
            PH_IDS;
            bf16_t* PB = WSP(bf16_t, WS_PROJ); float* OATT = WSP(float, WS_R1); float* btab = WSP(float, WS_BTAB);
            float* btl = (float*)(lds + att2::L_BT);
            for (int i = tid; i < 8 * 256; i += NTHR) btl[i] = btab[i];
            __syncthreads();
            const att::bf16* PBb = (const att::bf16*)PB;
#pragma unroll 1
            for (int L = cu; L < 512; L += G) {
                const int k_ = L >> 3, hm = L & 7, b = k_ >> 5, x = k_ & 31, h = hm >> 1;
#pragma unroll 1
                for (int pass = 0; pass < 2; ++pass) {
                    const int qb = pass ? 63 - x : x;
                    att2::Blk c;
                    c.Q = PBb + ((size_t)(20 + hm) * T + (size_t)b * SEQ + qb * 128) * 128; c.K = PBb + ((size_t)(28 + hm) * T + (size_t)b * SEQ) * 128;
                    c.V0 = PBb + ((size_t)(36 + h * 2) * T + (size_t)b * SEQ) * 128; c.V1 = PBb + ((size_t)(37 + h * 2) * T + (size_t)b * SEQ) * 128;
                    c.O0 = OATT + ((size_t)((b * 8 + hm) * 2 + 0) * SEQ + qb * 128) * 128; c.O1 = OATT + ((size_t)((b * 8 + hm) * 2 + 1) * SEQ + qb * 128) * 128;
                    c.P0 = qb * 128; c.hm = hm;
                    att2::attn2_block(c, (char*)lds);
                }
            }
        }
        GRID_BAR();

        {
            PH_IDS;
            float* OATT = WSP(float, WS_R1); bf16_t* Y = WSP(bf16_t, WS_Y); float* lamp = WSP(float, WS_LAM);
            const float lam_init = 0.8f - 0.6f * expf(-0.3f * (float)l);
            const float lam = lamp[l]; const float* sg = INP(11) + (size_t)l * 256;
            const f32x4 gv = *(const f32x4*)(sg + 4 * lane);
            for (int it = gw; it < T * 4; it += 2 * NGW) {
                const int half = lane >> 5, e = (lane & 31) * 4;
                const int itb = it + NGW;
                const int ra = it >> 2, ha = it & 3, ba = ra >> 13, ta = ra & (SEQ - 1);
                const int rb = itb >> 2, hb = itb & 3, bb = rb >> 13, tb = rb & (SEQ - 1);
                const size_t a0 = ((size_t)(((ba * 4 + ha) * 2 + 0) * 2 + half) * SEQ + ta) * 128 + e, a1 = ((size_t)(((ba * 4 + ha) * 2 + 1) * 2 + half) * SEQ + ta) * 128 + e;
                const size_t b0 = ((size_t)(((bb * 4 + hb) * 2 + 0) * 2 + half) * SEQ + tb) * 128 + e, b1 = ((size_t)(((bb * 4 + hb) * 2 + 1) * 2 + half) * SEQ + tb) * 128 + e;
                const f32x4 oa0 = *(const f32x4*)(OATT + a0), oa1 = *(const f32x4*)(OATT + a1), ob0 = *(const f32x4*)(OATT + b0), ob1 = *(const f32x4*)(OATT + b1);
                const f32x4 da = oa0 - oa1 * lam, db = ob0 - ob1 * lam;
                const float ssa = wave_sum(da[0] * da[0] + da[1] * da[1] + da[2] * da[2] + da[3] * da[3]);
                const float ssb = wave_sum(db[0] * db[0] + db[1] * db[1] + db[2] * db[2] + db[3] * db[3]);
                const float sca = rsqrtf(ssa * (1.f / 256.f) + LN_EPS) * (1.f - lam_init), scb = rsqrtf(ssb * (1.f / 256.f) + LN_EPS) * (1.f - lam_init);
                u32x2 wa; wa.x = cvt_pk_bf16(da[0] * sca * gv[0], da[1] * sca * gv[1]); wa.y = cvt_pk_bf16(da[2] * sca * gv[2], da[3] * sca * gv[3]);
                u32x2 wb; wb.x = cvt_pk_bf16(db[0] * scb * gv[0], db[1] * scb * gv[1]); wb.y = cvt_pk_bf16(db[2] * scb * gv[2], db[3] * scb * gv[3]);
                *(u32x2*)(Y + (size_t)ra * DM + 1024 + ha * 256 + 4 * lane) = wa;
                *(u32x2*)(Y + (size_t)rb * DM + 1024 + hb * 256 + 4 * lane) = wb;
            }
        }
        GRID_BAR();

#define LN_OUT_PASS(gam, bet) do { PH_IDS; float* X = out_opaque(a); const bf16_t* ZB = WSP(bf16_t, WS_XN); \
            for (int r0_ = gw; r0_ < T; r0_ += 2 * NGW) { u32x4 wq[2][4];                          \
                _Pragma("unroll") for (int q = 0; q < 2; ++q) _Pragma("unroll") for (int j = 0; j < 4; ++j) wq[q][j] = *(const u32x4*)(ZB + (size_t)(r0_ + q * NGW) * DM + 8 * lane + 512 * j); \
                _Pragma("unroll") for (int q = 0; q < 2; ++q) { const int r = r0_ + q * NGW; float* xr = X + (size_t)r * DM; f32x4 v[8]; float s = 0.f; \
                    _Pragma("unroll") for (int j = 0; j < 4; ++j) { const u32x4 w = wq[q][j]; \
                        v[2 * j] = (f32x4){bf_lo(w.x), bf_hi(w.x), bf_lo(w.y), bf_hi(w.y)}; v[2 * j + 1] = (f32x4){bf_lo(w.z), bf_hi(w.z), bf_lo(w.w), bf_hi(w.w)}; } \
                    _Pragma("unroll") for (int j = 0; j < 8; ++j) s += (v[j][0] + v[j][1]) + (v[j][2] + v[j][3]); \
                    const float mean = wave_sum(s) * (1.f / DM); float s2 = 0.f; \
                    _Pragma("unroll") for (int j = 0; j < 8; ++j) { v[j] = v[j] - mean; s2 += (v[j][0] * v[j][0] + v[j][1] * v[j][1]) + (v[j][2] * v[j][2] + v[j][3] * v[j][3]); } \
                    const float rstd = rsqrtf(wave_sum(s2) * (1.f / DM) + LN_EPS); \
                    _Pragma("unroll") for (int j = 0; j < 8; ++j) { const int c = 8 * lane + 512 * (j >> 1) + 4 * (j & 1); \
                        const f32x4 gg = *(const f32x4*)((gam) + c), bb = *(const f32x4*)((bet) + c); \
                        *(f32x4*)(xr + c) = v[j] * rstd * gg + bb; } } } } while (0)

        {
            unsigned char* ws = ws_opaque(a); float* X = out_opaque(a); float* ST = (float*)(ws + WS_ST);
            pg8::Gemm g{(const bf16_t*)(ws + WS_Y), (const bf16_t*)(ws + WS_W + (size_t)l * W_LAYER + W_OUT), DM, DM, DM, 1, 0, 0, 0, 0};
            pg8::Order S; S.init(T, DM, 1, G, cu_opaque());
            pg8::EpiRes E{nullptr, l == 0 ? INP(0) : nullptr, ST + (size_t)(l > 0 ? 3 * l - 1 : 0) * T * 2, INP(22) + (size_t)(l > 0 ? l - 1 : 0) * DM, INP(23) + (size_t)(l > 0 ? l - 1 : 0) * DM,
                          (bf16_t*)(ws + WS_XN), ST + (size_t)(3 * l) * T * 2, ALPHA, 0};
            pg8::gemm_phase<pg8::EpiRes, true>((LAS unsigned char*)lds, g, S, E);
        }
        GRID_BAR();

        {
            unsigned char* ws = ws_opaque(a);
            const float* cl = (const float*)(ws + WS_C) + (size_t)l * C_LAYER;
            pg8::Gemm g{(const bf16_t*)(ws + WS_XN), (const bf16_t*)(ws + WS_W + (size_t)l * W_LAYER + W_KV), DM, DM, DM, 4, (long)SEQ * DM, 0, (long)4 * NMEM * DM, (long)NMEM * DM};
            pg8::Order S; S.init(SEQ, NMEM, 8, G, cu_opaque());
            pg8::EpiSoftmax E{(bf16_t*)(ws + WS_PROJ + 64 * MiB), (const float*)(ws + WS_ST) + (size_t)(3 * l) * T * 2, cl + C_Q, cl + C_QK2, 0.044194173824159216f};
            pg8::gemm_phase<pg8::EpiSoftmax, true>((LAS unsigned char*)lds, g, S, E);
        }
        GRID_BAR();
        {
            unsigned char* ws = ws_opaque(a); float* ST = (float*)(ws + WS_ST);
            pg8::Gemm g{(const bf16_t*)(ws + WS_PROJ + 64 * MiB), (const bf16_t*)(ws + WS_W + (size_t)l * W_LAYER + W_KV + 8 * MiB), 1024, 1024, 1024, 1, (long)SEQ * 1024, 0, (long)DM * 1024, 0};
            pg8::Order S; S.init(SEQ, DM, 2, G, cu_opaque());
            pg8::EpiRes E{nullptr, nullptr, ST + (size_t)(3 * l) * T * 2, INP(13) + (size_t)l * DM, INP(14) + (size_t)l * DM, (bf16_t*)(ws + WS_XN), ST + (size_t)(3 * l + 1) * T * 2, ALPHA, SEQ};
            pg8::gemm_phase<pg8::EpiRes, true>((LAS unsigned char*)lds, g, S, E);
        }
        GRID_BAR();
        {
            unsigned char* ws = ws_opaque(a);
            const float* cl = (const float*)(ws + WS_C) + (size_t)l * C_LAYER;
            pg8::Gemm g{(const bf16_t*)(ws + WS_XN), (const bf16_t*)(ws + WS_W + (size_t)l * W_LAYER + W_GU), DM, DM, DM, 1, 0, 0, 0, 0};
            pg8::Order S; S.init(T, 2 * DFF, 1, G, cu_opaque());
            pg8::EpiSwiglu E{(bf16_t*)(ws + WS_PROJ), (const float*)(ws + WS_ST) + (size_t)(3 * l + 1) * T * 2, cl + C_GU, cl + C_GU + 2 * DFF};
            pg8::gemm_phase<pg8::EpiSwiglu, true>((LAS unsigned char*)lds, g, S, E);
        }
        GRID_BAR();
        {
            unsigned char* ws = ws_opaque(a); float* X = out_opaque(a); float* ST = (float*)(ws + WS_ST);
            pg8::Gemm g{(const bf16_t*)(ws + WS_PROJ), (const bf16_t*)(ws + WS_W + (size_t)l * W_LAYER + W_D), DFF, DFF, DFF, 1, 0, 0, 0, 0};
            pg8::Order S; S.init(T, DM, 1, G, cu_opaque());
            pg8::EpiRes E{nullptr, nullptr, ST + (size_t)(3 * l + 1) * T * 2, INP(18) + (size_t)l * DM, INP(19) + (size_t)l * DM, (bf16_t*)(ws + WS_XN), ST + (size_t)(3 * l + 2) * T * 2, ALPHA, 0};
            pg8::gemm_phase<pg8::EpiRes, true>((LAS unsigned char*)lds, g, S, E);
        }
        GRID_BAR();
        if (l + 1 == DEPTH) { LN_OUT_PASS(INP(22) + (size_t)l * DM, INP(23) + (size_t)l * DM); }
#undef LN_OUT_PASS
    }
    if (a.ws == nullptr) cg::this_grid().sync();
}

extern "C" void kernel_launch(void* const* d_in, const int* in_sizes, int n_in, void* d_out, int out_size, void* d_ws, size_t ws_size, hipStream_t stream) {
    static int grid = 0;
    if (grid == 0) {
        if (n_in != 24 || in_sizes[0] != T * DM || out_size != T * DM || ws_size < WS_END) {
            fprintf(stderr, "kernel_launch: unexpected shapes (n_in %d, in0 %d, out %d, ws %zu); nothing launched\n", n_in, n_in > 0 ? in_sizes[0] : -1, out_size, ws_size); grid = -1; return; }
        int dev = 0, cus = 0, per_cu = 0;
        (void)hipGetDevice(&dev);
        if (hipDeviceGetAttribute(&cus, hipDeviceAttributeMultiprocessorCount, dev) != hipSuccess || cus <= 0) cus = 256;
        if (hipFuncSetAttribute((const void*)mega_fwd, hipFuncAttributeMaxDynamicSharedMemorySize, LDS_BYTES) != hipSuccess) fprintf(stderr, "kernel_launch: hipFuncSetAttribute failed\n");
        if (hipOccupancyMaxActiveBlocksPerMultiprocessor(&per_cu, (const void*)mega_fwd, NTHR, LDS_BYTES) != hipSuccess || per_cu < 1) { fprintf(stderr, "kernel_launch: occupancy query says %d\n", per_cu); per_cu = 1; }
        (void)hipGetLastError();
        grid = cus * per_cu;
    }
    if (grid < 0) return;
    if (hipMemsetAsync((char*)d_ws + WS_BAR, 0, WS_ST + 1 * MiB - WS_BAR, stream) != hipSuccess) { fprintf(stderr, "kernel_launch: hipMemsetAsync failed\n"); return; }
    Args a{};
    for (int i = 0; i < 24; ++i) a.in[i] = (const float*)d_in[i];
    a.out = (float*)d_out; a.ws = (unsigned char*)d_ws;
    void* args[] = {&a};
    hipError_t e = hipLaunchCooperativeKernel((const void*)mega_fwd, dim3(grid), dim3(NTHR), args, LDS_BYTES, stream);
    if (e != hipSuccess) fprintf(stderr, "cooperative launch failed: %s (grid %d)\n", hipGetErrorString(e), grid);
}
```

```cpp
#include <hip/hip_runtime.h>
#include <hip/hip_cooperative_groups.h>
#include <hip/hip_bf16.h>
#include <cstdio>
#include <cstdint>
namespace cg = cooperative_groups;

constexpr int BATCH = 2, SEQ = 8192, DM = 2048, DEPTH = 2, T = BATCH * SEQ;
constexpr int NMEM = 256, INC = 5632, DFF = 5632;
constexpr float ALPHA = 1.4142135623730951f;
constexpr float LN_EPS = 1e-5f;
constexpr int NTHR = 512, NWAVES = 8;

constexpr size_t MiB = 1u << 20;
constexpr size_t WS_LAM = 0;
constexpr size_t WS_BTAB = 4096;
constexpr size_t WS_BAR = 512 * 1024;
constexpr size_t WS_C = 576 * 1024;
constexpr int C_Q = 0, C_GU = 4096, C_IN = 4096 + 22528, C_QK2 = 4096 + 22528 + 11264, C_LAYER = C_QK2 + 2048;
constexpr size_t WS_ST = 1 * MiB;
constexpr size_t WS_WTRIL = 12 * MiB;
constexpr size_t WS_MEMBF = 2 * MiB;
constexpr size_t WS_KV = 4 * MiB;
constexpr size_t WS_W = 16 * MiB;
constexpr size_t W_IN = 0, W_OUT = 22 * MiB, W_Q = 30 * MiB, W_KV = 38 * MiB, W_O = 54 * MiB, W_GU = 62 * MiB, W_D = 106 * MiB, W_LAYER = 128 * MiB;
constexpr size_t WS_XN = 272 * MiB;
constexpr size_t WS_PROJ = 336 * MiB;
constexpr size_t WS_R1 = 512 * MiB;
constexpr size_t WS_Y = 640 * MiB;
constexpr size_t WS_END = 704 * MiB;
constexpr int LDS_BYTES = 147456;

typedef unsigned short bf16_t;
typedef short bf16x8 __attribute__((ext_vector_type(8)));
typedef float f32x4 __attribute__((ext_vector_type(4)));
typedef float f32x16 __attribute__((ext_vector_type(16)));
typedef unsigned u32x4 __attribute__((ext_vector_type(4)));
typedef unsigned u32x2 __attribute__((ext_vector_type(2)));
#define LAS __attribute__((address_space(3)))
#define GAS __attribute__((address_space(1)))

__device__ __forceinline__ unsigned cvt_pk_bf16(float lo, float hi) { unsigned r; asm volatile("v_cvt_pk_bf16_f32 %0, %1, %2" : "=v"(r) : "v"(lo), "v"(hi)); return r; }
__device__ __forceinline__ float bf_lo(unsigned w) { return __uint_as_float(w << 16); }
__device__ __forceinline__ float bf_hi(unsigned w) { return __uint_as_float(w & 0xffff0000u); }
__device__ __forceinline__ float bf2f(bf16_t b) { return __uint_as_float(((unsigned)b) << 16); }
__device__ __forceinline__ bf16_t f2bf(float f) { return (bf16_t)(cvt_pk_bf16(f, 0.f) & 0xffffu); }
__device__ __forceinline__ int ltid() { int t = threadIdx.x; asm volatile("" : "+v"(t)); return t; }
__device__ __forceinline__ int cu_opaque() { int c = blockIdx.x; asm volatile("" : "+s"(c)); return c; }
#define PH_IDS const int cu = cu_opaque(); const int tid = ltid(), lane = tid & 63, wave = __builtin_amdgcn_readfirstlane(tid >> 6), gw = cu * NWAVES + wave, gt = cu * NTHR + tid; (void)lane; (void)wave; (void)gw; (void)gt
__device__ __forceinline__ float wave_sum(float v) {
#pragma unroll
    for (int o = 1; o < 64; o <<= 1) v += __shfl_xor(v, o);
    return v;
}
__device__ __forceinline__ float wave_max(float v) {
#pragma unroll
    for (int o = 1; o < 64; o <<= 1) v = fmaxf(v, __shfl_xor(v, o));
    return v;
}
__device__ __forceinline__ float gelu_tanh(float x) {
    const float y = 0.7978845608028654f * (x + 0.044715f * x * x * x);
    return x * __builtin_amdgcn_rcpf(1.f + __expf(-2.f * y));
}

namespace pg8 {
constexpr int BM = 256, BK = 64, HALF = 128, HTB = HALF * BK * 2, STAGE_BYTES = 8 * HTB, NXCD = 8, WGM = 8;
__host__ __device__ __forceinline__ int lds_byte(int r, int c) { const int st = (r >> 4) * 2 + (c >> 5), rr = r & 15, cc = c & 31, ob = rr * 64 + cc * 2; return st * 1024 + (ob ^ (((ob >> 9) & 1) << 5)); }
__host__ __device__ __forceinline__ void stage_rc(int b, int& R, int& C) { const int st = b / 1024, sb = b % 1024, swz = sb ^ (((sb >> 9) & 1) << 5); R = (st >> 1) * 16 + swz / 64; C = (st & 1) * 32 + (swz % 64) / 2; }
__host__ __device__ __forceinline__ int perm32(int rho) { const int n = rho >> 4, i = rho & 15; return 8 * (i >> 2) + 4 * n + (i & 3); }

struct Unit { int pm, pn, bz; };
struct Gemm { const bf16_t* A; const bf16_t* Bt; int lda, ldb, K, nb0; long a_s1, a_s0, b_s1, b_s0; };
__device__ __forceinline__ const char* unit_a(const Gemm& g, const Unit& u) { const int b1 = u.bz / g.nb0, b0 = u.bz % g.nb0; return (const char*)(g.A + (size_t)b1 * g.a_s1 + (size_t)b0 * g.a_s0 + (size_t)u.pm * BM * g.lda); }
__device__ __forceinline__ const char* unit_b(const Gemm& g, const Unit& u) { const int b1 = u.bz / g.nb0, b0 = u.bz % g.nb0; return (const char*)(g.Bt + (size_t)b1 * g.b_s1 + (size_t)b0 * g.b_s0 + (size_t)u.pn * BM * g.ldb); }

struct Order {
    int nM, nN, nB, G, c;
    __device__ void init(int M, int N, int nB_, int G_, int c_) { nM = M / BM; nN = N / BM; nB = nB_; G = G_; c = c_; }
    __device__ bool next(int i, Unit& u) const {
        const long L = (long)i * G + c; const int nwg = nM * nN; if (c < 0 || L >= (long)nwg * nB) return false;
        if (nB > 1) { u.bz = (int)(L / nwg); const int w = (int)(L % nwg); u.pn = w / nM; u.pm = w % nM; return true; }
        u.bz = 0;
        int wgid = (int)L; { const int q = nwg / NXCD, r = nwg % NXCD, xcd = wgid % NXCD, off = wgid / NXCD; wgid = (xcd < r ? xcd * (q + 1) : r * (q + 1) + (xcd - r) * q) + off; }
        const int nig = WGM * nN, gid = wgid / nig, fm = gid * WGM, gsz = (nM - fm) < WGM ? (nM - fm) : WGM;
        u.pm = fm + ((wgid % nig) % gsz); u.pn = (wgid % nig) / gsz; return true;
    }
};

__device__ __forceinline__ void row_stats(const float* st, int row, float& mean, float& rstd) {
    const float s1 = st[2 * row], s2 = st[2 * row + 1];
    mean = s1 * (1.f / DM); const float var = fmaxf(s2 * (1.f / DM) - mean * mean, 0.f); rstd = rsqrtf(var + LN_EPS);
}
struct EpiSplit {
    static constexpr bool PERM = true, AFTER_DRAIN = false;
    bf16_t* P; const float* st; const float* c1; const float* c2;
    float* gst;
    __device__ __forceinline__ void operator()(const f32x4 (&acc)[2][2][4][2], const Unit& u, int wr, int wc, int fr, int fq) const {
        const int row0 = u.pm * BM + wr * 64 + fr, col0 = u.pn * BM + wc * 32 + 8 * fq;
        const bool vg = (u.pn == 8 || u.pn == 9);
        f32x4 k1[2][2], k2[2][2];
        if (st) {
#pragma unroll
            for (int bj = 0; bj < 2; ++bj)
#pragma unroll
                for (int n = 0; n < 2; ++n) { k1[bj][n] = *(const f32x4*)(c1 + col0 + bj * HALF + 4 * n); k2[bj][n] = *(const f32x4*)(c2 + col0 + bj * HALF + 4 * n); } }
#pragma unroll
        for (int ai = 0; ai < 2; ++ai)
#pragma unroll
            for (int m = 0; m < 4; ++m) { const int row = row0 + ai * HALF + m * 16;
                float mean = 0.f, rstd = 1.f; if (st) row_stats(st, row, mean, rstd);
                float gs = 0.f, gq = 0.f;
#pragma unroll
                for (int bj = 0; bj < 2; ++bj) { f32x4 v0 = acc[ai][bj][m][0], v1 = acc[ai][bj][m][1];
                    if (st) { v0 = (v0 - k1[bj][0] * mean) * rstd + k2[bj][0]; v1 = (v1 - k1[bj][1] * mean) * rstd + k2[bj][1]; }
                    u32x4 w; w.x = cvt_pk_bf16(v0[0], v0[1]); w.y = cvt_pk_bf16(v0[2], v0[3]); w.z = cvt_pk_bf16(v1[0], v1[1]); w.w = cvt_pk_bf16(v1[2], v1[3]);
                    *(u32x4*)(P + ((size_t)(u.pn * 2 + bj) * T + row) * 128 + wc * 32 + 8 * fq) = w;
                    if (vg) {
#pragma unroll
                        for (int j = 0; j < 4; ++j) { const float x0 = gelu_tanh(bf_lo(w[j])), x1 = gelu_tanh(bf_hi(w[j])); gs += x0 + x1; gq += x0 * x0 + x1 * x1; } } }
                if (vg) { gs += __shfl_xor(gs, 16); gs += __shfl_xor(gs, 32); gq += __shfl_xor(gq, 16); gq += __shfl_xor(gq, 32);
                    if (fq == 0) { unsafeAtomicAdd(gst + 2 * row, gs); unsafeAtomicAdd(gst + 2 * row + 1, gq); } } }
    }
};
struct EpiBf16 {
    static constexpr bool PERM = true, AFTER_DRAIN = false;
    bf16_t* O; int ldc, nb0; long o_s1, o_s0; float scale; const float* st; const float* c1; const float* c2; float* rsum;
    __device__ __forceinline__ void operator()(const f32x4 (&acc)[2][2][4][2], const Unit& u, int wr, int wc, int fr, int fq) const {
        const int row0 = u.pm * BM + wr * 64 + fr, col0 = u.pn * BM + wc * 32 + 8 * fq;
        bf16_t* base = O + (size_t)(u.bz / nb0) * o_s1 + (size_t)(u.bz % nb0) * o_s0;
        f32x4 k1[2][2], k2[2][2];
        if (st) {
#pragma unroll
            for (int bj = 0; bj < 2; ++bj)
#pragma unroll
                for (int n = 0; n < 2; ++n) { k1[bj][n] = *(const f32x4*)(c1 + col0 + bj * HALF + 4 * n); k2[bj][n] = *(const f32x4*)(c2 + col0 + bj * HALF + 4 * n); } }
#pragma unroll
        for (int ai = 0; ai < 2; ++ai)
#pragma unroll
            for (int m = 0; m < 4; ++m) { const int row = row0 + ai * HALF + m * 16; bf16_t* rowp = base + (size_t)row * ldc + col0;
                float mean = 0.f, rstd = 1.f; if (st) row_stats(st, row, mean, rstd);
                float rs = 0.f;
#pragma unroll
                for (int bj = 0; bj < 2; ++bj) { f32x4 v0 = acc[ai][bj][m][0], v1 = acc[ai][bj][m][1];
                    if (st) { v0 = (v0 - k1[bj][0] * mean) * rstd + k2[bj][0]; v1 = (v1 - k1[bj][1] * mean) * rstd + k2[bj][1]; }
                    v0 = v0 * scale; v1 = v1 * scale;
                    u32x4 w; w.x = cvt_pk_bf16(v0[0], v0[1]); w.y = cvt_pk_bf16(v0[2], v0[3]); w.z = cvt_pk_bf16(v1[0], v1[1]); w.w = cvt_pk_bf16(v1[2], v1[3]);
                    *(u32x4*)(rowp + bj * HALF) = w;
                    if (rsum) rs += ((bf_lo(w.x) + bf_hi(w.x)) + (bf_lo(w.y) + bf_hi(w.y))) + ((bf_lo(w.z) + bf_hi(w.z)) + (bf_lo(w.w) + bf_hi(w.w))); }
                if (rsum) { rs += __shfl_xor(rs, 16); rs += __shfl_xor(rs, 32); if (fq == 0) unsafeAtomicAdd(rsum + u.bz * 256 + row, rs); } }
    }
};
struct EpiF32 {
    static constexpr bool PERM = false, AFTER_DRAIN = false;
    float* out; int ldc; long o_bs; float scale;
    __device__ __forceinline__ void operator()(const f32x4 (&acc)[2][2][4][2], const Unit& u, int wr, int wc, int fr, int fq) const {
        const int row0 = u.pm * BM + wr * 64 + fr, col0 = u.pn * BM + wc * 32 + 4 * fq;
        float* ob = out + (size_t)u.bz * o_bs;
#pragma unroll
        for (int ai = 0; ai < 2; ++ai)
#pragma unroll
            for (int m = 0; m < 4; ++m) { const size_t off = (size_t)(row0 + ai * HALF + m * 16) * ldc + col0;
#pragma unroll
                for (int bj = 0; bj < 2; ++bj)
#pragma unroll
                    for (int n = 0; n < 2; ++n) *(f32x4*)(ob + off + bj * HALF + n * 16) = acc[ai][bj][m][n] * scale; }
    }
};
struct EpiRes {
    static constexpr bool PERM = true, AFTER_DRAIN = false;
    float* X; const float* raw; const float* pst; const float* pg; const float* pb; bf16_t* ZB; float* cst; float alpha; int brows;
    __device__ __forceinline__ void operator()(const f32x4 (&acc)[2][2][4][2], const Unit& u, int wr, int wc, int fr, int fq) const {
        const int row0 = u.bz * brows + u.pm * BM + wr * 64 + fr, col0 = u.pn * BM + wc * 32 + 8 * fq;
        f32x4 gv[2][2], bv[2][2];
        if (!raw) {
#pragma unroll
            for (int bj = 0; bj < 2; ++bj)
#pragma unroll
                for (int n = 0; n < 2; ++n) { gv[bj][n] = *(const f32x4*)(pg + col0 + bj * HALF + 4 * n); bv[bj][n] = *(const f32x4*)(pb + col0 + bj * HALF + 4 * n); } }
#pragma unroll
        for (int pq = 0; pq < 4; ++pq) { const int ai = pq >> 1;
            u32x4 zpre[2][2]; float mpre[2], rpre[2];
            if (!raw) {
#pragma unroll
                for (int mm = 0; mm < 2; ++mm) { const int row = row0 + ai * HALF + ((pq & 1) * 2 + mm) * 16; const size_t off = (size_t)row * DM + col0;
                    zpre[mm][0] = *(const u32x4*)(ZB + off); zpre[mm][1] = *(const u32x4*)(ZB + off + HALF);
                    mpre[mm] = pst[2 * row]; rpre[mm] = pst[2 * row + 1]; } }
#pragma unroll
            for (int mm = 0; mm < 2; ++mm) { const int m = (pq & 1) * 2 + mm; const int row = row0 + ai * HALF + m * 16; const size_t off = (size_t)row * DM + col0;
                float mean = 0.f, rstd = 1.f;
                if (!raw) { mean = mpre[mm] * (1.f / DM); const float var = fmaxf(rpre[mm] * (1.f / DM) - mean * mean, 0.f); rstd = rsqrtf(var + LN_EPS); }
                float s1 = 0.f, s2 = 0.f;
#pragma unroll
                for (int bj = 0; bj < 2; ++bj) { f32x4 r0, r1;
                    if (raw) { r0 = *(const f32x4*)(raw + off + bj * HALF); r1 = *(const f32x4*)(raw + off + bj * HALF + 4); }
                    else { const u32x4 zw = zpre[mm][bj];
                        r0 = (f32x4){bf_lo(zw.x), bf_hi(zw.x), bf_lo(zw.y), bf_hi(zw.y)}; r1 = (f32x4){bf_lo(zw.z), bf_hi(zw.z), bf_lo(zw.w), bf_hi(zw.w)};
                        r0 = (r0 - mean) * rstd * gv[bj][0] + bv[bj][0]; r1 = (r1 - mean) * rstd * gv[bj][1] + bv[bj][1]; }
                    const f32x4 z0 = acc[ai][bj][m][0] + r0 * alpha, z1 = acc[ai][bj][m][1] + r1 * alpha;
                    if (X) { *(f32x4*)(X + off + bj * HALF) = z0; *(f32x4*)(X + off + bj * HALF + 4) = z1; }
                    u32x4 w; w.x = cvt_pk_bf16(z0[0], z0[1]); w.y = cvt_pk_bf16(z0[2], z0[3]); w.z = cvt_pk_bf16(z1[0], z1[1]); w.w = cvt_pk_bf16(z1[2], z1[3]);
                    *(u32x4*)(ZB + off + bj * HALF) = w;
                    s1 += ((z0[0] + z0[1]) + (z0[2] + z0[3])) + ((z1[0] + z1[1]) + (z1[2] + z1[3]));
                    s2 += ((z0[0] * z0[0] + z0[1] * z0[1]) + (z0[2] * z0[2] + z0[3] * z0[3])) + ((z1[0] * z1[0] + z1[1] * z1[1]) + (z1[2] * z1[2] + z1[3] * z1[3])); }
                s1 += __shfl_xor(s1, 16); s1 += __shfl_xor(s1, 32); s2 += __shfl_xor(s2, 16); s2 += __shfl_xor(s2, 32);
                if (fq == 0) { unsafeAtomicAdd(cst + 2 * row, s1); unsafeAtomicAdd(cst + 2 * row + 1, s2); } }
            asm volatile("" ::: "memory"); }
    }
};
struct EpiSwiglu {
    static constexpr bool PERM = true, AFTER_DRAIN = false;
    bf16_t* H; const float* st; const float* c1; const float* c2;
    __device__ __forceinline__ void operator()(const f32x4 (&acc)[2][2][4][2], const Unit& u, int wr, int wc, int fr, int fq) const {
        const int row0 = u.pm * BM + wr * 64 + fr, col0 = u.pn * HALF + wc * 32 + 8 * fq, ccol0 = u.pn * BM + wc * 32 + 8 * fq;
        f32x4 k1[2][2], k2[2][2];
#pragma unroll
        for (int bj = 0; bj < 2; ++bj)
#pragma unroll
            for (int n = 0; n < 2; ++n) { k1[bj][n] = *(const f32x4*)(c1 + ccol0 + bj * HALF + 4 * n); k2[bj][n] = *(const f32x4*)(c2 + ccol0 + bj * HALF + 4 * n); }
#pragma unroll
        for (int ai = 0; ai < 2; ++ai)
#pragma unroll
            for (int m = 0; m < 4; ++m) { const int row = row0 + ai * HALF + m * 16; bf16_t* rowp = H + (size_t)row * DFF + col0;
                float mean, rstd; row_stats(st, row, mean, rstd);
                float h[8];
#pragma unroll
                for (int n = 0; n < 2; ++n) { const f32x4 gq = (acc[ai][0][m][n] - k1[0][n] * mean) * rstd + k2[0][n], uq = (acc[ai][1][m][n] - k1[1][n] * mean) * rstd + k2[1][n];
#pragma unroll
                    for (int j = 0; j < 4; ++j) h[n * 4 + j] = gq[j] * __builtin_amdgcn_rcpf(1.f + __expf(-gq[j])) * uq[j]; }
                u32x4 w; w.x = cvt_pk_bf16(h[0], h[1]); w.y = cvt_pk_bf16(h[2], h[3]); w.z = cvt_pk_bf16(h[4], h[5]); w.w = cvt_pk_bf16(h[6], h[7]);
                *(u32x4*)rowp = w; }
    }
};

struct EpiSoftmax {
    static constexpr bool PERM = true, AFTER_DRAIN = true;
    bf16_t* PALL; const float* st; const float* c1; const float* c2; float scale;
    __device__ __forceinline__ void fused(f32x4 (&acc)[2][2][4][2], const Unit& u, int wr, int wc, int fr, int fq, LAS unsigned char* lds) const {
        const int b = u.bz >> 2, h = u.bz & 3, rl0 = wr * 64 + fr, cc0 = wc * 32 + 8 * fq;
        LAS float* PMX = (LAS float*)lds; LAS float* PSM = PMX + 1024;
        f32x4 k1[2][2], k2[2][2];
#pragma unroll
        for (int bj = 0; bj < 2; ++bj)
#pragma unroll
            for (int n = 0; n < 2; ++n) { k1[bj][n] = *(const f32x4*)(c1 + u.bz * 256 + cc0 + bj * HALF + 4 * n); k2[bj][n] = *(const f32x4*)(c2 + u.bz * 256 + cc0 + bj * HALF + 4 * n); }
#pragma unroll
        for (int ai = 0; ai < 2; ++ai)
#pragma unroll
            for (int m = 0; m < 4; ++m) { const int rl = rl0 + ai * HALF + m * 16, row = b * SEQ + u.pm * BM + rl;
                float mean, rstd; row_stats(st, row, mean, rstd);
                float mx = -__builtin_inff();
#pragma unroll
                for (int bj = 0; bj < 2; ++bj)
#pragma unroll
                    for (int n = 0; n < 2; ++n) { const f32x4 v = ((acc[ai][bj][m][n] - k1[bj][n] * mean) * rstd + k2[bj][n]) * scale; acc[ai][bj][m][n] = v;
                        mx = fmaxf(mx, fmaxf(fmaxf(v[0], v[1]), fmaxf(v[2], v[3]))); }
                mx = fmaxf(mx, __shfl_xor(mx, 16)); mx = fmaxf(mx, __shfl_xor(mx, 32));
                if (fq == 0) PMX[rl * 4 + wc] = mx; }
        asm volatile("s_waitcnt lgkmcnt(0)" ::: "memory"); __builtin_amdgcn_s_barrier(); asm volatile("" ::: "memory");
#pragma unroll
        for (int ai = 0; ai < 2; ++ai)
#pragma unroll
            for (int m = 0; m < 4; ++m) { const int rl = rl0 + ai * HALF + m * 16;
                const f32x4 q = *(const LAS f32x4*)(PMX + rl * 4); const float mx = fmaxf(fmaxf(q[0], q[1]), fmaxf(q[2], q[3]));
                float sm = 0.f;
#pragma unroll
                for (int bj = 0; bj < 2; ++bj)
#pragma unroll
                    for (int n = 0; n < 2; ++n) { f32x4 e = acc[ai][bj][m][n] - mx; e[0] = __expf(e[0]); e[1] = __expf(e[1]); e[2] = __expf(e[2]); e[3] = __expf(e[3]); acc[ai][bj][m][n] = e;
                        sm += (e[0] + e[1]) + (e[2] + e[3]); }
                sm += __shfl_xor(sm, 16); sm += __shfl_xor(sm, 32);
                if (fq == 0) PSM[rl * 4 + wc] = sm; }
        asm volatile("s_waitcnt lgkmcnt(0)" ::: "memory"); __builtin_amdgcn_s_barrier(); asm volatile("" ::: "memory");
#pragma unroll
        for (int ai = 0; ai < 2; ++ai)
#pragma unroll
            for (int m = 0; m < 4; ++m) { const int rl = rl0 + ai * HALF + m * 16, row = b * SEQ + u.pm * BM + rl;
                const f32x4 q = *(const LAS f32x4*)(PSM + rl * 4); const float inv = __builtin_amdgcn_rcpf((q[0] + q[1]) + (q[2] + q[3]));
                bf16_t* rowp = PALL + (size_t)row * 1024 + h * 256 + cc0;
#pragma unroll
                for (int bj = 0; bj < 2; ++bj) { const f32x4 v0 = acc[ai][bj][m][0] * inv, v1 = acc[ai][bj][m][1] * inv;
                    u32x4 w; w.x = cvt_pk_bf16(v0[0], v0[1]); w.y = cvt_pk_bf16(v0[2], v0[3]); w.z = cvt_pk_bf16(v1[0], v1[1]); w.w = cvt_pk_bf16(v1[2], v1[3]);
                    *(u32x4*)(rowp + bj * HALF) = w; } }
    }
};

template <class Epi, bool ALIGN_EPI>
__device__ __forceinline__ void gemm_phase(LAS unsigned char* lds, const Gemm g, const Order& S, const Epi& E) {
    const int tid = ltid(), wid = __builtin_amdgcn_readfirstlane(tid >> 6), lane = tid & 63, wr = wid >> 2, wc = wid & 3, fr = lane & 15, fq = lane >> 4;
    const int K = g.K, nt = K / BK;
    unsigned voffA[2], voffB[2];
#pragma unroll
    for (int i = 0; i < 2; ++i) { int R, C; stage_rc(tid * 16 + i * 8192, R, C); const int Rb = Epi::PERM ? ((R & ~31) + perm32(R & 31)) : R;
        voffA[i] = (unsigned)(R * g.lda + C) * 2u; voffB[i] = (unsigned)(Rb * g.ldb + C) * 2u; }
    const size_t kstep = (size_t)(BK * 2);
    const size_t hstepA = (size_t)HALF * g.lda * 2, hstepB = (size_t)HALF * g.ldb * 2;
    const unsigned ldsw = (unsigned)wid * 1024u;
    const int aoff = lds_byte(wr * 64 + fr, fq * 8), boff = lds_byte(wc * 32 + fr, fq * 8);
#define PG8_SA(b, h) (((b) * 2 + (h)) * HTB)
#define PG8_SB(b, h) ((4 + (b) * 2 + (h)) * HTB)
#define PG8_STAGE(bufoff, gbase, voff) do { _Pragma("unroll") for (int _i = 0; _i < 2; ++_i) \
        __builtin_amdgcn_global_load_lds((const unsigned*)((const char*)(gbase) + (voff)[_i]), (LAS unsigned*)(lds + (bufoff) + ldsw + _i * 8192), 16, 0, 0); } while (0)
#define PG8_LDA(dst, b, h) do { _Pragma("unroll") for (int m = 0; m < 4; ++m) _Pragma("unroll") for (int k = 0; k < 2; ++k) dst[m][k] = *(const LAS bf16x8*)(lds + PG8_SA(b, h) + aoff + m * 2048 + k * 1024); } while (0)
#define PG8_LDB(dst, b, h) do { _Pragma("unroll") for (int n = 0; n < 2; ++n) _Pragma("unroll") for (int k = 0; k < 2; ++k) dst[n][k] = *(const LAS bf16x8*)(lds + PG8_SB(b, h) + boff + n * 2048 + k * 1024); } while (0)
#define PG8_MMA(ai, bj, At, Bt) do { __builtin_amdgcn_s_setprio(1); _Pragma("unroll") for (int m = 0; m < 4; ++m) _Pragma("unroll") for (int n = 0; n < 2; ++n) _Pragma("unroll") for (int k = 0; k < 2; ++k) \
        acc[ai][bj][m][n] = __builtin_amdgcn_mfma_f32_16x16x32_bf16(Bt[n][k], At[m][k], acc[ai][bj][m][n], 0, 0, 0); __builtin_amdgcn_s_setprio(0); } while (0)
#define PG8_WAIT_V(n) asm volatile("s_waitcnt vmcnt(" #n ")" ::: "memory")
#define PG8_WAIT_L(n) asm volatile("s_waitcnt lgkmcnt(" #n ")" ::: "memory")
#define PG8_BAR __builtin_amdgcn_s_barrier()
#define PG8_SCHED __builtin_amdgcn_sched_barrier(0)
    Unit cur, nxt; int ui = 0;
    if (!S.next(0, cur)) return;
    f32x4 acc[2][2][4][2];
#pragma unroll
    for (int a = 0; a < 2; ++a)
#pragma unroll
        for (int b = 0; b < 2; ++b)
#pragma unroll
            for (int m = 0; m < 4; ++m)
#pragma unroll
                for (int n = 0; n < 2; ++n) acc[a][b][m][n] = (f32x4){0.f, 0.f, 0.f, 0.f};
    bf16x8 At[4][2], B0[2][2], B1[2][2];
    const char* cA = unit_a(g, cur); const char* cB = unit_b(g, cur);
    PG8_STAGE(PG8_SB(0, 0), cB, voffB); PG8_STAGE(PG8_SB(0, 1), cB + hstepB, voffB); PG8_STAGE(PG8_SA(0, 0), cA, voffA); PG8_STAGE(PG8_SA(0, 1), cA + hstepA, voffA);
    if (wr == 1) PG8_BAR;
    PG8_WAIT_V(2); PG8_BAR;
    PG8_STAGE(PG8_SB(1, 0), cB + kstep, voffB); PG8_STAGE(PG8_SA(1, 0), cA + kstep, voffA); PG8_STAGE(PG8_SB(1, 1), cB + hstepB + kstep, voffB);
    PG8_WAIT_V(6); PG8_BAR;
    for (;;) {
        const bool has_next = S.next(ui + 1, nxt);
        const char* nA = has_next ? unit_a(g, nxt) : cA; const char* nB = has_next ? unit_b(g, nxt) : cB;
        for (int t = 0; t < nt; t += 2) {
            const bool last = (t == nt - 2);
            const char* a1 = cA + (size_t)(t + 1) * kstep;
            const char* a2 = last ? nA : cA + (size_t)(t + 2) * kstep; const char* b2 = last ? nB : cB + (size_t)(t + 2) * kstep;
            const char* a3 = a2 + kstep; const char* b3 = b2 + kstep;
            PG8_LDB(B0, 0, 0); PG8_LDB(B1, 0, 1); PG8_SCHED; PG8_LDA(At, 0, 0); PG8_STAGE(PG8_SA(1, 1), a1 + hstepA, voffA);
            PG8_WAIT_V(8); PG8_WAIT_L(0); PG8_BAR; PG8_MMA(0, 0, At, B0); PG8_MMA(0, 1, At, B1); PG8_BAR; PG8_SCHED;
            PG8_LDA(At, 0, 1); PG8_STAGE(PG8_SB(0, 0), b2, voffB); PG8_STAGE(PG8_SB(0, 1), b2 + hstepB, voffB); PG8_STAGE(PG8_SA(0, 0), a2, voffA);
            PG8_WAIT_V(8); PG8_WAIT_L(0); PG8_BAR; PG8_MMA(1, 0, At, B0); PG8_MMA(1, 1, At, B1); PG8_BAR; PG8_SCHED;
            PG8_LDB(B0, 1, 0); PG8_LDB(B1, 1, 1); PG8_SCHED; PG8_LDA(At, 1, 0); PG8_STAGE(PG8_SA(0, 1), a2 + hstepA, voffA);
            PG8_WAIT_V(8); PG8_WAIT_L(0); PG8_BAR; PG8_MMA(0, 0, At, B0); PG8_MMA(0, 1, At, B1); PG8_BAR; PG8_SCHED;
            PG8_LDA(At, 1, 1); PG8_STAGE(PG8_SB(1, 0), b3, voffB); PG8_STAGE(PG8_SB(1, 1), b3 + hstepB, voffB); PG8_STAGE(PG8_SA(1, 0), a3, voffA);
            PG8_WAIT_V(8); PG8_WAIT_L(0); PG8_BAR; PG8_MMA(1, 0, At, B0); PG8_MMA(1, 1, At, B1); PG8_BAR; PG8_SCHED;
        }
        if constexpr (ALIGN_EPI) { if (wr == 0) PG8_BAR; }
        if constexpr (!Epi::AFTER_DRAIN) E(acc, cur, wr, wc, fr, fq);
        if (!has_next) break;
#pragma unroll
        for (int a = 0; a < 2; ++a)
#pragma unroll
            for (int b = 0; b < 2; ++b)
#pragma unroll
                for (int m = 0; m < 4; ++m)
#pragma unroll
                    for (int n = 0; n < 2; ++n) acc[a][b][m][n] = (f32x4){0.f, 0.f, 0.f, 0.f};
        cur = nxt; cA = nA; cB = nB; ++ui;
        if constexpr (ALIGN_EPI) { if (wr == 1) PG8_BAR; }
    }
    PG8_WAIT_V(0);
    if constexpr (!ALIGN_EPI) { if (wr == 0) PG8_BAR; }
    PG8_BAR;
    if constexpr (Epi::AFTER_DRAIN) E.fused(acc, cur, wr, wc, fr, fq, lds);
#undef PG8_SA
#undef PG8_SB
#undef PG8_STAGE
#undef PG8_LDA
#undef PG8_LDB
#undef PG8_MMA
#undef PG8_WAIT_V
#undef PG8_WAIT_L
#undef PG8_BAR
#undef PG8_SCHED
}
}

namespace att {
using bf16 = __hip_bfloat16;
typedef short s16x4 __attribute__((ext_vector_type(4)));
constexpr int D = 128;
constexpr float THR = 8.f;
constexpr float SCALE = 0.08838834764831845f;
constexpr int NW = 8, QBLK = 32, KVBLK = 64, QB = NW * QBLK;
constexpr int SHM_V = KVBLK * D * 2, SHM_K = KVBLK * D * 2;
constexpr int ATT_LDS = 2 * SHM_V + 2 * SHM_K + NW * 64 * 4;
constexpr int BT_OFF = ATT_LDS;

#define KSWZ(row, colB) ((row) * 256 + ((colB) ^ (((row) & 7) << 4)))
#define SBAR() __builtin_amdgcn_sched_barrier(0)
__device__ __forceinline__ int v_st(int k, int c) { const int kk = (k & ~0xC) | ((k & 4) << 1) | ((k & 8) >> 1); return ((kk >> 3) * 4 + (c >> 5)) * 512 + ((kk & 7) * 32 + (c & 31)) * 2; }
__device__ __forceinline__ int v_rd_base(int lane) { return ((lane & 3) << 3) | (((lane >> 2) & 3) << 6) | (((lane >> 4) & 1) << 5) | (((lane >> 5) & 1) << 8); }
constexpr int v_rd_off(int d0, int ks, int half) { return d0 * 512 + ks * 4096 + half * 2048; }
__device__ __forceinline__ int crow(int r, int hi) { return (r & 3) + 8 * (r >> 2) + 4 * hi; }
__device__ __forceinline__ unsigned cvtpk(float lo, float hi) { unsigned r; asm volatile("v_cvt_pk_bf16_f32 %0, %1, %2" : "=v"(r) : "v"(lo), "v"(hi)); return r; }
__device__ __forceinline__ bf16x8 load8(const bf16* p) { return *reinterpret_cast<const bf16x8*>(p); }
__device__ __forceinline__ void bias_mask_tile(f32x16& p0, f32x16& p1, int dq, const float* bt) {
    const float NEG = -__builtin_inff();
#pragma unroll
    for (int r = 0; r < 16; ++r) {
        const int c = (r & 3) + 8 * (r >> 2);
        const int d0 = dq - c, d1 = dq - c - 32;
        const unsigned i0 = (unsigned)d0 < 255u ? (unsigned)d0 : 255u, i1 = (unsigned)d1 < 255u ? (unsigned)d1 : 255u;
        const float b0 = bt[i0], b1 = bt[i1];
        p0[r] = d0 >= 0 ? p0[r] + b0 : NEG;
        p1[r] = d1 >= 0 ? p1[r] + b1 : NEG;
    }
}
__device__ __forceinline__ void partialSM(f32x16& p0, f32x16& p1, float& m_reg, float& mn, float& alpha) {
    float pmax = p0[0]; for (int r = 1; r < 16; ++r) pmax = fmaxf(pmax, p0[r]); for (int r = 0; r < 16; ++r) pmax = fmaxf(pmax, p1[r]);
    { auto rr = __builtin_amdgcn_permlane32_swap(__float_as_uint(pmax), __float_as_uint(pmax), false, false);
      pmax = fmaxf(__uint_as_float(rr[0]), __uint_as_float(rr[1])); }
    constexpr float C2 = 1.4426950408889634f * SCALE;
    if (__builtin_expect(__all((pmax - m_reg) * SCALE <= THR), 1)) { mn = m_reg; alpha = 1.f; }
    else { mn = fmaxf(m_reg, pmax); alpha = __builtin_amdgcn_exp2f((m_reg - mn) * C2); m_reg = mn; }
    const float mnL = -mn * C2;
    for (int r = 0; r < 16; ++r) p0[r] = fmaf(p0[r], C2, mnL); for (int r = 0; r < 16; ++r) p1[r] = fmaf(p1[r], C2, mnL);
    for (int r = 0; r < 16; ++r) p0[r] = __builtin_amdgcn_exp2f(p0[r]);
}
__device__ __forceinline__ void finishSM(f32x16& p0, f32x16& p1, float alpha, float& l_reg, bf16x8& pa0, bf16x8& pa1, bf16x8& pa2, bf16x8& pa3) {
    for (int r = 0; r < 16; ++r) p1[r] = __builtin_amdgcn_exp2f(p1[r]);
    float ps = 0; for (int r = 0; r < 16; ++r) ps += p0[r]; for (int r = 0; r < 16; ++r) ps += p1[r];
    { auto rr = __builtin_amdgcn_permlane32_swap(__float_as_uint(ps), __float_as_uint(ps), false, false);
      ps = __uint_as_float(rr[0]) + __uint_as_float(rr[1]); }
    l_reg = l_reg * alpha + ps;
#define PK4(P, B_, OUT) do { unsigned a0 = cvtpk(P[B_+0], P[B_+1]), a1 = cvtpk(P[B_+2], P[B_+3]);                          \
        unsigned b0 = cvtpk(P[B_+4], P[B_+5]), b1 = cvtpk(P[B_+6], P[B_+7]);                                             \
        auto r0 = __builtin_amdgcn_permlane32_swap(a0, b0, false, false); auto r1 = __builtin_amdgcn_permlane32_swap(a1, b1, false, false); \
        u32x4 w = {r0[0], r1[0], r0[1], r1[1]}; OUT = *reinterpret_cast<bf16x8*>(&w); } while (0)
    PK4(p0, 0, pa0); PK4(p0, 8, pa1); PK4(p1, 0, pa2); PK4(p1, 8, pa3);
#undef PK4
}
template <int KB>
__device__ __forceinline__ void qkt(f32x16& p0, f32x16& p1, const char* K_lds, int r32, int hi, const bf16x8* qr) {
    p0 = f32x16{}; p1 = f32x16{};
    const char* kb[4];
#pragma unroll
    for (int dd = 0; dd < 4; ++dd) kb[dd] = K_lds + KB * SHM_K + KSWZ(r32, (dd * 16 + hi * 8) * 2);
#pragma unroll
    for (int d0 = 0; d0 < 8; ++d0) { const char* a = kb[d0 & 3] + (d0 >> 2) * 128;
        bf16x8 b0 = *reinterpret_cast<const bf16x8*>(a);
        bf16x8 b1 = *reinterpret_cast<const bf16x8*>(a + 32 * 256);
        p0 = __builtin_amdgcn_mfma_f32_32x32x16_bf16(b0, qr[d0], p0, 0, 0, 0);
        p1 = __builtin_amdgcn_mfma_f32_32x32x16_bf16(b1, qr[d0], p1, 0, 0, 0); }
}
template <int VB>
__device__ __forceinline__ void pv_tile(f32x16* o, int vb0, bf16x8 pa0, bf16x8 pa1, bf16x8 pa2, bf16x8 pa3) {
#define TRRD(dst, off) asm volatile("ds_read_b64_tr_b16 %0, %1 offset:%2" : "=&v"(dst) : "v"(vb0), "i"(off) : "memory")
#define PV_D0(d0) do { s16x4 l0, l1, l2, l3, h0, h1, h2, h3; constexpr int b_ = VB * SHM_V + v_rd_off(d0, 0, 0); \
        TRRD(l0, b_); TRRD(h0, b_ + 2048); TRRD(l1, b_ + 4096); TRRD(h1, b_ + 6144); TRRD(l2, b_ + 8192); TRRD(h2, b_ + 10240); TRRD(l3, b_ + 12288); TRRD(h3, b_ + 14336); \
        asm volatile("s_waitcnt lgkmcnt(0)" ::: "memory"); SBAR();   \
        o[d0] = __builtin_amdgcn_mfma_f32_32x32x16_bf16(pa0, (bf16x8){l0[0], l0[1], l0[2], l0[3], h0[0], h0[1], h0[2], h0[3]}, o[d0], 0, 0, 0);   \
        o[d0] = __builtin_amdgcn_mfma_f32_32x32x16_bf16(pa1, (bf16x8){l1[0], l1[1], l1[2], l1[3], h1[0], h1[1], h1[2], h1[3]}, o[d0], 0, 0, 0);   \
        o[d0] = __builtin_amdgcn_mfma_f32_32x32x16_bf16(pa2, (bf16x8){l2[0], l2[1], l2[2], l2[3], h2[0], h2[1], h2[2], h2[3]}, o[d0], 0, 0, 0);   \
        o[d0] = __builtin_amdgcn_mfma_f32_32x32x16_bf16(pa3, (bf16x8){l3[0], l3[1], l3[2], l3[3], h3[0], h3[1], h3[2], h3[3]}, o[d0], 0, 0, 0); } while (0)
    PV_D0(0); PV_D0(1); PV_D0(2); PV_D0(3);
#undef PV_D0
#undef TRRD
}
struct BlockRef { const bf16* Q; const bf16* K; const bf16* V; float* O; int P0; int hm; };
struct Seam { bf16x8 qr[8]; bf16x8 st_v0, st_v1, st_k0, st_k1; };
#define ROW(p, k0, rr) ((p) + (size_t)((k0) + (rr)) * D + sc)
#define VMW() asm volatile("s_waitcnt vmcnt(0)" ::: "memory")
#define VMWN(n) asm volatile("s_waitcnt vmcnt(%0)" :: "i"(n) : "memory")
#define SLOAD_H(Kp, Vp, k0) do { S.st_v0 = load8(ROW(Vp, k0, sr)); S.st_v1 = load8(ROW(Vp, k0, 32 + sr));              \
                         S.st_k0 = load8(ROW(Kp, k0, sr)); S.st_k1 = load8(ROW(Kp, k0, 32 + sr)); } while (0)
#define SWRITE_HK(bf) do { *(bf16x8*)(K_lds + (bf) * SHM_K + kws) = S.st_k0; *(bf16x8*)(K_lds + (bf) * SHM_K + kws + 32 * 256) = S.st_k1; } while (0)
#define SWRITE_HV(bf) do { *(bf16x8*)(V_lds + (bf) * SHM_V + vst0) = S.st_v0; *(bf16x8*)(V_lds + (bf) * SHM_V + vst1) = S.st_v1; } while (0)
#define SWRITE_H(bf) do { SWRITE_HV(bf); SWRITE_HK(bf); } while (0)
__device__ __forceinline__ void attn_prime(const BlockRef& cur, char* lds, Seam& S) {
    const int tid = ltid(), wid = __builtin_amdgcn_readfirstlane(tid >> 6), lane = tid & 63, r32 = lane & 31, hi = lane >> 5;
    const int sr = tid >> 4, sc = (tid & 15) * 8, kws = KSWZ(sr, sc * 2); char* K_lds = lds + 2 * SHM_V;
    const int kb0 = 0;
    for (int d0 = 0; d0 < 8; ++d0) S.qr[d0] = load8(cur.Q + (size_t)(wid * QBLK + r32) * D + d0 * 16 + hi * 8);
    SLOAD_H(cur.K, cur.V, kb0); VMW(); SWRITE_HK(0);
    __syncthreads();
}
__device__ __forceinline__ void attn_block(const BlockRef& cur, const BlockRef& nxt, char* lds, Seam& S) {
    const int tid = ltid(), wid = __builtin_amdgcn_readfirstlane(tid >> 6), lane = tid & 63, r32 = lane & 31, hi = lane >> 5;
    const int j_lo = 0;
    const int j_hi = (cur.P0 + QB - 1) / KVBLK + 1;
    const int NT = j_hi - j_lo;
    const int kbn = 0;
    const int qlo = cur.P0 + wid * QBLK, qm = qlo + r32 - 4 * hi;
    char* V_lds = lds; char* K_lds = lds + 2 * SHM_V;
    float* ws = (float*)(lds + 2 * SHM_V + 2 * SHM_K) + wid * 64; float* li_l = ws, * al_l = ws + 32;
    const float* bt = (const float*)(lds + BT_OFF) + cur.hm * 256;
    float m_reg = -1e30f, l_reg = 0; f32x16 o[4] = {};
    const int sr = tid >> 4, sc = (tid & 15) * 8, vst0 = v_st(sr, sc), vst1 = v_st(32 + sr, sc), kws = KSWZ(sr, sc * 2);
    const int vb0 = (int)(uintptr_t)V_lds + v_rd_base(lane);
    const bf16* Kh = cur.K; const bf16* Vh = cur.V;
#define RESC(a) do { if (__any((a) < 1.f)) { if (hi == 0) al_l[r32] = (a); asm volatile("s_waitcnt lgkmcnt(0)" ::: "memory");              \
                     for (int d_ = 0; d_ < 4; ++d_) for (int r = 0; r < 16; ++r) o[d_][r] *= al_l[crow(r, hi)]; } } while (0)
#define KBASE(t) ((j_lo + (t)) * KVBLK)
#define MASKT(P0_, P1_, t) do { const int kb_ = KBASE(t); if (kb_ + KVBLK - 1 > qlo - 128) bias_mask_tile(P0_, P1_, qm - kb_, bt); } while (0)
    constexpr int NQL = 8;
#define SEAM_K0() do { VMWN(NQL); SWRITE_HK(0); SBAR(); } while (0)
    f32x16 pA0, pA1, pB0, pB1; float mnA, mnB, alA, alB; bf16x8 pa0, pa1, pa2, pa3;
    SWRITE_HV(0); SBAR();
    if (NT > 1) { SLOAD_H(Kh, Vh, KBASE(1)); }
    SBAR(); qkt<0>(pA0, pA1, K_lds, r32, hi, S.qr);
    MASKT(pA0, pA1, 0); partialSM(pA0, pA1, m_reg, mnA, alA);
    if (NT > 1) { VMW(); SWRITE_H(1); }
    __syncthreads();
#define HALF_STEP(PX0, PX1, mnX, alX, PY0, PY1, alY, t, KB, VB, SB) do {                                                      \
        SBAR(); qkt<KB>(PX0, PX1, K_lds, r32, hi, S.qr);                                             \
        finishSM(PY0, PY1, alY, l_reg, pa0, pa1, pa2, pa3); SBAR();                                                           \
        if ((t) + 1 < NT) { SLOAD_H(Kh, Vh, KBASE((t) + 1)); SBAR(); }                                               \
        pv_tile<VB>(o, vb0, pa0, pa1, pa2, pa3); MASKT(PX0, PX1, (t)); partialSM(PX0, PX1, m_reg, mnX, alX);                                        \
        __syncthreads();                                                                                                      \
        if ((t) + 1 < NT) { VMW(); SWRITE_H(SB); }                                                                          \
        RESC(alX); __syncthreads(); } while (0)
    for (int t = 1; t + 1 < NT; t += 2) {
        HALF_STEP(pB0, pB1, mnB, alB, pA0, pA1, alA, t, 1, 0, 0);
        HALF_STEP(pA0, pA1, mnA, alA, pB0, pB1, alB, t + 1, 0, 1, 1);
    }
    const bool even = (NT & 1) == 0;
    if (even) { SBAR(); qkt<1>(pB0, pB1, K_lds, r32, hi, S.qr); SBAR(); }
    SLOAD_H(nxt.K, nxt.V, kbn); SBAR();
#pragma unroll
    for (int d0 = 0; d0 < 8; ++d0) S.qr[d0] = load8(nxt.Q + (size_t)(wid * QBLK + r32) * D + d0 * 16 + hi * 8);
    SBAR();
    finishSM(pA0, pA1, alA, l_reg, pa0, pa1, pa2, pa3); SBAR();
    pv_tile<0>(o, vb0, pa0, pa1, pa2, pa3);
    if (even) { MASKT(pB0, pB1, NT - 1); partialSM(pB0, pB1, m_reg, mnB, alB); __syncthreads(); RESC(alB);
        finishSM(pB0, pB1, alB, l_reg, pa0, pa1, pa2, pa3); SBAR(); pv_tile<1>(o, vb0, pa0, pa1, pa2, pa3); }
    SBAR(); SEAM_K0();
    if (hi == 0) li_l[r32] = l_reg; asm volatile("s_waitcnt lgkmcnt(0)" ::: "memory");
    float rli[16];
#pragma unroll
    for (int r = 0; r < 16; ++r) rli[r] = __builtin_amdgcn_rcpf(li_l[crow(r, hi)]);
    float* Ow = cur.O + (size_t)(wid * QBLK) * D;
#pragma unroll
    for (int r = 0; r < 16; ++r) { const int orow = crow(r, hi);
#pragma unroll
        for (int d0 = 0; d0 < 4; ++d0) { const float v = o[d0][r] * rli[r]; Ow[(size_t)orow * D + d0 * 32 + r32] = v; } }
    __syncthreads();
#undef RESC
#undef KBASE
#undef MASKT
#undef SEAM_K0
#undef HALF_STEP
}
#undef ROW
#undef VMW
#undef VMWN
#undef SLOAD_H
#undef SWRITE_HK
#undef SWRITE_HV
#undef SWRITE_H
}

namespace att2 {
using att::bf16; using att::D; using att::SHM_K; using att::SHM_V;
constexpr int L_V = 0, L_K = 65536, L_P = 98304, L_AL = 131072, L_FL = 132096, L_LB = 132224, L_BT = 133120;
struct Blk { const bf16* Q; const bf16* K; const bf16* V0; const bf16* V1; float* O0; float* O1; int P0; int hm; };
__device__ __forceinline__ void qkt_rt(f32x16& p0, f32x16& p1, const char* Kb, int r32, int hi, const bf16x8* qr) {
    p0 = f32x16{}; p1 = f32x16{};
    const char* kb[4];
#pragma unroll
    for (int dd = 0; dd < 4; ++dd) kb[dd] = Kb + KSWZ(r32, (dd * 16 + hi * 8) * 2);
#pragma unroll
    for (int d0 = 0; d0 < 8; ++d0) { const char* a = kb[d0 & 3] + (d0 >> 2) * 128;
        bf16x8 b0 = *reinterpret_cast<const bf16x8*>(a);
        bf16x8 b1 = *reinterpret_cast<const bf16x8*>(a + 32 * 256);
        p0 = __builtin_amdgcn_mfma_f32_32x32x16_bf16(b0, qr[d0], p0, 0, 0, 0);
        p1 = __builtin_amdgcn_mfma_f32_32x32x16_bf16(b1, qr[d0], p1, 0, 0, 0); }
}
#define A2_LOADT(t) do { const size_t ro_ = (size_t)((t) * 64 + sr) * D + sc; \
        sk0 = att::load8(c.K + ro_); sk1 = att::load8(c.K + ro_ + 32 * D); sv00 = att::load8(c.V0 + ro_); sv01 = att::load8(c.V0 + ro_ + 32 * D); sv10 = att::load8(c.V1 + ro_); sv11 = att::load8(c.V1 + ro_ + 32 * D); } while (0)
#define A2_WRITET(buf) do { char* kd_ = lds + L_K + (buf) * SHM_K; char* vd_ = lds + L_V + (buf) * 2 * SHM_V; \
        *(bf16x8*)(kd_ + kws) = sk0; *(bf16x8*)(kd_ + kws + 32 * 256) = sk1; *(bf16x8*)(vd_ + vst0) = sv00; *(bf16x8*)(vd_ + vst1) = sv01; *(bf16x8*)(vd_ + SHM_V + vst0) = sv10; *(bf16x8*)(vd_ + SHM_V + vst1) = sv11; } while (0)
__device__ __forceinline__ void attn2_block(const Blk& c, char* lds) {
    const int tid = ltid(), wid = __builtin_amdgcn_readfirstlane(tid >> 6), lane = tid & 63, r32 = lane & 31, hi = lane >> 5;
    const int g = wid & 3;
    const int NT = (c.P0 + 127) / 64 + 1;
    const int sr = tid >> 4, sc = (tid & 15) * 8, kws = KSWZ(sr, sc * 2), vst0 = att::v_st(sr, sc), vst1 = att::v_st(32 + sr, sc);
    bf16x8 sk0, sk1, sv00, sv01, sv10, sv11;
    float* ALb = (float*)(lds + L_AL) + g * 64; unsigned* FLb = (unsigned*)(lds + L_FL) + g * 2; float* LBb = (float*)(lds + L_LB) + g * 32;
    char* Pb = lds + L_P + g * 8192;
    A2_LOADT(0);
    if (wid < 4) {
        bf16x8 qr[8];
#pragma unroll
        for (int d0 = 0; d0 < 8; ++d0) qr[d0] = att::load8(c.Q + (size_t)(g * 32 + r32) * D + d0 * 16 + hi * 8);
        asm volatile("s_waitcnt vmcnt(0)" ::: "memory"); A2_WRITET(0); __syncthreads();
        const int qlo = c.P0 + g * 32, qm = qlo + r32 - 4 * hi;
        const float* bt = (const float*)(lds + L_BT) + c.hm * 256;
        float m_reg = -1e30f, l_reg = 0.f;
        for (int s = 0; s <= NT; ++s) {
            const int par = s & 1;
            if (s + 1 < NT) A2_LOADT(s + 1);
            SBAR();
            if (s < NT) {
                f32x16 p0, p1; float mn, al; bf16x8 pa0, pa1, pa2, pa3;
                qkt_rt(p0, p1, lds + L_K + par * SHM_K, r32, hi, qr);
                const int kb_ = s * 64;
                if (kb_ + 63 > qlo - 128) att::bias_mask_tile(p0, p1, qm - kb_, bt);
                att::partialSM(p0, p1, m_reg, mn, al);
                att::finishSM(p0, p1, al, l_reg, pa0, pa1, pa2, pa3);
                char* pw = Pb + par * 4096 + lane * 16;
                *(bf16x8*)(pw) = pa0; *(bf16x8*)(pw + 1024) = pa1; *(bf16x8*)(pw + 2048) = pa2; *(bf16x8*)(pw + 3072) = pa3;
                if (hi == 0) ALb[par * 32 + r32] = al;
                const bool resc = __any(al < 1.f);
                if (lane == 0) FLb[par] = resc ? 1u : 0u;
            }
            __syncthreads();
            if (s + 1 < NT) { asm volatile("s_waitcnt vmcnt(0)" ::: "memory"); A2_WRITET((s + 1) & 1); }
            __syncthreads();
        }
        if (hi == 0) LBb[r32] = l_reg;
        __syncthreads();
        __syncthreads();
    } else {
        asm volatile("s_waitcnt vmcnt(0)" ::: "memory"); A2_WRITET(0); __syncthreads();
        f32x16 o[8];
#pragma unroll
        for (int d_ = 0; d_ < 8; ++d_) o[d_] = f32x16{};
        const int vbase = (int)(uintptr_t)(lds + L_V) + att::v_rd_base(lane);
        for (int s = 0; s <= NT; ++s) {
            if (s + 1 < NT) A2_LOADT(s + 1);
            SBAR();
            if (s >= 1) {
                const int par = (s - 1) & 1;
                const unsigned fl = (unsigned)__builtin_amdgcn_readfirstlane((int)FLb[par]);
                if (fl) {
#pragma unroll
                    for (int r = 0; r < 16; ++r) { const float a = ALb[par * 32 + att::crow(r, hi)];
#pragma unroll
                        for (int d_ = 0; d_ < 8; ++d_) o[d_][r] *= a; } }
                const char* pr = Pb + par * 4096 + lane * 16;
                const bf16x8 pa0 = *(const bf16x8*)(pr), pa1 = *(const bf16x8*)(pr + 1024), pa2 = *(const bf16x8*)(pr + 2048), pa3 = *(const bf16x8*)(pr + 3072);
                const int vb = vbase + par * 2 * SHM_V;
                att::pv_tile<0>(o, vb, pa0, pa1, pa2, pa3);
                att::pv_tile<0>(o + 4, vb + SHM_V, pa0, pa1, pa2, pa3);
            }
            __syncthreads();
            if (s + 1 < NT) { asm volatile("s_waitcnt vmcnt(0)" ::: "memory"); A2_WRITET((s + 1) & 1); }
            __syncthreads();
        }
        __syncthreads();
        float rli[16];
#pragma unroll
        for (int r = 0; r < 16; ++r) rli[r] = __builtin_amdgcn_rcpf(LBb[att::crow(r, hi)]);
#pragma unroll
        for (int hf = 0; hf < 2; ++hf) { float* Ow = (hf ? c.O1 : c.O0) + (size_t)(g * 32) * D;
#pragma unroll
            for (int r = 0; r < 16; ++r) { const int orow = att::crow(r, hi);
#pragma unroll
                for (int d0 = 0; d0 < 4; ++d0) Ow[(size_t)orow * D + d0 * 32 + r32] = o[hf * 4 + d0][r] * rli[r]; } }
        __syncthreads();
    }
}
#undef A2_LOADT
#undef A2_WRITET
}


#define XB_TMO      128
#define XB_XCNT(j)  (256  + 64 * (j))
#define XB_XSUB(j)  (1280 + 64 * (j))
#define XB_XGEN(j)  (2304 + 64 * (j))
#define XB_TOP      3328
#define XB_TOPGEN   3392
#define XCD_BAR_WORDS 3456
#define XB_SPIN_CAP (1u << 18)
__device__ __forceinline__ unsigned xb_ld(unsigned* p)              { return __hip_atomic_load(p, __ATOMIC_RELAXED, __HIP_MEMORY_SCOPE_AGENT); }
__device__ __forceinline__ unsigned xb_add(unsigned* p, unsigned v) { return __hip_atomic_fetch_add(p, v, __ATOMIC_RELAXED, __HIP_MEMORY_SCOPE_AGENT); }
__device__ __forceinline__ unsigned xb_xcc_id() { return (unsigned)__builtin_amdgcn_s_getreg((3 << 11) | 20) & 0xFu; }
#define XB_SPIN(cond, bar) do { unsigned _sp = 0; while (cond) { __builtin_amdgcn_s_sleep(1); \
    if ((++_sp & 255u) == 0u) { if (xb_ld(&(bar)[XB_TMO])) break; if (_sp > XB_SPIN_CAP) { atomicAdd(&(bar)[XB_TMO], 1u); break; } } } } while (0)
struct XcdBarrier { unsigned* bar; unsigned x; volatile LAS unsigned* st; };
__device__ __forceinline__ XcdBarrier xcd_barrier_post(unsigned* bar, volatile LAS unsigned* st) {
    XcdBarrier b; b.bar = bar; b.x = xb_xcc_id(); b.st = st;
    if (threadIdx.x == 0) (void)xb_add(&bar[XB_XCNT(b.x)], 1u);
    return b;
}
__device__ __forceinline__ void xcd_barrier_complete(unsigned* bar, unsigned x, unsigned& nloc, unsigned& nx) {
    const unsigned G = gridDim.x * gridDim.y * gridDim.z;
    unsigned sum, cnt, mine, sp = 0u;
    for (;;) {
        sum = 0u; cnt = 0u; mine = 0u;
#pragma unroll
        for (unsigned j = 0; j < 16; ++j) { const unsigned c = xb_ld(&bar[XB_XCNT(j)]); sum += c; cnt += (c > 0u) ? 1u : 0u; mine = (j == x) ? c : mine; }
        if (sum == G) break;
        __builtin_amdgcn_s_sleep(1);
        if ((++sp & 255u) == 0u) { if (xb_ld(&bar[XB_TMO])) break; if (sp > XB_SPIN_CAP) { atomicAdd(&bar[XB_TMO], 1u); break; } }
    }
    nloc = mine > 0u ? mine : 1u; nx = cnt > 0u ? cnt : 1u;
}
__device__ __forceinline__ void xcd_barrier(const XcdBarrier& b) {
    asm volatile("s_waitcnt vmcnt(0)" ::: "memory");
    __syncthreads();
    if (threadIdx.x == 0) {
        unsigned* bar = b.bar;
        __builtin_amdgcn_s_waitcnt(0);
        unsigned nloc = b.st[0], nx = b.st[1];
        if (nloc == 0u) { xcd_barrier_complete(bar, b.x, nloc, nx); b.st[0] = nloc; b.st[1] = nx; }
        const unsigned old = xb_add(&bar[XB_XSUB(b.x)], 1u);
        const unsigned gen = old / nloc;
        if (old + 1u == (gen + 1u) * nloc) {
            __builtin_amdgcn_fence(__ATOMIC_RELEASE, "agent");
            asm volatile("s_waitcnt vmcnt(0)" ::: "memory");
            const unsigned og = xb_add(&bar[XB_TOP], 1u);
            const unsigned tg = og / nx;
            if (og + 1u == (tg + 1u) * nx) xb_add(&bar[XB_TOPGEN], 1u);
            else XB_SPIN(xb_ld(&bar[XB_TOPGEN]) == tg, bar);
            __builtin_amdgcn_fence(__ATOMIC_ACQUIRE, "agent");
            xb_add(&bar[XB_XGEN(b.x)], 1u);
            asm volatile("s_waitcnt vmcnt(0)" ::: "memory");
        } else {
            XB_SPIN(xb_ld(&bar[XB_XGEN(b.x)]) == gen, bar);
            __builtin_amdgcn_fence(__ATOMIC_ACQUIRE, "agent");
            asm volatile("s_waitcnt vmcnt(0)" ::: "memory");
        }
    }
    __syncthreads();
}

struct Args { const float* in[24]; float* out; unsigned char* ws; };

__device__ __forceinline__ void p0_transpose_item(const float* W, int K, int N, bf16_t* WT, int swiglu, const float* gk, const float* bk, float* c1, float* c2, LAS float* scr, int item, int lane) {
    const int nblk = N / 64, kb = item / nblk, nb = item % nblk, k0 = 64 * kb, n0 = 64 * nb;
    const float* src = W + (size_t)(k0 + (lane >> 4)) * N + n0 + (lane & 15) * 4;
    f32x4 v[16];
#pragma unroll
    for (int i = 0; i < 16; ++i) v[i] = __builtin_nontemporal_load((const f32x4*)(src + (size_t)(4 * i) * N));
#pragma unroll
    for (int i = 0; i < 16; ++i) { LAS float* d = scr + (4 * i + (lane >> 4)) * 65 + (lane & 15) * 4; d[0] = v[i][0]; d[1] = v[i][1]; d[2] = v[i][2]; d[3] = v[i][3]; }
    asm volatile("s_waitcnt lgkmcnt(0)" ::: "memory");
    int r0 = n0;
    if (swiglu) { const int half = n0 / DFF, idx = n0 % DFF; r0 = 256 * (idx / 128) + 128 * half + (idx % 128); }
    const int c = lane & 7;
    float g8[8], b8[8];
#pragma unroll
    for (int e = 0; e < 8; ++e) { g8[e] = gk ? gk[k0 + 8 * c + e] : 1.f; b8[e] = gk ? bk[k0 + 8 * c + e] : 0.f; }
#pragma unroll
    for (int j = 0; j < 8; ++j) { const int n = (lane >> 3) + 8 * j; const LAS float* q = scr + (8 * c) * 65 + n;
        float w8[8];
#pragma unroll
        for (int e = 0; e < 8; ++e) w8[e] = q[e * 65];
        u32x4 o; o.x = cvt_pk_bf16(w8[0] * g8[0], w8[1] * g8[1]); o.y = cvt_pk_bf16(w8[2] * g8[2], w8[3] * g8[3]); o.z = cvt_pk_bf16(w8[4] * g8[4], w8[5] * g8[5]); o.w = cvt_pk_bf16(w8[6] * g8[6], w8[7] * g8[7]);
        *(u32x4*)(WT + (size_t)(r0 + n) * K + k0 + 8 * c) = o;
        if (gk) {
            float s1 = ((bf_lo(o.x) + bf_hi(o.x)) + (bf_lo(o.y) + bf_hi(o.y))) + ((bf_lo(o.z) + bf_hi(o.z)) + (bf_lo(o.w) + bf_hi(o.w)));
            float s2 = ((w8[0] * b8[0] + w8[1] * b8[1]) + (w8[2] * b8[2] + w8[3] * b8[3])) + ((w8[4] * b8[4] + w8[5] * b8[5]) + (w8[6] * b8[6] + w8[7] * b8[7]));
            s1 += __shfl_xor(s1, 1); s1 += __shfl_xor(s1, 2); s1 += __shfl_xor(s1, 4); s2 += __shfl_xor(s2, 1); s2 += __shfl_xor(s2, 2); s2 += __shfl_xor(s2, 4);
            if (c == 0) { unsafeAtomicAdd(c1 + r0 + n, s1); unsafeAtomicAdd(c2 + r0 + n, s2); }
        } }
    asm volatile("s_waitcnt lgkmcnt(0)" ::: "memory");
}

__device__ __forceinline__ void p0_wq_item(const float* W, bf16_t* WN, const float* gk, const float* bk, float* bW, int item, int lane) {
    const int kb = item >> 5, jb = item & 31, k0 = 64 * kb, j0 = 64 * jb, cg8 = lane & 7, kr = lane >> 3;
    float sacc[8];
#pragma unroll
    for (int e = 0; e < 8; ++e) sacc[e] = 0.f;
#pragma unroll
    for (int i = 0; i < 8; ++i) { const int k = k0 + 8 * i + kr; const float* src = W + (size_t)k * DM + j0 + 8 * cg8;
        const f32x4 v0 = __builtin_nontemporal_load((const f32x4*)src), v1 = __builtin_nontemporal_load((const f32x4*)(src + 4)); const float g = gk[k], bb = bk[k];
        u32x4 o; o.x = cvt_pk_bf16(v0[0] * g, v0[1] * g); o.y = cvt_pk_bf16(v0[2] * g, v0[3] * g); o.z = cvt_pk_bf16(v1[0] * g, v1[1] * g); o.w = cvt_pk_bf16(v1[2] * g, v1[3] * g);
        *(u32x4*)(WN + (size_t)k * DM + j0 + 8 * cg8) = o;
#pragma unroll
        for (int e = 0; e < 4; ++e) { sacc[e] += bb * v0[e]; sacc[4 + e] += bb * v1[e]; } }
#pragma unroll
    for (int e = 0; e < 8; ++e) { float v = sacc[e]; v += __shfl_xor(v, 8); v += __shfl_xor(v, 16); v += __shfl_xor(v, 32); if (kr == 0) unsafeAtomicAdd(bW + j0 + 8 * cg8 + e, v); }
}

__device__ __forceinline__ int causal_bucket(int n) {
    if (n < 16) return n;
    const float nf = (float)n;
    int large = 16 + (int)(logf(nf / 16.f) / 2.0794415416798357f * 16.f);
    return large < 31 ? large : 31;
}

__device__ __forceinline__ size_t zero_opaque() { size_t z = 0; asm volatile("" : "+s"(z)); return z; }
__device__ __forceinline__ const float* inp_ptr(const Args& a, int k) { return a.in[k] + zero_opaque(); }
#define INP(k) inp_ptr(a, k)
__device__ __forceinline__ unsigned char* ws_opaque(const Args& a) { return a.ws + zero_opaque(); }
__device__ __forceinline__ float* out_opaque(const Args& a) { return a.out + zero_opaque(); }
#define WSP(type, off) ((type*)(ws_opaque(a) + (off)))
__global__ void __launch_bounds__(NTHR, 2) mega_fwd(Args a) {
    extern __shared__ __attribute__((aligned(16))) unsigned char lds[];
    volatile LAS unsigned* bst = (volatile LAS unsigned*)((LAS unsigned char*)lds + LDS_BYTES - 64);
    if (threadIdx.x == 0) { bst[0] = 0u; bst[1] = 0u; }
    __syncthreads();
    (void)xcd_barrier_post((unsigned*)(a.ws + WS_BAR), bst);
#define GRID_BAR() do { XcdBarrier xb_; xb_.bar = (unsigned*)(ws_opaque(a) + WS_BAR); unsigned x_ = xb_xcc_id(); asm volatile("" : "+s"(x_)); xb_.x = x_; xb_.st = bst; xcd_barrier(xb_); } while (0)
    const int G = gridDim.x;
    const int NGW = G * NWAVES, NGT = G * NTHR;
    {
        PH_IDS;
        unsigned char* ws = ws_opaque(a);
        float* lamp = (float*)(ws + WS_LAM); float* btab = (float*)(ws + WS_BTAB); bf16_t* wtril = (bf16_t*)(ws + WS_WTRIL); bf16_t* membf = (bf16_t*)(ws + WS_MEMBF); bf16_t* XN = (bf16_t*)(ws + WS_XN);
        LAS float* scr = (LAS float*)((LAS unsigned char*)lds + wave * 17408);
        constexpr int I_IN = 32 * 88, I_SQ = 32 * 32, I_KV = 32 * 64, I_GU = 32 * 176, I_D = 88 * 32;
        constexpr int PER_LAYER = I_IN + 3 * I_SQ + I_KV + I_GU + I_D;
        for (int it = gw; it < 2 * PER_LAYER; it += NGW) {
            const int l = it / PER_LAYER; int r = it % PER_LAYER;
            unsigned char* wl = ws + WS_W + (size_t)l * W_LAYER;
            float* cl = (float*)(ws + WS_C) + (size_t)l * C_LAYER;
            if (r < I_IN) { const bool f = l > 0;
                p0_transpose_item(INP(3) + (size_t)l * DM * INC, DM, INC, (bf16_t*)(wl + W_IN), 0, f ? INP(22) : nullptr, f ? INP(23) : nullptr, cl + C_IN, cl + C_IN + INC, scr, r, lane); continue; } r -= I_IN;
            if (r < I_SQ) { p0_transpose_item(INP(12) + (size_t)l * DM * DM, DM, DM, (bf16_t*)(wl + W_OUT), 0, nullptr, nullptr, nullptr, nullptr, scr, r, lane); continue; } r -= I_SQ;
            if (r < I_SQ) { p0_wq_item(INP(15) + (size_t)l * DM * DM, (bf16_t*)(wl + W_Q), INP(13) + (size_t)l * DM, INP(14) + (size_t)l * DM, cl + C_Q + DM, r, lane); continue; } r -= I_SQ;
            if (r < I_KV) { p0_transpose_item(INP(16) + (size_t)l * DM * 2 * DM, DM, 2 * DM, (bf16_t*)(wl + W_KV), 0, nullptr, nullptr, nullptr, nullptr, scr, r, lane); continue; } r -= I_KV;
            if (r < I_SQ) { p0_transpose_item(INP(17) + (size_t)l * DM * DM, DM, DM, (bf16_t*)(wl + W_O), 0, nullptr, nullptr, nullptr, nullptr, scr, r, lane); continue; } r -= I_SQ;
            if (r < I_GU) { p0_transpose_item(INP(20) + (size_t)l * DM * 2 * DFF, DM, 2 * DFF, (bf16_t*)(wl + W_GU), 1, INP(18) + (size_t)l * DM, INP(19) + (size_t)l * DM, cl + C_GU, cl + C_GU + 2 * DFF, scr, r, lane); continue; } r -= I_GU;
            p0_transpose_item(INP(21) + (size_t)l * DFF * DM, DFF, DM, (bf16_t*)(wl + W_D), 0, nullptr, nullptr, nullptr, nullptr, scr, r, lane);
        }
        for (size_t i = gt; i < (size_t)T * DM / 8; i += (size_t)4 * NGT) {
            f32x4 v0[4], v1[4];
#pragma unroll
            for (int q = 0; q < 4; ++q) { const float* xp = INP(0) + (i + (size_t)q * NGT) * 8; v0[q] = __builtin_nontemporal_load((const f32x4*)xp); v1[q] = __builtin_nontemporal_load((const f32x4*)(xp + 4)); }
#pragma unroll
            for (int q = 0; q < 4; ++q) { u32x4 w; w.x = cvt_pk_bf16(v0[q][0], v0[q][1]); w.y = cvt_pk_bf16(v0[q][2], v0[q][3]); w.z = cvt_pk_bf16(v1[q][0], v1[q][1]); w.w = cvt_pk_bf16(v1[q][2], v1[q][3]);
                *(u32x4*)(XN + (i + (size_t)q * NGT) * 8) = w; }
        }
        for (size_t i = gt; i < (size_t)BATCH * NMEM * DM / 8; i += NGT) {
            const f32x4 v0 = *(const f32x4*)(INP(1) + i * 8), v1 = *(const f32x4*)(INP(1) + i * 8 + 4);
            u32x4 w; w.x = cvt_pk_bf16(v0[0], v0[1]); w.y = cvt_pk_bf16(v0[2], v0[3]); w.z = cvt_pk_bf16(v1[0], v1[1]); w.w = cvt_pk_bf16(v1[2], v1[3]);
            *(u32x4*)(membf + i * 8) = w;
        }
        for (int i = gt; i < DEPTH * 4 * 128 * 128; i += NGT) { const int s = i & 127, t = (i >> 7) & 127; wtril[i] = s <= t ? f2bf(INP(7)[i]) : (bf16_t)0; }
        if (gt < 8 * 256) { const int hm = gt >> 8, d = gt & 255; const float* rb = INP(2);
            btab[gt] = (rb[causal_bucket(d) * 8 + hm] - rb[31 * 8 + hm]) * (1.f / att::SCALE); }
        if (cu == 0 && wave == 0) {
            for (int l = 0; l < DEPTH; ++l) {
                const float* lq = INP(9) + l * 256; const float* lk = INP(10) + l * 256;
                float s0 = lq[lane] * lk[lane] + lq[lane + 64] * lk[lane + 64];
                float s1 = lq[128 + lane] * lk[128 + lane] + lq[192 + lane] * lk[192 + lane];
                s0 = wave_sum(s0); s1 = wave_sum(s1);
                const float lam_init = 0.8f - 0.6f * expf(-0.3f * (float)l);
                if (lane == 0) lamp[l] = expf(s0) - expf(s1) + lam_init;
            }
        }
    }
    GRID_BAR();

#pragma unroll 1
    for (int l = 0; l < DEPTH; ++l) {
        {
            unsigned char* ws = ws_opaque(a);
            pg8::Gemm g{(const bf16_t*)(ws + WS_XN), (const bf16_t*)(ws + WS_W + (size_t)l * W_LAYER + W_IN), DM, DM, DM, 1, 0, 0, 0, 0};
            pg8::Order S; S.init(T, INC, 1, G, cu_opaque());
            const float* cl = (const float*)(ws + WS_C) + (size_t)l * C_LAYER;
            const float* st = l > 0 ? (const float*)(ws + WS_ST) + (size_t)(3 * l - 1) * T * 2 : nullptr;
            pg8::EpiSplit E{(bf16_t*)(ws + WS_PROJ), st, cl + C_IN, cl + C_IN + INC, (float*)(ws + WS_ST) + (size_t)(6 + l) * T * 2};
            pg8::gemm_phase<pg8::EpiSplit, true>((LAS unsigned char*)lds, g, S, E);
        }
        if (l == 0) {
            {
                unsigned char* ws = ws_opaque(a);
                pg8::Gemm g{(const bf16_t*)(ws + WS_MEMBF), (const bf16_t*)(ws + WS_W + W_KV), DM, DM, DM, 1, 0, 0, (long)(W_LAYER / 2), 0};
                pg8::Order S; const int cu = cu_opaque(); S.init(BATCH * NMEM, 2 * DM, 2, G, cu >= 128 && cu < 192 ? cu - 128 : -1);
                pg8::EpiBf16 E{(bf16_t*)(ws + WS_KV), 2 * DM, 1, (long)(BATCH * NMEM) * 2 * DM, 0, 1.f, nullptr, nullptr, nullptr, nullptr};
                pg8::gemm_phase<pg8::EpiBf16, true>((LAS unsigned char*)lds, g, S, E);
            }
        }
        GRID_BAR();

        if (l == 0) {
#pragma unroll 1
            for (int L2 = 0; L2 < DEPTH; ++L2) {
                {
                    unsigned char* ws = ws_opaque(a); unsigned char* wl2 = ws + WS_W + (size_t)L2 * W_LAYER;
                    const bf16_t* KVl = (const bf16_t*)(ws + WS_KV) + (size_t)L2 * BATCH * NMEM * 2 * DM;
                    float* cl = (float*)(ws + WS_C) + (size_t)L2 * C_LAYER;
                    pg8::Gemm g{KVl, (const bf16_t*)(wl2 + W_Q), 2 * DM, DM, 512, 4, (long)NMEM * 2 * DM, 512, 0, 512};
                    pg8::Order S; const int cu = cu_opaque(); S.init(NMEM, DM, 8, G, cu >= 64 * L2 && cu < 64 * L2 + 64 ? cu - 64 * L2 : -1);
                    pg8::EpiBf16 E{(bf16_t*)(wl2 + W_KV), DM, 1, (long)NMEM * DM, 0, 1.f, nullptr, nullptr, nullptr, cl + C_Q};
                    pg8::gemm_phase<pg8::EpiBf16, true>((LAS unsigned char*)lds, g, S, E);
                }
                {
                    unsigned char* ws = ws_opaque(a); unsigned char* wl2 = ws + WS_W + (size_t)L2 * W_LAYER;
                    const bf16_t* KVl = (const bf16_t*)(ws + WS_KV) + (size_t)L2 * BATCH * NMEM * 2 * DM;
                    pg8::Gemm g{(const bf16_t*)(wl2 + W_O), KVl + DM, DM, 2 * DM, 512, 4, 0, 512, (long)NMEM * 2 * DM, 512};
                    pg8::Order S; const int cu = cu_opaque(); S.init(DM, NMEM, 8, G, cu >= 128 + 64 * L2 && cu < 192 + 64 * L2 ? cu - 128 - 64 * L2 : -1);
                    pg8::EpiBf16 E{(bf16_t*)(wl2 + W_KV + 8 * MiB), 1024, 4, (long)DM * 1024, 256, 1.f, nullptr, nullptr, nullptr, nullptr};
                    pg8::gemm_phase<pg8::EpiBf16, true>((LAS unsigned char*)lds, g, S, E);
                }
            }
            {
                PH_IDS;
                unsigned char* ws = ws_opaque(a);
                for (int it = gw; it < DEPTH * 2048; it += NGW) {
                    const int L2 = it >> 11, r = it & 2047, b = r >> 10, h = (r >> 8) & 3, n = r & 255;
                    const bf16_t* kp = (const bf16_t*)(ws + WS_KV) + ((size_t)L2 * BATCH * NMEM + b * NMEM + n) * 2 * DM + h * 512 + 8 * lane;
                    float* cl = (float*)(ws + WS_C) + (size_t)L2 * C_LAYER;
                    const float* bw = cl + C_Q + DM + h * 512 + 8 * lane;
                    const u32x4 kw = *(const u32x4*)kp; const f32x4 b0 = *(const f32x4*)bw, b1 = *(const f32x4*)(bw + 4);
                    float d = (bf_lo(kw.x) * b0[0] + bf_hi(kw.x) * b0[1]) + (bf_lo(kw.y) * b0[2] + bf_hi(kw.y) * b0[3]) + (bf_lo(kw.z) * b1[0] + bf_hi(kw.z) * b1[1]) + (bf_lo(kw.w) * b1[2] + bf_hi(kw.w) * b1[3]);
                    d = wave_sum(d);
                    if (lane == 0) cl[C_QK2 + r] = d;
                }
            }
            __syncthreads();
        }
        {
            PH_IDS;
            bf16_t* PB = WSP(bf16_t, WS_PROJ); bf16_t* Y = WSP(bf16_t, WS_Y);
            const float* cw = INP(4) + (size_t)l * 3 * 512;
            const int cg8 = tid & 63, c0 = cg8 * 8, gi = cg8 >> 4, cc = c0 & 127;
            float k0[8], k1[8], k2[8];
#pragma unroll
            for (int e = 0; e < 8; ++e) { k0[e] = cw[c0 + e]; k1[e] = cw[512 + c0 + e]; k2[e] = cw[1024 + c0 + e]; }
            for (int r4 = gt >> 6; r4 < T / 4; r4 += NGT >> 6) {
                const int r = 4 * r4, t = r & (SEQ - 1);
                const bf16_t* pb = PB + ((size_t)(0 + gi) * T + r) * 128 + cc;
                const bf16_t* pc = PB + ((size_t)(4 + gi) * T + r) * 128 + cc;
                const bf16_t* ph = PB + ((size_t)(8 + gi) * T + r) * 128 + cc;
                u32x4 wc[6], wh[6], wb[4];
#pragma unroll
                for (int i = 0; i < 6; ++i) { wc[i] = (u32x4){0, 0, 0, 0}; wh[i] = (u32x4){0, 0, 0, 0}; }
                if (t >= 2) { wc[0] = *(const u32x4*)(pc - 256); wh[0] = *(const u32x4*)(ph - 256); wc[1] = *(const u32x4*)(pc - 128); wh[1] = *(const u32x4*)(ph - 128); }
#pragma unroll
                for (int i = 0; i < 4; ++i) { wc[2 + i] = *(const u32x4*)(pc + i * 128); wh[2 + i] = *(const u32x4*)(ph + i * 128); wb[i] = *(const u32x4*)(pb + i * 128); }
                float z[6][8];
#pragma unroll
                for (int i = 0; i < 6; ++i)
#pragma unroll
                    for (int j = 0; j < 4; ++j) { z[i][2 * j] = bf_lo(wc[i][j]) * bf_lo(wh[i][j]); z[i][2 * j + 1] = bf_hi(wc[i][j]) * bf_hi(wh[i][j]); }
#pragma unroll
                for (int i = 0; i < 4; ++i) { float y[8];
#pragma unroll
                    for (int j = 0; j < 4; ++j) {
                        y[2 * j] = bf_lo(wb[i][j]) * (k0[2 * j] * z[i][2 * j] + k1[2 * j] * z[i + 1][2 * j] + k2[2 * j] * z[i + 2][2 * j]);
                        y[2 * j + 1] = bf_hi(wb[i][j]) * (k0[2 * j + 1] * z[i][2 * j + 1] + k1[2 * j + 1] * z[i + 1][2 * j + 1] + k2[2 * j + 1] * z[i + 2][2 * j + 1]); }
                    u32x4 w; w.x = cvt_pk_bf16(y[0], y[1]); w.y = cvt_pk_bf16(y[2], y[3]); w.z = cvt_pk_bf16(y[4], y[5]); w.w = cvt_pk_bf16(y[6], y[7]);
                    *(u32x4*)(Y + (size_t)(r + i) * DM + c0) = w; }
            }
        }
        {
            PH_IDS;
            bf16_t* PB = WSP(bf16_t, WS_PROJ); bf16_t* Y = WSP(bf16_t, WS_Y); bf16_t* wtril = WSP(bf16_t, WS_WTRIL);
            float* st = (float*)(lds + 40960);
            bf16_t* vT = (bf16_t*)lds;
            const float* lng = INP(5) + (size_t)l * 512; const float* lnb = INP(6) + (size_t)l * 512;
            const float* bs = INP(8) + (size_t)l * 512;
            const float* gstat = WSP(float, WS_ST) + (size_t)(6 + l) * T * 2;
            float* svL = (float*)(lds + 49152);
            for (int un = cu; un < (T / 128) * 4; un += G) {
                const int ch = un >> 2, gi = un & 3, r0 = ch * 128;
                if (tid < 128) {
                    const float s1 = gstat[2 * (r0 + tid)], s2 = gstat[2 * (r0 + tid) + 1];
                    const float mean = s1 * (1.f / 512.f), var = fmaxf(s2 * (1.f / 512.f) - mean * mean, 0.f);
                    st[2 * tid] = mean; st[2 * tid + 1] = rsqrtf(var + LN_EPS); }
                __syncthreads();
                {
                    const int tok = tid >> 2, cq = (tid & 3) * 32; const float mean = st[2 * tok], rstd = st[2 * tok + 1];
                    const bf16_t* vp = PB + ((size_t)(16 + gi) * T + r0 + tok) * 128 + cq;
#pragma unroll
                    for (int i = 0; i < 4; ++i) { const u32x4 w = *(const u32x4*)(vp + 8 * i);
#pragma unroll
                        for (int j = 0; j < 4; ++j) { const int c = cq + 8 * i + 2 * j;
                            const float x0 = gelu_tanh(bf_lo(w[j])), x1 = gelu_tanh(bf_hi(w[j]));
                            vT[c * 136 + tok] = f2bf((x0 - mean) * rstd * lng[gi * 128 + c] + lnb[gi * 128 + c]);
                            vT[(c + 1) * 136 + tok] = f2bf((x1 - mean) * rstd * lng[gi * 128 + c + 1] + lnb[gi * 128 + c + 1]); } }
                }
                __syncthreads();
                {
                    f32x4 acc[8];
#pragma unroll
                    for (int ct = 0; ct < 8; ++ct) acc[ct] = (f32x4){0.f, 0.f, 0.f, 0.f};
                    const bf16_t* wrow = wtril + ((size_t)(l * 4 + gi) * 128 + 16 * wave + (lane & 15)) * 128 + 8 * (lane >> 4);
#pragma unroll
                    for (int kk = 0; kk < 4; ++kk) { const bf16x8 av = *(const bf16x8*)(wrow + kk * 32);
#pragma unroll
                        for (int ct = 0; ct < 8; ++ct) { const bf16x8 bv = *(const bf16x8*)(vT + (ct * 16 + (lane & 15)) * 136 + kk * 32 + 8 * (lane >> 4));
                            acc[ct] = __builtin_amdgcn_mfma_f32_16x16x32_bf16(av, bv, acc[ct], 0, 0, 0); } }
#pragma unroll
                    for (int j = 0; j < 4; ++j) { const int t = 16 * wave + 4 * (lane >> 4) + j; const float bt = bs[gi * 128 + t];
#pragma unroll
                        for (int ct = 0; ct < 8; ++ct) svL[t * 132 + ct * 16 + (lane & 15)] = acc[ct][j] + bt; }
                }
                __syncthreads();
                {
                    const int c0 = (tid & 15) * 8;
#pragma unroll
                    for (int i = 0; i < 4; ++i) { const int t = 32 * i + (tid >> 4);
                        const u32x4 uw = *(const u32x4*)(PB + ((size_t)(12 + gi) * T + r0 + t) * 128 + c0);
                        const f32x4 s0 = *(const f32x4*)(svL + t * 132 + c0), s1 = *(const f32x4*)(svL + t * 132 + c0 + 4);
                        u32x4 w; w.x = cvt_pk_bf16(gelu_tanh(bf_lo(uw.x)) * s0[0], gelu_tanh(bf_hi(uw.x)) * s0[1]); w.y = cvt_pk_bf16(gelu_tanh(bf_lo(uw.y)) * s0[2], gelu_tanh(bf_hi(uw.y)) * s0[3]);
                        w.z = cvt_pk_bf16(gelu_tanh(bf_lo(uw.z)) * s1[0], gelu_tanh(bf_hi(uw.z)) * s1[1]); w.w = cvt_pk_bf16(gelu_tanh(bf_lo(uw.w)) * s1[2], gelu_tanh(bf_hi(uw.w)) * s1[3]);
                        *(u32x4*)(Y + (size_t)(r0 + t) * DM + 512 + gi * 128 + c0) = w; }
                }
                __syncthreads();
            }
        }
        {
            PH_IDS;
            bf16_t* PB = WSP(bf16_t, WS_PROJ); float* OATT = WSP(float, WS_R1); float* btab = WSP(float, WS_BTAB);
            float* btl = (float*)(lds + att2::L_BT);
            for (int i = tid; i < 8 * 256; i += NTHR) btl[i] = btab[i];
            __syncthreads();
            const att::bf16* PBb = (const att::bf16*)PB;
#pragma unroll 1
            for (int L = cu; L < 512; L += G) {
                const int k_ = L >> 3, hm = L & 7, b = k_ >> 5, x = k_ & 31, h = hm >> 1;
#pragma unroll 1
                for (int pass = 0; pass < 2; ++pass) {
                    const int qb = pass ? 63 - x : x;
                    att2::Blk c;
                    c.Q = PBb + ((size_t)(20 + hm) * T + (size_t)b * SEQ + qb * 128) * 128; c.K = PBb + ((size_t)(28 + hm) * T + (size_t)b * SEQ) * 128;
                    c.V0 = PBb + ((size_t)(36 + h * 2) * T + (size_t)b * SEQ) * 128; c.V1 = PBb + ((size_t)(37 + h * 2) * T + (size_t)b * SEQ) * 128;
                    c.O0 = OATT + ((size_t)((b * 8 + hm) * 2 + 0) * SEQ + qb * 128) * 128; c.O1 = OATT + ((size_t)((b * 8 + hm) * 2 + 1) * SEQ + qb * 128) * 128;
                    c.P0 = qb * 128; c.hm = hm;
                    att2::attn2_block(c, (char*)lds);
                }
            }
        }
        GRID_BAR();

        {
            PH_IDS;
            float* OATT = WSP(float, WS_R1); bf16_t* Y = WSP(bf16_t, WS_Y); float* lamp = WSP(float, WS_LAM);
            const float lam_init = 0.8f - 0.6f * expf(-0.3f * (float)l);
            const float lam = lamp[l]; const float* sg = INP(11) + (size_t)l * 256;
            const f32x4 gv = *(const f32x4*)(sg + 4 * lane);
            for (int it = gw; it < T * 4; it += 2 * NGW) {
                const int half = lane >> 5, e = (lane & 31) * 4;
                const int itb = it + NGW;
                const int ra = it >> 2, ha = it & 3, ba = ra >> 13, ta = ra & (SEQ - 1);
                const int rb = itb >> 2, hb = itb & 3, bb = rb >> 13, tb = rb & (SEQ - 1);
                const size_t a0 = ((size_t)(((ba * 4 + ha) * 2 + 0) * 2 + half) * SEQ + ta) * 128 + e, a1 = ((size_t)(((ba * 4 + ha) * 2 + 1) * 2 + half) * SEQ + ta) * 128 + e;
                const size_t b0 = ((size_t)(((bb * 4 + hb) * 2 + 0) * 2 + half) * SEQ + tb) * 128 + e, b1 = ((size_t)(((bb * 4 + hb) * 2 + 1) * 2 + half) * SEQ + tb) * 128 + e;
                const f32x4 oa0 = *(const f32x4*)(OATT + a0), oa1 = *(const f32x4*)(OATT + a1), ob0 = *(const f32x4*)(OATT + b0), ob1 = *(const f32x4*)(OATT + b1);
                const f32x4 da = oa0 - oa1 * lam, db = ob0 - ob1 * lam;
                const float ssa = wave_sum(da[0] * da[0] + da[1] * da[1] + da[2] * da[2] + da[3] * da[3]);
                const float ssb = wave_sum(db[0] * db[0] + db[1] * db[1] + db[2] * db[2] + db[3] * db[3]);
                const float sca = rsqrtf(ssa * (1.f / 256.f) + LN_EPS) * (1.f - lam_init), scb = rsqrtf(ssb * (1.f / 256.f) + LN_EPS) * (1.f - lam_init);
                u32x2 wa; wa.x = cvt_pk_bf16(da[0] * sca * gv[0], da[1] * sca * gv[1]); wa.y = cvt_pk_bf16(da[2] * sca * gv[2], da[3] * sca * gv[3]);
                u32x2 wb; wb.x = cvt_pk_bf16(db[0] * scb * gv[0], db[1] * scb * gv[1]); wb.y = cvt_pk_bf16(db[2] * scb * gv[2], db[3] * scb * gv[3]);
                *(u32x2*)(Y + (size_t)ra * DM + 1024 + ha * 256 + 4 * lane) = wa;
                *(u32x2*)(Y + (size_t)rb * DM + 1024 + hb * 256 + 4 * lane) = wb;
            }
        }
        GRID_BAR();

#define LN_OUT_PASS(gam, bet) do { PH_IDS; float* X = out_opaque(a); const bf16_t* ZB = WSP(bf16_t, WS_XN); \
            for (int r0_ = gw; r0_ < T; r0_ += 2 * NGW) { u32x4 wq[2][4];                          \
                _Pragma("unroll") for (int q = 0; q < 2; ++q) _Pragma("unroll") for (int j = 0; j < 4; ++j) wq[q][j] = *(const u32x4*)(ZB + (size_t)(r0_ + q * NGW) * DM + 8 * lane + 512 * j); \
                _Pragma("unroll") for (int q = 0; q < 2; ++q) { const int r = r0_ + q * NGW; float* xr = X + (size_t)r * DM; f32x4 v[8]; float s = 0.f; \
                    _Pragma("unroll") for (int j = 0; j < 4; ++j) { const u32x4 w = wq[q][j]; \
                        v[2 * j] = (f32x4){bf_lo(w.x), bf_hi(w.x), bf_lo(w.y), bf_hi(w.y)}; v[2 * j + 1] = (f32x4){bf_lo(w.z), bf_hi(w.z), bf_lo(w.w), bf_hi(w.w)}; } \
                    _Pragma("unroll") for (int j = 0; j < 8; ++j) s += (v[j][0] + v[j][1]) + (v[j][2] + v[j][3]); \
                    const float mean = wave_sum(s) * (1.f / DM); float s2 = 0.f; \
                    _Pragma("unroll") for (int j = 0; j < 8; ++j) { v[j] = v[j] - mean; s2 += (v[j][0] * v[j][0] + v[j][1] * v[j][1]) + (v[j][2] * v[j][2] + v[j][3] * v[j][3]); } \
                    const float rstd = rsqrtf(wave_sum(s2) * (1.f / DM) + LN_EPS); \
                    _Pragma("unroll") for (int j = 0; j < 8; ++j) { const int c = 8 * lane + 512 * (j >> 1) + 4 * (j & 1); \
                        const f32x4 gg = *(const f32x4*)((gam) + c), bb = *(const f32x4*)((bet) + c); \
                        *(f32x4*)(xr + c) = v[j] * rstd * gg + bb; } } } } while (0)

        {
            unsigned char* ws = ws_opaque(a); float* X = out_opaque(a); float* ST = (float*)(ws + WS_ST);
            pg8::Gemm g{(const bf16_t*)(ws + WS_Y), (const bf16_t*)(ws + WS_W + (size_t)l * W_LAYER + W_OUT), DM, DM, DM, 1, 0, 0, 0, 0};
            pg8::Order S; S.init(T, DM, 1, G, cu_opaque());
            pg8::EpiRes E{nullptr, l == 0 ? INP(0) : nullptr, ST + (size_t)(l > 0 ? 3 * l - 1 : 0) * T * 2, INP(22) + (size_t)(l > 0 ? l - 1 : 0) * DM, INP(23) + (size_t)(l > 0 ? l - 1 : 0) * DM,
                          (bf16_t*)(ws + WS_XN), ST + (size_t)(3 * l) * T * 2, ALPHA, 0};
            pg8::gemm_phase<pg8::EpiRes, true>((LAS unsigned char*)lds, g, S, E);
        }
        GRID_BAR();

        {
            unsigned char* ws = ws_opaque(a);
            const float* cl = (const float*)(ws + WS_C) + (size_t)l * C_LAYER;
            pg8::Gemm g{(const bf16_t*)(ws + WS_XN), (const bf16_t*)(ws + WS_W + (size_t)l * W_LAYER + W_KV), DM, DM, DM, 4, (long)SEQ * DM, 0, (long)4 * NMEM * DM, (long)NMEM * DM};
            pg8::Order S; S.init(SEQ, NMEM, 8, G, cu_opaque());
            pg8::EpiSoftmax E{(bf16_t*)(ws + WS_PROJ + 64 * MiB), (const float*)(ws + WS_ST) + (size_t)(3 * l) * T * 2, cl + C_Q, cl + C_QK2, 0.044194173824159216f};
            pg8::gemm_phase<pg8::EpiSoftmax, true>((LAS unsigned char*)lds, g, S, E);
        }
        GRID_BAR();
        {
            unsigned char* ws = ws_opaque(a); float* ST = (float*)(ws + WS_ST);
            pg8::Gemm g{(const bf16_t*)(ws + WS_PROJ + 64 * MiB), (const bf16_t*)(ws + WS_W + (size_t)l * W_LAYER + W_KV + 8 * MiB), 1024, 1024, 1024, 1, (long)SEQ * 1024, 0, (long)DM * 1024, 0};
            pg8::Order S; S.init(SEQ, DM, 2, G, cu_opaque());
            pg8::EpiRes E{nullptr, nullptr, ST + (size_t)(3 * l) * T * 2, INP(13) + (size_t)l * DM, INP(14) + (size_t)l * DM, (bf16_t*)(ws + WS_XN), ST + (size_t)(3 * l + 1) * T * 2, ALPHA, SEQ};
            pg8::gemm_phase<pg8::EpiRes, true>((LAS unsigned char*)lds, g, S, E);
        }
        GRID_BAR();
        {
            unsigned char* ws = ws_opaque(a);
            const float* cl = (const float*)(ws + WS_C) + (size_t)l * C_LAYER;
            pg8::Gemm g{(const bf16_t*)(ws + WS_XN), (const bf16_t*)(ws + WS_W + (size_t)l * W_LAYER + W_GU), DM, DM, DM, 1, 0, 0, 0, 0};
            pg8::Order S; S.init(T, 2 * DFF, 1, G, cu_opaque());
            pg8::EpiSwiglu E{(bf16_t*)(ws + WS_PROJ), (const float*)(ws + WS_ST) + (size_t)(3 * l + 1) * T * 2, cl + C_GU, cl + C_GU + 2 * DFF};
            pg8::gemm_phase<pg8::EpiSwiglu, true>((LAS unsigned char*)lds, g, S, E);
        }
        GRID_BAR();
        {
            unsigned char* ws = ws_opaque(a); float* X = out_opaque(a); float* ST = (float*)(ws + WS_ST);
            pg8::Gemm g{(const bf16_t*)(ws + WS_PROJ), (const bf16_t*)(ws + WS_W + (size_t)l * W_LAYER + W_D), DFF, DFF, DFF, 1, 0, 0, 0, 0};
            pg8::Order S; S.init(T, DM, 1, G, cu_opaque());
            pg8::EpiRes E{nullptr, nullptr, ST + (size_t)(3 * l + 1) * T * 2, INP(18) + (size_t)l * DM, INP(19) + (size_t)l * DM, (bf16_t*)(ws + WS_XN), ST + (size_t)(3 * l + 2) * T * 2, ALPHA, 0};
            pg8::gemm_phase<pg8::EpiRes, true>((LAS unsigned char*)lds, g, S, E);
        }
        GRID_BAR();
        if (l + 1 == DEPTH) { LN_OUT_PASS(INP(22) + (size_t)l * DM, INP(23) + (size_t)l * DM); }
#undef LN_OUT_PASS
    }
    if (a.ws == nullptr) cg::this_grid().sync();
}

extern "C" void kernel_launch(void* const* d_in, const int* in_sizes, int n_in, void* d_out, int out_size, void* d_ws, size_t ws_size, hipStream_t stream) {
    static int grid = 0;
    if (grid == 0) {
        if (n_in != 24 || in_sizes[0] != T * DM || out_size != T * DM || ws_size < WS_END) {
            fprintf(stderr, "kernel_launch: unexpected shapes (n_in %d, in0 %d, out %d, ws %zu); nothing launched\n", n_in, n_in > 0 ? in_sizes[0] : -1, out_size, ws_size); grid = -1; return; }
        int dev = 0, cus = 0, per_cu = 0;
        (void)hipGetDevice(&dev);
        if (hipDeviceGetAttribute(&cus, hipDeviceAttributeMultiprocessorCount, dev) != hipSuccess || cus <= 0) cus = 256;
        if (hipFuncSetAttribute((const void*)mega_fwd, hipFuncAttributeMaxDynamicSharedMemorySize, LDS_BYTES) != hipSuccess) fprintf(stderr, "kernel_launch: hipFuncSetAttribute failed\n");
        if (hipOccupancyMaxActiveBlocksPerMultiprocessor(&per_cu, (const void*)mega_fwd, NTHR, LDS_BYTES) != hipSuccess || per_cu < 1) { fprintf(stderr, "kernel_launch: occupancy query says %d\n", per_cu); per_cu = 1; }
        (void)hipGetLastError();
        grid = cus * per_cu;
    }
    if (grid < 0) return;
    if (hipMemsetAsync((char*)d_ws + WS_BAR, 0, WS_ST + 1 * MiB - WS_BAR, stream) != hipSuccess) { fprintf(stderr, "kernel_launch: hipMemsetAsync failed\n"); return; }
    Args a{};
    for (int i = 0; i < 24; ++i) a.in[i] = (const float*)d_in[i];
    a.out = (float*)d_out; a.ws = (unsigned char*)d_ws;
    void* args[] = {&a};
    hipError_t e = hipLaunchCooperativeKernel((const void*)mega_fwd, dim3(grid), dim3(NTHR), args, LDS_BYTES, stream);
    if (e != hipSuccess) fprintf(stderr, "cooperative launch failed: %s (grid %d)\n", hipGetErrorString(e), grid);
}
```

```cpp
#include <hip/hip_runtime.h>
#include <hip/hip_cooperative_groups.h>
#include <hip/hip_bf16.h>
#include <cstdio>
#include <cstdint>
namespace cg = cooperative_groups;

constexpr int BATCH = 2, SEQ = 8192, DM = 2048, DEPTH = 2, T = BATCH * SEQ;
constexpr int NMEM = 256, INC = 5632, DFF = 5632;
constexpr float ALPHA = 1.4142135623730951f;
constexpr float LN_EPS = 1e-5f;
constexpr int NTHR = 512, NWAVES = 8;

constexpr size_t MiB = 1u << 20;
constexpr size_t WS_LAM = 0;
constexpr size_t WS_BTAB = 4096;
constexpr size_t WS_BAR = 512 * 1024;
constexpr size_t WS_C = 576 * 1024;
constexpr int C_Q = 0, C_GU = 4096, C_IN = 4096 + 22528, C_QK2 = 4096 + 22528 + 11264, C_LAYER = C_QK2 + 2048;
constexpr size_t WS_ST = 1 * MiB;
constexpr size_t WS_WTRIL = 12 * MiB;
constexpr size_t WS_MEMBF = 2 * MiB;
constexpr size_t WS_KV = 4 * MiB;
constexpr size_t WS_W = 16 * MiB;
constexpr size_t W_IN = 0, W_OUT = 22 * MiB, W_Q = 30 * MiB, W_KV = 38 * MiB, W_O = 54 * MiB, W_GU = 62 * MiB, W_D = 106 * MiB, W_LAYER = 128 * MiB;
constexpr size_t WS_XN = 272 * MiB;
constexpr size_t WS_PROJ = 336 * MiB;
constexpr size_t WS_R1 = 512 * MiB;
constexpr size_t WS_Y = 640 * MiB;
constexpr size_t WS_END = 704 * MiB;
constexpr int LDS_BYTES = 147456;

typedef unsigned short bf16_t;
typedef short bf16x8 __attribute__((ext_vector_type(8)));
typedef float f32x4 __attribute__((ext_vector_type(4)));
typedef float f32x16 __attribute__((ext_vector_type(16)));
typedef unsigned u32x4 __attribute__((ext_vector_type(4)));
typedef unsigned u32x2 __attribute__((ext_vector_type(2)));
#define LAS __attribute__((address_space(3)))
#define GAS __attribute__((address_space(1)))

__device__ __forceinline__ unsigned cvt_pk_bf16(float lo, float hi) { unsigned r; asm volatile("v_cvt_pk_bf16_f32 %0, %1, %2" : "=v"(r) : "v"(lo), "v"(hi)); return r; }
__device__ __forceinline__ float bf_lo(unsigned w) { return __uint_as_float(w << 16); }
__device__ __forceinline__ float bf_hi(unsigned w) { return __uint_as_float(w & 0xffff0000u); }
__device__ __forceinline__ float bf2f(bf16_t b) { return __uint_as_float(((unsigned)b) << 16); }
__device__ __forceinline__ bf16_t f2bf(float f) { return (bf16_t)(cvt_pk_bf16(f, 0.f) & 0xffffu); }
__device__ __forceinline__ int ltid() { int t = threadIdx.x; asm volatile("" : "+v"(t)); return t; }
__device__ __forceinline__ int cu_opaque() { int c = blockIdx.x; asm volatile("" : "+s"(c)); return c; }
#define PH_IDS const int cu = cu_opaque(); const int tid = ltid(), lane = tid & 63, wave = __builtin_amdgcn_readfirstlane(tid >> 6), gw = cu * NWAVES + wave, gt = cu * NTHR + tid; (void)lane; (void)wave; (void)gw; (void)gt
__device__ __forceinline__ float wave_sum(float v) {
#pragma unroll
    for (int o = 1; o < 64; o <<= 1) v += __shfl_xor(v, o);
    return v;
}
__device__ __forceinline__ float wave_max(float v) {
#pragma unroll
    for (int o = 1; o < 64; o <<= 1) v = fmaxf(v, __shfl_xor(v, o));
    return v;
}
__device__ __forceinline__ float gelu_tanh(float x) {
    const float y = 0.7978845608028654f * (x + 0.044715f * x * x * x);
    return x * __builtin_amdgcn_rcpf(1.f + __expf(-2.f * y));
}

namespace pg8 {
constexpr int BM = 256, BK = 64, HALF = 128, HTB = HALF * BK * 2, STAGE_BYTES = 8 * HTB, NXCD = 8, WGM = 8;
__host__ __device__ __forceinline__ int lds_byte(int r, int c) { const int st = (r >> 4) * 2 + (c >> 5), rr = r & 15, cc = c & 31, ob = rr * 64 + cc * 2; return st * 1024 + (ob ^ (((ob >> 9) & 1) << 5)); }
__host__ __device__ __forceinline__ void stage_rc(int b, int& R, int& C) { const int st = b / 1024, sb = b % 1024, swz = sb ^ (((sb >> 9) & 1) << 5); R = (st >> 1) * 16 + swz / 64; C = (st & 1) * 32 + (swz % 64) / 2; }
__host__ __device__ __forceinline__ int perm32(int rho) { const int n = rho >> 4, i = rho & 15; return 8 * (i >> 2) + 4 * n + (i & 3); }

struct Unit { int pm, pn, bz; };
struct Gemm { const bf16_t* A; const bf16_t* Bt; int lda, ldb, K, nb0; long a_s1, a_s0, b_s1, b_s0; };
__device__ __forceinline__ const char* unit_a(const Gemm& g, const Unit& u) { const int b1 = u.bz / g.nb0, b0 = u.bz % g.nb0; return (const char*)(g.A + (size_t)b1 * g.a_s1 + (size_t)b0 * g.a_s0 + (size_t)u.pm * BM * g.lda); }
__device__ __forceinline__ const char* unit_b(const Gemm& g, const Unit& u) { const int b1 = u.bz / g.nb0, b0 = u.bz % g.nb0; return (const char*)(g.Bt + (size_t)b1 * g.b_s1 + (size_t)b0 * g.b_s0 + (size_t)u.pn * BM * g.ldb); }

struct Order {
    int nM, nN, nB, G, c;
    __device__ void init(int M, int N, int nB_, int G_, int c_) { nM = M / BM; nN = N / BM; nB = nB_; G = G_; c = c_; }
    __device__ bool next(int i, Unit& u) const {
        const long L = (long)i * G + c; const int nwg = nM * nN; if (c < 0 || L >= (long)nwg * nB) return false;
        if (nB > 1) { u.bz = (int)(L / nwg); const int w = (int)(L % nwg); u.pn = w / nM; u.pm = w % nM; return true; }
        u.bz = 0;
        int wgid = (int)L; { const int q = nwg / NXCD, r = nwg % NXCD, xcd = wgid % NXCD, off = wgid / NXCD; wgid = (xcd < r ? xcd * (q + 1) : r * (q + 1) + (xcd - r) * q) + off; }
        const int nig = WGM * nN, gid = wgid / nig, fm = gid * WGM, gsz = (nM - fm) < WGM ? (nM - fm) : WGM;
        u.pm = fm + ((wgid % nig) % gsz); u.pn = (wgid % nig) / gsz; return true;
    }
};

__device__ __forceinline__ void row_stats(const float* st, int row, float& mean, float& rstd) {
    const float s1 = st[2 * row], s2 = st[2 * row + 1];
    mean = s1 * (1.f / DM); const float var = fmaxf(s2 * (1.f / DM) - mean * mean, 0.f); rstd = rsqrtf(var + LN_EPS);
}
struct EpiSplit {
    static constexpr bool PERM = true, AFTER_DRAIN = false;
    bf16_t* P; const float* st; const float* c1; const float* c2;
    float* gst;
    __device__ __forceinline__ void operator()(const f32x4 (&acc)[2][2][4][2], const Unit& u, int wr, int wc, int fr, int fq) const {
        const int row0 = u.pm * BM + wr * 64 + fr, col0 = u.pn * BM + wc * 32 + 8 * fq;
        const bool vg = (u.pn == 8 || u.pn == 9);
        f32x4 k1[2][2], k2[2][2];
        if (st) {
#pragma unroll
            for (int bj = 0; bj < 2; ++bj)
#pragma unroll
                for (int n = 0; n < 2; ++n) { k1[bj][n] = *(const f32x4*)(c1 + col0 + bj * HALF + 4 * n); k2[bj][n] = *(const f32x4*)(c2 + col0 + bj * HALF + 4 * n); } }
        float ms8[2][4], rs8[2][4];
        if (st) {
#pragma unroll
            for (int ai = 0; ai < 2; ++ai)
#pragma unroll
                for (int m = 0; m < 4; ++m) { ms8[ai][m] = st[2 * (row0 + ai * HALF + m * 16)]; rs8[ai][m] = st[2 * (row0 + ai * HALF + m * 16) + 1]; } }
#pragma unroll
        for (int ai = 0; ai < 2; ++ai)
#pragma unroll
            for (int m = 0; m < 4; ++m) { const int row = row0 + ai * HALF + m * 16;
                float mean = 0.f, rstd = 1.f;
                if (st) { mean = ms8[ai][m] * (1.f / DM); const float var = fmaxf(rs8[ai][m] * (1.f / DM) - mean * mean, 0.f); rstd = rsqrtf(var + LN_EPS); }
                float gs = 0.f, gq = 0.f;
#pragma unroll
                for (int bj = 0; bj < 2; ++bj) { f32x4 v0 = acc[ai][bj][m][0], v1 = acc[ai][bj][m][1];
                    if (st) { v0 = (v0 - k1[bj][0] * mean) * rstd + k2[bj][0]; v1 = (v1 - k1[bj][1] * mean) * rstd + k2[bj][1]; }
                    u32x4 w; w.x = cvt_pk_bf16(v0[0], v0[1]); w.y = cvt_pk_bf16(v0[2], v0[3]); w.z = cvt_pk_bf16(v1[0], v1[1]); w.w = cvt_pk_bf16(v1[2], v1[3]);
                    *(u32x4*)(P + ((size_t)(u.pn * 2 + bj) * T + row) * 128 + wc * 32 + 8 * fq) = w;
                    if (vg) {
#pragma unroll
                        for (int j = 0; j < 4; ++j) { const float x0 = gelu_tanh(bf_lo(w[j])), x1 = gelu_tanh(bf_hi(w[j])); gs += x0 + x1; gq += x0 * x0 + x1 * x1; } } }
                if (vg) { gs += __shfl_xor(gs, 16); gs += __shfl_xor(gs, 32); gq += __shfl_xor(gq, 16); gq += __shfl_xor(gq, 32);
                    if (fq == 0) { unsafeAtomicAdd(gst + 2 * row, gs); unsafeAtomicAdd(gst + 2 * row + 1, gq); } } }
    }
};
struct EpiBf16 {
    static constexpr bool PERM = true, AFTER_DRAIN = false;
    bf16_t* O; int ldc, nb0; long o_s1, o_s0; float scale; const float* st; const float* c1; const float* c2; float* rsum;
    __device__ __forceinline__ void operator()(const f32x4 (&acc)[2][2][4][2], const Unit& u, int wr, int wc, int fr, int fq) const {
        const int row0 = u.pm * BM + wr * 64 + fr, col0 = u.pn * BM + wc * 32 + 8 * fq;
        bf16_t* base = O + (size_t)(u.bz / nb0) * o_s1 + (size_t)(u.bz % nb0) * o_s0;
        f32x4 k1[2][2], k2[2][2];
        if (st) {
#pragma unroll
            for (int bj = 0; bj < 2; ++bj)
#pragma unroll
                for (int n = 0; n < 2; ++n) { k1[bj][n] = *(const f32x4*)(c1 + col0 + bj * HALF + 4 * n); k2[bj][n] = *(const f32x4*)(c2 + col0 + bj * HALF + 4 * n); } }
#pragma unroll
        for (int ai = 0; ai < 2; ++ai)
#pragma unroll
            for (int m = 0; m < 4; ++m) { const int row = row0 + ai * HALF + m * 16; bf16_t* rowp = base + (size_t)row * ldc + col0;
                float mean = 0.f, rstd = 1.f; if (st) row_stats(st, row, mean, rstd);
                float rs = 0.f;
#pragma unroll
                for (int bj = 0; bj < 2; ++bj) { f32x4 v0 = acc[ai][bj][m][0], v1 = acc[ai][bj][m][1];
                    if (st) { v0 = (v0 - k1[bj][0] * mean) * rstd + k2[bj][0]; v1 = (v1 - k1[bj][1] * mean) * rstd + k2[bj][1]; }
                    v0 = v0 * scale; v1 = v1 * scale;
                    u32x4 w; w.x = cvt_pk_bf16(v0[0], v0[1]); w.y = cvt_pk_bf16(v0[2], v0[3]); w.z = cvt_pk_bf16(v1[0], v1[1]); w.w = cvt_pk_bf16(v1[2], v1[3]);
                    *(u32x4*)(rowp + bj * HALF) = w;
                    if (rsum) rs += ((bf_lo(w.x) + bf_hi(w.x)) + (bf_lo(w.y) + bf_hi(w.y))) + ((bf_lo(w.z) + bf_hi(w.z)) + (bf_lo(w.w) + bf_hi(w.w))); }
                if (rsum) { rs += __shfl_xor(rs, 16); rs += __shfl_xor(rs, 32); if (fq == 0) unsafeAtomicAdd(rsum + u.bz * 256 + row, rs); } }
    }
};
struct EpiF32 {
    static constexpr bool PERM = false, AFTER_DRAIN = false;
    float* out; int ldc; long o_bs; float scale;
    __device__ __forceinline__ void operator()(const f32x4 (&acc)[2][2][4][2], const Unit& u, int wr, int wc, int fr, int fq) const {
        const int row0 = u.pm * BM + wr * 64 + fr, col0 = u.pn * BM + wc * 32 + 4 * fq;
        float* ob = out + (size_t)u.bz * o_bs;
#pragma unroll
        for (int ai = 0; ai < 2; ++ai)
#pragma unroll
            for (int m = 0; m < 4; ++m) { const size_t off = (size_t)(row0 + ai * HALF + m * 16) * ldc + col0;
#pragma unroll
                for (int bj = 0; bj < 2; ++bj)
#pragma unroll
                    for (int n = 0; n < 2; ++n) *(f32x4*)(ob + off + bj * HALF + n * 16) = acc[ai][bj][m][n] * scale; }
    }
};
struct EpiRes {
    static constexpr bool PERM = true, AFTER_DRAIN = false;
    float* X; const float* raw; const float* pst; const float* pg; const float* pb; bf16_t* ZB; float* cst; float alpha; int brows;
    __device__ __forceinline__ void operator()(const f32x4 (&acc)[2][2][4][2], const Unit& u, int wr, int wc, int fr, int fq) const {
        const int row0 = u.bz * brows + u.pm * BM + wr * 64 + fr, col0 = u.pn * BM + wc * 32 + 8 * fq;
        f32x4 gv[2][2], bv[2][2];
        if (!raw) {
#pragma unroll
            for (int bj = 0; bj < 2; ++bj)
#pragma unroll
                for (int n = 0; n < 2; ++n) { gv[bj][n] = *(const f32x4*)(pg + col0 + bj * HALF + 4 * n); bv[bj][n] = *(const f32x4*)(pb + col0 + bj * HALF + 4 * n); } }
#pragma unroll
        for (int pq = 0; pq < 4; ++pq) { const int ai = pq >> 1;
            u32x4 zpre[2][2]; float mpre[2], rpre[2];
            if (!raw) {
#pragma unroll
                for (int mm = 0; mm < 2; ++mm) { const int row = row0 + ai * HALF + ((pq & 1) * 2 + mm) * 16; const size_t off = (size_t)row * DM + col0;
                    zpre[mm][0] = *(const u32x4*)(ZB + off); zpre[mm][1] = *(const u32x4*)(ZB + off + HALF);
                    mpre[mm] = pst[2 * row]; rpre[mm] = pst[2 * row + 1]; } }
#pragma unroll
            for (int mm = 0; mm < 2; ++mm) { const int m = (pq & 1) * 2 + mm; const int row = row0 + ai * HALF + m * 16; const size_t off = (size_t)row * DM + col0;
                float mean = 0.f, rstd = 1.f;
                if (!raw) { mean = mpre[mm] * (1.f / DM); const float var = fmaxf(rpre[mm] * (1.f / DM) - mean * mean, 0.f); rstd = rsqrtf(var + LN_EPS); }
                float s1 = 0.f, s2 = 0.f;
#pragma unroll
                for (int bj = 0; bj < 2; ++bj) { f32x4 r0, r1;
                    if (raw) { r0 = *(const f32x4*)(raw + off + bj * HALF); r1 = *(const f32x4*)(raw + off + bj * HALF + 4); }
                    else { const u32x4 zw = zpre[mm][bj];
                        r0 = (f32x4){bf_lo(zw.x), bf_hi(zw.x), bf_lo(zw.y), bf_hi(zw.y)}; r1 = (f32x4){bf_lo(zw.z), bf_hi(zw.z), bf_lo(zw.w), bf_hi(zw.w)};
                        r0 = (r0 - mean) * rstd * gv[bj][0] + bv[bj][0]; r1 = (r1 - mean) * rstd * gv[bj][1] + bv[bj][1]; }
                    const f32x4 z0 = acc[ai][bj][m][0] + r0 * alpha, z1 = acc[ai][bj][m][1] + r1 * alpha;
                    if (X) { *(f32x4*)(X + off + bj * HALF) = z0; *(f32x4*)(X + off + bj * HALF + 4) = z1; }
                    u32x4 w; w.x = cvt_pk_bf16(z0[0], z0[1]); w.y = cvt_pk_bf16(z0[2], z0[3]); w.z = cvt_pk_bf16(z1[0], z1[1]); w.w = cvt_pk_bf16(z1[2], z1[3]);
                    *(u32x4*)(ZB + off + bj * HALF) = w;
                    s1 += ((z0[0] + z0[1]) + (z0[2] + z0[3])) + ((z1[0] + z1[1]) + (z1[2] + z1[3]));
                    s2 += ((z0[0] * z0[0] + z0[1] * z0[1]) + (z0[2] * z0[2] + z0[3] * z0[3])) + ((z1[0] * z1[0] + z1[1] * z1[1]) + (z1[2] * z1[2] + z1[3] * z1[3])); }
                s1 += __shfl_xor(s1, 16); s1 += __shfl_xor(s1, 32); s2 += __shfl_xor(s2, 16); s2 += __shfl_xor(s2, 32);
                if (fq == 0) { unsafeAtomicAdd(cst + 2 * row, s1); unsafeAtomicAdd(cst + 2 * row + 1, s2); } }
            asm volatile("" ::: "memory"); }
    }
};
struct EpiSwiglu {
    static constexpr bool PERM = true, AFTER_DRAIN = false;
    bf16_t* H; const float* st; const float* c1; const float* c2;
    __device__ __forceinline__ void operator()(const f32x4 (&acc)[2][2][4][2], const Unit& u, int wr, int wc, int fr, int fq) const {
        const int row0 = u.pm * BM + wr * 64 + fr, col0 = u.pn * HALF + wc * 32 + 8 * fq, ccol0 = u.pn * BM + wc * 32 + 8 * fq;
        f32x4 k1[2][2], k2[2][2];
#pragma unroll
        for (int bj = 0; bj < 2; ++bj)
#pragma unroll
            for (int n = 0; n < 2; ++n) { k1[bj][n] = *(const f32x4*)(c1 + ccol0 + bj * HALF + 4 * n); k2[bj][n] = *(const f32x4*)(c2 + ccol0 + bj * HALF + 4 * n); }
        float mean8[2][4], rstd8[2][4];
#pragma unroll
        for (int ai = 0; ai < 2; ++ai)
#pragma unroll
            for (int m = 0; m < 4; ++m) { mean8[ai][m] = st[2 * (row0 + ai * HALF + m * 16)]; rstd8[ai][m] = st[2 * (row0 + ai * HALF + m * 16) + 1]; }
#pragma unroll
        for (int ai = 0; ai < 2; ++ai)
#pragma unroll
            for (int m = 0; m < 4; ++m) { const float mu = mean8[ai][m] * (1.f / DM); const float var = fmaxf(rstd8[ai][m] * (1.f / DM) - mu * mu, 0.f); mean8[ai][m] = mu; rstd8[ai][m] = rsqrtf(var + LN_EPS); }
#pragma unroll
        for (int ai = 0; ai < 2; ++ai)
#pragma unroll
            for (int m = 0; m < 4; ++m) { const int row = row0 + ai * HALF + m * 16; bf16_t* rowp = H + (size_t)row * DFF + col0;
                const float mean = mean8[ai][m], rstd = rstd8[ai][m];
                float h[8];
#pragma unroll
                for (int n = 0; n < 2; ++n) { const f32x4 gq = (acc[ai][0][m][n] - k1[0][n] * mean) * rstd + k2[0][n], uq = (acc[ai][1][m][n] - k1[1][n] * mean) * rstd + k2[1][n];
#pragma unroll
                    for (int j = 0; j < 4; ++j) h[n * 4 + j] = gq[j] * __builtin_amdgcn_rcpf(1.f + __expf(-gq[j])) * uq[j]; }
                u32x4 w; w.x = cvt_pk_bf16(h[0], h[1]); w.y = cvt_pk_bf16(h[2], h[3]); w.z = cvt_pk_bf16(h[4], h[5]); w.w = cvt_pk_bf16(h[6], h[7]);
                *(u32x4*)rowp = w; }
    }
};

struct EpiSoftmax {
    static constexpr bool PERM = true, AFTER_DRAIN = true;
    bf16_t* PALL; const float* st; const float* c1; const float* c2; float scale;
    __device__ __forceinline__ void fused(f32x4 (&acc)[2][2][4][2], const Unit& u, int wr, int wc, int fr, int fq, LAS unsigned char* lds) const {
        const int b = u.bz >> 2, h = u.bz & 3, rl0 = wr * 64 + fr, cc0 = wc * 32 + 8 * fq;
        LAS float* PMX = (LAS float*)lds; LAS float* PSM = PMX + 1024;
        f32x4 k1[2][2], k2[2][2];
#pragma unroll
        for (int bj = 0; bj < 2; ++bj)
#pragma unroll
            for (int n = 0; n < 2; ++n) { k1[bj][n] = *(const f32x4*)(c1 + u.bz * 256 + cc0 + bj * HALF + 4 * n); k2[bj][n] = *(const f32x4*)(c2 + u.bz * 256 + cc0 + bj * HALF + 4 * n); }
        float ms8[2][4], rs8[2][4];
#pragma unroll
        for (int ai = 0; ai < 2; ++ai)
#pragma unroll
            for (int m = 0; m < 4; ++m) { const int row = b * SEQ + u.pm * BM + rl0 + ai * HALF + m * 16; ms8[ai][m] = st[2 * row]; rs8[ai][m] = st[2 * row + 1]; }
#pragma unroll
        for (int ai = 0; ai < 2; ++ai)
#pragma unroll
            for (int m = 0; m < 4; ++m) { const int rl = rl0 + ai * HALF + m * 16;
                const float mean = ms8[ai][m] * (1.f / DM), rstd = rsqrtf(fmaxf(rs8[ai][m] * (1.f / DM) - mean * mean, 0.f) + LN_EPS);
                float mx = -__builtin_inff();
#pragma unroll
                for (int bj = 0; bj < 2; ++bj)
#pragma unroll
                    for (int n = 0; n < 2; ++n) { const f32x4 v = ((acc[ai][bj][m][n] - k1[bj][n] * mean) * rstd + k2[bj][n]) * scale; acc[ai][bj][m][n] = v;
                        mx = fmaxf(mx, fmaxf(fmaxf(v[0], v[1]), fmaxf(v[2], v[3]))); }
                mx = fmaxf(mx, __shfl_xor(mx, 16)); mx = fmaxf(mx, __shfl_xor(mx, 32));
                if (fq == 0) PMX[rl * 4 + wc] = mx; }
        asm volatile("s_waitcnt lgkmcnt(0)" ::: "memory"); __builtin_amdgcn_s_barrier(); asm volatile("" ::: "memory");
#pragma unroll
        for (int ai = 0; ai < 2; ++ai)
#pragma unroll
            for (int m = 0; m < 4; ++m) { const int rl = rl0 + ai * HALF + m * 16;
                const f32x4 q = *(const LAS f32x4*)(PMX + rl * 4); const float mx = fmaxf(fmaxf(q[0], q[1]), fmaxf(q[2], q[3]));
                float sm = 0.f;
#pragma unroll
                for (int bj = 0; bj < 2; ++bj)
#pragma unroll
                    for (int n = 0; n < 2; ++n) { f32x4 e = acc[ai][bj][m][n] - mx; e[0] = __expf(e[0]); e[1] = __expf(e[1]); e[2] = __expf(e[2]); e[3] = __expf(e[3]); acc[ai][bj][m][n] = e;
                        sm += (e[0] + e[1]) + (e[2] + e[3]); }
                sm += __shfl_xor(sm, 16); sm += __shfl_xor(sm, 32);
                if (fq == 0) PSM[rl * 4 + wc] = sm; }
        asm volatile("s_waitcnt lgkmcnt(0)" ::: "memory"); __builtin_amdgcn_s_barrier(); asm volatile("" ::: "memory");
#pragma unroll
        for (int ai = 0; ai < 2; ++ai)
#pragma unroll
            for (int m = 0; m < 4; ++m) { const int rl = rl0 + ai * HALF + m * 16, row = b * SEQ + u.pm * BM + rl;
                const f32x4 q = *(const LAS f32x4*)(PSM + rl * 4); const float inv = __builtin_amdgcn_rcpf((q[0] + q[1]) + (q[2] + q[3]));
                bf16_t* rowp = PALL + (size_t)row * 1024 + h * 256 + cc0;
#pragma unroll
                for (int bj = 0; bj < 2; ++bj) { const f32x4 v0 = acc[ai][bj][m][0] * inv, v1 = acc[ai][bj][m][1] * inv;
                    u32x4 w; w.x = cvt_pk_bf16(v0[0], v0[1]); w.y = cvt_pk_bf16(v0[2], v0[3]); w.z = cvt_pk_bf16(v1[0], v1[1]); w.w = cvt_pk_bf16(v1[2], v1[3]);
                    *(u32x4*)(rowp + bj * HALF) = w; } }
    }
};

template <class Epi, bool ALIGN_EPI>
__device__ __forceinline__ void gemm_phase(LAS unsigned char* lds, const Gemm g, const Order& S, const Epi& E) {
    const int tid = ltid(), wid = __builtin_amdgcn_readfirstlane(tid >> 6), lane = tid & 63, wr = wid >> 2, wc = wid & 3, fr = lane & 15, fq = lane >> 4;
    const int K = g.K, nt = K / BK;
    unsigned voffA[2], voffB[2];
#pragma unroll
    for (int i = 0; i < 2; ++i) { int R, C; stage_rc(tid * 16 + i * 8192, R, C); const int Rb = Epi::PERM ? ((R & ~31) + perm32(R & 31)) : R;
        voffA[i] = (unsigned)(R * g.lda + C) * 2u; voffB[i] = (unsigned)(Rb * g.ldb + C) * 2u; }
    const size_t kstep = (size_t)(BK * 2);
    const size_t hstepA = (size_t)HALF * g.lda * 2, hstepB = (size_t)HALF * g.ldb * 2;
    const unsigned ldsw = (unsigned)wid * 1024u;
    const int aoff = lds_byte(wr * 64 + fr, fq * 8), boff = lds_byte(wc * 32 + fr, fq * 8);
#define PG8_SA(b, h) (((b) * 2 + (h)) * HTB)
#define PG8_SB(b, h) ((4 + (b) * 2 + (h)) * HTB)
#define PG8_STAGE(bufoff, gbase, voff) do { _Pragma("unroll") for (int _i = 0; _i < 2; ++_i) \
        __builtin_amdgcn_global_load_lds((const unsigned*)((const char*)(gbase) + (voff)[_i]), (LAS unsigned*)(lds + (bufoff) + ldsw + _i * 8192), 16, 0, 0); } while (0)
#define PG8_LDA(dst, b, h) do { _Pragma("unroll") for (int m = 0; m < 4; ++m) _Pragma("unroll") for (int k = 0; k < 2; ++k) dst[m][k] = *(const LAS bf16x8*)(lds + PG8_SA(b, h) + aoff + m * 2048 + k * 1024); } while (0)
#define PG8_LDB(dst, b, h) do { _Pragma("unroll") for (int n = 0; n < 2; ++n) _Pragma("unroll") for (int k = 0; k < 2; ++k) dst[n][k] = *(const LAS bf16x8*)(lds + PG8_SB(b, h) + boff + n * 2048 + k * 1024); } while (0)
#define PG8_MMA(ai, bj, At, Bt) do { __builtin_amdgcn_s_setprio(1); _Pragma("unroll") for (int m = 0; m < 4; ++m) _Pragma("unroll") for (int n = 0; n < 2; ++n) _Pragma("unroll") for (int k = 0; k < 2; ++k) \
        acc[ai][bj][m][n] = __builtin_amdgcn_mfma_f32_16x16x32_bf16(Bt[n][k], At[m][k], acc[ai][bj][m][n], 0, 0, 0); __builtin_amdgcn_s_setprio(0); } while (0)
#define PG8_WAIT_V(n) asm volatile("s_waitcnt vmcnt(" #n ")" ::: "memory")
#define PG8_WAIT_L(n) asm volatile("s_waitcnt lgkmcnt(" #n ")" ::: "memory")
#define PG8_BAR __builtin_amdgcn_s_barrier()
#define PG8_SCHED __builtin_amdgcn_sched_barrier(0)
    Unit cur, nxt; int ui = 0;
    if (!S.next(0, cur)) return;
    f32x4 acc[2][2][4][2];
#pragma unroll
    for (int a = 0; a < 2; ++a)
#pragma unroll
        for (int b = 0; b < 2; ++b)
#pragma unroll
            for (int m = 0; m < 4; ++m)
#pragma unroll
                for (int n = 0; n < 2; ++n) acc[a][b][m][n] = (f32x4){0.f, 0.f, 0.f, 0.f};
    bf16x8 At[4][2], B0[2][2], B1[2][2];
    const char* cA = unit_a(g, cur); const char* cB = unit_b(g, cur);
    PG8_STAGE(PG8_SB(0, 0), cB, voffB); PG8_STAGE(PG8_SB(0, 1), cB + hstepB, voffB); PG8_STAGE(PG8_SA(0, 0), cA, voffA); PG8_STAGE(PG8_SA(0, 1), cA + hstepA, voffA);
    if (wr == 1) PG8_BAR;
    PG8_WAIT_V(2); PG8_BAR;
    PG8_STAGE(PG8_SB(1, 0), cB + kstep, voffB); PG8_STAGE(PG8_SA(1, 0), cA + kstep, voffA); PG8_STAGE(PG8_SB(1, 1), cB + hstepB + kstep, voffB);
    PG8_WAIT_V(6); PG8_BAR;
    for (;;) {
        const bool has_next = S.next(ui + 1, nxt);
        const char* nA = has_next ? unit_a(g, nxt) : cA; const char* nB = has_next ? unit_b(g, nxt) : cB;
        for (int t = 0; t < nt; t += 2) {
            const bool last = (t == nt - 2);
            const char* a1 = cA + (size_t)(t + 1) * kstep;
            const char* a2 = last ? nA : cA + (size_t)(t + 2) * kstep; const char* b2 = last ? nB : cB + (size_t)(t + 2) * kstep;
            const char* a3 = a2 + kstep; const char* b3 = b2 + kstep;
            PG8_LDB(B0, 0, 0); PG8_LDB(B1, 0, 1); PG8_SCHED; PG8_LDA(At, 0, 0); PG8_STAGE(PG8_SA(1, 1), a1 + hstepA, voffA);
            PG8_WAIT_V(8); PG8_WAIT_L(0); PG8_BAR; PG8_MMA(0, 0, At, B0); PG8_MMA(0, 1, At, B1); PG8_BAR; PG8_SCHED;
            PG8_LDA(At, 0, 1); PG8_STAGE(PG8_SB(0, 0), b2, voffB); PG8_STAGE(PG8_SB(0, 1), b2 + hstepB, voffB); PG8_STAGE(PG8_SA(0, 0), a2, voffA);
            PG8_WAIT_V(8); PG8_WAIT_L(0); PG8_BAR; PG8_MMA(1, 0, At, B0); PG8_MMA(1, 1, At, B1); PG8_BAR; PG8_SCHED;
            PG8_LDB(B0, 1, 0); PG8_LDB(B1, 1, 1); PG8_SCHED; PG8_LDA(At, 1, 0); PG8_STAGE(PG8_SA(0, 1), a2 + hstepA, voffA);
            PG8_WAIT_V(8); PG8_WAIT_L(0); PG8_BAR; PG8_MMA(0, 0, At, B0); PG8_MMA(0, 1, At, B1); PG8_BAR; PG8_SCHED;
            PG8_LDA(At, 1, 1); PG8_STAGE(PG8_SB(1, 0), b3, voffB); PG8_STAGE(PG8_SB(1, 1), b3 + hstepB, voffB); PG8_STAGE(PG8_SA(1, 0), a3, voffA);
            PG8_WAIT_V(8); PG8_WAIT_L(0); PG8_BAR; PG8_MMA(1, 0, At, B0); PG8_MMA(1, 1, At, B1); PG8_BAR; PG8_SCHED;
        }
        if constexpr (ALIGN_EPI) { if (wr == 0) PG8_BAR; }
        if constexpr (!Epi::AFTER_DRAIN) E(acc, cur, wr, wc, fr, fq);
        if (!has_next) break;
#pragma unroll
        for (int a = 0; a < 2; ++a)
#pragma unroll
            for (int b = 0; b < 2; ++b)
#pragma unroll
                for (int m = 0; m < 4; ++m)
#pragma unroll
                    for (int n = 0; n < 2; ++n) acc[a][b][m][n] = (f32x4){0.f, 0.f, 0.f, 0.f};
        cur = nxt; cA = nA; cB = nB; ++ui;
        if constexpr (ALIGN_EPI) { if (wr == 1) PG8_BAR; }
    }
    PG8_WAIT_V(0);
    if constexpr (!ALIGN_EPI) { if (wr == 0) PG8_BAR; }
    PG8_BAR;
    if constexpr (Epi::AFTER_DRAIN) E.fused(acc, cur, wr, wc, fr, fq, lds);
#undef PG8_SA
#undef PG8_SB
#undef PG8_STAGE
#undef PG8_LDA
#undef PG8_LDB
#undef PG8_MMA
#undef PG8_WAIT_V
#undef PG8_WAIT_L
#undef PG8_BAR
#undef PG8_SCHED
}
}

namespace att {
using bf16 = __hip_bfloat16;
typedef short s16x4 __attribute__((ext_vector_type(4)));
constexpr int D = 128;
constexpr float THR = 8.f;
constexpr float SCALE = 0.08838834764831845f;
constexpr int NW = 8, QBLK = 32, KVBLK = 64, QB = NW * QBLK;
constexpr int SHM_V = KVBLK * D * 2, SHM_K = KVBLK * D * 2;
constexpr int ATT_LDS = 2 * SHM_V + 2 * SHM_K + NW * 64 * 4;
constexpr int BT_OFF = ATT_LDS;

#define KSWZ(row, colB) ((row) * 256 + ((colB) ^ (((row) & 7) << 4)))
#define SBAR() __builtin_amdgcn_sched_barrier(0)
__device__ __forceinline__ int v_st(int k, int c) { const int kk = (k & ~0xC) | ((k & 4) << 1) | ((k & 8) >> 1); return ((kk >> 3) * 4 + (c >> 5)) * 512 + ((kk & 7) * 32 + (c & 31)) * 2; }
__device__ __forceinline__ int v_rd_base(int lane) { return ((lane & 3) << 3) | (((lane >> 2) & 3) << 6) | (((lane >> 4) & 1) << 5) | (((lane >> 5) & 1) << 8); }
constexpr int v_rd_off(int d0, int ks, int half) { return d0 * 512 + ks * 4096 + half * 2048; }
__device__ __forceinline__ int crow(int r, int hi) { return (r & 3) + 8 * (r >> 2) + 4 * hi; }
__device__ __forceinline__ unsigned cvtpk(float lo, float hi) { unsigned r; asm volatile("v_cvt_pk_bf16_f32 %0, %1, %2" : "=v"(r) : "v"(lo), "v"(hi)); return r; }
__device__ __forceinline__ bf16x8 load8(const bf16* p) { return *reinterpret_cast<const bf16x8*>(p); }
__device__ __forceinline__ void bias_mask_tile(f32x16& p0, f32x16& p1, int dq, const float* bt) {
    const float NEG = -__builtin_inff();
#pragma unroll
    for (int r = 0; r < 16; ++r) {
        const int c = (r & 3) + 8 * (r >> 2);
        const int d0 = dq - c, d1 = dq - c - 32;
        const unsigned i0 = (unsigned)d0 < 255u ? (unsigned)d0 : 255u, i1 = (unsigned)d1 < 255u ? (unsigned)d1 : 255u;
        const float b0 = bt[i0], b1 = bt[i1];
        p0[r] = d0 >= 0 ? p0[r] + b0 : NEG;
        p1[r] = d1 >= 0 ? p1[r] + b1 : NEG;
    }
}
__device__ __forceinline__ void partialSM(f32x16& p0, f32x16& p1, float& m_reg, float& mn, float& alpha) {
    float pmax = p0[0]; for (int r = 1; r < 16; ++r) pmax = fmaxf(pmax, p0[r]); for (int r = 0; r < 16; ++r) pmax = fmaxf(pmax, p1[r]);
    { auto rr = __builtin_amdgcn_permlane32_swap(__float_as_uint(pmax), __float_as_uint(pmax), false, false);
      pmax = fmaxf(__uint_as_float(rr[0]), __uint_as_float(rr[1])); }
    constexpr float C2 = 1.4426950408889634f * SCALE;
    if (__builtin_expect(__all((pmax - m_reg) * SCALE <= THR), 1)) { mn = m_reg; alpha = 1.f; }
    else { mn = fmaxf(m_reg, pmax); alpha = __builtin_amdgcn_exp2f((m_reg - mn) * C2); m_reg = mn; }
    const float mnL = -mn * C2;
    for (int r = 0; r < 16; ++r) p0[r] = fmaf(p0[r], C2, mnL); for (int r = 0; r < 16; ++r) p1[r] = fmaf(p1[r], C2, mnL);
    for (int r = 0; r < 16; ++r) p0[r] = __builtin_amdgcn_exp2f(p0[r]);
}
__device__ __forceinline__ void finishSM(f32x16& p0, f32x16& p1, float alpha, float& l_reg, bf16x8& pa0, bf16x8& pa1, bf16x8& pa2, bf16x8& pa3) {
    for (int r = 0; r < 16; ++r) p1[r] = __builtin_amdgcn_exp2f(p1[r]);
    float ps = 0; for (int r = 0; r < 16; ++r) ps += p0[r]; for (int r = 0; r < 16; ++r) ps += p1[r];
    { auto rr = __builtin_amdgcn_permlane32_swap(__float_as_uint(ps), __float_as_uint(ps), false, false);
      ps = __uint_as_float(rr[0]) + __uint_as_float(rr[1]); }
    l_reg = l_reg * alpha + ps;
#define PK4(P, B_, OUT) do { unsigned a0 = cvtpk(P[B_+0], P[B_+1]), a1 = cvtpk(P[B_+2], P[B_+3]);                          \
        unsigned b0 = cvtpk(P[B_+4], P[B_+5]), b1 = cvtpk(P[B_+6], P[B_+7]);                                             \
        auto r0 = __builtin_amdgcn_permlane32_swap(a0, b0, false, false); auto r1 = __builtin_amdgcn_permlane32_swap(a1, b1, false, false); \
        u32x4 w = {r0[0], r1[0], r0[1], r1[1]}; OUT = *reinterpret_cast<bf16x8*>(&w); } while (0)
    PK4(p0, 0, pa0); PK4(p0, 8, pa1); PK4(p1, 0, pa2); PK4(p1, 8, pa3);
#undef PK4
}
template <int KB>
__device__ __forceinline__ void qkt(f32x16& p0, f32x16& p1, const char* K_lds, int r32, int hi, const bf16x8* qr) {
    p0 = f32x16{}; p1 = f32x16{};
    const char* kb[4];
#pragma unroll
    for (int dd = 0; dd < 4; ++dd) kb[dd] = K_lds + KB * SHM_K + KSWZ(r32, (dd * 16 + hi * 8) * 2);
#pragma unroll
    for (int d0 = 0; d0 < 8; ++d0) { const char* a = kb[d0 & 3] + (d0 >> 2) * 128;
        bf16x8 b0 = *reinterpret_cast<const bf16x8*>(a);
        bf16x8 b1 = *reinterpret_cast<const bf16x8*>(a + 32 * 256);
        p0 = __builtin_amdgcn_mfma_f32_32x32x16_bf16(b0, qr[d0], p0, 0, 0, 0);
        p1 = __builtin_amdgcn_mfma_f32_32x32x16_bf16(b1, qr[d0], p1, 0, 0, 0); }
}
template <int VB>
__device__ __forceinline__ void pv_tile(f32x16* o, int vb0, bf16x8 pa0, bf16x8 pa1, bf16x8 pa2, bf16x8 pa3) {
#define TRRD(dst, off) asm volatile("ds_read_b64_tr_b16 %0, %1 offset:%2" : "=&v"(dst) : "v"(vb0), "i"(off) : "memory")
#define PV_D0(d0) do { s16x4 l0, l1, l2, l3, h0, h1, h2, h3; constexpr int b_ = VB * SHM_V + v_rd_off(d0, 0, 0); \
        TRRD(l0, b_); TRRD(h0, b_ + 2048); TRRD(l1, b_ + 4096); TRRD(h1, b_ + 6144); TRRD(l2, b_ + 8192); TRRD(h2, b_ + 10240); TRRD(l3, b_ + 12288); TRRD(h3, b_ + 14336); \
        asm volatile("s_waitcnt lgkmcnt(0)" ::: "memory"); SBAR();   \
        o[d0] = __builtin_amdgcn_mfma_f32_32x32x16_bf16(pa0, (bf16x8){l0[0], l0[1], l0[2], l0[3], h0[0], h0[1], h0[2], h0[3]}, o[d0], 0, 0, 0);   \
        o[d0] = __builtin_amdgcn_mfma_f32_32x32x16_bf16(pa1, (bf16x8){l1[0], l1[1], l1[2], l1[3], h1[0], h1[1], h1[2], h1[3]}, o[d0], 0, 0, 0);   \
        o[d0] = __builtin_amdgcn_mfma_f32_32x32x16_bf16(pa2, (bf16x8){l2[0], l2[1], l2[2], l2[3], h2[0], h2[1], h2[2], h2[3]}, o[d0], 0, 0, 0);   \
        o[d0] = __builtin_amdgcn_mfma_f32_32x32x16_bf16(pa3, (bf16x8){l3[0], l3[1], l3[2], l3[3], h3[0], h3[1], h3[2], h3[3]}, o[d0], 0, 0, 0); } while (0)
    PV_D0(0); PV_D0(1); PV_D0(2); PV_D0(3);
#undef PV_D0
#undef TRRD
}
struct BlockRef { const bf16* Q; const bf16* K; const bf16* V; float* O; int P0; int hm; };
struct Seam { bf16x8 qr[8]; bf16x8 st_v0, st_v1, st_k0, st_k1; };
#define ROW(p, k0, rr) ((p) + (size_t)((k0) + (rr)) * D + sc)
#define VMW() asm volatile("s_waitcnt vmcnt(0)" ::: "memory")
#define VMWN(n) asm volatile("s_waitcnt vmcnt(%0)" :: "i"(n) : "memory")
#define SLOAD_H(Kp, Vp, k0) do { S.st_v0 = load8(ROW(Vp, k0, sr)); S.st_v1 = load8(ROW(Vp, k0, 32 + sr));              \
                         S.st_k0 = load8(ROW(Kp, k0, sr)); S.st_k1 = load8(ROW(Kp, k0, 32 + sr)); } while (0)
#define SWRITE_HK(bf) do { *(bf16x8*)(K_lds + (bf) * SHM_K + kws) = S.st_k0; *(bf16x8*)(K_lds + (bf) * SHM_K + kws + 32 * 256) = S.st_k1; } while (0)
#define SWRITE_HV(bf) do { *(bf16x8*)(V_lds + (bf) * SHM_V + vst0) = S.st_v0; *(bf16x8*)(V_lds + (bf) * SHM_V + vst1) = S.st_v1; } while (0)
#define SWRITE_H(bf) do { SWRITE_HV(bf); SWRITE_HK(bf); } while (0)
__device__ __forceinline__ void attn_prime(const BlockRef& cur, char* lds, Seam& S) {
    const int tid = ltid(), wid = __builtin_amdgcn_readfirstlane(tid >> 6), lane = tid & 63, r32 = lane & 31, hi = lane >> 5;
    const int sr = tid >> 4, sc = (tid & 15) * 8, kws = KSWZ(sr, sc * 2); char* K_lds = lds + 2 * SHM_V;
    const int kb0 = 0;
    for (int d0 = 0; d0 < 8; ++d0) S.qr[d0] = load8(cur.Q + (size_t)(wid * QBLK + r32) * D + d0 * 16 + hi * 8);
    SLOAD_H(cur.K, cur.V, kb0); VMW(); SWRITE_HK(0);
    __syncthreads();
}
__device__ __forceinline__ void attn_block(const BlockRef& cur, const BlockRef& nxt, char* lds, Seam& S) {
    const int tid = ltid(), wid = __builtin_amdgcn_readfirstlane(tid >> 6), lane = tid & 63, r32 = lane & 31, hi = lane >> 5;
    const int j_lo = 0;
    const int j_hi = (cur.P0 + QB - 1) / KVBLK + 1;
    const int NT = j_hi - j_lo;
    const int kbn = 0;
    const int qlo = cur.P0 + wid * QBLK, qm = qlo + r32 - 4 * hi;
    char* V_lds = lds; char* K_lds = lds + 2 * SHM_V;
    float* ws = (float*)(lds + 2 * SHM_V + 2 * SHM_K) + wid * 64; float* li_l = ws, * al_l = ws + 32;
    const float* bt = (const float*)(lds + BT_OFF) + cur.hm * 256;
    float m_reg = -1e30f, l_reg = 0; f32x16 o[4] = {};
    const int sr = tid >> 4, sc = (tid & 15) * 8, vst0 = v_st(sr, sc), vst1 = v_st(32 + sr, sc), kws = KSWZ(sr, sc * 2);
    const int vb0 = (int)(uintptr_t)V_lds + v_rd_base(lane);
    const bf16* Kh = cur.K; const bf16* Vh = cur.V;
#define RESC(a) do { if (__any((a) < 1.f)) { if (hi == 0) al_l[r32] = (a); asm volatile("s_waitcnt lgkmcnt(0)" ::: "memory");              \
                     for (int d_ = 0; d_ < 4; ++d_) for (int r = 0; r < 16; ++r) o[d_][r] *= al_l[crow(r, hi)]; } } while (0)
#define KBASE(t) ((j_lo + (t)) * KVBLK)
#define MASKT(P0_, P1_, t) do { const int kb_ = KBASE(t); if (kb_ + KVBLK - 1 > qlo - 128) bias_mask_tile(P0_, P1_, qm - kb_, bt); } while (0)
    constexpr int NQL = 8;
#define SEAM_K0() do { VMWN(NQL); SWRITE_HK(0); SBAR(); } while (0)
    f32x16 pA0, pA1, pB0, pB1; float mnA, mnB, alA, alB; bf16x8 pa0, pa1, pa2, pa3;
    SWRITE_HV(0); SBAR();
    if (NT > 1) { SLOAD_H(Kh, Vh, KBASE(1)); }
    SBAR(); qkt<0>(pA0, pA1, K_lds, r32, hi, S.qr);
    MASKT(pA0, pA1, 0); partialSM(pA0, pA1, m_reg, mnA, alA);
    if (NT > 1) { VMW(); SWRITE_H(1); }
    __syncthreads();
#define HALF_STEP(PX0, PX1, mnX, alX, PY0, PY1, alY, t, KB, VB, SB) do {                                                      \
        SBAR(); qkt<KB>(PX0, PX1, K_lds, r32, hi, S.qr);                                             \
        finishSM(PY0, PY1, alY, l_reg, pa0, pa1, pa2, pa3); SBAR();                                                           \
        if ((t) + 1 < NT) { SLOAD_H(Kh, Vh, KBASE((t) + 1)); SBAR(); }                                               \
        pv_tile<VB>(o, vb0, pa0, pa1, pa2, pa3); MASKT(PX0, PX1, (t)); partialSM(PX0, PX1, m_reg, mnX, alX);                                        \
        __syncthreads();                                                                                                      \
        if ((t) + 1 < NT) { VMW(); SWRITE_H(SB); }                                                                          \
        RESC(alX); __syncthreads(); } while (0)
    for (int t = 1; t + 1 < NT; t += 2) {
        HALF_STEP(pB0, pB1, mnB, alB, pA0, pA1, alA, t, 1, 0, 0);
        HALF_STEP(pA0, pA1, mnA, alA, pB0, pB1, alB, t + 1, 0, 1, 1);
    }
    const bool even = (NT & 1) == 0;
    if (even) { SBAR(); qkt<1>(pB0, pB1, K_lds, r32, hi, S.qr); SBAR(); }
    SLOAD_H(nxt.K, nxt.V, kbn); SBAR();
#pragma unroll
    for (int d0 = 0; d0 < 8; ++d0) S.qr[d0] = load8(nxt.Q + (size_t)(wid * QBLK + r32) * D + d0 * 16 + hi * 8);
    SBAR();
    finishSM(pA0, pA1, alA, l_reg, pa0, pa1, pa2, pa3); SBAR();
    pv_tile<0>(o, vb0, pa0, pa1, pa2, pa3);
    if (even) { MASKT(pB0, pB1, NT - 1); partialSM(pB0, pB1, m_reg, mnB, alB); __syncthreads(); RESC(alB);
        finishSM(pB0, pB1, alB, l_reg, pa0, pa1, pa2, pa3); SBAR(); pv_tile<1>(o, vb0, pa0, pa1, pa2, pa3); }
    SBAR(); SEAM_K0();
    if (hi == 0) li_l[r32] = l_reg; asm volatile("s_waitcnt lgkmcnt(0)" ::: "memory");
    float rli[16];
#pragma unroll
    for (int r = 0; r < 16; ++r) rli[r] = __builtin_amdgcn_rcpf(li_l[crow(r, hi)]);
    float* Ow = cur.O + (size_t)(wid * QBLK) * D;
#pragma unroll
    for (int r = 0; r < 16; ++r) { const int orow = crow(r, hi);
#pragma unroll
        for (int d0 = 0; d0 < 4; ++d0) { const float v = o[d0][r] * rli[r]; Ow[(size_t)orow * D + d0 * 32 + r32] = v; } }
    __syncthreads();
#undef RESC
#undef KBASE
#undef MASKT
#undef SEAM_K0
#undef HALF_STEP
}
#undef ROW
#undef VMW
#undef VMWN
#undef SLOAD_H
#undef SWRITE_HK
#undef SWRITE_HV
#undef SWRITE_H
}

namespace att2 {
using att::bf16; using att::D; using att::SHM_K; using att::SHM_V;
constexpr int L_V = 0, L_K = 65536, L_P = 98304, L_AL = 131072, L_FL = 132096, L_LB = 132224, L_BT = 133120;
struct Blk { const bf16* Q; const bf16* K; const bf16* V0; const bf16* V1; float* O0; float* O1; int P0; int hm; };
__device__ __forceinline__ void qkt_rt(f32x16& p0, f32x16& p1, const char* Kb, int r32, int hi, const bf16x8* qr) {
    p0 = f32x16{}; p1 = f32x16{};
    const char* kb[4];
#pragma unroll
    for (int dd = 0; dd < 4; ++dd) kb[dd] = Kb + KSWZ(r32, (dd * 16 + hi * 8) * 2);
#pragma unroll
    for (int d0 = 0; d0 < 8; ++d0) { const char* a = kb[d0 & 3] + (d0 >> 2) * 128;
        bf16x8 b0 = *reinterpret_cast<const bf16x8*>(a);
        bf16x8 b1 = *reinterpret_cast<const bf16x8*>(a + 32 * 256);
        p0 = __builtin_amdgcn_mfma_f32_32x32x16_bf16(b0, qr[d0], p0, 0, 0, 0);
        p1 = __builtin_amdgcn_mfma_f32_32x32x16_bf16(b1, qr[d0], p1, 0, 0, 0); }
}
#define A2_LOADT(t) do { const size_t ro_ = (size_t)((t) * 64 + sr) * D + sc; \
        sk0 = att::load8(c.K + ro_); sk1 = att::load8(c.K + ro_ + 32 * D); sv00 = att::load8(c.V0 + ro_); sv01 = att::load8(c.V0 + ro_ + 32 * D); sv10 = att::load8(c.V1 + ro_); sv11 = att::load8(c.V1 + ro_ + 32 * D); } while (0)
#define A2_WRITET(buf) do { char* kd_ = lds + L_K + (buf) * SHM_K; char* vd_ = lds + L_V + (buf) * 2 * SHM_V; \
        *(bf16x8*)(kd_ + kws) = sk0; *(bf16x8*)(kd_ + kws + 32 * 256) = sk1; *(bf16x8*)(vd_ + vst0) = sv00; *(bf16x8*)(vd_ + vst1) = sv01; *(bf16x8*)(vd_ + SHM_V + vst0) = sv10; *(bf16x8*)(vd_ + SHM_V + vst1) = sv11; } while (0)
__device__ __forceinline__ void attn2_block(const Blk& c, char* lds) {
    const int tid = ltid(), wid = __builtin_amdgcn_readfirstlane(tid >> 6), lane = tid & 63, r32 = lane & 31, hi = lane >> 5;
    const int g = wid & 3;
    const int NT = (c.P0 + 127) / 64 + 1;
    const int sr = tid >> 4, sc = (tid & 15) * 8, kws = KSWZ(sr, sc * 2), vst0 = att::v_st(sr, sc), vst1 = att::v_st(32 + sr, sc);
    bf16x8 sk0, sk1, sv00, sv01, sv10, sv11;
    float* ALb = (float*)(lds + L_AL) + g * 64; unsigned* FLb = (unsigned*)(lds + L_FL) + g * 2; float* LBb = (float*)(lds + L_LB) + g * 32;
    char* Pb = lds + L_P + g * 8192;
    A2_LOADT(0);
    if (wid < 4) {
        bf16x8 qr[8];
#pragma unroll
        for (int d0 = 0; d0 < 8; ++d0) qr[d0] = att::load8(c.Q + (size_t)(g * 32 + r32) * D + d0 * 16 + hi * 8);
        asm volatile("s_waitcnt vmcnt(0)" ::: "memory"); A2_WRITET(0); __syncthreads();
        const int qlo = c.P0 + g * 32, qm = qlo + r32 - 4 * hi;
        const float* bt = (const float*)(lds + L_BT) + c.hm * 256;
        float m_reg = -1e30f, l_reg = 0.f;
        for (int s = 0; s <= NT; ++s) {
            const int par = s & 1;
            if (s + 1 < NT) A2_LOADT(s + 1);
            SBAR();
            if (s < NT) {
                f32x16 p0, p1; float mn, al; bf16x8 pa0, pa1, pa2, pa3;
                qkt_rt(p0, p1, lds + L_K + par * SHM_K, r32, hi, qr);
                const int kb_ = s * 64;
                if (kb_ + 63 > qlo - 128) att::bias_mask_tile(p0, p1, qm - kb_, bt);
                att::partialSM(p0, p1, m_reg, mn, al);
                att::finishSM(p0, p1, al, l_reg, pa0, pa1, pa2, pa3);
                char* pw = Pb + par * 4096 + lane * 16;
                *(bf16x8*)(pw) = pa0; *(bf16x8*)(pw + 1024) = pa1; *(bf16x8*)(pw + 2048) = pa2; *(bf16x8*)(pw + 3072) = pa3;
                if (hi == 0) ALb[par * 32 + r32] = al;
                const bool resc = __any(al < 1.f);
                if (lane == 0) FLb[par] = resc ? 1u : 0u;
            }
            __syncthreads();
            if (s + 1 < NT) { asm volatile("s_waitcnt vmcnt(0)" ::: "memory"); A2_WRITET((s + 1) & 1); }
            __syncthreads();
        }
        if (hi == 0) LBb[r32] = l_reg;
        __syncthreads();
        __syncthreads();
    } else {
        asm volatile("s_waitcnt vmcnt(0)" ::: "memory"); A2_WRITET(0); __syncthreads();
        f32x16 o[8];
#pragma unroll
        for (int d_ = 0; d_ < 8; ++d_) o[d_] = f32x16{};
        const int vbase = (int)(uintptr_t)(lds + L_V) + att::v_rd_base(lane);
        for (int s = 0; s <= NT; ++s) {
            if (s + 1 < NT) A2_LOADT(s + 1);
            SBAR();
            if (s >= 1) {
                const int par = (s - 1) & 1;
                const unsigned fl = (unsigned)__builtin_amdgcn_readfirstlane((int)FLb[par]);
                if (fl) {
#pragma unroll
                    for (int r = 0; r < 16; ++r) { const float a = ALb[par * 32 + att::crow(r, hi)];
#pragma unroll
                        for (int d_ = 0; d_ < 8; ++d_) o[d_][r] *= a; } }
                const char* pr = Pb + par * 4096 + lane * 16;
                const bf16x8 pa0 = *(const bf16x8*)(pr), pa1 = *(const bf16x8*)(pr + 1024), pa2 = *(const bf16x8*)(pr + 2048), pa3 = *(const bf16x8*)(pr + 3072);
                const int vb = vbase + par * 2 * SHM_V;
                att::pv_tile<0>(o, vb, pa0, pa1, pa2, pa3);
                att::pv_tile<0>(o + 4, vb + SHM_V, pa0, pa1, pa2, pa3);
            }
            __syncthreads();
            if (s + 1 < NT) { asm volatile("s_waitcnt vmcnt(0)" ::: "memory"); A2_WRITET((s + 1) & 1); }
            __syncthreads();
        }
        __syncthreads();
        float rli[16];
#pragma unroll
        for (int r = 0; r < 16; ++r) rli[r] = __builtin_amdgcn_rcpf(LBb[att::crow(r, hi)]);
#pragma unroll
        for (int hf = 0; hf < 2; ++hf) { float* Ow = (hf ? c.O1 : c.O0) + (size_t)(g * 32) * D;
#pragma unroll
            for (int r = 0; r < 16; ++r) { const int orow = att::crow(r, hi);
#pragma unroll
                for (int d0 = 0; d0 < 4; ++d0) Ow[(size_t)orow * D + d0 * 32 + r32] = o[hf * 4 + d0][r] * rli[r]; } }
        __syncthreads();
    }
}
#undef A2_LOADT
#undef A2_WRITET
}


#define XB_TMO      128
#define XB_XCNT(j)  (256  + 64 * (j))
#define XB_XSUB(j)  (1280 + 64 * (j))
#define XB_XGEN(j)  (2304 + 64 * (j))
#define XB_TOP      3328
#define XB_TOPGEN   3392
#define XCD_BAR_WORDS 3456
#define XB_SPIN_CAP (1u << 18)
__device__ __forceinline__ unsigned xb_ld(unsigned* p)              { return __hip_atomic_load(p, __ATOMIC_RELAXED, __HIP_MEMORY_SCOPE_AGENT); }
__device__ __forceinline__ unsigned xb_add(unsigned* p, unsigned v) { return __hip_atomic_fetch_add(p, v, __ATOMIC_RELAXED, __HIP_MEMORY_SCOPE_AGENT); }
__device__ __forceinline__ unsigned xb_xcc_id() { return (unsigned)__builtin_amdgcn_s_getreg((3 << 11) | 20) & 0xFu; }
#define XB_SPIN(cond, bar) do { unsigned _sp = 0; while (cond) { __builtin_amdgcn_s_sleep(1); \
    if ((++_sp & 255u) == 0u) { if (xb_ld(&(bar)[XB_TMO])) break; if (_sp > XB_SPIN_CAP) { atomicAdd(&(bar)[XB_TMO], 1u); break; } } } } while (0)
struct XcdBarrier { unsigned* bar; unsigned x; volatile LAS unsigned* st; };
__device__ __forceinline__ XcdBarrier xcd_barrier_post(unsigned* bar, volatile LAS unsigned* st) {
    XcdBarrier b; b.bar = bar; b.x = xb_xcc_id(); b.st = st;
    if (threadIdx.x == 0) (void)xb_add(&bar[XB_XCNT(b.x)], 1u);
    return b;
}
__device__ __forceinline__ void xcd_barrier_complete(unsigned* bar, unsigned x, unsigned& nloc, unsigned& nx) {
    const unsigned G = gridDim.x * gridDim.y * gridDim.z;
    unsigned sum, cnt, mine, sp = 0u;
    for (;;) {
        sum = 0u; cnt = 0u; mine = 0u;
#pragma unroll
        for (unsigned j = 0; j < 16; ++j) { const unsigned c = xb_ld(&bar[XB_XCNT(j)]); sum += c; cnt += (c > 0u) ? 1u : 0u; mine = (j == x) ? c : mine; }
        if (sum == G) break;
        __builtin_amdgcn_s_sleep(1);
        if ((++sp & 255u) == 0u) { if (xb_ld(&bar[XB_TMO])) break; if (sp > XB_SPIN_CAP) { atomicAdd(&bar[XB_TMO], 1u); break; } }
    }
    nloc = mine > 0u ? mine : 1u; nx = cnt > 0u ? cnt : 1u;
}
__device__ __forceinline__ void xcd_barrier(const XcdBarrier& b) {
    asm volatile("s_waitcnt vmcnt(0)" ::: "memory");
    __syncthreads();
    if (threadIdx.x == 0) {
        unsigned* bar = b.bar;
        __builtin_amdgcn_s_waitcnt(0);
        unsigned nloc = b.st[0], nx = b.st[1];
        if (nloc == 0u) { xcd_barrier_complete(bar, b.x, nloc, nx); b.st[0] = nloc; b.st[1] = nx; }
        const unsigned old = xb_add(&bar[XB_XSUB(b.x)], 1u);
        const unsigned gen = old / nloc;
        if (old + 1u == (gen + 1u) * nloc) {
            __builtin_amdgcn_fence(__ATOMIC_RELEASE, "agent");
            asm volatile("s_waitcnt vmcnt(0)" ::: "memory");
            const unsigned og = xb_add(&bar[XB_TOP], 1u);
            const unsigned tg = og / nx;
            if (og + 1u == (tg + 1u) * nx) xb_add(&bar[XB_TOPGEN], 1u);
            else XB_SPIN(xb_ld(&bar[XB_TOPGEN]) == tg, bar);
            __builtin_amdgcn_fence(__ATOMIC_ACQUIRE, "agent");
            xb_add(&bar[XB_XGEN(b.x)], 1u);
            asm volatile("s_waitcnt vmcnt(0)" ::: "memory");
        } else {
            XB_SPIN(xb_ld(&bar[XB_XGEN(b.x)]) == gen, bar);
            __builtin_amdgcn_fence(__ATOMIC_ACQUIRE, "agent");
            asm volatile("s_waitcnt vmcnt(0)" ::: "memory");
        }
    }
    __syncthreads();
}

struct Args { const float* in[24]; float* out; unsigned char* ws; };

__device__ __forceinline__ void p0_transpose_item(const float* W, int K, int N, bf16_t* WT, int swiglu, const float* gk, const float* bk, float* c1, float* c2, LAS float* scr, int item, int lane) {
    const int nblk = N / 64, kb = item / nblk, nb = item % nblk, k0 = 64 * kb, n0 = 64 * nb;
    const float* src = W + (size_t)(k0 + (lane >> 4)) * N + n0 + (lane & 15) * 4;
    f32x4 v[16];
#pragma unroll
    for (int i = 0; i < 16; ++i) v[i] = __builtin_nontemporal_load((const f32x4*)(src + (size_t)(4 * i) * N));
#pragma unroll
    for (int i = 0; i < 16; ++i) { LAS float* d = scr + (4 * i + (lane >> 4)) * 65 + (lane & 15) * 4; d[0] = v[i][0]; d[1] = v[i][1]; d[2] = v[i][2]; d[3] = v[i][3]; }
    asm volatile("s_waitcnt lgkmcnt(0)" ::: "memory");
    int r0 = n0;
    if (swiglu) { const int half = n0 / DFF, idx = n0 % DFF; r0 = 256 * (idx / 128) + 128 * half + (idx % 128); }
    const int c = lane & 7;
    float g8[8], b8[8];
#pragma unroll
    for (int e = 0; e < 8; ++e) { g8[e] = gk ? gk[k0 + 8 * c + e] : 1.f; b8[e] = gk ? bk[k0 + 8 * c + e] : 0.f; }
#pragma unroll
    for (int j = 0; j < 8; ++j) { const int n = (lane >> 3) + 8 * j; const LAS float* q = scr + (8 * c) * 65 + n;
        float w8[8];
#pragma unroll
        for (int e = 0; e < 8; ++e) w8[e] = q[e * 65];
        u32x4 o; o.x = cvt_pk_bf16(w8[0] * g8[0], w8[1] * g8[1]); o.y = cvt_pk_bf16(w8[2] * g8[2], w8[3] * g8[3]); o.z = cvt_pk_bf16(w8[4] * g8[4], w8[5] * g8[5]); o.w = cvt_pk_bf16(w8[6] * g8[6], w8[7] * g8[7]);
        *(u32x4*)(WT + (size_t)(r0 + n) * K + k0 + 8 * c) = o;
        if (gk) {
            float s1 = ((bf_lo(o.x) + bf_hi(o.x)) + (bf_lo(o.y) + bf_hi(o.y))) + ((bf_lo(o.z) + bf_hi(o.z)) + (bf_lo(o.w) + bf_hi(o.w)));
            float s2 = ((w8[0] * b8[0] + w8[1] * b8[1]) + (w8[2] * b8[2] + w8[3] * b8[3])) + ((w8[4] * b8[4] + w8[5] * b8[5]) + (w8[6] * b8[6] + w8[7] * b8[7]));
            s1 += __shfl_xor(s1, 1); s1 += __shfl_xor(s1, 2); s1 += __shfl_xor(s1, 4); s2 += __shfl_xor(s2, 1); s2 += __shfl_xor(s2, 2); s2 += __shfl_xor(s2, 4);
            if (c == 0) { unsafeAtomicAdd(c1 + r0 + n, s1); unsafeAtomicAdd(c2 + r0 + n, s2); }
        } }
    asm volatile("s_waitcnt lgkmcnt(0)" ::: "memory");
}

__device__ __forceinline__ void p0_wq_item(const float* W, bf16_t* WN, const float* gk, const float* bk, float* bW, int item, int lane) {
    const int kb = item >> 5, jb = item & 31, k0 = 64 * kb, j0 = 64 * jb, cg8 = lane & 7, kr = lane >> 3;
    float sacc[8];
#pragma unroll
    for (int e = 0; e < 8; ++e) sacc[e] = 0.f;
#pragma unroll
    for (int i = 0; i < 8; ++i) { const int k = k0 + 8 * i + kr; const float* src = W + (size_t)k * DM + j0 + 8 * cg8;
        const f32x4 v0 = __builtin_nontemporal_load((const f32x4*)src), v1 = __builtin_nontemporal_load((const f32x4*)(src + 4)); const float g = gk[k], bb = bk[k];
        u32x4 o; o.x = cvt_pk_bf16(v0[0] * g, v0[1] * g); o.y = cvt_pk_bf16(v0[2] * g, v0[3] * g); o.z = cvt_pk_bf16(v1[0] * g, v1[1] * g); o.w = cvt_pk_bf16(v1[2] * g, v1[3] * g);
        *(u32x4*)(WN + (size_t)k * DM + j0 + 8 * cg8) = o;
#pragma unroll
        for (int e = 0; e < 4; ++e) { sacc[e] += bb * v0[e]; sacc[4 + e] += bb * v1[e]; } }
#pragma unroll
    for (int e = 0; e < 8; ++e) { float v = sacc[e]; v += __shfl_xor(v, 8); v += __shfl_xor(v, 16); v += __shfl_xor(v, 32); if (kr == 0) unsafeAtomicAdd(bW + j0 + 8 * cg8 + e, v); }
}

__device__ __forceinline__ int causal_bucket(int n) {
    if (n < 16) return n;
    const float nf = (float)n;
    int large = 16 + (int)(logf(nf / 16.f) / 2.0794415416798357f * 16.f);
    return large < 31 ? large : 31;
}

__device__ __forceinline__ size_t zero_opaque() { size_t z = 0; asm volatile("" : "+s"(z)); return z; }
__device__ __forceinline__ const float* inp_ptr(const Args& a, int k) { return a.in[k] + zero_opaque(); }
#define INP(k) inp_ptr(a, k)
__device__ __forceinline__ unsigned char* ws_opaque(const Args& a) { return a.ws + zero_opaque(); }
__device__ __forceinline__ float* out_opaque(const Args& a) { return a.out + zero_opaque(); }
#define WSP(type, off) ((type*)(ws_opaque(a) + (off)))
__global__ void __launch_bounds__(NTHR, 2) mega_fwd(Args a) {
    extern __shared__ __attribute__((aligned(16))) unsigned char lds[];
    volatile LAS unsigned* bst = (volatile LAS unsigned*)((LAS unsigned char*)lds + LDS_BYTES - 64);
    if (threadIdx.x == 0) { bst[0] = 0u; bst[1] = 0u; }
    __syncthreads();
    (void)xcd_barrier_post((unsigned*)(a.ws + WS_BAR), bst);
#define GRID_BAR() do { XcdBarrier xb_; xb_.bar = (unsigned*)(ws_opaque(a) + WS_BAR); unsigned x_ = xb_xcc_id(); asm volatile("" : "+s"(x_)); xb_.x = x_; xb_.st = bst; xcd_barrier(xb_); } while (0)
    const int G = gridDim.x;
    const int NGW = G * NWAVES, NGT = G * NTHR;
    {
        PH_IDS;
        unsigned char* ws = ws_opaque(a);
        float* lamp = (float*)(ws + WS_LAM); float* btab = (float*)(ws + WS_BTAB); bf16_t* wtril = (bf16_t*)(ws + WS_WTRIL); bf16_t* membf = (bf16_t*)(ws + WS_MEMBF); bf16_t* XN = (bf16_t*)(ws + WS_XN);
        LAS float* scr = (LAS float*)((LAS unsigned char*)lds + wave * 17408);
        constexpr int I_IN = 32 * 88, I_SQ = 32 * 32, I_KV = 32 * 64, I_GU = 32 * 176, I_D = 88 * 32;
        constexpr int PER_LAYER = I_IN + 3 * I_SQ + I_KV + I_GU + I_D;
        for (int it = gw; it < 2 * PER_LAYER; it += NGW) {
            const int l = it / PER_LAYER; int r = it % PER_LAYER;
            unsigned char* wl = ws + WS_W + (size_t)l * W_LAYER;
            float* cl = (float*)(ws + WS_C) + (size_t)l * C_LAYER;
            if (r < I_IN) { const bool f = l > 0;
                p0_transpose_item(INP(3) + (size_t)l * DM * INC, DM, INC, (bf16_t*)(wl + W_IN), 0, f ? INP(22) : nullptr, f ? INP(23) : nullptr, cl + C_IN, cl + C_IN + INC, scr, r, lane); continue; } r -= I_IN;
            if (r < I_SQ) { p0_transpose_item(INP(12) + (size_t)l * DM * DM, DM, DM, (bf16_t*)(wl + W_OUT), 0, nullptr, nullptr, nullptr, nullptr, scr, r, lane); continue; } r -= I_SQ;
            if (r < I_SQ) { p0_wq_item(INP(15) + (size_t)l * DM * DM, (bf16_t*)(wl + W_Q), INP(13) + (size_t)l * DM, INP(14) + (size_t)l * DM, cl + C_Q + DM, r, lane); continue; } r -= I_SQ;
            if (r < I_KV) { p0_transpose_item(INP(16) + (size_t)l * DM * 2 * DM, DM, 2 * DM, (bf16_t*)(wl + W_KV), 0, nullptr, nullptr, nullptr, nullptr, scr, r, lane); continue; } r -= I_KV;
            if (r < I_SQ) { p0_transpose_item(INP(17) + (size_t)l * DM * DM, DM, DM, (bf16_t*)(wl + W_O), 0, nullptr, nullptr, nullptr, nullptr, scr, r, lane); continue; } r -= I_SQ;
            if (r < I_GU) { p0_transpose_item(INP(20) + (size_t)l * DM * 2 * DFF, DM, 2 * DFF, (bf16_t*)(wl + W_GU), 1, INP(18) + (size_t)l * DM, INP(19) + (size_t)l * DM, cl + C_GU, cl + C_GU + 2 * DFF, scr, r, lane); continue; } r -= I_GU;
            p0_transpose_item(INP(21) + (size_t)l * DFF * DM, DFF, DM, (bf16_t*)(wl + W_D), 0, nullptr, nullptr, nullptr, nullptr, scr, r, lane);
        }
        for (size_t i = gt; i < (size_t)T * DM / 8; i += (size_t)4 * NGT) {
            f32x4 v0[4], v1[4];
#pragma unroll
            for (int q = 0; q < 4; ++q) { const float* xp = INP(0) + (i + (size_t)q * NGT) * 8; v0[q] = __builtin_nontemporal_load((const f32x4*)xp); v1[q] = __builtin_nontemporal_load((const f32x4*)(xp + 4)); }
#pragma unroll
            for (int q = 0; q < 4; ++q) { u32x4 w; w.x = cvt_pk_bf16(v0[q][0], v0[q][1]); w.y = cvt_pk_bf16(v0[q][2], v0[q][3]); w.z = cvt_pk_bf16(v1[q][0], v1[q][1]); w.w = cvt_pk_bf16(v1[q][2], v1[q][3]);
                *(u32x4*)(XN + (i + (size_t)q * NGT) * 8) = w; }
        }
        for (size_t i = gt; i < (size_t)BATCH * NMEM * DM / 8; i += NGT) {
            const f32x4 v0 = *(const f32x4*)(INP(1) + i * 8), v1 = *(const f32x4*)(INP(1) + i * 8 + 4);
            u32x4 w; w.x = cvt_pk_bf16(v0[0], v0[1]); w.y = cvt_pk_bf16(v0[2], v0[3]); w.z = cvt_pk_bf16(v1[0], v1[1]); w.w = cvt_pk_bf16(v1[2], v1[3]);
            *(u32x4*)(membf + i * 8) = w;
        }
        for (int i = gt; i < DEPTH * 4 * 128 * 128; i += NGT) { const int s = i & 127, t = (i >> 7) & 127; wtril[i] = s <= t ? f2bf(INP(7)[i]) : (bf16_t)0; }
        if (gt < 8 * 256) { const int hm = gt >> 8, d = gt & 255; const float* rb = INP(2);
            btab[gt] = (rb[causal_bucket(d) * 8 + hm] - rb[31 * 8 + hm]) * (1.f / att::SCALE); }
        if (cu == 0 && wave == 0) {
            for (int l = 0; l < DEPTH; ++l) {
                const float* lq = INP(9) + l * 256; const float* lk = INP(10) + l * 256;
                float s0 = lq[lane] * lk[lane] + lq[lane + 64] * lk[lane + 64];
                float s1 = lq[128 + lane] * lk[128 + lane] + lq[192 + lane] * lk[192 + lane];
                s0 = wave_sum(s0); s1 = wave_sum(s1);
                const float lam_init = 0.8f - 0.6f * expf(-0.3f * (float)l);
                if (lane == 0) lamp[l] = expf(s0) - expf(s1) + lam_init;
            }
        }
    }
    GRID_BAR();

#pragma unroll 1
    for (int l = 0; l < DEPTH; ++l) {
        {
            unsigned char* ws = ws_opaque(a);
            pg8::Gemm g{(const bf16_t*)(ws + WS_XN), (const bf16_t*)(ws + WS_W + (size_t)l * W_LAYER + W_IN), DM, DM, DM, 1, 0, 0, 0, 0};
            pg8::Order S; S.init(T, INC, 1, G, cu_opaque());
            const float* cl = (const float*)(ws + WS_C) + (size_t)l * C_LAYER;
            const float* st = l > 0 ? (const float*)(ws + WS_ST) + (size_t)(3 * l - 1) * T * 2 : nullptr;
            pg8::EpiSplit E{(bf16_t*)(ws + WS_PROJ), st, cl + C_IN, cl + C_IN + INC, (float*)(ws + WS_ST) + (size_t)(6 + l) * T * 2};
            pg8::gemm_phase<pg8::EpiSplit, true>((LAS unsigned char*)lds, g, S, E);
        }
        if (l == 0) {
            {
                unsigned char* ws = ws_opaque(a);
                pg8::Gemm g{(const bf16_t*)(ws + WS_MEMBF), (const bf16_t*)(ws + WS_W + W_KV), DM, DM, DM, 1, 0, 0, (long)(W_LAYER / 2), 0};
                pg8::Order S; const int cu = cu_opaque(); S.init(BATCH * NMEM, 2 * DM, 2, G, cu >= 128 && cu < 192 ? cu - 128 : -1);
                pg8::EpiBf16 E{(bf16_t*)(ws + WS_KV), 2 * DM, 1, (long)(BATCH * NMEM) * 2 * DM, 0, 1.f, nullptr, nullptr, nullptr, nullptr};
                pg8::gemm_phase<pg8::EpiBf16, true>((LAS unsigned char*)lds, g, S, E);
            }
        }
        GRID_BAR();

        if (l == 0) {
#pragma unroll 1
            for (int L2 = 0; L2 < DEPTH; ++L2) {
                {
                    unsigned char* ws = ws_opaque(a); unsigned char* wl2 = ws + WS_W + (size_t)L2 * W_LAYER;
                    const bf16_t* KVl = (const bf16_t*)(ws + WS_KV) + (size_t)L2 * BATCH * NMEM * 2 * DM;
                    float* cl = (float*)(ws + WS_C) + (size_t)L2 * C_LAYER;
                    pg8::Gemm g{KVl, (const bf16_t*)(wl2 + W_Q), 2 * DM, DM, 512, 4, (long)NMEM * 2 * DM, 512, 0, 512};
                    pg8::Order S; const int cu = cu_opaque(); S.init(NMEM, DM, 8, G, cu >= 64 * L2 && cu < 64 * L2 + 64 ? cu - 64 * L2 : -1);
                    pg8::EpiBf16 E{(bf16_t*)(wl2 + W_KV), DM, 1, (long)NMEM * DM, 0, 1.f, nullptr, nullptr, nullptr, cl + C_Q};
                    pg8::gemm_phase<pg8::EpiBf16, true>((LAS unsigned char*)lds, g, S, E);
                }
                {
                    unsigned char* ws = ws_opaque(a); unsigned char* wl2 = ws + WS_W + (size_t)L2 * W_LAYER;
                    const bf16_t* KVl = (const bf16_t*)(ws + WS_KV) + (size_t)L2 * BATCH * NMEM * 2 * DM;
                    pg8::Gemm g{(const bf16_t*)(wl2 + W_O), KVl + DM, DM, 2 * DM, 512, 4, 0, 512, (long)NMEM * 2 * DM, 512};
                    pg8::Order S; const int cu = cu_opaque(); S.init(DM, NMEM, 8, G, cu >= 128 + 64 * L2 && cu < 192 + 64 * L2 ? cu - 128 - 64 * L2 : -1);
                    pg8::EpiBf16 E{(bf16_t*)(wl2 + W_KV + 8 * MiB), 1024, 4, (long)DM * 1024, 256, 1.f, nullptr, nullptr, nullptr, nullptr};
                    pg8::gemm_phase<pg8::EpiBf16, true>((LAS unsigned char*)lds, g, S, E);
                }
            }
            {
                PH_IDS;
                unsigned char* ws = ws_opaque(a);
                for (int it = gw; it < DEPTH * 2048; it += NGW) {
                    const int L2 = it >> 11, r = it & 2047, b = r >> 10, h = (r >> 8) & 3, n = r & 255;
                    const bf16_t* kp = (const bf16_t*)(ws + WS_KV) + ((size_t)L2 * BATCH * NMEM + b * NMEM + n) * 2 * DM + h * 512 + 8 * lane;
                    float* cl = (float*)(ws + WS_C) + (size_t)L2 * C_LAYER;
                    const float* bw = cl + C_Q + DM + h * 512 + 8 * lane;
                    const u32x4 kw = *(const u32x4*)kp; const f32x4 b0 = *(const f32x4*)bw, b1 = *(const f32x4*)(bw + 4);
                    float d = (bf_lo(kw.x) * b0[0] + bf_hi(kw.x) * b0[1]) + (bf_lo(kw.y) * b0[2] + bf_hi(kw.y) * b0[3]) + (bf_lo(kw.z) * b1[0] + bf_hi(kw.z) * b1[1]) + (bf_lo(kw.w) * b1[2] + bf_hi(kw.w) * b1[3]);
                    d = wave_sum(d);
                    if (lane == 0) cl[C_QK2 + r] = d;
                }
            }
            __syncthreads();
        }
        {
            PH_IDS;
            bf16_t* PB = WSP(bf16_t, WS_PROJ); bf16_t* Y = WSP(bf16_t, WS_Y);
            const float* cw = INP(4) + (size_t)l * 3 * 512;
            const int cg8 = tid & 63, c0 = cg8 * 8, gi = cg8 >> 4, cc = c0 & 127;
            float k0[8], k1[8], k2[8];
#pragma unroll
            for (int e = 0; e < 8; ++e) { k0[e] = cw[c0 + e]; k1[e] = cw[512 + c0 + e]; k2[e] = cw[1024 + c0 + e]; }
            for (int r4 = gt >> 6; r4 < T / 4; r4 += NGT >> 6) {
                const int r = 4 * r4, t = r & (SEQ - 1);
                const bf16_t* pb = PB + ((size_t)(0 + gi) * T + r) * 128 + cc;
                const bf16_t* pc = PB + ((size_t)(4 + gi) * T + r) * 128 + cc;
                const bf16_t* ph = PB + ((size_t)(8 + gi) * T + r) * 128 + cc;
                u32x4 wc[6], wh[6], wb[4];
#pragma unroll
                for (int i = 0; i < 6; ++i) { wc[i] = (u32x4){0, 0, 0, 0}; wh[i] = (u32x4){0, 0, 0, 0}; }
                if (t >= 2) { wc[0] = *(const u32x4*)(pc - 256); wh[0] = *(const u32x4*)(ph - 256); wc[1] = *(const u32x4*)(pc - 128); wh[1] = *(const u32x4*)(ph - 128); }
#pragma unroll
                for (int i = 0; i < 4; ++i) { wc[2 + i] = *(const u32x4*)(pc + i * 128); wh[2 + i] = *(const u32x4*)(ph + i * 128); wb[i] = *(const u32x4*)(pb + i * 128); }
                float z[6][8];
#pragma unroll
                for (int i = 0; i < 6; ++i)
#pragma unroll
                    for (int j = 0; j < 4; ++j) { z[i][2 * j] = bf_lo(wc[i][j]) * bf_lo(wh[i][j]); z[i][2 * j + 1] = bf_hi(wc[i][j]) * bf_hi(wh[i][j]); }
#pragma unroll
                for (int i = 0; i < 4; ++i) { float y[8];
#pragma unroll
                    for (int j = 0; j < 4; ++j) {
                        y[2 * j] = bf_lo(wb[i][j]) * (k0[2 * j] * z[i][2 * j] + k1[2 * j] * z[i + 1][2 * j] + k2[2 * j] * z[i + 2][2 * j]);
                        y[2 * j + 1] = bf_hi(wb[i][j]) * (k0[2 * j + 1] * z[i][2 * j + 1] + k1[2 * j + 1] * z[i + 1][2 * j + 1] + k2[2 * j + 1] * z[i + 2][2 * j + 1]); }
                    u32x4 w; w.x = cvt_pk_bf16(y[0], y[1]); w.y = cvt_pk_bf16(y[2], y[3]); w.z = cvt_pk_bf16(y[4], y[5]); w.w = cvt_pk_bf16(y[6], y[7]);
                    *(u32x4*)(Y + (size_t)(r + i) * DM + c0) = w; }
            }
        }
        {
            PH_IDS;
            bf16_t* PB = WSP(bf16_t, WS_PROJ); bf16_t* Y = WSP(bf16_t, WS_Y); bf16_t* wtril = WSP(bf16_t, WS_WTRIL);
            float* st = (float*)(lds + 40960);
            bf16_t* vT = (bf16_t*)lds;
            const float* lng = INP(5) + (size_t)l * 512; const float* lnb = INP(6) + (size_t)l * 512;
            const float* bs = INP(8) + (size_t)l * 512;
            const float* gstat = WSP(float, WS_ST) + (size_t)(6 + l) * T * 2;
            float* svL = (float*)(lds + 49152);
            for (int un = cu; un < (T / 128) * 4; un += G) {
                const int ch = un >> 2, gi = un & 3, r0 = ch * 128;
                if (tid < 128) {
                    const float s1 = gstat[2 * (r0 + tid)], s2 = gstat[2 * (r0 + tid) + 1];
                    const float mean = s1 * (1.f / 512.f), var = fmaxf(s2 * (1.f / 512.f) - mean * mean, 0.f);
                    st[2 * tid] = mean; st[2 * tid + 1] = rsqrtf(var + LN_EPS); }
                __syncthreads();
                {
                    const int tok = tid >> 2, cq = (tid & 3) * 32; const float mean = st[2 * tok], rstd = st[2 * tok + 1];
                    const bf16_t* vp = PB + ((size_t)(16 + gi) * T + r0 + tok) * 128 + cq;
#pragma unroll
                    for (int i = 0; i < 4; ++i) { const u32x4 w = *(const u32x4*)(vp + 8 * i);
#pragma unroll
                        for (int j = 0; j < 4; ++j) { const int c = cq + 8 * i + 2 * j;
                            const float x0 = gelu_tanh(bf_lo(w[j])), x1 = gelu_tanh(bf_hi(w[j]));
                            vT[c * 136 + tok] = f2bf((x0 - mean) * rstd * lng[gi * 128 + c] + lnb[gi * 128 + c]);
                            vT[(c + 1) * 136 + tok] = f2bf((x1 - mean) * rstd * lng[gi * 128 + c + 1] + lnb[gi * 128 + c + 1]); } }
                }
                __syncthreads();
                {
                    f32x4 acc[8];
#pragma unroll
                    for (int ct = 0; ct < 8; ++ct) acc[ct] = (f32x4){0.f, 0.f, 0.f, 0.f};
                    const bf16_t* wrow = wtril + ((size_t)(l * 4 + gi) * 128 + 16 * wave + (lane & 15)) * 128 + 8 * (lane >> 4);
#pragma unroll
                    for (int kk = 0; kk < 4; ++kk) { const bf16x8 av = *(const bf16x8*)(wrow + kk * 32);
#pragma unroll
                        for (int ct = 0; ct < 8; ++ct) { const bf16x8 bv = *(const bf16x8*)(vT + (ct * 16 + (lane & 15)) * 136 + kk * 32 + 8 * (lane >> 4));
                            acc[ct] = __builtin_amdgcn_mfma_f32_16x16x32_bf16(av, bv, acc[ct], 0, 0, 0); } }
#pragma unroll
                    for (int j = 0; j < 4; ++j) { const int t = 16 * wave + 4 * (lane >> 4) + j; const float bt = bs[gi * 128 + t];
#pragma unroll
                        for (int ct = 0; ct < 8; ++ct) svL[t * 132 + ct * 16 + (lane & 15)] = acc[ct][j] + bt; }
                }
                __syncthreads();
                {
                    const int c0 = (tid & 15) * 8;
#pragma unroll
                    for (int i = 0; i < 4; ++i) { const int t = 32 * i + (tid >> 4);
                        const u32x4 uw = *(const u32x4*)(PB + ((size_t)(12 + gi) * T + r0 + t) * 128 + c0);
                        const f32x4 s0 = *(const f32x4*)(svL + t * 132 + c0), s1 = *(const f32x4*)(svL + t * 132 + c0 + 4);
                        u32x4 w; w.x = cvt_pk_bf16(gelu_tanh(bf_lo(uw.x)) * s0[0], gelu_tanh(bf_hi(uw.x)) * s0[1]); w.y = cvt_pk_bf16(gelu_tanh(bf_lo(uw.y)) * s0[2], gelu_tanh(bf_hi(uw.y)) * s0[3]);
                        w.z = cvt_pk_bf16(gelu_tanh(bf_lo(uw.z)) * s1[0], gelu_tanh(bf_hi(uw.z)) * s1[1]); w.w = cvt_pk_bf16(gelu_tanh(bf_lo(uw.w)) * s1[2], gelu_tanh(bf_hi(uw.w)) * s1[3]);
                        *(u32x4*)(Y + (size_t)(r0 + t) * DM + 512 + gi * 128 + c0) = w; }
                }
                __syncthreads();
            }
        }
        {
            PH_IDS;
            bf16_t* PB = WSP(bf16_t, WS_PROJ); float* OATT = WSP(float, WS_R1); float* btab = WSP(float, WS_BTAB);
            float* btl = (float*)(lds + att2::L_BT);
            for (int i = tid; i < 8 * 256; i += NTHR) btl[i] = btab[i];
            __syncthreads();
            const att::bf16* PBb = (const att::bf16*)PB;
#pragma unroll 1
            for (int L = cu; L < 512; L += G) {
                const int k_ = L >> 3, hm = L & 7, b = k_ >> 5, x = k_ & 31, h = hm >> 1;
#pragma unroll 1
                for (int pass = 0; pass < 2; ++pass) {
                    const int qb = pass ? 63 - x : x;
                    att2::Blk c;
                    c.Q = PBb + ((size_t)(20 + hm) * T + (size_t)b * SEQ + qb * 128) * 128; c.K = PBb + ((size_t)(28 + hm) * T + (size_t)b * SEQ) * 128;
                    c.V0 = PBb + ((size_t)(36 + h * 2) * T + (size_t)b * SEQ) * 128; c.V1 = PBb + ((size_t)(37 + h * 2) * T + (size_t)b * SEQ) * 128;
                    c.O0 = OATT + ((size_t)((b * 8 + hm) * 2 + 0) * SEQ + qb * 128) * 128; c.O1 = OATT + ((size_t)((b * 8 + hm) * 2 + 1) * SEQ + qb * 128) * 128;
                    c.P0 = qb * 128; c.hm = hm;
                    att2::attn2_block(c, (char*)lds);
                }
            }
        }
        GRID_BAR();

        {
            PH_IDS;
            float* OATT = WSP(float, WS_R1); bf16_t* Y = WSP(bf16_t, WS_Y); float* lamp = WSP(float, WS_LAM);
            const float lam_init = 0.8f - 0.6f * expf(-0.3f * (float)l);
            const float lam = lamp[l]; const float* sg = INP(11) + (size_t)l * 256;
            const f32x4 gv = *(const f32x4*)(sg + 4 * lane);
            for (int it = gw; it < T * 4; it += 2 * NGW) {
                const int half = lane >> 5, e = (lane & 31) * 4;
                const int itb = it + NGW;
                const int ra = it >> 2, ha = it & 3, ba = ra >> 13, ta = ra & (SEQ - 1);
                const int rb = itb >> 2, hb = itb & 3, bb = rb >> 13, tb = rb & (SEQ - 1);
                const size_t a0 = ((size_t)(((ba * 4 + ha) * 2 + 0) * 2 + half) * SEQ + ta) * 128 + e, a1 = ((size_t)(((ba * 4 + ha) * 2 + 1) * 2 + half) * SEQ + ta) * 128 + e;
                const size_t b0 = ((size_t)(((bb * 4 + hb) * 2 + 0) * 2 + half) * SEQ + tb) * 128 + e, b1 = ((size_t)(((bb * 4 + hb) * 2 + 1) * 2 + half) * SEQ + tb) * 128 + e;
                const f32x4 oa0 = *(const f32x4*)(OATT + a0), oa1 = *(const f32x4*)(OATT + a1), ob0 = *(const f32x4*)(OATT + b0), ob1 = *(const f32x4*)(OATT + b1);
                const f32x4 da = oa0 - oa1 * lam, db = ob0 - ob1 * lam;
                const float ssa = wave_sum(da[0] * da[0] + da[1] * da[1] + da[2] * da[2] + da[3] * da[3]);
                const float ssb = wave_sum(db[0] * db[0] + db[1] * db[1] + db[2] * db[2] + db[3] * db[3]);
                const float sca = rsqrtf(ssa * (1.f / 256.f) + LN_EPS) * (1.f - lam_init), scb = rsqrtf(ssb * (1.f / 256.f) + LN_EPS) * (1.f - lam_init);
                u32x2 wa; wa.x = cvt_pk_bf16(da[0] * sca * gv[0], da[1] * sca * gv[1]); wa.y = cvt_pk_bf16(da[2] * sca * gv[2], da[3] * sca * gv[3]);
                u32x2 wb; wb.x = cvt_pk_bf16(db[0] * scb * gv[0], db[1] * scb * gv[1]); wb.y = cvt_pk_bf16(db[2] * scb * gv[2], db[3] * scb * gv[3]);
                *(u32x2*)(Y + (size_t)ra * DM + 1024 + ha * 256 + 4 * lane) = wa;
                *(u32x2*)(Y + (size_t)rb * DM + 1024 + hb * 256 + 4 * lane) = wb;
            }
        }
        GRID_BAR();

#define LN_OUT_PASS(gam, bet) do { PH_IDS; float* X = out_opaque(a); const bf16_t* ZB = WSP(bf16_t, WS_XN); \
            for (int r0_ = gw; r0_ < T; r0_ += 2 * NGW) { u32x4 wq[2][4];                          \
                _Pragma("unroll") for (int q = 0; q < 2; ++q) _Pragma("unroll") for (int j = 0; j < 4; ++j) wq[q][j] = *(const u32x4*)(ZB + (size_t)(r0_ + q * NGW) * DM + 8 * lane + 512 * j); \
                _Pragma("unroll") for (int q = 0; q < 2; ++q) { const int r = r0_ + q * NGW; float* xr = X + (size_t)r * DM; f32x4 v[8]; float s = 0.f; \
                    _Pragma("unroll") for (int j = 0; j < 4; ++j) { const u32x4 w = wq[q][j]; \
                        v[2 * j] = (f32x4){bf_lo(w.x), bf_hi(w.x), bf_lo(w.y), bf_hi(w.y)}; v[2 * j + 1] = (f32x4){bf_lo(w.z), bf_hi(w.z), bf_lo(w.w), bf_hi(w.w)}; } \
                    _Pragma("unroll") for (int j = 0; j < 8; ++j) s += (v[j][0] + v[j][1]) + (v[j][2] + v[j][3]); \
                    const float mean = wave_sum(s) * (1.f / DM); float s2 = 0.f; \
                    _Pragma("unroll") for (int j = 0; j < 8; ++j) { v[j] = v[j] - mean; s2 += (v[j][0] * v[j][0] + v[j][1] * v[j][1]) + (v[j][2] * v[j][2] + v[j][3] * v[j][3]); } \
                    const float rstd = rsqrtf(wave_sum(s2) * (1.f / DM) + LN_EPS); \
                    _Pragma("unroll") for (int j = 0; j < 8; ++j) { const int c = 8 * lane + 512 * (j >> 1) + 4 * (j & 1); \
                        const f32x4 gg = *(const f32x4*)((gam) + c), bb = *(const f32x4*)((bet) + c); \
                        *(f32x4*)(xr + c) = v[j] * rstd * gg + bb; } } } } while (0)

        {
            unsigned char* ws = ws_opaque(a); float* X = out_opaque(a); float* ST = (float*)(ws + WS_ST);
            pg8::Gemm g{(const bf16_t*)(ws + WS_Y), (const bf16_t*)(ws + WS_W + (size_t)l * W_LAYER + W_OUT), DM, DM, DM, 1, 0, 0, 0, 0};
            pg8::Order S; S.init(T, DM, 1, G, cu_opaque());
            pg8::EpiRes E{nullptr, l == 0 ? INP(0) : nullptr, ST + (size_t)(l > 0 ? 3 * l - 1 : 0) * T * 2, INP(22) + (size_t)(l > 0 ? l - 1 : 0) * DM, INP(23) + (size_t)(l > 0 ? l - 1 : 0) * DM,
                          (bf16_t*)(ws + WS_XN), ST + (size_t)(3 * l) * T * 2, ALPHA, 0};
            pg8::gemm_phase<pg8::EpiRes, true>((LAS unsigned char*)lds, g, S, E);
        }
        GRID_BAR();

        {
            unsigned char* ws = ws_opaque(a);
            const float* cl = (const float*)(ws + WS_C) + (size_t)l * C_LAYER;
            pg8::Gemm g{(const bf16_t*)(ws + WS_XN), (const bf16_t*)(ws + WS_W + (size_t)l * W_LAYER + W_KV), DM, DM, DM, 4, (long)SEQ * DM, 0, (long)4 * NMEM * DM, (long)NMEM * DM};
            pg8::Order S; S.init(SEQ, NMEM, 8, G, cu_opaque());
            pg8::EpiSoftmax E{(bf16_t*)(ws + WS_PROJ + 64 * MiB), (const float*)(ws + WS_ST) + (size_t)(3 * l) * T * 2, cl + C_Q, cl + C_QK2, 0.044194173824159216f};
            pg8::gemm_phase<pg8::EpiSoftmax, true>((LAS unsigned char*)lds, g, S, E);
        }
        GRID_BAR();
        {
            unsigned char* ws = ws_opaque(a); float* ST = (float*)(ws + WS_ST);
            pg8::Gemm g{(const bf16_t*)(ws + WS_PROJ + 64 * MiB), (const bf16_t*)(ws + WS_W + (size_t)l * W_LAYER + W_KV + 8 * MiB), 1024, 1024, 1024, 1, (long)SEQ * 1024, 0, (long)DM * 1024, 0};
            pg8::Order S; S.init(SEQ, DM, 2, G, cu_opaque());
            pg8::EpiRes E{nullptr, nullptr, ST + (size_t)(3 * l) * T * 2, INP(13) + (size_t)l * DM, INP(14) + (size_t)l * DM, (bf16_t*)(ws + WS_XN), ST + (size_t)(3 * l + 1) * T * 2, ALPHA, SEQ};
            pg8::gemm_phase<pg8::EpiRes, true>((LAS unsigned char*)lds, g, S, E);
        }
        GRID_BAR();
        {
            unsigned char* ws = ws_opaque(a);
            const float* cl = (const float*)(ws + WS_C) + (size_t)l * C_LAYER;
            pg8::Gemm g{(const bf16_t*)(ws + WS_XN), (const bf16_t*)(ws + WS_W + (size_t)l * W_LAYER + W_GU), DM, DM, DM, 1, 0, 0, 0, 0};
            pg8::Order S; S.init(T, 2 * DFF, 1, G, cu_opaque());
            pg8::EpiSwiglu E{(bf16_t*)(ws + WS_PROJ), (const float*)(ws + WS_ST) + (size_t)(3 * l + 1) * T * 2, cl + C_GU, cl + C_GU + 2 * DFF};
            pg8::gemm_phase<pg8::EpiSwiglu, true>((LAS unsigned char*)lds, g, S, E);
        }
        GRID_BAR();
        {
            unsigned char* ws = ws_opaque(a); float* X = out_opaque(a); float* ST = (float*)(ws + WS_ST);
            pg8::Gemm g{(const bf16_t*)(ws + WS_PROJ), (const bf16_t*)(ws + WS_W + (size_t)l * W_LAYER + W_D), DFF, DFF, DFF, 1, 0, 0, 0, 0};
            pg8::Order S; S.init(T, DM, 1, G, cu_opaque());
            pg8::EpiRes E{nullptr, nullptr, ST + (size_t)(3 * l + 1) * T * 2, INP(18) + (size_t)l * DM, INP(19) + (size_t)l * DM, (bf16_t*)(ws + WS_XN), ST + (size_t)(3 * l + 2) * T * 2, ALPHA, 0};
            pg8::gemm_phase<pg8::EpiRes, true>((LAS unsigned char*)lds, g, S, E);
        }
        GRID_BAR();
        if (l + 1 == DEPTH) { LN_OUT_PASS(INP(22) + (size_t)l * DM, INP(23) + (size_t)l * DM); }
#undef LN_OUT_PASS
    }
    if (a.ws == nullptr) cg::this_grid().sync();
}

extern "C" void kernel_launch(void* const* d_in, const int* in_sizes, int n_in, void* d_out, int out_size, void* d_ws, size_t ws_size, hipStream_t stream) {
    static int grid = 0;
    if (grid == 0) {
        if (n_in != 24 || in_sizes[0] != T * DM || out_size != T * DM || ws_size < WS_END) {
            fprintf(stderr, "kernel_launch: unexpected shapes (n_in %d, in0 %d, out %d, ws %zu); nothing launched\n", n_in, n_in > 0 ? in_sizes[0] : -1, out_size, ws_size); grid = -1; return; }
        int dev = 0, cus = 0, per_cu = 0;
        (void)hipGetDevice(&dev);
        if (hipDeviceGetAttribute(&cus, hipDeviceAttributeMultiprocessorCount, dev) != hipSuccess || cus <= 0) cus = 256;
        if (hipFuncSetAttribute((const void*)mega_fwd, hipFuncAttributeMaxDynamicSharedMemorySize, LDS_BYTES) != hipSuccess) fprintf(stderr, "kernel_launch: hipFuncSetAttribute failed\n");
        if (hipOccupancyMaxActiveBlocksPerMultiprocessor(&per_cu, (const void*)mega_fwd, NTHR, LDS_BYTES) != hipSuccess || per_cu < 1) { fprintf(stderr, "kernel_launch: occupancy query says %d\n", per_cu); per_cu = 1; }
        (void)hipGetLastError();
        grid = cus * per_cu;
    }
    if (grid < 0) return;
    if (hipMemsetAsync((char*)d_ws + WS_BAR, 0, WS_ST + 1 * MiB - WS_BAR, stream) != hipSuccess) { fprintf(stderr, "kernel_launch: hipMemsetAsync failed\n"); return; }
    Args a{};
    for (int i = 0; i < 24; ++i) a.in[i] = (const float*)d_in[i];
    a.out = (float*)d_out; a.ws = (unsigned char*)d_ws;
    void* args[] = {&a};
    hipError_t e = hipLaunchCooperativeKernel((const void*)mega_fwd, dim3(grid), dim3(NTHR), args, LDS_BYTES, stream);
    if (e != hipSuccess) fprintf(stderr, "cooperative launch failed: %s (grid %d)\n", hipGetErrorString(e), grid);
}
```
